# Optimizing an MI355X kernel written in HIP

```python
import jax
import jax.numpy as jnp
from jax import lax
import numpy as np

D_MODEL = 1024
BATCH = 32
SEQ = 256
DEPTH = 2
DEC_BATCH = 4
DEC_SEQ = 1024
PAST_LEN = 256

GRID_W = 64
N_BRANCH = 3
D_A = D_MODEL // 2
N_A = 64
H_A = D_A // N_A
W_LORA = 64
A_LORA = 64
G_LORA = 128
D_B = D_MODEL // 2
DH_B = 64
H_B = D_B // DH_B
NA_KH = 8
NA_KW = 16
D_C = D_MODEL // 2
DH_C = 64
H_C = D_C // DH_C
RET_CHUNK = 64
D_FF = 2816
ROPE_BASE = 10000.0
QBLOCK = 128
RWKV_COLS = 3 * D_A + W_LORA + A_LORA + G_LORA
NA_COLS = 3 * D_B
RET_COLS = 4 * D_C
GATE_COLS = N_BRANCH * D_MODEL
IN_COLS = RWKV_COLS + NA_COLS + RET_COLS + GATE_COLS
NEG_BIG = -1e9
RWKV_LN_EPS = 64e-5
RET_GN_EPS = 1e-5
F32 = jnp.float32

kernel_name = 'hybrid_rwkv7_natten_retention_diffusion_step'


def rmsnorm(x, g, eps=1e-6):
    xf = x.astype(F32)
    y = xf * lax.rsqrt(jnp.mean(xf * xf, axis=-1, keepdims=True) + eps)
    return (y * g.astype(F32)).astype(x.dtype)


def head_groupnorm(y, eps):
    B, T, H, Dh = y.shape
    yf = y.astype(F32)
    mu = jnp.mean(yf, axis=-1, keepdims=True)
    var = jnp.mean(jnp.square(yf - mu), axis=-1, keepdims=True)
    return ((yf - mu) * lax.rsqrt(var + eps)).reshape(B, T, H * Dh)


def dwconv3(x, w):
    xp = jnp.pad(x, ((0, 0), (1, 1), (0, 0)))
    return xp[:, :-2] * w[0] + xp[:, 1:-1] * w[1] + xp[:, 2:] * w[2]


def ada_modulation(cvec, w, b):
    m = jax.nn.silu(cvec) @ w + b
    return m.reshape(m.shape[0], 6, D_MODEL)


def axial_rope(x):
    B, T, H, Dh = x.shape
    t = jnp.arange(T)
    half = Dh // 2
    nf = half // 2
    inv = ROPE_BASE ** (-jnp.arange(nf, dtype=F32) / nf)

    def rot(xp, pos):
        ang = pos.astype(F32)[:, None] * inv[None, :]
        cos = jnp.cos(ang)[None, :, None, :]
        sin = jnp.sin(ang)[None, :, None, :]
        x1 = xp[..., :nf].astype(F32)
        x2 = xp[..., nf:].astype(F32)
        return jnp.concatenate([x1 * cos - x2 * sin, x1 * sin + x2 * cos], axis=-1)

    out = jnp.concatenate([rot(x[..., :half], t // GRID_W), rot(x[..., half:], t % GRID_W)], axis=-1)
    return out.astype(x.dtype)


def wkv7_scan(r, w, k, v, a, b, s0, reverse):
    xs = tuple(jnp.moveaxis(t.astype(F32), 1, 0) for t in (r, w, k, v, a, b))

    def step(S, inp):
        r_t, w_t, k_t, v_t, a_t, b_t = inp
        sa = jnp.einsum('bhvk,bhk->bhv', S, a_t)
        S = S * w_t[:, :, None, :] + sa[..., None] * b_t[:, :, None, :] + v_t[..., None] * k_t[:, :, None, :]
        return S, jnp.einsum('bhvk,bhk->bhv', S, r_t)

    S, ys = lax.scan(step, s0.astype(F32), xs, reverse=reverse)
    return jnp.moveaxis(ys, 0, 1), S


def rwkv7_branch(z, s0, lp):
    B, T, _ = z.shape
    r, k, v, wl, al, gl = jnp.split(z, [D_A, 2 * D_A, 3 * D_A, 3 * D_A + W_LORA, 3 * D_A + W_LORA + A_LORA], axis=-1)
    heads = lambda t: t.reshape(B, T, H_A, N_A)
    kk = heads(k * lp['rwkv_k_k']).astype(F32)
    kk = kk / jnp.maximum(jnp.sqrt(jnp.sum(kk * kk, axis=-1, keepdims=True)), 1e-12)
    g = jax.nn.sigmoid(gl) @ lp['rwkv_g_up']
    wt = jnp.tanh(wl)
    ys = []
    states = []
    for d in range(2):
        w_log = -jax.nn.softplus(-(lp['rwkv_w0'][d] + wt @ lp['rwkv_w_up'][d]).astype(F32)) - 0.5
        decay = jnp.exp(-jnp.exp(w_log))
        a = jax.nn.sigmoid((lp['rwkv_a0'][d] + al @ lp['rwkv_a_up'][d]).astype(F32))
        k_d = k.astype(F32) * (1.0 + (a - 1.0) * lp['rwkv_k_a'].astype(F32))
        y_d, s_d = wkv7_scan(heads(r), heads(decay), heads(k_d), heads(v), -kk, kk * heads(a), s0[:, d], d == 1)
        ys.append(y_d)
        states.append(s_d)
    y = ys[0] + ys[1]
    bonus = jnp.sum(heads(r) * heads(k) * lp['rwkv_r_k'], axis=-1, keepdims=True) * heads(v)
    o = head_groupnorm(y, RWKV_LN_EPS) * lp['rwkv_ln_g'].astype(F32) + lp['rwkv_ln_b'].astype(F32)
    o = (o.astype(z.dtype) + bonus.reshape(B, T, D_A)) * g
    return o @ lp['w_o_rwkv'], jnp.stack(states, axis=1).astype(s0.dtype)


def dense_attention(q, k, v):
    B, L, H, D = q.shape
    qb = q.reshape(B, L // QBLOCK, QBLOCK, H, D).transpose(1, 0, 2, 3, 4)

    def block(qi):
        s = jnp.einsum('bqhd,bhkd->bhqk', qi, k).astype(F32) * (D ** -0.5)
        p = jax.nn.softmax(s, axis=-1).astype(v.dtype)
        return jnp.einsum('bhqk,bhkd->bqhd', p, v)

    o = lax.map(block, qb)
    return o.transpose(1, 0, 2, 3, 4).reshape(B, L, H, D)


def neighbourhood_attention(q, k, v, k_ctx, v_ctx, rpb):
    B, T, H, D = q.shape
    rows = T // GRID_W
    kh = min(NA_KH, rows)
    scale = D ** -0.5
    qg = q.reshape(B, rows, GRID_W, H, D).transpose(1, 0, 2, 3, 4)
    kg = k.reshape(B, rows, GRID_W, H, D)
    vg = v.reshape(B, rows, GRID_W, H, D)
    cols = jnp.arange(GRID_W)
    c_start = jnp.clip(cols - NA_KW // 2, 0, GRID_W - NA_KW)
    col_valid = (cols[None, :] >= c_start[:, None]) & (cols[None, :] < c_start[:, None] + NA_KW)
    dc = jnp.clip(cols[None, :] - cols[:, None], -(NA_KW - 1), NA_KW - 1) + NA_KW - 1
    r_idx = jnp.arange(rows)
    r_start = jnp.clip(r_idx - kh // 2, 0, rows - kh)

    def row_block(args):
        q_r, r, rs = args
        k_r = lax.dynamic_slice_in_dim(kg, rs, kh, axis=1)
        v_r = lax.dynamic_slice_in_dim(vg, rs, kh, axis=1)
        dr = rs + jnp.arange(kh) - r + NA_KH - 1
        bias = rpb[:, dr[None, :, None], dc[:, None, :]].astype(F32)
        s_loc = jnp.einsum('bqhd,bjwhd->bhqjw', q_r, k_r).astype(F32) * scale + bias[None]
        s_loc = jnp.where(col_valid[:, None, :], s_loc, NEG_BIG).reshape(B, H, GRID_W, kh * GRID_W)
        s_ctx = jnp.einsum('bqhd,bhld->bhql', q_r, k_ctx).astype(F32) * scale
        p = jax.nn.softmax(jnp.concatenate([s_loc, s_ctx], axis=-1), axis=-1).astype(v.dtype)
        o = jnp.einsum('bhqn,bnhd->bqhd', p[..., :kh * GRID_W], v_r.reshape(B, kh * GRID_W, H, D))
        return o + jnp.einsum('bhql,bhld->bqhd', p[..., kh * GRID_W:], v_ctx)

    o = lax.map(row_block, (qg, r_idx, r_start))
    return o.transpose(1, 0, 2, 3, 4).reshape(B, T, H, D)


def retention_chunkwise(q, k, v, log_gamma, s0):
    B, T, H, Dh = q.shape
    n = T // RET_CHUNK
    j = jnp.arange(RET_CHUNK, dtype=F32)
    diff = j[:, None] - j[None, :]
    dmat = jnp.where(diff >= 0, jnp.exp(log_gamma[:, None, None] * jnp.maximum(diff, 0.0)), 0.0)
    xi = jnp.exp(log_gamma[:, None] * (j + 1.0))[:, :, None]
    zeta = jnp.exp(log_gamma[:, None] * (RET_CHUNK - 1.0 - j))[:, :, None]
    g_chunk = jnp.exp(log_gamma * RET_CHUNK)[:, None, None]

    def chunks(t):
        return t.astype(F32).reshape(B, n, RET_CHUNK, H, Dh).transpose(1, 0, 3, 2, 4)

    def step(S, inp):
        qi, ki, vi = inp
        inner = jnp.einsum('bhid,bhjd->bhij', qi, ki) * dmat
        o = jnp.einsum('bhij,bhjv->bhiv', inner, vi) + jnp.einsum('bhid,bhdv->bhiv', qi, S) * xi
        S = S * g_chunk + jnp.einsum('bhjd,bhjv->bhdv', ki * zeta, vi)
        return S, o

    S, o = lax.scan(step, s0.astype(F32), (chunks(q), chunks(k), chunks(v)))
    return o.transpose(1, 0, 3, 2, 4).reshape(B, T, H, Dh), S


def retention_branch(z, s0, lp, use_rope):
    B, T, _ = z.shape
    q, k, v, g = jnp.split(z, 4, axis=-1)
    q, k, v = (t.reshape(B, T, H_C, DH_C) for t in (q, k, v))
    if use_rope:
        q, k = axial_rope(q), axial_rope(k)
    k = k * (DH_C ** -0.5)
    lg = jax.nn.log_sigmoid(lp['ret_decay'].astype(F32))
    y_f, s_f = retention_chunkwise(q, k, v, lg[0], s0[:, 0])
    y_b, s_b = retention_chunkwise(jnp.flip(q, 1), jnp.flip(k, 1), jnp.flip(v, 1), lg[1], s0[:, 1])
    y = y_f + jnp.flip(y_b, 1)
    o = (head_groupnorm(y, RET_GN_EPS) * lp['ret_gn'].astype(F32)).astype(z.dtype) * jax.nn.silu(g)
    return o @ lp['w_o_ret'], jnp.stack([s_f, s_b], axis=1).astype(s0.dtype)


def conv_ffn(h, w_up, w_conv, w_down):
    u = dwconv3(h @ w_up, w_conv)
    val, gate = jnp.split(u, 2, axis=-1)
    return (jax.nn.gelu(gate) * val) @ w_down


def trunk_layer(x, m, lp, s_rwkv, s_ret, k_ctx, v_ctx, is_ctx):
    B, T, _ = x.shape
    sh1, sc1, g1, sh2, sc2, g2 = (m[:, i][:, None, :] for i in range(6))
    h = rmsnorm(x, lp['norm_mix_pre']) * (1.0 + sc1) + sh1
    z = h @ lp['w_in']
    o0 = RWKV_COLS
    o1 = o0 + NA_COLS
    o2 = o1 + RET_COLS
    z_rwkv = dwconv3(z[..., :o0], lp['rwkv_conv'])
    z_na = z[..., o0:o1]
    z_ret = z[..., o1:o2]
    gates = jax.nn.sigmoid(z[..., o2:]).reshape(B, T, N_BRANCH, D_MODEL)
    out_a, st_rwkv = rwkv7_branch(z_rwkv, s_rwkv, lp)
    q, k, v = (t.reshape(B, T, H_B, DH_B) for t in jnp.split(z_na, 3, axis=-1))
    if is_ctx:
        k_ctx = k.transpose(0, 2, 1, 3)
        v_ctx = v.transpose(0, 2, 1, 3)
        o_na = dense_attention(q, k_ctx, v_ctx)
    else:
        o_na = neighbourhood_attention(q, k, v, k_ctx, v_ctx, lp['na_rpb'])
    out_b = o_na.reshape(B, T, D_B) @ lp['w_o_na']
    out_c, st_ret = retention_branch(z_ret, s_ret, lp, not is_ctx)
    merged = gates[:, :, 0] * out_a + gates[:, :, 1] * out_b + gates[:, :, 2] * out_c
    x = x + g1 * rmsnorm(merged @ lp['w_out'], lp['norm_mix_post'])
    h2 = rmsnorm(x, lp['norm_ffn_pre']) * (1.0 + sc2) + sh2
    x = x + g2 * rmsnorm(conv_ffn(h2, lp['ffn_up'], lp['ffn_conv'], lp['ffn_down']), lp['norm_ffn_post'])
    return x, st_rwkv, st_ret, k_ctx, v_ctx


def setup_inputs(seed: int = 0) -> dict:
    key = jax.random.key(seed)
    ks = jax.random.split(key, 48)
    cnt = [0]

    def nxt():
        cnt[0] += 1
        return ks[cnt[0] - 1]

    def nrm(shape, scale):
        return jax.random.normal(nxt(), shape, F32) * scale

    def gain(shape):
        return 1.0 + nrm(shape, 0.05)

    def conv3(ch):
        return nrm((DEPTH, 3, ch), 0.2).at[:, 1].add(1.0)

    ret_base = jnp.log(2.0 ** (5.0 + jnp.arange(H_C, dtype=F32)) - 1.0)
    return {
        'x_prompt': nrm((BATCH, SEQ, D_MODEL), 1.0),
        'x_sample': nrm((DEC_BATCH, DEC_SEQ, D_MODEL), 1.0),
        'cache_na_k': nrm((DEC_BATCH, DEPTH, H_B, PAST_LEN, DH_B), 1.0),
        'cache_na_v': nrm((DEC_BATCH, DEPTH, H_B, PAST_LEN, DH_B), 1.0),
        'state_rwkv': nrm((DEC_BATCH, DEPTH, 2, H_A, N_A, N_A), 0.3),
        'state_ret': nrm((DEC_BATCH, DEPTH, 2, H_C, DH_C, DH_C), 0.3),
        'c': nrm((DEC_BATCH, D_MODEL), 1.0),
        'c_ctx': nrm((D_MODEL,), 1.0),
        'ada_w': nrm((DEPTH, D_MODEL, 6 * D_MODEL), D_MODEL ** -0.5),
        'ada_b': nrm((DEPTH, 6 * D_MODEL), 0.01),
        'norm_mix_pre': gain((DEPTH, D_MODEL)),
        'norm_mix_post': gain((DEPTH, D_MODEL)),
        'norm_ffn_pre': gain((DEPTH, D_MODEL)),
        'norm_ffn_post': gain((DEPTH, D_MODEL)),
        'w_in': nrm((DEPTH, D_MODEL, IN_COLS), D_MODEL ** -0.5),
        'rwkv_conv': conv3(RWKV_COLS),
        'rwkv_w0': jax.random.uniform(nxt(), (DEPTH, 2, D_A), F32, -6.0, 1.0),
        'rwkv_w_up': nrm((DEPTH, 2, W_LORA, D_A), 0.5 * W_LORA ** -0.5),
        'rwkv_a0': nrm((DEPTH, 2, D_A), 0.3),
        'rwkv_a_up': nrm((DEPTH, 2, A_LORA, D_A), 0.5 * A_LORA ** -0.5),
        'rwkv_g_up': nrm((DEPTH, G_LORA, D_A), G_LORA ** -0.5),
        'rwkv_k_k': 0.85 + nrm((DEPTH, D_A), 0.05),
        'rwkv_k_a': gain((DEPTH, D_A)),
        'rwkv_r_k': nrm((DEPTH, H_A, N_A), 0.1),
        'rwkv_ln_g': gain((DEPTH, D_A)),
        'rwkv_ln_b': nrm((DEPTH, D_A), 0.01),
        'na_rpb': nrm((DEPTH, H_B, 2 * NA_KH - 1, 2 * NA_KW - 1), 0.1),
        'ret_decay': ret_base + nrm((DEPTH, 2, H_C), 0.05),
        'ret_gn': gain((DEPTH, D_C)),
        'w_o_rwkv': nrm((DEPTH, D_A, D_MODEL), D_A ** -0.5),
        'w_o_na': nrm((DEPTH, D_B, D_MODEL), D_B ** -0.5),
        'w_o_ret': nrm((DEPTH, D_C, D_MODEL), D_C ** -0.5),
        'w_out': nrm((DEPTH, D_MODEL, D_MODEL), D_MODEL ** -0.5),
        'ffn_up': nrm((DEPTH, D_MODEL, 2 * D_FF), D_MODEL ** -0.5),
        'ffn_conv': conv3(2 * D_FF),
        'ffn_down': nrm((DEPTH, D_FF, D_MODEL), D_FF ** -0.5),
    }


def reference(x_prompt, x_sample, cache_na_k, cache_na_v, state_rwkv, state_ret, c,
              c_ctx, ada_w, ada_b, norm_mix_pre, norm_mix_post, norm_ffn_pre, norm_ffn_post,
              w_in, rwkv_conv, rwkv_w0, rwkv_w_up, rwkv_a0, rwkv_a_up, rwkv_g_up,
              rwkv_k_k, rwkv_k_a, rwkv_r_k, rwkv_ln_g, rwkv_ln_b, na_rpb, ret_decay, ret_gn,
              w_o_rwkv, w_o_na, w_o_ret, w_out, ffn_up, ffn_conv, ffn_down):
    bp = x_prompt.shape[0]
    xp = x_prompt
    xs = x_sample
    new_k, new_v, new_rw, new_rt = [], [], [], []
    for l in range(DEPTH):
        lp = {
            'norm_mix_pre': norm_mix_pre[l], 'norm_mix_post': norm_mix_post[l],
            'norm_ffn_pre': norm_ffn_pre[l], 'norm_ffn_post': norm_ffn_post[l],
            'w_in': w_in[l], 'rwkv_conv': rwkv_conv[l], 'rwkv_w0': rwkv_w0[l], 'rwkv_w_up': rwkv_w_up[l],
            'rwkv_a0': rwkv_a0[l], 'rwkv_a_up': rwkv_a_up[l], 'rwkv_g_up': rwkv_g_up[l],
            'rwkv_k_k': rwkv_k_k[l], 'rwkv_k_a': rwkv_k_a[l], 'rwkv_r_k': rwkv_r_k[l],
            'rwkv_ln_g': rwkv_ln_g[l], 'rwkv_ln_b': rwkv_ln_b[l], 'na_rpb': na_rpb[l],
            'ret_decay': ret_decay[l], 'ret_gn': ret_gn[l], 'w_o_rwkv': w_o_rwkv[l], 'w_o_na': w_o_na[l],
            'w_o_ret': w_o_ret[l], 'w_out': w_out[l], 'ffn_up': ffn_up[l], 'ffn_conv': ffn_conv[l],
            'ffn_down': ffn_down[l],
        }
        m_ctx = ada_modulation(c_ctx[None, :], ada_w[l], ada_b[l])
        zero_rw = jnp.zeros((bp, 2, H_A, N_A, N_A), xp.dtype)
        zero_rt = jnp.zeros((bp, 2, H_C, DH_C, DH_C), xp.dtype)
        xp, st_rw, st_rt, k_c, v_c = trunk_layer(xp, m_ctx, lp, zero_rw, zero_rt, None, None, True)
        new_k.append(k_c)
        new_v.append(v_c)
        new_rw.append(st_rw)
        new_rt.append(st_rt)
        m_lat = ada_modulation(c, ada_w[l], ada_b[l])
        xs, _, _, _, _ = trunk_layer(xs, m_lat, lp, state_rwkv[:, l], state_ret[:, l],
                                     cache_na_k[:, l], cache_na_v[:, l], False)
    return (xp, xs, jnp.stack(new_k, axis=1), jnp.stack(new_v, axis=1), jnp.stack(new_rw, axis=1), jnp.stack(new_rt, axis=1))
```

```cpp
#include <hip/hip_runtime.h>
#include <hip/hip_cooperative_groups.h>
#include <cstdio>
namespace cg = cooperative_groups;

#ifndef MEGA
#define MEGA 1
#endif

typedef unsigned short bf16_t;
typedef short bf16x8 __attribute__((ext_vector_type(8)));
typedef short bf16x4 __attribute__((ext_vector_type(4)));
typedef float f32x4 __attribute__((ext_vector_type(4)));
typedef float f32x2 __attribute__((ext_vector_type(2)));
typedef unsigned u32x4 __attribute__((ext_vector_type(4)));
typedef unsigned u32x2 __attribute__((ext_vector_type(2)));
#define DI __device__ __forceinline__
#define MFMA16(a, b, c) __builtin_amdgcn_mfma_f32_16x16x32_bf16((a), (b), (c), 0, 0, 0)

constexpr int NT = 256;
constexpr int D = 1024, MC = 8192, ML = 4096, MT = 12288;
constexpr int NZR = 1792, NZN = 1536, NZT = 2048, INC = 8448, FF = 2816;
constexpr int LDT = 72;
constexpr int SMEM_BYTES = 128 * 132 * 4;
constexpr size_t O_K = 12582912, O_V = 20971520, O_RW = 29360128, O_RT = 33554432;
constexpr size_t WS_CTRL = 0;
constexpr size_t WS_MOD = 4096;
constexpr size_t WS_WIN = 262144;
constexpr size_t WS_WUP = WS_WIN;
constexpr size_t WS_WDN = WS_WIN + (size_t)5632 * 1024 * 2;
constexpr size_t WS_WO3 = WS_WIN + (size_t)INC * 1024 * 2;
constexpr size_t WS_WOUT = WS_WO3 + (size_t)3 * 1024 * 512 * 2;
constexpr size_t WS_H = WS_WOUT + (size_t)1024 * 1024 * 2;
constexpr size_t WS_Z = WS_H + (size_t)MT * 1024 * 2;
constexpr size_t WS_ZR = WS_Z;
constexpr size_t WS_ZN = WS_ZR + (size_t)MT * NZR * 2;
constexpr size_t WS_ZT = WS_ZN + (size_t)MT * NZN * 2;
constexpr size_t WS_MERGED = WS_ZR;
constexpr size_t WS_OA = WS_ZN;
constexpr size_t WS_U = WS_ZT;
constexpr size_t WS_HID = WS_Z;
constexpr size_t WS_F = WS_ZT;
constexpr size_t WS_Y = WS_ZT + (size_t)MT * NZT * 2;
constexpr size_t WS_ONA = WS_Y + (size_t)2 * MT * 512 * 4;
constexpr size_t WS_ORET = WS_ONA + (size_t)MT * 512 * 2;
constexpr size_t WS_END = WS_ORET + (size_t)MT * 512 * 2;

struct P {
  const float *x_prompt, *x_sample, *cache_k, *cache_v, *state_rwkv, *state_ret, *c, *c_ctx, *ada_w, *ada_b;
  const float *norm_mix_pre, *norm_mix_post, *norm_ffn_pre, *norm_ffn_post, *w_in, *rwkv_conv, *rwkv_w0, *rwkv_w_up, *rwkv_a0, *rwkv_a_up, *rwkv_g_up;
  const float *rwkv_k_k, *rwkv_k_a, *rwkv_r_k, *rwkv_ln_g, *rwkv_ln_b, *na_rpb, *ret_decay, *ret_gn, *w_o_rwkv, *w_o_na, *w_o_ret, *w_out, *ffn_up, *ffn_conv, *ffn_down;
  float* out; char* ws;
};

DI int threadIdx_x_raw() { return (int)__builtin_amdgcn_workitem_id_x(); }
DI int tidx() { int t = threadIdx_x_raw(); asm volatile("" : "+v"(t)); return t; }
DI bf16_t f2bf(float x) { unsigned u = __float_as_uint(x); u += 0x7fffu + ((u >> 16) & 1u); return (bf16_t)(u >> 16); }
DI float bf2f(bf16_t b) { return __uint_as_float(((unsigned)b) << 16); }
DI unsigned pack2(float a, float b) { return (unsigned)f2bf(a) | ((unsigned)f2bf(b) << 16); }
DI float bflo(unsigned u) { return __uint_as_float(u << 16); }
DI float bfhi(unsigned u) { return __uint_as_float(u & 0xffff0000u); }
DI void unpack8(const u32x4 r, float (&f)[8]) { f[0] = bflo(r[0]); f[1] = bfhi(r[0]); f[2] = bflo(r[1]); f[3] = bfhi(r[1]); f[4] = bflo(r[2]); f[5] = bfhi(r[2]); f[6] = bflo(r[3]); f[7] = bfhi(r[3]); }
DI u32x4 pack8(const float (&f)[8]) { u32x4 r; r[0] = pack2(f[0], f[1]); r[1] = pack2(f[2], f[3]); r[2] = pack2(f[4], f[5]); r[3] = pack2(f[6], f[7]); return r; }
DI float sigmoidf_(float x) { return 1.f / (1.f + __expf(-x)); }
DI float wave_sum(float v) { for (int o = 32; o > 0; o >>= 1) v += __shfl_xor(v, o); return v; }
DI void tokinfo(int m, int& t, int& T, int& mi) { if (m < MC) { t = m & 255; T = 256; mi = 0; } else { int q = m - MC; t = q & 1023; T = 1024; mi = 1 + (q >> 10); } }

__device__ void convert_T(const float* __restrict__ W, int K, int N, bf16_t* __restrict__ Wt, char* smem) {
  float* t = (float*)smem;
  const int tid = tidx(), ntn = N >> 6, nitems = (K >> 6) * ntn;
  for (int it = blockIdx.x; it < nitems; it += gridDim.x) {
    const int k0 = (it / ntn) << 6, n0 = (it % ntn) << 6;
    __syncthreads();
#pragma unroll
    for (int i = 0; i < 4; ++i) { const int k = (tid >> 4) + 16 * i, c4 = (tid & 15) * 4;
      const float4 v = *(const float4*)(W + (size_t)(k0 + k) * N + n0 + c4);
      t[k * 65 + c4] = v.x; t[k * 65 + c4 + 1] = v.y; t[k * 65 + c4 + 2] = v.z; t[k * 65 + c4 + 3] = v.w; }
    __syncthreads();
#pragma unroll
    for (int i = 0; i < 2; ++i) { const int c = tid + 256 * i, n = c >> 3, kc = c & 7; float f[8];
#pragma unroll
      for (int e = 0; e < 8; ++e) f[e] = t[(kc * 8 + e) * 65 + n];
      *(u32x4*)(Wt + (size_t)(n0 + n) * K + k0 + kc * 8) = pack8(f); }
  }
}

__device__ void ada_phase(const P& p, char* smem) {
  float* sc = (float*)smem;
  float* red = sc + 640;
  float* mod = (float*)(p.ws + WS_MOD);
  const int tid = tidx(), kq = tid >> 5, cq = tid & 31;
  for (int it = blockIdx.x; it < 2 * 48 * 8; it += gridDim.x) {
    const int l = it / 384, rem = it % 384, nb = rem >> 3, ks = rem & 7;
    const int n0 = nb * 128, k0 = ks * 128;
    __syncthreads();
    for (int e = tid; e < 640; e += NT) { const int i = e >> 7, k = e & 127; const float v = (i == 0) ? p.c_ctx[k0 + k] : p.c[(i - 1) * D + k0 + k]; sc[e] = v * sigmoidf_(v); }
    __syncthreads();
    float acc[5][4];
#pragma unroll
    for (int i = 0; i < 5; ++i)
#pragma unroll
      for (int j = 0; j < 4; ++j) acc[i][j] = 0.f;
    const float* wp = p.ada_w + ((size_t)l * D + k0 + kq * 16) * 6144 + n0 + cq * 4;
#pragma unroll 4
    for (int kk = 0; kk < 16; ++kk) { const float4 w = *(const float4*)(wp + (size_t)kk * 6144);
#pragma unroll
      for (int i = 0; i < 5; ++i) { const float s = sc[i * 128 + kq * 16 + kk]; acc[i][0] += s * w.x; acc[i][1] += s * w.y; acc[i][2] += s * w.z; acc[i][3] += s * w.w; } }
#pragma unroll
    for (int i = 0; i < 5; ++i)
#pragma unroll
      for (int j = 0; j < 4; ++j) red[(kq * 5 + i) * 128 + cq * 4 + j] = acc[i][j];
    __syncthreads();
    for (int e = tid; e < 640; e += NT) { const int i = e >> 7, n = e & 127; float s = 0.f;
#pragma unroll
      for (int q = 0; q < 8; ++q) s += red[(q * 5 + i) * 128 + n];
      if (ks == 0) s += p.ada_b[l * 6144 + n0 + n];
      atomicAdd(mod + ((size_t)l * 5 + i) * 6144 + n0 + n, s); }
  }
}

__device__ void norm_phase(const P& p, const float* xin  , const float* u, const float* gpost, const float* modU, int gate_idx,
                           float* xout, const float* gpre, const float* modN, int shift_idx, bf16_t* hout) {
  const int lane = tidx() & 63, wave = tidx() >> 6, nw = NT / 64;
  for (int m = blockIdx.x * nw + wave; m < MT; m += gridDim.x * nw) {
    int t, T, mi; tokinfo(m, t, T, mi);
    const float* xr = xin ? xin + (size_t)m * D : (m < MC ? p.x_prompt + (size_t)m * D : p.x_sample + (size_t)(m - MC) * D);
    float4 x[4];
#pragma unroll
    for (int i = 0; i < 4; ++i) x[i] = *(const float4*)(xr + i * 256 + lane * 4);
    if (u) {
      float4 uu[4]; float ss = 0.f;
#pragma unroll
      for (int i = 0; i < 4; ++i) { uu[i] = *(const float4*)(u + (size_t)m * D + i * 256 + lane * 4); ss += uu[i].x * uu[i].x + uu[i].y * uu[i].y + uu[i].z * uu[i].z + uu[i].w * uu[i].w; }
      ss = wave_sum(ss); const float rs = rsqrtf(ss * (1.f / D) + 1e-6f);
#pragma unroll
      for (int i = 0; i < 4; ++i) { const int c = i * 256 + lane * 4; const float4 g = *(const float4*)(gpost + c); const float4 ga = *(const float4*)(modU + ((size_t)mi * 6 + gate_idx) * D + c);
        x[i].x += ga.x * uu[i].x * rs * g.x; x[i].y += ga.y * uu[i].y * rs * g.y; x[i].z += ga.z * uu[i].z * rs * g.z; x[i].w += ga.w * uu[i].w * rs * g.w; }
    }
    if (xout) {
#pragma unroll
      for (int i = 0; i < 4; ++i) *(float4*)(xout + (size_t)m * D + i * 256 + lane * 4) = x[i];
    }
    if (hout) {
      float ss = 0.f;
#pragma unroll
      for (int i = 0; i < 4; ++i) ss += x[i].x * x[i].x + x[i].y * x[i].y + x[i].z * x[i].z + x[i].w * x[i].w;
      ss = wave_sum(ss); const float rs = rsqrtf(ss * (1.f / D) + 1e-6f);
#pragma unroll
      for (int i = 0; i < 4; ++i) { const int c = i * 256 + lane * 4; const float4 g = *(const float4*)(gpre + c);
        const float4 sh = *(const float4*)(modN + ((size_t)mi * 6 + shift_idx) * D + c); const float4 sc = *(const float4*)(modN + ((size_t)mi * 6 + shift_idx + 1) * D + c);
        u32x2 o; o.x = pack2(x[i].x * rs * g.x * (1.f + sc.x) + sh.x, x[i].y * rs * g.y * (1.f + sc.y) + sh.y); o.y = pack2(x[i].z * rs * g.z * (1.f + sc.z) + sh.z, x[i].w * rs * g.w * (1.f + sc.w) + sh.w);
        *(u32x2*)(hout + (size_t)m * D + c) = o; }
    }
  }
}

struct TileSrc { const bf16_t* A; int lda; int arow0; const bf16_t* B; int ldb; int brow0, brow1; int K; };

template <int NN> DI void zero_acc(f32x4 (&acc)[4][NN]) {
#pragma unroll
  for (int m = 0; m < 4; ++m)
#pragma unroll
    for (int n = 0; n < NN; ++n) acc[m][n] = (f32x4){0.f, 0.f, 0.f, 0.f};
}

template <int NN> DI void gemm_tile(f32x4 (&acc)[4][NN], const TileSrc& s, char* smem) {
  bf16_t* sA = (bf16_t*)smem; bf16_t* sB = sA + 128 * LDT;
  const int tid = tidx(), lane = tid & 63, wave = tid >> 6, wr = wave >> 1, wc = wave & 1, fr = lane & 15, fq = lane >> 4;
  const bf16_t* ga[4]; const bf16_t* gb[NN];
#pragma unroll
  for (int i = 0; i < 4; ++i) { const int c = tid + 256 * i, row = c >> 3, kc = c & 7;
    int ar = s.arow0 + row; ar = ar < 0 ? 0 : (ar > MT - 1 ? MT - 1 : ar);
    ga[i] = s.A + (size_t)ar * s.lda + kc * 8; }
#pragma unroll
  for (int i = 0; i < NN; ++i) { const int c = tid + 256 * i, row = c >> 3, kc = c & 7;
    const int br = row < 64 ? s.brow0 + row : s.brow1 + row - 64;
    gb[i] = s.B + (size_t)br * s.ldb + kc * 8; }
  u32x4 ra[4], rb[NN];
#pragma unroll
  for (int i = 0; i < 4; ++i) ra[i] = *(const u32x4*)ga[i];
#pragma unroll
  for (int i = 0; i < NN; ++i) rb[i] = *(const u32x4*)gb[i];
  const int nk = s.K >> 6;
#pragma unroll 1
  for (int kt = 0; kt < nk; ++kt) {
    __syncthreads();
#pragma unroll
    for (int i = 0; i < 4; ++i) { const int c = tid + 256 * i, row = c >> 3, kc = c & 7; *(u32x4*)(sA + row * LDT + kc * 8) = ra[i]; }
#pragma unroll
    for (int i = 0; i < NN; ++i) { const int c = tid + 256 * i, row = c >> 3, kc = c & 7; *(u32x4*)(sB + row * LDT + kc * 8) = rb[i]; }
    __syncthreads();
    { const int kn = (kt + 1 < nk ? kt + 1 : kt) * 64;
#pragma unroll
      for (int i = 0; i < 4; ++i) ra[i] = *(const u32x4*)(ga[i] + kn);
#pragma unroll
      for (int i = 0; i < NN; ++i) rb[i] = *(const u32x4*)(gb[i] + kn); }
#pragma unroll
    for (int ks = 0; ks < 2; ++ks) {
      bf16x8 bfr[NN];
#pragma unroll
      for (int n = 0; n < NN; ++n) bfr[n] = *(const bf16x8*)(sB + (wc * 16 * NN + n * 16 + fr) * LDT + ks * 32 + fq * 8);
#pragma unroll
      for (int m = 0; m < 4; ++m) { const bf16x8 af = *(const bf16x8*)(sA + (wr * 64 + m * 16 + fr) * LDT + ks * 32 + fq * 8);
#pragma unroll
        for (int n = 0; n < NN; ++n) acc[m][n] = MFMA16(bfr[n], af, acc[m][n]); }
    }
  }
}

DI void stage_acc(const f32x4 (&acc)[4][4], float* sC) {
  const int lane = tidx() & 63, wave = tidx() >> 6, wr = wave >> 1, wc = wave & 1, fr = lane & 15, fq = lane >> 4;
  __syncthreads();
#pragma unroll
  for (int m = 0; m < 4; ++m)
#pragma unroll
    for (int n = 0; n < 4; ++n) *(f32x4*)(sC + (wr * 64 + m * 16 + fr) * 132 + wc * 64 + n * 16 + fq * 4) = acc[m][n];
  __syncthreads();
}

DI float gelu_tanh(float x) { const float u = 0.7978845608f * (x + 0.044715f * x * x * x); const float e = __expf(2.f * u); const float th = 1.f - 2.f / (e + 1.f); return 0.5f * x * (1.f + th); }

__device__ void phase_win(const P& p, int l, char* smem) {
  const bf16_t* H = (const bf16_t*)(p.ws + WS_H); const bf16_t* Wt = (const bf16_t*)(p.ws + WS_WIN);
  bf16_t* zr = (bf16_t*)(p.ws + WS_ZR); bf16_t* zn = (bf16_t*)(p.ws + WS_ZN); bf16_t* zt = (bf16_t*)(p.ws + WS_ZT);
  const int tid = tidx(), lane = tid & 63, wave = tid >> 6, wr = wave >> 1, wc = wave & 1, fr = lane & 15, fq = lane >> 4;
  const int nconv = 98 * 14, nreg = 96 * 28;
  for (int it = blockIdx.x; it < nconv + nreg; it += gridDim.x) {
    f32x4 acc[4][4]; zero_acc<4>(acc);
    if (it < nconv) {
      const int mt = it / 14, nt = it % 14, n0 = nt * 128, arow0 = mt * 126 - 1;
      TileSrc s{H, D, arow0, Wt, D, n0, n0 + 64, D};
      gemm_tile<4>(acc, s, smem);
      float* sC = (float*)smem; stage_acc(acc, sC);
      const float* cw = p.rwkv_conv + (size_t)l * 3 * NZR;
      for (int e = tid; e < 126 * 32; e += NT) {
        const int tr = 1 + (e >> 5), c4 = (e & 31) * 4, g = arow0 + tr;
        if (g < MT) { int t, T, mi; tokinfo(g, t, T, mi);
          const float pm = t > 0 ? 1.f : 0.f, nm = t < T - 1 ? 1.f : 0.f;
          const f32x4 a = *(const f32x4*)(sC + (tr - 1) * 132 + c4), b = *(const f32x4*)(sC + tr * 132 + c4), c = *(const f32x4*)(sC + (tr + 1) * 132 + c4);
          const float4 w0 = *(const float4*)(cw + n0 + c4), w1 = *(const float4*)(cw + NZR + n0 + c4), w2 = *(const float4*)(cw + 2 * NZR + n0 + c4);
          u32x2 o; o.x = pack2(pm * a[0] * w0.x + b[0] * w1.x + nm * c[0] * w2.x, pm * a[1] * w0.y + b[1] * w1.y + nm * c[1] * w2.y);
          o.y = pack2(pm * a[2] * w0.z + b[2] * w1.z + nm * c[2] * w2.z, pm * a[3] * w0.w + b[3] * w1.w + nm * c[3] * w2.w);
          *(u32x2*)(zr + (size_t)g * NZR + n0 + c4) = o; }
      }
    } else {
      const int r = it - nconv, mt = r / 28, nt = r % 28, n0 = nt * 128, row0 = mt * 128;
      TileSrc s{H, D, row0, Wt, D, NZR + n0, NZR + n0 + 64, D};
      gemm_tile<4>(acc, s, smem);
#pragma unroll
      for (int m = 0; m < 4; ++m) { const int row = row0 + wr * 64 + m * 16 + fr;
#pragma unroll
        for (int n = 0; n < 4; ++n) { const int col = n0 + wc * 64 + n * 16 + fq * 4; const f32x4 v = acc[m][n];
          u32x2 o; o.x = pack2(v[0], v[1]); o.y = pack2(v[2], v[3]);
          if (col < NZN) {
            *(u32x2*)(zn + (size_t)row * NZN + col) = o;
            if (row < MC && col >= 512) { const int part = col - 512, isv = part >> 9, pp = part & 511, hh = pp >> 6, d = pp & 63, b = row >> 8, t = row & 255;
              float* dst = p.out + (isv ? O_V : O_K) + ((((size_t)b * 2 + l) * 8 + hh) * 256 + t) * 64 + d; *(f32x4*)dst = v; }
          } else { *(u32x2*)(zt + (size_t)row * NZT + (col - NZN)) = o; }
        } }
    }
  }
}

__device__ void phase_merge(const P& p, char* smem) {
  const bf16_t* H = (const bf16_t*)(p.ws + WS_H); const bf16_t* Wt = (const bf16_t*)(p.ws + WS_WIN); const bf16_t* Wo3 = (const bf16_t*)(p.ws + WS_WO3);
  bf16_t* mg = (bf16_t*)(p.ws + WS_MERGED);
  const int tid = tidx(), lane = tid & 63, wave = tid >> 6, wr = wave >> 1, wc = wave & 1, fr = lane & 15, fq = lane >> 4;
  for (int it = blockIdx.x; it < 96 * 16; it += gridDim.x) {
    const int mt = it >> 4, nt = it & 15, n0 = nt * 64, row0 = mt * 128;
    f32x4 macc[4][2]; zero_acc<2>(macc);
#pragma unroll 1
    for (int i = 0; i < 3; ++i) {
      const bf16_t* O = (const bf16_t*)(p.ws + (i == 0 ? WS_OA : (i == 1 ? WS_ONA : WS_ORET)));
      f32x4 g[4][2]; zero_acc<2>(g);
      { TileSrc s{H, D, row0, Wt, D, 5376 + i * 1024 + n0, 0, D}; gemm_tile<2>(g, s, smem); }
      f32x4 a2[4][2]; zero_acc<2>(a2);
      { TileSrc s{O, 512, row0, Wo3 + (size_t)i * 1024 * 512, 512, n0, 0, 512}; gemm_tile<2>(a2, s, smem); }
#pragma unroll
      for (int m = 0; m < 4; ++m)
#pragma unroll
        for (int n = 0; n < 2; ++n)
#pragma unroll
          for (int j = 0; j < 4; ++j) macc[m][n][j] += sigmoidf_(g[m][n][j]) * a2[m][n][j];
    }
#pragma unroll
    for (int m = 0; m < 4; ++m) { const int row = row0 + wr * 64 + m * 16 + fr;
#pragma unroll
      for (int n = 0; n < 2; ++n) { const int col = n0 + wc * 32 + n * 16 + fq * 4; u32x2 o; o.x = pack2(macc[m][n][0], macc[m][n][1]); o.y = pack2(macc[m][n][2], macc[m][n][3]); *(u32x2*)(mg + (size_t)row * D + col) = o; } }
  }
}

__device__ void phase_gemm_f32(const bf16_t* A, int K, const bf16_t* Bt, float* C, char* smem) {
  const int tid = tidx(), lane = tid & 63, wave = tid >> 6, wr = wave >> 1, wc = wave & 1, fr = lane & 15, fq = lane >> 4;
  for (int it = blockIdx.x; it < 96 * 8; it += gridDim.x) {
    const int mt = it >> 3, nt = it & 7, n0 = nt * 128, row0 = mt * 128;
    f32x4 acc[4][4]; zero_acc<4>(acc);
    TileSrc s{A, K, row0, Bt, K, n0, n0 + 64, K}; gemm_tile<4>(acc, s, smem);
#pragma unroll
    for (int m = 0; m < 4; ++m) { const int row = row0 + wr * 64 + m * 16 + fr;
#pragma unroll
      for (int n = 0; n < 4; ++n) *(f32x4*)(C + (size_t)row * D + n0 + wc * 64 + n * 16 + fq * 4) = acc[m][n]; }
  }
}

__device__ void phase_ffn_up(const P& p, int l, char* smem) {
  const bf16_t* H = (const bf16_t*)(p.ws + WS_H); const bf16_t* Wt = (const bf16_t*)(p.ws + WS_WUP); bf16_t* hid = (bf16_t*)(p.ws + WS_HID);
  const int tid = tidx();
  const float* cw = p.ffn_conv + (size_t)l * 3 * 2 * FF;
  for (int it = blockIdx.x; it < 98 * 44; it += gridDim.x) {
    const int mt = it / 44, nt = it % 44, c0 = nt * 64, arow0 = mt * 126 - 1;
    f32x4 acc[4][4]; zero_acc<4>(acc);
    TileSrc s{H, D, arow0, Wt, D, c0, FF + c0, D};
    gemm_tile<4>(acc, s, smem);
    float* sC = (float*)smem; stage_acc(acc, sC);
    for (int e = tid; e < 126 * 16; e += NT) {
      const int tr = 1 + (e >> 4), c4 = (e & 15) * 4, g = arow0 + tr;
      if (g < MT) { int t, T, mi; tokinfo(g, t, T, mi);
        const float pm = t > 0 ? 1.f : 0.f, nm = t < T - 1 ? 1.f : 0.f;
        const f32x4 va = *(const f32x4*)(sC + (tr - 1) * 132 + c4), vb = *(const f32x4*)(sC + tr * 132 + c4), vc = *(const f32x4*)(sC + (tr + 1) * 132 + c4);
        const f32x4 ga = *(const f32x4*)(sC + (tr - 1) * 132 + 64 + c4), gb = *(const f32x4*)(sC + tr * 132 + 64 + c4), gc = *(const f32x4*)(sC + (tr + 1) * 132 + 64 + c4);
        const f32x4 v0 = *(const f32x4*)(cw + c0 + c4), v1 = *(const f32x4*)(cw + 2 * FF + c0 + c4), v2 = *(const f32x4*)(cw + 4 * FF + c0 + c4);
        const f32x4 g0 = *(const f32x4*)(cw + FF + c0 + c4), g1 = *(const f32x4*)(cw + 3 * FF + c0 + c4), g2 = *(const f32x4*)(cw + 5 * FF + c0 + c4);
        float r[4];
#pragma unroll
        for (int j = 0; j < 4; ++j) { const float val = pm * va[j] * v0[j] + vb[j] * v1[j] + nm * vc[j] * v2[j]; const float gt = pm * ga[j] * g0[j] + gb[j] * g1[j] + nm * gc[j] * g2[j]; r[j] = gelu_tanh(gt) * val; }
        u32x2 o; o.x = pack2(r[0], r[1]); o.y = pack2(r[2], r[3]);
        *(u32x2*)(hid + (size_t)g * FF + c0 + c4) = o; }
    }
  }
}

template <int CTRL> DI float dppf(float v) { return __int_as_float(__builtin_amdgcn_mov_dpp(__float_as_int(v), CTRL, 0xF, 0xF, true)); }
DI float quad_sum(float v) { v += dppf<0xB1>(v); v += dppf<0x4E>(v); return v; }

__device__ void scan_task(const P& p, int l, int seq, int h, int d, char* smem) {
  float* sR = (float*)smem; float* sW = sR + 1024; float* sKD = sW + 1024; float* sB = sKD + 1024; float* sNK = sB + 1024; float* sV = sNK + 1024; float* sK = sV + 1024; float* sY = sK + 1024;
  float* sKn = sY + 1024; float* sKK = sKn + 16; bf16_t* sWT = (bf16_t*)(sKK + 64); bf16_t* sAL = sWT + 16 * LDT;
  const int tid = tidx(), lane = tid & 63, wave = tid >> 6, fr = lane & 15, fq = lane >> 4;
  const int row0 = seq < 32 ? seq * 256 : MC + (seq - 32) * 1024, T = seq < 32 ? 256 : 1024, nch = T >> 4;
  const bf16_t* zr = (const bf16_t*)(p.ws + WS_ZR);
  float* yout = (float*)(p.ws + WS_Y) + (size_t)d * MT * 512;
  __syncthreads();
  if (tid < 64) sKK[tid] = p.rwkv_k_k[l * 512 + h * 64 + tid];
  const int cc = wave * 16 + fr, gc = h * 64 + cc;
  bf16x8 bw[2], ba[2];
#pragma unroll
  for (int ks = 0; ks < 2; ++ks)
#pragma unroll
    for (int e = 0; e < 8; ++e) { const int k = ks * 32 + fq * 8 + e;
      bw[ks][e] = (short)f2bf(p.rwkv_w_up[((size_t)(l * 2 + d) * 64 + k) * 512 + gc]); ba[ks][e] = (short)f2bf(p.rwkv_a_up[((size_t)(l * 2 + d) * 64 + k) * 512 + gc]); }
  const float w0c = p.rwkv_w0[(l * 2 + d) * 512 + gc], a0c = p.rwkv_a0[(l * 2 + d) * 512 + gc], kac = p.rwkv_k_a[l * 512 + gc];
  const int v = tid >> 2, q = tid & 3;
  f32x2 S[8];
  if (seq >= 32) { const float* s0 = p.state_rwkv + (((((size_t)(seq - 32) * 2 + l) * 2 + d) * 8 + h) * 64 + v) * 64 + q * 16;
#pragma unroll
    for (int i = 0; i < 8; ++i) { S[i].x = s0[2 * i]; S[i].y = s0[2 * i + 1]; } }
  else {
#pragma unroll
    for (int i = 0; i < 8; ++i) S[i] = (f32x2){0.f, 0.f}; }
  const int segbase[5] = {h * 64, 512 + h * 64, 1024 + h * 64, 1536, 1600};
  int ct[3], cseg[3], cpart[3]; bool cval[3]; size_t coff[3];
#pragma unroll
  for (int i = 0; i < 3; ++i) { const int c = tid + 256 * i; cval[i] = c < 640; const int cx = cval[i] ? c : 0; ct[i] = cx / 40; const int rem = cx % 40; cseg[i] = rem >> 3; cpart[i] = rem & 7;
    const int sb = cseg[i] == 0 ? segbase[0] : (cseg[i] == 1 ? segbase[1] : (cseg[i] == 2 ? segbase[2] : (cseg[i] == 3 ? segbase[3] : segbase[4])));
    coff[i] = (size_t)ct[i] * NZR + sb + cpart[i] * 8; }
  u32x4 pre[3];
  { const int t0 = (d ? nch - 1 : 0) * 16;
#pragma unroll
    for (int i = 0; i < 3; ++i) pre[i] = *(const u32x4*)(zr + (size_t)(row0 + t0) * NZR + coff[i]); }
  __syncthreads();
  for (int ci = 0; ci < nch; ++ci) {
    const int chunk = d ? nch - 1 - ci : ci, t0 = chunk * 16;
#pragma unroll
    for (int i = 0; i < 3; ++i) {
      float f[8]; unpack8(pre[i], f); float ps = 0.f;
      if (cval[i]) {
        const int t = ct[i], o = t * 64 + cpart[i] * 8;
        if (cseg[i] == 0) { *(float4*)(sR + o) = make_float4(f[0], f[1], f[2], f[3]); *(float4*)(sR + o + 4) = make_float4(f[4], f[5], f[6], f[7]); }
        else if (cseg[i] == 1) { *(float4*)(sK + o) = make_float4(f[0], f[1], f[2], f[3]); *(float4*)(sK + o + 4) = make_float4(f[4], f[5], f[6], f[7]);
#pragma unroll
          for (int e = 0; e < 8; ++e) { const float kk = f[e] * sKK[cpart[i] * 8 + e]; ps += kk * kk; } }
        else if (cseg[i] == 2) { *(float4*)(sV + o) = make_float4(f[0], f[1], f[2], f[3]); *(float4*)(sV + o + 4) = make_float4(f[4], f[5], f[6], f[7]); }
        else if (cseg[i] == 3) { float g[8];
#pragma unroll
          for (int e = 0; e < 8; ++e) g[e] = 1.f - 2.f / (__expf(2.f * f[e]) + 1.f);
          *(u32x4*)(sWT + t * LDT + cpart[i] * 8) = pack8(g); }
        else { *(u32x4*)(sAL + t * LDT + cpart[i] * 8) = pre[i]; }
      }
      ps += __shfl_xor(ps, 1); ps += __shfl_xor(ps, 2); ps += __shfl_xor(ps, 4);
      if (cval[i] && cseg[i] == 1 && cpart[i] == 0) sKn[ct[i]] = ps;
    }
    __syncthreads();
    {
      f32x4 aw = {0.f, 0.f, 0.f, 0.f}, aa = {0.f, 0.f, 0.f, 0.f};
#pragma unroll
      for (int ks = 0; ks < 2; ++ks) { const bf16x8 fw = *(const bf16x8*)(sWT + fr * LDT + ks * 32 + fq * 8); const bf16x8 fa = *(const bf16x8*)(sAL + fr * LDT + ks * 32 + fq * 8);
        aw = MFMA16(fw, bw[ks], aw); aa = MFMA16(fa, ba[ks], aa); }
#pragma unroll
      for (int j = 0; j < 4; ++j) { const int t = fq * 4 + j, o = t * 64 + cc;
        const float dec = __expf(-0.6065306597f * sigmoidf_(w0c + aw[j]));
        const float a = sigmoidf_(a0c + aa[j]);
        const float kv = sK[o];
        const float kkv = kv * sKK[cc] / fmaxf(sqrtf(sKn[t]), 1e-12f);
        sW[o] = dec; sKD[o] = kv * (1.f + (a - 1.f) * kac); sB[o] = kkv * a; sNK[o] = -kkv; }
    }
    __syncthreads();
    { const int cn = ci + 1 < nch ? ci + 1 : ci; const int nt0 = (d ? nch - 1 - cn : cn) * 16;
#pragma unroll
      for (int i = 0; i < 3; ++i) pre[i] = *(const u32x4*)(zr + (size_t)(row0 + nt0) * NZR + coff[i]); }
#pragma unroll 1
    for (int si = 0; si < 16; ++si) {
      const int t = d ? 15 - si : si, o = t * 64 + q * 16;
      f32x2 an[8], wv[8], bv[8], kd[8], rv[8];
#pragma unroll
      for (int i = 0; i < 4; ++i) { const f32x4 x = *(const f32x4*)(sNK + o + 4 * i); an[2 * i] = (f32x2){x[0], x[1]}; an[2 * i + 1] = (f32x2){x[2], x[3]}; }
#pragma unroll
      for (int i = 0; i < 4; ++i) { const f32x4 x = *(const f32x4*)(sW + o + 4 * i); wv[2 * i] = (f32x2){x[0], x[1]}; wv[2 * i + 1] = (f32x2){x[2], x[3]}; }
#pragma unroll
      for (int i = 0; i < 4; ++i) { const f32x4 x = *(const f32x4*)(sB + o + 4 * i); bv[2 * i] = (f32x2){x[0], x[1]}; bv[2 * i + 1] = (f32x2){x[2], x[3]}; }
#pragma unroll
      for (int i = 0; i < 4; ++i) { const f32x4 x = *(const f32x4*)(sKD + o + 4 * i); kd[2 * i] = (f32x2){x[0], x[1]}; kd[2 * i + 1] = (f32x2){x[2], x[3]}; }
#pragma unroll
      for (int i = 0; i < 4; ++i) { const f32x4 x = *(const f32x4*)(sR + o + 4 * i); rv[2 * i] = (f32x2){x[0], x[1]}; rv[2 * i + 1] = (f32x2){x[2], x[3]}; }
      const float vv = sV[t * 64 + v];
      f32x2 sa2 = S[0] * an[0];
#pragma unroll
      for (int i = 1; i < 8; ++i) sa2 += S[i] * an[i];
      const float sa = quad_sum(sa2.x + sa2.y);
      const f32x2 sav = {sa, sa}, vvv = {vv, vv};
      f32x2 y2 = {0.f, 0.f};
#pragma unroll
      for (int i = 0; i < 8; ++i) { S[i] = S[i] * wv[i] + (sav * bv[i] + vvv * kd[i]); y2 += S[i] * rv[i]; }
      const float y = quad_sum(y2.x + y2.y);
      if (q == 0) sY[t * 64 + v] = y;
    }
    __syncthreads();
    { const int t = tid >> 4, v4 = (tid & 15) * 4; *(float4*)(yout + (size_t)(row0 + t0 + t) * 512 + h * 64 + v4) = *(const float4*)(sY + t * 64 + v4); }
  }
  if (seq < 32) { float* so = p.out + O_RW + (((((size_t)seq * 2 + l) * 2 + d) * 8 + h) * 64 + v) * 64 + q * 16;
#pragma unroll
    for (int i = 0; i < 8; ++i) { so[2 * i] = S[i].x; so[2 * i + 1] = S[i].y; } }
}

DI void qk_scores(const bf16_t* sK, const bf16x8 (&qf)[2], f32x4 (&sacc)[4], int fr, int fq) {
#pragma unroll
  for (int nt = 0; nt < 4; ++nt) { sacc[nt] = (f32x4){0.f, 0.f, 0.f, 0.f};
#pragma unroll
    for (int ks = 0; ks < 2; ++ks) { const bf16x8 kf = *(const bf16x8*)(sK + (nt * 16 + fr) * LDT + ks * 32 + fq * 8); sacc[nt] = MFMA16(kf, qf[ks], sacc[nt]); } }
}
DI void pv_accum(const bf16_t* sVt, const f32x4 (&pacc)[4], f32x4 (&o)[4], int fr, int fq) {
#pragma unroll
  for (int s = 0; s < 2; ++s) {
    bf16x8 pf; { const unsigned a = pack2(pacc[2 * s][0], pacc[2 * s][1]), b = pack2(pacc[2 * s][2], pacc[2 * s][3]), c = pack2(pacc[2 * s + 1][0], pacc[2 * s + 1][1]), dd = pack2(pacc[2 * s + 1][2], pacc[2 * s + 1][3]);
      const u32x4 u = (u32x4){a, b, c, dd}; pf = __builtin_bit_cast(bf16x8, u); }
#pragma unroll
    for (int dt = 0; dt < 4; ++dt) { const u32x2 lo = *(const u32x2*)(sVt + (dt * 16 + fr) * LDT + 32 * s + 4 * fq), hi = *(const u32x2*)(sVt + (dt * 16 + fr) * LDT + 32 * s + 16 + 4 * fq);
      const u32x4 u = (u32x4){lo[0], lo[1], hi[0], hi[1]}; const bf16x8 vf = __builtin_bit_cast(bf16x8, u); o[dt] = MFMA16(vf, pf, o[dt]); }
  }
}
DI void put_kv(bf16_t* sK, bf16_t* sVt, int key, int part, const float (&kf)[8], const float (&vf)[8]) {
  *(u32x4*)(sK + key * LDT + part * 8) = pack8(kf);
#pragma unroll
  for (int e = 0; e < 8; ++e) sVt[(part * 8 + e) * LDT + key] = f2bf(vf[e]);
}
DI void softmax_tile(f32x4 (&sacc)[4], f32x4 (&o)[4], float& mrun, float& lrun) {
  float mx = sacc[0][0];
#pragma unroll
  for (int nt = 0; nt < 4; ++nt)
#pragma unroll
    for (int j = 0; j < 4; ++j) mx = fmaxf(mx, sacc[nt][j]);
  mx = fmaxf(mx, __shfl_xor(mx, 16)); mx = fmaxf(mx, __shfl_xor(mx, 32));
  const float mnew = fmaxf(mrun, mx), alpha = exp2f(mrun - mnew); mrun = mnew;
  float ls = 0.f;
#pragma unroll
  for (int nt = 0; nt < 4; ++nt)
#pragma unroll
    for (int j = 0; j < 4; ++j) { const float pv = exp2f(sacc[nt][j] - mnew); sacc[nt][j] = pv; ls += pv; }
  lrun = lrun * alpha + ls;
#pragma unroll
  for (int dt = 0; dt < 4; ++dt) o[dt] *= alpha;
}
constexpr float LOG2E = 1.4426950408889634f;

__device__ void dense_task(const P& p, int b, int h, int qb, char* smem) {
  bf16_t* sK = (bf16_t*)smem; bf16_t* sVt = sK + 64 * LDT;
  const int tid = tidx(), lane = tid & 63, wave = tid >> 6, fr = lane & 15, fq = lane >> 4;
  const bf16_t* zn = (const bf16_t*)(p.ws + WS_ZN); bf16_t* ona = (bf16_t*)(p.ws + WS_ONA);
  const int qrow = b * 256 + qb * 64 + wave * 16 + fr;
  bf16x8 qf[2];
#pragma unroll
  for (int ks = 0; ks < 2; ++ks) qf[ks] = *(const bf16x8*)(zn + (size_t)qrow * NZN + h * 64 + ks * 32 + fq * 8);
  f32x4 o[4]; for (int dt = 0; dt < 4; ++dt) o[dt] = (f32x4){0.f, 0.f, 0.f, 0.f};
  float mrun = -1e30f, lrun = 0.f;
  for (int kt = 0; kt < 4; ++kt) {
    __syncthreads();
#pragma unroll
    for (int i = 0; i < 2; ++i) { const int c = tid + 256 * i, key = c >> 3, part = c & 7; const size_t ro = (size_t)(b * 256 + kt * 64 + key) * NZN + h * 64 + part * 8;
      const u32x4 kr = *(const u32x4*)(zn + ro + 512), vr = *(const u32x4*)(zn + ro + 1024); float vf[8]; unpack8(vr, vf);
      *(u32x4*)(sK + key * LDT + part * 8) = kr;
#pragma unroll
      for (int e = 0; e < 8; ++e) sVt[(part * 8 + e) * LDT + key] = f2bf(vf[e]); }
    __syncthreads();
    f32x4 sacc[4]; qk_scores(sK, qf, sacc, fr, fq);
#pragma unroll
    for (int nt = 0; nt < 4; ++nt) sacc[nt] *= (0.125f * LOG2E);
    softmax_tile(sacc, o, mrun, lrun);
    pv_accum(sVt, sacc, o, fr, fq);
  }
  lrun += __shfl_xor(lrun, 16); lrun += __shfl_xor(lrun, 32); const float inv = 1.f / lrun;
#pragma unroll
  for (int dt = 0; dt < 4; ++dt) { u32x2 ov; ov.x = pack2(o[dt][0] * inv, o[dt][1] * inv); ov.y = pack2(o[dt][2] * inv, o[dt][3] * inv); *(u32x2*)(ona + (size_t)qrow * 512 + h * 64 + dt * 16 + fq * 4) = ov; }
}

__device__ void na_task(const P& p, int l, int b, int h, int r, char* smem) {
  bf16_t* sK = (bf16_t*)smem; bf16_t* sVt = sK + 64 * LDT; float* sRpb = (float*)(sVt + 64 * LDT);
  const int tid = tidx(), lane = tid & 63, wave = tid >> 6, fr = lane & 15, fq = lane >> 4;
  const bf16_t* zn = (const bf16_t*)(p.ws + WS_ZN); bf16_t* ona = (bf16_t*)(p.ws + WS_ONA);
  const int base = MC + b * 1024, qcol = wave * 16 + fr, qrow = base + r * 64 + qcol;
  int rs = r - 4; rs = rs < 0 ? 0 : (rs > 8 ? 8 : rs);
  int cs = qcol - 8; cs = cs < 0 ? 0 : (cs > 48 ? 48 : cs);
  __syncthreads();
  for (int e = tid; e < 465; e += NT) sRpb[e] = p.na_rpb[((size_t)l * 8 + h) * 465 + e] * LOG2E;
  bf16x8 qf[2];
#pragma unroll
  for (int ks = 0; ks < 2; ++ks) qf[ks] = *(const bf16x8*)(zn + (size_t)qrow * NZN + h * 64 + ks * 32 + fq * 8);
  f32x4 o[4]; for (int dt = 0; dt < 4; ++dt) o[dt] = (f32x4){0.f, 0.f, 0.f, 0.f};
  float mrun = -1e30f, lrun = 0.f;
  for (int kt = 0; kt < 12; ++kt) {
    __syncthreads();
    if (kt < 8) {
#pragma unroll
      for (int i = 0; i < 2; ++i) { const int c = tid + 256 * i, key = c >> 3, part = c & 7; const size_t ro = (size_t)(base + (rs + kt) * 64 + key) * NZN + h * 64 + part * 8;
        const u32x4 kr = *(const u32x4*)(zn + ro + 512), vr = *(const u32x4*)(zn + ro + 1024); float vf[8]; unpack8(vr, vf);
        *(u32x4*)(sK + key * LDT + part * 8) = kr;
#pragma unroll
        for (int e = 0; e < 8; ++e) sVt[(part * 8 + e) * LDT + key] = f2bf(vf[e]); }
    } else {
#pragma unroll
      for (int i = 0; i < 2; ++i) { const int c = tid + 256 * i, key = c >> 3, part = c & 7; const size_t co = ((((size_t)b * 2 + l) * 8 + h) * 256 + (kt - 8) * 64 + key) * 64 + part * 8;
        const float4 k0 = *(const float4*)(p.cache_k + co), k1 = *(const float4*)(p.cache_k + co + 4), v0 = *(const float4*)(p.cache_v + co), v1 = *(const float4*)(p.cache_v + co + 4);
        const float kf[8] = {k0.x, k0.y, k0.z, k0.w, k1.x, k1.y, k1.z, k1.w}; const float vf[8] = {v0.x, v0.y, v0.z, v0.w, v1.x, v1.y, v1.z, v1.w};
        put_kv(sK, sVt, key, part, kf, vf); }
    }
    __syncthreads();
    f32x4 sacc[4]; qk_scores(sK, qf, sacc, fr, fq);
    if (kt < 8) { const int dr = rs + kt - r + 7;
#pragma unroll
      for (int nt = 0; nt < 4; ++nt)
#pragma unroll
        for (int j = 0; j < 4; ++j) { const int kc = nt * 16 + fq * 4 + j; const bool valid = kc >= cs && kc < cs + 16; int dc = kc - qcol; dc = dc < -15 ? -15 : (dc > 15 ? 15 : dc);
          sacc[nt][j] = valid ? sacc[nt][j] * (0.125f * LOG2E) + sRpb[dr * 31 + dc + 15] : -1e30f; }
    } else {
#pragma unroll
      for (int nt = 0; nt < 4; ++nt) sacc[nt] *= (0.125f * LOG2E);
    }
    softmax_tile(sacc, o, mrun, lrun);
    pv_accum(sVt, sacc, o, fr, fq);
  }
  lrun += __shfl_xor(lrun, 16); lrun += __shfl_xor(lrun, 32); const float inv = 1.f / lrun;
#pragma unroll
  for (int dt = 0; dt < 4; ++dt) { u32x2 ov; ov.x = pack2(o[dt][0] * inv, o[dt][1] * inv); ov.y = pack2(o[dt][2] * inv, o[dt][3] * inv); *(u32x2*)(ona + (size_t)qrow * 512 + h * 64 + dt * 16 + fq * 4) = ov; }
}

DI void rope8(const float (&own)[8], const float (&par)[8], int part, int n, float (&out)[8]) {
  const float pos = (float)((part >> 2) ? (n & 63) : (n >> 6));
  const bool isx2 = (part & 3) >= 2;
#pragma unroll
  for (int e = 0; e < 8; ++e) { const int i = (part & 1) * 8 + e; const float ang = pos * exp2f(-(float)i * 0.830482023721841f); const float sn = __sinf(ang), cs = __cosf(ang);
    out[e] = isx2 ? par[e] * sn + own[e] * cs : own[e] * cs - par[e] * sn; }
}

__device__ void ret_task(const P& p, int l, int seq, int h, int qb, char* smem) {
  bf16_t* sK = (bf16_t*)smem; bf16_t* sVt = sK + 64 * LDT; bf16_t* sQ = sVt + 64 * LDT;
  const int tid = tidx(), lane = tid & 63, wave = tid >> 6, fr = lane & 15, fq = lane >> 4;
  const bf16_t* zt = (const bf16_t*)(p.ws + WS_ZT); bf16_t* oret = (bf16_t*)(p.ws + WS_ORET);
  const bool lat = seq >= 32;
  const int row0 = lat ? MC + (seq - 32) * 1024 : seq * 256, T = lat ? 1024 : 256, nkt = T >> 6;
  const float xf = p.ret_decay[(l * 2 + 0) * 8 + h], xb = p.ret_decay[(l * 2 + 1) * 8 + h];
  const float lgf = -log1pf(__expf(-xf)) * LOG2E, lgb = -log1pf(__expf(-xb)) * LOG2E;
  __syncthreads();
#pragma unroll
  for (int i = 0; i < 2; ++i) { const int c = tid + 256 * i, qi = c >> 3, part = c & 7; const int n = qb * 64 + qi; const size_t ro = (size_t)(row0 + n) * NZT + h * 64;
    const u32x4 own = *(const u32x4*)(zt + ro + part * 8);
    if (lat) { const u32x4 par = *(const u32x4*)(zt + ro + (part ^ 2) * 8); float fo[8], fp[8], out[8]; unpack8(own, fo); unpack8(par, fp); rope8(fo, fp, part, n, out); *(u32x4*)(sQ + qi * LDT + part * 8) = pack8(out); }
    else *(u32x4*)(sQ + qi * LDT + part * 8) = own; }
  __syncthreads();
  const int qi = wave * 16 + fr, nq = qb * 64 + qi;
  bf16x8 qf[2];
#pragma unroll
  for (int ks = 0; ks < 2; ++ks) qf[ks] = *(const bf16x8*)(sQ + qi * LDT + ks * 32 + fq * 8);
  f32x4 o[4]; for (int dt = 0; dt < 4; ++dt) o[dt] = (f32x4){0.f, 0.f, 0.f, 0.f};
  for (int kt = 0; kt < nkt; ++kt) {
    __syncthreads();
#pragma unroll
    for (int i = 0; i < 2; ++i) { const int c = tid + 256 * i, key = c >> 3, part = c & 7; const int n = kt * 64 + key; const size_t ro = (size_t)(row0 + n) * NZT + h * 64;
      const u32x4 own = *(const u32x4*)(zt + ro + 512 + part * 8), vr = *(const u32x4*)(zt + ro + 1024 + part * 8);
      float kf[8], vf[8]; unpack8(own, kf); unpack8(vr, vf);
      if (lat) { const u32x4 par = *(const u32x4*)(zt + ro + 512 + (part ^ 2) * 8); float fp[8], out[8]; unpack8(par, fp); rope8(kf, fp, part, n, out);
#pragma unroll
        for (int e = 0; e < 8; ++e) kf[e] = out[e]; }
#pragma unroll
      for (int e = 0; e < 8; ++e) kf[e] *= 0.125f;
      put_kv(sK, sVt, key, part, kf, vf); }
    __syncthreads();
    f32x4 sacc[4]; qk_scores(sK, qf, sacc, fr, fq);
#pragma unroll
    for (int nt = 0; nt < 4; ++nt)
#pragma unroll
      for (int j = 0; j < 4; ++j) { const int mk = kt * 64 + nt * 16 + fq * 4 + j; const int df = nq - mk;
        const float dec = df > 0 ? exp2f(lgf * (float)df) : (df < 0 ? exp2f(lgb * (float)(-df)) : 2.f); sacc[nt][j] *= dec; }
    pv_accum(sVt, sacc, o, fr, fq);
  }
  if (lat) {
    for (int dir = 0; dir < 2; ++dir) {
      __syncthreads();
      const float* s0 = p.state_ret + ((((size_t)(seq - 32) * 2 + l) * 2 + dir) * 8 + h) * 4096;
#pragma unroll
      for (int i = 0; i < 2; ++i) { const int c = tid + 256 * i, dk = c >> 3, part = c & 7; const float4 a = *(const float4*)(s0 + dk * 64 + part * 8), bq = *(const float4*)(s0 + dk * 64 + part * 8 + 4);
        const float vf[8] = {a.x, a.y, a.z, a.w, bq.x, bq.y, bq.z, bq.w};
#pragma unroll
        for (int e = 0; e < 8; ++e) sVt[(part * 8 + e) * LDT + dk] = f2bf(vf[e]); }
      __syncthreads();
      const float xi = dir == 0 ? exp2f(lgf * (float)(nq + 1)) : exp2f(lgb * (float)(T - nq));
      f32x4 pacc[4];
#pragma unroll
      for (int s = 0; s < 2; ++s)
#pragma unroll
        for (int hh = 0; hh < 2; ++hh)
#pragma unroll
          for (int j = 0; j < 4; ++j) pacc[2 * s + hh][j] = xi * bf2f(sQ[qi * LDT + 32 * s + 16 * hh + 4 * fq + j]);
      pv_accum(sVt, pacc, o, fr, fq);
    }
  }
  float s1 = 0.f;
#pragma unroll
  for (int dt = 0; dt < 4; ++dt)
#pragma unroll
    for (int j = 0; j < 4; ++j) s1 += o[dt][j];
  s1 += __shfl_xor(s1, 16); s1 += __shfl_xor(s1, 32); const float mu = s1 * (1.f / 64.f);
  float s2 = 0.f;
#pragma unroll
  for (int dt = 0; dt < 4; ++dt)
#pragma unroll
    for (int j = 0; j < 4; ++j) { const float dlt = o[dt][j] - mu; s2 += dlt * dlt; }
  s2 += __shfl_xor(s2, 16); s2 += __shfl_xor(s2, 32); const float rstd = rsqrtf(s2 * (1.f / 64.f) + 1e-5f);
  const size_t qrow = (size_t)(row0 + nq);
#pragma unroll
  for (int dt = 0; dt < 4; ++dt) { const int dv = h * 64 + dt * 16 + fq * 4; const u32x2 gr = *(const u32x2*)(zt + qrow * NZT + 1536 + dv); const float4 gn = *(const float4*)(p.ret_gn + l * 512 + dv);
    const float g0 = bflo(gr.x), g1 = bfhi(gr.x), g2 = bflo(gr.y), g3 = bfhi(gr.y);
    u32x2 ov; ov.x = pack2((o[dt][0] - mu) * rstd * gn.x * g0 * sigmoidf_(g0), (o[dt][1] - mu) * rstd * gn.y * g1 * sigmoidf_(g1));
    ov.y = pack2((o[dt][2] - mu) * rstd * gn.z * g2 * sigmoidf_(g2), (o[dt][3] - mu) * rstd * gn.w * g3 * sigmoidf_(g3));
    *(u32x2*)(oret + qrow * 512 + dv) = ov; }
}

__device__ void retstate_task(const P& p, int l, int b, int h, char* smem) {
  float* sKf = (float*)smem; float* sKb = sKf + 64 * 64; float* sV = sKb + 64 * 64;
  const int tid = tidx(), dk = tid >> 2, dq = tid & 3;
  const bf16_t* zt = (const bf16_t*)(p.ws + WS_ZT);
  const float xf = p.ret_decay[(l * 2 + 0) * 8 + h], xb = p.ret_decay[(l * 2 + 1) * 8 + h];
  const float lgf = -log1pf(__expf(-xf)) * LOG2E, lgb = -log1pf(__expf(-xb)) * LOG2E;
  float af[16], ab[16];
#pragma unroll
  for (int i = 0; i < 16; ++i) { af[i] = 0.f; ab[i] = 0.f; }
  for (int kt = 0; kt < 4; ++kt) {
    __syncthreads();
#pragma unroll
    for (int i = 0; i < 2; ++i) { const int c = tid + 256 * i, key = c >> 3, part = c & 7, m = kt * 64 + key; const size_t ro = (size_t)(b * 256 + m) * NZT + h * 64 + part * 8;
      float kf[8], vf[8]; unpack8(*(const u32x4*)(zt + ro + 512), kf); unpack8(*(const u32x4*)(zt + ro + 1024), vf);
      const float wf = 0.125f * exp2f(lgf * (float)(255 - m)), wb = 0.125f * exp2f(lgb * (float)m);
#pragma unroll
      for (int e = 0; e < 8; ++e) { sKf[key * 64 + part * 8 + e] = kf[e] * wf; sKb[key * 64 + part * 8 + e] = kf[e] * wb; sV[key * 64 + part * 8 + e] = vf[e]; } }
    __syncthreads();
    for (int m = 0; m < 64; ++m) { const float kf = sKf[m * 64 + dk], kb = sKb[m * 64 + dk];
#pragma unroll
      for (int i = 0; i < 4; ++i) { const f32x4 vv = *(const f32x4*)(sV + m * 64 + dq * 16 + i * 4);
#pragma unroll
        for (int j = 0; j < 4; ++j) { af[i * 4 + j] += kf * vv[j]; ab[i * 4 + j] += kb * vv[j]; } } }
  }
  float* of = p.out + O_RT + ((((size_t)b * 2 + l) * 2 + 0) * 8 + h) * 4096 + dk * 64 + dq * 16; float* ob = of + 8 * 4096;
#pragma unroll
  for (int i = 0; i < 16; ++i) { of[i] = af[i]; ob[i] = ab[i]; }
}

constexpr int Q_SCAN_L = 64, Q_SCAN_C = 512, Q_RET_L = 512, Q_NA = 512, Q_DENSE = 1024, Q_RET_C = 1024, Q_RST = 256;
constexpr int Q_TOTAL = Q_SCAN_L + Q_SCAN_C + Q_RET_L + Q_NA + Q_DENSE + Q_RET_C + Q_RST;
__device__ void phase_mixers(const P& p, int l, char* smem) {
  __shared__ int s_task;
  int* ctr = (int*)(p.ws + WS_CTRL) + 64 * (l + 1);
  for (;;) {
    __syncthreads();
    if (tidx() == 0) s_task = atomicAdd(ctr, 1);
    __syncthreads();
    const int tk = s_task;
    if (tk >= Q_SCAN_L + Q_SCAN_C) break;
    if (tk < Q_SCAN_L) scan_task(p, l, 32 + (tk >> 4), (tk >> 1) & 7, tk & 1, smem);
    else { const int t2 = tk - Q_SCAN_L; scan_task(p, l, t2 >> 4, (t2 >> 1) & 7, t2 & 1, smem); }
  }
  for (;;) {
    __syncthreads();
    if (tidx() == 0) s_task = atomicAdd(ctr + 16, 1);
    __syncthreads();
    const int tk = s_task;
    if (tk >= Q_RET_L + Q_RET_C) break;
    if (tk < Q_RET_L) ret_task(p, l, 32 + (tk >> 7), (tk >> 4) & 7, tk & 15, smem);
    else { const int t2 = tk - Q_RET_L; ret_task(p, l, t2 >> 5, (t2 >> 2) & 7, t2 & 3, smem); }
  }
  for (;;) {
    __syncthreads();
    if (tidx() == 0) s_task = atomicAdd(ctr + 32, 1);
    __syncthreads();
    int tk = s_task;
    if (tk >= Q_NA + Q_DENSE + Q_RST) break;
    if (tk < Q_NA) { na_task(p, l, tk >> 7, (tk >> 4) & 7, tk & 15, smem); continue; } tk -= Q_NA;
    if (tk < Q_DENSE) { dense_task(p, tk >> 5, (tk >> 2) & 7, tk & 3, smem); continue; } tk -= Q_DENSE;
    retstate_task(p, l, tk >> 3, tk & 7, smem);
  }
}

__device__ void phase_rwkv_post(const P& p, int l, char* smem) {
  float* sg = (float*)smem;
  const int tid = tidx();
  const bf16_t* zr = (const bf16_t*)(p.ws + WS_ZR); const float* yf = (const float*)(p.ws + WS_Y); const float* yb = yf + (size_t)MT * 512; bf16_t* oa = (bf16_t*)(p.ws + WS_OA);
  const float* gup = p.rwkv_g_up + (size_t)l * 128 * 512;
  for (int m = blockIdx.x; m < MT; m += gridDim.x) {
    __syncthreads();
    if (tid < 128) sg[tid] = sigmoidf_(bf2f(zr[(size_t)m * NZR + 1664 + tid]));
    __syncthreads();
#pragma unroll
    for (int half = 0; half < 2; ++half) {
      const int c = half * 256 + tid, hh = c >> 6;
      const float y = yf[(size_t)m * 512 + c] + yb[(size_t)m * 512 + c];
      const float mu = wave_sum(y) * (1.f / 64.f); const float dl = y - mu; const float var = wave_sum(dl * dl) * (1.f / 64.f);
      float o = dl * rsqrtf(var + 64e-5f) * p.rwkv_ln_g[l * 512 + c] + p.rwkv_ln_b[l * 512 + c];
      const float r = bf2f(zr[(size_t)m * NZR + c]), k = bf2f(zr[(size_t)m * NZR + 512 + c]), v = bf2f(zr[(size_t)m * NZR + 1024 + c]);
      const float bonus = wave_sum(r * k * p.rwkv_r_k[l * 512 + c]) * v;
      float g = 0.f;
#pragma unroll 8
      for (int j = 0; j < 128; ++j) g += sg[j] * gup[j * 512 + c];
      oa[(size_t)m * 512 + c] = f2bf((o + bonus) * g);
      (void)hh;
    }
  }
}

DI void convert_layer_a(const P& p, int l, char* smem) {
  convert_T(p.w_in + (size_t)l * D * INC, D, INC, (bf16_t*)(p.ws + WS_WIN), smem);
  convert_T(p.w_o_rwkv + (size_t)l * 512 * D, 512, D, (bf16_t*)(p.ws + WS_WO3), smem);
  convert_T(p.w_o_na + (size_t)l * 512 * D, 512, D, (bf16_t*)(p.ws + WS_WO3) + (size_t)1024 * 512, smem);
  convert_T(p.w_o_ret + (size_t)l * 512 * D, 512, D, (bf16_t*)(p.ws + WS_WO3) + (size_t)2 * 1024 * 512, smem);
  convert_T(p.w_out + (size_t)l * D * D, D, D, (bf16_t*)(p.ws + WS_WOUT), smem);
}
DI void convert_layer_b(const P& p, int l, char* smem) {
  convert_T(p.ffn_up + (size_t)l * D * 2 * FF, D, 2 * FF, (bf16_t*)(p.ws + WS_WUP), smem);
  convert_T(p.ffn_down + (size_t)l * FF * D, FF, D, (bf16_t*)(p.ws + WS_WDN), smem);
}

template <int PH> DI void run_phase(const P& p, int l, char* smem) {
  const float* mod = (const float*)(p.ws + WS_MOD);
  float* xbuf = p.out;
  if (PH == 0) { ada_phase(p, smem); convert_layer_a(p, 0, smem); }
  else if (PH == 1) { norm_phase(p, nullptr, nullptr, nullptr, nullptr, 0, nullptr, p.norm_mix_pre, mod, 0, (bf16_t*)(p.ws + WS_H)); }
  else if (PH == 2) phase_win(p, l, smem);
  else if (PH == 4) phase_mixers(p, l, smem);
  else if (PH == 5) phase_rwkv_post(p, l, smem);
  else if (PH == 6) phase_merge(p, smem);
  else if (PH == 7) { phase_gemm_f32((const bf16_t*)(p.ws + WS_MERGED), D, (const bf16_t*)(p.ws + WS_WOUT), (float*)(p.ws + WS_U), smem); }
  else if (PH == 8) { convert_layer_b(p, l, smem);
    norm_phase(p, l == 0 ? nullptr : xbuf, (const float*)(p.ws + WS_U), p.norm_mix_post + l * D, mod + (size_t)l * 5 * 6144, 2, xbuf, p.norm_ffn_pre + l * D, mod + (size_t)l * 5 * 6144, 3, (bf16_t*)(p.ws + WS_H)); }
  else if (PH == 9) phase_ffn_up(p, l, smem);
  else if (PH == 11) { phase_gemm_f32((const bf16_t*)(p.ws + WS_HID), FF, (const bf16_t*)(p.ws + WS_WDN), (float*)(p.ws + WS_F), smem); }
  else if (PH == 12) {
    if (l == 0) { norm_phase(p, xbuf, (const float*)(p.ws + WS_F), p.norm_ffn_post, mod, 5, xbuf, p.norm_mix_pre + D, mod + (size_t)5 * 6144, 0, (bf16_t*)(p.ws + WS_H)); convert_layer_a(p, 1, smem); }
    else norm_phase(p, xbuf, (const float*)(p.ws + WS_F), p.norm_ffn_post + D, mod + (size_t)5 * 6144, 5, xbuf, nullptr, nullptr, 0, nullptr);
  }
}

#if MEGA
__global__ void __launch_bounds__(NT, 2) mega_kernel(P p) {
  extern __shared__ __attribute__((aligned(16))) char smem[];
  cg::grid_group grid = cg::this_grid();
  run_phase<0>(p, 0, smem); grid.sync();
  run_phase<1>(p, 0, smem); grid.sync();
#pragma unroll 1
  for (int l = 0; l < 2; ++l) {
    run_phase<2>(p, l, smem); grid.sync();
    run_phase<4>(p, l, smem); grid.sync();
    run_phase<5>(p, l, smem); grid.sync();
    run_phase<6>(p, l, smem); grid.sync();
    run_phase<7>(p, l, smem); grid.sync();
    run_phase<8>(p, l, smem); grid.sync();
    run_phase<9>(p, l, smem); grid.sync();
    run_phase<11>(p, l, smem); grid.sync();
    run_phase<12>(p, l, smem); if (l == 0) grid.sync();
  }
}
#else
template <int PH> __global__ void __launch_bounds__(NT, 2) phase_kernel(P p, int l) {
  extern __shared__ __attribute__((aligned(16))) char smem[];
  run_phase<PH>(p, l, smem);
}
#endif

extern "C" void kernel_launch(void* const* d_in, const int* in_sizes, int n_in, void* d_out, int out_size, void* d_ws, size_t ws_size, hipStream_t stream) {
  if (ws_size < WS_END || n_in < 36) { fprintf(stderr, "workspace too small: %zu < %zu\n", ws_size, (size_t)WS_END); return; }
  P p{};
  const float** pp = (const float**)&p;
  for (int i = 0; i < 36; ++i) pp[i] = (const float*)d_in[i];
  p.out = (float*)d_out; p.ws = (char*)d_ws;
  hipMemsetAsync(d_ws, 0, WS_WIN, stream);
#if MEGA
  static int grid_blocks = 0;
  if (!grid_blocks) {
    int dev = 0, cus = 0, per_cu = 0; hipGetDevice(&dev);
    hipDeviceGetAttribute(&cus, hipDeviceAttributeMultiprocessorCount, dev);
    hipFuncSetAttribute((const void*)mega_kernel, hipFuncAttributeMaxDynamicSharedMemorySize, SMEM_BYTES);
    hipOccupancyMaxActiveBlocksPerMultiprocessor(&per_cu, mega_kernel, NT, SMEM_BYTES);
    if (per_cu > 2) per_cu = 2;
    grid_blocks = cus * per_cu;
  }
  void* args[] = {&p};
  hipError_t e = hipLaunchCooperativeKernel((void*)mega_kernel, dim3(grid_blocks), dim3(NT), args, SMEM_BYTES, stream);
  if (e != hipSuccess) fprintf(stderr, "cooperative launch failed: %s (grid %d)\n", hipGetErrorString(e), grid_blocks);
#else
  const int G = 512;
#define LAUNCH(PH, L) do { hipFuncSetAttribute((const void*)phase_kernel<PH>, hipFuncAttributeMaxDynamicSharedMemorySize, SMEM_BYTES); phase_kernel<PH><<<G, NT, SMEM_BYTES, stream>>>(p, L); } while (0)
  LAUNCH(0, 0); LAUNCH(1, 0);
  for (int l = 0; l < 2; ++l) { LAUNCH(2, l); LAUNCH(4, l); LAUNCH(5, l); LAUNCH(6, l); LAUNCH(7, l); LAUNCH(8, l); LAUNCH(9, l); LAUNCH(11, l); LAUNCH(12, l); }
#endif
}
```

```cpp
#include <hip/hip_runtime.h>
#include <hip/hip_cooperative_groups.h>
#include <cstdio>
namespace cg = cooperative_groups;

#ifndef MEGA
#define MEGA 1
#endif
#define PROBE_GEMM2 0
#define PROBE_MIX2 0

typedef unsigned short bf16_t;
typedef short bf16x8 __attribute__((ext_vector_type(8)));
typedef short bf16x4 __attribute__((ext_vector_type(4)));
typedef float f32x4 __attribute__((ext_vector_type(4)));
typedef float f32x2 __attribute__((ext_vector_type(2)));
typedef unsigned u32x4 __attribute__((ext_vector_type(4)));
typedef unsigned u32x2 __attribute__((ext_vector_type(2)));
#define DI __device__ __forceinline__
#define MFMA16(a, b, c) __builtin_amdgcn_mfma_f32_16x16x32_bf16((a), (b), (c), 0, 0, 0)

constexpr int NT = 256;
constexpr int D = 1024, MC = 8192, ML = 4096, MT = 12288;
constexpr int NZR = 1792, NZN = 1536, NZT = 2048, INC = 8448, FF = 2816;
constexpr int LDT = 72;
constexpr int SMEM_BYTES = 128 * 132 * 4;
constexpr size_t O_K = 12582912, O_V = 20971520, O_RW = 29360128, O_RT = 33554432;
constexpr size_t WS_CTRL = 0;
constexpr size_t WS_MOD = 4096;
constexpr size_t WS_WIN = 262144;
constexpr size_t WS_WUP = WS_WIN;
constexpr size_t WS_WDN = WS_WIN + (size_t)5632 * 1024 * 2;
constexpr size_t WS_WO3 = WS_WIN + (size_t)INC * 1024 * 2;
constexpr size_t WS_WOUT = WS_WO3 + (size_t)3 * 1024 * 512 * 2;
constexpr size_t WS_H = WS_WOUT + (size_t)1024 * 1024 * 2;
constexpr size_t WS_Z = WS_H + (size_t)MT * 1024 * 2;
constexpr size_t WS_ZR = WS_Z;
constexpr size_t WS_ZN = WS_ZR + (size_t)MT * NZR * 2;
constexpr size_t WS_ZT = WS_ZN + (size_t)MT * NZN * 2;
constexpr size_t WS_MERGED = WS_ZR;
constexpr size_t WS_OA = WS_ZN;
constexpr size_t WS_U = WS_ZT;
constexpr size_t WS_HID = WS_Z;
constexpr size_t WS_F = WS_ZT;
constexpr size_t WS_Y = WS_ZT + (size_t)MT * NZT * 2;
constexpr size_t WS_ONA = WS_Y + (size_t)2 * MT * 512 * 4;
constexpr size_t WS_ORET = WS_ONA + (size_t)MT * 512 * 2;
constexpr size_t WS_END = WS_ORET + (size_t)MT * 512 * 2;

struct P {
  const float *x_prompt, *x_sample, *cache_k, *cache_v, *state_rwkv, *state_ret, *c, *c_ctx, *ada_w, *ada_b;
  const float *norm_mix_pre, *norm_mix_post, *norm_ffn_pre, *norm_ffn_post, *w_in, *rwkv_conv, *rwkv_w0, *rwkv_w_up, *rwkv_a0, *rwkv_a_up, *rwkv_g_up;
  const float *rwkv_k_k, *rwkv_k_a, *rwkv_r_k, *rwkv_ln_g, *rwkv_ln_b, *na_rpb, *ret_decay, *ret_gn, *w_o_rwkv, *w_o_na, *w_o_ret, *w_out, *ffn_up, *ffn_conv, *ffn_down;
  float* out; char* ws;
};

DI int threadIdx_x_raw() { return (int)__builtin_amdgcn_workitem_id_x(); }
DI int tidx() { int t = threadIdx_x_raw(); asm volatile("" : "+v"(t)); return t; }
DI bf16_t f2bf(float x) { unsigned u = __float_as_uint(x); u += 0x7fffu + ((u >> 16) & 1u); return (bf16_t)(u >> 16); }
DI float bf2f(bf16_t b) { return __uint_as_float(((unsigned)b) << 16); }
DI unsigned pack2(float a, float b) { return (unsigned)f2bf(a) | ((unsigned)f2bf(b) << 16); }
DI float bflo(unsigned u) { return __uint_as_float(u << 16); }
DI float bfhi(unsigned u) { return __uint_as_float(u & 0xffff0000u); }
DI void unpack8(const u32x4 r, float (&f)[8]) { f[0] = bflo(r[0]); f[1] = bfhi(r[0]); f[2] = bflo(r[1]); f[3] = bfhi(r[1]); f[4] = bflo(r[2]); f[5] = bfhi(r[2]); f[6] = bflo(r[3]); f[7] = bfhi(r[3]); }
DI u32x4 pack8(const float (&f)[8]) { u32x4 r; r[0] = pack2(f[0], f[1]); r[1] = pack2(f[2], f[3]); r[2] = pack2(f[4], f[5]); r[3] = pack2(f[6], f[7]); return r; }
DI float sigmoidf_(float x) { return 1.f / (1.f + __expf(-x)); }
DI float wave_sum(float v) { for (int o = 32; o > 0; o >>= 1) v += __shfl_xor(v, o); return v; }
DI void tokinfo(int m, int& t, int& T, int& mi) { if (m < MC) { t = m & 255; T = 256; mi = 0; } else { int q = m - MC; t = q & 1023; T = 1024; mi = 1 + (q >> 10); } }

__device__ void convert_T(const float* __restrict__ W, int K, int N, bf16_t* __restrict__ Wt, char* smem) {
  float* t = (float*)smem;
  const int tid = tidx(), ntn = N >> 6, nitems = (K >> 6) * ntn;
  for (int it = blockIdx.x; it < nitems; it += gridDim.x) {
    const int k0 = (it / ntn) << 6, n0 = (it % ntn) << 6;
    __syncthreads();
#pragma unroll
    for (int i = 0; i < 4; ++i) { const int k = (tid >> 4) + 16 * i, c4 = (tid & 15) * 4;
      const float4 v = *(const float4*)(W + (size_t)(k0 + k) * N + n0 + c4);
      t[k * 65 + c4] = v.x; t[k * 65 + c4 + 1] = v.y; t[k * 65 + c4 + 2] = v.z; t[k * 65 + c4 + 3] = v.w; }
    __syncthreads();
#pragma unroll
    for (int i = 0; i < 2; ++i) { const int c = tid + 256 * i, n = c >> 3, kc = c & 7; float f[8];
#pragma unroll
      for (int e = 0; e < 8; ++e) f[e] = t[(kc * 8 + e) * 65 + n];
      *(u32x4*)(Wt + (size_t)(n0 + n) * K + k0 + kc * 8) = pack8(f); }
  }
}

__device__ void ada_phase(const P& p, char* smem) {
  float* sc = (float*)smem;
  float* red = sc + 640;
  float* mod = (float*)(p.ws + WS_MOD);
  const int tid = tidx(), kq = tid >> 5, cq = tid & 31;
  for (int it = blockIdx.x; it < 2 * 48 * 8; it += gridDim.x) {
    const int l = it / 384, rem = it % 384, nb = rem >> 3, ks = rem & 7;
    const int n0 = nb * 128, k0 = ks * 128;
    __syncthreads();
    for (int e = tid; e < 640; e += NT) { const int i = e >> 7, k = e & 127; const float v = (i == 0) ? p.c_ctx[k0 + k] : p.c[(i - 1) * D + k0 + k]; sc[e] = v * sigmoidf_(v); }
    __syncthreads();
    float acc[5][4];
#pragma unroll
    for (int i = 0; i < 5; ++i)
#pragma unroll
      for (int j = 0; j < 4; ++j) acc[i][j] = 0.f;
    const float* wp = p.ada_w + ((size_t)l * D + k0 + kq * 16) * 6144 + n0 + cq * 4;
#pragma unroll 4
    for (int kk = 0; kk < 16; ++kk) { const float4 w = *(const float4*)(wp + (size_t)kk * 6144);
#pragma unroll
      for (int i = 0; i < 5; ++i) { const float s = sc[i * 128 + kq * 16 + kk]; acc[i][0] += s * w.x; acc[i][1] += s * w.y; acc[i][2] += s * w.z; acc[i][3] += s * w.w; } }
#pragma unroll
    for (int i = 0; i < 5; ++i)
#pragma unroll
      for (int j = 0; j < 4; ++j) red[(kq * 5 + i) * 128 + cq * 4 + j] = acc[i][j];
    __syncthreads();
    for (int e = tid; e < 640; e += NT) { const int i = e >> 7, n = e & 127; float s = 0.f;
#pragma unroll
      for (int q = 0; q < 8; ++q) s += red[(q * 5 + i) * 128 + n];
      if (ks == 0) s += p.ada_b[l * 6144 + n0 + n];
      atomicAdd(mod + ((size_t)l * 5 + i) * 6144 + n0 + n, s); }
  }
}

__device__ void norm_phase(const P& p, const float* xin  , const float* u, const float* gpost, const float* modU, int gate_idx,
                           float* xout, const float* gpre, const float* modN, int shift_idx, bf16_t* hout) {
  const int lane = tidx() & 63, wave = tidx() >> 6, nw = NT / 64;
  for (int m = blockIdx.x * nw + wave; m < MT; m += gridDim.x * nw) {
    int t, T, mi; tokinfo(m, t, T, mi);
    const float* xr = xin ? xin + (size_t)m * D : (m < MC ? p.x_prompt + (size_t)m * D : p.x_sample + (size_t)(m - MC) * D);
    float4 x[4];
#pragma unroll
    for (int i = 0; i < 4; ++i) x[i] = *(const float4*)(xr + i * 256 + lane * 4);
    if (u) {
      float4 uu[4]; float ss = 0.f;
#pragma unroll
      for (int i = 0; i < 4; ++i) { uu[i] = *(const float4*)(u + (size_t)m * D + i * 256 + lane * 4); ss += uu[i].x * uu[i].x + uu[i].y * uu[i].y + uu[i].z * uu[i].z + uu[i].w * uu[i].w; }
      ss = wave_sum(ss); const float rs = rsqrtf(ss * (1.f / D) + 1e-6f);
#pragma unroll
      for (int i = 0; i < 4; ++i) { const int c = i * 256 + lane * 4; const float4 g = *(const float4*)(gpost + c); const float4 ga = *(const float4*)(modU + ((size_t)mi * 6 + gate_idx) * D + c);
        x[i].x += ga.x * uu[i].x * rs * g.x; x[i].y += ga.y * uu[i].y * rs * g.y; x[i].z += ga.z * uu[i].z * rs * g.z; x[i].w += ga.w * uu[i].w * rs * g.w; }
    }
    if (xout) {
#pragma unroll
      for (int i = 0; i < 4; ++i) *(float4*)(xout + (size_t)m * D + i * 256 + lane * 4) = x[i];
    }
    if (hout) {
      float ss = 0.f;
#pragma unroll
      for (int i = 0; i < 4; ++i) ss += x[i].x * x[i].x + x[i].y * x[i].y + x[i].z * x[i].z + x[i].w * x[i].w;
      ss = wave_sum(ss); const float rs = rsqrtf(ss * (1.f / D) + 1e-6f);
#pragma unroll
      for (int i = 0; i < 4; ++i) { const int c = i * 256 + lane * 4; const float4 g = *(const float4*)(gpre + c);
        const float4 sh = *(const float4*)(modN + ((size_t)mi * 6 + shift_idx) * D + c); const float4 sc = *(const float4*)(modN + ((size_t)mi * 6 + shift_idx + 1) * D + c);
        u32x2 o; o.x = pack2(x[i].x * rs * g.x * (1.f + sc.x) + sh.x, x[i].y * rs * g.y * (1.f + sc.y) + sh.y); o.y = pack2(x[i].z * rs * g.z * (1.f + sc.z) + sh.z, x[i].w * rs * g.w * (1.f + sc.w) + sh.w);
        *(u32x2*)(hout + (size_t)m * D + c) = o; }
    }
  }
}

struct TileSrc { const bf16_t* A; int lda; int arow0; const bf16_t* B; int ldb; int brow0, brow1; int K; };

template <int NN> DI void zero_acc(f32x4 (&acc)[4][NN]) {
#pragma unroll
  for (int m = 0; m < 4; ++m)
#pragma unroll
    for (int n = 0; n < NN; ++n) acc[m][n] = (f32x4){0.f, 0.f, 0.f, 0.f};
}

template <int NN> DI void gemm_tile(f32x4 (&acc)[4][NN], const TileSrc& s, char* smem) {
  bf16_t* sA = (bf16_t*)smem; bf16_t* sB = sA + 128 * LDT;
  const int tid = tidx(), lane = tid & 63, wave = tid >> 6, wr = wave >> 1, wc = wave & 1, fr = lane & 15, fq = lane >> 4;
  const bf16_t* ga[4]; const bf16_t* gb[NN];
#pragma unroll
  for (int i = 0; i < 4; ++i) { const int c = tid + 256 * i, row = c >> 3, kc = c & 7;
    int ar = s.arow0 + row; ar = ar < 0 ? 0 : (ar > MT - 1 ? MT - 1 : ar);
    ga[i] = s.A + (size_t)ar * s.lda + kc * 8; }
#pragma unroll
  for (int i = 0; i < NN; ++i) { const int c = tid + 256 * i, row = c >> 3, kc = c & 7;
    const int br = row < 64 ? s.brow0 + row : s.brow1 + row - 64;
    gb[i] = s.B + (size_t)br * s.ldb + kc * 8; }
  u32x4 ra[4], rb[NN];
#pragma unroll
  for (int i = 0; i < 4; ++i) ra[i] = *(const u32x4*)ga[i];
#pragma unroll
  for (int i = 0; i < NN; ++i) rb[i] = *(const u32x4*)gb[i];
  const int nk = s.K >> 6;
#pragma unroll 1
  for (int kt = 0; kt < nk; ++kt) {
    __syncthreads();
#pragma unroll
    for (int i = 0; i < 4; ++i) { const int c = tid + 256 * i, row = c >> 3, kc = c & 7; *(u32x4*)(sA + row * LDT + kc * 8) = ra[i]; }
#pragma unroll
    for (int i = 0; i < NN; ++i) { const int c = tid + 256 * i, row = c >> 3, kc = c & 7; *(u32x4*)(sB + row * LDT + kc * 8) = rb[i]; }
    __syncthreads();
    { const int kn = (kt + 1 < nk ? kt + 1 : kt) * 64;
#pragma unroll
      for (int i = 0; i < 4; ++i) ra[i] = *(const u32x4*)(ga[i] + kn);
#pragma unroll
      for (int i = 0; i < NN; ++i) rb[i] = *(const u32x4*)(gb[i] + kn); }
#pragma unroll
    for (int ks = 0; ks < 2; ++ks) {
      bf16x8 bfr[NN];
#pragma unroll
      for (int n = 0; n < NN; ++n) bfr[n] = *(const bf16x8*)(sB + (wc * 16 * NN + n * 16 + fr) * LDT + ks * 32 + fq * 8);
#pragma unroll
      for (int m = 0; m < 4; ++m) { const bf16x8 af = *(const bf16x8*)(sA + (wr * 64 + m * 16 + fr) * LDT + ks * 32 + fq * 8);
#pragma unroll
        for (int n = 0; n < NN; ++n) acc[m][n] = MFMA16(bfr[n], af, acc[m][n]); }
    }
  }
}

DI void stage_acc(const f32x4 (&acc)[4][4], float* sC) {
  const int lane = tidx() & 63, wave = tidx() >> 6, wr = wave >> 1, wc = wave & 1, fr = lane & 15, fq = lane >> 4;
  __syncthreads();
#pragma unroll
  for (int m = 0; m < 4; ++m)
#pragma unroll
    for (int n = 0; n < 4; ++n) *(f32x4*)(sC + (wr * 64 + m * 16 + fr) * 132 + wc * 64 + n * 16 + fq * 4) = acc[m][n];
  __syncthreads();
}

DI float gelu_tanh(float x) { const float u = 0.7978845608f * (x + 0.044715f * x * x * x); const float e = __expf(2.f * u); const float th = 1.f - 2.f / (e + 1.f); return 0.5f * x * (1.f + th); }

__device__ void phase_win(const P& p, int l, char* smem) {
  const bf16_t* H = (const bf16_t*)(p.ws + WS_H); const bf16_t* Wt = (const bf16_t*)(p.ws + WS_WIN);
  bf16_t* zr = (bf16_t*)(p.ws + WS_ZR); bf16_t* zn = (bf16_t*)(p.ws + WS_ZN); bf16_t* zt = (bf16_t*)(p.ws + WS_ZT);
  const int tid = tidx(), lane = tid & 63, wave = tid >> 6, wr = wave >> 1, wc = wave & 1, fr = lane & 15, fq = lane >> 4;
  const int nconv = 98 * 14, nreg = 96 * 28;
  for (int it = blockIdx.x; it < nconv + nreg; it += gridDim.x) {
    f32x4 acc[4][4]; zero_acc<4>(acc);
    if (it < nconv) {
      const int mt = it / 14, nt = it % 14, n0 = nt * 128, arow0 = mt * 126 - 1;
      TileSrc s{H, D, arow0, Wt, D, n0, n0 + 64, D};
      gemm_tile<4>(acc, s, smem);
      float* sC = (float*)smem; stage_acc(acc, sC);
      const float* cw = p.rwkv_conv + (size_t)l * 3 * NZR;
      for (int e = tid; e < 126 * 32; e += NT) {
        const int tr = 1 + (e >> 5), c4 = (e & 31) * 4, g = arow0 + tr;
        if (g < MT) { int t, T, mi; tokinfo(g, t, T, mi);
          const float pm = t > 0 ? 1.f : 0.f, nm = t < T - 1 ? 1.f : 0.f;
          const f32x4 a = *(const f32x4*)(sC + (tr - 1) * 132 + c4), b = *(const f32x4*)(sC + tr * 132 + c4), c = *(const f32x4*)(sC + (tr + 1) * 132 + c4);
          const float4 w0 = *(const float4*)(cw + n0 + c4), w1 = *(const float4*)(cw + NZR + n0 + c4), w2 = *(const float4*)(cw + 2 * NZR + n0 + c4);
          u32x2 o; o.x = pack2(pm * a[0] * w0.x + b[0] * w1.x + nm * c[0] * w2.x, pm * a[1] * w0.y + b[1] * w1.y + nm * c[1] * w2.y);
          o.y = pack2(pm * a[2] * w0.z + b[2] * w1.z + nm * c[2] * w2.z, pm * a[3] * w0.w + b[3] * w1.w + nm * c[3] * w2.w);
          *(u32x2*)(zr + (size_t)g * NZR + n0 + c4) = o; }
      }
    } else {
      const int r = it - nconv, mt = r / 28, nt = r % 28, n0 = nt * 128, row0 = mt * 128;
      TileSrc s{H, D, row0, Wt, D, NZR + n0, NZR + n0 + 64, D};
      gemm_tile<4>(acc, s, smem);
#pragma unroll
      for (int m = 0; m < 4; ++m) { const int row = row0 + wr * 64 + m * 16 + fr;
#pragma unroll
        for (int n = 0; n < 4; ++n) { const int col = n0 + wc * 64 + n * 16 + fq * 4; const f32x4 v = acc[m][n];
          u32x2 o; o.x = pack2(v[0], v[1]); o.y = pack2(v[2], v[3]);
          if (col < NZN) {
            *(u32x2*)(zn + (size_t)row * NZN + col) = o;
            if (row < MC && col >= 512) { const int part = col - 512, isv = part >> 9, pp = part & 511, hh = pp >> 6, d = pp & 63, b = row >> 8, t = row & 255;
              float* dst = p.out + (isv ? O_V : O_K) + ((((size_t)b * 2 + l) * 8 + hh) * 256 + t) * 64 + d; *(f32x4*)dst = v; }
          } else { *(u32x2*)(zt + (size_t)row * NZT + (col - NZN)) = o; }
        } }
    }
  }
}

__device__ void phase_merge(const P& p, char* smem) {
  const bf16_t* H = (const bf16_t*)(p.ws + WS_H); const bf16_t* Wt = (const bf16_t*)(p.ws + WS_WIN); const bf16_t* Wo3 = (const bf16_t*)(p.ws + WS_WO3);
  bf16_t* mg = (bf16_t*)(p.ws + WS_MERGED);
  const int tid = tidx(), lane = tid & 63, wave = tid >> 6, wr = wave >> 1, wc = wave & 1, fr = lane & 15, fq = lane >> 4;
  for (int it = blockIdx.x; it < 96 * 16; it += gridDim.x) {
    const int mt = it >> 4, nt = it & 15, n0 = nt * 64, row0 = mt * 128;
    f32x4 macc[4][2]; zero_acc<2>(macc);
#pragma unroll 1
    for (int i = 0; i < 3; ++i) {
      const bf16_t* O = (const bf16_t*)(p.ws + (i == 0 ? WS_OA : (i == 1 ? WS_ONA : WS_ORET)));
      f32x4 g[4][2]; zero_acc<2>(g);
      { TileSrc s{H, D, row0, Wt, D, 5376 + i * 1024 + n0, 0, D}; gemm_tile<2>(g, s, smem); }
      f32x4 a2[4][2]; zero_acc<2>(a2);
      { TileSrc s{O, 512, row0, Wo3 + (size_t)i * 1024 * 512, 512, n0, 0, 512}; gemm_tile<2>(a2, s, smem); }
#pragma unroll
      for (int m = 0; m < 4; ++m)
#pragma unroll
        for (int n = 0; n < 2; ++n)
#pragma unroll
          for (int j = 0; j < 4; ++j) macc[m][n][j] += sigmoidf_(g[m][n][j]) * a2[m][n][j];
    }
#pragma unroll
    for (int m = 0; m < 4; ++m) { const int row = row0 + wr * 64 + m * 16 + fr;
#pragma unroll
      for (int n = 0; n < 2; ++n) { const int col = n0 + wc * 32 + n * 16 + fq * 4; u32x2 o; o.x = pack2(macc[m][n][0], macc[m][n][1]); o.y = pack2(macc[m][n][2], macc[m][n][3]); *(u32x2*)(mg + (size_t)row * D + col) = o; } }
  }
}

__device__ void phase_gemm_f32(const bf16_t* A, int K, const bf16_t* Bt, float* C, char* smem) {
  const int tid = tidx(), lane = tid & 63, wave = tid >> 6, wr = wave >> 1, wc = wave & 1, fr = lane & 15, fq = lane >> 4;
  for (int it = blockIdx.x; it < 96 * 8; it += gridDim.x) {
    const int mt = it >> 3, nt = it & 7, n0 = nt * 128, row0 = mt * 128;
    f32x4 acc[4][4]; zero_acc<4>(acc);
    TileSrc s{A, K, row0, Bt, K, n0, n0 + 64, K}; gemm_tile<4>(acc, s, smem);
#pragma unroll
    for (int m = 0; m < 4; ++m) { const int row = row0 + wr * 64 + m * 16 + fr;
#pragma unroll
      for (int n = 0; n < 4; ++n) *(f32x4*)(C + (size_t)row * D + n0 + wc * 64 + n * 16 + fq * 4) = acc[m][n]; }
  }
}

__device__ void phase_ffn_up(const P& p, int l, char* smem) {
  const bf16_t* H = (const bf16_t*)(p.ws + WS_H); const bf16_t* Wt = (const bf16_t*)(p.ws + WS_WUP); bf16_t* hid = (bf16_t*)(p.ws + WS_HID);
  const int tid = tidx();
  const float* cw = p.ffn_conv + (size_t)l * 3 * 2 * FF;
  for (int it = blockIdx.x; it < 98 * 44; it += gridDim.x) {
    const int mt = it / 44, nt = it % 44, c0 = nt * 64, arow0 = mt * 126 - 1;
    f32x4 acc[4][4]; zero_acc<4>(acc);
    TileSrc s{H, D, arow0, Wt, D, c0, FF + c0, D};
    gemm_tile<4>(acc, s, smem);
    float* sC = (float*)smem; stage_acc(acc, sC);
    for (int e = tid; e < 126 * 16; e += NT) {
      const int tr = 1 + (e >> 4), c4 = (e & 15) * 4, g = arow0 + tr;
      if (g < MT) { int t, T, mi; tokinfo(g, t, T, mi);
        const float pm = t > 0 ? 1.f : 0.f, nm = t < T - 1 ? 1.f : 0.f;
        const f32x4 va = *(const f32x4*)(sC + (tr - 1) * 132 + c4), vb = *(const f32x4*)(sC + tr * 132 + c4), vc = *(const f32x4*)(sC + (tr + 1) * 132 + c4);
        const f32x4 ga = *(const f32x4*)(sC + (tr - 1) * 132 + 64 + c4), gb = *(const f32x4*)(sC + tr * 132 + 64 + c4), gc = *(const f32x4*)(sC + (tr + 1) * 132 + 64 + c4);
        const f32x4 v0 = *(const f32x4*)(cw + c0 + c4), v1 = *(const f32x4*)(cw + 2 * FF + c0 + c4), v2 = *(const f32x4*)(cw + 4 * FF + c0 + c4);
        const f32x4 g0 = *(const f32x4*)(cw + FF + c0 + c4), g1 = *(const f32x4*)(cw + 3 * FF + c0 + c4), g2 = *(const f32x4*)(cw + 5 * FF + c0 + c4);
        float r[4];
#pragma unroll
        for (int j = 0; j < 4; ++j) { const float val = pm * va[j] * v0[j] + vb[j] * v1[j] + nm * vc[j] * v2[j]; const float gt = pm * ga[j] * g0[j] + gb[j] * g1[j] + nm * gc[j] * g2[j]; r[j] = gelu_tanh(gt) * val; }
        u32x2 o; o.x = pack2(r[0], r[1]); o.y = pack2(r[2], r[3]);
        *(u32x2*)(hid + (size_t)g * FF + c0 + c4) = o; }
    }
  }
}

template <int CTRL> DI float dppf(float v) { return __int_as_float(__builtin_amdgcn_mov_dpp(__float_as_int(v), CTRL, 0xF, 0xF, true)); }
DI float row16_sum(float v) { v += dppf<0xB1>(v); v += dppf<0x4E>(v); v += dppf<0x141>(v); v += dppf<0x140>(v); return v; }

__device__ void scan_task(const P& p, int l, int seq, int h, int d, char* smem) {
  float* sR = (float*)smem; float* sW = sR + 1024; float* sKD = sW + 1024; float* sB = sKD + 1024; float* sNK = sB + 1024; float* sV = sNK + 1024; float* sK = sV + 1024; float* sY = sK + 1024;
  float* sKn = sY + 1024; float* sKK = sKn + 16; bf16_t* sWT = (bf16_t*)(sKK + 64); bf16_t* sAL = sWT + 16 * LDT;
  const int tid = tidx(), lane = tid & 63, wave = tid >> 6, fr = lane & 15, fq = lane >> 4;
  const int row0 = seq < 32 ? seq * 256 : MC + (seq - 32) * 1024, T = seq < 32 ? 256 : 1024, nch = T >> 4;
  const bf16_t* zr = (const bf16_t*)(p.ws + WS_ZR);
  float* yout = (float*)(p.ws + WS_Y) + (size_t)d * MT * 512;
  __syncthreads();
  if (tid < 64) sKK[tid] = p.rwkv_k_k[l * 512 + h * 64 + tid];
  const int cc = wave * 16 + fr, gc = h * 64 + cc;
  bf16x8 bw[2], ba[2];
#pragma unroll
  for (int ks = 0; ks < 2; ++ks)
#pragma unroll
    for (int e = 0; e < 8; ++e) { const int k = ks * 32 + fq * 8 + e;
      bw[ks][e] = (short)f2bf(p.rwkv_w_up[((size_t)(l * 2 + d) * 64 + k) * 512 + gc]); ba[ks][e] = (short)f2bf(p.rwkv_a_up[((size_t)(l * 2 + d) * 64 + k) * 512 + gc]); }
  const float w0c = p.rwkv_w0[(l * 2 + d) * 512 + gc], a0c = p.rwkv_a0[(l * 2 + d) * 512 + gc], kac = p.rwkv_k_a[l * 512 + gc];
  const int rg = tid >> 4, kq = tid & 15;
  f32x2 S[4][2];
  if (seq >= 32) { const float* s0 = p.state_rwkv + (((((size_t)(seq - 32) * 2 + l) * 2 + d) * 8 + h) * 64 + rg * 4) * 64 + kq * 4;
#pragma unroll
    for (int r = 0; r < 4; ++r) { const f32x4 x = *(const f32x4*)(s0 + r * 64); S[r][0] = (f32x2){x[0], x[1]}; S[r][1] = (f32x2){x[2], x[3]}; } }
  else {
#pragma unroll
    for (int r = 0; r < 4; ++r) { S[r][0] = (f32x2){0.f, 0.f}; S[r][1] = (f32x2){0.f, 0.f}; } }
  if (seq >= 32) __builtin_amdgcn_s_setprio(2);
  const int segbase[5] = {h * 64, 512 + h * 64, 1024 + h * 64, 1536, 1600};
  int ct[3], cseg[3], cpart[3]; bool cval[3]; size_t coff[3];
#pragma unroll
  for (int i = 0; i < 3; ++i) { const int c = tid + 256 * i; cval[i] = c < 640; const int cx = cval[i] ? c : 0; ct[i] = cx / 40; const int rem = cx % 40; cseg[i] = rem >> 3; cpart[i] = rem & 7;
    const int sb = cseg[i] == 0 ? segbase[0] : (cseg[i] == 1 ? segbase[1] : (cseg[i] == 2 ? segbase[2] : (cseg[i] == 3 ? segbase[3] : segbase[4])));
    coff[i] = (size_t)ct[i] * NZR + sb + cpart[i] * 8; }
  u32x4 pre[3];
  { const int t0 = (d ? nch - 1 : 0) * 16;
#pragma unroll
    for (int i = 0; i < 3; ++i) pre[i] = *(const u32x4*)(zr + (size_t)(row0 + t0) * NZR + coff[i]); }
  __syncthreads();
  for (int ci = 0; ci < nch; ++ci) {
    const int chunk = d ? nch - 1 - ci : ci, t0 = chunk * 16;
#pragma unroll
    for (int i = 0; i < 3; ++i) {
      float f[8]; unpack8(pre[i], f); float ps = 0.f;
      if (cval[i]) {
        const int t = ct[i], o = t * 64 + cpart[i] * 8;
        if (cseg[i] == 0) { *(float4*)(sR + o) = make_float4(f[0], f[1], f[2], f[3]); *(float4*)(sR + o + 4) = make_float4(f[4], f[5], f[6], f[7]); }
        else if (cseg[i] == 1) { *(float4*)(sK + o) = make_float4(f[0], f[1], f[2], f[3]); *(float4*)(sK + o + 4) = make_float4(f[4], f[5], f[6], f[7]);
#pragma unroll
          for (int e = 0; e < 8; ++e) { const float kk = f[e] * sKK[cpart[i] * 8 + e]; ps += kk * kk; } }
        else if (cseg[i] == 2) { *(float4*)(sV + o) = make_float4(f[0], f[1], f[2], f[3]); *(float4*)(sV + o + 4) = make_float4(f[4], f[5], f[6], f[7]); }
        else if (cseg[i] == 3) { float g[8];
#pragma unroll
          for (int e = 0; e < 8; ++e) g[e] = 1.f - 2.f / (__expf(2.f * f[e]) + 1.f);
          *(u32x4*)(sWT + t * LDT + cpart[i] * 8) = pack8(g); }
        else { *(u32x4*)(sAL + t * LDT + cpart[i] * 8) = pre[i]; }
      }
      ps += __shfl_xor(ps, 1); ps += __shfl_xor(ps, 2); ps += __shfl_xor(ps, 4);
      if (cval[i] && cseg[i] == 1 && cpart[i] == 0) sKn[ct[i]] = ps;
    }
    __syncthreads();
    {
      f32x4 aw = {0.f, 0.f, 0.f, 0.f}, aa = {0.f, 0.f, 0.f, 0.f};
#pragma unroll
      for (int ks = 0; ks < 2; ++ks) { const bf16x8 fw = *(const bf16x8*)(sWT + fr * LDT + ks * 32 + fq * 8); const bf16x8 fa = *(const bf16x8*)(sAL + fr * LDT + ks * 32 + fq * 8);
        aw = MFMA16(fw, bw[ks], aw); aa = MFMA16(fa, ba[ks], aa); }
#pragma unroll
      for (int j = 0; j < 4; ++j) { const int t = fq * 4 + j, o = t * 64 + cc;
        const float dec = __expf(-0.6065306597f * sigmoidf_(w0c + aw[j]));
        const float a = sigmoidf_(a0c + aa[j]);
        const float kv = sK[o];
        const float kkv = kv * sKK[cc] / fmaxf(sqrtf(sKn[t]), 1e-12f);
        sW[o] = dec; sKD[o] = kv * (1.f + (a - 1.f) * kac); sB[o] = kkv * a; sNK[o] = -kkv; }
    }
    __syncthreads();
    { const int cn = ci + 1 < nch ? ci + 1 : ci; const int nt0 = (d ? nch - 1 - cn : cn) * 16;
#pragma unroll
      for (int i = 0; i < 3; ++i) pre[i] = *(const u32x4*)(zr + (size_t)(row0 + nt0) * NZR + coff[i]); }
#pragma unroll 2
    for (int si = 0; si < 16; ++si) {
      const int t = d ? 15 - si : si, o = t * 64 + kq * 4;
      const f32x4 an4 = *(const f32x4*)(sNK + o), w4 = *(const f32x4*)(sW + o), b4 = *(const f32x4*)(sB + o), kd4 = *(const f32x4*)(sKD + o), r4 = *(const f32x4*)(sR + o);
      const f32x4 v4 = *(const f32x4*)(sV + t * 64 + rg * 4);
      const f32x2 an[2] = {{an4[0], an4[1]}, {an4[2], an4[3]}}, wv[2] = {{w4[0], w4[1]}, {w4[2], w4[3]}}, bv[2] = {{b4[0], b4[1]}, {b4[2], b4[3]}}, kd[2] = {{kd4[0], kd4[1]}, {kd4[2], kd4[3]}}, rv[2] = {{r4[0], r4[1]}, {r4[2], r4[3]}};
      float sa[4];
#pragma unroll
      for (int r = 0; r < 4; ++r) { const f32x2 t2 = S[r][0] * an[0] + S[r][1] * an[1]; sa[r] = row16_sum(t2.x + t2.y); }
      f32x4 yv;
#pragma unroll
      for (int r = 0; r < 4; ++r) { const f32x2 sav = {sa[r], sa[r]}, vvv = {v4[r], v4[r]};
        S[r][0] = S[r][0] * wv[0] + (sav * bv[0] + vvv * kd[0]); S[r][1] = S[r][1] * wv[1] + (sav * bv[1] + vvv * kd[1]);
        const f32x2 y2 = S[r][0] * rv[0] + S[r][1] * rv[1]; yv[r] = row16_sum(y2.x + y2.y); }
      if (kq == 0) *(f32x4*)(sY + t * 64 + rg * 4) = yv;
    }
    __syncthreads();
    { const int t = tid >> 4, v4 = (tid & 15) * 4; *(float4*)(yout + (size_t)(row0 + t0 + t) * 512 + h * 64 + v4) = *(const float4*)(sY + t * 64 + v4); }
  }
  __builtin_amdgcn_s_setprio(0);
  if (seq < 32) { float* so = p.out + O_RW + (((((size_t)seq * 2 + l) * 2 + d) * 8 + h) * 64 + rg * 4) * 64 + kq * 4;
#pragma unroll
    for (int r = 0; r < 4; ++r) *(f32x4*)(so + r * 64) = (f32x4){S[r][0].x, S[r][0].y, S[r][1].x, S[r][1].y}; }
}

DI void qk_scores(const bf16_t* sK, const bf16x8 (&qf)[2], f32x4 (&sacc)[4], int fr, int fq) {
#pragma unroll
  for (int nt = 0; nt < 4; ++nt) { sacc[nt] = (f32x4){0.f, 0.f, 0.f, 0.f};
#pragma unroll
    for (int ks = 0; ks < 2; ++ks) { const bf16x8 kf = *(const bf16x8*)(sK + (nt * 16 + fr) * LDT + ks * 32 + fq * 8); sacc[nt] = MFMA16(kf, qf[ks], sacc[nt]); } }
}
DI void pv_accum(const bf16_t* sVt, const f32x4 (&pacc)[4], f32x4 (&o)[4], int fr, int fq) {
#pragma unroll
  for (int s = 0; s < 2; ++s) {
    bf16x8 pf; { const unsigned a = pack2(pacc[2 * s][0], pacc[2 * s][1]), b = pack2(pacc[2 * s][2], pacc[2 * s][3]), c = pack2(pacc[2 * s + 1][0], pacc[2 * s + 1][1]), dd = pack2(pacc[2 * s + 1][2], pacc[2 * s + 1][3]);
      const u32x4 u = (u32x4){a, b, c, dd}; pf = __builtin_bit_cast(bf16x8, u); }
#pragma unroll
    for (int dt = 0; dt < 4; ++dt) { const u32x2 lo = *(const u32x2*)(sVt + (dt * 16 + fr) * LDT + 32 * s + 4 * fq), hi = *(const u32x2*)(sVt + (dt * 16 + fr) * LDT + 32 * s + 16 + 4 * fq);
      const u32x4 u = (u32x4){lo[0], lo[1], hi[0], hi[1]}; const bf16x8 vf = __builtin_bit_cast(bf16x8, u); o[dt] = MFMA16(vf, pf, o[dt]); }
  }
}
DI void put_kv(bf16_t* sK, bf16_t* sVt, int key, int part, const float (&kf)[8], const float (&vf)[8]) {
  *(u32x4*)(sK + key * LDT + part * 8) = pack8(kf);
#pragma unroll
  for (int e = 0; e < 8; ++e) sVt[(part * 8 + e) * LDT + key] = f2bf(vf[e]);
}
DI void softmax_tile(f32x4 (&sacc)[4], f32x4 (&o)[4], float& mrun, float& lrun) {
  float mx = sacc[0][0];
#pragma unroll
  for (int nt = 0; nt < 4; ++nt)
#pragma unroll
    for (int j = 0; j < 4; ++j) mx = fmaxf(mx, sacc[nt][j]);
  mx = fmaxf(mx, __shfl_xor(mx, 16)); mx = fmaxf(mx, __shfl_xor(mx, 32));
  const float mnew = fmaxf(mrun, mx), alpha = exp2f(mrun - mnew); mrun = mnew;
  float ls = 0.f;
#pragma unroll
  for (int nt = 0; nt < 4; ++nt)
#pragma unroll
    for (int j = 0; j < 4; ++j) { const float pv = exp2f(sacc[nt][j] - mnew); sacc[nt][j] = pv; ls += pv; }
  lrun = lrun * alpha + ls;
#pragma unroll
  for (int dt = 0; dt < 4; ++dt) o[dt] *= alpha;
}
constexpr float LOG2E = 1.4426950408889634f;

__device__ void dense_task(const P& p, int b, int h, int qb, char* smem) {
  bf16_t* sK = (bf16_t*)smem; bf16_t* sVt = sK + 64 * LDT;
  const int tid = tidx(), lane = tid & 63, wave = tid >> 6, fr = lane & 15, fq = lane >> 4;
  const bf16_t* zn = (const bf16_t*)(p.ws + WS_ZN); bf16_t* ona = (bf16_t*)(p.ws + WS_ONA);
  const int qrow = b * 256 + qb * 64 + wave * 16 + fr;
  bf16x8 qf[2];
#pragma unroll
  for (int ks = 0; ks < 2; ++ks) qf[ks] = *(const bf16x8*)(zn + (size_t)qrow * NZN + h * 64 + ks * 32 + fq * 8);
  f32x4 o[4]; for (int dt = 0; dt < 4; ++dt) o[dt] = (f32x4){0.f, 0.f, 0.f, 0.f};
  float mrun = -1e30f, lrun = 0.f;
  for (int kt = 0; kt < 4; ++kt) {
    __syncthreads();
#pragma unroll
    for (int i = 0; i < 2; ++i) { const int c = tid + 256 * i, key = c >> 3, part = c & 7; const size_t ro = (size_t)(b * 256 + kt * 64 + key) * NZN + h * 64 + part * 8;
      const u32x4 kr = *(const u32x4*)(zn + ro + 512), vr = *(const u32x4*)(zn + ro + 1024); float vf[8]; unpack8(vr, vf);
      *(u32x4*)(sK + key * LDT + part * 8) = kr;
#pragma unroll
      for (int e = 0; e < 8; ++e) sVt[(part * 8 + e) * LDT + key] = f2bf(vf[e]); }
    __syncthreads();
    f32x4 sacc[4]; qk_scores(sK, qf, sacc, fr, fq);
#pragma unroll
    for (int nt = 0; nt < 4; ++nt) sacc[nt] *= (0.125f * LOG2E);
    softmax_tile(sacc, o, mrun, lrun);
    pv_accum(sVt, sacc, o, fr, fq);
  }
  lrun += __shfl_xor(lrun, 16); lrun += __shfl_xor(lrun, 32); const float inv = 1.f / lrun;
#pragma unroll
  for (int dt = 0; dt < 4; ++dt) { u32x2 ov; ov.x = pack2(o[dt][0] * inv, o[dt][1] * inv); ov.y = pack2(o[dt][2] * inv, o[dt][3] * inv); *(u32x2*)(ona + (size_t)qrow * 512 + h * 64 + dt * 16 + fq * 4) = ov; }
}

__device__ void na_task(const P& p, int l, int b, int h, int r, char* smem) {
  bf16_t* sK = (bf16_t*)smem; bf16_t* sVt = sK + 64 * LDT; float* sRpb = (float*)(sVt + 64 * LDT);
  const int tid = tidx(), lane = tid & 63, wave = tid >> 6, fr = lane & 15, fq = lane >> 4;
  const bf16_t* zn = (const bf16_t*)(p.ws + WS_ZN); bf16_t* ona = (bf16_t*)(p.ws + WS_ONA);
  const int base = MC + b * 1024, qcol = wave * 16 + fr, qrow = base + r * 64 + qcol;
  int rs = r - 4; rs = rs < 0 ? 0 : (rs > 8 ? 8 : rs);
  int cs = qcol - 8; cs = cs < 0 ? 0 : (cs > 48 ? 48 : cs);
  __syncthreads();
  for (int e = tid; e < 465; e += NT) sRpb[e] = p.na_rpb[((size_t)l * 8 + h) * 465 + e] * LOG2E;
  bf16x8 qf[2];
#pragma unroll
  for (int ks = 0; ks < 2; ++ks) qf[ks] = *(const bf16x8*)(zn + (size_t)qrow * NZN + h * 64 + ks * 32 + fq * 8);
  f32x4 o[4]; for (int dt = 0; dt < 4; ++dt) o[dt] = (f32x4){0.f, 0.f, 0.f, 0.f};
  float mrun = -1e30f, lrun = 0.f;
  for (int kt = 0; kt < 12; ++kt) {
    __syncthreads();
    if (kt < 8) {
#pragma unroll
      for (int i = 0; i < 2; ++i) { const int c = tid + 256 * i, key = c >> 3, part = c & 7; const size_t ro = (size_t)(base + (rs + kt) * 64 + key) * NZN + h * 64 + part * 8;
        const u32x4 kr = *(const u32x4*)(zn + ro + 512), vr = *(const u32x4*)(zn + ro + 1024); float vf[8]; unpack8(vr, vf);
        *(u32x4*)(sK + key * LDT + part * 8) = kr;
#pragma unroll
        for (int e = 0; e < 8; ++e) sVt[(part * 8 + e) * LDT + key] = f2bf(vf[e]); }
    } else {
#pragma unroll
      for (int i = 0; i < 2; ++i) { const int c = tid + 256 * i, key = c >> 3, part = c & 7; const size_t co = ((((size_t)b * 2 + l) * 8 + h) * 256 + (kt - 8) * 64 + key) * 64 + part * 8;
        const float4 k0 = *(const float4*)(p.cache_k + co), k1 = *(const float4*)(p.cache_k + co + 4), v0 = *(const float4*)(p.cache_v + co), v1 = *(const float4*)(p.cache_v + co + 4);
        const float kf[8] = {k0.x, k0.y, k0.z, k0.w, k1.x, k1.y, k1.z, k1.w}; const float vf[8] = {v0.x, v0.y, v0.z, v0.w, v1.x, v1.y, v1.z, v1.w};
        put_kv(sK, sVt, key, part, kf, vf); }
    }
    __syncthreads();
    f32x4 sacc[4]; qk_scores(sK, qf, sacc, fr, fq);
    if (kt < 8) { const int dr = rs + kt - r + 7;
#pragma unroll
      for (int nt = 0; nt < 4; ++nt)
#pragma unroll
        for (int j = 0; j < 4; ++j) { const int kc = nt * 16 + fq * 4 + j; const bool valid = kc >= cs && kc < cs + 16; int dc = kc - qcol; dc = dc < -15 ? -15 : (dc > 15 ? 15 : dc);
          sacc[nt][j] = valid ? sacc[nt][j] * (0.125f * LOG2E) + sRpb[dr * 31 + dc + 15] : -1e30f; }
    } else {
#pragma unroll
      for (int nt = 0; nt < 4; ++nt) sacc[nt] *= (0.125f * LOG2E);
    }
    softmax_tile(sacc, o, mrun, lrun);
    pv_accum(sVt, sacc, o, fr, fq);
  }
  lrun += __shfl_xor(lrun, 16); lrun += __shfl_xor(lrun, 32); const float inv = 1.f / lrun;
#pragma unroll
  for (int dt = 0; dt < 4; ++dt) { u32x2 ov; ov.x = pack2(o[dt][0] * inv, o[dt][1] * inv); ov.y = pack2(o[dt][2] * inv, o[dt][3] * inv); *(u32x2*)(ona + (size_t)qrow * 512 + h * 64 + dt * 16 + fq * 4) = ov; }
}

DI void rope8(const float (&own)[8], const float (&par)[8], int part, int n, float (&out)[8]) {
  const float pos = (float)((part >> 2) ? (n & 63) : (n >> 6));
  const bool isx2 = (part & 3) >= 2;
#pragma unroll
  for (int e = 0; e < 8; ++e) { const int i = (part & 1) * 8 + e; const float ang = pos * exp2f(-(float)i * 0.830482023721841f); const float sn = __sinf(ang), cs = __cosf(ang);
    out[e] = isx2 ? par[e] * sn + own[e] * cs : own[e] * cs - par[e] * sn; }
}

__device__ void ret_task(const P& p, int l, int seq, int h, int qb, char* smem) {
  bf16_t* sK = (bf16_t*)smem; bf16_t* sVt = sK + 64 * LDT; bf16_t* sQ = sVt + 64 * LDT;
  const int tid = tidx(), lane = tid & 63, wave = tid >> 6, fr = lane & 15, fq = lane >> 4;
  const bf16_t* zt = (const bf16_t*)(p.ws + WS_ZT); bf16_t* oret = (bf16_t*)(p.ws + WS_ORET);
  const bool lat = seq >= 32;
  const int row0 = lat ? MC + (seq - 32) * 1024 : seq * 256, T = lat ? 1024 : 256, nkt = T >> 6;
  const float xf = p.ret_decay[(l * 2 + 0) * 8 + h], xb = p.ret_decay[(l * 2 + 1) * 8 + h];
  const float lgf = -log1pf(__expf(-xf)) * LOG2E, lgb = -log1pf(__expf(-xb)) * LOG2E;
  __syncthreads();
#pragma unroll
  for (int i = 0; i < 2; ++i) { const int c = tid + 256 * i, qi = c >> 3, part = c & 7; const int n = qb * 64 + qi; const size_t ro = (size_t)(row0 + n) * NZT + h * 64;
    const u32x4 own = *(const u32x4*)(zt + ro + part * 8);
    if (lat) { const u32x4 par = *(const u32x4*)(zt + ro + (part ^ 2) * 8); float fo[8], fp[8], out[8]; unpack8(own, fo); unpack8(par, fp); rope8(fo, fp, part, n, out); *(u32x4*)(sQ + qi * LDT + part * 8) = pack8(out); }
    else *(u32x4*)(sQ + qi * LDT + part * 8) = own; }
  __syncthreads();
  const int qi = wave * 16 + fr, nq = qb * 64 + qi;
  bf16x8 qf[2];
#pragma unroll
  for (int ks = 0; ks < 2; ++ks) qf[ks] = *(const bf16x8*)(sQ + qi * LDT + ks * 32 + fq * 8);
  f32x4 o[4]; for (int dt = 0; dt < 4; ++dt) o[dt] = (f32x4){0.f, 0.f, 0.f, 0.f};
  for (int kt = 0; kt < nkt; ++kt) {
    __syncthreads();
#pragma unroll
    for (int i = 0; i < 2; ++i) { const int c = tid + 256 * i, key = c >> 3, part = c & 7; const int n = kt * 64 + key; const size_t ro = (size_t)(row0 + n) * NZT + h * 64;
      const u32x4 own = *(const u32x4*)(zt + ro + 512 + part * 8), vr = *(const u32x4*)(zt + ro + 1024 + part * 8);
      float kf[8], vf[8]; unpack8(own, kf); unpack8(vr, vf);
      if (lat) { const u32x4 par = *(const u32x4*)(zt + ro + 512 + (part ^ 2) * 8); float fp[8], out[8]; unpack8(par, fp); rope8(kf, fp, part, n, out);
#pragma unroll
        for (int e = 0; e < 8; ++e) kf[e] = out[e]; }
#pragma unroll
      for (int e = 0; e < 8; ++e) kf[e] *= 0.125f;
      put_kv(sK, sVt, key, part, kf, vf); }
    __syncthreads();
    f32x4 sacc[4]; qk_scores(sK, qf, sacc, fr, fq);
#pragma unroll
    for (int nt = 0; nt < 4; ++nt)
#pragma unroll
      for (int j = 0; j < 4; ++j) { const int mk = kt * 64 + nt * 16 + fq * 4 + j; const int df = nq - mk;
        const float dec = df > 0 ? exp2f(lgf * (float)df) : (df < 0 ? exp2f(lgb * (float)(-df)) : 2.f); sacc[nt][j] *= dec; }
    pv_accum(sVt, sacc, o, fr, fq);
  }
  if (lat) {
    for (int dir = 0; dir < 2; ++dir) {
      __syncthreads();
      const float* s0 = p.state_ret + ((((size_t)(seq - 32) * 2 + l) * 2 + dir) * 8 + h) * 4096;
#pragma unroll
      for (int i = 0; i < 2; ++i) { const int c = tid + 256 * i, dk = c >> 3, part = c & 7; const float4 a = *(const float4*)(s0 + dk * 64 + part * 8), bq = *(const float4*)(s0 + dk * 64 + part * 8 + 4);
        const float vf[8] = {a.x, a.y, a.z, a.w, bq.x, bq.y, bq.z, bq.w};
#pragma unroll
        for (int e = 0; e < 8; ++e) sVt[(part * 8 + e) * LDT + dk] = f2bf(vf[e]); }
      __syncthreads();
      const float xi = dir == 0 ? exp2f(lgf * (float)(nq + 1)) : exp2f(lgb * (float)(T - nq));
      f32x4 pacc[4];
#pragma unroll
      for (int s = 0; s < 2; ++s)
#pragma unroll
        for (int hh = 0; hh < 2; ++hh)
#pragma unroll
          for (int j = 0; j < 4; ++j) pacc[2 * s + hh][j] = xi * bf2f(sQ[qi * LDT + 32 * s + 16 * hh + 4 * fq + j]);
      pv_accum(sVt, pacc, o, fr, fq);
    }
  }
  float s1 = 0.f;
#pragma unroll
  for (int dt = 0; dt < 4; ++dt)
#pragma unroll
    for (int j = 0; j < 4; ++j) s1 += o[dt][j];
  s1 += __shfl_xor(s1, 16); s1 += __shfl_xor(s1, 32); const float mu = s1 * (1.f / 64.f);
  float s2 = 0.f;
#pragma unroll
  for (int dt = 0; dt < 4; ++dt)
#pragma unroll
    for (int j = 0; j < 4; ++j) { const float dlt = o[dt][j] - mu; s2 += dlt * dlt; }
  s2 += __shfl_xor(s2, 16); s2 += __shfl_xor(s2, 32); const float rstd = rsqrtf(s2 * (1.f / 64.f) + 1e-5f);
  const size_t qrow = (size_t)(row0 + nq);
#pragma unroll
  for (int dt = 0; dt < 4; ++dt) { const int dv = h * 64 + dt * 16 + fq * 4; const u32x2 gr = *(const u32x2*)(zt + qrow * NZT + 1536 + dv); const float4 gn = *(const float4*)(p.ret_gn + l * 512 + dv);
    const float g0 = bflo(gr.x), g1 = bfhi(gr.x), g2 = bflo(gr.y), g3 = bfhi(gr.y);
    u32x2 ov; ov.x = pack2((o[dt][0] - mu) * rstd * gn.x * g0 * sigmoidf_(g0), (o[dt][1] - mu) * rstd * gn.y * g1 * sigmoidf_(g1));
    ov.y = pack2((o[dt][2] - mu) * rstd * gn.z * g2 * sigmoidf_(g2), (o[dt][3] - mu) * rstd * gn.w * g3 * sigmoidf_(g3));
    *(u32x2*)(oret + qrow * 512 + dv) = ov; }
}

__device__ void retstate_task(const P& p, int l, int b, int h, char* smem) {
  float* sKf = (float*)smem; float* sKb = sKf + 64 * 64; float* sV = sKb + 64 * 64;
  const int tid = tidx(), dk = tid >> 2, dq = tid & 3;
  const bf16_t* zt = (const bf16_t*)(p.ws + WS_ZT);
  const float xf = p.ret_decay[(l * 2 + 0) * 8 + h], xb = p.ret_decay[(l * 2 + 1) * 8 + h];
  const float lgf = -log1pf(__expf(-xf)) * LOG2E, lgb = -log1pf(__expf(-xb)) * LOG2E;
  float af[16], ab[16];
#pragma unroll
  for (int i = 0; i < 16; ++i) { af[i] = 0.f; ab[i] = 0.f; }
  for (int kt = 0; kt < 4; ++kt) {
    __syncthreads();
#pragma unroll
    for (int i = 0; i < 2; ++i) { const int c = tid + 256 * i, key = c >> 3, part = c & 7, m = kt * 64 + key; const size_t ro = (size_t)(b * 256 + m) * NZT + h * 64 + part * 8;
      float kf[8], vf[8]; unpack8(*(const u32x4*)(zt + ro + 512), kf); unpack8(*(const u32x4*)(zt + ro + 1024), vf);
      const float wf = 0.125f * exp2f(lgf * (float)(255 - m)), wb = 0.125f * exp2f(lgb * (float)m);
#pragma unroll
      for (int e = 0; e < 8; ++e) { sKf[key * 64 + part * 8 + e] = kf[e] * wf; sKb[key * 64 + part * 8 + e] = kf[e] * wb; sV[key * 64 + part * 8 + e] = vf[e]; } }
    __syncthreads();
    for (int m = 0; m < 64; ++m) { const float kf = sKf[m * 64 + dk], kb = sKb[m * 64 + dk];
#pragma unroll
      for (int i = 0; i < 4; ++i) { const f32x4 vv = *(const f32x4*)(sV + m * 64 + dq * 16 + i * 4);
#pragma unroll
        for (int j = 0; j < 4; ++j) { af[i * 4 + j] += kf * vv[j]; ab[i * 4 + j] += kb * vv[j]; } } }
  }
  float* of = p.out + O_RT + ((((size_t)b * 2 + l) * 2 + 0) * 8 + h) * 4096 + dk * 64 + dq * 16; float* ob = of + 8 * 4096;
#pragma unroll
  for (int i = 0; i < 16; ++i) { of[i] = af[i]; ob[i] = ab[i]; }
}

constexpr int Q_SCAN_L = 64, Q_SCAN_C = 512, Q_RET_L = 512, Q_NA = 512, Q_DENSE = 1024, Q_RET_C = 1024, Q_RST = 256;
constexpr int Q_TOTAL = Q_SCAN_L + Q_SCAN_C + Q_RET_L + Q_NA + Q_DENSE + Q_RET_C + Q_RST;
__device__ void phase_mixers(const P& p, int l, char* smem, int rep = 0) {
  __shared__ int s_task;
  int* ctr = (int*)(p.ws + WS_CTRL) + 64 * (l + 1) + 4 * rep;
  for (;;) {
    __syncthreads();
    if (tidx() == 0) s_task = atomicAdd(ctr, 1);
    __syncthreads();
    const int tk = s_task;
    if (tk >= Q_SCAN_L + Q_SCAN_C) break;
    if (tk < Q_SCAN_L) scan_task(p, l, 32 + (tk >> 4), (tk >> 1) & 7, tk & 1, smem);
    else { const int t2 = tk - Q_SCAN_L; scan_task(p, l, t2 >> 4, (t2 >> 1) & 7, t2 & 1, smem); }
  }
  for (;;) {
    __syncthreads();
    if (tidx() == 0) s_task = atomicAdd(ctr + 16, 1);
    __syncthreads();
    const int tk = s_task;
    if (tk >= Q_RET_L + Q_RET_C) break;
    if (tk < Q_RET_L) ret_task(p, l, 32 + (tk >> 7), (tk >> 4) & 7, tk & 15, smem);
    else { const int t2 = tk - Q_RET_L; ret_task(p, l, t2 >> 5, (t2 >> 2) & 7, t2 & 3, smem); }
  }
  for (;;) {
    __syncthreads();
    if (tidx() == 0) s_task = atomicAdd(ctr + 32, 1);
    __syncthreads();
    int tk = s_task;
    if (tk >= Q_NA + Q_DENSE + Q_RST) break;
    if (tk < Q_NA) { na_task(p, l, tk >> 7, (tk >> 4) & 7, tk & 15, smem); continue; } tk -= Q_NA;
    if (tk < Q_DENSE) { dense_task(p, tk >> 5, (tk >> 2) & 7, tk & 3, smem); continue; } tk -= Q_DENSE;
    retstate_task(p, l, tk >> 3, tk & 7, smem);
  }
}

__device__ void phase_rwkv_post(const P& p, int l, char* smem) {
  float* sg = (float*)smem;
  const int tid = tidx();
  const bf16_t* zr = (const bf16_t*)(p.ws + WS_ZR); const float* yf = (const float*)(p.ws + WS_Y); const float* yb = yf + (size_t)MT * 512; bf16_t* oa = (bf16_t*)(p.ws + WS_OA);
  const float* gup = p.rwkv_g_up + (size_t)l * 128 * 512;
  for (int it = blockIdx.x; it < MT / 8; it += gridDim.x) {
    const int m0 = it * 8;
    __syncthreads();
    for (int e = tid; e < 1024; e += NT) sg[e] = sigmoidf_(bf2f(zr[(size_t)(m0 + (e >> 7)) * NZR + 1664 + (e & 127)]));
    __syncthreads();
    float g[8][2];
#pragma unroll
    for (int tk = 0; tk < 8; ++tk) { g[tk][0] = 0.f; g[tk][1] = 0.f; }
#pragma unroll 4
    for (int j = 0; j < 128; ++j) { const float g0 = gup[j * 512 + tid], g1 = gup[j * 512 + 256 + tid];
#pragma unroll
      for (int tk = 0; tk < 8; ++tk) { const float sv = sg[tk * 128 + j]; g[tk][0] += sv * g0; g[tk][1] += sv * g1; } }
#pragma unroll
    for (int tk = 0; tk < 8; ++tk) { const int m = m0 + tk;
#pragma unroll
      for (int half = 0; half < 2; ++half) {
        const int c = half * 256 + tid;
        const float y = yf[(size_t)m * 512 + c] + yb[(size_t)m * 512 + c];
        const float mu = wave_sum(y) * (1.f / 64.f); const float dl = y - mu; const float var = wave_sum(dl * dl) * (1.f / 64.f);
        const float o = dl * rsqrtf(var + 64e-5f) * p.rwkv_ln_g[l * 512 + c] + p.rwkv_ln_b[l * 512 + c];
        const float r = bf2f(zr[(size_t)m * NZR + c]), k = bf2f(zr[(size_t)m * NZR + 512 + c]), v = bf2f(zr[(size_t)m * NZR + 1024 + c]);
        const float bonus = wave_sum(r * k * p.rwkv_r_k[l * 512 + c]) * v;
        oa[(size_t)m * 512 + c] = f2bf((o + bonus) * g[tk][half]);
      } }
  }
}

DI void convert_layer_a(const P& p, int l, char* smem) {
  convert_T(p.w_in + (size_t)l * D * INC, D, INC, (bf16_t*)(p.ws + WS_WIN), smem);
  convert_T(p.w_o_rwkv + (size_t)l * 512 * D, 512, D, (bf16_t*)(p.ws + WS_WO3), smem);
  convert_T(p.w_o_na + (size_t)l * 512 * D, 512, D, (bf16_t*)(p.ws + WS_WO3) + (size_t)1024 * 512, smem);
  convert_T(p.w_o_ret + (size_t)l * 512 * D, 512, D, (bf16_t*)(p.ws + WS_WO3) + (size_t)2 * 1024 * 512, smem);
  convert_T(p.w_out + (size_t)l * D * D, D, D, (bf16_t*)(p.ws + WS_WOUT), smem);
}
DI void convert_layer_b(const P& p, int l, char* smem) {
  convert_T(p.ffn_up + (size_t)l * D * 2 * FF, D, 2 * FF, (bf16_t*)(p.ws + WS_WUP), smem);
  convert_T(p.ffn_down + (size_t)l * FF * D, FF, D, (bf16_t*)(p.ws + WS_WDN), smem);
}

template <int PH> DI void run_phase(const P& p, int l, char* smem) {
  const float* mod = (const float*)(p.ws + WS_MOD);
  float* xbuf = p.out;
  if (PH == 0) { ada_phase(p, smem); convert_layer_a(p, 0, smem); }
  else if (PH == 1) { norm_phase(p, nullptr, nullptr, nullptr, nullptr, 0, nullptr, p.norm_mix_pre, mod, 0, (bf16_t*)(p.ws + WS_H)); }
  else if (PH == 2) phase_win(p, l, smem);
  else if (PH == 4) phase_mixers(p, l, smem);
  else if (PH == 5) phase_rwkv_post(p, l, smem);
  else if (PH == 6) phase_merge(p, smem);
  else if (PH == 7) { phase_gemm_f32((const bf16_t*)(p.ws + WS_MERGED), D, (const bf16_t*)(p.ws + WS_WOUT), (float*)(p.ws + WS_U), smem); }
  else if (PH == 8) { convert_layer_b(p, l, smem);
    norm_phase(p, l == 0 ? nullptr : xbuf, (const float*)(p.ws + WS_U), p.norm_mix_post + l * D, mod + (size_t)l * 5 * 6144, 2, xbuf, p.norm_ffn_pre + l * D, mod + (size_t)l * 5 * 6144, 3, (bf16_t*)(p.ws + WS_H)); }
  else if (PH == 9) phase_ffn_up(p, l, smem);
  else if (PH == 11) { phase_gemm_f32((const bf16_t*)(p.ws + WS_HID), FF, (const bf16_t*)(p.ws + WS_WDN), (float*)(p.ws + WS_F), smem); }
  else if (PH == 12) {
    if (l == 0) { norm_phase(p, xbuf, (const float*)(p.ws + WS_F), p.norm_ffn_post, mod, 5, xbuf, p.norm_mix_pre + D, mod + (size_t)5 * 6144, 0, (bf16_t*)(p.ws + WS_H)); convert_layer_a(p, 1, smem); }
    else norm_phase(p, xbuf, (const float*)(p.ws + WS_F), p.norm_ffn_post + D, mod + (size_t)5 * 6144, 5, xbuf, nullptr, nullptr, 0, nullptr);
  }
}

#if MEGA
__global__ void __launch_bounds__(NT, 2) mega_kernel(P p) {
  extern __shared__ __attribute__((aligned(16))) char smem[];
  cg::grid_group grid = cg::this_grid();
  run_phase<0>(p, 0, smem); grid.sync();
  run_phase<1>(p, 0, smem); grid.sync();
#pragma unroll 1
  for (int l = 0; l < 2; ++l) {
    run_phase<2>(p, l, smem); grid.sync();
#if PROBE_GEMM2
    run_phase<2>(p, l, smem); grid.sync();
#endif
    run_phase<4>(p, l, smem); grid.sync();
#if PROBE_MIX2
    phase_mixers(p, l, smem, 1); grid.sync();
#endif
    run_phase<5>(p, l, smem); grid.sync();
    run_phase<6>(p, l, smem); grid.sync();
#if PROBE_GEMM2
    run_phase<6>(p, l, smem); grid.sync();
#endif
    run_phase<7>(p, l, smem); grid.sync();
#if PROBE_GEMM2
    run_phase<7>(p, l, smem); grid.sync();
#endif
    run_phase<8>(p, l, smem); grid.sync();
    run_phase<9>(p, l, smem); grid.sync();
#if PROBE_GEMM2
    run_phase<9>(p, l, smem); grid.sync();
#endif
    run_phase<11>(p, l, smem); grid.sync();
#if PROBE_GEMM2
    run_phase<11>(p, l, smem); grid.sync();
#endif
    run_phase<12>(p, l, smem); if (l == 0) grid.sync();
  }
}
#else
template <int PH> __global__ void __launch_bounds__(NT, 2) phase_kernel(P p, int l) {
  extern __shared__ __attribute__((aligned(16))) char smem[];
  run_phase<PH>(p, l, smem);
}
#endif

extern "C" void kernel_launch(void* const* d_in, const int* in_sizes, int n_in, void* d_out, int out_size, void* d_ws, size_t ws_size, hipStream_t stream) {
  if (ws_size < WS_END || n_in < 36) { fprintf(stderr, "workspace too small: %zu < %zu\n", ws_size, (size_t)WS_END); return; }
  P p{};
  const float** pp = (const float**)&p;
  for (int i = 0; i < 36; ++i) pp[i] = (const float*)d_in[i];
  p.out = (float*)d_out; p.ws = (char*)d_ws;
  hipMemsetAsync(d_ws, 0, WS_WIN, stream);
#if MEGA
  static int grid_blocks = 0;
  if (!grid_blocks) {
    int dev = 0, cus = 0, per_cu = 0; hipGetDevice(&dev);
    hipDeviceGetAttribute(&cus, hipDeviceAttributeMultiprocessorCount, dev);
    hipFuncSetAttribute((const void*)mega_kernel, hipFuncAttributeMaxDynamicSharedMemorySize, SMEM_BYTES);
    hipOccupancyMaxActiveBlocksPerMultiprocessor(&per_cu, mega_kernel, NT, SMEM_BYTES);
    if (per_cu > 2) per_cu = 2;
    grid_blocks = cus * per_cu;
  }
  void* args[] = {&p};
  hipError_t e = hipLaunchCooperativeKernel((void*)mega_kernel, dim3(grid_blocks), dim3(NT), args, SMEM_BYTES, stream);
  if (e != hipSuccess) fprintf(stderr, "cooperative launch failed: %s (grid %d)\n", hipGetErrorString(e), grid_blocks);
#else
  const int G = 512;
#define LAUNCH(PH, L) do { hipFuncSetAttribute((const void*)phase_kernel<PH>, hipFuncAttributeMaxDynamicSharedMemorySize, SMEM_BYTES); phase_kernel<PH><<<G, NT, SMEM_BYTES, stream>>>(p, L); } while (0)
  LAUNCH(0, 0); LAUNCH(1, 0);
  for (int l = 0; l < 2; ++l) { LAUNCH(2, l); LAUNCH(4, l); LAUNCH(5, l); LAUNCH(6, l); LAUNCH(7, l); LAUNCH(8, l); LAUNCH(9, l); LAUNCH(11, l); LAUNCH(12, l); }
#endif
}
```

```cpp
#include <hip/hip_runtime.h>
#include <hip/hip_cooperative_groups.h>
#include <cstdio>
namespace cg = cooperative_groups;

#ifndef MEGA
#define MEGA 1
#endif
#define PROBE_GEMM2 0
#define PROBE_MIX2 0

typedef unsigned short bf16_t;
typedef short bf16x8 __attribute__((ext_vector_type(8)));
typedef short bf16x4 __attribute__((ext_vector_type(4)));
typedef float f32x4 __attribute__((ext_vector_type(4)));
typedef float f32x2 __attribute__((ext_vector_type(2)));
typedef unsigned u32x4 __attribute__((ext_vector_type(4)));
typedef unsigned u32x2 __attribute__((ext_vector_type(2)));
#define DI __device__ __forceinline__
#define MFMA16(a, b, c) __builtin_amdgcn_mfma_f32_16x16x32_bf16((a), (b), (c), 0, 0, 0)

constexpr int NT = 256;
constexpr int D = 1024, MC = 8192, ML = 4096, MT = 12288;
constexpr int NZR = 1792, NZN = 1536, NZT = 2048, INC = 8448, FF = 2816;
constexpr int LDH = 1088, LDO = 576, LZT = 2112;
constexpr int LDT = 72;
constexpr int SMEM_BYTES = 2 * 256 * LDT * 2;
constexpr size_t O_K = 12582912, O_V = 20971520, O_RW = 29360128, O_RT = 33554432;
constexpr size_t WS_CTRL = 0;
constexpr size_t WS_MOD = 4096;
constexpr size_t WS_BAR = 262144;
constexpr size_t WS_WIN = 278528;
constexpr size_t WS_WUP = WS_WIN;
constexpr size_t WS_WDN = WS_WIN + (size_t)5632 * LDH * 2;
constexpr size_t WS_WO3 = WS_WIN + (size_t)INC * LDH * 2;
constexpr size_t WS_WOUT = WS_WO3 + (size_t)3 * 1024 * LDO * 2;
constexpr size_t WS_H = WS_WOUT + (size_t)1024 * LDH * 2;
constexpr size_t WS_Z = WS_H + (size_t)MT * LDH * 2;
constexpr size_t WS_ZR = WS_Z;
constexpr size_t WS_ZN = WS_ZR + (size_t)MT * NZR * 2;
constexpr size_t WS_ZT = WS_ZN + (size_t)MT * NZN * 2;
constexpr size_t WS_MERGED = WS_ZR;
constexpr size_t WS_OA = WS_ZN;
constexpr size_t WS_U = WS_ZT;
constexpr size_t WS_HID = WS_Z;
constexpr size_t WS_F = WS_ZT;
constexpr size_t WS_Y = WS_ZT + (size_t)MT * LZT * 2;
constexpr size_t WS_ONA = WS_Y + (size_t)2 * MT * 512 * 4;
constexpr size_t WS_ORET = WS_ONA + (size_t)MT * LDO * 2;
constexpr size_t WS_END = WS_ORET + (size_t)MT * LDO * 2;

struct P {
  const float *x_prompt, *x_sample, *cache_k, *cache_v, *state_rwkv, *state_ret, *c, *c_ctx, *ada_w, *ada_b;
  const float *norm_mix_pre, *norm_mix_post, *norm_ffn_pre, *norm_ffn_post, *w_in, *rwkv_conv, *rwkv_w0, *rwkv_w_up, *rwkv_a0, *rwkv_a_up, *rwkv_g_up;
  const float *rwkv_k_k, *rwkv_k_a, *rwkv_r_k, *rwkv_ln_g, *rwkv_ln_b, *na_rpb, *ret_decay, *ret_gn, *w_o_rwkv, *w_o_na, *w_o_ret, *w_out, *ffn_up, *ffn_conv, *ffn_down;
  float* out; char* ws;
};

DI int threadIdx_x_raw() { return (int)__builtin_amdgcn_workitem_id_x(); }
DI int tidx() { int t = threadIdx_x_raw(); asm volatile("" : "+v"(t)); return t; }
DI bf16_t f2bf(float x) { unsigned u = __float_as_uint(x); u += 0x7fffu + ((u >> 16) & 1u); return (bf16_t)(u >> 16); }
DI float bf2f(bf16_t b) { return __uint_as_float(((unsigned)b) << 16); }
DI unsigned pack2(float a, float b) { return (unsigned)f2bf(a) | ((unsigned)f2bf(b) << 16); }
DI float bflo(unsigned u) { return __uint_as_float(u << 16); }
DI float bfhi(unsigned u) { return __uint_as_float(u & 0xffff0000u); }
DI void unpack8(const u32x4 r, float (&f)[8]) { f[0] = bflo(r[0]); f[1] = bfhi(r[0]); f[2] = bflo(r[1]); f[3] = bfhi(r[1]); f[4] = bflo(r[2]); f[5] = bfhi(r[2]); f[6] = bflo(r[3]); f[7] = bfhi(r[3]); }
DI u32x4 pack8(const float (&f)[8]) { u32x4 r; r[0] = pack2(f[0], f[1]); r[1] = pack2(f[2], f[3]); r[2] = pack2(f[4], f[5]); r[3] = pack2(f[6], f[7]); return r; }
DI float sigmoidf_(float x) { return 1.f / (1.f + __expf(-x)); }
DI float wave_sum(float v) { for (int o = 32; o > 0; o >>= 1) v += __shfl_xor(v, o); return v; }
DI void tokinfo(int m, int& t, int& T, int& mi) { if (m < MC) { t = m & 255; T = 256; mi = 0; } else { int q = m - MC; t = q & 1023; T = 1024; mi = 1 + (q >> 10); } }

#define XB_TMO      128
#define XB_XCNT(j)  (256  + 64 * (j))
#define XB_XSUB(j)  (1280 + 64 * (j))
#define XB_XGEN(j)  (2304 + 64 * (j))
#define XB_TOP      3328
#define XB_TOPGEN   3392
#define XB_SPIN_CAP (1u << 20)
#define LAS __attribute__((address_space(3)))
DI unsigned xb_ld(unsigned* p) { return __hip_atomic_load(p, __ATOMIC_RELAXED, __HIP_MEMORY_SCOPE_AGENT); }
DI unsigned xb_add(unsigned* p, unsigned v) { return __hip_atomic_fetch_add(p, v, __ATOMIC_RELAXED, __HIP_MEMORY_SCOPE_AGENT); }
DI unsigned xb_xcc_id() { return (unsigned)__builtin_amdgcn_s_getreg((3 << 11) | 20) & 0xFu; }
#define XB_SPIN(cond, bar) do { unsigned _sp = 0; while (cond) { __builtin_amdgcn_s_sleep(1); \
    if ((++_sp & 255u) == 0u) { if (xb_ld(&(bar)[XB_TMO])) break; if (_sp > XB_SPIN_CAP) { atomicAdd(&(bar)[XB_TMO], 1u); break; } } } } while (0)
struct XcdBarrier { unsigned* bar; unsigned x; volatile LAS unsigned* st; };
DI XcdBarrier xcd_barrier_post(unsigned* bar, volatile LAS unsigned* st) {
  XcdBarrier b; b.bar = bar; b.x = xb_xcc_id(); b.st = st;
  if (tidx() == 0) (void)xb_add(&bar[XB_XCNT(b.x)], 1u);
  return b;
}
DI void xcd_barrier_complete(unsigned* bar, unsigned x, unsigned& nloc, unsigned& nx) {
  const unsigned G = gridDim.x * gridDim.y * gridDim.z;
  unsigned sum, cnt, mine, sp = 0u;
  for (;;) {
    sum = 0u; cnt = 0u; mine = 0u;
#pragma unroll
    for (unsigned j = 0; j < 16; ++j) { const unsigned c = xb_ld(&bar[XB_XCNT(j)]); sum += c; cnt += (c > 0u) ? 1u : 0u; mine = (j == x) ? c : mine; }
    if (sum == G) break;
    __builtin_amdgcn_s_sleep(1);
    if ((++sp & 255u) == 0u) { if (xb_ld(&bar[XB_TMO])) break; if (sp > XB_SPIN_CAP) { atomicAdd(&bar[XB_TMO], 1u); break; } }
  }
  nloc = mine > 0u ? mine : 1u; nx = cnt > 0u ? cnt : 1u;
}
DI void xcd_barrier(const XcdBarrier& b) {
  asm volatile("s_waitcnt vmcnt(0)" ::: "memory");
  __syncthreads();
  if (tidx() == 0) {
    unsigned* bar = b.bar;
    __builtin_amdgcn_s_waitcnt(0);
    unsigned nloc = b.st[0], nx = b.st[1];
    if (nloc == 0u) { xcd_barrier_complete(bar, b.x, nloc, nx); b.st[0] = nloc; b.st[1] = nx; }
    const unsigned old = xb_add(&bar[XB_XSUB(b.x)], 1u);
    const unsigned gen = old / nloc;
    if (old + 1u == (gen + 1u) * nloc) {
      __builtin_amdgcn_fence(__ATOMIC_RELEASE, "agent");
      asm volatile("s_waitcnt vmcnt(0)" ::: "memory");
      const unsigned og = xb_add(&bar[XB_TOP], 1u);
      const unsigned tg = og / nx;
      if (og + 1u == (tg + 1u) * nx) xb_add(&bar[XB_TOPGEN], 1u);
      else XB_SPIN(xb_ld(&bar[XB_TOPGEN]) == tg, bar);
      __builtin_amdgcn_fence(__ATOMIC_ACQUIRE, "agent");
      xb_add(&bar[XB_XGEN(b.x)], 1u);
      asm volatile("s_waitcnt vmcnt(0)" ::: "memory");
    } else {
      XB_SPIN(xb_ld(&bar[XB_XGEN(b.x)]) == gen, bar);
      __builtin_amdgcn_fence(__ATOMIC_ACQUIRE, "agent");
      asm volatile("s_waitcnt vmcnt(0)" ::: "memory");
    }
  }
  __syncthreads();
}

__device__ void convert_T(const float* __restrict__ W, int K, int N, bf16_t* __restrict__ Wt, int ldt, char* smem) {
  float* t = (float*)smem;
  const int tid = tidx(), ntn = N >> 6, nitems = (K >> 6) * ntn;
  for (int it = blockIdx.x; it < nitems; it += gridDim.x) {
    const int k0 = (it / ntn) << 6, n0 = (it % ntn) << 6;
    __syncthreads();
#pragma unroll
    for (int i = 0; i < 4; ++i) { const int k = (tid >> 4) + 16 * i, c4 = (tid & 15) * 4;
      const float4 v = *(const float4*)(W + (size_t)(k0 + k) * N + n0 + c4);
      t[k * 65 + c4] = v.x; t[k * 65 + c4 + 1] = v.y; t[k * 65 + c4 + 2] = v.z; t[k * 65 + c4 + 3] = v.w; }
    __syncthreads();
#pragma unroll
    for (int i = 0; i < 2; ++i) { const int c = tid + 256 * i, n = c >> 3, kc = c & 7; float f[8];
#pragma unroll
      for (int e = 0; e < 8; ++e) f[e] = t[(kc * 8 + e) * 65 + n];
      *(u32x4*)(Wt + (size_t)(n0 + n) * ldt + k0 + kc * 8) = pack8(f); }
  }
}

__device__ void ada_phase(const P& p, char* smem) {
  float* sc = (float*)smem;
  float* red = sc + 640;
  float* mod = (float*)(p.ws + WS_MOD);
  const int tid = tidx(), kq = tid >> 5, cq = tid & 31;
  for (int it = blockIdx.x; it < 2 * 48 * 8; it += gridDim.x) {
    const int l = it / 384, rem = it % 384, nb = rem >> 3, ks = rem & 7;
    const int n0 = nb * 128, k0 = ks * 128;
    __syncthreads();
    for (int e = tid; e < 640; e += NT) { const int i = e >> 7, k = e & 127; const float v = (i == 0) ? p.c_ctx[k0 + k] : p.c[(i - 1) * D + k0 + k]; sc[e] = v * sigmoidf_(v); }
    __syncthreads();
    float acc[5][4];
#pragma unroll
    for (int i = 0; i < 5; ++i)
#pragma unroll
      for (int j = 0; j < 4; ++j) acc[i][j] = 0.f;
    const float* wp = p.ada_w + ((size_t)l * D + k0 + kq * 16) * 6144 + n0 + cq * 4;
#pragma unroll 4
    for (int kk = 0; kk < 16; ++kk) { const float4 w = *(const float4*)(wp + (size_t)kk * 6144);
#pragma unroll
      for (int i = 0; i < 5; ++i) { const float s = sc[i * 128 + kq * 16 + kk]; acc[i][0] += s * w.x; acc[i][1] += s * w.y; acc[i][2] += s * w.z; acc[i][3] += s * w.w; } }
#pragma unroll
    for (int i = 0; i < 5; ++i)
#pragma unroll
      for (int j = 0; j < 4; ++j) red[(kq * 5 + i) * 128 + cq * 4 + j] = acc[i][j];
    __syncthreads();
    for (int e = tid; e < 640; e += NT) { const int i = e >> 7, n = e & 127; float s = 0.f;
#pragma unroll
      for (int q = 0; q < 8; ++q) s += red[(q * 5 + i) * 128 + n];
      if (ks == 0) s += p.ada_b[l * 6144 + n0 + n];
      atomicAdd(mod + ((size_t)l * 5 + i) * 6144 + n0 + n, s); }
  }
}

__device__ void norm_phase(const P& p, const float* xin  , const float* u, const float* gpost, const float* modU, int gate_idx,
                           float* xout, const float* gpre, const float* modN, int shift_idx, bf16_t* hout) {
  const int lane = tidx() & 63, wave = tidx() >> 6, nw = NT / 64;
  for (int m = blockIdx.x * nw + wave; m < MT; m += gridDim.x * nw) {
    int t, T, mi; tokinfo(m, t, T, mi);
    const float* xr = xin ? xin + (size_t)m * D : (m < MC ? p.x_prompt + (size_t)m * D : p.x_sample + (size_t)(m - MC) * D);
    float4 x[4];
#pragma unroll
    for (int i = 0; i < 4; ++i) x[i] = *(const float4*)(xr + i * 256 + lane * 4);
    if (u) {
      float4 uu[4]; float ss = 0.f;
#pragma unroll
      for (int i = 0; i < 4; ++i) { uu[i] = *(const float4*)(u + (size_t)m * D + i * 256 + lane * 4); ss += uu[i].x * uu[i].x + uu[i].y * uu[i].y + uu[i].z * uu[i].z + uu[i].w * uu[i].w; }
      ss = wave_sum(ss); const float rs = rsqrtf(ss * (1.f / D) + 1e-6f);
#pragma unroll
      for (int i = 0; i < 4; ++i) { const int c = i * 256 + lane * 4; const float4 g = *(const float4*)(gpost + c); const float4 ga = *(const float4*)(modU + ((size_t)mi * 6 + gate_idx) * D + c);
        x[i].x += ga.x * uu[i].x * rs * g.x; x[i].y += ga.y * uu[i].y * rs * g.y; x[i].z += ga.z * uu[i].z * rs * g.z; x[i].w += ga.w * uu[i].w * rs * g.w; }
    }
    if (xout) {
#pragma unroll
      for (int i = 0; i < 4; ++i) *(float4*)(xout + (size_t)m * D + i * 256 + lane * 4) = x[i];
    }
    if (hout) {
      float ss = 0.f;
#pragma unroll
      for (int i = 0; i < 4; ++i) ss += x[i].x * x[i].x + x[i].y * x[i].y + x[i].z * x[i].z + x[i].w * x[i].w;
      ss = wave_sum(ss); const float rs = rsqrtf(ss * (1.f / D) + 1e-6f);
#pragma unroll
      for (int i = 0; i < 4; ++i) { const int c = i * 256 + lane * 4; const float4 g = *(const float4*)(gpre + c);
        const float4 sh = *(const float4*)(modN + ((size_t)mi * 6 + shift_idx) * D + c); const float4 sc = *(const float4*)(modN + ((size_t)mi * 6 + shift_idx + 1) * D + c);
        u32x2 o; o.x = pack2(x[i].x * rs * g.x * (1.f + sc.x) + sh.x, x[i].y * rs * g.y * (1.f + sc.y) + sh.y); o.y = pack2(x[i].z * rs * g.z * (1.f + sc.z) + sh.z, x[i].w * rs * g.w * (1.f + sc.w) + sh.w);
        *(u32x2*)(hout + (size_t)m * LDH + c) = o; }
    }
  }
}

struct TileSrc { const bf16_t* A; int lda; int arow0; const bf16_t* B; int ldb; int brow0, brow1; int K; };

template <int NN> DI void zero_acc(f32x4 (&acc)[4][NN]) {
#pragma unroll
  for (int m = 0; m < 4; ++m)
#pragma unroll
    for (int n = 0; n < NN; ++n) acc[m][n] = (f32x4){0.f, 0.f, 0.f, 0.f};
}

template <int NN> DI void gemm_tile(f32x4 (&acc)[4][NN], const TileSrc& s, char* smem) {
  bf16_t* sbase = (bf16_t*)smem;
  const int tid = tidx(), lane = tid & 63, wave = tid >> 6, wr = wave >> 1, wc = wave & 1, fr = lane & 15, fq = lane >> 4;
  const bf16_t* ga[4]; const bf16_t* gb[NN];
#pragma unroll
  for (int i = 0; i < 4; ++i) { const int c = tid + 256 * i, row = c >> 3, kc = c & 7;
    int ar = s.arow0 + row; ar = ar < 0 ? 0 : (ar > MT - 1 ? MT - 1 : ar);
    ga[i] = s.A + (size_t)ar * s.lda + kc * 8; }
#pragma unroll
  for (int i = 0; i < NN; ++i) { const int c = tid + 256 * i, row = c >> 3, kc = c & 7;
    const int br = row < 64 ? s.brow0 + row : s.brow1 + row - 64;
    gb[i] = s.B + (size_t)br * s.ldb + kc * 8; }
  const int wofs = (tid >> 3) * LDT + (tid & 7) * 8;
  const int nk = s.K >> 6;
  u32x4 ra0[4], rb0[NN], ra1[4], rb1[NN];
#define GT_LOAD(RA, RB, KT) do { const int kn_ = ((KT) < nk ? (KT) : nk - 1) * 64; \
    _Pragma("unroll") for (int i = 0; i < 4; ++i) RA[i] = *(const u32x4*)(ga[i] + kn_); \
    _Pragma("unroll") for (int i = 0; i < NN; ++i) RB[i] = *(const u32x4*)(gb[i] + kn_); } while (0)
#define GT_STORE(RA, RB, ST) do { bf16_t* sA_ = sbase + (ST) * (256 * LDT); bf16_t* sB_ = sA_ + 128 * LDT; \
    _Pragma("unroll") for (int i = 0; i < 4; ++i) *(u32x4*)(sA_ + wofs + i * 32 * LDT) = RA[i]; \
    _Pragma("unroll") for (int i = 0; i < NN; ++i) *(u32x4*)(sB_ + wofs + i * 32 * LDT) = RB[i]; } while (0)
#define GT_COMPUTE(ST) do { const bf16_t* sA_ = sbase + (ST) * (256 * LDT); const bf16_t* sB_ = sA_ + 128 * LDT; \
    _Pragma("unroll") for (int ks = 0; ks < 2; ++ks) { bf16x8 bfr[NN]; \
      _Pragma("unroll") for (int n = 0; n < NN; ++n) bfr[n] = *(const bf16x8*)(sB_ + (wc * 16 * NN + n * 16 + fr) * LDT + ks * 32 + fq * 8); \
      _Pragma("unroll") for (int m = 0; m < 4; ++m) { const bf16x8 af = *(const bf16x8*)(sA_ + (wr * 64 + m * 16 + fr) * LDT + ks * 32 + fq * 8); \
        _Pragma("unroll") for (int n = 0; n < NN; ++n) acc[m][n] = MFMA16(bfr[n], af, acc[m][n]); } } } while (0)
  GT_LOAD(ra0, rb0, 0); GT_LOAD(ra1, rb1, 1);
  __syncthreads();
  GT_STORE(ra0, rb0, 0);
  GT_LOAD(ra0, rb0, 2);
  __syncthreads();
#pragma unroll 1
  for (int kt = 0; kt < nk; kt += 2) {
    GT_STORE(ra1, rb1, 1); GT_LOAD(ra1, rb1, kt + 3); GT_COMPUTE(0); __syncthreads();
    GT_STORE(ra0, rb0, 0); GT_LOAD(ra0, rb0, kt + 4); GT_COMPUTE(1); __syncthreads();
  }
#undef GT_LOAD
#undef GT_STORE
#undef GT_COMPUTE
}

DI void stage_acc(const f32x4 (&acc)[4][4], float* sC) {
  const int lane = tidx() & 63, wave = tidx() >> 6, wr = wave >> 1, wc = wave & 1, fr = lane & 15, fq = lane >> 4;
  __syncthreads();
#pragma unroll
  for (int m = 0; m < 4; ++m)
#pragma unroll
    for (int n = 0; n < 4; ++n) *(f32x4*)(sC + (wr * 64 + m * 16 + fr) * 132 + wc * 64 + n * 16 + fq * 4) = acc[m][n];
  __syncthreads();
}

DI float gelu_tanh(float x) { const float u = 0.7978845608f * (x + 0.044715f * x * x * x); const float e = __expf(2.f * u); const float th = 1.f - 2.f / (e + 1.f); return 0.5f * x * (1.f + th); }

struct TileIter {
  int m_lo, rows, NTn, G, efull, count, e, stride;
  DI void init(int MTn, int NTn_) { const int x = blockIdx.x & 7; m_lo = (x * MTn) >> 3; rows = (((x + 1) * MTn) >> 3) - m_lo; NTn = NTn_; G = (rows + 1) >> 1;
    efull = (rows / G) * G * NTn; count = rows * NTn; e = blockIdx.x >> 3; stride = gridDim.x >> 3; }
  DI bool next(int& mt, int& nt) { if (e >= count) return false;
    if (e < efull) { const int grp = e / (G * NTn), rem = e - grp * G * NTn; nt = rem / G; mt = m_lo + grp * G + (rem - nt * G); }
    else { const int rem = e - efull, gsz = rows - (rows / G) * G; nt = rem / gsz; mt = m_lo + (rows / G) * G + (rem - nt * gsz); }
    e += stride; return true; }
};

__device__ void phase_win(const P& p, int l, char* smem) {
  const bf16_t* H = (const bf16_t*)(p.ws + WS_H); const bf16_t* Wt = (const bf16_t*)(p.ws + WS_WIN);
  bf16_t* zr = (bf16_t*)(p.ws + WS_ZR); bf16_t* zn = (bf16_t*)(p.ws + WS_ZN); bf16_t* zt = (bf16_t*)(p.ws + WS_ZT);
  const int tid = tidx(), lane = tid & 63, wave = tid >> 6, wr = wave >> 1, wc = wave & 1, fr = lane & 15, fq = lane >> 4;
  TileIter ti; int mt, nt;
  ti.init(98, 14);
  while (ti.next(mt, nt)) {
    f32x4 acc[4][4]; zero_acc<4>(acc);
    {
      const int n0 = nt * 128, arow0 = mt * 126 - 1;
      TileSrc s{H, LDH, arow0, Wt, LDH, n0, n0 + 64, D};
      gemm_tile<4>(acc, s, smem);
      float* sC = (float*)smem; stage_acc(acc, sC);
      const float* cw = p.rwkv_conv + (size_t)l * 3 * NZR;
      for (int e = tid; e < 126 * 32; e += NT) {
        const int tr = 1 + (e >> 5), c4 = (e & 31) * 4, g = arow0 + tr;
        if (g < MT) { int t, T, mi; tokinfo(g, t, T, mi);
          const float pm = t > 0 ? 1.f : 0.f, nm = t < T - 1 ? 1.f : 0.f;
          const f32x4 a = *(const f32x4*)(sC + (tr - 1) * 132 + c4), b = *(const f32x4*)(sC + tr * 132 + c4), c = *(const f32x4*)(sC + (tr + 1) * 132 + c4);
          const float4 w0 = *(const float4*)(cw + n0 + c4), w1 = *(const float4*)(cw + NZR + n0 + c4), w2 = *(const float4*)(cw + 2 * NZR + n0 + c4);
          u32x2 o; o.x = pack2(pm * a[0] * w0.x + b[0] * w1.x + nm * c[0] * w2.x, pm * a[1] * w0.y + b[1] * w1.y + nm * c[1] * w2.y);
          o.y = pack2(pm * a[2] * w0.z + b[2] * w1.z + nm * c[2] * w2.z, pm * a[3] * w0.w + b[3] * w1.w + nm * c[3] * w2.w);
          *(u32x2*)(zr + (size_t)g * NZR + n0 + c4) = o; }
      }
    }
  }
  ti.init(96, 28);
  while (ti.next(mt, nt)) {
    f32x4 acc[4][4]; zero_acc<4>(acc);
    {
      const int n0 = nt * 128, row0 = mt * 128;
      TileSrc s{H, LDH, row0, Wt, LDH, NZR + n0, NZR + n0 + 64, D};
      gemm_tile<4>(acc, s, smem);
#pragma unroll
      for (int m = 0; m < 4; ++m) { const int row = row0 + wr * 64 + m * 16 + fr;
#pragma unroll
        for (int n = 0; n < 4; ++n) { const int col = n0 + wc * 64 + n * 16 + fq * 4; const f32x4 v = acc[m][n];
          u32x2 o; o.x = pack2(v[0], v[1]); o.y = pack2(v[2], v[3]);
          if (col < NZN) {
            *(u32x2*)(zn + (size_t)row * NZN + col) = o;
            if (row < MC && col >= 512) { const int part = col - 512, isv = part >> 9, pp = part & 511, hh = pp >> 6, d = pp & 63, b = row >> 8, t = row & 255;
              float* dst = p.out + (isv ? O_V : O_K) + ((((size_t)b * 2 + l) * 8 + hh) * 256 + t) * 64 + d; *(f32x4*)dst = v; }
          } else { *(u32x2*)(zt + (size_t)row * LZT + (col - NZN)) = o; }
        } }
    }
  }
}

__device__ void phase_merge(const P& p, char* smem) {
  const bf16_t* H = (const bf16_t*)(p.ws + WS_H); const bf16_t* Wt = (const bf16_t*)(p.ws + WS_WIN); const bf16_t* Wo3 = (const bf16_t*)(p.ws + WS_WO3);
  bf16_t* mg = (bf16_t*)(p.ws + WS_MERGED);
  const int tid = tidx(), lane = tid & 63, wave = tid >> 6, wr = wave >> 1, wc = wave & 1, fr = lane & 15, fq = lane >> 4;
  TileIter ti; int mt, nt; ti.init(96, 16);
  while (ti.next(mt, nt)) {
    const int n0 = nt * 64, row0 = mt * 128;
    f32x4 macc[4][2]; zero_acc<2>(macc);
#pragma unroll 1
    for (int i = 0; i < 3; ++i) {
      const bf16_t* O = (const bf16_t*)(p.ws + (i == 0 ? WS_OA : (i == 1 ? WS_ONA : WS_ORET)));
      f32x4 g[4][2]; zero_acc<2>(g);
      { TileSrc s{H, LDH, row0, Wt, LDH, 5376 + i * 1024 + n0, 0, D}; gemm_tile<2>(g, s, smem); }
      f32x4 a2[4][2]; zero_acc<2>(a2);
      { TileSrc s{O, LDO, row0, Wo3 + (size_t)i * 1024 * LDO, LDO, n0, 0, 512}; gemm_tile<2>(a2, s, smem); }
#pragma unroll
      for (int m = 0; m < 4; ++m)
#pragma unroll
        for (int n = 0; n < 2; ++n)
#pragma unroll
          for (int j = 0; j < 4; ++j) macc[m][n][j] += sigmoidf_(g[m][n][j]) * a2[m][n][j];
    }
#pragma unroll
    for (int m = 0; m < 4; ++m) { const int row = row0 + wr * 64 + m * 16 + fr;
#pragma unroll
      for (int n = 0; n < 2; ++n) { const int col = n0 + wc * 32 + n * 16 + fq * 4; u32x2 o; o.x = pack2(macc[m][n][0], macc[m][n][1]); o.y = pack2(macc[m][n][2], macc[m][n][3]); *(u32x2*)(mg + (size_t)row * LDH + col) = o; } }
  }
}

__device__ void phase_gemm_f32(const bf16_t* A, int lda, int K, const bf16_t* Bt, int ldb, float* C, char* smem) {
  const int tid = tidx(), lane = tid & 63, wave = tid >> 6, wr = wave >> 1, wc = wave & 1, fr = lane & 15, fq = lane >> 4;
  TileIter ti; int mt, nt; ti.init(96, 8);
  while (ti.next(mt, nt)) {
    const int n0 = nt * 128, row0 = mt * 128;
    f32x4 acc[4][4]; zero_acc<4>(acc);
    TileSrc s{A, lda, row0, Bt, ldb, n0, n0 + 64, K}; gemm_tile<4>(acc, s, smem);
#pragma unroll
    for (int m = 0; m < 4; ++m) { const int row = row0 + wr * 64 + m * 16 + fr;
#pragma unroll
      for (int n = 0; n < 4; ++n) *(f32x4*)(C + (size_t)row * D + n0 + wc * 64 + n * 16 + fq * 4) = acc[m][n]; }
  }
}

__device__ void phase_ffn_up(const P& p, int l, char* smem) {
  const bf16_t* H = (const bf16_t*)(p.ws + WS_H); const bf16_t* Wt = (const bf16_t*)(p.ws + WS_WUP); bf16_t* hid = (bf16_t*)(p.ws + WS_HID);
  const int tid = tidx();
  const float* cw = p.ffn_conv + (size_t)l * 3 * 2 * FF;
  TileIter ti; int mt, nt; ti.init(98, 44);
  while (ti.next(mt, nt)) {
    const int c0 = nt * 64, arow0 = mt * 126 - 1;
    f32x4 acc[4][4]; zero_acc<4>(acc);
    TileSrc s{H, LDH, arow0, Wt, LDH, c0, FF + c0, D};
    gemm_tile<4>(acc, s, smem);
    float* sC = (float*)smem; stage_acc(acc, sC);
    for (int e = tid; e < 126 * 16; e += NT) {
      const int tr = 1 + (e >> 4), c4 = (e & 15) * 4, g = arow0 + tr;
      if (g < MT) { int t, T, mi; tokinfo(g, t, T, mi);
        const float pm = t > 0 ? 1.f : 0.f, nm = t < T - 1 ? 1.f : 0.f;
        const f32x4 va = *(const f32x4*)(sC + (tr - 1) * 132 + c4), vb = *(const f32x4*)(sC + tr * 132 + c4), vc = *(const f32x4*)(sC + (tr + 1) * 132 + c4);
        const f32x4 ga = *(const f32x4*)(sC + (tr - 1) * 132 + 64 + c4), gb = *(const f32x4*)(sC + tr * 132 + 64 + c4), gc = *(const f32x4*)(sC + (tr + 1) * 132 + 64 + c4);
        const f32x4 v0 = *(const f32x4*)(cw + c0 + c4), v1 = *(const f32x4*)(cw + 2 * FF + c0 + c4), v2 = *(const f32x4*)(cw + 4 * FF + c0 + c4);
        const f32x4 g0 = *(const f32x4*)(cw + FF + c0 + c4), g1 = *(const f32x4*)(cw + 3 * FF + c0 + c4), g2 = *(const f32x4*)(cw + 5 * FF + c0 + c4);
        float r[4];
#pragma unroll
        for (int j = 0; j < 4; ++j) { const float val = pm * va[j] * v0[j] + vb[j] * v1[j] + nm * vc[j] * v2[j]; const float gt = pm * ga[j] * g0[j] + gb[j] * g1[j] + nm * gc[j] * g2[j]; r[j] = gelu_tanh(gt) * val; }
        u32x2 o; o.x = pack2(r[0], r[1]); o.y = pack2(r[2], r[3]);
        *(u32x2*)(hid + (size_t)g * FF + c0 + c4) = o; }
    }
  }
}

template <int CTRL> DI float dppf(float v) { return __int_as_float(__builtin_amdgcn_mov_dpp(__float_as_int(v), CTRL, 0xF, 0xF, true)); }
DI float row16_sum(float v) { v += dppf<0xB1>(v); v += dppf<0x4E>(v); v += dppf<0x141>(v); v += dppf<0x140>(v); return v; }

__device__ void scan_task(const P& p, int l, int seq, int h, int d, char* smem) {
  float* sR = (float*)smem; float* sW = sR + 1024; float* sKD = sW + 1024; float* sB = sKD + 1024; float* sNK = sB + 1024; float* sV = sNK + 1024; float* sK = sV + 1024; float* sY = sK + 1024;
  float* sKn = sY + 1024; float* sKK = sKn + 16; bf16_t* sWT = (bf16_t*)(sKK + 64); bf16_t* sAL = sWT + 16 * LDT;
  const int tid = tidx(), lane = tid & 63, wave = tid >> 6, fr = lane & 15, fq = lane >> 4;
  const int row0 = seq < 32 ? seq * 256 : MC + (seq - 32) * 1024, T = seq < 32 ? 256 : 1024, nch = T >> 4;
  const bf16_t* zr = (const bf16_t*)(p.ws + WS_ZR);
  float* yout = (float*)(p.ws + WS_Y) + (size_t)d * MT * 512;
  __syncthreads();
  if (tid < 64) sKK[tid] = p.rwkv_k_k[l * 512 + h * 64 + tid];
  const int cc = wave * 16 + fr, gc = h * 64 + cc;
  bf16x8 bw[2], ba[2];
#pragma unroll
  for (int ks = 0; ks < 2; ++ks)
#pragma unroll
    for (int e = 0; e < 8; ++e) { const int k = ks * 32 + fq * 8 + e;
      bw[ks][e] = (short)f2bf(p.rwkv_w_up[((size_t)(l * 2 + d) * 64 + k) * 512 + gc]); ba[ks][e] = (short)f2bf(p.rwkv_a_up[((size_t)(l * 2 + d) * 64 + k) * 512 + gc]); }
  const float w0c = p.rwkv_w0[(l * 2 + d) * 512 + gc], a0c = p.rwkv_a0[(l * 2 + d) * 512 + gc], kac = p.rwkv_k_a[l * 512 + gc];
  const int rg = tid >> 4, kq = tid & 15;
  f32x2 S[4][2];
  if (seq >= 32) { const float* s0 = p.state_rwkv + (((((size_t)(seq - 32) * 2 + l) * 2 + d) * 8 + h) * 64 + rg * 4) * 64 + kq * 4;
#pragma unroll
    for (int r = 0; r < 4; ++r) { const f32x4 x = *(const f32x4*)(s0 + r * 64); S[r][0] = (f32x2){x[0], x[1]}; S[r][1] = (f32x2){x[2], x[3]}; } }
  else {
#pragma unroll
    for (int r = 0; r < 4; ++r) { S[r][0] = (f32x2){0.f, 0.f}; S[r][1] = (f32x2){0.f, 0.f}; } }
  if (seq >= 32) __builtin_amdgcn_s_setprio(2);
  const int segbase[5] = {h * 64, 512 + h * 64, 1024 + h * 64, 1536, 1600};
  int ct[3], cseg[3], cpart[3]; bool cval[3]; size_t coff[3];
#pragma unroll
  for (int i = 0; i < 3; ++i) { const int c = tid + 256 * i; cval[i] = c < 640; const int cx = cval[i] ? c : 0; ct[i] = cx / 40; const int rem = cx % 40; cseg[i] = rem >> 3; cpart[i] = rem & 7;
    const int sb = cseg[i] == 0 ? segbase[0] : (cseg[i] == 1 ? segbase[1] : (cseg[i] == 2 ? segbase[2] : (cseg[i] == 3 ? segbase[3] : segbase[4])));
    coff[i] = (size_t)ct[i] * NZR + sb + cpart[i] * 8; }
  u32x4 pre[3];
  { const int t0 = (d ? nch - 1 : 0) * 16;
#pragma unroll
    for (int i = 0; i < 3; ++i) pre[i] = *(const u32x4*)(zr + (size_t)(row0 + t0) * NZR + coff[i]); }
  __syncthreads();
  for (int ci = 0; ci < nch; ++ci) {
    const int chunk = d ? nch - 1 - ci : ci, t0 = chunk * 16;
#pragma unroll
    for (int i = 0; i < 3; ++i) {
      float f[8]; unpack8(pre[i], f); float ps = 0.f;
      if (cval[i]) {
        const int t = ct[i], o = t * 64 + cpart[i] * 8;
        if (cseg[i] == 0) { *(float4*)(sR + o) = make_float4(f[0], f[1], f[2], f[3]); *(float4*)(sR + o + 4) = make_float4(f[4], f[5], f[6], f[7]); }
        else if (cseg[i] == 1) { *(float4*)(sK + o) = make_float4(f[0], f[1], f[2], f[3]); *(float4*)(sK + o + 4) = make_float4(f[4], f[5], f[6], f[7]);
#pragma unroll
          for (int e = 0; e < 8; ++e) { const float kk = f[e] * sKK[cpart[i] * 8 + e]; ps += kk * kk; } }
        else if (cseg[i] == 2) { *(float4*)(sV + o) = make_float4(f[0], f[1], f[2], f[3]); *(float4*)(sV + o + 4) = make_float4(f[4], f[5], f[6], f[7]); }
        else if (cseg[i] == 3) { float g[8];
#pragma unroll
          for (int e = 0; e < 8; ++e) g[e] = 1.f - 2.f / (__expf(2.f * f[e]) + 1.f);
          *(u32x4*)(sWT + t * LDT + cpart[i] * 8) = pack8(g); }
        else { *(u32x4*)(sAL + t * LDT + cpart[i] * 8) = pre[i]; }
      }
      ps += __shfl_xor(ps, 1); ps += __shfl_xor(ps, 2); ps += __shfl_xor(ps, 4);
      if (cval[i] && cseg[i] == 1 && cpart[i] == 0) sKn[ct[i]] = ps;
    }
    __syncthreads();
    {
      f32x4 aw = {0.f, 0.f, 0.f, 0.f}, aa = {0.f, 0.f, 0.f, 0.f};
#pragma unroll
      for (int ks = 0; ks < 2; ++ks) { const bf16x8 fw = *(const bf16x8*)(sWT + fr * LDT + ks * 32 + fq * 8); const bf16x8 fa = *(const bf16x8*)(sAL + fr * LDT + ks * 32 + fq * 8);
        aw = MFMA16(fw, bw[ks], aw); aa = MFMA16(fa, ba[ks], aa); }
#pragma unroll
      for (int j = 0; j < 4; ++j) { const int t = fq * 4 + j, o = t * 64 + cc;
        const float dec = __expf(-0.6065306597f * sigmoidf_(w0c + aw[j]));
        const float a = sigmoidf_(a0c + aa[j]);
        const float kv = sK[o];
        const float kkv = kv * sKK[cc] / fmaxf(sqrtf(sKn[t]), 1e-12f);
        sW[o] = dec; sKD[o] = kv * (1.f + (a - 1.f) * kac); sB[o] = kkv * a; sNK[o] = -kkv; }
    }
    __syncthreads();
    { const int cn = ci + 1 < nch ? ci + 1 : ci; const int nt0 = (d ? nch - 1 - cn : cn) * 16;
#pragma unroll
      for (int i = 0; i < 3; ++i) pre[i] = *(const u32x4*)(zr + (size_t)(row0 + nt0) * NZR + coff[i]); }
#pragma unroll 2
    for (int si = 0; si < 16; ++si) {
      const int t = d ? 15 - si : si, o = t * 64 + kq * 4;
      const f32x4 an4 = *(const f32x4*)(sNK + o), w4 = *(const f32x4*)(sW + o), b4 = *(const f32x4*)(sB + o), kd4 = *(const f32x4*)(sKD + o), r4 = *(const f32x4*)(sR + o);
      const f32x4 v4 = *(const f32x4*)(sV + t * 64 + rg * 4);
      const f32x2 an[2] = {{an4[0], an4[1]}, {an4[2], an4[3]}}, wv[2] = {{w4[0], w4[1]}, {w4[2], w4[3]}}, bv[2] = {{b4[0], b4[1]}, {b4[2], b4[3]}}, kd[2] = {{kd4[0], kd4[1]}, {kd4[2], kd4[3]}}, rv[2] = {{r4[0], r4[1]}, {r4[2], r4[3]}};
      float sa[4];
#pragma unroll
      for (int r = 0; r < 4; ++r) { const f32x2 t2 = S[r][0] * an[0] + S[r][1] * an[1]; sa[r] = row16_sum(t2.x + t2.y); }
      f32x4 yv;
#pragma unroll
      for (int r = 0; r < 4; ++r) { const f32x2 sav = {sa[r], sa[r]}, vvv = {v4[r], v4[r]};
        S[r][0] = S[r][0] * wv[0] + (sav * bv[0] + vvv * kd[0]); S[r][1] = S[r][1] * wv[1] + (sav * bv[1] + vvv * kd[1]);
        const f32x2 y2 = S[r][0] * rv[0] + S[r][1] * rv[1]; yv[r] = row16_sum(y2.x + y2.y); }
      if (kq == 0) *(f32x4*)(sY + t * 64 + rg * 4) = yv;
    }
    __syncthreads();
    { const int t = tid >> 4, v4 = (tid & 15) * 4; *(float4*)(yout + (size_t)(row0 + t0 + t) * 512 + h * 64 + v4) = *(const float4*)(sY + t * 64 + v4); }
  }
  __builtin_amdgcn_s_setprio(0);
  if (seq < 32) { float* so = p.out + O_RW + (((((size_t)seq * 2 + l) * 2 + d) * 8 + h) * 64 + rg * 4) * 64 + kq * 4;
#pragma unroll
    for (int r = 0; r < 4; ++r) *(f32x4*)(so + r * 64) = (f32x4){S[r][0].x, S[r][0].y, S[r][1].x, S[r][1].y}; }
}

DI void qk_scores(const bf16_t* sK, const bf16x8 (&qf)[2], f32x4 (&sacc)[4], int fr, int fq) {
#pragma unroll
  for (int nt = 0; nt < 4; ++nt) { sacc[nt] = (f32x4){0.f, 0.f, 0.f, 0.f};
#pragma unroll
    for (int ks = 0; ks < 2; ++ks) { const bf16x8 kf = *(const bf16x8*)(sK + (nt * 16 + fr) * LDT + ks * 32 + fq * 8); sacc[nt] = MFMA16(kf, qf[ks], sacc[nt]); } }
}
DI void pv_accum(const bf16_t* sVt, const f32x4 (&pacc)[4], f32x4 (&o)[4], int fr, int fq) {
#pragma unroll
  for (int s = 0; s < 2; ++s) {
    bf16x8 pf; { const unsigned a = pack2(pacc[2 * s][0], pacc[2 * s][1]), b = pack2(pacc[2 * s][2], pacc[2 * s][3]), c = pack2(pacc[2 * s + 1][0], pacc[2 * s + 1][1]), dd = pack2(pacc[2 * s + 1][2], pacc[2 * s + 1][3]);
      const u32x4 u = (u32x4){a, b, c, dd}; pf = __builtin_bit_cast(bf16x8, u); }
#pragma unroll
    for (int dt = 0; dt < 4; ++dt) { const u32x2 lo = *(const u32x2*)(sVt + (dt * 16 + fr) * LDT + 32 * s + 4 * fq), hi = *(const u32x2*)(sVt + (dt * 16 + fr) * LDT + 32 * s + 16 + 4 * fq);
      const u32x4 u = (u32x4){lo[0], lo[1], hi[0], hi[1]}; const bf16x8 vf = __builtin_bit_cast(bf16x8, u); o[dt] = MFMA16(vf, pf, o[dt]); }
  }
}
DI void put_kv(bf16_t* sK, bf16_t* sVt, int key, int part, const float (&kf)[8], const float (&vf)[8]) {
  *(u32x4*)(sK + key * LDT + part * 8) = pack8(kf);
#pragma unroll
  for (int e = 0; e < 8; ++e) sVt[(part * 8 + e) * LDT + key] = f2bf(vf[e]);
}
DI void softmax_tile(f32x4 (&sacc)[4], f32x4 (&o)[4], float& mrun, float& lrun) {
  float mx = sacc[0][0];
#pragma unroll
  for (int nt = 0; nt < 4; ++nt)
#pragma unroll
    for (int j = 0; j < 4; ++j) mx = fmaxf(mx, sacc[nt][j]);
  mx = fmaxf(mx, __shfl_xor(mx, 16)); mx = fmaxf(mx, __shfl_xor(mx, 32));
  const float mnew = fmaxf(mrun, mx), alpha = exp2f(mrun - mnew); mrun = mnew;
  float ls = 0.f;
#pragma unroll
  for (int nt = 0; nt < 4; ++nt)
#pragma unroll
    for (int j = 0; j < 4; ++j) { const float pv = exp2f(sacc[nt][j] - mnew); sacc[nt][j] = pv; ls += pv; }
  lrun = lrun * alpha + ls;
#pragma unroll
  for (int dt = 0; dt < 4; ++dt) o[dt] *= alpha;
}
constexpr float LOG2E = 1.4426950408889634f;

__device__ void dense_task(const P& p, int b, int h, int qb, char* smem) {
  bf16_t* sK = (bf16_t*)smem; bf16_t* sVt = sK + 64 * LDT;
  const int tid = tidx(), lane = tid & 63, wave = tid >> 6, fr = lane & 15, fq = lane >> 4;
  const bf16_t* zn = (const bf16_t*)(p.ws + WS_ZN); bf16_t* ona = (bf16_t*)(p.ws + WS_ONA);
  const int qrow = b * 256 + qb * 64 + wave * 16 + fr;
  bf16x8 qf[2];
#pragma unroll
  for (int ks = 0; ks < 2; ++ks) qf[ks] = *(const bf16x8*)(zn + (size_t)qrow * NZN + h * 64 + ks * 32 + fq * 8);
  f32x4 o[4]; for (int dt = 0; dt < 4; ++dt) o[dt] = (f32x4){0.f, 0.f, 0.f, 0.f};
  float mrun = -1e30f, lrun = 0.f;
  for (int kt = 0; kt < 4; ++kt) {
    __syncthreads();
#pragma unroll
    for (int i = 0; i < 2; ++i) { const int c = tid + 256 * i, key = c >> 3, part = c & 7; const size_t ro = (size_t)(b * 256 + kt * 64 + key) * NZN + h * 64 + part * 8;
      const u32x4 kr = *(const u32x4*)(zn + ro + 512), vr = *(const u32x4*)(zn + ro + 1024); float vf[8]; unpack8(vr, vf);
      *(u32x4*)(sK + key * LDT + part * 8) = kr;
#pragma unroll
      for (int e = 0; e < 8; ++e) sVt[(part * 8 + e) * LDT + key] = f2bf(vf[e]); }
    __syncthreads();
    f32x4 sacc[4]; qk_scores(sK, qf, sacc, fr, fq);
#pragma unroll
    for (int nt = 0; nt < 4; ++nt) sacc[nt] *= (0.125f * LOG2E);
    softmax_tile(sacc, o, mrun, lrun);
    pv_accum(sVt, sacc, o, fr, fq);
  }
  lrun += __shfl_xor(lrun, 16); lrun += __shfl_xor(lrun, 32); const float inv = 1.f / lrun;
#pragma unroll
  for (int dt = 0; dt < 4; ++dt) { u32x2 ov; ov.x = pack2(o[dt][0] * inv, o[dt][1] * inv); ov.y = pack2(o[dt][2] * inv, o[dt][3] * inv); *(u32x2*)(ona + (size_t)qrow * LDO + h * 64 + dt * 16 + fq * 4) = ov; }
}

__device__ void na_task(const P& p, int l, int b, int h, int r, char* smem) {
  bf16_t* sK = (bf16_t*)smem; bf16_t* sVt = sK + 64 * LDT; float* sRpb = (float*)(sVt + 64 * LDT);
  const int tid = tidx(), lane = tid & 63, wave = tid >> 6, fr = lane & 15, fq = lane >> 4;
  const bf16_t* zn = (const bf16_t*)(p.ws + WS_ZN); bf16_t* ona = (bf16_t*)(p.ws + WS_ONA);
  const int base = MC + b * 1024, qcol = wave * 16 + fr, qrow = base + r * 64 + qcol;
  int rs = r - 4; rs = rs < 0 ? 0 : (rs > 8 ? 8 : rs);
  int cs = qcol - 8; cs = cs < 0 ? 0 : (cs > 48 ? 48 : cs);
  __syncthreads();
  for (int e = tid; e < 465; e += NT) sRpb[e] = p.na_rpb[((size_t)l * 8 + h) * 465 + e] * LOG2E;
  bf16x8 qf[2];
#pragma unroll
  for (int ks = 0; ks < 2; ++ks) qf[ks] = *(const bf16x8*)(zn + (size_t)qrow * NZN + h * 64 + ks * 32 + fq * 8);
  f32x4 o[4]; for (int dt = 0; dt < 4; ++dt) o[dt] = (f32x4){0.f, 0.f, 0.f, 0.f};
  float mrun = -1e30f, lrun = 0.f;
  for (int kt = 0; kt < 12; ++kt) {
    __syncthreads();
    if (kt < 8) {
#pragma unroll
      for (int i = 0; i < 2; ++i) { const int c = tid + 256 * i, key = c >> 3, part = c & 7; const size_t ro = (size_t)(base + (rs + kt) * 64 + key) * NZN + h * 64 + part * 8;
        const u32x4 kr = *(const u32x4*)(zn + ro + 512), vr = *(const u32x4*)(zn + ro + 1024); float vf[8]; unpack8(vr, vf);
        *(u32x4*)(sK + key * LDT + part * 8) = kr;
#pragma unroll
        for (int e = 0; e < 8; ++e) sVt[(part * 8 + e) * LDT + key] = f2bf(vf[e]); }
    } else {
#pragma unroll
      for (int i = 0; i < 2; ++i) { const int c = tid + 256 * i, key = c >> 3, part = c & 7; const size_t co = ((((size_t)b * 2 + l) * 8 + h) * 256 + (kt - 8) * 64 + key) * 64 + part * 8;
        const float4 k0 = *(const float4*)(p.cache_k + co), k1 = *(const float4*)(p.cache_k + co + 4), v0 = *(const float4*)(p.cache_v + co), v1 = *(const float4*)(p.cache_v + co + 4);
        const float kf[8] = {k0.x, k0.y, k0.z, k0.w, k1.x, k1.y, k1.z, k1.w}; const float vf[8] = {v0.x, v0.y, v0.z, v0.w, v1.x, v1.y, v1.z, v1.w};
        put_kv(sK, sVt, key, part, kf, vf); }
    }
    __syncthreads();
    f32x4 sacc[4]; qk_scores(sK, qf, sacc, fr, fq);
    if (kt < 8) { const int dr = rs + kt - r + 7;
#pragma unroll
      for (int nt = 0; nt < 4; ++nt)
#pragma unroll
        for (int j = 0; j < 4; ++j) { const int kc = nt * 16 + fq * 4 + j; const bool valid = kc >= cs && kc < cs + 16; int dc = kc - qcol; dc = dc < -15 ? -15 : (dc > 15 ? 15 : dc);
          sacc[nt][j] = valid ? sacc[nt][j] * (0.125f * LOG2E) + sRpb[dr * 31 + dc + 15] : -1e30f; }
    } else {
#pragma unroll
      for (int nt = 0; nt < 4; ++nt) sacc[nt] *= (0.125f * LOG2E);
    }
    softmax_tile(sacc, o, mrun, lrun);
    pv_accum(sVt, sacc, o, fr, fq);
  }
  lrun += __shfl_xor(lrun, 16); lrun += __shfl_xor(lrun, 32); const float inv = 1.f / lrun;
#pragma unroll
  for (int dt = 0; dt < 4; ++dt) { u32x2 ov; ov.x = pack2(o[dt][0] * inv, o[dt][1] * inv); ov.y = pack2(o[dt][2] * inv, o[dt][3] * inv); *(u32x2*)(ona + (size_t)qrow * LDO + h * 64 + dt * 16 + fq * 4) = ov; }
}

DI void rope8(const float (&own)[8], const float (&par)[8], int part, int n, float (&out)[8]) {
  const float pos = (float)((part >> 2) ? (n & 63) : (n >> 6));
  const bool isx2 = (part & 3) >= 2;
#pragma unroll
  for (int e = 0; e < 8; ++e) { const int i = (part & 1) * 8 + e; const float ang = pos * exp2f(-(float)i * 0.830482023721841f); const float sn = __sinf(ang), cs = __cosf(ang);
    out[e] = isx2 ? par[e] * sn + own[e] * cs : own[e] * cs - par[e] * sn; }
}

__device__ void ret_task(const P& p, int l, int seq, int h, int qb, char* smem) {
  bf16_t* sK = (bf16_t*)smem; bf16_t* sVt = sK + 64 * LDT; bf16_t* sQ = sVt + 64 * LDT;
  const int tid = tidx(), lane = tid & 63, wave = tid >> 6, fr = lane & 15, fq = lane >> 4;
  const bf16_t* zt = (const bf16_t*)(p.ws + WS_ZT); bf16_t* oret = (bf16_t*)(p.ws + WS_ORET);
  const bool lat = seq >= 32;
  const int row0 = lat ? MC + (seq - 32) * 1024 : seq * 256, T = lat ? 1024 : 256, nkt = T >> 6;
  const float xf = p.ret_decay[(l * 2 + 0) * 8 + h], xb = p.ret_decay[(l * 2 + 1) * 8 + h];
  const float lgf = -log1pf(__expf(-xf)) * LOG2E, lgb = -log1pf(__expf(-xb)) * LOG2E;
  __syncthreads();
#pragma unroll
  for (int i = 0; i < 2; ++i) { const int c = tid + 256 * i, qi = c >> 3, part = c & 7; const int n = qb * 64 + qi; const size_t ro = (size_t)(row0 + n) * LZT + h * 64;
    const u32x4 own = *(const u32x4*)(zt + ro + part * 8);
    if (lat) { const u32x4 par = *(const u32x4*)(zt + ro + (part ^ 2) * 8); float fo[8], fp[8], out[8]; unpack8(own, fo); unpack8(par, fp); rope8(fo, fp, part, n, out); *(u32x4*)(sQ + qi * LDT + part * 8) = pack8(out); }
    else *(u32x4*)(sQ + qi * LDT + part * 8) = own; }
  __syncthreads();
  const int qi = wave * 16 + fr, nq = qb * 64 + qi;
  bf16x8 qf[2];
#pragma unroll
  for (int ks = 0; ks < 2; ++ks) qf[ks] = *(const bf16x8*)(sQ + qi * LDT + ks * 32 + fq * 8);
  f32x4 o[4]; for (int dt = 0; dt < 4; ++dt) o[dt] = (f32x4){0.f, 0.f, 0.f, 0.f};
  for (int kt = 0; kt < nkt; ++kt) {
    __syncthreads();
#pragma unroll
    for (int i = 0; i < 2; ++i) { const int c = tid + 256 * i, key = c >> 3, part = c & 7; const int n = kt * 64 + key; const size_t ro = (size_t)(row0 + n) * LZT + h * 64;
      const u32x4 own = *(const u32x4*)(zt + ro + 512 + part * 8), vr = *(const u32x4*)(zt + ro + 1024 + part * 8);
      float kf[8], vf[8]; unpack8(own, kf); unpack8(vr, vf);
      if (lat) { const u32x4 par = *(const u32x4*)(zt + ro + 512 + (part ^ 2) * 8); float fp[8], out[8]; unpack8(par, fp); rope8(kf, fp, part, n, out);
#pragma unroll
        for (int e = 0; e < 8; ++e) kf[e] = out[e]; }
#pragma unroll
      for (int e = 0; e < 8; ++e) kf[e] *= 0.125f;
      put_kv(sK, sVt, key, part, kf, vf); }
    __syncthreads();
    f32x4 sacc[4]; qk_scores(sK, qf, sacc, fr, fq);
#pragma unroll
    for (int nt = 0; nt < 4; ++nt)
#pragma unroll
      for (int j = 0; j < 4; ++j) { const int mk = kt * 64 + nt * 16 + fq * 4 + j; const int df = nq - mk;
        const float dec = df > 0 ? exp2f(lgf * (float)df) : (df < 0 ? exp2f(lgb * (float)(-df)) : 2.f); sacc[nt][j] *= dec; }
    pv_accum(sVt, sacc, o, fr, fq);
  }
  if (lat) {
    for (int dir = 0; dir < 2; ++dir) {
      __syncthreads();
      const float* s0 = p.state_ret + ((((size_t)(seq - 32) * 2 + l) * 2 + dir) * 8 + h) * 4096;
#pragma unroll
      for (int i = 0; i < 2; ++i) { const int c = tid + 256 * i, dk = c >> 3, part = c & 7; const float4 a = *(const float4*)(s0 + dk * 64 + part * 8), bq = *(const float4*)(s0 + dk * 64 + part * 8 + 4);
        const float vf[8] = {a.x, a.y, a.z, a.w, bq.x, bq.y, bq.z, bq.w};
#pragma unroll
        for (int e = 0; e < 8; ++e) sVt[(part * 8 + e) * LDT + dk] = f2bf(vf[e]); }
      __syncthreads();
      const float xi = dir == 0 ? exp2f(lgf * (float)(nq + 1)) : exp2f(lgb * (float)(T - nq));
      f32x4 pacc[4];
#pragma unroll
      for (int s = 0; s < 2; ++s)
#pragma unroll
        for (int hh = 0; hh < 2; ++hh)
#pragma unroll
          for (int j = 0; j < 4; ++j) pacc[2 * s + hh][j] = xi * bf2f(sQ[qi * LDT + 32 * s + 16 * hh + 4 * fq + j]);
      pv_accum(sVt, pacc, o, fr, fq);
    }
  }
  float s1 = 0.f;
#pragma unroll
  for (int dt = 0; dt < 4; ++dt)
#pragma unroll
    for (int j = 0; j < 4; ++j) s1 += o[dt][j];
  s1 += __shfl_xor(s1, 16); s1 += __shfl_xor(s1, 32); const float mu = s1 * (1.f / 64.f);
  float s2 = 0.f;
#pragma unroll
  for (int dt = 0; dt < 4; ++dt)
#pragma unroll
    for (int j = 0; j < 4; ++j) { const float dlt = o[dt][j] - mu; s2 += dlt * dlt; }
  s2 += __shfl_xor(s2, 16); s2 += __shfl_xor(s2, 32); const float rstd = rsqrtf(s2 * (1.f / 64.f) + 1e-5f);
  const size_t qrow = (size_t)(row0 + nq);
#pragma unroll
  for (int dt = 0; dt < 4; ++dt) { const int dv = h * 64 + dt * 16 + fq * 4; const u32x2 gr = *(const u32x2*)(zt + qrow * LZT + 1536 + dv); const float4 gn = *(const float4*)(p.ret_gn + l * 512 + dv);
    const float g0 = bflo(gr.x), g1 = bfhi(gr.x), g2 = bflo(gr.y), g3 = bfhi(gr.y);
    u32x2 ov; ov.x = pack2((o[dt][0] - mu) * rstd * gn.x * g0 * sigmoidf_(g0), (o[dt][1] - mu) * rstd * gn.y * g1 * sigmoidf_(g1));
    ov.y = pack2((o[dt][2] - mu) * rstd * gn.z * g2 * sigmoidf_(g2), (o[dt][3] - mu) * rstd * gn.w * g3 * sigmoidf_(g3));
    *(u32x2*)(oret + qrow * LDO + dv) = ov; }
}

__device__ void retstate_task(const P& p, int l, int b, int h, char* smem) {
  float* sKf = (float*)smem; float* sKb = sKf + 64 * 64; float* sV = sKb + 64 * 64;
  const int tid = tidx(), dk = tid >> 2, dq = tid & 3;
  const bf16_t* zt = (const bf16_t*)(p.ws + WS_ZT);
  const float xf = p.ret_decay[(l * 2 + 0) * 8 + h], xb = p.ret_decay[(l * 2 + 1) * 8 + h];
  const float lgf = -log1pf(__expf(-xf)) * LOG2E, lgb = -log1pf(__expf(-xb)) * LOG2E;
  float af[16], ab[16];
#pragma unroll
  for (int i = 0; i < 16; ++i) { af[i] = 0.f; ab[i] = 0.f; }
  for (int kt = 0; kt < 4; ++kt) {
    __syncthreads();
#pragma unroll
    for (int i = 0; i < 2; ++i) { const int c = tid + 256 * i, key = c >> 3, part = c & 7, m = kt * 64 + key; const size_t ro = (size_t)(b * 256 + m) * LZT + h * 64 + part * 8;
      float kf[8], vf[8]; unpack8(*(const u32x4*)(zt + ro + 512), kf); unpack8(*(const u32x4*)(zt + ro + 1024), vf);
      const float wf = 0.125f * exp2f(lgf * (float)(255 - m)), wb = 0.125f * exp2f(lgb * (float)m);
#pragma unroll
      for (int e = 0; e < 8; ++e) { sKf[key * 64 + part * 8 + e] = kf[e] * wf; sKb[key * 64 + part * 8 + e] = kf[e] * wb; sV[key * 64 + part * 8 + e] = vf[e]; } }
    __syncthreads();
    for (int m = 0; m < 64; ++m) { const float kf = sKf[m * 64 + dk], kb = sKb[m * 64 + dk];
#pragma unroll
      for (int i = 0; i < 4; ++i) { const f32x4 vv = *(const f32x4*)(sV + m * 64 + dq * 16 + i * 4);
#pragma unroll
        for (int j = 0; j < 4; ++j) { af[i * 4 + j] += kf * vv[j]; ab[i * 4 + j] += kb * vv[j]; } } }
  }
  float* of = p.out + O_RT + ((((size_t)b * 2 + l) * 2 + 0) * 8 + h) * 4096 + dk * 64 + dq * 16; float* ob = of + 8 * 4096;
#pragma unroll
  for (int i = 0; i < 16; ++i) { of[i] = af[i]; ob[i] = ab[i]; }
}

constexpr int Q_SCAN_L = 64, Q_SCAN_C = 512, Q_RET_L = 512, Q_NA = 512, Q_DENSE = 1024, Q_RET_C = 1024, Q_RST = 256;
constexpr int Q_TOTAL = Q_SCAN_L + Q_SCAN_C + Q_RET_L + Q_NA + Q_DENSE + Q_RET_C + Q_RST;
__device__ void phase_mixers(const P& p, int l, char* smem, int rep = 0) {
  __shared__ int s_task;
  int* ctr = (int*)(p.ws + WS_CTRL) + 64 * (l + 1) + 4 * rep;
  for (;;) {
    __syncthreads();
    if (tidx() == 0) s_task = atomicAdd(ctr, 1);
    __syncthreads();
    const int tk = s_task;
    if (tk >= Q_SCAN_L + Q_SCAN_C) break;
    if (tk < Q_SCAN_L) scan_task(p, l, 32 + (tk >> 4), (tk >> 1) & 7, tk & 1, smem);
    else { const int t2 = tk - Q_SCAN_L; scan_task(p, l, t2 >> 4, (t2 >> 1) & 7, t2 & 1, smem); }
  }
  for (;;) {
    __syncthreads();
    if (tidx() == 0) s_task = atomicAdd(ctr + 16, 1);
    __syncthreads();
    const int tk = s_task;
    if (tk >= Q_RET_L + Q_RET_C) break;
    if (tk < Q_RET_L) ret_task(p, l, 32 + (tk >> 7), (tk >> 4) & 7, tk & 15, smem);
    else { const int t2 = tk - Q_RET_L; ret_task(p, l, t2 >> 5, (t2 >> 2) & 7, t2 & 3, smem); }
  }
  for (;;) {
    __syncthreads();
    if (tidx() == 0) s_task = atomicAdd(ctr + 32, 1);
    __syncthreads();
    int tk = s_task;
    if (tk >= Q_NA + Q_DENSE + Q_RST) break;
    if (tk < Q_NA) { na_task(p, l, tk >> 7, (tk >> 4) & 7, tk & 15, smem); continue; } tk -= Q_NA;
    if (tk < Q_DENSE) { dense_task(p, tk >> 5, (tk >> 2) & 7, tk & 3, smem); continue; } tk -= Q_DENSE;
    retstate_task(p, l, tk >> 3, tk & 7, smem);
  }
}

__device__ void phase_rwkv_post(const P& p, int l, char* smem) {
  float* sg = (float*)smem;
  const int tid = tidx();
  const bf16_t* zr = (const bf16_t*)(p.ws + WS_ZR); const float* yf = (const float*)(p.ws + WS_Y); const float* yb = yf + (size_t)MT * 512; bf16_t* oa = (bf16_t*)(p.ws + WS_OA);
  const float* gup = p.rwkv_g_up + (size_t)l * 128 * 512;
  for (int it = blockIdx.x; it < MT / 8; it += gridDim.x) {
    const int m0 = it * 8;
    __syncthreads();
    for (int e = tid; e < 1024; e += NT) sg[e] = sigmoidf_(bf2f(zr[(size_t)(m0 + (e >> 7)) * NZR + 1664 + (e & 127)]));
    __syncthreads();
    float g[8][2];
#pragma unroll
    for (int tk = 0; tk < 8; ++tk) { g[tk][0] = 0.f; g[tk][1] = 0.f; }
#pragma unroll 4
    for (int j = 0; j < 128; ++j) { const float g0 = gup[j * 512 + tid], g1 = gup[j * 512 + 256 + tid];
#pragma unroll
      for (int tk = 0; tk < 8; ++tk) { const float sv = sg[tk * 128 + j]; g[tk][0] += sv * g0; g[tk][1] += sv * g1; } }
#pragma unroll
    for (int tk = 0; tk < 8; ++tk) { const int m = m0 + tk;
#pragma unroll
      for (int half = 0; half < 2; ++half) {
        const int c = half * 256 + tid;
        const float y = yf[(size_t)m * 512 + c] + yb[(size_t)m * 512 + c];
        const float mu = wave_sum(y) * (1.f / 64.f); const float dl = y - mu; const float var = wave_sum(dl * dl) * (1.f / 64.f);
        const float o = dl * rsqrtf(var + 64e-5f) * p.rwkv_ln_g[l * 512 + c] + p.rwkv_ln_b[l * 512 + c];
        const float r = bf2f(zr[(size_t)m * NZR + c]), k = bf2f(zr[(size_t)m * NZR + 512 + c]), v = bf2f(zr[(size_t)m * NZR + 1024 + c]);
        const float bonus = wave_sum(r * k * p.rwkv_r_k[l * 512 + c]) * v;
        oa[(size_t)m * LDO + c] = f2bf((o + bonus) * g[tk][half]);
      } }
  }
}

DI void convert_layer_a(const P& p, int l, char* smem) {
  convert_T(p.w_in + (size_t)l * D * INC, D, INC, (bf16_t*)(p.ws + WS_WIN), LDH, smem);
  convert_T(p.w_o_rwkv + (size_t)l * 512 * D, 512, D, (bf16_t*)(p.ws + WS_WO3), LDO, smem);
  convert_T(p.w_o_na + (size_t)l * 512 * D, 512, D, (bf16_t*)(p.ws + WS_WO3) + (size_t)1024 * LDO, LDO, smem);
  convert_T(p.w_o_ret + (size_t)l * 512 * D, 512, D, (bf16_t*)(p.ws + WS_WO3) + (size_t)2 * 1024 * LDO, LDO, smem);
  convert_T(p.w_out + (size_t)l * D * D, D, D, (bf16_t*)(p.ws + WS_WOUT), LDH, smem);
}
DI void convert_layer_b(const P& p, int l, char* smem) {
  convert_T(p.ffn_up + (size_t)l * D * 2 * FF, D, 2 * FF, (bf16_t*)(p.ws + WS_WUP), LDH, smem);
  convert_T(p.ffn_down + (size_t)l * FF * D, FF, D, (bf16_t*)(p.ws + WS_WDN), FF, smem);
}

template <int PH> DI void run_phase(const P& p, int l, char* smem) {
  const float* mod = (const float*)(p.ws + WS_MOD);
  float* xbuf = p.out;
  if (PH == 0) { ada_phase(p, smem); convert_layer_a(p, 0, smem); }
  else if (PH == 1) { norm_phase(p, nullptr, nullptr, nullptr, nullptr, 0, nullptr, p.norm_mix_pre, mod, 0, (bf16_t*)(p.ws + WS_H)); }
  else if (PH == 2) phase_win(p, l, smem);
  else if (PH == 4) phase_mixers(p, l, smem);
  else if (PH == 5) phase_rwkv_post(p, l, smem);
  else if (PH == 6) phase_merge(p, smem);
  else if (PH == 7) { phase_gemm_f32((const bf16_t*)(p.ws + WS_MERGED), LDH, D, (const bf16_t*)(p.ws + WS_WOUT), LDH, (float*)(p.ws + WS_U), smem); }
  else if (PH == 8) { convert_layer_b(p, l, smem);
    norm_phase(p, l == 0 ? nullptr : xbuf, (const float*)(p.ws + WS_U), p.norm_mix_post + l * D, mod + (size_t)l * 5 * 6144, 2, xbuf, p.norm_ffn_pre + l * D, mod + (size_t)l * 5 * 6144, 3, (bf16_t*)(p.ws + WS_H)); }
  else if (PH == 9) phase_ffn_up(p, l, smem);
  else if (PH == 11) { phase_gemm_f32((const bf16_t*)(p.ws + WS_HID), FF, FF, (const bf16_t*)(p.ws + WS_WDN), FF, (float*)(p.ws + WS_F), smem); }
  else if (PH == 12) {
    if (l == 0) { norm_phase(p, xbuf, (const float*)(p.ws + WS_F), p.norm_ffn_post, mod, 5, xbuf, p.norm_mix_pre + D, mod + (size_t)5 * 6144, 0, (bf16_t*)(p.ws + WS_H)); convert_layer_a(p, 1, smem); }
    else norm_phase(p, xbuf, (const float*)(p.ws + WS_F), p.norm_ffn_post + D, mod + (size_t)5 * 6144, 5, xbuf, nullptr, nullptr, 0, nullptr);
  }
}

#if MEGA
__global__ void __launch_bounds__(NT, 2) mega_kernel(P p) {
  extern __shared__ __attribute__((aligned(16))) char smem[];
  __shared__ u32x4 xb_words;
  cg::grid_group grid = cg::this_grid();
  if (tidx() == 0) xb_words = (u32x4){0u, 0u, 0u, 0u};
  __syncthreads();
  const XcdBarrier xb = xcd_barrier_post((unsigned*)(p.ws + WS_BAR), (volatile LAS unsigned*)&xb_words);
#define GSYNC() xcd_barrier(xb)
  run_phase<0>(p, 0, smem); grid.sync();
  run_phase<1>(p, 0, smem); GSYNC();
#pragma unroll 1
  for (int l = 0; l < 2; ++l) {
    run_phase<2>(p, l, smem); GSYNC();
    run_phase<4>(p, l, smem); GSYNC();
    run_phase<5>(p, l, smem); GSYNC();
    run_phase<6>(p, l, smem); GSYNC();
    run_phase<7>(p, l, smem); GSYNC();
    run_phase<8>(p, l, smem); GSYNC();
    run_phase<9>(p, l, smem); GSYNC();
    run_phase<11>(p, l, smem); GSYNC();
    run_phase<12>(p, l, smem); if (l == 0) GSYNC();
  }
#undef GSYNC
}
#else
template <int PH> __global__ void __launch_bounds__(NT, 2) phase_kernel(P p, int l) {
  extern __shared__ __attribute__((aligned(16))) char smem[];
  run_phase<PH>(p, l, smem);
}
#endif

extern "C" void kernel_launch(void* const* d_in, const int* in_sizes, int n_in, void* d_out, int out_size, void* d_ws, size_t ws_size, hipStream_t stream) {
  if (ws_size < WS_END || n_in < 36) { fprintf(stderr, "workspace too small: %zu < %zu\n", ws_size, (size_t)WS_END); return; }
  P p{};
  const float** pp = (const float**)&p;
  for (int i = 0; i < 36; ++i) pp[i] = (const float*)d_in[i];
  p.out = (float*)d_out; p.ws = (char*)d_ws;
  hipMemsetAsync(d_ws, 0, WS_WIN, stream);
#if MEGA
  static int grid_blocks = 0;
  if (!grid_blocks) {
    int dev = 0, cus = 0, per_cu = 0; hipGetDevice(&dev);
    hipDeviceGetAttribute(&cus, hipDeviceAttributeMultiprocessorCount, dev);
    hipFuncSetAttribute((const void*)mega_kernel, hipFuncAttributeMaxDynamicSharedMemorySize, SMEM_BYTES);
    hipOccupancyMaxActiveBlocksPerMultiprocessor(&per_cu, mega_kernel, NT, SMEM_BYTES);
    if (per_cu > 2) per_cu = 2;
    grid_blocks = cus * per_cu;
  }
  void* args[] = {&p};
  hipError_t e = hipLaunchCooperativeKernel((void*)mega_kernel, dim3(grid_blocks), dim3(NT), args, SMEM_BYTES, stream);
  if (e != hipSuccess) fprintf(stderr, "cooperative launch failed: %s (grid %d)\n", hipGetErrorString(e), grid_blocks);
#else
  const int G = 512;
#define LAUNCH(PH, L) do { hipFuncSetAttribute((const void*)phase_kernel<PH>, hipFuncAttributeMaxDynamicSharedMemorySize, SMEM_BYTES); phase_kernel<PH><<<G, NT, SMEM_BYTES, stream>>>(p, L); } while (0)
  LAUNCH(0, 0); LAUNCH(1, 0);
  for (int l = 0; l < 2; ++l) { LAUNCH(2, l); LAUNCH(4, l); LAUNCH(5, l); LAUNCH(6, l); LAUNCH(7, l); LAUNCH(8, l); LAUNCH(9, l); LAUNCH(11, l); LAUNCH(12, l); }
#endif
}
```

```cpp
#include <hip/hip_runtime.h>
#include <hip/hip_cooperative_groups.h>
#include <cstdio>
namespace cg = cooperative_groups;

#ifndef MEGA
#define MEGA 1
#endif
#define PROBE_MASK 0

typedef unsigned short bf16_t;
typedef short bf16x8 __attribute__((ext_vector_type(8)));
typedef short bf16x4 __attribute__((ext_vector_type(4)));
typedef float f32x4 __attribute__((ext_vector_type(4)));
typedef float f32x2 __attribute__((ext_vector_type(2)));
typedef unsigned u32x4 __attribute__((ext_vector_type(4)));
typedef unsigned u32x2 __attribute__((ext_vector_type(2)));
#define DI __device__ __forceinline__
#define MFMA16(a, b, c) __builtin_amdgcn_mfma_f32_16x16x32_bf16((a), (b), (c), 0, 0, 0)

constexpr int NT = 256;
constexpr int D = 1024, MC = 8192, ML = 4096, MT = 12288;
constexpr int NZR = 1792, NZN = 1536, NZT = 2048, INC = 8448, FF = 2816;
constexpr int LDH = 1088, LDO = 576, LZT = 2112;
constexpr int LDT = 72;
constexpr int SMEM_BYTES = 2 * 256 * LDT * 2;
constexpr size_t O_K = 12582912, O_V = 20971520, O_RW = 29360128, O_RT = 33554432;
constexpr size_t WS_CTRL = 0;
constexpr size_t WS_MOD = 4096;
constexpr size_t WS_BAR = 262144;
constexpr size_t WS_CUF = 278528;
constexpr size_t WS_WIN = 294912;
constexpr size_t WS_WUP = WS_WIN;
constexpr size_t WS_WDN = WS_WIN + (size_t)5632 * LDH * 2;
constexpr size_t WS_WO3 = WS_WIN + (size_t)INC * LDH * 2;
constexpr size_t WS_WOUT = WS_WO3 + (size_t)3 * 1024 * LDO * 2;
constexpr size_t WS_H = WS_WOUT + (size_t)1024 * LDH * 2;
constexpr size_t WS_Z = WS_H + (size_t)MT * LDH * 2;
constexpr size_t WS_ZR = WS_Z;
constexpr size_t WS_ZN = WS_ZR + (size_t)MT * NZR * 2;
constexpr size_t WS_ZT = WS_ZN + (size_t)MT * NZN * 2;
constexpr size_t WS_MERGED = WS_ZR;
constexpr size_t WS_OA = WS_ZN;
constexpr size_t WS_U = WS_ZT;
constexpr size_t WS_HID = WS_Z;
constexpr size_t WS_F = WS_ZT;
constexpr size_t WS_Y = WS_ZT + (size_t)MT * LZT * 2;
constexpr size_t WS_ONA = WS_Y + (size_t)2 * MT * 512 * 4;
constexpr size_t WS_ORET = WS_ONA + (size_t)MT * LDO * 2;
constexpr size_t WS_END = WS_ORET + (size_t)MT * LDO * 2;

struct P {
  const float *x_prompt, *x_sample, *cache_k, *cache_v, *state_rwkv, *state_ret, *c, *c_ctx, *ada_w, *ada_b;
  const float *norm_mix_pre, *norm_mix_post, *norm_ffn_pre, *norm_ffn_post, *w_in, *rwkv_conv, *rwkv_w0, *rwkv_w_up, *rwkv_a0, *rwkv_a_up, *rwkv_g_up;
  const float *rwkv_k_k, *rwkv_k_a, *rwkv_r_k, *rwkv_ln_g, *rwkv_ln_b, *na_rpb, *ret_decay, *ret_gn, *w_o_rwkv, *w_o_na, *w_o_ret, *w_out, *ffn_up, *ffn_conv, *ffn_down;
  float* out; char* ws;
};

DI int threadIdx_x_raw() { return (int)__builtin_amdgcn_workitem_id_x(); }
DI int tidx() { int t = threadIdx_x_raw(); asm volatile("" : "+v"(t)); return t; }
DI bf16_t f2bf(float x) { unsigned u = __float_as_uint(x); u += 0x7fffu + ((u >> 16) & 1u); return (bf16_t)(u >> 16); }
DI float bf2f(bf16_t b) { return __uint_as_float(((unsigned)b) << 16); }
DI unsigned pack2(float a, float b) { return (unsigned)f2bf(a) | ((unsigned)f2bf(b) << 16); }
DI float bflo(unsigned u) { return __uint_as_float(u << 16); }
DI float bfhi(unsigned u) { return __uint_as_float(u & 0xffff0000u); }
DI void unpack8(const u32x4 r, float (&f)[8]) { f[0] = bflo(r[0]); f[1] = bfhi(r[0]); f[2] = bflo(r[1]); f[3] = bfhi(r[1]); f[4] = bflo(r[2]); f[5] = bfhi(r[2]); f[6] = bflo(r[3]); f[7] = bfhi(r[3]); }
DI u32x4 pack8(const float (&f)[8]) { u32x4 r; r[0] = pack2(f[0], f[1]); r[1] = pack2(f[2], f[3]); r[2] = pack2(f[4], f[5]); r[3] = pack2(f[6], f[7]); return r; }
DI float sigmoidf_(float x) { return 1.f / (1.f + __expf(-x)); }
DI float wave_sum(float v) { for (int o = 32; o > 0; o >>= 1) v += __shfl_xor(v, o); return v; }
DI void tokinfo(int m, int& t, int& T, int& mi) { if (m < MC) { t = m & 255; T = 256; mi = 0; } else { int q = m - MC; t = q & 1023; T = 1024; mi = 1 + (q >> 10); } }

#define XB_TMO      128
#define XB_XCNT(j)  (256  + 64 * (j))
#define XB_XSUB(j)  (1280 + 64 * (j))
#define XB_XGEN(j)  (2304 + 64 * (j))
#define XB_TOP      3328
#define XB_TOPGEN   3392
#define XB_SPIN_CAP (1u << 20)
#define LAS __attribute__((address_space(3)))
DI unsigned xb_ld(unsigned* p) { return __hip_atomic_load(p, __ATOMIC_RELAXED, __HIP_MEMORY_SCOPE_AGENT); }
DI unsigned xb_add(unsigned* p, unsigned v) { return __hip_atomic_fetch_add(p, v, __ATOMIC_RELAXED, __HIP_MEMORY_SCOPE_AGENT); }
DI unsigned xb_xcc_id() { return (unsigned)__builtin_amdgcn_s_getreg((3 << 11) | 20) & 0xFu; }
#define XB_SPIN(cond, bar) do { unsigned _sp = 0; while (cond) { __builtin_amdgcn_s_sleep(1); \
    if ((++_sp & 255u) == 0u) { if (xb_ld(&(bar)[XB_TMO])) break; if (_sp > XB_SPIN_CAP) { atomicAdd(&(bar)[XB_TMO], 1u); break; } } } } while (0)
struct XcdBarrier { unsigned* bar; unsigned x; volatile LAS unsigned* st; };
DI XcdBarrier xcd_barrier_post(unsigned* bar, volatile LAS unsigned* st) {
  XcdBarrier b; b.bar = bar; b.x = xb_xcc_id(); b.st = st;
  if (tidx() == 0) (void)xb_add(&bar[XB_XCNT(b.x)], 1u);
  return b;
}
DI void xcd_barrier_complete(unsigned* bar, unsigned x, unsigned& nloc, unsigned& nx) {
  const unsigned G = gridDim.x * gridDim.y * gridDim.z;
  unsigned sum, cnt, mine, sp = 0u;
  for (;;) {
    sum = 0u; cnt = 0u; mine = 0u;
#pragma unroll
    for (unsigned j = 0; j < 16; ++j) { const unsigned c = xb_ld(&bar[XB_XCNT(j)]); sum += c; cnt += (c > 0u) ? 1u : 0u; mine = (j == x) ? c : mine; }
    if (sum == G) break;
    __builtin_amdgcn_s_sleep(1);
    if ((++sp & 255u) == 0u) { if (xb_ld(&bar[XB_TMO])) break; if (sp > XB_SPIN_CAP) { atomicAdd(&bar[XB_TMO], 1u); break; } }
  }
  nloc = mine > 0u ? mine : 1u; nx = cnt > 0u ? cnt : 1u;
}
DI void xcd_barrier(const XcdBarrier& b) {
  asm volatile("s_waitcnt vmcnt(0)" ::: "memory");
  __syncthreads();
  if (tidx() == 0) {
    unsigned* bar = b.bar;
    __builtin_amdgcn_s_waitcnt(0);
    unsigned nloc = b.st[0], nx = b.st[1];
    if (nloc == 0u) { xcd_barrier_complete(bar, b.x, nloc, nx); b.st[0] = nloc; b.st[1] = nx; }
    const unsigned old = xb_add(&bar[XB_XSUB(b.x)], 1u);
    const unsigned gen = old / nloc;
    if (old + 1u == (gen + 1u) * nloc) {
      __builtin_amdgcn_fence(__ATOMIC_RELEASE, "agent");
      asm volatile("s_waitcnt vmcnt(0)" ::: "memory");
      const unsigned og = xb_add(&bar[XB_TOP], 1u);
      const unsigned tg = og / nx;
      if (og + 1u == (tg + 1u) * nx) xb_add(&bar[XB_TOPGEN], 1u);
      else XB_SPIN(xb_ld(&bar[XB_TOPGEN]) == tg, bar);
      __builtin_amdgcn_fence(__ATOMIC_ACQUIRE, "agent");
      xb_add(&bar[XB_XGEN(b.x)], 1u);
      asm volatile("s_waitcnt vmcnt(0)" ::: "memory");
    } else {
      XB_SPIN(xb_ld(&bar[XB_XGEN(b.x)]) == gen, bar);
      __builtin_amdgcn_fence(__ATOMIC_ACQUIRE, "agent");
      asm volatile("s_waitcnt vmcnt(0)" ::: "memory");
    }
  }
  __syncthreads();
}

__device__ void convert_T(const float* __restrict__ W, int K, int N, bf16_t* __restrict__ Wt, int ldt, char* smem) {
  float* t = (float*)smem;
  const int tid = tidx(), ntn = N >> 6, nitems = (K >> 6) * ntn;
  for (int it = blockIdx.x; it < nitems; it += gridDim.x) {
    const int k0 = (it / ntn) << 6, n0 = (it % ntn) << 6;
    __syncthreads();
#pragma unroll
    for (int i = 0; i < 4; ++i) { const int k = (tid >> 4) + 16 * i, c4 = (tid & 15) * 4;
      const float4 v = *(const float4*)(W + (size_t)(k0 + k) * N + n0 + c4);
      t[k * 65 + c4] = v.x; t[k * 65 + c4 + 1] = v.y; t[k * 65 + c4 + 2] = v.z; t[k * 65 + c4 + 3] = v.w; }
    __syncthreads();
#pragma unroll
    for (int i = 0; i < 2; ++i) { const int c = tid + 256 * i, n = c >> 3, kc = c & 7; float f[8];
#pragma unroll
      for (int e = 0; e < 8; ++e) f[e] = t[(kc * 8 + e) * 65 + n];
      *(u32x4*)(Wt + (size_t)(n0 + n) * ldt + k0 + kc * 8) = pack8(f); }
  }
}

__device__ void ada_phase(const P& p, char* smem) {
  float* sc = (float*)smem;
  float* red = sc + 640;
  float* mod = (float*)(p.ws + WS_MOD);
  const int tid = tidx(), kq = tid >> 5, cq = tid & 31;
  for (int it = blockIdx.x; it < 2 * 48 * 8; it += gridDim.x) {
    const int l = it / 384, rem = it % 384, nb = rem >> 3, ks = rem & 7;
    const int n0 = nb * 128, k0 = ks * 128;
    __syncthreads();
    for (int e = tid; e < 640; e += NT) { const int i = e >> 7, k = e & 127; const float v = (i == 0) ? p.c_ctx[k0 + k] : p.c[(i - 1) * D + k0 + k]; sc[e] = v * sigmoidf_(v); }
    __syncthreads();
    float acc[5][4];
#pragma unroll
    for (int i = 0; i < 5; ++i)
#pragma unroll
      for (int j = 0; j < 4; ++j) acc[i][j] = 0.f;
    const float* wp = p.ada_w + ((size_t)l * D + k0 + kq * 16) * 6144 + n0 + cq * 4;
#pragma unroll 4
    for (int kk = 0; kk < 16; ++kk) { const float4 w = *(const float4*)(wp + (size_t)kk * 6144);
#pragma unroll
      for (int i = 0; i < 5; ++i) { const float s = sc[i * 128 + kq * 16 + kk]; acc[i][0] += s * w.x; acc[i][1] += s * w.y; acc[i][2] += s * w.z; acc[i][3] += s * w.w; } }
#pragma unroll
    for (int i = 0; i < 5; ++i)
#pragma unroll
      for (int j = 0; j < 4; ++j) red[(kq * 5 + i) * 128 + cq * 4 + j] = acc[i][j];
    __syncthreads();
    for (int e = tid; e < 640; e += NT) { const int i = e >> 7, n = e & 127; float s = 0.f;
#pragma unroll
      for (int q = 0; q < 8; ++q) s += red[(q * 5 + i) * 128 + n];
      if (ks == 0) s += p.ada_b[l * 6144 + n0 + n];
      atomicAdd(mod + ((size_t)l * 5 + i) * 6144 + n0 + n, s); }
  }
}

__device__ void norm_phase(const P& p, const float* xin  , const float* u, const float* gpost, const float* modU, int gate_idx,
                           float* xout, const float* gpre, const float* modN, int shift_idx, bf16_t* hout) {
  const int lane = tidx() & 63, wave = tidx() >> 6, nw = NT / 64;
  for (int m = blockIdx.x * nw + wave; m < MT; m += gridDim.x * nw) {
    int t, T, mi; tokinfo(m, t, T, mi);
    const float* xr = xin ? xin + (size_t)m * D : (m < MC ? p.x_prompt + (size_t)m * D : p.x_sample + (size_t)(m - MC) * D);
    float4 x[4];
#pragma unroll
    for (int i = 0; i < 4; ++i) x[i] = *(const float4*)(xr + i * 256 + lane * 4);
    if (u) {
      float4 uu[4]; float ss = 0.f;
#pragma unroll
      for (int i = 0; i < 4; ++i) { uu[i] = *(const float4*)(u + (size_t)m * D + i * 256 + lane * 4); ss += uu[i].x * uu[i].x + uu[i].y * uu[i].y + uu[i].z * uu[i].z + uu[i].w * uu[i].w; }
      ss = wave_sum(ss); const float rs = rsqrtf(ss * (1.f / D) + 1e-6f);
#pragma unroll
      for (int i = 0; i < 4; ++i) { const int c = i * 256 + lane * 4; const float4 g = *(const float4*)(gpost + c); const float4 ga = *(const float4*)(modU + ((size_t)mi * 6 + gate_idx) * D + c);
        x[i].x += ga.x * uu[i].x * rs * g.x; x[i].y += ga.y * uu[i].y * rs * g.y; x[i].z += ga.z * uu[i].z * rs * g.z; x[i].w += ga.w * uu[i].w * rs * g.w; }
    }
    if (xout) {
#pragma unroll
      for (int i = 0; i < 4; ++i) *(float4*)(xout + (size_t)m * D + i * 256 + lane * 4) = x[i];
    }
    if (hout) {
      float ss = 0.f;
#pragma unroll
      for (int i = 0; i < 4; ++i) ss += x[i].x * x[i].x + x[i].y * x[i].y + x[i].z * x[i].z + x[i].w * x[i].w;
      ss = wave_sum(ss); const float rs = rsqrtf(ss * (1.f / D) + 1e-6f);
#pragma unroll
      for (int i = 0; i < 4; ++i) { const int c = i * 256 + lane * 4; const float4 g = *(const float4*)(gpre + c);
        const float4 sh = *(const float4*)(modN + ((size_t)mi * 6 + shift_idx) * D + c); const float4 sc = *(const float4*)(modN + ((size_t)mi * 6 + shift_idx + 1) * D + c);
        u32x2 o; o.x = pack2(x[i].x * rs * g.x * (1.f + sc.x) + sh.x, x[i].y * rs * g.y * (1.f + sc.y) + sh.y); o.y = pack2(x[i].z * rs * g.z * (1.f + sc.z) + sh.z, x[i].w * rs * g.w * (1.f + sc.w) + sh.w);
        *(u32x2*)(hout + (size_t)m * LDH + c) = o; }
    }
  }
}

struct TileSrc { const bf16_t* A; int lda; int arow0; const bf16_t* B; int ldb; int brow0, brow1; int K; };

template <int NN> DI void zero_acc(f32x4 (&acc)[4][NN]) {
#pragma unroll
  for (int m = 0; m < 4; ++m)
#pragma unroll
    for (int n = 0; n < NN; ++n) acc[m][n] = (f32x4){0.f, 0.f, 0.f, 0.f};
}

template <int NN> DI void gemm_tile(f32x4 (&acc)[4][NN], const TileSrc& s, char* smem) {
  bf16_t* sbase = (bf16_t*)smem;
  const int tid = tidx(), lane = tid & 63, wave = tid >> 6, wr = wave >> 1, wc = wave & 1, fr = lane & 15, fq = lane >> 4;
  const bf16_t* ga[4]; const bf16_t* gb[NN];
#pragma unroll
  for (int i = 0; i < 4; ++i) { const int c = tid + 256 * i, row = c >> 3, kc = c & 7;
    int ar = s.arow0 + row; ar = ar < 0 ? 0 : (ar > MT - 1 ? MT - 1 : ar);
    ga[i] = s.A + (size_t)ar * s.lda + kc * 8; }
#pragma unroll
  for (int i = 0; i < NN; ++i) { const int c = tid + 256 * i, row = c >> 3, kc = c & 7;
    const int br = row < 64 ? s.brow0 + row : s.brow1 + row - 64;
    gb[i] = s.B + (size_t)br * s.ldb + kc * 8; }
  const int wofs = (tid >> 3) * LDT + (tid & 7) * 8;
  const int nk = s.K >> 6;
  u32x4 ra0[4], rb0[NN], ra1[4], rb1[NN];
#define GT_LOAD(RA, RB, KT) do { const int kn_ = ((KT) < nk ? (KT) : nk - 1) * 64; \
    _Pragma("unroll") for (int i = 0; i < 4; ++i) RA[i] = *(const u32x4*)(ga[i] + kn_); \
    _Pragma("unroll") for (int i = 0; i < NN; ++i) RB[i] = *(const u32x4*)(gb[i] + kn_); } while (0)
#define GT_STORE(RA, RB, ST) do { bf16_t* sA_ = sbase + (ST) * (256 * LDT); bf16_t* sB_ = sA_ + 128 * LDT; \
    _Pragma("unroll") for (int i = 0; i < 4; ++i) *(u32x4*)(sA_ + wofs + i * 32 * LDT) = RA[i]; \
    _Pragma("unroll") for (int i = 0; i < NN; ++i) *(u32x4*)(sB_ + wofs + i * 32 * LDT) = RB[i]; } while (0)
#define GT_COMPUTE(ST) do { const bf16_t* sA_ = sbase + (ST) * (256 * LDT); const bf16_t* sB_ = sA_ + 128 * LDT; \
    _Pragma("unroll") for (int ks = 0; ks < 2; ++ks) { bf16x8 bfr[NN]; \
      _Pragma("unroll") for (int n = 0; n < NN; ++n) bfr[n] = *(const bf16x8*)(sB_ + (wc * 16 * NN + n * 16 + fr) * LDT + ks * 32 + fq * 8); \
      _Pragma("unroll") for (int m = 0; m < 4; ++m) { const bf16x8 af = *(const bf16x8*)(sA_ + (wr * 64 + m * 16 + fr) * LDT + ks * 32 + fq * 8); \
        _Pragma("unroll") for (int n = 0; n < NN; ++n) acc[m][n] = MFMA16(bfr[n], af, acc[m][n]); } } } while (0)
  GT_LOAD(ra0, rb0, 0); GT_LOAD(ra1, rb1, 1);
  __syncthreads();
  GT_STORE(ra0, rb0, 0);
  GT_LOAD(ra0, rb0, 2);
  __syncthreads();
#pragma unroll 1
  for (int kt = 0; kt < nk; kt += 2) {
    GT_STORE(ra1, rb1, 1); GT_LOAD(ra1, rb1, kt + 3); GT_COMPUTE(0); __syncthreads();
    GT_STORE(ra0, rb0, 0); GT_LOAD(ra0, rb0, kt + 4); GT_COMPUTE(1); __syncthreads();
  }
#undef GT_LOAD
#undef GT_STORE
#undef GT_COMPUTE
}

DI void stage_acc(const f32x4 (&acc)[4][4], float* sC) {
  const int lane = tidx() & 63, wave = tidx() >> 6, wr = wave >> 1, wc = wave & 1, fr = lane & 15, fq = lane >> 4;
  __syncthreads();
#pragma unroll
  for (int m = 0; m < 4; ++m)
#pragma unroll
    for (int n = 0; n < 4; ++n) *(f32x4*)(sC + (wr * 64 + m * 16 + fr) * 132 + wc * 64 + n * 16 + fq * 4) = acc[m][n];
  __syncthreads();
}

DI float gelu_tanh(float x) { const float u = 0.7978845608f * (x + 0.044715f * x * x * x); const float e = __expf(2.f * u); const float th = 1.f - 2.f / (e + 1.f); return 0.5f * x * (1.f + th); }

struct TileIter {
  int m_lo, rows, NTn, G, efull, count, e, stride;
  DI void init(int MTn, int NTn_) { const int x = blockIdx.x & 7; m_lo = (x * MTn) >> 3; rows = (((x + 1) * MTn) >> 3) - m_lo; NTn = NTn_; G = (rows + 1) >> 1;
    efull = (rows / G) * G * NTn; count = rows * NTn; e = blockIdx.x >> 3; stride = gridDim.x >> 3; }
  DI bool next(int& mt, int& nt) { if (e >= count) return false;
    if (e < efull) { const int grp = e / (G * NTn), rem = e - grp * G * NTn; nt = rem / G; mt = m_lo + grp * G + (rem - nt * G); }
    else { const int rem = e - efull, gsz = rows - (rows / G) * G; nt = rem / gsz; mt = m_lo + (rows / G) * G + (rem - nt * gsz); }
    e += stride; return true; }
};

__device__ void phase_win(const P& p, int l, char* smem) {
  const bf16_t* H = (const bf16_t*)(p.ws + WS_H); const bf16_t* Wt = (const bf16_t*)(p.ws + WS_WIN);
  bf16_t* zr = (bf16_t*)(p.ws + WS_ZR); bf16_t* zn = (bf16_t*)(p.ws + WS_ZN); bf16_t* zt = (bf16_t*)(p.ws + WS_ZT);
  const int tid = tidx(), lane = tid & 63, wave = tid >> 6, wr = wave >> 1, wc = wave & 1, fr = lane & 15, fq = lane >> 4;
  TileIter ti; int mt, nt;
  ti.init(98, 14);
  while (ti.next(mt, nt)) {
    f32x4 acc[4][4]; zero_acc<4>(acc);
    {
      const int n0 = nt * 128, arow0 = mt * 126 - 1;
      TileSrc s{H, LDH, arow0, Wt, LDH, n0, n0 + 64, D};
      gemm_tile<4>(acc, s, smem);
      float* sC = (float*)smem; stage_acc(acc, sC);
      const float* cw = p.rwkv_conv + (size_t)l * 3 * NZR;
      for (int e = tid; e < 126 * 32; e += NT) {
        const int tr = 1 + (e >> 5), c4 = (e & 31) * 4, g = arow0 + tr;
        if (g < MT) { int t, T, mi; tokinfo(g, t, T, mi);
          const float pm = t > 0 ? 1.f : 0.f, nm = t < T - 1 ? 1.f : 0.f;
          const f32x4 a = *(const f32x4*)(sC + (tr - 1) * 132 + c4), b = *(const f32x4*)(sC + tr * 132 + c4), c = *(const f32x4*)(sC + (tr + 1) * 132 + c4);
          const float4 w0 = *(const float4*)(cw + n0 + c4), w1 = *(const float4*)(cw + NZR + n0 + c4), w2 = *(const float4*)(cw + 2 * NZR + n0 + c4);
          u32x2 o; o.x = pack2(pm * a[0] * w0.x + b[0] * w1.x + nm * c[0] * w2.x, pm * a[1] * w0.y + b[1] * w1.y + nm * c[1] * w2.y);
          o.y = pack2(pm * a[2] * w0.z + b[2] * w1.z + nm * c[2] * w2.z, pm * a[3] * w0.w + b[3] * w1.w + nm * c[3] * w2.w);
          *(u32x2*)(zr + (size_t)g * NZR + n0 + c4) = o; }
      }
    }
  }
  ti.init(96, 28);
  while (ti.next(mt, nt)) {
    f32x4 acc[4][4]; zero_acc<4>(acc);
    {
      const int n0 = nt * 128, row0 = mt * 128;
      TileSrc s{H, LDH, row0, Wt, LDH, NZR + n0, NZR + n0 + 64, D};
      gemm_tile<4>(acc, s, smem);
#pragma unroll
      for (int m = 0; m < 4; ++m) { const int row = row0 + wr * 64 + m * 16 + fr;
#pragma unroll
        for (int n = 0; n < 4; ++n) { const int col = n0 + wc * 64 + n * 16 + fq * 4; const f32x4 v = acc[m][n];
          u32x2 o; o.x = pack2(v[0], v[1]); o.y = pack2(v[2], v[3]);
          if (col < NZN) {
            *(u32x2*)(zn + (size_t)row * NZN + col) = o;
            if (row < MC && col >= 512) { const int part = col - 512, isv = part >> 9, pp = part & 511, hh = pp >> 6, d = pp & 63, b = row >> 8, t = row & 255;
              float* dst = p.out + (isv ? O_V : O_K) + ((((size_t)b * 2 + l) * 8 + hh) * 256 + t) * 64 + d; *(f32x4*)dst = v; }
          } else { *(u32x2*)(zt + (size_t)row * LZT + (col - NZN)) = o; }
        } }
    }
  }
}

__device__ void phase_merge(const P& p, char* smem) {
  const bf16_t* H = (const bf16_t*)(p.ws + WS_H); const bf16_t* Wt = (const bf16_t*)(p.ws + WS_WIN); const bf16_t* Wo3 = (const bf16_t*)(p.ws + WS_WO3);
  bf16_t* mg = (bf16_t*)(p.ws + WS_MERGED);
  const int tid = tidx(), lane = tid & 63, wave = tid >> 6, wr = wave >> 1, wc = wave & 1, fr = lane & 15, fq = lane >> 4;
  TileIter ti; int mt, nt; ti.init(96, 16);
  while (ti.next(mt, nt)) {
    const int n0 = nt * 64, row0 = mt * 128;
    f32x4 macc[4][2]; zero_acc<2>(macc);
#pragma unroll 1
    for (int i = 0; i < 3; ++i) {
      const bf16_t* O = (const bf16_t*)(p.ws + (i == 0 ? WS_OA : (i == 1 ? WS_ONA : WS_ORET)));
      f32x4 g[4][2]; zero_acc<2>(g);
      { TileSrc s{H, LDH, row0, Wt, LDH, 5376 + i * 1024 + n0, 0, D}; gemm_tile<2>(g, s, smem); }
      f32x4 a2[4][2]; zero_acc<2>(a2);
      { TileSrc s{O, LDO, row0, Wo3 + (size_t)i * 1024 * LDO, LDO, n0, 0, 512}; gemm_tile<2>(a2, s, smem); }
#pragma unroll
      for (int m = 0; m < 4; ++m)
#pragma unroll
        for (int n = 0; n < 2; ++n)
#pragma unroll
          for (int j = 0; j < 4; ++j) macc[m][n][j] += sigmoidf_(g[m][n][j]) * a2[m][n][j];
    }
#pragma unroll
    for (int m = 0; m < 4; ++m) { const int row = row0 + wr * 64 + m * 16 + fr;
#pragma unroll
      for (int n = 0; n < 2; ++n) { const int col = n0 + wc * 32 + n * 16 + fq * 4; u32x2 o; o.x = pack2(macc[m][n][0], macc[m][n][1]); o.y = pack2(macc[m][n][2], macc[m][n][3]); *(u32x2*)(mg + (size_t)row * LDH + col) = o; } }
  }
}

__device__ void phase_gemm_f32(const bf16_t* A, int lda, int K, const bf16_t* Bt, int ldb, float* C, char* smem) {
  const int tid = tidx(), lane = tid & 63, wave = tid >> 6, wr = wave >> 1, wc = wave & 1, fr = lane & 15, fq = lane >> 4;
  TileIter ti; int mt, nt; ti.init(96, 8);
  while (ti.next(mt, nt)) {
    const int n0 = nt * 128, row0 = mt * 128;
    f32x4 acc[4][4]; zero_acc<4>(acc);
    TileSrc s{A, lda, row0, Bt, ldb, n0, n0 + 64, K}; gemm_tile<4>(acc, s, smem);
#pragma unroll
    for (int m = 0; m < 4; ++m) { const int row = row0 + wr * 64 + m * 16 + fr;
#pragma unroll
      for (int n = 0; n < 4; ++n) *(f32x4*)(C + (size_t)row * D + n0 + wc * 64 + n * 16 + fq * 4) = acc[m][n]; }
  }
}

__device__ void phase_ffn_up(const P& p, int l, char* smem) {
  const bf16_t* H = (const bf16_t*)(p.ws + WS_H); const bf16_t* Wt = (const bf16_t*)(p.ws + WS_WUP); bf16_t* hid = (bf16_t*)(p.ws + WS_HID);
  const int tid = tidx();
  const float* cw = p.ffn_conv + (size_t)l * 3 * 2 * FF;
  TileIter ti; int mt, nt; ti.init(98, 44);
  while (ti.next(mt, nt)) {
    const int c0 = nt * 64, arow0 = mt * 126 - 1;
    f32x4 acc[4][4]; zero_acc<4>(acc);
    TileSrc s{H, LDH, arow0, Wt, LDH, c0, FF + c0, D};
    gemm_tile<4>(acc, s, smem);
    float* sC = (float*)smem; stage_acc(acc, sC);
    for (int e = tid; e < 126 * 16; e += NT) {
      const int tr = 1 + (e >> 4), c4 = (e & 15) * 4, g = arow0 + tr;
      if (g < MT) { int t, T, mi; tokinfo(g, t, T, mi);
        const float pm = t > 0 ? 1.f : 0.f, nm = t < T - 1 ? 1.f : 0.f;
        const f32x4 va = *(const f32x4*)(sC + (tr - 1) * 132 + c4), vb = *(const f32x4*)(sC + tr * 132 + c4), vc = *(const f32x4*)(sC + (tr + 1) * 132 + c4);
        const f32x4 ga = *(const f32x4*)(sC + (tr - 1) * 132 + 64 + c4), gb = *(const f32x4*)(sC + tr * 132 + 64 + c4), gc = *(const f32x4*)(sC + (tr + 1) * 132 + 64 + c4);
        const f32x4 v0 = *(const f32x4*)(cw + c0 + c4), v1 = *(const f32x4*)(cw + 2 * FF + c0 + c4), v2 = *(const f32x4*)(cw + 4 * FF + c0 + c4);
        const f32x4 g0 = *(const f32x4*)(cw + FF + c0 + c4), g1 = *(const f32x4*)(cw + 3 * FF + c0 + c4), g2 = *(const f32x4*)(cw + 5 * FF + c0 + c4);
        float r[4];
#pragma unroll
        for (int j = 0; j < 4; ++j) { const float val = pm * va[j] * v0[j] + vb[j] * v1[j] + nm * vc[j] * v2[j]; const float gt = pm * ga[j] * g0[j] + gb[j] * g1[j] + nm * gc[j] * g2[j]; r[j] = gelu_tanh(gt) * val; }
        u32x2 o; o.x = pack2(r[0], r[1]); o.y = pack2(r[2], r[3]);
        *(u32x2*)(hid + (size_t)g * FF + c0 + c4) = o; }
    }
  }
}

template <int CTRL> DI float dppf(float v) { return __int_as_float(__builtin_amdgcn_mov_dpp(__float_as_int(v), CTRL, 0xF, 0xF, true)); }
DI float row16_sum(float v) { v += dppf<0xB1>(v); v += dppf<0x4E>(v); v += dppf<0x141>(v); v += dppf<0x140>(v); return v; }

__device__ void scan_task(const P& p, int l, int seq, int h, int d, char* smem) {
  float* sR = (float*)smem; float* sW = sR + 1024; float* sKD = sW + 1024; float* sB = sKD + 1024; float* sNK = sB + 1024; float* sV = sNK + 1024; float* sK = sV + 1024; float* sY = sK + 1024;
  float* sKn = sY + 1024; float* sKK = sKn + 16; bf16_t* sWT = (bf16_t*)(sKK + 64); bf16_t* sAL = sWT + 16 * LDT;
  const int tid = tidx(), lane = tid & 63, wave = tid >> 6, fr = lane & 15, fq = lane >> 4;
  const int row0 = seq < 32 ? seq * 256 : MC + (seq - 32) * 1024, T = seq < 32 ? 256 : 1024, nch = T >> 4;
  const bf16_t* zr = (const bf16_t*)(p.ws + WS_ZR);
  float* yout = (float*)(p.ws + WS_Y) + (size_t)d * MT * 512;
  __syncthreads();
  if (tid < 64) sKK[tid] = p.rwkv_k_k[l * 512 + h * 64 + tid];
  const int cc = wave * 16 + fr, gc = h * 64 + cc;
  bf16x8 bw[2], ba[2];
#pragma unroll
  for (int ks = 0; ks < 2; ++ks)
#pragma unroll
    for (int e = 0; e < 8; ++e) { const int k = ks * 32 + fq * 8 + e;
      bw[ks][e] = (short)f2bf(p.rwkv_w_up[((size_t)(l * 2 + d) * 64 + k) * 512 + gc]); ba[ks][e] = (short)f2bf(p.rwkv_a_up[((size_t)(l * 2 + d) * 64 + k) * 512 + gc]); }
  const float w0c = p.rwkv_w0[(l * 2 + d) * 512 + gc], a0c = p.rwkv_a0[(l * 2 + d) * 512 + gc], kac = p.rwkv_k_a[l * 512 + gc];
  const int rg = tid >> 4, kq = tid & 15;
  f32x2 S[4][2];
  if (seq >= 32) { const float* s0 = p.state_rwkv + (((((size_t)(seq - 32) * 2 + l) * 2 + d) * 8 + h) * 64 + rg * 4) * 64 + kq * 4;
#pragma unroll
    for (int r = 0; r < 4; ++r) { const f32x4 x = *(const f32x4*)(s0 + r * 64); S[r][0] = (f32x2){x[0], x[1]}; S[r][1] = (f32x2){x[2], x[3]}; } }
  else {
#pragma unroll
    for (int r = 0; r < 4; ++r) { S[r][0] = (f32x2){0.f, 0.f}; S[r][1] = (f32x2){0.f, 0.f}; } }
  if (seq >= 32) __builtin_amdgcn_s_setprio(2);
  const int segbase[5] = {h * 64, 512 + h * 64, 1024 + h * 64, 1536, 1600};
  int ct[3], cseg[3], cpart[3]; bool cval[3]; size_t coff[3];
#pragma unroll
  for (int i = 0; i < 3; ++i) { const int c = tid + 256 * i; cval[i] = c < 640; const int cx = cval[i] ? c : 0; ct[i] = cx / 40; const int rem = cx % 40; cseg[i] = rem >> 3; cpart[i] = rem & 7;
    const int sb = cseg[i] == 0 ? segbase[0] : (cseg[i] == 1 ? segbase[1] : (cseg[i] == 2 ? segbase[2] : (cseg[i] == 3 ? segbase[3] : segbase[4])));
    coff[i] = (size_t)ct[i] * NZR + sb + cpart[i] * 8; }
  u32x4 pre[3];
  { const int t0 = (d ? nch - 1 : 0) * 16;
#pragma unroll
    for (int i = 0; i < 3; ++i) pre[i] = *(const u32x4*)(zr + (size_t)(row0 + t0) * NZR + coff[i]); }
  __syncthreads();
  for (int ci = 0; ci < nch; ++ci) {
    const int chunk = d ? nch - 1 - ci : ci, t0 = chunk * 16;
#pragma unroll
    for (int i = 0; i < 3; ++i) {
      float f[8]; unpack8(pre[i], f); float ps = 0.f;
      if (cval[i]) {
        const int t = ct[i], o = t * 64 + cpart[i] * 8;
        if (cseg[i] == 0) { *(float4*)(sR + o) = make_float4(f[0], f[1], f[2], f[3]); *(float4*)(sR + o + 4) = make_float4(f[4], f[5], f[6], f[7]); }
        else if (cseg[i] == 1) { *(float4*)(sK + o) = make_float4(f[0], f[1], f[2], f[3]); *(float4*)(sK + o + 4) = make_float4(f[4], f[5], f[6], f[7]);
#pragma unroll
          for (int e = 0; e < 8; ++e) { const float kk = f[e] * sKK[cpart[i] * 8 + e]; ps += kk * kk; } }
        else if (cseg[i] == 2) { *(float4*)(sV + o) = make_float4(f[0], f[1], f[2], f[3]); *(float4*)(sV + o + 4) = make_float4(f[4], f[5], f[6], f[7]); }
        else if (cseg[i] == 3) { float g[8];
#pragma unroll
          for (int e = 0; e < 8; ++e) g[e] = 1.f - 2.f / (__expf(2.f * f[e]) + 1.f);
          *(u32x4*)(sWT + t * LDT + cpart[i] * 8) = pack8(g); }
        else { *(u32x4*)(sAL + t * LDT + cpart[i] * 8) = pre[i]; }
      }
      ps += __shfl_xor(ps, 1); ps += __shfl_xor(ps, 2); ps += __shfl_xor(ps, 4);
      if (cval[i] && cseg[i] == 1 && cpart[i] == 0) sKn[ct[i]] = ps;
    }
    __syncthreads();
    {
      f32x4 aw = {0.f, 0.f, 0.f, 0.f}, aa = {0.f, 0.f, 0.f, 0.f};
#pragma unroll
      for (int ks = 0; ks < 2; ++ks) { const bf16x8 fw = *(const bf16x8*)(sWT + fr * LDT + ks * 32 + fq * 8); const bf16x8 fa = *(const bf16x8*)(sAL + fr * LDT + ks * 32 + fq * 8);
        aw = MFMA16(fw, bw[ks], aw); aa = MFMA16(fa, ba[ks], aa); }
#pragma unroll
      for (int j = 0; j < 4; ++j) { const int t = fq * 4 + j, o = t * 64 + cc;
        const float dec = __expf(-0.6065306597f * sigmoidf_(w0c + aw[j]));
        const float a = sigmoidf_(a0c + aa[j]);
        const float kv = sK[o];
        const float kkv = kv * sKK[cc] / fmaxf(sqrtf(sKn[t]), 1e-12f);
        sW[o] = dec; sKD[o] = kv * (1.f + (a - 1.f) * kac); sB[o] = kkv * a; sNK[o] = -kkv; }
    }
    __syncthreads();
    { const int cn = ci + 1 < nch ? ci + 1 : ci; const int nt0 = (d ? nch - 1 - cn : cn) * 16;
#pragma unroll
      for (int i = 0; i < 3; ++i) pre[i] = *(const u32x4*)(zr + (size_t)(row0 + nt0) * NZR + coff[i]); }
#pragma unroll 2
    for (int si = 0; si < 16; ++si) {
      const int t = d ? 15 - si : si, o = t * 64 + kq * 4;
      const f32x4 an4 = *(const f32x4*)(sNK + o), w4 = *(const f32x4*)(sW + o), b4 = *(const f32x4*)(sB + o), kd4 = *(const f32x4*)(sKD + o), r4 = *(const f32x4*)(sR + o);
      const f32x4 v4 = *(const f32x4*)(sV + t * 64 + rg * 4);
      const f32x2 an[2] = {{an4[0], an4[1]}, {an4[2], an4[3]}}, wv[2] = {{w4[0], w4[1]}, {w4[2], w4[3]}}, bv[2] = {{b4[0], b4[1]}, {b4[2], b4[3]}}, kd[2] = {{kd4[0], kd4[1]}, {kd4[2], kd4[3]}}, rv[2] = {{r4[0], r4[1]}, {r4[2], r4[3]}};
      float sa[4];
#pragma unroll
      for (int r = 0; r < 4; ++r) { const f32x2 t2 = S[r][0] * an[0] + S[r][1] * an[1]; sa[r] = row16_sum(t2.x + t2.y); }
      f32x4 yv;
#pragma unroll
      for (int r = 0; r < 4; ++r) { const f32x2 sav = {sa[r], sa[r]}, vvv = {v4[r], v4[r]};
        S[r][0] = S[r][0] * wv[0] + (sav * bv[0] + vvv * kd[0]); S[r][1] = S[r][1] * wv[1] + (sav * bv[1] + vvv * kd[1]);
        const f32x2 y2 = S[r][0] * rv[0] + S[r][1] * rv[1]; yv[r] = row16_sum(y2.x + y2.y); }
      if (kq == 0) *(f32x4*)(sY + t * 64 + rg * 4) = yv;
    }
    __syncthreads();
    { const int t = tid >> 4, v4 = (tid & 15) * 4; *(float4*)(yout + (size_t)(row0 + t0 + t) * 512 + h * 64 + v4) = *(const float4*)(sY + t * 64 + v4); }
  }
  __builtin_amdgcn_s_setprio(0);
  if (seq < 32) { float* so = p.out + O_RW + (((((size_t)seq * 2 + l) * 2 + d) * 8 + h) * 64 + rg * 4) * 64 + kq * 4;
#pragma unroll
    for (int r = 0; r < 4; ++r) *(f32x4*)(so + r * 64) = (f32x4){S[r][0].x, S[r][0].y, S[r][1].x, S[r][1].y}; }
}

DI void qk_scores(const bf16_t* sK, const bf16x8 (&qf)[2], f32x4 (&sacc)[4], int fr, int fq) {
#pragma unroll
  for (int nt = 0; nt < 4; ++nt) { sacc[nt] = (f32x4){0.f, 0.f, 0.f, 0.f};
#pragma unroll
    for (int ks = 0; ks < 2; ++ks) { const bf16x8 kf = *(const bf16x8*)(sK + (nt * 16 + fr) * LDT + ks * 32 + fq * 8); sacc[nt] = MFMA16(kf, qf[ks], sacc[nt]); } }
}
DI void pv_accum(const bf16_t* sVt, const f32x4 (&pacc)[4], f32x4 (&o)[4], int fr, int fq) {
#pragma unroll
  for (int s = 0; s < 2; ++s) {
    bf16x8 pf; { const unsigned a = pack2(pacc[2 * s][0], pacc[2 * s][1]), b = pack2(pacc[2 * s][2], pacc[2 * s][3]), c = pack2(pacc[2 * s + 1][0], pacc[2 * s + 1][1]), dd = pack2(pacc[2 * s + 1][2], pacc[2 * s + 1][3]);
      const u32x4 u = (u32x4){a, b, c, dd}; pf = __builtin_bit_cast(bf16x8, u); }
#pragma unroll
    for (int dt = 0; dt < 4; ++dt) { const u32x2 lo = *(const u32x2*)(sVt + (dt * 16 + fr) * LDT + 32 * s + 4 * fq), hi = *(const u32x2*)(sVt + (dt * 16 + fr) * LDT + 32 * s + 16 + 4 * fq);
      const u32x4 u = (u32x4){lo[0], lo[1], hi[0], hi[1]}; const bf16x8 vf = __builtin_bit_cast(bf16x8, u); o[dt] = MFMA16(vf, pf, o[dt]); }
  }
}
DI void put_kv(bf16_t* sK, bf16_t* sVt, int key, int part, const float (&kf)[8], const float (&vf)[8]) {
  *(u32x4*)(sK + key * LDT + part * 8) = pack8(kf);
#pragma unroll
  for (int e = 0; e < 8; ++e) sVt[(part * 8 + e) * LDT + key] = f2bf(vf[e]);
}
DI void softmax_tile(f32x4 (&sacc)[4], f32x4 (&o)[4], float& mrun, float& lrun) {
  float mx = sacc[0][0];
#pragma unroll
  for (int nt = 0; nt < 4; ++nt)
#pragma unroll
    for (int j = 0; j < 4; ++j) mx = fmaxf(mx, sacc[nt][j]);
  mx = fmaxf(mx, __shfl_xor(mx, 16)); mx = fmaxf(mx, __shfl_xor(mx, 32));
  const float mnew = fmaxf(mrun, mx), alpha = exp2f(mrun - mnew); mrun = mnew;
  float ls = 0.f;
#pragma unroll
  for (int nt = 0; nt < 4; ++nt)
#pragma unroll
    for (int j = 0; j < 4; ++j) { const float pv = exp2f(sacc[nt][j] - mnew); sacc[nt][j] = pv; ls += pv; }
  lrun = lrun * alpha + ls;
#pragma unroll
  for (int dt = 0; dt < 4; ++dt) o[dt] *= alpha;
}
constexpr float LOG2E = 1.4426950408889634f;

__device__ void dense_task(const P& p, int b, int h, int qb, char* smem) {
  bf16_t* sK = (bf16_t*)smem; bf16_t* sVt = sK + 64 * LDT;
  const int tid = tidx(), lane = tid & 63, wave = tid >> 6, fr = lane & 15, fq = lane >> 4;
  const bf16_t* zn = (const bf16_t*)(p.ws + WS_ZN); bf16_t* ona = (bf16_t*)(p.ws + WS_ONA);
  const int qrow = b * 256 + qb * 64 + wave * 16 + fr;
  bf16x8 qf[2];
#pragma unroll
  for (int ks = 0; ks < 2; ++ks) qf[ks] = *(const bf16x8*)(zn + (size_t)qrow * NZN + h * 64 + ks * 32 + fq * 8);
  f32x4 o[4]; for (int dt = 0; dt < 4; ++dt) o[dt] = (f32x4){0.f, 0.f, 0.f, 0.f};
  float mrun = -1e30f, lrun = 0.f;
  u32x4 pk[2], pv[2];
#pragma unroll
  for (int i = 0; i < 2; ++i) { const int c = tid + 256 * i, key = c >> 3, part = c & 7; const size_t ro = (size_t)(b * 256 + key) * NZN + h * 64 + part * 8; pk[i] = *(const u32x4*)(zn + ro + 512); pv[i] = *(const u32x4*)(zn + ro + 1024); }
  for (int kt = 0; kt < 4; ++kt) {
    __syncthreads();
#pragma unroll
    for (int i = 0; i < 2; ++i) { const int c = tid + 256 * i, key = c >> 3, part = c & 7; float vf[8]; unpack8(pv[i], vf);
      *(u32x4*)(sK + key * LDT + part * 8) = pk[i];
#pragma unroll
      for (int e = 0; e < 8; ++e) sVt[(part * 8 + e) * LDT + key] = f2bf(vf[e]); }
    __syncthreads();
    { const int kn = kt < 3 ? kt + 1 : 3;
#pragma unroll
      for (int i = 0; i < 2; ++i) { const int c = tid + 256 * i, key = c >> 3, part = c & 7; const size_t ro = (size_t)(b * 256 + kn * 64 + key) * NZN + h * 64 + part * 8; pk[i] = *(const u32x4*)(zn + ro + 512); pv[i] = *(const u32x4*)(zn + ro + 1024); } }
    f32x4 sacc[4]; qk_scores(sK, qf, sacc, fr, fq);
#pragma unroll
    for (int nt = 0; nt < 4; ++nt) sacc[nt] *= (0.125f * LOG2E);
    softmax_tile(sacc, o, mrun, lrun);
    pv_accum(sVt, sacc, o, fr, fq);
  }
  lrun += __shfl_xor(lrun, 16); lrun += __shfl_xor(lrun, 32); const float inv = 1.f / lrun;
#pragma unroll
  for (int dt = 0; dt < 4; ++dt) { u32x2 ov; ov.x = pack2(o[dt][0] * inv, o[dt][1] * inv); ov.y = pack2(o[dt][2] * inv, o[dt][3] * inv); *(u32x2*)(ona + (size_t)qrow * LDO + h * 64 + dt * 16 + fq * 4) = ov; }
}

__device__ void na_task(const P& p, int l, int b, int h, int r, char* smem) {
  bf16_t* sK = (bf16_t*)smem; bf16_t* sVt = sK + 64 * LDT; float* sRpb = (float*)(sVt + 64 * LDT);
  const int tid = tidx(), lane = tid & 63, wave = tid >> 6, fr = lane & 15, fq = lane >> 4;
  const bf16_t* zn = (const bf16_t*)(p.ws + WS_ZN); bf16_t* ona = (bf16_t*)(p.ws + WS_ONA);
  const int base = MC + b * 1024, qcol = wave * 16 + fr, qrow = base + r * 64 + qcol;
  int rs = r - 4; rs = rs < 0 ? 0 : (rs > 8 ? 8 : rs);
  int cs = qcol - 8; cs = cs < 0 ? 0 : (cs > 48 ? 48 : cs);
  __syncthreads();
  for (int e = tid; e < 465; e += NT) sRpb[e] = p.na_rpb[((size_t)l * 8 + h) * 465 + e] * LOG2E;
  bf16x8 qf[2];
#pragma unroll
  for (int ks = 0; ks < 2; ++ks) qf[ks] = *(const bf16x8*)(zn + (size_t)qrow * NZN + h * 64 + ks * 32 + fq * 8);
  f32x4 o[4]; for (int dt = 0; dt < 4; ++dt) o[dt] = (f32x4){0.f, 0.f, 0.f, 0.f};
  float mrun = -1e30f, lrun = 0.f;
  u32x4 pre[8];
#define NA_ISSUE(KT) do { const int kt_ = (KT); \
    if (kt_ < 8) { _Pragma("unroll") for (int i = 0; i < 2; ++i) { const int c = tid + 256 * i, key = c >> 3, part = c & 7; const size_t ro = (size_t)(base + (rs + kt_) * 64 + key) * NZN + h * 64 + part * 8; \
        pre[4 * i] = *(const u32x4*)(zn + ro + 512); pre[4 * i + 1] = *(const u32x4*)(zn + ro + 1024); } } \
    else { _Pragma("unroll") for (int i = 0; i < 2; ++i) { const int c = tid + 256 * i, key = c >> 3, part = c & 7; const size_t co = ((((size_t)b * 2 + l) * 8 + h) * 256 + (kt_ - 8) * 64 + key) * 64 + part * 8; \
        pre[4 * i] = *(const u32x4*)(p.cache_k + co); pre[4 * i + 1] = *(const u32x4*)(p.cache_k + co + 4); pre[4 * i + 2] = *(const u32x4*)(p.cache_v + co); pre[4 * i + 3] = *(const u32x4*)(p.cache_v + co + 4); } } } while (0)
  NA_ISSUE(0);
  for (int kt = 0; kt < 12; ++kt) {
    __syncthreads();
    if (kt < 8) {
#pragma unroll
      for (int i = 0; i < 2; ++i) { const int c = tid + 256 * i, key = c >> 3, part = c & 7; float vf[8]; unpack8(pre[4 * i + 1], vf);
        *(u32x4*)(sK + key * LDT + part * 8) = pre[4 * i];
#pragma unroll
        for (int e = 0; e < 8; ++e) sVt[(part * 8 + e) * LDT + key] = f2bf(vf[e]); }
    } else {
#pragma unroll
      for (int i = 0; i < 2; ++i) { const int c = tid + 256 * i, key = c >> 3, part = c & 7;
        const f32x4 k0 = __builtin_bit_cast(f32x4, pre[4 * i]), k1 = __builtin_bit_cast(f32x4, pre[4 * i + 1]), v0 = __builtin_bit_cast(f32x4, pre[4 * i + 2]), v1 = __builtin_bit_cast(f32x4, pre[4 * i + 3]);
        const float kf[8] = {k0[0], k0[1], k0[2], k0[3], k1[0], k1[1], k1[2], k1[3]}; const float vf[8] = {v0[0], v0[1], v0[2], v0[3], v1[0], v1[1], v1[2], v1[3]};
        put_kv(sK, sVt, key, part, kf, vf); }
    }
    __syncthreads();
    NA_ISSUE(kt < 11 ? kt + 1 : 11);
    f32x4 sacc[4]; qk_scores(sK, qf, sacc, fr, fq);
    if (kt < 8) { const int dr = rs + kt - r + 7;
#pragma unroll
      for (int nt = 0; nt < 4; ++nt)
#pragma unroll
        for (int j = 0; j < 4; ++j) { const int kc = nt * 16 + fq * 4 + j; const bool valid = kc >= cs && kc < cs + 16; int dc = kc - qcol; dc = dc < -15 ? -15 : (dc > 15 ? 15 : dc);
          sacc[nt][j] = valid ? sacc[nt][j] * (0.125f * LOG2E) + sRpb[dr * 31 + dc + 15] : -1e30f; }
    } else {
#pragma unroll
      for (int nt = 0; nt < 4; ++nt) sacc[nt] *= (0.125f * LOG2E);
    }
    softmax_tile(sacc, o, mrun, lrun);
    pv_accum(sVt, sacc, o, fr, fq);
  }
#undef NA_ISSUE
  lrun += __shfl_xor(lrun, 16); lrun += __shfl_xor(lrun, 32); const float inv = 1.f / lrun;
#pragma unroll
  for (int dt = 0; dt < 4; ++dt) { u32x2 ov; ov.x = pack2(o[dt][0] * inv, o[dt][1] * inv); ov.y = pack2(o[dt][2] * inv, o[dt][3] * inv); *(u32x2*)(ona + (size_t)qrow * LDO + h * 64 + dt * 16 + fq * 4) = ov; }
}

DI void rope8(const float (&own)[8], const float (&par)[8], int part, int n, float (&out)[8]) {
  const float pos = (float)((part >> 2) ? (n & 63) : (n >> 6));
  const bool isx2 = (part & 3) >= 2;
#pragma unroll
  for (int e = 0; e < 8; ++e) { const int i = (part & 1) * 8 + e; const float ang = pos * exp2f(-(float)i * 0.830482023721841f); const float sn = __sinf(ang), cs = __cosf(ang);
    out[e] = isx2 ? par[e] * sn + own[e] * cs : own[e] * cs - par[e] * sn; }
}

__device__ void ret_task(const P& p, int l, int seq, int h, int qb, char* smem) {
  bf16_t* sK = (bf16_t*)smem; bf16_t* sVt = sK + 64 * LDT; bf16_t* sQ = sVt + 64 * LDT;
  const int tid = tidx(), lane = tid & 63, wave = tid >> 6, fr = lane & 15, fq = lane >> 4;
  const bf16_t* zt = (const bf16_t*)(p.ws + WS_ZT); bf16_t* oret = (bf16_t*)(p.ws + WS_ORET);
  const bool lat = seq >= 32;
  const int row0 = lat ? MC + (seq - 32) * 1024 : seq * 256, T = lat ? 1024 : 256, nkt = T >> 6;
  const float xf = p.ret_decay[(l * 2 + 0) * 8 + h], xb = p.ret_decay[(l * 2 + 1) * 8 + h];
  const float lgf = -log1pf(__expf(-xf)) * LOG2E, lgb = -log1pf(__expf(-xb)) * LOG2E;
  __syncthreads();
#pragma unroll
  for (int i = 0; i < 2; ++i) { const int c = tid + 256 * i, qi = c >> 3, part = c & 7; const int n = qb * 64 + qi; const size_t ro = (size_t)(row0 + n) * LZT + h * 64;
    const u32x4 own = *(const u32x4*)(zt + ro + part * 8);
    if (lat) { const u32x4 par = *(const u32x4*)(zt + ro + (part ^ 2) * 8); float fo[8], fp[8], out[8]; unpack8(own, fo); unpack8(par, fp); rope8(fo, fp, part, n, out); *(u32x4*)(sQ + qi * LDT + part * 8) = pack8(out); }
    else *(u32x4*)(sQ + qi * LDT + part * 8) = own; }
  __syncthreads();
  const int qi = wave * 16 + fr, nq = qb * 64 + qi;
  bf16x8 qf[2];
#pragma unroll
  for (int ks = 0; ks < 2; ++ks) qf[ks] = *(const bf16x8*)(sQ + qi * LDT + ks * 32 + fq * 8);
  f32x4 o[4]; for (int dt = 0; dt < 4; ++dt) o[dt] = (f32x4){0.f, 0.f, 0.f, 0.f};
  u32x4 rk[2], rp[2], rv[2];
#define RET_ISSUE(KT) do { _Pragma("unroll") for (int i = 0; i < 2; ++i) { const int c = tid + 256 * i, key = c >> 3, part = c & 7; const size_t ro = (size_t)(row0 + (KT) * 64 + key) * LZT + h * 64; \
    rk[i] = *(const u32x4*)(zt + ro + 512 + part * 8); rp[i] = *(const u32x4*)(zt + ro + 512 + (part ^ 2) * 8); rv[i] = *(const u32x4*)(zt + ro + 1024 + part * 8); } } while (0)
  RET_ISSUE(0);
  for (int kt = 0; kt < nkt; ++kt) {
    __syncthreads();
#pragma unroll
    for (int i = 0; i < 2; ++i) { const int c = tid + 256 * i, key = c >> 3, part = c & 7; const int n = kt * 64 + key;
      float kf[8], vf[8]; unpack8(rk[i], kf); unpack8(rv[i], vf);
      if (lat) { float fp[8], out[8]; unpack8(rp[i], fp); rope8(kf, fp, part, n, out);
#pragma unroll
        for (int e = 0; e < 8; ++e) kf[e] = out[e]; }
#pragma unroll
      for (int e = 0; e < 8; ++e) kf[e] *= 0.125f;
      put_kv(sK, sVt, key, part, kf, vf); }
    __syncthreads();
    RET_ISSUE(kt + 1 < nkt ? kt + 1 : kt);
    f32x4 sacc[4]; qk_scores(sK, qf, sacc, fr, fq);
#pragma unroll
    for (int nt = 0; nt < 4; ++nt)
#pragma unroll
      for (int j = 0; j < 4; ++j) { const int mk = kt * 64 + nt * 16 + fq * 4 + j; const int df = nq - mk;
        const float dec = df > 0 ? exp2f(lgf * (float)df) : (df < 0 ? exp2f(lgb * (float)(-df)) : 2.f); sacc[nt][j] *= dec; }
    pv_accum(sVt, sacc, o, fr, fq);
  }
#undef RET_ISSUE
  if (lat) {
    for (int dir = 0; dir < 2; ++dir) {
      __syncthreads();
      const float* s0 = p.state_ret + ((((size_t)(seq - 32) * 2 + l) * 2 + dir) * 8 + h) * 4096;
#pragma unroll
      for (int i = 0; i < 2; ++i) { const int c = tid + 256 * i, dk = c >> 3, part = c & 7; const float4 a = *(const float4*)(s0 + dk * 64 + part * 8), bq = *(const float4*)(s0 + dk * 64 + part * 8 + 4);
        const float vf[8] = {a.x, a.y, a.z, a.w, bq.x, bq.y, bq.z, bq.w};
#pragma unroll
        for (int e = 0; e < 8; ++e) sVt[(part * 8 + e) * LDT + dk] = f2bf(vf[e]); }
      __syncthreads();
      const float xi = dir == 0 ? exp2f(lgf * (float)(nq + 1)) : exp2f(lgb * (float)(T - nq));
      f32x4 pacc[4];
#pragma unroll
      for (int s = 0; s < 2; ++s)
#pragma unroll
        for (int hh = 0; hh < 2; ++hh)
#pragma unroll
          for (int j = 0; j < 4; ++j) pacc[2 * s + hh][j] = xi * bf2f(sQ[qi * LDT + 32 * s + 16 * hh + 4 * fq + j]);
      pv_accum(sVt, pacc, o, fr, fq);
    }
  }
  float s1 = 0.f;
#pragma unroll
  for (int dt = 0; dt < 4; ++dt)
#pragma unroll
    for (int j = 0; j < 4; ++j) s1 += o[dt][j];
  s1 += __shfl_xor(s1, 16); s1 += __shfl_xor(s1, 32); const float mu = s1 * (1.f / 64.f);
  float s2 = 0.f;
#pragma unroll
  for (int dt = 0; dt < 4; ++dt)
#pragma unroll
    for (int j = 0; j < 4; ++j) { const float dlt = o[dt][j] - mu; s2 += dlt * dlt; }
  s2 += __shfl_xor(s2, 16); s2 += __shfl_xor(s2, 32); const float rstd = rsqrtf(s2 * (1.f / 64.f) + 1e-5f);
  const size_t qrow = (size_t)(row0 + nq);
#pragma unroll
  for (int dt = 0; dt < 4; ++dt) { const int dv = h * 64 + dt * 16 + fq * 4; const u32x2 gr = *(const u32x2*)(zt + qrow * LZT + 1536 + dv); const float4 gn = *(const float4*)(p.ret_gn + l * 512 + dv);
    const float g0 = bflo(gr.x), g1 = bfhi(gr.x), g2 = bflo(gr.y), g3 = bfhi(gr.y);
    u32x2 ov; ov.x = pack2((o[dt][0] - mu) * rstd * gn.x * g0 * sigmoidf_(g0), (o[dt][1] - mu) * rstd * gn.y * g1 * sigmoidf_(g1));
    ov.y = pack2((o[dt][2] - mu) * rstd * gn.z * g2 * sigmoidf_(g2), (o[dt][3] - mu) * rstd * gn.w * g3 * sigmoidf_(g3));
    *(u32x2*)(oret + qrow * LDO + dv) = ov; }
}

__device__ void retstate_task(const P& p, int l, int b, int h, char* smem) {
  float* sKf = (float*)smem; float* sKb = sKf + 64 * 64; float* sV = sKb + 64 * 64;
  const int tid = tidx(), dk = tid >> 2, dq = tid & 3;
  const bf16_t* zt = (const bf16_t*)(p.ws + WS_ZT);
  const float xf = p.ret_decay[(l * 2 + 0) * 8 + h], xb = p.ret_decay[(l * 2 + 1) * 8 + h];
  const float lgf = -log1pf(__expf(-xf)) * LOG2E, lgb = -log1pf(__expf(-xb)) * LOG2E;
  float af[16], ab[16];
#pragma unroll
  for (int i = 0; i < 16; ++i) { af[i] = 0.f; ab[i] = 0.f; }
  for (int kt = 0; kt < 4; ++kt) {
    __syncthreads();
#pragma unroll
    for (int i = 0; i < 2; ++i) { const int c = tid + 256 * i, key = c >> 3, part = c & 7, m = kt * 64 + key; const size_t ro = (size_t)(b * 256 + m) * LZT + h * 64 + part * 8;
      float kf[8], vf[8]; unpack8(*(const u32x4*)(zt + ro + 512), kf); unpack8(*(const u32x4*)(zt + ro + 1024), vf);
      const float wf = 0.125f * exp2f(lgf * (float)(255 - m)), wb = 0.125f * exp2f(lgb * (float)m);
#pragma unroll
      for (int e = 0; e < 8; ++e) { sKf[key * 64 + part * 8 + e] = kf[e] * wf; sKb[key * 64 + part * 8 + e] = kf[e] * wb; sV[key * 64 + part * 8 + e] = vf[e]; } }
    __syncthreads();
    for (int m = 0; m < 64; ++m) { const float kf = sKf[m * 64 + dk], kb = sKb[m * 64 + dk];
#pragma unroll
      for (int i = 0; i < 4; ++i) { const f32x4 vv = *(const f32x4*)(sV + m * 64 + dq * 16 + i * 4);
#pragma unroll
        for (int j = 0; j < 4; ++j) { af[i * 4 + j] += kf * vv[j]; ab[i * 4 + j] += kb * vv[j]; } } }
  }
  float* of = p.out + O_RT + ((((size_t)b * 2 + l) * 2 + 0) * 8 + h) * 4096 + dk * 64 + dq * 16; float* ob = of + 8 * 4096;
#pragma unroll
  for (int i = 0; i < 16; ++i) { of[i] = af[i]; ob[i] = ab[i]; }
}

constexpr int Q_SCAN_L = 64, Q_SCAN_C = 512, Q_RET_L = 512, Q_NA = 512, Q_DENSE = 1024, Q_RET_C = 1024, Q_RST = 256;
constexpr int Q_TOTAL = Q_SCAN_L + Q_SCAN_C + Q_RET_L + Q_NA + Q_DENSE + Q_RET_C + Q_RST;
template <int QMASK> __device__ void phase_mixers(const P& p, int l, char* smem, int rep = 0) {
  __shared__ int s_task;
  int* ctr = (int*)(p.ws + WS_CTRL) + 64 * (l + 1) + 4 * rep;
  if (QMASK & 1) {
    __shared__ int s_prim;
    if (tidx() == 0) { const unsigned cu = ((unsigned)__builtin_amdgcn_s_getreg((7 << 11) | (8 << 6) | 4) & 0xffu) | (xb_xcc_id() << 8);
      s_prim = atomicAdd((int*)(p.ws + WS_CUF) + l * 2048 + (int)(cu & 2047u), 1) == 0 ? 1 : 0; }
    for (;;) {
      __syncthreads();
      if (tidx() == 0) { int tk = -1;
        if (s_prim) { const int t = atomicAdd(ctr, 1); if (t < Q_SCAN_L) tk = t; else s_prim = 0; }
        if (tk < 0) { const int t = atomicAdd(ctr + 1, 1); if (t < Q_SCAN_C) tk = Q_SCAN_L + t; }
        if (tk < 0) { const int t = atomicAdd(ctr, 1); if (t < Q_SCAN_L) tk = t; }
        s_task = tk < 0 ? Q_SCAN_L + Q_SCAN_C : tk; }
      __syncthreads();
      const int tk = s_task;
      if (tk >= Q_SCAN_L + Q_SCAN_C) break;
      const bool lat = tk < Q_SCAN_L; const int t2 = lat ? tk : tk - Q_SCAN_L;
      scan_task(p, l, (lat ? 32 : 0) + (t2 >> 4), (t2 >> 1) & 7, t2 & 1, smem);
    }
  }
  if (QMASK & 2) for (;;) {
    __syncthreads();
    if (tidx() == 0) s_task = atomicAdd(ctr + 16, 1);
    __syncthreads();
    const int tk = s_task;
    if (tk >= Q_RET_L + Q_RET_C) break;
    if (tk < Q_RET_L) ret_task(p, l, 32 + (tk >> 7), (tk >> 4) & 7, tk & 15, smem);
    else { const int t2 = tk - Q_RET_L; ret_task(p, l, t2 >> 5, (t2 >> 2) & 7, t2 & 3, smem); }
  }
  if (QMASK & 4) for (;;) {
    __syncthreads();
    if (tidx() == 0) s_task = atomicAdd(ctr + 32, 1);
    __syncthreads();
    int tk = s_task;
    if (tk >= Q_NA + Q_DENSE + Q_RST) break;
    if (tk < Q_NA) { na_task(p, l, tk >> 7, (tk >> 4) & 7, tk & 15, smem); continue; } tk -= Q_NA;
    if (tk < Q_DENSE) { dense_task(p, tk >> 5, (tk >> 2) & 7, tk & 3, smem); continue; } tk -= Q_DENSE;
    retstate_task(p, l, tk >> 3, tk & 7, smem);
  }
}

__device__ void phase_rwkv_post(const P& p, int l, char* smem) {
  float* sg = (float*)smem;
  const int tid = tidx();
  const bf16_t* zr = (const bf16_t*)(p.ws + WS_ZR); const float* yf = (const float*)(p.ws + WS_Y); const float* yb = yf + (size_t)MT * 512; bf16_t* oa = (bf16_t*)(p.ws + WS_OA);
  const float* gup = p.rwkv_g_up + (size_t)l * 128 * 512;
  for (int it = blockIdx.x; it < MT / 8; it += gridDim.x) {
    const int m0 = it * 8;
    __syncthreads();
    for (int e = tid; e < 1024; e += NT) sg[e] = sigmoidf_(bf2f(zr[(size_t)(m0 + (e >> 7)) * NZR + 1664 + (e & 127)]));
    __syncthreads();
    float g[8][2];
#pragma unroll
    for (int tk = 0; tk < 8; ++tk) { g[tk][0] = 0.f; g[tk][1] = 0.f; }
#pragma unroll 4
    for (int j = 0; j < 128; ++j) { const float g0 = gup[j * 512 + tid], g1 = gup[j * 512 + 256 + tid];
#pragma unroll
      for (int tk = 0; tk < 8; ++tk) { const float sv = sg[tk * 128 + j]; g[tk][0] += sv * g0; g[tk][1] += sv * g1; } }
#pragma unroll
    for (int tk = 0; tk < 8; ++tk) { const int m = m0 + tk;
#pragma unroll
      for (int half = 0; half < 2; ++half) {
        const int c = half * 256 + tid;
        const float y = yf[(size_t)m * 512 + c] + yb[(size_t)m * 512 + c];
        const float mu = wave_sum(y) * (1.f / 64.f); const float dl = y - mu; const float var = wave_sum(dl * dl) * (1.f / 64.f);
        const float o = dl * rsqrtf(var + 64e-5f) * p.rwkv_ln_g[l * 512 + c] + p.rwkv_ln_b[l * 512 + c];
        const float r = bf2f(zr[(size_t)m * NZR + c]), k = bf2f(zr[(size_t)m * NZR + 512 + c]), v = bf2f(zr[(size_t)m * NZR + 1024 + c]);
        const float bonus = wave_sum(r * k * p.rwkv_r_k[l * 512 + c]) * v;
        oa[(size_t)m * LDO + c] = f2bf((o + bonus) * g[tk][half]);
      } }
  }
}

DI void convert_layer_a(const P& p, int l, char* smem) {
  convert_T(p.w_in + (size_t)l * D * INC, D, INC, (bf16_t*)(p.ws + WS_WIN), LDH, smem);
  convert_T(p.w_o_rwkv + (size_t)l * 512 * D, 512, D, (bf16_t*)(p.ws + WS_WO3), LDO, smem);
  convert_T(p.w_o_na + (size_t)l * 512 * D, 512, D, (bf16_t*)(p.ws + WS_WO3) + (size_t)1024 * LDO, LDO, smem);
  convert_T(p.w_o_ret + (size_t)l * 512 * D, 512, D, (bf16_t*)(p.ws + WS_WO3) + (size_t)2 * 1024 * LDO, LDO, smem);
  convert_T(p.w_out + (size_t)l * D * D, D, D, (bf16_t*)(p.ws + WS_WOUT), LDH, smem);
}
DI void convert_layer_b(const P& p, int l, char* smem) {
  convert_T(p.ffn_up + (size_t)l * D * 2 * FF, D, 2 * FF, (bf16_t*)(p.ws + WS_WUP), LDH, smem);
  convert_T(p.ffn_down + (size_t)l * FF * D, FF, D, (bf16_t*)(p.ws + WS_WDN), FF, smem);
}

template <int PH> DI void run_phase(const P& p, int l, char* smem) {
  const float* mod = (const float*)(p.ws + WS_MOD);
  float* xbuf = p.out;
  if (PH == 0) { ada_phase(p, smem); convert_layer_a(p, 0, smem); }
  else if (PH == 1) { norm_phase(p, nullptr, nullptr, nullptr, nullptr, 0, nullptr, p.norm_mix_pre, mod, 0, (bf16_t*)(p.ws + WS_H)); }
  else if (PH == 2) phase_win(p, l, smem);
  else if (PH == 4) phase_mixers<7>(p, l, smem);
  else if (PH == 5) phase_rwkv_post(p, l, smem);
  else if (PH == 6) phase_merge(p, smem);
  else if (PH == 7) { phase_gemm_f32((const bf16_t*)(p.ws + WS_MERGED), LDH, D, (const bf16_t*)(p.ws + WS_WOUT), LDH, (float*)(p.ws + WS_U), smem); }
  else if (PH == 8) { convert_layer_b(p, l, smem);
    norm_phase(p, l == 0 ? nullptr : xbuf, (const float*)(p.ws + WS_U), p.norm_mix_post + l * D, mod + (size_t)l * 5 * 6144, 2, xbuf, p.norm_ffn_pre + l * D, mod + (size_t)l * 5 * 6144, 3, (bf16_t*)(p.ws + WS_H)); }
  else if (PH == 9) phase_ffn_up(p, l, smem);
  else if (PH == 11) { phase_gemm_f32((const bf16_t*)(p.ws + WS_HID), FF, FF, (const bf16_t*)(p.ws + WS_WDN), FF, (float*)(p.ws + WS_F), smem); }
  else if (PH == 12) {
    if (l == 0) { norm_phase(p, xbuf, (const float*)(p.ws + WS_F), p.norm_ffn_post, mod, 5, xbuf, p.norm_mix_pre + D, mod + (size_t)5 * 6144, 0, (bf16_t*)(p.ws + WS_H)); convert_layer_a(p, 1, smem); }
    else norm_phase(p, xbuf, (const float*)(p.ws + WS_F), p.norm_ffn_post + D, mod + (size_t)5 * 6144, 5, xbuf, nullptr, nullptr, 0, nullptr);
  }
}

#if MEGA
__global__ void __launch_bounds__(NT, 2) mega_kernel(P p) {
  extern __shared__ __attribute__((aligned(16))) char smem[];
  __shared__ u32x4 xb_words;
  cg::grid_group grid = cg::this_grid();
  if (tidx() == 0) xb_words = (u32x4){0u, 0u, 0u, 0u};
  __syncthreads();
  const XcdBarrier xb = xcd_barrier_post((unsigned*)(p.ws + WS_BAR), (volatile LAS unsigned*)&xb_words);
#define GSYNC() xcd_barrier(xb)
  run_phase<0>(p, 0, smem); grid.sync();
  run_phase<1>(p, 0, smem); GSYNC();
#pragma unroll 1
  for (int l = 0; l < 2; ++l) {
    run_phase<2>(p, l, smem); GSYNC();
    if (PROBE_MASK & 1) { run_phase<2>(p, l, smem); GSYNC(); }
    run_phase<4>(p, l, smem); GSYNC();
    if (PROBE_MASK & 2) { phase_mixers<1>(p, l, smem, 1); GSYNC(); }
    if (PROBE_MASK & 256) { phase_mixers<2>(p, l, smem, 1); GSYNC(); }
    if (PROBE_MASK & 512) { phase_mixers<4>(p, l, smem, 1); GSYNC(); }
    run_phase<5>(p, l, smem); GSYNC();
    if (PROBE_MASK & 4) { run_phase<5>(p, l, smem); GSYNC(); }
    run_phase<6>(p, l, smem); GSYNC();
    if (PROBE_MASK & 8) { run_phase<6>(p, l, smem); GSYNC(); }
    run_phase<7>(p, l, smem); GSYNC();
    if (PROBE_MASK & 16) { run_phase<7>(p, l, smem); GSYNC(); }
    run_phase<8>(p, l, smem); GSYNC();
    run_phase<9>(p, l, smem); GSYNC();
    if (PROBE_MASK & 32) { run_phase<9>(p, l, smem); GSYNC(); }
    run_phase<11>(p, l, smem); GSYNC();
    if (PROBE_MASK & 64) { run_phase<11>(p, l, smem); GSYNC(); }
    if (PROBE_MASK & 128) { convert_layer_a(p, l, smem); GSYNC(); convert_layer_b(p, l, smem); GSYNC(); }
    run_phase<12>(p, l, smem); if (l == 0) GSYNC();
  }
#undef GSYNC
}
#else
template <int PH> __global__ void __launch_bounds__(NT, 2) phase_kernel(P p, int l) {
  extern __shared__ __attribute__((aligned(16))) char smem[];
  run_phase<PH>(p, l, smem);
}
#endif

extern "C" void kernel_launch(void* const* d_in, const int* in_sizes, int n_in, void* d_out, int out_size, void* d_ws, size_t ws_size, hipStream_t stream) {
  if (ws_size < WS_END || n_in < 36) { fprintf(stderr, "workspace too small: %zu < %zu\n", ws_size, (size_t)WS_END); return; }
  P p{};
  const float** pp = (const float**)&p;
  for (int i = 0; i < 36; ++i) pp[i] = (const float*)d_in[i];
  p.out = (float*)d_out; p.ws = (char*)d_ws;
  hipMemsetAsync(d_ws, 0, WS_WIN, stream);
#if MEGA
  static int grid_blocks = 0;
  if (!grid_blocks) {
    int dev = 0, cus = 0, per_cu = 0; hipGetDevice(&dev);
    hipDeviceGetAttribute(&cus, hipDeviceAttributeMultiprocessorCount, dev);
    hipFuncSetAttribute((const void*)mega_kernel, hipFuncAttributeMaxDynamicSharedMemorySize, SMEM_BYTES);
    hipOccupancyMaxActiveBlocksPerMultiprocessor(&per_cu, mega_kernel, NT, SMEM_BYTES);
    if (per_cu > 2) per_cu = 2;
    grid_blocks = cus * per_cu;
  }
  void* args[] = {&p};
  hipError_t e = hipLaunchCooperativeKernel((void*)mega_kernel, dim3(grid_blocks), dim3(NT), args, SMEM_BYTES, stream);
  if (e != hipSuccess) fprintf(stderr, "cooperative launch failed: %s (grid %d)\n", hipGetErrorString(e), grid_blocks);
#else
  const int G = 512;
#define LAUNCH(PH, L) do { hipFuncSetAttribute((const void*)phase_kernel<PH>, hipFuncAttributeMaxDynamicSharedMemorySize, SMEM_BYTES); phase_kernel<PH><<<G, NT, SMEM_BYTES, stream>>>(p, L); } while (0)
  LAUNCH(0, 0); LAUNCH(1, 0);
  for (int l = 0; l < 2; ++l) { LAUNCH(2, l); LAUNCH(4, l); LAUNCH(5, l); LAUNCH(6, l); LAUNCH(7, l); LAUNCH(8, l); LAUNCH(9, l); LAUNCH(11, l); LAUNCH(12, l); }
#endif
}
```

```cpp
#include <hip/hip_runtime.h>
#include <hip/hip_cooperative_groups.h>
#include <cstdio>
namespace cg = cooperative_groups;

#ifndef MEGA
#define MEGA 1
#endif
#define PROBE_MASK 0

typedef unsigned short bf16_t;
typedef short bf16x8 __attribute__((ext_vector_type(8)));
typedef short bf16x4 __attribute__((ext_vector_type(4)));
typedef float f32x4 __attribute__((ext_vector_type(4)));
typedef float f32x2 __attribute__((ext_vector_type(2)));
typedef unsigned u32x4 __attribute__((ext_vector_type(4)));
typedef unsigned u32x2 __attribute__((ext_vector_type(2)));
#define DI __device__ __forceinline__
#define MFMA16(a, b, c) __builtin_amdgcn_mfma_f32_16x16x32_bf16((a), (b), (c), 0, 0, 0)

constexpr int NT = 256;
constexpr int D = 1024, MC = 8192, ML = 4096, MT = 12288;
constexpr int NZR = 1792, NZN = 1536, NZT = 2048, INC = 8448, FF = 2816;
constexpr int LDH = 1088, LDO = 576, LZT = 2112, LDG = 136;
constexpr int LDT = 72;
constexpr int SMEM_BYTES = 2 * 256 * LDT * 2;
constexpr size_t O_K = 12582912, O_V = 20971520, O_RW = 29360128, O_RT = 33554432;
constexpr size_t WS_CTRL = 0;
constexpr size_t WS_MOD = 4096;
constexpr size_t WS_BAR = 262144;
constexpr size_t WS_CUF = 278528;
constexpr size_t WS_WG = 294912;
constexpr size_t WS_WIN = 434176;
constexpr size_t WS_WUP = WS_WIN;
constexpr size_t WS_WDN = WS_WIN + (size_t)5632 * LDH * 2;
constexpr size_t WS_WO3 = WS_WIN + (size_t)INC * LDH * 2;
constexpr size_t WS_WOUT = WS_WO3 + (size_t)3 * 1024 * LDO * 2;
constexpr size_t WS_H = WS_WOUT + (size_t)1024 * LDH * 2;
constexpr size_t WS_Z = WS_H + (size_t)MT * LDH * 2;
constexpr size_t WS_ZR = WS_Z;
constexpr size_t WS_ZN = WS_ZR + (size_t)MT * NZR * 2;
constexpr size_t WS_ZT = WS_ZN + (size_t)MT * NZN * 2;
constexpr size_t WS_MERGED = WS_ZR;
constexpr size_t WS_OA = WS_ZN;
constexpr size_t WS_U = WS_ZT;
constexpr size_t WS_HID = WS_Z;
constexpr size_t WS_F = WS_ZT;
constexpr size_t WS_Y = WS_ZT + (size_t)MT * LZT * 2;
constexpr size_t WS_ONA = WS_Y + (size_t)2 * MT * 512 * 4;
constexpr size_t WS_ORET = WS_ONA + (size_t)MT * LDO * 2;
constexpr size_t WS_END = WS_ORET + (size_t)MT * LDO * 2;

struct P {
  const float *x_prompt, *x_sample, *cache_k, *cache_v, *state_rwkv, *state_ret, *c, *c_ctx, *ada_w, *ada_b;
  const float *norm_mix_pre, *norm_mix_post, *norm_ffn_pre, *norm_ffn_post, *w_in, *rwkv_conv, *rwkv_w0, *rwkv_w_up, *rwkv_a0, *rwkv_a_up, *rwkv_g_up;
  const float *rwkv_k_k, *rwkv_k_a, *rwkv_r_k, *rwkv_ln_g, *rwkv_ln_b, *na_rpb, *ret_decay, *ret_gn, *w_o_rwkv, *w_o_na, *w_o_ret, *w_out, *ffn_up, *ffn_conv, *ffn_down;
  float* out; char* ws;
};

DI int threadIdx_x_raw() { return (int)__builtin_amdgcn_workitem_id_x(); }
DI int tidx() { int t = threadIdx_x_raw(); asm volatile("" : "+v"(t)); return t; }
DI bf16_t f2bf(float x) { unsigned u = __float_as_uint(x); u += 0x7fffu + ((u >> 16) & 1u); return (bf16_t)(u >> 16); }
DI float bf2f(bf16_t b) { return __uint_as_float(((unsigned)b) << 16); }
DI unsigned pack2(float a, float b) { return (unsigned)f2bf(a) | ((unsigned)f2bf(b) << 16); }
DI float bflo(unsigned u) { return __uint_as_float(u << 16); }
DI float bfhi(unsigned u) { return __uint_as_float(u & 0xffff0000u); }
DI void unpack8(const u32x4 r, float (&f)[8]) { f[0] = bflo(r[0]); f[1] = bfhi(r[0]); f[2] = bflo(r[1]); f[3] = bfhi(r[1]); f[4] = bflo(r[2]); f[5] = bfhi(r[2]); f[6] = bflo(r[3]); f[7] = bfhi(r[3]); }
DI u32x4 pack8(const float (&f)[8]) { u32x4 r; r[0] = pack2(f[0], f[1]); r[1] = pack2(f[2], f[3]); r[2] = pack2(f[4], f[5]); r[3] = pack2(f[6], f[7]); return r; }
DI float sigmoidf_(float x) { return 1.f / (1.f + __expf(-x)); }
DI float wave_sum(float v) { for (int o = 32; o > 0; o >>= 1) v += __shfl_xor(v, o); return v; }
DI void tokinfo(int m, int& t, int& T, int& mi) { if (m < MC) { t = m & 255; T = 256; mi = 0; } else { int q = m - MC; t = q & 1023; T = 1024; mi = 1 + (q >> 10); } }

#define XB_TMO      128
#define XB_XCNT(j)  (256  + 64 * (j))
#define XB_XSUB(j)  (1280 + 64 * (j))
#define XB_XGEN(j)  (2304 + 64 * (j))
#define XB_TOP      3328
#define XB_TOPGEN   3392
#define XB_SPIN_CAP (1u << 20)
#define LAS __attribute__((address_space(3)))
DI unsigned xb_ld(unsigned* p) { return __hip_atomic_load(p, __ATOMIC_RELAXED, __HIP_MEMORY_SCOPE_AGENT); }
DI unsigned xb_add(unsigned* p, unsigned v) { return __hip_atomic_fetch_add(p, v, __ATOMIC_RELAXED, __HIP_MEMORY_SCOPE_AGENT); }
DI unsigned xb_xcc_id() { return (unsigned)__builtin_amdgcn_s_getreg((3 << 11) | 20) & 0xFu; }
#define XB_SPIN(cond, bar) do { unsigned _sp = 0; while (cond) { __builtin_amdgcn_s_sleep(1); \
    if ((++_sp & 255u) == 0u) { if (xb_ld(&(bar)[XB_TMO])) break; if (_sp > XB_SPIN_CAP) { atomicAdd(&(bar)[XB_TMO], 1u); break; } } } } while (0)
struct XcdBarrier { unsigned* bar; unsigned x; volatile LAS unsigned* st; };
DI XcdBarrier xcd_barrier_post(unsigned* bar, volatile LAS unsigned* st) {
  XcdBarrier b; b.bar = bar; b.x = xb_xcc_id(); b.st = st;
  if (tidx() == 0) (void)xb_add(&bar[XB_XCNT(b.x)], 1u);
  return b;
}
DI void xcd_barrier_complete(unsigned* bar, unsigned x, unsigned& nloc, unsigned& nx) {
  const unsigned G = gridDim.x * gridDim.y * gridDim.z;
  unsigned sum, cnt, mine, sp = 0u;
  for (;;) {
    sum = 0u; cnt = 0u; mine = 0u;
#pragma unroll
    for (unsigned j = 0; j < 16; ++j) { const unsigned c = xb_ld(&bar[XB_XCNT(j)]); sum += c; cnt += (c > 0u) ? 1u : 0u; mine = (j == x) ? c : mine; }
    if (sum == G) break;
    __builtin_amdgcn_s_sleep(1);
    if ((++sp & 255u) == 0u) { if (xb_ld(&bar[XB_TMO])) break; if (sp > XB_SPIN_CAP) { atomicAdd(&bar[XB_TMO], 1u); break; } }
  }
  nloc = mine > 0u ? mine : 1u; nx = cnt > 0u ? cnt : 1u;
}
DI void xcd_barrier(const XcdBarrier& b) {
  asm volatile("s_waitcnt vmcnt(0)" ::: "memory");
  __syncthreads();
  if (tidx() == 0) {
    unsigned* bar = b.bar;
    __builtin_amdgcn_s_waitcnt(0);
    unsigned nloc = b.st[0], nx = b.st[1];
    if (nloc == 0u) { xcd_barrier_complete(bar, b.x, nloc, nx); b.st[0] = nloc; b.st[1] = nx; }
    const unsigned old = xb_add(&bar[XB_XSUB(b.x)], 1u);
    const unsigned gen = old / nloc;
    if (old + 1u == (gen + 1u) * nloc) {
      __builtin_amdgcn_fence(__ATOMIC_RELEASE, "agent");
      asm volatile("s_waitcnt vmcnt(0)" ::: "memory");
      const unsigned og = xb_add(&bar[XB_TOP], 1u);
      const unsigned tg = og / nx;
      if (og + 1u == (tg + 1u) * nx) xb_add(&bar[XB_TOPGEN], 1u);
      else XB_SPIN(xb_ld(&bar[XB_TOPGEN]) == tg, bar);
      __builtin_amdgcn_fence(__ATOMIC_ACQUIRE, "agent");
      xb_add(&bar[XB_XGEN(b.x)], 1u);
      asm volatile("s_waitcnt vmcnt(0)" ::: "memory");
    } else {
      XB_SPIN(xb_ld(&bar[XB_XGEN(b.x)]) == gen, bar);
      __builtin_amdgcn_fence(__ATOMIC_ACQUIRE, "agent");
      asm volatile("s_waitcnt vmcnt(0)" ::: "memory");
    }
  }
  __syncthreads();
}

__device__ void convert_T(const float* __restrict__ W, int K, int N, bf16_t* __restrict__ Wt, int ldt, char* smem) {
  float* t = (float*)smem;
  const int tid = tidx(), ntn = N >> 6, nitems = (K >> 6) * ntn;
  for (int it = blockIdx.x; it < nitems; it += gridDim.x) {
    const int k0 = (it / ntn) << 6, n0 = (it % ntn) << 6;
    __syncthreads();
#pragma unroll
    for (int i = 0; i < 4; ++i) { const int k = (tid >> 4) + 16 * i, c4 = (tid & 15) * 4;
      const float4 v = *(const float4*)(W + (size_t)(k0 + k) * N + n0 + c4);
      t[k * 65 + c4] = v.x; t[k * 65 + c4 + 1] = v.y; t[k * 65 + c4 + 2] = v.z; t[k * 65 + c4 + 3] = v.w; }
    __syncthreads();
#pragma unroll
    for (int i = 0; i < 2; ++i) { const int c = tid + 256 * i, n = c >> 3, kc = c & 7; float f[8];
#pragma unroll
      for (int e = 0; e < 8; ++e) f[e] = t[(kc * 8 + e) * 65 + n];
      *(u32x4*)(Wt + (size_t)(n0 + n) * ldt + k0 + kc * 8) = pack8(f); }
  }
}

__device__ void ada_phase(const P& p, char* smem) {
  float* sc = (float*)smem;
  float* red = sc + 640;
  float* mod = (float*)(p.ws + WS_MOD);
  const int tid = tidx(), kq = tid >> 5, cq = tid & 31;
  for (int it = blockIdx.x; it < 2 * 48 * 8; it += gridDim.x) {
    const int l = it / 384, rem = it % 384, nb = rem >> 3, ks = rem & 7;
    const int n0 = nb * 128, k0 = ks * 128;
    __syncthreads();
    for (int e = tid; e < 640; e += NT) { const int i = e >> 7, k = e & 127; const float v = (i == 0) ? p.c_ctx[k0 + k] : p.c[(i - 1) * D + k0 + k]; sc[e] = v * sigmoidf_(v); }
    __syncthreads();
    float acc[5][4];
#pragma unroll
    for (int i = 0; i < 5; ++i)
#pragma unroll
      for (int j = 0; j < 4; ++j) acc[i][j] = 0.f;
    const float* wp = p.ada_w + ((size_t)l * D + k0 + kq * 16) * 6144 + n0 + cq * 4;
#pragma unroll 4
    for (int kk = 0; kk < 16; ++kk) { const float4 w = *(const float4*)(wp + (size_t)kk * 6144);
#pragma unroll
      for (int i = 0; i < 5; ++i) { const float s = sc[i * 128 + kq * 16 + kk]; acc[i][0] += s * w.x; acc[i][1] += s * w.y; acc[i][2] += s * w.z; acc[i][3] += s * w.w; } }
#pragma unroll
    for (int i = 0; i < 5; ++i)
#pragma unroll
      for (int j = 0; j < 4; ++j) red[(kq * 5 + i) * 128 + cq * 4 + j] = acc[i][j];
    __syncthreads();
    for (int e = tid; e < 640; e += NT) { const int i = e >> 7, n = e & 127; float s = 0.f;
#pragma unroll
      for (int q = 0; q < 8; ++q) s += red[(q * 5 + i) * 128 + n];
      if (ks == 0) s += p.ada_b[l * 6144 + n0 + n];
      atomicAdd(mod + ((size_t)l * 5 + i) * 6144 + n0 + n, s); }
  }
}

__device__ void norm_phase(const P& p, const float* xin  , const float* u, const float* gpost, const float* modU, int gate_idx,
                           float* xout, const float* gpre, const float* modN, int shift_idx, bf16_t* hout) {
  const int lane = tidx() & 63, wave = tidx() >> 6, nw = NT / 64;
  for (int m = blockIdx.x * nw + wave; m < MT; m += gridDim.x * nw) {
    int t, T, mi; tokinfo(m, t, T, mi);
    const float* xr = xin ? xin + (size_t)m * D : (m < MC ? p.x_prompt + (size_t)m * D : p.x_sample + (size_t)(m - MC) * D);
    float4 x[4];
#pragma unroll
    for (int i = 0; i < 4; ++i) x[i] = *(const float4*)(xr + i * 256 + lane * 4);
    if (u) {
      float4 uu[4]; float ss = 0.f;
#pragma unroll
      for (int i = 0; i < 4; ++i) { uu[i] = *(const float4*)(u + (size_t)m * D + i * 256 + lane * 4); ss += uu[i].x * uu[i].x + uu[i].y * uu[i].y + uu[i].z * uu[i].z + uu[i].w * uu[i].w; }
      ss = wave_sum(ss); const float rs = rsqrtf(ss * (1.f / D) + 1e-6f);
#pragma unroll
      for (int i = 0; i < 4; ++i) { const int c = i * 256 + lane * 4; const float4 g = *(const float4*)(gpost + c); const float4 ga = *(const float4*)(modU + ((size_t)mi * 6 + gate_idx) * D + c);
        x[i].x += ga.x * uu[i].x * rs * g.x; x[i].y += ga.y * uu[i].y * rs * g.y; x[i].z += ga.z * uu[i].z * rs * g.z; x[i].w += ga.w * uu[i].w * rs * g.w; }
    }
    if (xout) {
#pragma unroll
      for (int i = 0; i < 4; ++i) *(float4*)(xout + (size_t)m * D + i * 256 + lane * 4) = x[i];
    }
    if (hout) {
      float ss = 0.f;
#pragma unroll
      for (int i = 0; i < 4; ++i) ss += x[i].x * x[i].x + x[i].y * x[i].y + x[i].z * x[i].z + x[i].w * x[i].w;
      ss = wave_sum(ss); const float rs = rsqrtf(ss * (1.f / D) + 1e-6f);
#pragma unroll
      for (int i = 0; i < 4; ++i) { const int c = i * 256 + lane * 4; const float4 g = *(const float4*)(gpre + c);
        const float4 sh = *(const float4*)(modN + ((size_t)mi * 6 + shift_idx) * D + c); const float4 sc = *(const float4*)(modN + ((size_t)mi * 6 + shift_idx + 1) * D + c);
        u32x2 o; o.x = pack2(x[i].x * rs * g.x * (1.f + sc.x) + sh.x, x[i].y * rs * g.y * (1.f + sc.y) + sh.y); o.y = pack2(x[i].z * rs * g.z * (1.f + sc.z) + sh.z, x[i].w * rs * g.w * (1.f + sc.w) + sh.w);
        *(u32x2*)(hout + (size_t)m * LDH + c) = o; }
    }
  }
}

struct TileSrc { const bf16_t* A; int lda; int arow0; const bf16_t* B; int ldb; int brow0, brow1; int K; };

template <int NN> DI void zero_acc(f32x4 (&acc)[4][NN]) {
#pragma unroll
  for (int m = 0; m < 4; ++m)
#pragma unroll
    for (int n = 0; n < NN; ++n) acc[m][n] = (f32x4){0.f, 0.f, 0.f, 0.f};
}

template <int NN> DI void gemm_tile(f32x4 (&acc)[4][NN], const TileSrc& s, char* smem) {
  bf16_t* sbase = (bf16_t*)smem;
  const int tid = tidx(), lane = tid & 63, wave = tid >> 6, wr = wave >> 1, wc = wave & 1, fr = lane & 15, fq = lane >> 4;
  const bf16_t* ga[4]; const bf16_t* gb[NN];
#pragma unroll
  for (int i = 0; i < 4; ++i) { const int c = tid + 256 * i, row = c >> 3, kc = c & 7;
    int ar = s.arow0 + row; ar = ar < 0 ? 0 : (ar > MT - 1 ? MT - 1 : ar);
    ga[i] = s.A + (size_t)ar * s.lda + kc * 8; }
#pragma unroll
  for (int i = 0; i < NN; ++i) { const int c = tid + 256 * i, row = c >> 3, kc = c & 7;
    const int br = row < 64 ? s.brow0 + row : s.brow1 + row - 64;
    gb[i] = s.B + (size_t)br * s.ldb + kc * 8; }
  const int wofs = (tid >> 3) * LDT + (tid & 7) * 8;
  const int nk = s.K >> 6;
  u32x4 ra0[4], rb0[NN], ra1[4], rb1[NN];
#define GT_LOAD(RA, RB, KT) do { const int kn_ = ((KT) < nk ? (KT) : nk - 1) * 64; \
    _Pragma("unroll") for (int i = 0; i < 4; ++i) RA[i] = *(const u32x4*)(ga[i] + kn_); \
    _Pragma("unroll") for (int i = 0; i < NN; ++i) RB[i] = *(const u32x4*)(gb[i] + kn_); } while (0)
#define GT_STORE(RA, RB, ST) do { bf16_t* sA_ = sbase + (ST) * (256 * LDT); bf16_t* sB_ = sA_ + 128 * LDT; \
    _Pragma("unroll") for (int i = 0; i < 4; ++i) *(u32x4*)(sA_ + wofs + i * 32 * LDT) = RA[i]; \
    _Pragma("unroll") for (int i = 0; i < NN; ++i) *(u32x4*)(sB_ + wofs + i * 32 * LDT) = RB[i]; } while (0)
#define GT_COMPUTE(ST) do { const bf16_t* sA_ = sbase + (ST) * (256 * LDT); const bf16_t* sB_ = sA_ + 128 * LDT; \
    _Pragma("unroll") for (int ks = 0; ks < 2; ++ks) { bf16x8 bfr[NN]; \
      _Pragma("unroll") for (int n = 0; n < NN; ++n) bfr[n] = *(const bf16x8*)(sB_ + (wc * 16 * NN + n * 16 + fr) * LDT + ks * 32 + fq * 8); \
      _Pragma("unroll") for (int m = 0; m < 4; ++m) { const bf16x8 af = *(const bf16x8*)(sA_ + (wr * 64 + m * 16 + fr) * LDT + ks * 32 + fq * 8); \
        _Pragma("unroll") for (int n = 0; n < NN; ++n) acc[m][n] = MFMA16(bfr[n], af, acc[m][n]); } } } while (0)
  GT_LOAD(ra0, rb0, 0); GT_LOAD(ra1, rb1, 1);
  __syncthreads();
  GT_STORE(ra0, rb0, 0);
  GT_LOAD(ra0, rb0, 2);
  __syncthreads();
#pragma unroll 1
  for (int kt = 0; kt < nk; kt += 2) {
    GT_STORE(ra1, rb1, 1); GT_LOAD(ra1, rb1, kt + 3); GT_COMPUTE(0); __syncthreads();
    GT_STORE(ra0, rb0, 0); GT_LOAD(ra0, rb0, kt + 4); GT_COMPUTE(1); __syncthreads();
  }
#undef GT_LOAD
#undef GT_STORE
#undef GT_COMPUTE
}

DI void stage_acc(const f32x4 (&acc)[4][4], float* sC) {
  const int lane = tidx() & 63, wave = tidx() >> 6, wr = wave >> 1, wc = wave & 1, fr = lane & 15, fq = lane >> 4;
  __syncthreads();
#pragma unroll
  for (int m = 0; m < 4; ++m)
#pragma unroll
    for (int n = 0; n < 4; ++n) *(f32x4*)(sC + (wr * 64 + m * 16 + fr) * 132 + wc * 64 + n * 16 + fq * 4) = acc[m][n];
  __syncthreads();
}

DI float gelu_tanh(float x) { const float u = 0.7978845608f * (x + 0.044715f * x * x * x); const float e = __expf(2.f * u); const float th = 1.f - 2.f / (e + 1.f); return 0.5f * x * (1.f + th); }

struct TileIter {
  int m_lo, rows, NTn, G, efull, count, e, stride;
  DI void init(int MTn, int NTn_) { const int x = blockIdx.x & 7; m_lo = (x * MTn) >> 3; rows = (((x + 1) * MTn) >> 3) - m_lo; NTn = NTn_; G = (rows + 1) >> 1;
    efull = (rows / G) * G * NTn; count = rows * NTn; e = blockIdx.x >> 3; stride = gridDim.x >> 3; }
  DI bool next(int& mt, int& nt) { if (e >= count) return false;
    if (e < efull) { const int grp = e / (G * NTn), rem = e - grp * G * NTn; nt = rem / G; mt = m_lo + grp * G + (rem - nt * G); }
    else { const int rem = e - efull, gsz = rows - (rows / G) * G; nt = rem / gsz; mt = m_lo + (rows / G) * G + (rem - nt * gsz); }
    e += stride; return true; }
};

__device__ void phase_win(const P& p, int l, char* smem) {
  const bf16_t* H = (const bf16_t*)(p.ws + WS_H); const bf16_t* Wt = (const bf16_t*)(p.ws + WS_WIN);
  bf16_t* zr = (bf16_t*)(p.ws + WS_ZR); bf16_t* zn = (bf16_t*)(p.ws + WS_ZN); bf16_t* zt = (bf16_t*)(p.ws + WS_ZT);
  const int tid = tidx(), lane = tid & 63, wave = tid >> 6, wr = wave >> 1, wc = wave & 1, fr = lane & 15, fq = lane >> 4;
  TileIter ti; int mt, nt;
  ti.init(98, 14);
  while (ti.next(mt, nt)) {
    f32x4 acc[4][4]; zero_acc<4>(acc);
    {
      const int n0 = nt * 128, arow0 = mt * 126 - 1;
      TileSrc s{H, LDH, arow0, Wt, LDH, n0, n0 + 64, D};
      gemm_tile<4>(acc, s, smem);
      float* sC = (float*)smem; stage_acc(acc, sC);
      const float* cw = p.rwkv_conv + (size_t)l * 3 * NZR;
      for (int e = tid; e < 126 * 32; e += NT) {
        const int tr = 1 + (e >> 5), c4 = (e & 31) * 4, g = arow0 + tr;
        if (g < MT) { int t, T, mi; tokinfo(g, t, T, mi);
          const float pm = t > 0 ? 1.f : 0.f, nm = t < T - 1 ? 1.f : 0.f;
          const f32x4 a = *(const f32x4*)(sC + (tr - 1) * 132 + c4), b = *(const f32x4*)(sC + tr * 132 + c4), c = *(const f32x4*)(sC + (tr + 1) * 132 + c4);
          const float4 w0 = *(const float4*)(cw + n0 + c4), w1 = *(const float4*)(cw + NZR + n0 + c4), w2 = *(const float4*)(cw + 2 * NZR + n0 + c4);
          float r0 = pm * a[0] * w0.x + b[0] * w1.x + nm * c[0] * w2.x, r1 = pm * a[1] * w0.y + b[1] * w1.y + nm * c[1] * w2.y;
          float r2 = pm * a[2] * w0.z + b[2] * w1.z + nm * c[2] * w2.z, r3 = pm * a[3] * w0.w + b[3] * w1.w + nm * c[3] * w2.w;
          if (n0 == 1664) { r0 = sigmoidf_(r0); r1 = sigmoidf_(r1); r2 = sigmoidf_(r2); r3 = sigmoidf_(r3); }
          u32x2 o; o.x = pack2(r0, r1); o.y = pack2(r2, r3);
          *(u32x2*)(zr + (size_t)g * NZR + n0 + c4) = o; }
      }
    }
  }
  ti.init(96, 28);
  while (ti.next(mt, nt)) {
    f32x4 acc[4][4]; zero_acc<4>(acc);
    {
      const int n0 = nt * 128, row0 = mt * 128;
      TileSrc s{H, LDH, row0, Wt, LDH, NZR + n0, NZR + n0 + 64, D};
      gemm_tile<4>(acc, s, smem);
#pragma unroll
      for (int m = 0; m < 4; ++m) { const int row = row0 + wr * 64 + m * 16 + fr;
#pragma unroll
        for (int n = 0; n < 4; ++n) { const int col = n0 + wc * 64 + n * 16 + fq * 4; const f32x4 v = acc[m][n];
          u32x2 o; o.x = pack2(v[0], v[1]); o.y = pack2(v[2], v[3]);
          if (col < NZN) {
            *(u32x2*)(zn + (size_t)row * NZN + col) = o;
            if (row < MC && col >= 512) { const int part = col - 512, isv = part >> 9, pp = part & 511, hh = pp >> 6, d = pp & 63, b = row >> 8, t = row & 255;
              float* dst = p.out + (isv ? O_V : O_K) + ((((size_t)b * 2 + l) * 8 + hh) * 256 + t) * 64 + d; *(f32x4*)dst = v; }
          } else { *(u32x2*)(zt + (size_t)row * LZT + (col - NZN)) = o; }
        } }
    }
  }
}

__device__ void phase_merge(const P& p, char* smem) {
  const bf16_t* H = (const bf16_t*)(p.ws + WS_H); const bf16_t* Wt = (const bf16_t*)(p.ws + WS_WIN); const bf16_t* Wo3 = (const bf16_t*)(p.ws + WS_WO3);
  bf16_t* mg = (bf16_t*)(p.ws + WS_MERGED);
  const int tid = tidx(), lane = tid & 63, wave = tid >> 6, wr = wave >> 1, wc = wave & 1, fr = lane & 15, fq = lane >> 4;
  TileIter ti; int mt, nt; ti.init(96, 16);
  while (ti.next(mt, nt)) {
    const int n0 = nt * 64, row0 = mt * 128;
    f32x4 macc[4][2]; zero_acc<2>(macc);
#pragma unroll 1
    for (int i = 0; i < 3; ++i) {
      const bf16_t* O = (const bf16_t*)(p.ws + (i == 0 ? WS_OA : (i == 1 ? WS_ONA : WS_ORET)));
      f32x4 g[4][2]; zero_acc<2>(g);
      { TileSrc s{H, LDH, row0, Wt, LDH, 5376 + i * 1024 + n0, 0, D}; gemm_tile<2>(g, s, smem); }
      f32x4 a2[4][2]; zero_acc<2>(a2);
      { TileSrc s{O, LDO, row0, Wo3 + (size_t)i * 1024 * LDO, LDO, n0, 0, 512}; gemm_tile<2>(a2, s, smem); }
#pragma unroll
      for (int m = 0; m < 4; ++m)
#pragma unroll
        for (int n = 0; n < 2; ++n)
#pragma unroll
          for (int j = 0; j < 4; ++j) macc[m][n][j] += sigmoidf_(g[m][n][j]) * a2[m][n][j];
    }
#pragma unroll
    for (int m = 0; m < 4; ++m) { const int row = row0 + wr * 64 + m * 16 + fr;
#pragma unroll
      for (int n = 0; n < 2; ++n) { const int col = n0 + wc * 32 + n * 16 + fq * 4; u32x2 o; o.x = pack2(macc[m][n][0], macc[m][n][1]); o.y = pack2(macc[m][n][2], macc[m][n][3]); *(u32x2*)(mg + (size_t)row * LDH + col) = o; } }
  }
}

__device__ void phase_gemm_f32(const bf16_t* A, int lda, int K, const bf16_t* Bt, int ldb, float* C, char* smem) {
  const int tid = tidx(), lane = tid & 63, wave = tid >> 6, wr = wave >> 1, wc = wave & 1, fr = lane & 15, fq = lane >> 4;
  TileIter ti; int mt, nt; ti.init(96, 8);
  while (ti.next(mt, nt)) {
    const int n0 = nt * 128, row0 = mt * 128;
    f32x4 acc[4][4]; zero_acc<4>(acc);
    TileSrc s{A, lda, row0, Bt, ldb, n0, n0 + 64, K}; gemm_tile<4>(acc, s, smem);
#pragma unroll
    for (int m = 0; m < 4; ++m) { const int row = row0 + wr * 64 + m * 16 + fr;
#pragma unroll
      for (int n = 0; n < 4; ++n) *(f32x4*)(C + (size_t)row * D + n0 + wc * 64 + n * 16 + fq * 4) = acc[m][n]; }
  }
}

__device__ void phase_ffn_up(const P& p, int l, char* smem) {
  const bf16_t* H = (const bf16_t*)(p.ws + WS_H); const bf16_t* Wt = (const bf16_t*)(p.ws + WS_WUP); bf16_t* hid = (bf16_t*)(p.ws + WS_HID);
  const int tid = tidx();
  const float* cw = p.ffn_conv + (size_t)l * 3 * 2 * FF;
  TileIter ti; int mt, nt; ti.init(98, 44);
  while (ti.next(mt, nt)) {
    const int c0 = nt * 64, arow0 = mt * 126 - 1;
    f32x4 acc[4][4]; zero_acc<4>(acc);
    TileSrc s{H, LDH, arow0, Wt, LDH, c0, FF + c0, D};
    gemm_tile<4>(acc, s, smem);
    float* sC = (float*)smem; stage_acc(acc, sC);
    for (int e = tid; e < 126 * 16; e += NT) {
      const int tr = 1 + (e >> 4), c4 = (e & 15) * 4, g = arow0 + tr;
      if (g < MT) { int t, T, mi; tokinfo(g, t, T, mi);
        const float pm = t > 0 ? 1.f : 0.f, nm = t < T - 1 ? 1.f : 0.f;
        const f32x4 va = *(const f32x4*)(sC + (tr - 1) * 132 + c4), vb = *(const f32x4*)(sC + tr * 132 + c4), vc = *(const f32x4*)(sC + (tr + 1) * 132 + c4);
        const f32x4 ga = *(const f32x4*)(sC + (tr - 1) * 132 + 64 + c4), gb = *(const f32x4*)(sC + tr * 132 + 64 + c4), gc = *(const f32x4*)(sC + (tr + 1) * 132 + 64 + c4);
        const f32x4 v0 = *(const f32x4*)(cw + c0 + c4), v1 = *(const f32x4*)(cw + 2 * FF + c0 + c4), v2 = *(const f32x4*)(cw + 4 * FF + c0 + c4);
        const f32x4 g0 = *(const f32x4*)(cw + FF + c0 + c4), g1 = *(const f32x4*)(cw + 3 * FF + c0 + c4), g2 = *(const f32x4*)(cw + 5 * FF + c0 + c4);
        float r[4];
#pragma unroll
        for (int j = 0; j < 4; ++j) { const float val = pm * va[j] * v0[j] + vb[j] * v1[j] + nm * vc[j] * v2[j]; const float gt = pm * ga[j] * g0[j] + gb[j] * g1[j] + nm * gc[j] * g2[j]; r[j] = gelu_tanh(gt) * val; }
        u32x2 o; o.x = pack2(r[0], r[1]); o.y = pack2(r[2], r[3]);
        *(u32x2*)(hid + (size_t)g * FF + c0 + c4) = o; }
    }
  }
}

template <int CTRL> DI float dppf(float v) { return __int_as_float(__builtin_amdgcn_mov_dpp(__float_as_int(v), CTRL, 0xF, 0xF, true)); }
DI float row16_sum(float v) { v += dppf<0xB1>(v); v += dppf<0x4E>(v); v += dppf<0x141>(v); v += dppf<0x140>(v); return v; }

__device__ void scan_task(const P& p, int l, int seq, int h, int d, char* smem) {
  float* sR = (float*)smem; float* sW = sR + 1024; float* sKD = sW + 1024; float* sB = sKD + 1024; float* sNK = sB + 1024; float* sV = sNK + 1024; float* sK = sV + 1024; float* sY = sK + 1024;
  float* sKn = sY + 1024; float* sKK = sKn + 16; bf16_t* sWT = (bf16_t*)(sKK + 64); bf16_t* sAL = sWT + 16 * LDT;
  const int tid = tidx(), lane = tid & 63, wave = tid >> 6, fr = lane & 15, fq = lane >> 4;
  const int row0 = seq < 32 ? seq * 256 : MC + (seq - 32) * 1024, T = seq < 32 ? 256 : 1024, nch = T >> 4;
  const bf16_t* zr = (const bf16_t*)(p.ws + WS_ZR);
  float* yout = (float*)(p.ws + WS_Y) + (size_t)d * MT * 512;
  __syncthreads();
  if (tid < 64) sKK[tid] = p.rwkv_k_k[l * 512 + h * 64 + tid];
  const int cc = wave * 16 + fr, gc = h * 64 + cc;
  bf16x8 bw[2], ba[2];
#pragma unroll
  for (int ks = 0; ks < 2; ++ks)
#pragma unroll
    for (int e = 0; e < 8; ++e) { const int k = ks * 32 + fq * 8 + e;
      bw[ks][e] = (short)f2bf(p.rwkv_w_up[((size_t)(l * 2 + d) * 64 + k) * 512 + gc]); ba[ks][e] = (short)f2bf(p.rwkv_a_up[((size_t)(l * 2 + d) * 64 + k) * 512 + gc]); }
  const float w0c = p.rwkv_w0[(l * 2 + d) * 512 + gc], a0c = p.rwkv_a0[(l * 2 + d) * 512 + gc], kac = p.rwkv_k_a[l * 512 + gc];
  const int rg = tid >> 4, kq = tid & 15;
  f32x2 S[4][2];
  if (seq >= 32) { const float* s0 = p.state_rwkv + (((((size_t)(seq - 32) * 2 + l) * 2 + d) * 8 + h) * 64 + rg * 4) * 64 + kq * 4;
#pragma unroll
    for (int r = 0; r < 4; ++r) { const f32x4 x = *(const f32x4*)(s0 + r * 64); S[r][0] = (f32x2){x[0], x[1]}; S[r][1] = (f32x2){x[2], x[3]}; } }
  else {
#pragma unroll
    for (int r = 0; r < 4; ++r) { S[r][0] = (f32x2){0.f, 0.f}; S[r][1] = (f32x2){0.f, 0.f}; } }
  if (seq >= 32) __builtin_amdgcn_s_setprio(2);
  const int segbase[5] = {h * 64, 512 + h * 64, 1024 + h * 64, 1536, 1600};
  int ct[3], cseg[3], cpart[3]; bool cval[3]; size_t coff[3];
#pragma unroll
  for (int i = 0; i < 3; ++i) { const int c = tid + 256 * i; cval[i] = c < 640; const int cx = cval[i] ? c : 0; ct[i] = cx / 40; const int rem = cx % 40; cseg[i] = rem >> 3; cpart[i] = rem & 7;
    const int sb = cseg[i] == 0 ? segbase[0] : (cseg[i] == 1 ? segbase[1] : (cseg[i] == 2 ? segbase[2] : (cseg[i] == 3 ? segbase[3] : segbase[4])));
    coff[i] = (size_t)ct[i] * NZR + sb + cpart[i] * 8; }
  u32x4 pre[3];
  { const int t0 = (d ? nch - 1 : 0) * 16;
#pragma unroll
    for (int i = 0; i < 3; ++i) pre[i] = *(const u32x4*)(zr + (size_t)(row0 + t0) * NZR + coff[i]); }
  __syncthreads();
  for (int ci = 0; ci < nch; ++ci) {
    const int chunk = d ? nch - 1 - ci : ci, t0 = chunk * 16;
#pragma unroll
    for (int i = 0; i < 3; ++i) {
      float f[8]; unpack8(pre[i], f); float ps = 0.f;
      if (cval[i]) {
        const int t = ct[i], o = t * 64 + cpart[i] * 8;
        if (cseg[i] == 0) { *(float4*)(sR + o) = make_float4(f[0], f[1], f[2], f[3]); *(float4*)(sR + o + 4) = make_float4(f[4], f[5], f[6], f[7]); }
        else if (cseg[i] == 1) { *(float4*)(sK + o) = make_float4(f[0], f[1], f[2], f[3]); *(float4*)(sK + o + 4) = make_float4(f[4], f[5], f[6], f[7]);
#pragma unroll
          for (int e = 0; e < 8; ++e) { const float kk = f[e] * sKK[cpart[i] * 8 + e]; ps += kk * kk; } }
        else if (cseg[i] == 2) { *(float4*)(sV + o) = make_float4(f[0], f[1], f[2], f[3]); *(float4*)(sV + o + 4) = make_float4(f[4], f[5], f[6], f[7]); }
        else if (cseg[i] == 3) { float g[8];
#pragma unroll
          for (int e = 0; e < 8; ++e) g[e] = 1.f - 2.f / (__expf(2.f * f[e]) + 1.f);
          *(u32x4*)(sWT + t * LDT + cpart[i] * 8) = pack8(g); }
        else { *(u32x4*)(sAL + t * LDT + cpart[i] * 8) = pre[i]; }
      }
      ps += __shfl_xor(ps, 1); ps += __shfl_xor(ps, 2); ps += __shfl_xor(ps, 4);
      if (cval[i] && cseg[i] == 1 && cpart[i] == 0) sKn[ct[i]] = ps;
    }
    __syncthreads();
    {
      f32x4 aw = {0.f, 0.f, 0.f, 0.f}, aa = {0.f, 0.f, 0.f, 0.f};
#pragma unroll
      for (int ks = 0; ks < 2; ++ks) { const bf16x8 fw = *(const bf16x8*)(sWT + fr * LDT + ks * 32 + fq * 8); const bf16x8 fa = *(const bf16x8*)(sAL + fr * LDT + ks * 32 + fq * 8);
        aw = MFMA16(fw, bw[ks], aw); aa = MFMA16(fa, ba[ks], aa); }
#pragma unroll
      for (int j = 0; j < 4; ++j) { const int t = fq * 4 + j, o = t * 64 + cc;
        const float dec = __expf(-0.6065306597f * sigmoidf_(w0c + aw[j]));
        const float a = sigmoidf_(a0c + aa[j]);
        const float kv = sK[o];
        const float kkv = kv * sKK[cc] / fmaxf(sqrtf(sKn[t]), 1e-12f);
        sW[o] = dec; sKD[o] = kv * (1.f + (a - 1.f) * kac); sB[o] = kkv * a; sNK[o] = -kkv; }
    }
    __syncthreads();
    { const int cn = ci + 1 < nch ? ci + 1 : ci; const int nt0 = (d ? nch - 1 - cn : cn) * 16;
#pragma unroll
      for (int i = 0; i < 3; ++i) pre[i] = *(const u32x4*)(zr + (size_t)(row0 + nt0) * NZR + coff[i]); }
#pragma unroll 2
    for (int si = 0; si < 16; ++si) {
      const int t = d ? 15 - si : si, o = t * 64 + kq * 4;
      const f32x4 an4 = *(const f32x4*)(sNK + o), w4 = *(const f32x4*)(sW + o), b4 = *(const f32x4*)(sB + o), kd4 = *(const f32x4*)(sKD + o), r4 = *(const f32x4*)(sR + o);
      const f32x4 v4 = *(const f32x4*)(sV + t * 64 + rg * 4);
      const f32x2 an[2] = {{an4[0], an4[1]}, {an4[2], an4[3]}}, wv[2] = {{w4[0], w4[1]}, {w4[2], w4[3]}}, bv[2] = {{b4[0], b4[1]}, {b4[2], b4[3]}}, kd[2] = {{kd4[0], kd4[1]}, {kd4[2], kd4[3]}}, rv[2] = {{r4[0], r4[1]}, {r4[2], r4[3]}};
      float sa[4];
#pragma unroll
      for (int r = 0; r < 4; ++r) { const f32x2 t2 = S[r][0] * an[0] + S[r][1] * an[1]; sa[r] = row16_sum(t2.x + t2.y); }
      f32x4 yv;
#pragma unroll
      for (int r = 0; r < 4; ++r) { const f32x2 sav = {sa[r], sa[r]}, vvv = {v4[r], v4[r]};
        S[r][0] = S[r][0] * wv[0] + (sav * bv[0] + vvv * kd[0]); S[r][1] = S[r][1] * wv[1] + (sav * bv[1] + vvv * kd[1]);
        const f32x2 y2 = S[r][0] * rv[0] + S[r][1] * rv[1]; yv[r] = row16_sum(y2.x + y2.y); }
      if (kq == 0) *(f32x4*)(sY + t * 64 + rg * 4) = yv;
    }
    __syncthreads();
    { const int t = tid >> 4, v4 = (tid & 15) * 4; *(float4*)(yout + (size_t)(row0 + t0 + t) * 512 + h * 64 + v4) = *(const float4*)(sY + t * 64 + v4); }
  }
  __builtin_amdgcn_s_setprio(0);
  if (seq < 32) { float* so = p.out + O_RW + (((((size_t)seq * 2 + l) * 2 + d) * 8 + h) * 64 + rg * 4) * 64 + kq * 4;
#pragma unroll
    for (int r = 0; r < 4; ++r) *(f32x4*)(so + r * 64) = (f32x4){S[r][0].x, S[r][0].y, S[r][1].x, S[r][1].y}; }
}

DI void qk_scores(const bf16_t* sK, const bf16x8 (&qf)[2], f32x4 (&sacc)[4], int fr, int fq) {
#pragma unroll
  for (int nt = 0; nt < 4; ++nt) { sacc[nt] = (f32x4){0.f, 0.f, 0.f, 0.f};
#pragma unroll
    for (int ks = 0; ks < 2; ++ks) { const bf16x8 kf = *(const bf16x8*)(sK + (nt * 16 + fr) * LDT + ks * 32 + fq * 8); sacc[nt] = MFMA16(kf, qf[ks], sacc[nt]); } }
}
DI void pv_accum(const bf16_t* sVt, const f32x4 (&pacc)[4], f32x4 (&o)[4], int fr, int fq) {
#pragma unroll
  for (int s = 0; s < 2; ++s) {
    bf16x8 pf; { const unsigned a = pack2(pacc[2 * s][0], pacc[2 * s][1]), b = pack2(pacc[2 * s][2], pacc[2 * s][3]), c = pack2(pacc[2 * s + 1][0], pacc[2 * s + 1][1]), dd = pack2(pacc[2 * s + 1][2], pacc[2 * s + 1][3]);
      const u32x4 u = (u32x4){a, b, c, dd}; pf = __builtin_bit_cast(bf16x8, u); }
#pragma unroll
    for (int dt = 0; dt < 4; ++dt) { const u32x2 lo = *(const u32x2*)(sVt + (dt * 16 + fr) * LDT + 32 * s + 4 * fq), hi = *(const u32x2*)(sVt + (dt * 16 + fr) * LDT + 32 * s + 16 + 4 * fq);
      const u32x4 u = (u32x4){lo[0], lo[1], hi[0], hi[1]}; const bf16x8 vf = __builtin_bit_cast(bf16x8, u); o[dt] = MFMA16(vf, pf, o[dt]); }
  }
}
DI void put_kv(bf16_t* sK, bf16_t* sVt, int key, int part, const float (&kf)[8], const float (&vf)[8]) {
  *(u32x4*)(sK + key * LDT + part * 8) = pack8(kf);
#pragma unroll
  for (int e = 0; e < 8; ++e) sVt[(part * 8 + e) * LDT + key] = f2bf(vf[e]);
}
DI void softmax_tile(f32x4 (&sacc)[4], f32x4 (&o)[4], float& mrun, float& lrun) {
  float mx = sacc[0][0];
#pragma unroll
  for (int nt = 0; nt < 4; ++nt)
#pragma unroll
    for (int j = 0; j < 4; ++j) mx = fmaxf(mx, sacc[nt][j]);
  mx = fmaxf(mx, __shfl_xor(mx, 16)); mx = fmaxf(mx, __shfl_xor(mx, 32));
  const float mnew = fmaxf(mrun, mx), alpha = exp2f(mrun - mnew); mrun = mnew;
  float ls = 0.f;
#pragma unroll
  for (int nt = 0; nt < 4; ++nt)
#pragma unroll
    for (int j = 0; j < 4; ++j) { const float pv = exp2f(sacc[nt][j] - mnew); sacc[nt][j] = pv; ls += pv; }
  lrun = lrun * alpha + ls;
#pragma unroll
  for (int dt = 0; dt < 4; ++dt) o[dt] *= alpha;
}
constexpr float LOG2E = 1.4426950408889634f;

__device__ void dense_task(const P& p, int b, int h, int qb, char* smem) {
  bf16_t* sK = (bf16_t*)smem; bf16_t* sVt = sK + 64 * LDT;
  const int tid = tidx(), lane = tid & 63, wave = tid >> 6, fr = lane & 15, fq = lane >> 4;
  const bf16_t* zn = (const bf16_t*)(p.ws + WS_ZN); bf16_t* ona = (bf16_t*)(p.ws + WS_ONA);
  const int qrow = b * 256 + qb * 64 + wave * 16 + fr;
  bf16x8 qf[2];
#pragma unroll
  for (int ks = 0; ks < 2; ++ks) qf[ks] = *(const bf16x8*)(zn + (size_t)qrow * NZN + h * 64 + ks * 32 + fq * 8);
  f32x4 o[4]; for (int dt = 0; dt < 4; ++dt) o[dt] = (f32x4){0.f, 0.f, 0.f, 0.f};
  float mrun = -1e30f, lrun = 0.f;
  u32x4 pk[2], pv[2];
#pragma unroll
  for (int i = 0; i < 2; ++i) { const int c = tid + 256 * i, key = c >> 3, part = c & 7; const size_t ro = (size_t)(b * 256 + key) * NZN + h * 64 + part * 8; pk[i] = *(const u32x4*)(zn + ro + 512); pv[i] = *(const u32x4*)(zn + ro + 1024); }
  for (int kt = 0; kt < 4; ++kt) {
    __syncthreads();
#pragma unroll
    for (int i = 0; i < 2; ++i) { const int c = tid + 256 * i, key = c >> 3, part = c & 7; float vf[8]; unpack8(pv[i], vf);
      *(u32x4*)(sK + key * LDT + part * 8) = pk[i];
#pragma unroll
      for (int e = 0; e < 8; ++e) sVt[(part * 8 + e) * LDT + key] = f2bf(vf[e]); }
    __syncthreads();
    { const int kn = kt < 3 ? kt + 1 : 3;
#pragma unroll
      for (int i = 0; i < 2; ++i) { const int c = tid + 256 * i, key = c >> 3, part = c & 7; const size_t ro = (size_t)(b * 256 + kn * 64 + key) * NZN + h * 64 + part * 8; pk[i] = *(const u32x4*)(zn + ro + 512); pv[i] = *(const u32x4*)(zn + ro + 1024); } }
    f32x4 sacc[4]; qk_scores(sK, qf, sacc, fr, fq);
#pragma unroll
    for (int nt = 0; nt < 4; ++nt) sacc[nt] *= (0.125f * LOG2E);
    softmax_tile(sacc, o, mrun, lrun);
    pv_accum(sVt, sacc, o, fr, fq);
  }
  lrun += __shfl_xor(lrun, 16); lrun += __shfl_xor(lrun, 32); const float inv = 1.f / lrun;
#pragma unroll
  for (int dt = 0; dt < 4; ++dt) { u32x2 ov; ov.x = pack2(o[dt][0] * inv, o[dt][1] * inv); ov.y = pack2(o[dt][2] * inv, o[dt][3] * inv); *(u32x2*)(ona + (size_t)qrow * LDO + h * 64 + dt * 16 + fq * 4) = ov; }
}

__device__ void na_task(const P& p, int l, int b, int h, int r, char* smem) {
  bf16_t* sK = (bf16_t*)smem; bf16_t* sVt = sK + 64 * LDT; float* sRpb = (float*)(sVt + 64 * LDT);
  const int tid = tidx(), lane = tid & 63, wave = tid >> 6, fr = lane & 15, fq = lane >> 4;
  const bf16_t* zn = (const bf16_t*)(p.ws + WS_ZN); bf16_t* ona = (bf16_t*)(p.ws + WS_ONA);
  const int base = MC + b * 1024, qcol = wave * 16 + fr, qrow = base + r * 64 + qcol;
  int rs = r - 4; rs = rs < 0 ? 0 : (rs > 8 ? 8 : rs);
  int cs = qcol - 8; cs = cs < 0 ? 0 : (cs > 48 ? 48 : cs);
  __syncthreads();
  for (int e = tid; e < 465; e += NT) sRpb[e] = p.na_rpb[((size_t)l * 8 + h) * 465 + e] * LOG2E;
  bf16x8 qf[2];
#pragma unroll
  for (int ks = 0; ks < 2; ++ks) qf[ks] = *(const bf16x8*)(zn + (size_t)qrow * NZN + h * 64 + ks * 32 + fq * 8);
  f32x4 o[4]; for (int dt = 0; dt < 4; ++dt) o[dt] = (f32x4){0.f, 0.f, 0.f, 0.f};
  float mrun = -1e30f, lrun = 0.f;
  u32x4 pre[8];
#define NA_ISSUE(KT) do { const int kt_ = (KT); \
    if (kt_ < 8) { _Pragma("unroll") for (int i = 0; i < 2; ++i) { const int c = tid + 256 * i, key = c >> 3, part = c & 7; const size_t ro = (size_t)(base + (rs + kt_) * 64 + key) * NZN + h * 64 + part * 8; \
        pre[4 * i] = *(const u32x4*)(zn + ro + 512); pre[4 * i + 1] = *(const u32x4*)(zn + ro + 1024); } } \
    else { _Pragma("unroll") for (int i = 0; i < 2; ++i) { const int c = tid + 256 * i, key = c >> 3, part = c & 7; const size_t co = ((((size_t)b * 2 + l) * 8 + h) * 256 + (kt_ - 8) * 64 + key) * 64 + part * 8; \
        pre[4 * i] = *(const u32x4*)(p.cache_k + co); pre[4 * i + 1] = *(const u32x4*)(p.cache_k + co + 4); pre[4 * i + 2] = *(const u32x4*)(p.cache_v + co); pre[4 * i + 3] = *(const u32x4*)(p.cache_v + co + 4); } } } while (0)
  NA_ISSUE(0);
  for (int kt = 0; kt < 12; ++kt) {
    __syncthreads();
    if (kt < 8) {
#pragma unroll
      for (int i = 0; i < 2; ++i) { const int c = tid + 256 * i, key = c >> 3, part = c & 7; float vf[8]; unpack8(pre[4 * i + 1], vf);
        *(u32x4*)(sK + key * LDT + part * 8) = pre[4 * i];
#pragma unroll
        for (int e = 0; e < 8; ++e) sVt[(part * 8 + e) * LDT + key] = f2bf(vf[e]); }
    } else {
#pragma unroll
      for (int i = 0; i < 2; ++i) { const int c = tid + 256 * i, key = c >> 3, part = c & 7;
        const f32x4 k0 = __builtin_bit_cast(f32x4, pre[4 * i]), k1 = __builtin_bit_cast(f32x4, pre[4 * i + 1]), v0 = __builtin_bit_cast(f32x4, pre[4 * i + 2]), v1 = __builtin_bit_cast(f32x4, pre[4 * i + 3]);
        const float kf[8] = {k0[0], k0[1], k0[2], k0[3], k1[0], k1[1], k1[2], k1[3]}; const float vf[8] = {v0[0], v0[1], v0[2], v0[3], v1[0], v1[1], v1[2], v1[3]};
        put_kv(sK, sVt, key, part, kf, vf); }
    }
    __syncthreads();
    NA_ISSUE(kt < 11 ? kt + 1 : 11);
    f32x4 sacc[4]; qk_scores(sK, qf, sacc, fr, fq);
    if (kt < 8) { const int dr = rs + kt - r + 7;
#pragma unroll
      for (int nt = 0; nt < 4; ++nt)
#pragma unroll
        for (int j = 0; j < 4; ++j) { const int kc = nt * 16 + fq * 4 + j; const bool valid = kc >= cs && kc < cs + 16; int dc = kc - qcol; dc = dc < -15 ? -15 : (dc > 15 ? 15 : dc);
          sacc[nt][j] = valid ? sacc[nt][j] * (0.125f * LOG2E) + sRpb[dr * 31 + dc + 15] : -1e30f; }
    } else {
#pragma unroll
      for (int nt = 0; nt < 4; ++nt) sacc[nt] *= (0.125f * LOG2E);
    }
    softmax_tile(sacc, o, mrun, lrun);
    pv_accum(sVt, sacc, o, fr, fq);
  }
#undef NA_ISSUE
  lrun += __shfl_xor(lrun, 16); lrun += __shfl_xor(lrun, 32); const float inv = 1.f / lrun;
#pragma unroll
  for (int dt = 0; dt < 4; ++dt) { u32x2 ov; ov.x = pack2(o[dt][0] * inv, o[dt][1] * inv); ov.y = pack2(o[dt][2] * inv, o[dt][3] * inv); *(u32x2*)(ona + (size_t)qrow * LDO + h * 64 + dt * 16 + fq * 4) = ov; }
}

DI void rope8(const float (&own)[8], const float (&par)[8], int part, int n, float (&out)[8]) {
  const float pos = (float)((part >> 2) ? (n & 63) : (n >> 6));
  const bool isx2 = (part & 3) >= 2;
#pragma unroll
  for (int e = 0; e < 8; ++e) { const int i = (part & 1) * 8 + e; const float ang = pos * exp2f(-(float)i * 0.830482023721841f); const float sn = __sinf(ang), cs = __cosf(ang);
    out[e] = isx2 ? par[e] * sn + own[e] * cs : own[e] * cs - par[e] * sn; }
}

__device__ void ret_task(const P& p, int l, int seq, int h, int qb, char* smem) {
  bf16_t* sK = (bf16_t*)smem; bf16_t* sVt = sK + 64 * LDT; bf16_t* sQ = sVt + 64 * LDT;
  const int tid = tidx(), lane = tid & 63, wave = tid >> 6, fr = lane & 15, fq = lane >> 4;
  const bf16_t* zt = (const bf16_t*)(p.ws + WS_ZT); bf16_t* oret = (bf16_t*)(p.ws + WS_ORET);
  const bool lat = seq >= 32;
  const int row0 = lat ? MC + (seq - 32) * 1024 : seq * 256, T = lat ? 1024 : 256, nkt = T >> 6;
  const float xf = p.ret_decay[(l * 2 + 0) * 8 + h], xb = p.ret_decay[(l * 2 + 1) * 8 + h];
  const float lgf = -log1pf(__expf(-xf)) * LOG2E, lgb = -log1pf(__expf(-xb)) * LOG2E;
  __syncthreads();
#pragma unroll
  for (int i = 0; i < 2; ++i) { const int c = tid + 256 * i, qi = c >> 3, part = c & 7; const int n = qb * 64 + qi; const size_t ro = (size_t)(row0 + n) * LZT + h * 64;
    const u32x4 own = *(const u32x4*)(zt + ro + part * 8);
    if (lat) { const u32x4 par = *(const u32x4*)(zt + ro + (part ^ 2) * 8); float fo[8], fp[8], out[8]; unpack8(own, fo); unpack8(par, fp); rope8(fo, fp, part, n, out); *(u32x4*)(sQ + qi * LDT + part * 8) = pack8(out); }
    else *(u32x4*)(sQ + qi * LDT + part * 8) = own; }
  __syncthreads();
  const int qi = wave * 16 + fr, nq = qb * 64 + qi;
  bf16x8 qf[2];
#pragma unroll
  for (int ks = 0; ks < 2; ++ks) qf[ks] = *(const bf16x8*)(sQ + qi * LDT + ks * 32 + fq * 8);
  f32x4 o[4]; for (int dt = 0; dt < 4; ++dt) o[dt] = (f32x4){0.f, 0.f, 0.f, 0.f};
  u32x4 rk[2], rp[2], rv[2];
#define RET_ISSUE(KT) do { _Pragma("unroll") for (int i = 0; i < 2; ++i) { const int c = tid + 256 * i, key = c >> 3, part = c & 7; const size_t ro = (size_t)(row0 + (KT) * 64 + key) * LZT + h * 64; \
    rk[i] = *(const u32x4*)(zt + ro + 512 + part * 8); rp[i] = *(const u32x4*)(zt + ro + 512 + (part ^ 2) * 8); rv[i] = *(const u32x4*)(zt + ro + 1024 + part * 8); } } while (0)
  RET_ISSUE(0);
  for (int kt = 0; kt < nkt; ++kt) {
    __syncthreads();
#pragma unroll
    for (int i = 0; i < 2; ++i) { const int c = tid + 256 * i, key = c >> 3, part = c & 7; const int n = kt * 64 + key;
      float kf[8], vf[8]; unpack8(rk[i], kf); unpack8(rv[i], vf);
      if (lat) { float fp[8], out[8]; unpack8(rp[i], fp); rope8(kf, fp, part, n, out);
#pragma unroll
        for (int e = 0; e < 8; ++e) kf[e] = out[e]; }
#pragma unroll
      for (int e = 0; e < 8; ++e) kf[e] *= 0.125f;
      put_kv(sK, sVt, key, part, kf, vf); }
    __syncthreads();
    RET_ISSUE(kt + 1 < nkt ? kt + 1 : kt);
    f32x4 sacc[4]; qk_scores(sK, qf, sacc, fr, fq);
#pragma unroll
    for (int nt = 0; nt < 4; ++nt)
#pragma unroll
      for (int j = 0; j < 4; ++j) { const int mk = kt * 64 + nt * 16 + fq * 4 + j; const int df = nq - mk;
        const float dec = df > 0 ? exp2f(lgf * (float)df) : (df < 0 ? exp2f(lgb * (float)(-df)) : 2.f); sacc[nt][j] *= dec; }
    pv_accum(sVt, sacc, o, fr, fq);
  }
#undef RET_ISSUE
  if (lat) {
    for (int dir = 0; dir < 2; ++dir) {
      __syncthreads();
      const float* s0 = p.state_ret + ((((size_t)(seq - 32) * 2 + l) * 2 + dir) * 8 + h) * 4096;
#pragma unroll
      for (int i = 0; i < 2; ++i) { const int c = tid + 256 * i, dk = c >> 3, part = c & 7; const float4 a = *(const float4*)(s0 + dk * 64 + part * 8), bq = *(const float4*)(s0 + dk * 64 + part * 8 + 4);
        const float vf[8] = {a.x, a.y, a.z, a.w, bq.x, bq.y, bq.z, bq.w};
#pragma unroll
        for (int e = 0; e < 8; ++e) sVt[(part * 8 + e) * LDT + dk] = f2bf(vf[e]); }
      __syncthreads();
      const float xi = dir == 0 ? exp2f(lgf * (float)(nq + 1)) : exp2f(lgb * (float)(T - nq));
      f32x4 pacc[4];
#pragma unroll
      for (int s = 0; s < 2; ++s)
#pragma unroll
        for (int hh = 0; hh < 2; ++hh)
#pragma unroll
          for (int j = 0; j < 4; ++j) pacc[2 * s + hh][j] = xi * bf2f(sQ[qi * LDT + 32 * s + 16 * hh + 4 * fq + j]);
      pv_accum(sVt, pacc, o, fr, fq);
    }
  }
  float s1 = 0.f;
#pragma unroll
  for (int dt = 0; dt < 4; ++dt)
#pragma unroll
    for (int j = 0; j < 4; ++j) s1 += o[dt][j];
  s1 += __shfl_xor(s1, 16); s1 += __shfl_xor(s1, 32); const float mu = s1 * (1.f / 64.f);
  float s2 = 0.f;
#pragma unroll
  for (int dt = 0; dt < 4; ++dt)
#pragma unroll
    for (int j = 0; j < 4; ++j) { const float dlt = o[dt][j] - mu; s2 += dlt * dlt; }
  s2 += __shfl_xor(s2, 16); s2 += __shfl_xor(s2, 32); const float rstd = rsqrtf(s2 * (1.f / 64.f) + 1e-5f);
  const size_t qrow = (size_t)(row0 + nq);
#pragma unroll
  for (int dt = 0; dt < 4; ++dt) { const int dv = h * 64 + dt * 16 + fq * 4; const u32x2 gr = *(const u32x2*)(zt + qrow * LZT + 1536 + dv); const float4 gn = *(const float4*)(p.ret_gn + l * 512 + dv);
    const float g0 = bflo(gr.x), g1 = bfhi(gr.x), g2 = bflo(gr.y), g3 = bfhi(gr.y);
    u32x2 ov; ov.x = pack2((o[dt][0] - mu) * rstd * gn.x * g0 * sigmoidf_(g0), (o[dt][1] - mu) * rstd * gn.y * g1 * sigmoidf_(g1));
    ov.y = pack2((o[dt][2] - mu) * rstd * gn.z * g2 * sigmoidf_(g2), (o[dt][3] - mu) * rstd * gn.w * g3 * sigmoidf_(g3));
    *(u32x2*)(oret + qrow * LDO + dv) = ov; }
}

__device__ void retstate_task(const P& p, int l, int b, int h, char* smem) {
  float* sKf = (float*)smem; float* sKb = sKf + 64 * 64; float* sV = sKb + 64 * 64;
  const int tid = tidx(), dk = tid >> 2, dq = tid & 3;
  const bf16_t* zt = (const bf16_t*)(p.ws + WS_ZT);
  const float xf = p.ret_decay[(l * 2 + 0) * 8 + h], xb = p.ret_decay[(l * 2 + 1) * 8 + h];
  const float lgf = -log1pf(__expf(-xf)) * LOG2E, lgb = -log1pf(__expf(-xb)) * LOG2E;
  float af[16], ab[16];
#pragma unroll
  for (int i = 0; i < 16; ++i) { af[i] = 0.f; ab[i] = 0.f; }
  for (int kt = 0; kt < 4; ++kt) {
    __syncthreads();
#pragma unroll
    for (int i = 0; i < 2; ++i) { const int c = tid + 256 * i, key = c >> 3, part = c & 7, m = kt * 64 + key; const size_t ro = (size_t)(b * 256 + m) * LZT + h * 64 + part * 8;
      float kf[8], vf[8]; unpack8(*(const u32x4*)(zt + ro + 512), kf); unpack8(*(const u32x4*)(zt + ro + 1024), vf);
      const float wf = 0.125f * exp2f(lgf * (float)(255 - m)), wb = 0.125f * exp2f(lgb * (float)m);
#pragma unroll
      for (int e = 0; e < 8; ++e) { sKf[key * 64 + part * 8 + e] = kf[e] * wf; sKb[key * 64 + part * 8 + e] = kf[e] * wb; sV[key * 64 + part * 8 + e] = vf[e]; } }
    __syncthreads();
    for (int m = 0; m < 64; ++m) { const float kf = sKf[m * 64 + dk], kb = sKb[m * 64 + dk];
#pragma unroll
      for (int i = 0; i < 4; ++i) { const f32x4 vv = *(const f32x4*)(sV + m * 64 + dq * 16 + i * 4);
#pragma unroll
        for (int j = 0; j < 4; ++j) { af[i * 4 + j] += kf * vv[j]; ab[i * 4 + j] += kb * vv[j]; } } }
  }
  float* of = p.out + O_RT + ((((size_t)b * 2 + l) * 2 + 0) * 8 + h) * 4096 + dk * 64 + dq * 16; float* ob = of + 8 * 4096;
#pragma unroll
  for (int i = 0; i < 16; ++i) { of[i] = af[i]; ob[i] = ab[i]; }
}

constexpr int Q_SCAN_L = 64, Q_SCAN_C = 512, Q_RET_L = 512, Q_NA = 512, Q_DENSE = 1024, Q_RET_C = 1024, Q_RST = 256;
constexpr int Q_TOTAL = Q_SCAN_L + Q_SCAN_C + Q_RET_L + Q_NA + Q_DENSE + Q_RET_C + Q_RST;
template <int QMASK> __device__ void phase_mixers(const P& p, int l, char* smem, int rep = 0) {
  __shared__ int s_task;
  int* ctr = (int*)(p.ws + WS_CTRL) + 64 * (l + 1) + 4 * rep;
  if (QMASK & 1) {
    __shared__ int s_prim;
    if (tidx() == 0) { const unsigned cu = ((unsigned)__builtin_amdgcn_s_getreg((7 << 11) | (8 << 6) | 4) & 0xffu) | (xb_xcc_id() << 8);
      s_prim = atomicAdd((int*)(p.ws + WS_CUF) + l * 2048 + (int)(cu & 2047u), 1) == 0 ? 1 : 0; }
    for (;;) {
      __syncthreads();
      if (tidx() == 0) { int tk = -1;
        if (s_prim) { const int t = atomicAdd(ctr, 1); if (t < Q_SCAN_L) tk = t; else s_prim = 0; }
        if (tk < 0) { const int t = atomicAdd(ctr + 1, 1); if (t < Q_SCAN_C) tk = Q_SCAN_L + t; }
        if (tk < 0) { const int t = atomicAdd(ctr, 1); if (t < Q_SCAN_L) tk = t; }
        s_task = tk < 0 ? Q_SCAN_L + Q_SCAN_C : tk; }
      __syncthreads();
      const int tk = s_task;
      if (tk >= Q_SCAN_L + Q_SCAN_C) break;
      const bool lat = tk < Q_SCAN_L; const int t2 = lat ? tk : tk - Q_SCAN_L;
      scan_task(p, l, (lat ? 32 : 0) + (t2 >> 4), (t2 >> 1) & 7, t2 & 1, smem);
    }
  }
  if (QMASK & 2) for (;;) {
    __syncthreads();
    if (tidx() == 0) s_task = atomicAdd(ctr + 16, 1);
    __syncthreads();
    const int tk = s_task;
    if (tk >= Q_RET_L + Q_RET_C) break;
    if (tk < Q_RET_L) ret_task(p, l, 32 + (tk >> 7), (tk >> 4) & 7, tk & 15, smem);
    else { const int t2 = tk - Q_RET_L; ret_task(p, l, t2 >> 5, (t2 >> 2) & 7, t2 & 3, smem); }
  }
  if (QMASK & 4) for (;;) {
    __syncthreads();
    if (tidx() == 0) s_task = atomicAdd(ctr + 32, 1);
    __syncthreads();
    int tk = s_task;
    if (tk >= Q_NA + Q_DENSE + Q_RST) break;
    if (tk < Q_NA) { na_task(p, l, tk >> 7, (tk >> 4) & 7, tk & 15, smem); continue; } tk -= Q_NA;
    if (tk < Q_DENSE) { dense_task(p, tk >> 5, (tk >> 2) & 7, tk & 3, smem); continue; } tk -= Q_DENSE;
    retstate_task(p, l, tk >> 3, tk & 7, smem);
  }
}

__device__ void phase_rwkv_post(const P& p, int l, char* smem) {
  const bf16_t* zr = (const bf16_t*)(p.ws + WS_ZR); const float* yf = (const float*)(p.ws + WS_Y); const float* yb = yf + (size_t)MT * 512; bf16_t* oa = (bf16_t*)(p.ws + WS_OA);
  const bf16_t* Gt = (const bf16_t*)(p.ws + WS_WG);
  const int tid = tidx(), lane = tid & 63, wave = tid >> 6, wr = wave >> 1, wc = wave & 1, fr = lane & 15, fq = lane >> 4;
  TileIter ti; int mt, nt; ti.init(96, 4);
  while (ti.next(mt, nt)) {
    const int row0 = mt * 128, n0 = nt * 128;
    f32x4 acc[4][4]; zero_acc<4>(acc);
    TileSrc s{zr + 1664, NZR, row0, Gt, LDG, n0, n0 + 64, 128}; gemm_tile<4>(acc, s, smem);
    const int cb = n0 + wc * 64 + fq * 4;
#pragma unroll
    for (int m = 0; m < 4; ++m) { const size_t row = (size_t)(row0 + wr * 64 + m * 16 + fr);
      f32x4 y[4]; float s1 = 0.f, rk = 0.f; f32x4 vv[4];
#pragma unroll
      for (int n = 0; n < 4; ++n) { const int c = cb + n * 16; y[n] = *(const f32x4*)(yf + row * 512 + c) + *(const f32x4*)(yb + row * 512 + c); s1 += y[n][0] + y[n][1] + y[n][2] + y[n][3];
        const u32x2 rr = *(const u32x2*)(zr + row * NZR + c), kk = *(const u32x2*)(zr + row * NZR + 512 + c), v2 = *(const u32x2*)(zr + row * NZR + 1024 + c); const f32x4 rkw = *(const f32x4*)(p.rwkv_r_k + l * 512 + c);
        rk += bflo(rr.x) * bflo(kk.x) * rkw[0] + bfhi(rr.x) * bfhi(kk.x) * rkw[1] + bflo(rr.y) * bflo(kk.y) * rkw[2] + bfhi(rr.y) * bfhi(kk.y) * rkw[3];
        vv[n] = (f32x4){bflo(v2.x), bfhi(v2.x), bflo(v2.y), bfhi(v2.y)}; }
      s1 += __shfl_xor(s1, 16); s1 += __shfl_xor(s1, 32); rk += __shfl_xor(rk, 16); rk += __shfl_xor(rk, 32);
      const float mu = s1 * (1.f / 64.f); float s2 = 0.f;
#pragma unroll
      for (int n = 0; n < 4; ++n)
#pragma unroll
        for (int j = 0; j < 4; ++j) { const float dl = y[n][j] - mu; s2 += dl * dl; }
      s2 += __shfl_xor(s2, 16); s2 += __shfl_xor(s2, 32); const float rstd = rsqrtf(s2 * (1.f / 64.f) + 64e-5f);
#pragma unroll
      for (int n = 0; n < 4; ++n) { const int c = cb + n * 16; const f32x4 lg = *(const f32x4*)(p.rwkv_ln_g + l * 512 + c), lb = *(const f32x4*)(p.rwkv_ln_b + l * 512 + c);
        float o[4];
#pragma unroll
        for (int j = 0; j < 4; ++j) o[j] = ((y[n][j] - mu) * rstd * lg[j] + lb[j] + rk * vv[n][j]) * acc[m][n][j];
        u32x2 ov; ov.x = pack2(o[0], o[1]); ov.y = pack2(o[2], o[3]); *(u32x2*)(oa + row * LDO + c) = ov; }
    }
  }
}

DI void convert_layer_a(const P& p, int l, char* smem) {
  convert_T(p.w_in + (size_t)l * D * INC, D, INC, (bf16_t*)(p.ws + WS_WIN), LDH, smem);
  convert_T(p.w_o_rwkv + (size_t)l * 512 * D, 512, D, (bf16_t*)(p.ws + WS_WO3), LDO, smem);
  convert_T(p.w_o_na + (size_t)l * 512 * D, 512, D, (bf16_t*)(p.ws + WS_WO3) + (size_t)1024 * LDO, LDO, smem);
  convert_T(p.w_o_ret + (size_t)l * 512 * D, 512, D, (bf16_t*)(p.ws + WS_WO3) + (size_t)2 * 1024 * LDO, LDO, smem);
  convert_T(p.w_out + (size_t)l * D * D, D, D, (bf16_t*)(p.ws + WS_WOUT), LDH, smem);
  convert_T(p.rwkv_g_up + (size_t)l * 128 * 512, 128, 512, (bf16_t*)(p.ws + WS_WG), LDG, smem);
}
DI void convert_layer_b(const P& p, int l, char* smem) {
  convert_T(p.ffn_up + (size_t)l * D * 2 * FF, D, 2 * FF, (bf16_t*)(p.ws + WS_WUP), LDH, smem);
  convert_T(p.ffn_down + (size_t)l * FF * D, FF, D, (bf16_t*)(p.ws + WS_WDN), FF, smem);
}

template <int PH> DI void run_phase(const P& p, int l, char* smem) {
  const float* mod = (const float*)(p.ws + WS_MOD);
  float* xbuf = p.out;
  if (PH == 0) { ada_phase(p, smem); convert_layer_a(p, 0, smem); }
  else if (PH == 1) { norm_phase(p, nullptr, nullptr, nullptr, nullptr, 0, nullptr, p.norm_mix_pre, mod, 0, (bf16_t*)(p.ws + WS_H)); }
  else if (PH == 2) phase_win(p, l, smem);
  else if (PH == 4) phase_mixers<7>(p, l, smem);
  else if (PH == 5) phase_rwkv_post(p, l, smem);
  else if (PH == 6) phase_merge(p, smem);
  else if (PH == 7) { phase_gemm_f32((const bf16_t*)(p.ws + WS_MERGED), LDH, D, (const bf16_t*)(p.ws + WS_WOUT), LDH, (float*)(p.ws + WS_U), smem); }
  else if (PH == 8) { convert_layer_b(p, l, smem);
    norm_phase(p, l == 0 ? nullptr : xbuf, (const float*)(p.ws + WS_U), p.norm_mix_post + l * D, mod + (size_t)l * 5 * 6144, 2, xbuf, p.norm_ffn_pre + l * D, mod + (size_t)l * 5 * 6144, 3, (bf16_t*)(p.ws + WS_H)); }
  else if (PH == 9) phase_ffn_up(p, l, smem);
  else if (PH == 11) { phase_gemm_f32((const bf16_t*)(p.ws + WS_HID), FF, FF, (const bf16_t*)(p.ws + WS_WDN), FF, (float*)(p.ws + WS_F), smem); }
  else if (PH == 12) {
    if (l == 0) { norm_phase(p, xbuf, (const float*)(p.ws + WS_F), p.norm_ffn_post, mod, 5, xbuf, p.norm_mix_pre + D, mod + (size_t)5 * 6144, 0, (bf16_t*)(p.ws + WS_H)); convert_layer_a(p, 1, smem); }
    else norm_phase(p, xbuf, (const float*)(p.ws + WS_F), p.norm_ffn_post + D, mod + (size_t)5 * 6144, 5, xbuf, nullptr, nullptr, 0, nullptr);
  }
}

#if MEGA
__global__ void __launch_bounds__(NT, 2) mega_kernel(P p) {
  extern __shared__ __attribute__((aligned(16))) char smem[];
  __shared__ u32x4 xb_words;
  cg::grid_group grid = cg::this_grid();
  if (tidx() == 0) xb_words = (u32x4){0u, 0u, 0u, 0u};
  __syncthreads();
  const XcdBarrier xb = xcd_barrier_post((unsigned*)(p.ws + WS_BAR), (volatile LAS unsigned*)&xb_words);
#define GSYNC() xcd_barrier(xb)
  run_phase<0>(p, 0, smem); grid.sync();
  run_phase<1>(p, 0, smem); GSYNC();
#pragma unroll 1
  for (int l = 0; l < 2; ++l) {
    run_phase<2>(p, l, smem); GSYNC();
    if (PROBE_MASK & 1) { run_phase<2>(p, l, smem); GSYNC(); }
    run_phase<4>(p, l, smem); GSYNC();
    if (PROBE_MASK & 2) { phase_mixers<1>(p, l, smem, 1); GSYNC(); }
    if (PROBE_MASK & 256) { phase_mixers<2>(p, l, smem, 1); GSYNC(); }
    if (PROBE_MASK & 512) { phase_mixers<4>(p, l, smem, 1); GSYNC(); }
    run_phase<5>(p, l, smem); GSYNC();
    if (PROBE_MASK & 4) { run_phase<5>(p, l, smem); GSYNC(); }
    run_phase<6>(p, l, smem); GSYNC();
    if (PROBE_MASK & 8) { run_phase<6>(p, l, smem); GSYNC(); }
    run_phase<7>(p, l, smem); GSYNC();
    if (PROBE_MASK & 16) { run_phase<7>(p, l, smem); GSYNC(); }
    run_phase<8>(p, l, smem); GSYNC();
    run_phase<9>(p, l, smem); GSYNC();
    if (PROBE_MASK & 32) { run_phase<9>(p, l, smem); GSYNC(); }
    run_phase<11>(p, l, smem); GSYNC();
    if (PROBE_MASK & 64) { run_phase<11>(p, l, smem); GSYNC(); }
    if (PROBE_MASK & 128) { convert_layer_a(p, l, smem); GSYNC(); convert_layer_b(p, l, smem); GSYNC(); }
    run_phase<12>(p, l, smem); if (l == 0) GSYNC();
  }
#undef GSYNC
}
#else
template <int PH> __global__ void __launch_bounds__(NT, 2) phase_kernel(P p, int l) {
  extern __shared__ __attribute__((aligned(16))) char smem[];
  run_phase<PH>(p, l, smem);
}
#endif

extern "C" void kernel_launch(void* const* d_in, const int* in_sizes, int n_in, void* d_out, int out_size, void* d_ws, size_t ws_size, hipStream_t stream) {
  if (ws_size < WS_END || n_in < 36) { fprintf(stderr, "workspace too small: %zu < %zu\n", ws_size, (size_t)WS_END); return; }
  P p{};
  const float** pp = (const float**)&p;
  for (int i = 0; i < 36; ++i) pp[i] = (const float*)d_in[i];
  p.out = (float*)d_out; p.ws = (char*)d_ws;
  hipMemsetAsync(d_ws, 0, WS_WIN, stream);
#if MEGA
  static int grid_blocks = 0;
  if (!grid_blocks) {
    int dev = 0, cus = 0, per_cu = 0; hipGetDevice(&dev);
    hipDeviceGetAttribute(&cus, hipDeviceAttributeMultiprocessorCount, dev);
    hipFuncSetAttribute((const void*)mega_kernel, hipFuncAttributeMaxDynamicSharedMemorySize, SMEM_BYTES);
    hipOccupancyMaxActiveBlocksPerMultiprocessor(&per_cu, mega_kernel, NT, SMEM_BYTES);
    if (per_cu > 2) per_cu = 2;
    grid_blocks = cus * per_cu;
  }
  void* args[] = {&p};
  hipError_t e = hipLaunchCooperativeKernel((void*)mega_kernel, dim3(grid_blocks), dim3(NT), args, SMEM_BYTES, stream);
  if (e != hipSuccess) fprintf(stderr, "cooperative launch failed: %s (grid %d)\n", hipGetErrorString(e), grid_blocks);
#else
  const int G = 512;
#define LAUNCH(PH, L) do { hipFuncSetAttribute((const void*)phase_kernel<PH>, hipFuncAttributeMaxDynamicSharedMemorySize, SMEM_BYTES); phase_kernel<PH><<<G, NT, SMEM_BYTES, stream>>>(p, L); } while (0)
  LAUNCH(0, 0); LAUNCH(1, 0);
  for (int l = 0; l < 2; ++l) { LAUNCH(2, l); LAUNCH(4, l); LAUNCH(5, l); LAUNCH(6, l); LAUNCH(7, l); LAUNCH(8, l); LAUNCH(9, l); LAUNCH(11, l); LAUNCH(12, l); }
#endif
}
```

```cpp
#include <hip/hip_runtime.h>
#include <hip/hip_cooperative_groups.h>
#include <cstdio>
namespace cg = cooperative_groups;

#ifndef MEGA
#define MEGA 1
#endif
#define PROBE_MASK 0

typedef unsigned short bf16_t;
typedef short bf16x8 __attribute__((ext_vector_type(8)));
typedef short bf16x4 __attribute__((ext_vector_type(4)));
typedef float f32x4 __attribute__((ext_vector_type(4)));
typedef float f32x2 __attribute__((ext_vector_type(2)));
typedef unsigned u32x4 __attribute__((ext_vector_type(4)));
typedef unsigned u32x2 __attribute__((ext_vector_type(2)));
#define DI __device__ __forceinline__
#define MFMA16(a, b, c) __builtin_amdgcn_mfma_f32_16x16x32_bf16((a), (b), (c), 0, 0, 0)

constexpr int NT = 256;
constexpr int D = 1024, MC = 8192, ML = 4096, MT = 12288;
constexpr int NZR = 1792, NZN = 1536, NZT = 2048, INC = 8448, FF = 2816;
constexpr int LDH = 1088, LDO = 576, LZT = 2112, LDG = 136;
constexpr int LDT = 72;
constexpr int SMEM_BYTES = 2 * 256 * LDT * 2;
constexpr size_t O_K = 12582912, O_V = 20971520, O_RW = 29360128, O_RT = 33554432;
constexpr size_t WS_CTRL = 0;
constexpr size_t WS_MOD = 4096;
constexpr size_t WS_BAR = 262144;
constexpr size_t WS_CUF = 278528;
constexpr size_t WS_WG = 294912;
constexpr size_t WS_WIN = 434176;
constexpr size_t WS_WUP = WS_WIN;
constexpr size_t WS_WDN = WS_WIN + (size_t)5632 * LDH * 2;
constexpr size_t WS_WO3 = WS_WIN + (size_t)INC * LDH * 2;
constexpr size_t WS_WOUT = WS_WO3 + (size_t)3 * 1024 * LDO * 2;
constexpr size_t WS_H = WS_WOUT + (size_t)1024 * LDH * 2;
constexpr size_t WS_Z = WS_H + (size_t)MT * LDH * 2;
constexpr size_t WS_ZR = WS_Z;
constexpr size_t WS_ZN = WS_ZR + (size_t)MT * NZR * 2;
constexpr size_t WS_ZT = WS_ZN + (size_t)MT * NZN * 2;
constexpr size_t WS_MERGED = WS_ZR;
constexpr size_t WS_OA = WS_ZN;
constexpr size_t WS_U = WS_ZT;
constexpr size_t WS_HID = WS_Z;
constexpr size_t WS_F = WS_ZT;
constexpr size_t WS_Y = WS_ZT + (size_t)MT * LZT * 2;
constexpr size_t WS_ONA = WS_Y + (size_t)2 * MT * 512 * 4;
constexpr size_t WS_ORET = WS_ONA + (size_t)MT * LDO * 2;
constexpr size_t WS_END = WS_ORET + (size_t)MT * LDO * 2;

struct P {
  const float *x_prompt, *x_sample, *cache_k, *cache_v, *state_rwkv, *state_ret, *c, *c_ctx, *ada_w, *ada_b;
  const float *norm_mix_pre, *norm_mix_post, *norm_ffn_pre, *norm_ffn_post, *w_in, *rwkv_conv, *rwkv_w0, *rwkv_w_up, *rwkv_a0, *rwkv_a_up, *rwkv_g_up;
  const float *rwkv_k_k, *rwkv_k_a, *rwkv_r_k, *rwkv_ln_g, *rwkv_ln_b, *na_rpb, *ret_decay, *ret_gn, *w_o_rwkv, *w_o_na, *w_o_ret, *w_out, *ffn_up, *ffn_conv, *ffn_down;
  float* out; char* ws;
};

DI int threadIdx_x_raw() { return (int)__builtin_amdgcn_workitem_id_x(); }
DI int tidx() { int t = threadIdx_x_raw(); asm volatile("" : "+v"(t)); return t; }
DI bf16_t f2bf(float x) { unsigned u = __float_as_uint(x); u += 0x7fffu + ((u >> 16) & 1u); return (bf16_t)(u >> 16); }
DI float bf2f(bf16_t b) { return __uint_as_float(((unsigned)b) << 16); }
DI unsigned pack2(float a, float b) { return (unsigned)f2bf(a) | ((unsigned)f2bf(b) << 16); }
DI float bflo(unsigned u) { return __uint_as_float(u << 16); }
DI float bfhi(unsigned u) { return __uint_as_float(u & 0xffff0000u); }
DI void unpack8(const u32x4 r, float (&f)[8]) { f[0] = bflo(r[0]); f[1] = bfhi(r[0]); f[2] = bflo(r[1]); f[3] = bfhi(r[1]); f[4] = bflo(r[2]); f[5] = bfhi(r[2]); f[6] = bflo(r[3]); f[7] = bfhi(r[3]); }
DI u32x4 pack8(const float (&f)[8]) { u32x4 r; r[0] = pack2(f[0], f[1]); r[1] = pack2(f[2], f[3]); r[2] = pack2(f[4], f[5]); r[3] = pack2(f[6], f[7]); return r; }
DI float sigmoidf_(float x) { return 1.f / (1.f + __expf(-x)); }
DI float wave_sum(float v) { for (int o = 32; o > 0; o >>= 1) v += __shfl_xor(v, o); return v; }
DI void tokinfo(int m, int& t, int& T, int& mi) { if (m < MC) { t = m & 255; T = 256; mi = 0; } else { int q = m - MC; t = q & 1023; T = 1024; mi = 1 + (q >> 10); } }

#define XB_TMO      128
#define XB_XCNT(j)  (256  + 64 * (j))
#define XB_XSUB(j)  (1280 + 64 * (j))
#define XB_XGEN(j)  (2304 + 64 * (j))
#define XB_TOP      3328
#define XB_TOPGEN   3392
#define XB_SPIN_CAP (1u << 20)
#define LAS __attribute__((address_space(3)))
DI unsigned xb_ld(unsigned* p) { return __hip_atomic_load(p, __ATOMIC_RELAXED, __HIP_MEMORY_SCOPE_AGENT); }
DI unsigned xb_add(unsigned* p, unsigned v) { return __hip_atomic_fetch_add(p, v, __ATOMIC_RELAXED, __HIP_MEMORY_SCOPE_AGENT); }
DI unsigned xb_xcc_id() { return (unsigned)__builtin_amdgcn_s_getreg((3 << 11) | 20) & 0xFu; }
#define XB_SPIN(cond, bar) do { unsigned _sp = 0; while (cond) { __builtin_amdgcn_s_sleep(1); \
    if ((++_sp & 255u) == 0u) { if (xb_ld(&(bar)[XB_TMO])) break; if (_sp > XB_SPIN_CAP) { atomicAdd(&(bar)[XB_TMO], 1u); break; } } } } while (0)
struct XcdBarrier { unsigned* bar; unsigned x; volatile LAS unsigned* st; };
DI XcdBarrier xcd_barrier_post(unsigned* bar, volatile LAS unsigned* st) {
  XcdBarrier b; b.bar = bar; b.x = xb_xcc_id(); b.st = st;
  if (tidx() == 0) (void)xb_add(&bar[XB_XCNT(b.x)], 1u);
  return b;
}
DI void xcd_barrier_complete(unsigned* bar, unsigned x, unsigned& nloc, unsigned& nx) {
  const unsigned G = gridDim.x * gridDim.y * gridDim.z;
  unsigned sum, cnt, mine, sp = 0u;
  for (;;) {
    sum = 0u; cnt = 0u; mine = 0u;
#pragma unroll
    for (unsigned j = 0; j < 16; ++j) { const unsigned c = xb_ld(&bar[XB_XCNT(j)]); sum += c; cnt += (c > 0u) ? 1u : 0u; mine = (j == x) ? c : mine; }
    if (sum == G) break;
    __builtin_amdgcn_s_sleep(1);
    if ((++sp & 255u) == 0u) { if (xb_ld(&bar[XB_TMO])) break; if (sp > XB_SPIN_CAP) { atomicAdd(&bar[XB_TMO], 1u); break; } }
  }
  nloc = mine > 0u ? mine : 1u; nx = cnt > 0u ? cnt : 1u;
}
DI void xcd_barrier(const XcdBarrier& b) {
  asm volatile("s_waitcnt vmcnt(0)" ::: "memory");
  __syncthreads();
  if (tidx() == 0) {
    unsigned* bar = b.bar;
    __builtin_amdgcn_s_waitcnt(0);
    unsigned nloc = b.st[0], nx = b.st[1];
    if (nloc == 0u) { xcd_barrier_complete(bar, b.x, nloc, nx); b.st[0] = nloc; b.st[1] = nx; }
    const unsigned old = xb_add(&bar[XB_XSUB(b.x)], 1u);
    const unsigned gen = old / nloc;
    if (old + 1u == (gen + 1u) * nloc) {
      __builtin_amdgcn_fence(__ATOMIC_RELEASE, "agent");
      asm volatile("s_waitcnt vmcnt(0)" ::: "memory");
      const unsigned og = xb_add(&bar[XB_TOP], 1u);
      const unsigned tg = og / nx;
      if (og + 1u == (tg + 1u) * nx) xb_add(&bar[XB_TOPGEN], 1u);
      else XB_SPIN(xb_ld(&bar[XB_TOPGEN]) == tg, bar);
      __builtin_amdgcn_fence(__ATOMIC_ACQUIRE, "agent");
      xb_add(&bar[XB_XGEN(b.x)], 1u);
      asm volatile("s_waitcnt vmcnt(0)" ::: "memory");
    } else {
      XB_SPIN(xb_ld(&bar[XB_XGEN(b.x)]) == gen, bar);
      __builtin_amdgcn_fence(__ATOMIC_ACQUIRE, "agent");
      asm volatile("s_waitcnt vmcnt(0)" ::: "memory");
    }
  }
  __syncthreads();
}

__device__ void convert_T(const float* __restrict__ W, int K, int N, bf16_t* __restrict__ Wt, int ldt, char* smem) {
  float* t = (float*)smem;
  const int tid = tidx(), ntn = N >> 6, nitems = (K >> 6) * ntn;
  for (int it = blockIdx.x; it < nitems; it += gridDim.x) {
    const int k0 = (it / ntn) << 6, n0 = (it % ntn) << 6;
    __syncthreads();
#pragma unroll
    for (int i = 0; i < 4; ++i) { const int k = (tid >> 4) + 16 * i, c4 = (tid & 15) * 4;
      const float4 v = *(const float4*)(W + (size_t)(k0 + k) * N + n0 + c4);
      t[k * 65 + c4] = v.x; t[k * 65 + c4 + 1] = v.y; t[k * 65 + c4 + 2] = v.z; t[k * 65 + c4 + 3] = v.w; }
    __syncthreads();
#pragma unroll
    for (int i = 0; i < 2; ++i) { const int c = tid + 256 * i, n = c >> 3, kc = c & 7; float f[8];
#pragma unroll
      for (int e = 0; e < 8; ++e) f[e] = t[(kc * 8 + e) * 65 + n];
      *(u32x4*)(Wt + (size_t)(n0 + n) * ldt + k0 + kc * 8) = pack8(f); }
  }
}

__device__ void ada_phase(const P& p, char* smem) {
  float* sc = (float*)smem;
  float* red = sc + 640;
  float* mod = (float*)(p.ws + WS_MOD);
  const int tid = tidx(), kq = tid >> 5, cq = tid & 31;
  for (int it = blockIdx.x; it < 2 * 48 * 8; it += gridDim.x) {
    const int l = it / 384, rem = it % 384, nb = rem >> 3, ks = rem & 7;
    const int n0 = nb * 128, k0 = ks * 128;
    __syncthreads();
    for (int e = tid; e < 640; e += NT) { const int i = e >> 7, k = e & 127; const float v = (i == 0) ? p.c_ctx[k0 + k] : p.c[(i - 1) * D + k0 + k]; sc[e] = v * sigmoidf_(v); }
    __syncthreads();
    float acc[5][4];
#pragma unroll
    for (int i = 0; i < 5; ++i)
#pragma unroll
      for (int j = 0; j < 4; ++j) acc[i][j] = 0.f;
    const float* wp = p.ada_w + ((size_t)l * D + k0 + kq * 16) * 6144 + n0 + cq * 4;
#pragma unroll 4
    for (int kk = 0; kk < 16; ++kk) { const float4 w = *(const float4*)(wp + (size_t)kk * 6144);
#pragma unroll
      for (int i = 0; i < 5; ++i) { const float s = sc[i * 128 + kq * 16 + kk]; acc[i][0] += s * w.x; acc[i][1] += s * w.y; acc[i][2] += s * w.z; acc[i][3] += s * w.w; } }
#pragma unroll
    for (int i = 0; i < 5; ++i)
#pragma unroll
      for (int j = 0; j < 4; ++j) red[(kq * 5 + i) * 128 + cq * 4 + j] = acc[i][j];
    __syncthreads();
    for (int e = tid; e < 640; e += NT) { const int i = e >> 7, n = e & 127; float s = 0.f;
#pragma unroll
      for (int q = 0; q < 8; ++q) s += red[(q * 5 + i) * 128 + n];
      if (ks == 0) s += p.ada_b[l * 6144 + n0 + n];
      atomicAdd(mod + ((size_t)l * 5 + i) * 6144 + n0 + n, s); }
  }
}

__device__ void norm_phase(const P& p, const float* xin  , const float* u, const float* gpost, const float* modU, int gate_idx,
                           float* xout, const float* gpre, const float* modN, int shift_idx, bf16_t* hout) {
  const int lane = tidx() & 63, wave = tidx() >> 6, nw = NT / 64;
  for (int m = blockIdx.x * nw + wave; m < MT; m += gridDim.x * nw) {
    int t, T, mi; tokinfo(m, t, T, mi);
    const float* xr = xin ? xin + (size_t)m * D : (m < MC ? p.x_prompt + (size_t)m * D : p.x_sample + (size_t)(m - MC) * D);
    float4 x[4];
#pragma unroll
    for (int i = 0; i < 4; ++i) x[i] = *(const float4*)(xr + i * 256 + lane * 4);
    if (u) {
      float4 uu[4]; float ss = 0.f;
#pragma unroll
      for (int i = 0; i < 4; ++i) { uu[i] = *(const float4*)(u + (size_t)m * D + i * 256 + lane * 4); ss += uu[i].x * uu[i].x + uu[i].y * uu[i].y + uu[i].z * uu[i].z + uu[i].w * uu[i].w; }
      ss = wave_sum(ss); const float rs = rsqrtf(ss * (1.f / D) + 1e-6f);
#pragma unroll
      for (int i = 0; i < 4; ++i) { const int c = i * 256 + lane * 4; const float4 g = *(const float4*)(gpost + c); const float4 ga = *(const float4*)(modU + ((size_t)mi * 6 + gate_idx) * D + c);
        x[i].x += ga.x * uu[i].x * rs * g.x; x[i].y += ga.y * uu[i].y * rs * g.y; x[i].z += ga.z * uu[i].z * rs * g.z; x[i].w += ga.w * uu[i].w * rs * g.w; }
    }
    if (xout) {
#pragma unroll
      for (int i = 0; i < 4; ++i) *(float4*)(xout + (size_t)m * D + i * 256 + lane * 4) = x[i];
    }
    if (hout) {
      float ss = 0.f;
#pragma unroll
      for (int i = 0; i < 4; ++i) ss += x[i].x * x[i].x + x[i].y * x[i].y + x[i].z * x[i].z + x[i].w * x[i].w;
      ss = wave_sum(ss); const float rs = rsqrtf(ss * (1.f / D) + 1e-6f);
#pragma unroll
      for (int i = 0; i < 4; ++i) { const int c = i * 256 + lane * 4; const float4 g = *(const float4*)(gpre + c);
        const float4 sh = *(const float4*)(modN + ((size_t)mi * 6 + shift_idx) * D + c); const float4 sc = *(const float4*)(modN + ((size_t)mi * 6 + shift_idx + 1) * D + c);
        u32x2 o; o.x = pack2(x[i].x * rs * g.x * (1.f + sc.x) + sh.x, x[i].y * rs * g.y * (1.f + sc.y) + sh.y); o.y = pack2(x[i].z * rs * g.z * (1.f + sc.z) + sh.z, x[i].w * rs * g.w * (1.f + sc.w) + sh.w);
        *(u32x2*)(hout + (size_t)m * LDH + c) = o; }
    }
  }
}

struct TileSrc { const bf16_t* A; int lda; int arow0; const bf16_t* B; int ldb; int brow0, brow1; int K; };

template <int NN> DI void zero_acc(f32x4 (&acc)[4][NN]) {
#pragma unroll
  for (int m = 0; m < 4; ++m)
#pragma unroll
    for (int n = 0; n < NN; ++n) acc[m][n] = (f32x4){0.f, 0.f, 0.f, 0.f};
}

template <int NN> DI void gemm_tile(f32x4 (&acc)[4][NN], const TileSrc& s, char* smem) {
  bf16_t* sbase = (bf16_t*)smem;
  const int tid = tidx(), lane = tid & 63, wave = tid >> 6, wr = wave >> 1, wc = wave & 1, fr = lane & 15, fq = lane >> 4;
  const bf16_t* ga[4]; const bf16_t* gb[NN];
#pragma unroll
  for (int i = 0; i < 4; ++i) { const int c = tid + 256 * i, row = c >> 3, kc = c & 7;
    int ar = s.arow0 + row; ar = ar < 0 ? 0 : (ar > MT - 1 ? MT - 1 : ar);
    ga[i] = s.A + (size_t)ar * s.lda + kc * 8; }
#pragma unroll
  for (int i = 0; i < NN; ++i) { const int c = tid + 256 * i, row = c >> 3, kc = c & 7;
    const int br = row < 64 ? s.brow0 + row : s.brow1 + row - 64;
    gb[i] = s.B + (size_t)br * s.ldb + kc * 8; }
  int wofs; { const int r = tid >> 3, kc = tid & 7, ob = (r & 15) * 64 + (kc & 3) * 16; wofs = (((r >> 4) * 2 + (kc >> 2)) * 1024 + (ob ^ (((ob >> 9) & 1) << 5))) >> 1; }
  int robase; { const int ob = fr * 64 + fq * 16; robase = (ob ^ (((ob >> 9) & 1) << 5)) >> 1; }
  const int nk = s.K >> 6;
  u32x4 ra0[4], rb0[NN], ra1[4], rb1[NN];
#define GT_LOAD(RA, RB, KT) do { const int kn_ = ((KT) < nk ? (KT) : nk - 1) * 64; \
    _Pragma("unroll") for (int i = 0; i < 4; ++i) RA[i] = *(const u32x4*)(ga[i] + kn_); \
    _Pragma("unroll") for (int i = 0; i < NN; ++i) RB[i] = *(const u32x4*)(gb[i] + kn_); } while (0)
#define GT_STORE(RA, RB, ST) do { bf16_t* sA_ = sbase + (ST) * 16384; bf16_t* sB_ = sA_ + 8192; \
    _Pragma("unroll") for (int i = 0; i < 4; ++i) *(u32x4*)(sA_ + wofs + i * 2048) = RA[i]; \
    _Pragma("unroll") for (int i = 0; i < NN; ++i) *(u32x4*)(sB_ + wofs + i * 2048) = RB[i]; } while (0)
#define GT_COMPUTE(ST) do { const bf16_t* sA_ = sbase + (ST) * 16384 + robase; const bf16_t* sB_ = sA_ + 8192; \
    _Pragma("unroll") for (int ks = 0; ks < 2; ++ks) { bf16x8 bfr[NN]; \
      _Pragma("unroll") for (int n = 0; n < NN; ++n) bfr[n] = *(const bf16x8*)(sB_ + ((wc * NN + n) * 2 + ks) * 512); \
      _Pragma("unroll") for (int m = 0; m < 4; ++m) { const bf16x8 af = *(const bf16x8*)(sA_ + ((wr * 4 + m) * 2 + ks) * 512); \
        _Pragma("unroll") for (int n = 0; n < NN; ++n) acc[m][n] = MFMA16(bfr[n], af, acc[m][n]); } } } while (0)
  GT_LOAD(ra0, rb0, 0); GT_LOAD(ra1, rb1, 1);
  __syncthreads();
  GT_STORE(ra0, rb0, 0);
  GT_LOAD(ra0, rb0, 2);
  __syncthreads();
#pragma unroll 1
  for (int kt = 0; kt < nk; kt += 2) {
    GT_STORE(ra1, rb1, 1); GT_LOAD(ra1, rb1, kt + 3); GT_COMPUTE(0); __syncthreads();
    GT_STORE(ra0, rb0, 0); GT_LOAD(ra0, rb0, kt + 4); GT_COMPUTE(1); __syncthreads();
  }
#undef GT_LOAD
#undef GT_STORE
#undef GT_COMPUTE
}

DI void stage_acc(const f32x4 (&acc)[4][4], float* sC) {
  const int lane = tidx() & 63, wave = tidx() >> 6, wr = wave >> 1, wc = wave & 1, fr = lane & 15, fq = lane >> 4;
  __syncthreads();
#pragma unroll
  for (int m = 0; m < 4; ++m)
#pragma unroll
    for (int n = 0; n < 4; ++n) *(f32x4*)(sC + (wr * 64 + m * 16 + fr) * 132 + wc * 64 + n * 16 + fq * 4) = acc[m][n];
  __syncthreads();
}

DI float gelu_tanh(float x) { const float u = 0.7978845608f * (x + 0.044715f * x * x * x); const float e = __expf(2.f * u); const float th = 1.f - 2.f / (e + 1.f); return 0.5f * x * (1.f + th); }

struct TileIter {
  int m_lo, rows, NTn, G, efull, count, e, stride;
  DI void init(int MTn, int NTn_) { const int x = blockIdx.x & 7; m_lo = (x * MTn) >> 3; rows = (((x + 1) * MTn) >> 3) - m_lo; NTn = NTn_; G = (rows + 1) >> 1;
    efull = (rows / G) * G * NTn; count = rows * NTn; e = blockIdx.x >> 3; stride = gridDim.x >> 3; }
  DI bool next(int& mt, int& nt) { if (e >= count) return false;
    if (e < efull) { const int grp = e / (G * NTn), rem = e - grp * G * NTn; nt = rem / G; mt = m_lo + grp * G + (rem - nt * G); }
    else { const int rem = e - efull, gsz = rows - (rows / G) * G; nt = rem / gsz; mt = m_lo + (rows / G) * G + (rem - nt * gsz); }
    e += stride; return true; }
};

__device__ void phase_win(const P& p, int l, char* smem) {
  const bf16_t* H = (const bf16_t*)(p.ws + WS_H); const bf16_t* Wt = (const bf16_t*)(p.ws + WS_WIN);
  bf16_t* zr = (bf16_t*)(p.ws + WS_ZR); bf16_t* zn = (bf16_t*)(p.ws + WS_ZN); bf16_t* zt = (bf16_t*)(p.ws + WS_ZT);
  const int tid = tidx(), lane = tid & 63, wave = tid >> 6, wr = wave >> 1, wc = wave & 1, fr = lane & 15, fq = lane >> 4;
  TileIter ti; int mt, nt;
  ti.init(98, 14);
  while (ti.next(mt, nt)) {
    f32x4 acc[4][4]; zero_acc<4>(acc);
    {
      const int n0 = nt * 128, arow0 = mt * 126 - 1;
      TileSrc s{H, LDH, arow0, Wt, LDH, n0, n0 + 64, D};
      gemm_tile<4>(acc, s, smem);
      float* sC = (float*)smem; stage_acc(acc, sC);
      const float* cw = p.rwkv_conv + (size_t)l * 3 * NZR;
      for (int e = tid; e < 126 * 32; e += NT) {
        const int tr = 1 + (e >> 5), c4 = (e & 31) * 4, g = arow0 + tr;
        if (g < MT) { int t, T, mi; tokinfo(g, t, T, mi);
          const float pm = t > 0 ? 1.f : 0.f, nm = t < T - 1 ? 1.f : 0.f;
          const f32x4 a = *(const f32x4*)(sC + (tr - 1) * 132 + c4), b = *(const f32x4*)(sC + tr * 132 + c4), c = *(const f32x4*)(sC + (tr + 1) * 132 + c4);
          const float4 w0 = *(const float4*)(cw + n0 + c4), w1 = *(const float4*)(cw + NZR + n0 + c4), w2 = *(const float4*)(cw + 2 * NZR + n0 + c4);
          float r0 = pm * a[0] * w0.x + b[0] * w1.x + nm * c[0] * w2.x, r1 = pm * a[1] * w0.y + b[1] * w1.y + nm * c[1] * w2.y;
          float r2 = pm * a[2] * w0.z + b[2] * w1.z + nm * c[2] * w2.z, r3 = pm * a[3] * w0.w + b[3] * w1.w + nm * c[3] * w2.w;
          if (n0 == 1664) { r0 = sigmoidf_(r0); r1 = sigmoidf_(r1); r2 = sigmoidf_(r2); r3 = sigmoidf_(r3); }
          u32x2 o; o.x = pack2(r0, r1); o.y = pack2(r2, r3);
          *(u32x2*)(zr + (size_t)g * NZR + n0 + c4) = o; }
      }
    }
  }
  ti.init(96, 28);
  while (ti.next(mt, nt)) {
    f32x4 acc[4][4]; zero_acc<4>(acc);
    {
      const int n0 = nt * 128, row0 = mt * 128;
      TileSrc s{H, LDH, row0, Wt, LDH, NZR + n0, NZR + n0 + 64, D};
      gemm_tile<4>(acc, s, smem);
#pragma unroll
      for (int m = 0; m < 4; ++m) { const int row = row0 + wr * 64 + m * 16 + fr;
#pragma unroll
        for (int n = 0; n < 4; ++n) { const int col = n0 + wc * 64 + n * 16 + fq * 4; const f32x4 v = acc[m][n];
          u32x2 o; o.x = pack2(v[0], v[1]); o.y = pack2(v[2], v[3]);
          if (col < NZN) {
            *(u32x2*)(zn + (size_t)row * NZN + col) = o;
            if (row < MC && col >= 512) { const int part = col - 512, isv = part >> 9, pp = part & 511, hh = pp >> 6, d = pp & 63, b = row >> 8, t = row & 255;
              float* dst = p.out + (isv ? O_V : O_K) + ((((size_t)b * 2 + l) * 8 + hh) * 256 + t) * 64 + d; *(f32x4*)dst = v; }
          } else { *(u32x2*)(zt + (size_t)row * LZT + (col - NZN)) = o; }
        } }
    }
  }
}

__device__ void phase_merge(const P& p, char* smem) {
  const bf16_t* H = (const bf16_t*)(p.ws + WS_H); const bf16_t* Wt = (const bf16_t*)(p.ws + WS_WIN); const bf16_t* Wo3 = (const bf16_t*)(p.ws + WS_WO3);
  bf16_t* mg = (bf16_t*)(p.ws + WS_MERGED);
  const int tid = tidx(), lane = tid & 63, wave = tid >> 6, wr = wave >> 1, wc = wave & 1, fr = lane & 15, fq = lane >> 4;
  TileIter ti; int mt, nt; ti.init(96, 16);
  while (ti.next(mt, nt)) {
    const int n0 = nt * 64, row0 = mt * 128;
    f32x4 macc[4][2]; zero_acc<2>(macc);
#pragma unroll 1
    for (int i = 0; i < 3; ++i) {
      const bf16_t* O = (const bf16_t*)(p.ws + (i == 0 ? WS_OA : (i == 1 ? WS_ONA : WS_ORET)));
      f32x4 g[4][2]; zero_acc<2>(g);
      { TileSrc s{H, LDH, row0, Wt, LDH, 5376 + i * 1024 + n0, 0, D}; gemm_tile<2>(g, s, smem); }
      f32x4 a2[4][2]; zero_acc<2>(a2);
      { TileSrc s{O, LDO, row0, Wo3 + (size_t)i * 1024 * LDO, LDO, n0, 0, 512}; gemm_tile<2>(a2, s, smem); }
#pragma unroll
      for (int m = 0; m < 4; ++m)
#pragma unroll
        for (int n = 0; n < 2; ++n)
#pragma unroll
          for (int j = 0; j < 4; ++j) macc[m][n][j] += sigmoidf_(g[m][n][j]) * a2[m][n][j];
    }
#pragma unroll
    for (int m = 0; m < 4; ++m) { const int row = row0 + wr * 64 + m * 16 + fr;
#pragma unroll
      for (int n = 0; n < 2; ++n) { const int col = n0 + wc * 32 + n * 16 + fq * 4; u32x2 o; o.x = pack2(macc[m][n][0], macc[m][n][1]); o.y = pack2(macc[m][n][2], macc[m][n][3]); *(u32x2*)(mg + (size_t)row * LDH + col) = o; } }
  }
}

__device__ void phase_gemm_f32(const bf16_t* A, int lda, int K, const bf16_t* Bt, int ldb, float* C, char* smem) {
  const int tid = tidx(), lane = tid & 63, wave = tid >> 6, wr = wave >> 1, wc = wave & 1, fr = lane & 15, fq = lane >> 4;
  TileIter ti; int mt, nt; ti.init(96, 8);
  while (ti.next(mt, nt)) {
    const int n0 = nt * 128, row0 = mt * 128;
    f32x4 acc[4][4]; zero_acc<4>(acc);
    TileSrc s{A, lda, row0, Bt, ldb, n0, n0 + 64, K}; gemm_tile<4>(acc, s, smem);
#pragma unroll
    for (int m = 0; m < 4; ++m) { const int row = row0 + wr * 64 + m * 16 + fr;
#pragma unroll
      for (int n = 0; n < 4; ++n) *(f32x4*)(C + (size_t)row * D + n0 + wc * 64 + n * 16 + fq * 4) = acc[m][n]; }
  }
}

__device__ void phase_ffn_up(const P& p, int l, char* smem) {
  const bf16_t* H = (const bf16_t*)(p.ws + WS_H); const bf16_t* Wt = (const bf16_t*)(p.ws + WS_WUP); bf16_t* hid = (bf16_t*)(p.ws + WS_HID);
  const int tid = tidx();
  const float* cw = p.ffn_conv + (size_t)l * 3 * 2 * FF;
  TileIter ti; int mt, nt; ti.init(98, 44);
  while (ti.next(mt, nt)) {
    const int c0 = nt * 64, arow0 = mt * 126 - 1;
    f32x4 acc[4][4]; zero_acc<4>(acc);
    TileSrc s{H, LDH, arow0, Wt, LDH, c0, FF + c0, D};
    gemm_tile<4>(acc, s, smem);
    float* sC = (float*)smem; stage_acc(acc, sC);
    for (int e = tid; e < 126 * 16; e += NT) {
      const int tr = 1 + (e >> 4), c4 = (e & 15) * 4, g = arow0 + tr;
      if (g < MT) { int t, T, mi; tokinfo(g, t, T, mi);
        const float pm = t > 0 ? 1.f : 0.f, nm = t < T - 1 ? 1.f : 0.f;
        const f32x4 va = *(const f32x4*)(sC + (tr - 1) * 132 + c4), vb = *(const f32x4*)(sC + tr * 132 + c4), vc = *(const f32x4*)(sC + (tr + 1) * 132 + c4);
        const f32x4 ga = *(const f32x4*)(sC + (tr - 1) * 132 + 64 + c4), gb = *(const f32x4*)(sC + tr * 132 + 64 + c4), gc = *(const f32x4*)(sC + (tr + 1) * 132 + 64 + c4);
        const f32x4 v0 = *(const f32x4*)(cw + c0 + c4), v1 = *(const f32x4*)(cw + 2 * FF + c0 + c4), v2 = *(const f32x4*)(cw + 4 * FF + c0 + c4);
        const f32x4 g0 = *(const f32x4*)(cw + FF + c0 + c4), g1 = *(const f32x4*)(cw + 3 * FF + c0 + c4), g2 = *(const f32x4*)(cw + 5 * FF + c0 + c4);
        float r[4];
#pragma unroll
        for (int j = 0; j < 4; ++j) { const float val = pm * va[j] * v0[j] + vb[j] * v1[j] + nm * vc[j] * v2[j]; const float gt = pm * ga[j] * g0[j] + gb[j] * g1[j] + nm * gc[j] * g2[j]; r[j] = gelu_tanh(gt) * val; }
        u32x2 o; o.x = pack2(r[0], r[1]); o.y = pack2(r[2], r[3]);
        *(u32x2*)(hid + (size_t)g * FF + c0 + c4) = o; }
    }
  }
}

template <int CTRL> DI float dppf(float v) { return __int_as_float(__builtin_amdgcn_mov_dpp(__float_as_int(v), CTRL, 0xF, 0xF, true)); }
DI float row16_sum(float v) { v += dppf<0xB1>(v); v += dppf<0x4E>(v); v += dppf<0x141>(v); v += dppf<0x140>(v); return v; }

DI float frcp(float x) { return __builtin_amdgcn_rcpf(x); }
DI float fsig(float x) { return frcp(1.f + __expf(-x)); }
__device__ void scan_task(const P& p, int l, int seq, int h, int d, int half, char* smem) {
  float* sR = (float*)smem; float* sW = sR + 1024; float* sKD = sW + 1024; float* sB = sKD + 1024; float* sNK = sB + 1024; float* sV = sNK + 1024; float* sK = sV + 1024; float* sY = sK + 1024;
  float* sKn = sY + 1024; float* sKK = sKn + 16; bf16_t* sWT = (bf16_t*)(sKK + 64); bf16_t* sAL = sWT + 16 * LDT;
  const int tid = tidx(), lane = tid & 63, wave = tid >> 6, fr = lane & 15, fq = lane >> 4;
  const int row0 = seq < 32 ? seq * 256 : MC + (seq - 32) * 1024, T = seq < 32 ? 256 : 1024, nch = T >> 4;
  const bf16_t* zr = (const bf16_t*)(p.ws + WS_ZR);
  float* yout = (float*)(p.ws + WS_Y) + (size_t)d * MT * 512;
  __syncthreads();
  if (tid < 64) sKK[tid] = p.rwkv_k_k[l * 512 + h * 64 + tid];
  const int cc = wave * 16 + fr, gc = h * 64 + cc;
  bf16x8 bw[2], ba[2];
#pragma unroll
  for (int ks = 0; ks < 2; ++ks)
#pragma unroll
    for (int e = 0; e < 8; ++e) { const int k = ks * 32 + fq * 8 + e;
      bw[ks][e] = (short)f2bf(p.rwkv_w_up[((size_t)(l * 2 + d) * 64 + k) * 512 + gc]); ba[ks][e] = (short)f2bf(p.rwkv_a_up[((size_t)(l * 2 + d) * 64 + k) * 512 + gc]); }
  const float w0c = p.rwkv_w0[(l * 2 + d) * 512 + gc], a0c = p.rwkv_a0[(l * 2 + d) * 512 + gc], kac = p.rwkv_k_a[l * 512 + gc];
  const int rg = tid >> 4, kq = tid & 15, rbase = half * 32 + rg * 2;
  f32x2 S[2][2];
  if (seq >= 32) { const float* s0 = p.state_rwkv + (((((size_t)(seq - 32) * 2 + l) * 2 + d) * 8 + h) * 64 + rbase) * 64 + kq * 4;
#pragma unroll
    for (int r = 0; r < 2; ++r) { const f32x4 x = *(const f32x4*)(s0 + r * 64); S[r][0] = (f32x2){x[0], x[1]}; S[r][1] = (f32x2){x[2], x[3]}; } }
  else {
#pragma unroll
    for (int r = 0; r < 2; ++r) { S[r][0] = (f32x2){0.f, 0.f}; S[r][1] = (f32x2){0.f, 0.f}; } }
  if (seq >= 32) __builtin_amdgcn_s_setprio(2);
  const int at = (tid & 127) >> 3, apart = tid & 7, ahi = tid >> 7;
  size_t coff[3];
  { const int sb0 = ahi ? 512 + h * 64 : h * 64, sb1 = ahi ? 1536 : 1024 + h * 64, sb2 = 1600;
    coff[0] = (size_t)at * NZR + sb0 + apart * 8; coff[1] = (size_t)at * NZR + sb1 + apart * 8; coff[2] = (size_t)at * NZR + sb2 + apart * 8; }
  u32x4 pre[3];
  { const int t0 = (d ? nch - 1 : 0) * 16;
#pragma unroll
    for (int i = 0; i < 3; ++i) pre[i] = *(const u32x4*)(zr + (size_t)(row0 + t0) * NZR + coff[i]); }
  __syncthreads();
  for (int ci = 0; ci < nch; ++ci) {
    const int chunk = d ? nch - 1 - ci : ci, t0 = chunk * 16;
    { const int o = at * 64 + apart * 8; float f[8];
      unpack8(pre[0], f);
      if (ahi == 0) { *(f32x4*)(sR + o) = (f32x4){f[0], f[1], f[2], f[3]}; *(f32x4*)(sR + o + 4) = (f32x4){f[4], f[5], f[6], f[7]}; }
      else { *(f32x4*)(sK + o) = (f32x4){f[0], f[1], f[2], f[3]}; *(f32x4*)(sK + o + 4) = (f32x4){f[4], f[5], f[6], f[7]}; float ps = 0.f;
#pragma unroll
        for (int e = 0; e < 8; ++e) { const float kk = f[e] * sKK[apart * 8 + e]; ps += kk * kk; }
        ps += dppf<0xB1>(ps); ps += dppf<0x4E>(ps); ps += dppf<0x141>(ps);
        if (apart == 0) sKn[at] = ps; }
      unpack8(pre[1], f);
      if (ahi == 0) { *(f32x4*)(sV + o) = (f32x4){f[0], f[1], f[2], f[3]}; *(f32x4*)(sV + o + 4) = (f32x4){f[4], f[5], f[6], f[7]}; }
      else { float g[8];
#pragma unroll
        for (int e = 0; e < 8; ++e) g[e] = 1.f - 2.f * frcp(__expf(2.f * f[e]) + 1.f);
        *(u32x4*)(sWT + at * LDT + apart * 8) = pack8(g); }
      if (ahi == 0) *(u32x4*)(sAL + at * LDT + apart * 8) = pre[2];
    }
    __syncthreads();
    {
      f32x4 aw = {0.f, 0.f, 0.f, 0.f}, aa = {0.f, 0.f, 0.f, 0.f};
#pragma unroll
      for (int ks = 0; ks < 2; ++ks) { const bf16x8 fw = *(const bf16x8*)(sWT + fr * LDT + ks * 32 + fq * 8); const bf16x8 fa = *(const bf16x8*)(sAL + fr * LDT + ks * 32 + fq * 8);
        aw = MFMA16(fw, bw[ks], aw); aa = MFMA16(fa, ba[ks], aa); }
      const float kkc = sKK[cc];
#pragma unroll
      for (int j = 0; j < 4; ++j) { const int t = fq * 4 + j, o = t * 64 + cc;
        const float dec = __expf(-0.6065306597f * fsig(w0c + aw[j]));
        const float a = fsig(a0c + aa[j]);
        const float kv = sK[o];
        const float kkv = kv * kkc * __builtin_amdgcn_rsqf(fmaxf(sKn[t], 1e-24f));
        sW[o] = dec; sKD[o] = kv * (1.f + (a - 1.f) * kac); sB[o] = kkv * a; sNK[o] = -kkv; }
    }
    __syncthreads();
    { const int cn = ci + 1 < nch ? ci + 1 : ci; const int nt0 = (d ? nch - 1 - cn : cn) * 16;
#pragma unroll
      for (int i = 0; i < 3; ++i) pre[i] = *(const u32x4*)(zr + (size_t)(row0 + nt0) * NZR + coff[i]); }
#pragma unroll 2
    for (int si = 0; si < 16; ++si) {
      const int t = d ? 15 - si : si, o = t * 64 + kq * 4;
      const f32x4 an4 = *(const f32x4*)(sNK + o), w4 = *(const f32x4*)(sW + o), b4 = *(const f32x4*)(sB + o), kd4 = *(const f32x4*)(sKD + o), r4 = *(const f32x4*)(sR + o);
      const f32x2 v2 = *(const f32x2*)(sV + t * 64 + rbase);
      const f32x2 an[2] = {{an4[0], an4[1]}, {an4[2], an4[3]}}, wv[2] = {{w4[0], w4[1]}, {w4[2], w4[3]}}, bv[2] = {{b4[0], b4[1]}, {b4[2], b4[3]}}, kd[2] = {{kd4[0], kd4[1]}, {kd4[2], kd4[3]}}, rv[2] = {{r4[0], r4[1]}, {r4[2], r4[3]}};
      float sa[2];
#pragma unroll
      for (int r = 0; r < 2; ++r) { const f32x2 t2 = S[r][0] * an[0] + S[r][1] * an[1]; sa[r] = row16_sum(t2.x + t2.y); }
      f32x2 yv;
#pragma unroll
      for (int r = 0; r < 2; ++r) { const f32x2 sav = {sa[r], sa[r]}, vvv = {v2[r], v2[r]};
        S[r][0] = S[r][0] * wv[0] + (sav * bv[0] + vvv * kd[0]); S[r][1] = S[r][1] * wv[1] + (sav * bv[1] + vvv * kd[1]);
        const f32x2 y2 = S[r][0] * rv[0] + S[r][1] * rv[1]; yv[r] = row16_sum(y2.x + y2.y); }
      if (kq == 0) *(f32x2*)(sY + t * 64 + rbase) = yv;
    }
    __syncthreads();
    { const int t = tid >> 4, vv = half * 32 + (tid & 15) * 2; *(f32x2*)(yout + (size_t)(row0 + t0 + t) * 512 + h * 64 + vv) = *(const f32x2*)(sY + t * 64 + vv); }
  }
  __builtin_amdgcn_s_setprio(0);
  if (seq < 32) { float* so = p.out + O_RW + (((((size_t)seq * 2 + l) * 2 + d) * 8 + h) * 64 + rbase) * 64 + kq * 4;
#pragma unroll
    for (int r = 0; r < 2; ++r) *(f32x4*)(so + r * 64) = (f32x4){S[r][0].x, S[r][0].y, S[r][1].x, S[r][1].y}; }
}

DI void qk_scores(const bf16_t* sK, const bf16x8 (&qf)[2], f32x4 (&sacc)[4], int fr, int fq) {
#pragma unroll
  for (int nt = 0; nt < 4; ++nt) { sacc[nt] = (f32x4){0.f, 0.f, 0.f, 0.f};
#pragma unroll
    for (int ks = 0; ks < 2; ++ks) { const bf16x8 kf = *(const bf16x8*)(sK + (nt * 16 + fr) * LDT + ks * 32 + fq * 8); sacc[nt] = MFMA16(kf, qf[ks], sacc[nt]); } }
}
DI void pv_accum(const bf16_t* sVt, const f32x4 (&pacc)[4], f32x4 (&o)[4], int fr, int fq) {
#pragma unroll
  for (int s = 0; s < 2; ++s) {
    bf16x8 pf; { const unsigned a = pack2(pacc[2 * s][0], pacc[2 * s][1]), b = pack2(pacc[2 * s][2], pacc[2 * s][3]), c = pack2(pacc[2 * s + 1][0], pacc[2 * s + 1][1]), dd = pack2(pacc[2 * s + 1][2], pacc[2 * s + 1][3]);
      const u32x4 u = (u32x4){a, b, c, dd}; pf = __builtin_bit_cast(bf16x8, u); }
#pragma unroll
    for (int dt = 0; dt < 4; ++dt) { const u32x2 lo = *(const u32x2*)(sVt + (dt * 16 + fr) * LDT + 32 * s + 4 * fq), hi = *(const u32x2*)(sVt + (dt * 16 + fr) * LDT + 32 * s + 16 + 4 * fq);
      const u32x4 u = (u32x4){lo[0], lo[1], hi[0], hi[1]}; const bf16x8 vf = __builtin_bit_cast(bf16x8, u); o[dt] = MFMA16(vf, pf, o[dt]); }
  }
}
DI void put_kv(bf16_t* sK, bf16_t* sVt, int key, int part, const float (&kf)[8], const float (&vf)[8]) {
  *(u32x4*)(sK + key * LDT + part * 8) = pack8(kf);
#pragma unroll
  for (int e = 0; e < 8; ++e) sVt[(part * 8 + e) * LDT + key] = f2bf(vf[e]);
}
DI void softmax_tile(f32x4 (&sacc)[4], f32x4 (&o)[4], float& mrun, float& lrun) {
  float mx = sacc[0][0];
#pragma unroll
  for (int nt = 0; nt < 4; ++nt)
#pragma unroll
    for (int j = 0; j < 4; ++j) mx = fmaxf(mx, sacc[nt][j]);
  mx = fmaxf(mx, __shfl_xor(mx, 16)); mx = fmaxf(mx, __shfl_xor(mx, 32));
  const float mnew = fmaxf(mrun, mx), alpha = exp2f(mrun - mnew); mrun = mnew;
  float ls = 0.f;
#pragma unroll
  for (int nt = 0; nt < 4; ++nt)
#pragma unroll
    for (int j = 0; j < 4; ++j) { const float pv = exp2f(sacc[nt][j] - mnew); sacc[nt][j] = pv; ls += pv; }
  lrun = lrun * alpha + ls;
#pragma unroll
  for (int dt = 0; dt < 4; ++dt) o[dt] *= alpha;
}
constexpr float LOG2E = 1.4426950408889634f;

__device__ void dense_task(const P& p, int b, int h, int qb, char* smem) {
  bf16_t* sK = (bf16_t*)smem; bf16_t* sVt = sK + 64 * LDT;
  const int tid = tidx(), lane = tid & 63, wave = tid >> 6, fr = lane & 15, fq = lane >> 4;
  const bf16_t* zn = (const bf16_t*)(p.ws + WS_ZN); bf16_t* ona = (bf16_t*)(p.ws + WS_ONA);
  const int qrow = b * 256 + qb * 64 + wave * 16 + fr;
  bf16x8 qf[2];
#pragma unroll
  for (int ks = 0; ks < 2; ++ks) qf[ks] = *(const bf16x8*)(zn + (size_t)qrow * NZN + h * 64 + ks * 32 + fq * 8);
  f32x4 o[4]; for (int dt = 0; dt < 4; ++dt) o[dt] = (f32x4){0.f, 0.f, 0.f, 0.f};
  float mrun = -1e30f, lrun = 0.f;
  u32x4 pk[2], pv[2];
#pragma unroll
  for (int i = 0; i < 2; ++i) { const int c = tid + 256 * i, key = c >> 3, part = c & 7; const size_t ro = (size_t)(b * 256 + key) * NZN + h * 64 + part * 8; pk[i] = *(const u32x4*)(zn + ro + 512); pv[i] = *(const u32x4*)(zn + ro + 1024); }
  for (int kt = 0; kt < 4; ++kt) {
    __syncthreads();
#pragma unroll
    for (int i = 0; i < 2; ++i) { const int c = tid + 256 * i, key = c >> 3, part = c & 7; float vf[8]; unpack8(pv[i], vf);
      *(u32x4*)(sK + key * LDT + part * 8) = pk[i];
#pragma unroll
      for (int e = 0; e < 8; ++e) sVt[(part * 8 + e) * LDT + key] = f2bf(vf[e]); }
    __syncthreads();
    { const int kn = kt < 3 ? kt + 1 : 3;
#pragma unroll
      for (int i = 0; i < 2; ++i) { const int c = tid + 256 * i, key = c >> 3, part = c & 7; const size_t ro = (size_t)(b * 256 + kn * 64 + key) * NZN + h * 64 + part * 8; pk[i] = *(const u32x4*)(zn + ro + 512); pv[i] = *(const u32x4*)(zn + ro + 1024); } }
    f32x4 sacc[4]; qk_scores(sK, qf, sacc, fr, fq);
#pragma unroll
    for (int nt = 0; nt < 4; ++nt) sacc[nt] *= (0.125f * LOG2E);
    softmax_tile(sacc, o, mrun, lrun);
    pv_accum(sVt, sacc, o, fr, fq);
  }
  lrun += __shfl_xor(lrun, 16); lrun += __shfl_xor(lrun, 32); const float inv = 1.f / lrun;
#pragma unroll
  for (int dt = 0; dt < 4; ++dt) { u32x2 ov; ov.x = pack2(o[dt][0] * inv, o[dt][1] * inv); ov.y = pack2(o[dt][2] * inv, o[dt][3] * inv); *(u32x2*)(ona + (size_t)qrow * LDO + h * 64 + dt * 16 + fq * 4) = ov; }
}

__device__ void na_task(const P& p, int l, int b, int h, int r, char* smem) {
  bf16_t* sK = (bf16_t*)smem; bf16_t* sVt = sK + 64 * LDT; float* sRpb = (float*)(sVt + 64 * LDT);
  const int tid = tidx(), lane = tid & 63, wave = tid >> 6, fr = lane & 15, fq = lane >> 4;
  const bf16_t* zn = (const bf16_t*)(p.ws + WS_ZN); bf16_t* ona = (bf16_t*)(p.ws + WS_ONA);
  const int base = MC + b * 1024, qcol = wave * 16 + fr, qrow = base + r * 64 + qcol;
  int rs = r - 4; rs = rs < 0 ? 0 : (rs > 8 ? 8 : rs);
  int cs = qcol - 8; cs = cs < 0 ? 0 : (cs > 48 ? 48 : cs);
  __syncthreads();
  for (int e = tid; e < 465; e += NT) sRpb[e] = p.na_rpb[((size_t)l * 8 + h) * 465 + e] * LOG2E;
  bf16x8 qf[2];
#pragma unroll
  for (int ks = 0; ks < 2; ++ks) qf[ks] = *(const bf16x8*)(zn + (size_t)qrow * NZN + h * 64 + ks * 32 + fq * 8);
  f32x4 o[4]; for (int dt = 0; dt < 4; ++dt) o[dt] = (f32x4){0.f, 0.f, 0.f, 0.f};
  float mrun = -1e30f, lrun = 0.f;
  u32x4 pre[8];
#define NA_ISSUE(KT) do { const int kt_ = (KT); \
    if (kt_ < 8) { _Pragma("unroll") for (int i = 0; i < 2; ++i) { const int c = tid + 256 * i, key = c >> 3, part = c & 7; const size_t ro = (size_t)(base + (rs + kt_) * 64 + key) * NZN + h * 64 + part * 8; \
        pre[4 * i] = *(const u32x4*)(zn + ro + 512); pre[4 * i + 1] = *(const u32x4*)(zn + ro + 1024); } } \
    else { _Pragma("unroll") for (int i = 0; i < 2; ++i) { const int c = tid + 256 * i, key = c >> 3, part = c & 7; const size_t co = ((((size_t)b * 2 + l) * 8 + h) * 256 + (kt_ - 8) * 64 + key) * 64 + part * 8; \
        pre[4 * i] = *(const u32x4*)(p.cache_k + co); pre[4 * i + 1] = *(const u32x4*)(p.cache_k + co + 4); pre[4 * i + 2] = *(const u32x4*)(p.cache_v + co); pre[4 * i + 3] = *(const u32x4*)(p.cache_v + co + 4); } } } while (0)
  NA_ISSUE(0);
  for (int kt = 0; kt < 12; ++kt) {
    __syncthreads();
    if (kt < 8) {
#pragma unroll
      for (int i = 0; i < 2; ++i) { const int c = tid + 256 * i, key = c >> 3, part = c & 7; float vf[8]; unpack8(pre[4 * i + 1], vf);
        *(u32x4*)(sK + key * LDT + part * 8) = pre[4 * i];
#pragma unroll
        for (int e = 0; e < 8; ++e) sVt[(part * 8 + e) * LDT + key] = f2bf(vf[e]); }
    } else {
#pragma unroll
      for (int i = 0; i < 2; ++i) { const int c = tid + 256 * i, key = c >> 3, part = c & 7;
        const f32x4 k0 = __builtin_bit_cast(f32x4, pre[4 * i]), k1 = __builtin_bit_cast(f32x4, pre[4 * i + 1]), v0 = __builtin_bit_cast(f32x4, pre[4 * i + 2]), v1 = __builtin_bit_cast(f32x4, pre[4 * i + 3]);
        const float kf[8] = {k0[0], k0[1], k0[2], k0[3], k1[0], k1[1], k1[2], k1[3]}; const float vf[8] = {v0[0], v0[1], v0[2], v0[3], v1[0], v1[1], v1[2], v1[3]};
        put_kv(sK, sVt, key, part, kf, vf); }
    }
    __syncthreads();
    NA_ISSUE(kt < 11 ? kt + 1 : 11);
    f32x4 sacc[4]; qk_scores(sK, qf, sacc, fr, fq);
    if (kt < 8) { const int dr = rs + kt - r + 7;
#pragma unroll
      for (int nt = 0; nt < 4; ++nt)
#pragma unroll
        for (int j = 0; j < 4; ++j) { const int kc = nt * 16 + fq * 4 + j; const bool valid = kc >= cs && kc < cs + 16; int dc = kc - qcol; dc = dc < -15 ? -15 : (dc > 15 ? 15 : dc);
          sacc[nt][j] = valid ? sacc[nt][j] * (0.125f * LOG2E) + sRpb[dr * 31 + dc + 15] : -1e30f; }
    } else {
#pragma unroll
      for (int nt = 0; nt < 4; ++nt) sacc[nt] *= (0.125f * LOG2E);
    }
    softmax_tile(sacc, o, mrun, lrun);
    pv_accum(sVt, sacc, o, fr, fq);
  }
#undef NA_ISSUE
  lrun += __shfl_xor(lrun, 16); lrun += __shfl_xor(lrun, 32); const float inv = 1.f / lrun;
#pragma unroll
  for (int dt = 0; dt < 4; ++dt) { u32x2 ov; ov.x = pack2(o[dt][0] * inv, o[dt][1] * inv); ov.y = pack2(o[dt][2] * inv, o[dt][3] * inv); *(u32x2*)(ona + (size_t)qrow * LDO + h * 64 + dt * 16 + fq * 4) = ov; }
}

DI void rope8(const float (&own)[8], const float (&par)[8], int part, int n, float (&out)[8]) {
  const float pos = (float)((part >> 2) ? (n & 63) : (n >> 6));
  const bool isx2 = (part & 3) >= 2;
#pragma unroll
  for (int e = 0; e < 8; ++e) { const int i = (part & 1) * 8 + e; const float ang = pos * exp2f(-(float)i * 0.830482023721841f); const float sn = __sinf(ang), cs = __cosf(ang);
    out[e] = isx2 ? par[e] * sn + own[e] * cs : own[e] * cs - par[e] * sn; }
}

__device__ void ret_task(const P& p, int l, int seq, int h, int qb, char* smem) {
  bf16_t* sK = (bf16_t*)smem; bf16_t* sVt = sK + 64 * LDT; bf16_t* sQ = sVt + 64 * LDT;
  const int tid = tidx(), lane = tid & 63, wave = tid >> 6, fr = lane & 15, fq = lane >> 4;
  const bf16_t* zt = (const bf16_t*)(p.ws + WS_ZT); bf16_t* oret = (bf16_t*)(p.ws + WS_ORET);
  const bool lat = seq >= 32;
  const int row0 = lat ? MC + (seq - 32) * 1024 : seq * 256, T = lat ? 1024 : 256, nkt = T >> 6;
  const float xf = p.ret_decay[(l * 2 + 0) * 8 + h], xb = p.ret_decay[(l * 2 + 1) * 8 + h];
  const float lgf = -log1pf(__expf(-xf)) * LOG2E, lgb = -log1pf(__expf(-xb)) * LOG2E;
  __syncthreads();
#pragma unroll
  for (int i = 0; i < 2; ++i) { const int c = tid + 256 * i, qi = c >> 3, part = c & 7; const int n = qb * 64 + qi; const size_t ro = (size_t)(row0 + n) * LZT + h * 64;
    const u32x4 own = *(const u32x4*)(zt + ro + part * 8);
    if (lat) { const u32x4 par = *(const u32x4*)(zt + ro + (part ^ 2) * 8); float fo[8], fp[8], out[8]; unpack8(own, fo); unpack8(par, fp); rope8(fo, fp, part, n, out); *(u32x4*)(sQ + qi * LDT + part * 8) = pack8(out); }
    else *(u32x4*)(sQ + qi * LDT + part * 8) = own; }
  __syncthreads();
  const int qi = wave * 16 + fr, nq = qb * 64 + qi;
  bf16x8 qf[2];
#pragma unroll
  for (int ks = 0; ks < 2; ++ks) qf[ks] = *(const bf16x8*)(sQ + qi * LDT + ks * 32 + fq * 8);
  f32x4 o[4]; for (int dt = 0; dt < 4; ++dt) o[dt] = (f32x4){0.f, 0.f, 0.f, 0.f};
  u32x4 rk[2], rp[2], rv[2];
#define RET_ISSUE(KT) do { _Pragma("unroll") for (int i = 0; i < 2; ++i) { const int c = tid + 256 * i, key = c >> 3, part = c & 7; const size_t ro = (size_t)(row0 + (KT) * 64 + key) * LZT + h * 64; \
    rk[i] = *(const u32x4*)(zt + ro + 512 + part * 8); rp[i] = *(const u32x4*)(zt + ro + 512 + (part ^ 2) * 8); rv[i] = *(const u32x4*)(zt + ro + 1024 + part * 8); } } while (0)
  RET_ISSUE(0);
  for (int kt = 0; kt < nkt; ++kt) {
    __syncthreads();
#pragma unroll
    for (int i = 0; i < 2; ++i) { const int c = tid + 256 * i, key = c >> 3, part = c & 7; const int n = kt * 64 + key;
      float kf[8], vf[8]; unpack8(rk[i], kf); unpack8(rv[i], vf);
      if (lat) { float fp[8], out[8]; unpack8(rp[i], fp); rope8(kf, fp, part, n, out);
#pragma unroll
        for (int e = 0; e < 8; ++e) kf[e] = out[e]; }
#pragma unroll
      for (int e = 0; e < 8; ++e) kf[e] *= 0.125f;
      put_kv(sK, sVt, key, part, kf, vf); }
    __syncthreads();
    RET_ISSUE(kt + 1 < nkt ? kt + 1 : kt);
    f32x4 sacc[4]; qk_scores(sK, qf, sacc, fr, fq);
#pragma unroll
    for (int nt = 0; nt < 4; ++nt)
#pragma unroll
      for (int j = 0; j < 4; ++j) { const int mk = kt * 64 + nt * 16 + fq * 4 + j; const int df = nq - mk;
        const float dec = df > 0 ? exp2f(lgf * (float)df) : (df < 0 ? exp2f(lgb * (float)(-df)) : 2.f); sacc[nt][j] *= dec; }
    pv_accum(sVt, sacc, o, fr, fq);
  }
#undef RET_ISSUE
  if (lat) {
    for (int dir = 0; dir < 2; ++dir) {
      __syncthreads();
      const float* s0 = p.state_ret + ((((size_t)(seq - 32) * 2 + l) * 2 + dir) * 8 + h) * 4096;
#pragma unroll
      for (int i = 0; i < 2; ++i) { const int c = tid + 256 * i, dk = c >> 3, part = c & 7; const float4 a = *(const float4*)(s0 + dk * 64 + part * 8), bq = *(const float4*)(s0 + dk * 64 + part * 8 + 4);
        const float vf[8] = {a.x, a.y, a.z, a.w, bq.x, bq.y, bq.z, bq.w};
#pragma unroll
        for (int e = 0; e < 8; ++e) sVt[(part * 8 + e) * LDT + dk] = f2bf(vf[e]); }
      __syncthreads();
      const float xi = dir == 0 ? exp2f(lgf * (float)(nq + 1)) : exp2f(lgb * (float)(T - nq));
      f32x4 pacc[4];
#pragma unroll
      for (int s = 0; s < 2; ++s)
#pragma unroll
        for (int hh = 0; hh < 2; ++hh)
#pragma unroll
          for (int j = 0; j < 4; ++j) pacc[2 * s + hh][j] = xi * bf2f(sQ[qi * LDT + 32 * s + 16 * hh + 4 * fq + j]);
      pv_accum(sVt, pacc, o, fr, fq);
    }
  }
  float s1 = 0.f;
#pragma unroll
  for (int dt = 0; dt < 4; ++dt)
#pragma unroll
    for (int j = 0; j < 4; ++j) s1 += o[dt][j];
  s1 += __shfl_xor(s1, 16); s1 += __shfl_xor(s1, 32); const float mu = s1 * (1.f / 64.f);
  float s2 = 0.f;
#pragma unroll
  for (int dt = 0; dt < 4; ++dt)
#pragma unroll
    for (int j = 0; j < 4; ++j) { const float dlt = o[dt][j] - mu; s2 += dlt * dlt; }
  s2 += __shfl_xor(s2, 16); s2 += __shfl_xor(s2, 32); const float rstd = rsqrtf(s2 * (1.f / 64.f) + 1e-5f);
  const size_t qrow = (size_t)(row0 + nq);
#pragma unroll
  for (int dt = 0; dt < 4; ++dt) { const int dv = h * 64 + dt * 16 + fq * 4; const u32x2 gr = *(const u32x2*)(zt + qrow * LZT + 1536 + dv); const float4 gn = *(const float4*)(p.ret_gn + l * 512 + dv);
    const float g0 = bflo(gr.x), g1 = bfhi(gr.x), g2 = bflo(gr.y), g3 = bfhi(gr.y);
    u32x2 ov; ov.x = pack2((o[dt][0] - mu) * rstd * gn.x * g0 * sigmoidf_(g0), (o[dt][1] - mu) * rstd * gn.y * g1 * sigmoidf_(g1));
    ov.y = pack2((o[dt][2] - mu) * rstd * gn.z * g2 * sigmoidf_(g2), (o[dt][3] - mu) * rstd * gn.w * g3 * sigmoidf_(g3));
    *(u32x2*)(oret + qrow * LDO + dv) = ov; }
}

__device__ void retstate_task(const P& p, int l, int b, int h, char* smem) {
  float* sKf = (float*)smem; float* sKb = sKf + 64 * 64; float* sV = sKb + 64 * 64;
  const int tid = tidx(), dk = tid >> 2, dq = tid & 3;
  const bf16_t* zt = (const bf16_t*)(p.ws + WS_ZT);
  const float xf = p.ret_decay[(l * 2 + 0) * 8 + h], xb = p.ret_decay[(l * 2 + 1) * 8 + h];
  const float lgf = -log1pf(__expf(-xf)) * LOG2E, lgb = -log1pf(__expf(-xb)) * LOG2E;
  float af[16], ab[16];
#pragma unroll
  for (int i = 0; i < 16; ++i) { af[i] = 0.f; ab[i] = 0.f; }
  for (int kt = 0; kt < 4; ++kt) {
    __syncthreads();
#pragma unroll
    for (int i = 0; i < 2; ++i) { const int c = tid + 256 * i, key = c >> 3, part = c & 7, m = kt * 64 + key; const size_t ro = (size_t)(b * 256 + m) * LZT + h * 64 + part * 8;
      float kf[8], vf[8]; unpack8(*(const u32x4*)(zt + ro + 512), kf); unpack8(*(const u32x4*)(zt + ro + 1024), vf);
      const float wf = 0.125f * exp2f(lgf * (float)(255 - m)), wb = 0.125f * exp2f(lgb * (float)m);
#pragma unroll
      for (int e = 0; e < 8; ++e) { sKf[key * 64 + part * 8 + e] = kf[e] * wf; sKb[key * 64 + part * 8 + e] = kf[e] * wb; sV[key * 64 + part * 8 + e] = vf[e]; } }
    __syncthreads();
    for (int m = 0; m < 64; ++m) { const float kf = sKf[m * 64 + dk], kb = sKb[m * 64 + dk];
#pragma unroll
      for (int i = 0; i < 4; ++i) { const f32x4 vv = *(const f32x4*)(sV + m * 64 + dq * 16 + i * 4);
#pragma unroll
        for (int j = 0; j < 4; ++j) { af[i * 4 + j] += kf * vv[j]; ab[i * 4 + j] += kb * vv[j]; } } }
  }
  float* of = p.out + O_RT + ((((size_t)b * 2 + l) * 2 + 0) * 8 + h) * 4096 + dk * 64 + dq * 16; float* ob = of + 8 * 4096;
#pragma unroll
  for (int i = 0; i < 16; ++i) { of[i] = af[i]; ob[i] = ab[i]; }
}

constexpr int Q_SCAN_L = 128, Q_SCAN_C = 1024, Q_RET_L = 512, Q_NA = 512, Q_DENSE = 1024, Q_RET_C = 1024, Q_RST = 256;
constexpr int Q_TOTAL = Q_SCAN_L + Q_SCAN_C + Q_RET_L + Q_NA + Q_DENSE + Q_RET_C + Q_RST;
template <int QMASK> __device__ void phase_mixers(const P& p, int l, char* smem, int rep = 0) {
  __shared__ int s_task;
  int* ctr = (int*)(p.ws + WS_CTRL) + 64 * (l + 1) + 4 * rep;
  if (QMASK & 1) {
    __shared__ int s_prim;
    if (tidx() == 0) { const unsigned cu = ((unsigned)__builtin_amdgcn_s_getreg((7 << 11) | (8 << 6) | 4) & 0xffu) | (xb_xcc_id() << 8);
      s_prim = (atomicAdd((int*)(p.ws + WS_CUF) + l * 2048 + (int)(cu & 2047u), 1) & 1) == 0 ? 1 : 0; }
    for (;;) {
      __syncthreads();
      if (tidx() == 0) { int tk = -1;
        if (s_prim) { const int t = atomicAdd(ctr, 1); if (t < Q_SCAN_L) tk = t; else s_prim = 0; }
        if (tk < 0) { const int t = atomicAdd(ctr + 1, 1); if (t < Q_SCAN_C) tk = Q_SCAN_L + t; }
        if (tk < 0) { const int t = atomicAdd(ctr, 1); if (t < Q_SCAN_L) tk = t; }
        s_task = tk < 0 ? Q_SCAN_L + Q_SCAN_C : tk; }
      __syncthreads();
      const int tk = s_task;
      if (tk >= Q_SCAN_L + Q_SCAN_C) break;
      const bool lat = tk < Q_SCAN_L; const int t2 = lat ? tk : tk - Q_SCAN_L;
      scan_task(p, l, (lat ? 32 : 0) + (t2 >> 5), (t2 >> 2) & 7, (t2 >> 1) & 1, t2 & 1, smem);
    }
  }
  if (QMASK & 2) for (;;) {
    __syncthreads();
    if (tidx() == 0) s_task = atomicAdd(ctr + 16, 1);
    __syncthreads();
    const int tk = s_task;
    if (tk >= Q_RET_L + Q_RET_C) break;
    if (tk < Q_RET_L) ret_task(p, l, 32 + (tk >> 7), (tk >> 4) & 7, tk & 15, smem);
    else { const int t2 = tk - Q_RET_L; ret_task(p, l, t2 >> 5, (t2 >> 2) & 7, t2 & 3, smem); }
  }
  if (QMASK & 4) for (;;) {
    __syncthreads();
    if (tidx() == 0) s_task = atomicAdd(ctr + 32, 1);
    __syncthreads();
    int tk = s_task;
    if (tk >= Q_NA + Q_DENSE + Q_RST) break;
    if (tk < Q_NA) { na_task(p, l, tk >> 7, (tk >> 4) & 7, tk & 15, smem); continue; } tk -= Q_NA;
    if (tk < Q_DENSE) { dense_task(p, tk >> 5, (tk >> 2) & 7, tk & 3, smem); continue; } tk -= Q_DENSE;
    retstate_task(p, l, tk >> 3, tk & 7, smem);
  }
}

__device__ void phase_rwkv_post(const P& p, int l, char* smem) {
  const bf16_t* zr = (const bf16_t*)(p.ws + WS_ZR); const float* yf = (const float*)(p.ws + WS_Y); const float* yb = yf + (size_t)MT * 512; bf16_t* oa = (bf16_t*)(p.ws + WS_OA);
  const bf16_t* Gt = (const bf16_t*)(p.ws + WS_WG);
  const int tid = tidx(), lane = tid & 63, wave = tid >> 6, wr = wave >> 1, wc = wave & 1, fr = lane & 15, fq = lane >> 4;
  TileIter ti; int mt, nt; ti.init(96, 4);
  while (ti.next(mt, nt)) {
    const int row0 = mt * 128, n0 = nt * 128;
    f32x4 acc[4][4]; zero_acc<4>(acc);
    TileSrc s{zr + 1664, NZR, row0, Gt, LDG, n0, n0 + 64, 128}; gemm_tile<4>(acc, s, smem);
    const int cb = n0 + wc * 64 + fq * 4;
#pragma unroll
    for (int m = 0; m < 4; ++m) { const size_t row = (size_t)(row0 + wr * 64 + m * 16 + fr);
      f32x4 y[4]; float s1 = 0.f, rk = 0.f; f32x4 vv[4];
#pragma unroll
      for (int n = 0; n < 4; ++n) { const int c = cb + n * 16; y[n] = *(const f32x4*)(yf + row * 512 + c) + *(const f32x4*)(yb + row * 512 + c); s1 += y[n][0] + y[n][1] + y[n][2] + y[n][3];
        const u32x2 rr = *(const u32x2*)(zr + row * NZR + c), kk = *(const u32x2*)(zr + row * NZR + 512 + c), v2 = *(const u32x2*)(zr + row * NZR + 1024 + c); const f32x4 rkw = *(const f32x4*)(p.rwkv_r_k + l * 512 + c);
        rk += bflo(rr.x) * bflo(kk.x) * rkw[0] + bfhi(rr.x) * bfhi(kk.x) * rkw[1] + bflo(rr.y) * bflo(kk.y) * rkw[2] + bfhi(rr.y) * bfhi(kk.y) * rkw[3];
        vv[n] = (f32x4){bflo(v2.x), bfhi(v2.x), bflo(v2.y), bfhi(v2.y)}; }
      s1 += __shfl_xor(s1, 16); s1 += __shfl_xor(s1, 32); rk += __shfl_xor(rk, 16); rk += __shfl_xor(rk, 32);
      const float mu = s1 * (1.f / 64.f); float s2 = 0.f;
#pragma unroll
      for (int n = 0; n < 4; ++n)
#pragma unroll
        for (int j = 0; j < 4; ++j) { const float dl = y[n][j] - mu; s2 += dl * dl; }
      s2 += __shfl_xor(s2, 16); s2 += __shfl_xor(s2, 32); const float rstd = rsqrtf(s2 * (1.f / 64.f) + 64e-5f);
#pragma unroll
      for (int n = 0; n < 4; ++n) { const int c = cb + n * 16; const f32x4 lg = *(const f32x4*)(p.rwkv_ln_g + l * 512 + c), lb = *(const f32x4*)(p.rwkv_ln_b + l * 512 + c);
        float o[4];
#pragma unroll
        for (int j = 0; j < 4; ++j) o[j] = ((y[n][j] - mu) * rstd * lg[j] + lb[j] + rk * vv[n][j]) * acc[m][n][j];
        u32x2 ov; ov.x = pack2(o[0], o[1]); ov.y = pack2(o[2], o[3]); *(u32x2*)(oa + row * LDO + c) = ov; }
    }
  }
}

template <int MODE> __device__ void phase_probe_gemm(const P& p, char* smem) {
  const bf16_t* H = (const bf16_t*)(p.ws + WS_H); const bf16_t* Wt = (const bf16_t*)(p.ws + WS_WUP); float* C = (float*)(p.ws + WS_Y);
  const int tid = tidx(), lane = tid & 63, wave = tid >> 6, wr = wave >> 1, wc = wave & 1, fr = lane & 15, fq = lane >> 4;
  TileIter ti; int mt, nt; ti.init(96, 28);
  while (ti.next(mt, nt)) {
    const int n0 = nt * 128, row0 = mt * 128;
    f32x4 acc[4][4]; zero_acc<4>(acc);
    TileSrc s{H, LDH, MODE == 2 ? 0 : row0, Wt, LDH, MODE == 2 ? 0 : n0, MODE == 2 ? 64 : n0 + 64, D}; gemm_tile<4>(acc, s, smem);
#pragma unroll
    for (int m = 0; m < 4; ++m) { const int row = row0 + wr * 64 + m * 16 + fr;
#pragma unroll
      for (int n = 0; n < 4; ++n) *(f32x4*)(C + (size_t)row * D + (n0 & 1023) + wc * 64 + n * 16 + fq * 4) = acc[m][n]; }
  }
}

DI void convert_layer_a(const P& p, int l, char* smem) {
  convert_T(p.w_in + (size_t)l * D * INC, D, INC, (bf16_t*)(p.ws + WS_WIN), LDH, smem);
  convert_T(p.w_o_rwkv + (size_t)l * 512 * D, 512, D, (bf16_t*)(p.ws + WS_WO3), LDO, smem);
  convert_T(p.w_o_na + (size_t)l * 512 * D, 512, D, (bf16_t*)(p.ws + WS_WO3) + (size_t)1024 * LDO, LDO, smem);
  convert_T(p.w_o_ret + (size_t)l * 512 * D, 512, D, (bf16_t*)(p.ws + WS_WO3) + (size_t)2 * 1024 * LDO, LDO, smem);
  convert_T(p.w_out + (size_t)l * D * D, D, D, (bf16_t*)(p.ws + WS_WOUT), LDH, smem);
  convert_T(p.rwkv_g_up + (size_t)l * 128 * 512, 128, 512, (bf16_t*)(p.ws + WS_WG), LDG, smem);
}
DI void convert_layer_b(const P& p, int l, char* smem) {
  convert_T(p.ffn_up + (size_t)l * D * 2 * FF, D, 2 * FF, (bf16_t*)(p.ws + WS_WUP), LDH, smem);
  convert_T(p.ffn_down + (size_t)l * FF * D, FF, D, (bf16_t*)(p.ws + WS_WDN), FF, smem);
}

template <int PH> DI void run_phase(const P& p, int l, char* smem) {
  const float* mod = (const float*)(p.ws + WS_MOD);
  float* xbuf = p.out;
  if (PH == 0) { ada_phase(p, smem); convert_layer_a(p, 0, smem); }
  else if (PH == 1) { norm_phase(p, nullptr, nullptr, nullptr, nullptr, 0, nullptr, p.norm_mix_pre, mod, 0, (bf16_t*)(p.ws + WS_H)); }
  else if (PH == 2) phase_win(p, l, smem);
  else if (PH == 4) phase_mixers<7>(p, l, smem);
  else if (PH == 5) phase_rwkv_post(p, l, smem);
  else if (PH == 6) phase_merge(p, smem);
  else if (PH == 7) { phase_gemm_f32((const bf16_t*)(p.ws + WS_MERGED), LDH, D, (const bf16_t*)(p.ws + WS_WOUT), LDH, (float*)(p.ws + WS_U), smem); }
  else if (PH == 8) { convert_layer_b(p, l, smem);
    norm_phase(p, l == 0 ? nullptr : xbuf, (const float*)(p.ws + WS_U), p.norm_mix_post + l * D, mod + (size_t)l * 5 * 6144, 2, xbuf, p.norm_ffn_pre + l * D, mod + (size_t)l * 5 * 6144, 3, (bf16_t*)(p.ws + WS_H)); }
  else if (PH == 9) phase_ffn_up(p, l, smem);
  else if (PH == 11) { phase_gemm_f32((const bf16_t*)(p.ws + WS_HID), FF, FF, (const bf16_t*)(p.ws + WS_WDN), FF, (float*)(p.ws + WS_F), smem); }
  else if (PH == 12) {
    if (l == 0) { norm_phase(p, xbuf, (const float*)(p.ws + WS_F), p.norm_ffn_post, mod, 5, xbuf, p.norm_mix_pre + D, mod + (size_t)5 * 6144, 0, (bf16_t*)(p.ws + WS_H)); convert_layer_a(p, 1, smem); }
    else norm_phase(p, xbuf, (const float*)(p.ws + WS_F), p.norm_ffn_post + D, mod + (size_t)5 * 6144, 5, xbuf, nullptr, nullptr, 0, nullptr);
  }
}

#if MEGA
__global__ void __launch_bounds__(NT, 2) mega_kernel(P p) {
  extern __shared__ __attribute__((aligned(16))) char smem[];
  __shared__ u32x4 xb_words;
  cg::grid_group grid = cg::this_grid();
  if (tidx() == 0) xb_words = (u32x4){0u, 0u, 0u, 0u};
  __syncthreads();
  const XcdBarrier xb = xcd_barrier_post((unsigned*)(p.ws + WS_BAR), (volatile LAS unsigned*)&xb_words);
#define GSYNC() xcd_barrier(xb)
  run_phase<0>(p, 0, smem); grid.sync();
  run_phase<1>(p, 0, smem); GSYNC();
#pragma unroll 1
  for (int l = 0; l < 2; ++l) {
    run_phase<2>(p, l, smem); GSYNC();
    if (PROBE_MASK & 1) { run_phase<2>(p, l, smem); GSYNC(); }
    run_phase<4>(p, l, smem); GSYNC();
    if (PROBE_MASK & 2) { phase_mixers<1>(p, l, smem, 1); GSYNC(); }
    if (PROBE_MASK & 256) { phase_mixers<2>(p, l, smem, 1); GSYNC(); }
    if (PROBE_MASK & 512) { phase_mixers<4>(p, l, smem, 1); GSYNC(); }
    run_phase<5>(p, l, smem); GSYNC();
    if (PROBE_MASK & 4) { run_phase<5>(p, l, smem); GSYNC(); }
    run_phase<6>(p, l, smem); GSYNC();
    if (PROBE_MASK & 8) { run_phase<6>(p, l, smem); GSYNC(); }
    run_phase<7>(p, l, smem); GSYNC();
    if (PROBE_MASK & 16) { run_phase<7>(p, l, smem); GSYNC(); }
    run_phase<8>(p, l, smem); GSYNC();
    run_phase<9>(p, l, smem); GSYNC();
    if (PROBE_MASK & 1024) { phase_probe_gemm<1>(p, smem); GSYNC(); }
    if (PROBE_MASK & 2048) { phase_probe_gemm<2>(p, smem); GSYNC(); }
    if (PROBE_MASK & 32) { run_phase<9>(p, l, smem); GSYNC(); }
    run_phase<11>(p, l, smem); GSYNC();
    if (PROBE_MASK & 64) { run_phase<11>(p, l, smem); GSYNC(); }
    if (PROBE_MASK & 128) { convert_layer_a(p, l, smem); GSYNC(); convert_layer_b(p, l, smem); GSYNC(); }
    run_phase<12>(p, l, smem); if (l == 0) GSYNC();
  }
#undef GSYNC
}
#else
template <int PH> __global__ void __launch_bounds__(NT, 2) phase_kernel(P p, int l) {
  extern __shared__ __attribute__((aligned(16))) char smem[];
  run_phase<PH>(p, l, smem);
}
#endif

extern "C" void kernel_launch(void* const* d_in, const int* in_sizes, int n_in, void* d_out, int out_size, void* d_ws, size_t ws_size, hipStream_t stream) {
  if (ws_size < WS_END || n_in < 36) { fprintf(stderr, "workspace too small: %zu < %zu\n", ws_size, (size_t)WS_END); return; }
  P p{};
  const float** pp = (const float**)&p;
  for (int i = 0; i < 36; ++i) pp[i] = (const float*)d_in[i];
  p.out = (float*)d_out; p.ws = (char*)d_ws;
  hipMemsetAsync(d_ws, 0, WS_WIN, stream);
#if MEGA
  static int grid_blocks = 0;
  if (!grid_blocks) {
    int dev = 0, cus = 0, per_cu = 0; hipGetDevice(&dev);
    hipDeviceGetAttribute(&cus, hipDeviceAttributeMultiprocessorCount, dev);
    hipFuncSetAttribute((const void*)mega_kernel, hipFuncAttributeMaxDynamicSharedMemorySize, SMEM_BYTES);
    hipOccupancyMaxActiveBlocksPerMultiprocessor(&per_cu, mega_kernel, NT, SMEM_BYTES);
    if (per_cu > 2) per_cu = 2;
    grid_blocks = cus * per_cu;
  }
  void* args[] = {&p};
  hipError_t e = hipLaunchCooperativeKernel((void*)mega_kernel, dim3(grid_blocks), dim3(NT), args, SMEM_BYTES, stream);
  if (e != hipSuccess) fprintf(stderr, "cooperative launch failed: %s (grid %d)\n", hipGetErrorString(e), grid_blocks);
#else
  const int G = 512;
#define LAUNCH(PH, L) do { hipFuncSetAttribute((const void*)phase_kernel<PH>, hipFuncAttributeMaxDynamicSharedMemorySize, SMEM_BYTES); phase_kernel<PH><<<G, NT, SMEM_BYTES, stream>>>(p, L); } while (0)
  LAUNCH(0, 0); LAUNCH(1, 0);
  for (int l = 0; l < 2; ++l) { LAUNCH(2, l); LAUNCH(4, l); LAUNCH(5, l); LAUNCH(6, l); LAUNCH(7, l); LAUNCH(8, l); LAUNCH(9, l); LAUNCH(11, l); LAUNCH(12, l); }
#endif
}
```

```cpp
#include <hip/hip_runtime.h>
#include <hip/hip_cooperative_groups.h>
#include <cstdio>
namespace cg = cooperative_groups;

#ifndef MEGA
#define MEGA 1
#endif
#define PROBE_MASK 0

typedef unsigned short bf16_t;
typedef short bf16x8 __attribute__((ext_vector_type(8)));
typedef short bf16x4 __attribute__((ext_vector_type(4)));
typedef float f32x4 __attribute__((ext_vector_type(4)));
typedef float f32x2 __attribute__((ext_vector_type(2)));
typedef unsigned u32x4 __attribute__((ext_vector_type(4)));
typedef unsigned u32x2 __attribute__((ext_vector_type(2)));
#define DI __device__ __forceinline__
#define MFMA16(a, b, c) __builtin_amdgcn_mfma_f32_16x16x32_bf16((a), (b), (c), 0, 0, 0)

constexpr int NT = 256;
constexpr int NTP = 512;
constexpr int VSMEM = 65536;
constexpr int D = 1024, MC = 8192, ML = 4096, MT = 12288;
constexpr int NZR = 1792, NZN = 1536, NZT = 2048, INC = 8448, FF = 2816;
constexpr int LDH = 1088, LDO = 576, LZT = 2112, LDG = 136;
constexpr int LDT = 72;
constexpr int SMEM_BYTES = 131072;
constexpr size_t O_K = 12582912, O_V = 20971520, O_RW = 29360128, O_RT = 33554432;
constexpr size_t WS_CTRL = 0;
constexpr size_t WS_MOD = 4096;
constexpr size_t WS_BAR = 262144;
constexpr size_t WS_CUF = 278528;
constexpr size_t WS_WG = 294912;
constexpr size_t WS_WIN = 434176;
constexpr size_t WS_WUP = WS_WIN;
constexpr size_t WS_WDN = WS_WIN + (size_t)5632 * LDH * 2;
constexpr size_t WS_WO3 = WS_WIN + (size_t)INC * LDH * 2;
constexpr size_t WS_WOUT = WS_WO3 + (size_t)3 * 1024 * LDO * 2;
constexpr size_t WS_H = WS_WOUT + (size_t)1024 * LDH * 2;
constexpr size_t WS_Z = WS_H + (size_t)MT * LDH * 2;
constexpr size_t WS_ZR = WS_Z;
constexpr size_t WS_ZN = WS_ZR + (size_t)MT * NZR * 2;
constexpr size_t WS_ZT = WS_ZN + (size_t)MT * NZN * 2;
constexpr size_t WS_MERGED = WS_ZR;
constexpr size_t WS_OA = WS_ZN;
constexpr size_t WS_U = WS_ZT;
constexpr size_t WS_HID = WS_Z;
constexpr size_t WS_F = WS_ZT;
constexpr size_t WS_Y = WS_ZT + (size_t)MT * LZT * 2;
constexpr size_t WS_ONA = WS_Y + (size_t)2 * MT * 512 * 4;
constexpr size_t WS_ORET = WS_ONA + (size_t)MT * LDO * 2;
constexpr size_t WS_END = WS_ORET + (size_t)MT * LDO * 2;

struct P {
  const float *x_prompt, *x_sample, *cache_k, *cache_v, *state_rwkv, *state_ret, *c, *c_ctx, *ada_w, *ada_b;
  const float *norm_mix_pre, *norm_mix_post, *norm_ffn_pre, *norm_ffn_post, *w_in, *rwkv_conv, *rwkv_w0, *rwkv_w_up, *rwkv_a0, *rwkv_a_up, *rwkv_g_up;
  const float *rwkv_k_k, *rwkv_k_a, *rwkv_r_k, *rwkv_ln_g, *rwkv_ln_b, *na_rpb, *ret_decay, *ret_gn, *w_o_rwkv, *w_o_na, *w_o_ret, *w_out, *ffn_up, *ffn_conv, *ffn_down;
  float* out; char* ws;
};

DI int threadIdx_x_raw() { return (int)__builtin_amdgcn_workitem_id_x(); }
DI int ptid() { int t = threadIdx_x_raw(); asm volatile("" : "+v"(t)); return t; }
DI int tidx() { return ptid() & 255; }
DI int vhalf() { return ptid() >> 8; }
DI int vblk() { return (int)blockIdx.x * 2 + vhalf(); }
DI int vgrid() { return (int)gridDim.x * 2; }
DI bf16_t f2bf(float x) { unsigned u = __float_as_uint(x); u += 0x7fffu + ((u >> 16) & 1u); return (bf16_t)(u >> 16); }
DI float bf2f(bf16_t b) { return __uint_as_float(((unsigned)b) << 16); }
DI unsigned pack2(float a, float b) { return (unsigned)f2bf(a) | ((unsigned)f2bf(b) << 16); }
DI float bflo(unsigned u) { return __uint_as_float(u << 16); }
DI float bfhi(unsigned u) { return __uint_as_float(u & 0xffff0000u); }
DI void unpack8(const u32x4 r, float (&f)[8]) { f[0] = bflo(r[0]); f[1] = bfhi(r[0]); f[2] = bflo(r[1]); f[3] = bfhi(r[1]); f[4] = bflo(r[2]); f[5] = bfhi(r[2]); f[6] = bflo(r[3]); f[7] = bfhi(r[3]); }
DI u32x4 pack8(const float (&f)[8]) { u32x4 r; r[0] = pack2(f[0], f[1]); r[1] = pack2(f[2], f[3]); r[2] = pack2(f[4], f[5]); r[3] = pack2(f[6], f[7]); return r; }
DI float sigmoidf_(float x) { return 1.f / (1.f + __expf(-x)); }
DI float shfl_x(float v, int m) { const int lane = ptid() & 63; return __int_as_float(__builtin_amdgcn_ds_bpermute((lane ^ m) << 2, __float_as_int(v))); }
DI float wave_sum(float v) { for (int o = 32; o > 0; o >>= 1) v += shfl_x(v, o); return v; }
DI void tokinfo(int m, int& t, int& T, int& mi) { if (m < MC) { t = m & 255; T = 256; mi = 0; } else { int q = m - MC; t = q & 1023; T = 1024; mi = 1 + (q >> 10); } }

#define XB_TMO      128
#define XB_XCNT(j)  (256  + 64 * (j))
#define XB_XSUB(j)  (1280 + 64 * (j))
#define XB_XGEN(j)  (2304 + 64 * (j))
#define XB_TOP      3328
#define XB_TOPGEN   3392
#define XB_SPIN_CAP (1u << 20)
#define LAS __attribute__((address_space(3)))
DI unsigned xb_ld(unsigned* p) { return __hip_atomic_load(p, __ATOMIC_RELAXED, __HIP_MEMORY_SCOPE_AGENT); }
DI unsigned xb_add(unsigned* p, unsigned v) { return __hip_atomic_fetch_add(p, v, __ATOMIC_RELAXED, __HIP_MEMORY_SCOPE_AGENT); }
DI unsigned xb_xcc_id() { return (unsigned)__builtin_amdgcn_s_getreg((3 << 11) | 20) & 0xFu; }
#define XB_SPIN(cond, bar) do { unsigned _sp = 0; while (cond) { __builtin_amdgcn_s_sleep(1); \
    if ((++_sp & 255u) == 0u) { if (xb_ld(&(bar)[XB_TMO])) break; if (_sp > XB_SPIN_CAP) { atomicAdd(&(bar)[XB_TMO], 1u); break; } } } } while (0)
struct XcdBarrier { unsigned* bar; unsigned x; volatile LAS unsigned* st; };
DI XcdBarrier xcd_barrier_post(unsigned* bar, volatile LAS unsigned* st) {
  XcdBarrier b; b.bar = bar; b.x = xb_xcc_id(); b.st = st;
  if (ptid() == 0) (void)xb_add(&bar[XB_XCNT(b.x)], 1u);
  return b;
}
DI void xcd_barrier_complete(unsigned* bar, unsigned x, unsigned& nloc, unsigned& nx) {
  const unsigned G = gridDim.x * gridDim.y * gridDim.z;
  unsigned sum, cnt, mine, sp = 0u;
  for (;;) {
    sum = 0u; cnt = 0u; mine = 0u;
#pragma unroll
    for (unsigned j = 0; j < 16; ++j) { const unsigned c = xb_ld(&bar[XB_XCNT(j)]); sum += c; cnt += (c > 0u) ? 1u : 0u; mine = (j == x) ? c : mine; }
    if (sum == G) break;
    __builtin_amdgcn_s_sleep(1);
    if ((++sp & 255u) == 0u) { if (xb_ld(&bar[XB_TMO])) break; if (sp > XB_SPIN_CAP) { atomicAdd(&bar[XB_TMO], 1u); break; } }
  }
  nloc = mine > 0u ? mine : 1u; nx = cnt > 0u ? cnt : 1u;
}
DI void xcd_barrier(const XcdBarrier& b) {
  asm volatile("s_waitcnt vmcnt(0)" ::: "memory");
  __syncthreads();
  if (ptid() == 0) {
    unsigned* bar = b.bar;
    __builtin_amdgcn_s_waitcnt(0);
    unsigned nloc = b.st[0], nx = b.st[1];
    if (nloc == 0u) { xcd_barrier_complete(bar, b.x, nloc, nx); b.st[0] = nloc; b.st[1] = nx; }
    const unsigned old = xb_add(&bar[XB_XSUB(b.x)], 1u);
    const unsigned gen = old / nloc;
    if (old + 1u == (gen + 1u) * nloc) {
      __builtin_amdgcn_fence(__ATOMIC_RELEASE, "agent");
      asm volatile("s_waitcnt vmcnt(0)" ::: "memory");
      const unsigned og = xb_add(&bar[XB_TOP], 1u);
      const unsigned tg = og / nx;
      if (og + 1u == (tg + 1u) * nx) xb_add(&bar[XB_TOPGEN], 1u);
      else XB_SPIN(xb_ld(&bar[XB_TOPGEN]) == tg, bar);
      __builtin_amdgcn_fence(__ATOMIC_ACQUIRE, "agent");
      xb_add(&bar[XB_XGEN(b.x)], 1u);
      asm volatile("s_waitcnt vmcnt(0)" ::: "memory");
    } else {
      XB_SPIN(xb_ld(&bar[XB_XGEN(b.x)]) == gen, bar);
      __builtin_amdgcn_fence(__ATOMIC_ACQUIRE, "agent");
      asm volatile("s_waitcnt vmcnt(0)" ::: "memory");
    }
  }
  __syncthreads();
}

__device__ void convert_T(const float* __restrict__ W, int K, int N, bf16_t* __restrict__ Wt, int ldt, char* smem) {
  float* t = (float*)(smem + vhalf() * VSMEM);
  const int tid = tidx(), ntn = N >> 6, nitems = (K >> 6) * ntn;
  for (int it = vblk(); it < nitems; it += vgrid()) {
    const int k0 = (it / ntn) << 6, n0 = (it % ntn) << 6;
    __syncthreads();
#pragma unroll
    for (int i = 0; i < 4; ++i) { const int k = (tid >> 4) + 16 * i, c4 = (tid & 15) * 4;
      const float4 v = *(const float4*)(W + (size_t)(k0 + k) * N + n0 + c4);
      t[k * 65 + c4] = v.x; t[k * 65 + c4 + 1] = v.y; t[k * 65 + c4 + 2] = v.z; t[k * 65 + c4 + 3] = v.w; }
    __syncthreads();
#pragma unroll
    for (int i = 0; i < 2; ++i) { const int c = tid + 256 * i, n = c >> 3, kc = c & 7; float f[8];
#pragma unroll
      for (int e = 0; e < 8; ++e) f[e] = t[(kc * 8 + e) * 65 + n];
      *(u32x4*)(Wt + (size_t)(n0 + n) * ldt + k0 + kc * 8) = pack8(f); }
  }
}

__device__ void ada_phase(const P& p, char* smem) {
  float* sc = (float*)(smem + vhalf() * VSMEM);
  float* red = sc + 640;
  float* mod = (float*)(p.ws + WS_MOD);
  const int tid = tidx(), kq = tid >> 5, cq = tid & 31;
  for (int it = vblk(); it < 2 * 48 * 8; it += vgrid()) {
    const int l = it / 384, rem = it % 384, nb = rem >> 3, ks = rem & 7;
    const int n0 = nb * 128, k0 = ks * 128;
    __syncthreads();
    for (int e = tid; e < 640; e += NT) { const int i = e >> 7, k = e & 127; const float v = (i == 0) ? p.c_ctx[k0 + k] : p.c[(i - 1) * D + k0 + k]; sc[e] = v * sigmoidf_(v); }
    __syncthreads();
    float acc[5][4];
#pragma unroll
    for (int i = 0; i < 5; ++i)
#pragma unroll
      for (int j = 0; j < 4; ++j) acc[i][j] = 0.f;
    const float* wp = p.ada_w + ((size_t)l * D + k0 + kq * 16) * 6144 + n0 + cq * 4;
#pragma unroll 4
    for (int kk = 0; kk < 16; ++kk) { const float4 w = *(const float4*)(wp + (size_t)kk * 6144);
#pragma unroll
      for (int i = 0; i < 5; ++i) { const float s = sc[i * 128 + kq * 16 + kk]; acc[i][0] += s * w.x; acc[i][1] += s * w.y; acc[i][2] += s * w.z; acc[i][3] += s * w.w; } }
#pragma unroll
    for (int i = 0; i < 5; ++i)
#pragma unroll
      for (int j = 0; j < 4; ++j) red[(kq * 5 + i) * 128 + cq * 4 + j] = acc[i][j];
    __syncthreads();
    for (int e = tid; e < 640; e += NT) { const int i = e >> 7, n = e & 127; float s = 0.f;
#pragma unroll
      for (int q = 0; q < 8; ++q) s += red[(q * 5 + i) * 128 + n];
      if (ks == 0) s += p.ada_b[l * 6144 + n0 + n];
      atomicAdd(mod + ((size_t)l * 5 + i) * 6144 + n0 + n, s); }
  }
}

__device__ void norm_phase(const P& p, const float* xin  , const float* u, const float* gpost, const float* modU, int gate_idx,
                           float* xout, const float* gpre, const float* modN, int shift_idx, bf16_t* hout) {
  const int lane = tidx() & 63, wave = tidx() >> 6, nw = NT / 64;
  for (int m = vblk() * nw + wave; m < MT; m += vgrid() * nw) {
    int t, T, mi; tokinfo(m, t, T, mi);
    const float* xr = xin ? xin + (size_t)m * D : (m < MC ? p.x_prompt + (size_t)m * D : p.x_sample + (size_t)(m - MC) * D);
    float4 x[4];
#pragma unroll
    for (int i = 0; i < 4; ++i) x[i] = *(const float4*)(xr + i * 256 + lane * 4);
    if (u) {
      float4 uu[4]; float ss = 0.f;
#pragma unroll
      for (int i = 0; i < 4; ++i) { uu[i] = *(const float4*)(u + (size_t)m * D + i * 256 + lane * 4); ss += uu[i].x * uu[i].x + uu[i].y * uu[i].y + uu[i].z * uu[i].z + uu[i].w * uu[i].w; }
      ss = wave_sum(ss); const float rs = rsqrtf(ss * (1.f / D) + 1e-6f);
#pragma unroll
      for (int i = 0; i < 4; ++i) { const int c = i * 256 + lane * 4; const float4 g = *(const float4*)(gpost + c); const float4 ga = *(const float4*)(modU + ((size_t)mi * 6 + gate_idx) * D + c);
        x[i].x += ga.x * uu[i].x * rs * g.x; x[i].y += ga.y * uu[i].y * rs * g.y; x[i].z += ga.z * uu[i].z * rs * g.z; x[i].w += ga.w * uu[i].w * rs * g.w; }
    }
    if (xout) {
#pragma unroll
      for (int i = 0; i < 4; ++i) *(float4*)(xout + (size_t)m * D + i * 256 + lane * 4) = x[i];
    }
    if (hout) {
      float ss = 0.f;
#pragma unroll
      for (int i = 0; i < 4; ++i) ss += x[i].x * x[i].x + x[i].y * x[i].y + x[i].z * x[i].z + x[i].w * x[i].w;
      ss = wave_sum(ss); const float rs = rsqrtf(ss * (1.f / D) + 1e-6f);
#pragma unroll
      for (int i = 0; i < 4; ++i) { const int c = i * 256 + lane * 4; const float4 g = *(const float4*)(gpre + c);
        const float4 sh = *(const float4*)(modN + ((size_t)mi * 6 + shift_idx) * D + c); const float4 sc = *(const float4*)(modN + ((size_t)mi * 6 + shift_idx + 1) * D + c);
        u32x2 o; o.x = pack2(x[i].x * rs * g.x * (1.f + sc.x) + sh.x, x[i].y * rs * g.y * (1.f + sc.y) + sh.y); o.y = pack2(x[i].z * rs * g.z * (1.f + sc.z) + sh.z, x[i].w * rs * g.w * (1.f + sc.w) + sh.w);
        *(u32x2*)(hout + (size_t)m * LDH + c) = o; }
    }
  }
}

struct TileSrc { const bf16_t* A; int lda; int arow0; const bf16_t* B; int ldb; int brow0, brow1; int K; };

template <int MM, int NN> DI void zero_acc(f32x4 (&acc)[MM][NN]) {
#pragma unroll
  for (int m = 0; m < MM; ++m)
#pragma unroll
    for (int n = 0; n < NN; ++n) acc[m][n] = (f32x4){0.f, 0.f, 0.f, 0.f};
}

template <int MM, int NN> DI void gemm_tile(f32x4 (&acc)[MM][NN], const TileSrc& s, char* smem) {
  constexpr int NA = MM / 2, NB = NN;
  bf16_t* sbase = (bf16_t*)smem;
  const int tid = ptid(), lane = tid & 63, wave = tid >> 6, wr = wave >> 2, wc = wave & 3, fr = lane & 15, fq = lane >> 4;
  unsigned oa_[NA], ob_[NB];
#pragma unroll
  for (int i = 0; i < NA; ++i) { const int row = (tid >> 3) + 64 * i, kc = tid & 7;
    int ar = s.arow0 + row; ar = ar < 0 ? 0 : (ar > MT - 1 ? MT - 1 : ar);
    oa_[i] = (unsigned)ar * (unsigned)s.lda + kc * 8; }
#pragma unroll
  for (int i = 0; i < NB; ++i) { const int row = (tid >> 3) + 64 * i, kc = tid & 7;
    const int br = row < 32 * NN ? s.brow0 + row : s.brow1 + row - 32 * NN;
    ob_[i] = (unsigned)br * (unsigned)s.ldb + kc * 8; }
  int wofs; { const int r = tid >> 3, kc = tid & 7, ob = (r & 15) * 64 + (kc & 3) * 16; wofs = (((r >> 4) * 2 + (kc >> 2)) * 1024 + (ob ^ (((ob >> 9) & 1) << 5))) >> 1; }
  int robase; { const int ob = fr * 64 + fq * 16; robase = (ob ^ (((ob >> 9) & 1) << 5)) >> 1; }
  const int nk = s.K >> 6;
  u32x4 ra[NA], rb[NB];
#define GT_LOAD(KT) do { const int kn_ = ((KT) < nk ? (KT) : nk - 1) * 64; \
    _Pragma("unroll") for (int i = 0; i < NA; ++i) ra[i] = *(const u32x4*)(s.A + (oa_[i] + kn_)); \
    _Pragma("unroll") for (int i = 0; i < NB; ++i) rb[i] = *(const u32x4*)(s.B + (ob_[i] + kn_)); } while (0)
#define GT_STORE(ST) do { bf16_t* sA_ = sbase + (ST) * 32768; bf16_t* sB_ = sA_ + 16384; \
    _Pragma("unroll") for (int i = 0; i < NA; ++i) *(u32x4*)(sA_ + wofs + i * 4096) = ra[i]; \
    _Pragma("unroll") for (int i = 0; i < NB; ++i) *(u32x4*)(sB_ + wofs + i * 4096) = rb[i]; } while (0)
#define GT_COMPUTE(ST) do { const bf16_t* sA_ = sbase + (ST) * 32768 + robase; const bf16_t* sB_ = sA_ + 16384; \
    _Pragma("unroll 1") for (int ks = 0; ks < 2; ++ks) { bf16x8 bfr[NN]; \
      _Pragma("unroll") for (int n = 0; n < NN; ++n) bfr[n] = *(const bf16x8*)(sB_ + ((wc * NN + n) * 2 + ks) * 512); \
      _Pragma("unroll") for (int m = 0; m < MM; ++m) { const bf16x8 af = *(const bf16x8*)(sA_ + ((wr * MM + m) * 2 + ks) * 512); \
        _Pragma("unroll") for (int n = 0; n < NN; ++n) acc[m][n] = MFMA16(bfr[n], af, acc[m][n]); } } } while (0)
  GT_LOAD(0);
  __syncthreads();
  GT_STORE(0);
  GT_LOAD(1);
  __syncthreads();
#pragma unroll 1
  for (int kt = 0; kt < nk; kt += 2) {
    GT_STORE(1); GT_LOAD(kt + 2); GT_COMPUTE(0); __syncthreads();
    GT_STORE(0); GT_LOAD(kt + 3); GT_COMPUTE(1); __syncthreads();
  }
#undef GT_LOAD
#undef GT_STORE
#undef GT_COMPUTE
}

DI float gelu_tanh(float x) { const float u = 0.7978845608f * (x + 0.044715f * x * x * x); const float e = __expf(2.f * u); const float th = 1.f - 2.f / (e + 1.f); return 0.5f * x * (1.f + th); }

struct TileIter {
  int m_lo, rows, NTn, G, efull, count, e, stride;
  DI void init(int MTn, int NTn_) { const int x = blockIdx.x & 7; m_lo = (x * MTn) >> 3; rows = (((x + 1) * MTn) >> 3) - m_lo; NTn = NTn_; G = (rows + 1) >> 1;
    efull = (rows / G) * G * NTn; count = rows * NTn; e = blockIdx.x >> 3; stride = gridDim.x >> 3; }
  DI bool next(int& mt, int& nt) { if (e >= count) return false;
    if (e < efull) { const int grp = e / (G * NTn), rem = e - grp * G * NTn; nt = rem / G; mt = m_lo + grp * G + (rem - nt * G); }
    else { const int rem = e - efull, gsz = rows - (rows / G) * G; nt = rem / gsz; mt = m_lo + (rows / G) * G + (rem - nt * gsz); }
    e += stride; return true; }
};

__device__ void phase_win(const P& p, int l, char* smem) {
  const bf16_t* H = (const bf16_t*)(p.ws + WS_H); const bf16_t* Wt = (const bf16_t*)(p.ws + WS_WIN);
  bf16_t* zr = (bf16_t*)(p.ws + WS_ZR); bf16_t* zn = (bf16_t*)(p.ws + WS_ZN); bf16_t* zt = (bf16_t*)(p.ws + WS_ZT);
  const int tid = ptid(), lane = tid & 63, wave = tid >> 6, wr = wave >> 2, wc = wave & 3, fr = lane & 15, fq = lane >> 4;
  TileIter ti; int mt, nt;
  ti.init(49, 7);
  while (ti.next(mt, nt)) {
    f32x4 acc[8][4]; zero_acc<8, 4>(acc);
    const int n0 = nt * 256, arow0 = mt * 254 - 1;
    TileSrc s{H, LDH, arow0, Wt, LDH, n0, n0 + 128, D};
    gemm_tile<8, 4>(acc, s, smem);
    float* sC = (float*)smem;
    const float* cw = p.rwkv_conv + (size_t)l * 3 * NZR;
#pragma unroll 1
    for (int sl = 0; sl < 4; ++sl) {
      __syncthreads();
      if (wc == sl) {
#pragma unroll
        for (int m = 0; m < 8; ++m)
#pragma unroll
          for (int n = 0; n < 4; ++n) *(f32x4*)(sC + (wr * 128 + m * 16 + fr) * 68 + n * 16 + fq * 4) = acc[m][n];
      }
      __syncthreads();
      const int nb = n0 + sl * 64;
      for (int e = tid; e < 254 * 16; e += NTP) {
        const int tr = 1 + (e >> 4), c4 = (e & 15) * 4, g = arow0 + tr;
        if (g < MT) { int t, T, mi; tokinfo(g, t, T, mi);
          const float pm = t > 0 ? 1.f : 0.f, nm = t < T - 1 ? 1.f : 0.f;
          const f32x4 a = *(const f32x4*)(sC + (tr - 1) * 68 + c4), b = *(const f32x4*)(sC + tr * 68 + c4), c = *(const f32x4*)(sC + (tr + 1) * 68 + c4);
          const float4 w0 = *(const float4*)(cw + nb + c4), w1 = *(const float4*)(cw + NZR + nb + c4), w2 = *(const float4*)(cw + 2 * NZR + nb + c4);
          float r0 = pm * a[0] * w0.x + b[0] * w1.x + nm * c[0] * w2.x, r1 = pm * a[1] * w0.y + b[1] * w1.y + nm * c[1] * w2.y;
          float r2 = pm * a[2] * w0.z + b[2] * w1.z + nm * c[2] * w2.z, r3 = pm * a[3] * w0.w + b[3] * w1.w + nm * c[3] * w2.w;
          if (nb >= 1664) { r0 = sigmoidf_(r0); r1 = sigmoidf_(r1); r2 = sigmoidf_(r2); r3 = sigmoidf_(r3); }
          u32x2 o; o.x = pack2(r0, r1); o.y = pack2(r2, r3);
          *(u32x2*)(zr + (size_t)g * NZR + nb + c4) = o; }
      }
    }
  }
  ti.init(48, 14);
  while (ti.next(mt, nt)) {
    f32x4 acc[8][4]; zero_acc<8, 4>(acc);
    const int n0 = nt * 256, row0 = mt * 256;
    TileSrc s{H, LDH, row0, Wt, LDH, NZR + n0, NZR + n0 + 128, D};
    gemm_tile<8, 4>(acc, s, smem);
#pragma unroll
    for (int m = 0; m < 8; ++m) { const int row = row0 + wr * 128 + m * 16 + fr;
#pragma unroll
      for (int n = 0; n < 4; ++n) { const int col = n0 + wc * 64 + n * 16 + fq * 4; const f32x4 v = acc[m][n];
        u32x2 o; o.x = pack2(v[0], v[1]); o.y = pack2(v[2], v[3]);
        if (col < NZN) {
          *(u32x2*)(zn + (size_t)row * NZN + col) = o;
          if (row < MC && col >= 512) { const int part = col - 512, isv = part >> 9, pp = part & 511, hh = pp >> 6, d = pp & 63, b = row >> 8, t = row & 255;
            float* dst = p.out + (isv ? O_V : O_K) + ((((size_t)b * 2 + l) * 8 + hh) * 256 + t) * 64 + d; *(f32x4*)dst = v; }
        } else { *(u32x2*)(zt + (size_t)row * LZT + (col - NZN)) = o; }
      } }
  }
}

__device__ void phase_merge(const P& p, char* smem) {
  const bf16_t* H = (const bf16_t*)(p.ws + WS_H); const bf16_t* Wt = (const bf16_t*)(p.ws + WS_WIN); const bf16_t* Wo3 = (const bf16_t*)(p.ws + WS_WO3);
  bf16_t* mg = (bf16_t*)(p.ws + WS_MERGED);
  const int tid = ptid(), lane = tid & 63, wave = tid >> 6, wr = wave >> 2, wc = wave & 3, fr = lane & 15, fq = lane >> 4;
  TileIter ti; int mt, nt; ti.init(96, 8);
  while (ti.next(mt, nt)) {
    const int n0 = nt * 128, row0 = mt * 128;
    f32x4 macc[4][2]; zero_acc<4, 2>(macc);
#pragma unroll 1
    for (int i = 0; i < 3; ++i) {
      const bf16_t* O = (const bf16_t*)(p.ws + (i == 0 ? WS_OA : (i == 1 ? WS_ONA : WS_ORET)));
      f32x4 g[4][2]; zero_acc<4, 2>(g);
      { TileSrc s{H, LDH, row0, Wt, LDH, 5376 + i * 1024 + n0, 5376 + i * 1024 + n0 + 64, D}; gemm_tile<4, 2>(g, s, smem); }
      f32x4 a2[4][2]; zero_acc<4, 2>(a2);
      { TileSrc s{O, LDO, row0, Wo3 + (size_t)i * 1024 * LDO, LDO, n0, n0 + 64, 512}; gemm_tile<4, 2>(a2, s, smem); }
#pragma unroll
      for (int m = 0; m < 4; ++m)
#pragma unroll
        for (int n = 0; n < 2; ++n)
#pragma unroll
          for (int j = 0; j < 4; ++j) macc[m][n][j] += sigmoidf_(g[m][n][j]) * a2[m][n][j];
    }
#pragma unroll
    for (int m = 0; m < 4; ++m) { const int row = row0 + wr * 64 + m * 16 + fr;
#pragma unroll
      for (int n = 0; n < 2; ++n) { const int col = n0 + wc * 32 + n * 16 + fq * 4; u32x2 o; o.x = pack2(macc[m][n][0], macc[m][n][1]); o.y = pack2(macc[m][n][2], macc[m][n][3]); *(u32x2*)(mg + (size_t)row * LDH + col) = o; } }
  }
}

__device__ void phase_gemm_f32(const bf16_t* A, int lda, int K, const bf16_t* Bt, int ldb, float* C, char* smem) {
  const int tid = ptid(), lane = tid & 63, wave = tid >> 6, wr = wave >> 2, wc = wave & 3, fr = lane & 15, fq = lane >> 4;
  TileIter ti; int mt, nt; ti.init(48, 4);
  while (ti.next(mt, nt)) {
    const int n0 = nt * 256, row0 = mt * 256;
    f32x4 acc[8][4]; zero_acc<8, 4>(acc);
    TileSrc s{A, lda, row0, Bt, ldb, n0, n0 + 128, K}; gemm_tile<8, 4>(acc, s, smem);
#pragma unroll
    for (int m = 0; m < 8; ++m) { const int row = row0 + wr * 128 + m * 16 + fr;
#pragma unroll
      for (int n = 0; n < 4; ++n) *(f32x4*)(C + (size_t)row * D + n0 + wc * 64 + n * 16 + fq * 4) = acc[m][n]; }
  }
}

__device__ void phase_ffn_up(const P& p, int l, char* smem) {
  const bf16_t* H = (const bf16_t*)(p.ws + WS_H); const bf16_t* Wt = (const bf16_t*)(p.ws + WS_WUP); bf16_t* hid = (bf16_t*)(p.ws + WS_HID);
  const int tid = ptid(), lane = tid & 63, wave = tid >> 6, wr = wave >> 2, wc = wave & 3, fr = lane & 15, fq = lane >> 4;
  const float* cw = p.ffn_conv + (size_t)l * 3 * 2 * FF;
  TileIter ti; int mt, nt; ti.init(49, 22);
  while (ti.next(mt, nt)) {
    const int c0 = nt * 128, arow0 = mt * 254 - 1;
    f32x4 acc[8][4]; zero_acc<8, 4>(acc);
    TileSrc s{H, LDH, arow0, Wt, LDH, c0, FF + c0, D};
    gemm_tile<8, 4>(acc, s, smem);
    float* sC = (float*)smem;
#pragma unroll
    for (int q = 0; q < 4; ++q) {
      __syncthreads();
      if ((wc & 1) == (q >> 1)) { const int cb = (wc >> 1) * 32;
#pragma unroll
        for (int m = 0; m < 8; ++m)
#pragma unroll
          for (int n = 0; n < 2; ++n) *(f32x4*)(sC + (wr * 128 + m * 16 + fr) * 68 + cb + n * 16 + fq * 4) = acc[m][(q & 1) * 2 + n];
      }
      __syncthreads();
      const int cq = c0 + q * 32;
      for (int e = tid; e < 254 * 8; e += NTP) {
        const int tr = 1 + (e >> 3), c4 = (e & 7) * 4, g = arow0 + tr;
        if (g < MT) { int t, T, mi; tokinfo(g, t, T, mi);
          const float pm = t > 0 ? 1.f : 0.f, nm = t < T - 1 ? 1.f : 0.f;
          const f32x4 va = *(const f32x4*)(sC + (tr - 1) * 68 + c4), vb = *(const f32x4*)(sC + tr * 68 + c4), vc = *(const f32x4*)(sC + (tr + 1) * 68 + c4);
          const f32x4 ga = *(const f32x4*)(sC + (tr - 1) * 68 + 32 + c4), gb = *(const f32x4*)(sC + tr * 68 + 32 + c4), gc = *(const f32x4*)(sC + (tr + 1) * 68 + 32 + c4);
          const f32x4 v0 = *(const f32x4*)(cw + cq + c4), v1 = *(const f32x4*)(cw + 2 * FF + cq + c4), v2 = *(const f32x4*)(cw + 4 * FF + cq + c4);
          const f32x4 g0 = *(const f32x4*)(cw + FF + cq + c4), g1 = *(const f32x4*)(cw + 3 * FF + cq + c4), g2 = *(const f32x4*)(cw + 5 * FF + cq + c4);
          float r[4];
#pragma unroll
          for (int j = 0; j < 4; ++j) { const float val = pm * va[j] * v0[j] + vb[j] * v1[j] + nm * vc[j] * v2[j]; const float gt = pm * ga[j] * g0[j] + gb[j] * g1[j] + nm * gc[j] * g2[j]; r[j] = gelu_tanh(gt) * val; }
          u32x2 o; o.x = pack2(r[0], r[1]); o.y = pack2(r[2], r[3]);
          *(u32x2*)(hid + (size_t)g * FF + cq + c4) = o; }
      }
    }
  }
}

template <int CTRL> DI float dppf(float v) { return __int_as_float(__builtin_amdgcn_mov_dpp(__float_as_int(v), CTRL, 0xF, 0xF, true)); }
DI float row16_sum(float v) { v += dppf<0xB1>(v); v += dppf<0x4E>(v); v += dppf<0x141>(v); v += dppf<0x140>(v); return v; }

DI float frcp(float x) { return __builtin_amdgcn_rcpf(x); }
DI float fsig(float x) { return frcp(1.f + __expf(-x)); }
__device__ void scan_task(const P& p, int l, int seq, int h, int d, int half, char* smem) {
  float* sR = (float*)smem; float* sW = sR + 1024; float* sKD = sW + 1024; float* sB = sKD + 1024; float* sNK = sB + 1024; float* sV = sNK + 1024; float* sK = sV + 1024; float* sY = sK + 1024;
  float* sKn = sY + 1024; float* sKK = sKn + 16; bf16_t* sWT = (bf16_t*)(sKK + 64); bf16_t* sAL = sWT + 16 * LDT;
  const int tid = tidx(), lane = tid & 63, wave = tid >> 6, fr = lane & 15, fq = lane >> 4;
  const int row0 = seq < 32 ? seq * 256 : MC + (seq - 32) * 1024, T = seq < 32 ? 256 : 1024, nch = T >> 4;
  const bf16_t* zr = (const bf16_t*)(p.ws + WS_ZR);
  float* yout = (float*)(p.ws + WS_Y) + (size_t)d * MT * 512;
  __syncthreads();
  if (tid < 64) sKK[tid] = p.rwkv_k_k[l * 512 + h * 64 + tid];
  const int cc = wave * 16 + fr, gc = h * 64 + cc;
  bf16x8 bw[2], ba[2];
#pragma unroll
  for (int ks = 0; ks < 2; ++ks)
#pragma unroll
    for (int e = 0; e < 8; ++e) { const int k = ks * 32 + fq * 8 + e;
      bw[ks][e] = (short)f2bf(p.rwkv_w_up[((size_t)(l * 2 + d) * 64 + k) * 512 + gc]); ba[ks][e] = (short)f2bf(p.rwkv_a_up[((size_t)(l * 2 + d) * 64 + k) * 512 + gc]); }
  const float w0c = p.rwkv_w0[(l * 2 + d) * 512 + gc], a0c = p.rwkv_a0[(l * 2 + d) * 512 + gc], kac = p.rwkv_k_a[l * 512 + gc];
  const int rg = tid >> 4, kq = tid & 15, rbase = half * 32 + rg * 2;
  f32x2 S[2][2];
  if (seq >= 32) { const float* s0 = p.state_rwkv + (((((size_t)(seq - 32) * 2 + l) * 2 + d) * 8 + h) * 64 + rbase) * 64 + kq * 4;
#pragma unroll
    for (int r = 0; r < 2; ++r) { const f32x4 x = *(const f32x4*)(s0 + r * 64); S[r][0] = (f32x2){x[0], x[1]}; S[r][1] = (f32x2){x[2], x[3]}; } }
  else {
#pragma unroll
    for (int r = 0; r < 2; ++r) { S[r][0] = (f32x2){0.f, 0.f}; S[r][1] = (f32x2){0.f, 0.f}; } }
  if (seq >= 32) __builtin_amdgcn_s_setprio(2);
  const int at = (tid & 127) >> 3, apart = tid & 7, ahi = tid >> 7;
  size_t coff[3];
  { const int sb0 = ahi ? 512 + h * 64 : h * 64, sb1 = ahi ? 1536 : 1024 + h * 64, sb2 = 1600;
    coff[0] = (size_t)at * NZR + sb0 + apart * 8; coff[1] = (size_t)at * NZR + sb1 + apart * 8; coff[2] = (size_t)at * NZR + sb2 + apart * 8; }
  u32x4 pre[3];
  { const int t0 = (d ? nch - 1 : 0) * 16;
#pragma unroll
    for (int i = 0; i < 3; ++i) pre[i] = *(const u32x4*)(zr + (size_t)(row0 + t0) * NZR + coff[i]); }
  __syncthreads();
  for (int ci = 0; ci < nch; ++ci) {
    const int chunk = d ? nch - 1 - ci : ci, t0 = chunk * 16;
    { const int o = at * 64 + apart * 8; float f[8];
      unpack8(pre[0], f);
      if (ahi == 0) { *(f32x4*)(sR + o) = (f32x4){f[0], f[1], f[2], f[3]}; *(f32x4*)(sR + o + 4) = (f32x4){f[4], f[5], f[6], f[7]}; }
      else { *(f32x4*)(sK + o) = (f32x4){f[0], f[1], f[2], f[3]}; *(f32x4*)(sK + o + 4) = (f32x4){f[4], f[5], f[6], f[7]}; float ps = 0.f;
#pragma unroll
        for (int e = 0; e < 8; ++e) { const float kk = f[e] * sKK[apart * 8 + e]; ps += kk * kk; }
        ps += dppf<0xB1>(ps); ps += dppf<0x4E>(ps); ps += dppf<0x141>(ps);
        if (apart == 0) sKn[at] = ps; }
      unpack8(pre[1], f);
      if (ahi == 0) { *(f32x4*)(sV + o) = (f32x4){f[0], f[1], f[2], f[3]}; *(f32x4*)(sV + o + 4) = (f32x4){f[4], f[5], f[6], f[7]}; }
      else { float g[8];
#pragma unroll
        for (int e = 0; e < 8; ++e) g[e] = 1.f - 2.f * frcp(__expf(2.f * f[e]) + 1.f);
        *(u32x4*)(sWT + at * LDT + apart * 8) = pack8(g); }
      if (ahi == 0) *(u32x4*)(sAL + at * LDT + apart * 8) = pre[2];
    }
    __syncthreads();
    {
      f32x4 aw = {0.f, 0.f, 0.f, 0.f}, aa = {0.f, 0.f, 0.f, 0.f};
#pragma unroll
      for (int ks = 0; ks < 2; ++ks) { const bf16x8 fw = *(const bf16x8*)(sWT + fr * LDT + ks * 32 + fq * 8); const bf16x8 fa = *(const bf16x8*)(sAL + fr * LDT + ks * 32 + fq * 8);
        aw = MFMA16(fw, bw[ks], aw); aa = MFMA16(fa, ba[ks], aa); }
      const float kkc = sKK[cc];
#pragma unroll
      for (int j = 0; j < 4; ++j) { const int t = fq * 4 + j, o = t * 64 + cc;
        const float dec = __expf(-0.6065306597f * fsig(w0c + aw[j]));
        const float a = fsig(a0c + aa[j]);
        const float kv = sK[o];
        const float kkv = kv * kkc * __builtin_amdgcn_rsqf(fmaxf(sKn[t], 1e-24f));
        sW[o] = dec; sKD[o] = kv * (1.f + (a - 1.f) * kac); sB[o] = kkv * a; sNK[o] = -kkv; }
    }
    __syncthreads();
    { const int cn = ci + 1 < nch ? ci + 1 : ci; const int nt0 = (d ? nch - 1 - cn : cn) * 16;
#pragma unroll
      for (int i = 0; i < 3; ++i) pre[i] = *(const u32x4*)(zr + (size_t)(row0 + nt0) * NZR + coff[i]); }
#pragma unroll 2
    for (int si = 0; si < 16; ++si) {
      const int t = d ? 15 - si : si, o = t * 64 + kq * 4;
      const f32x4 an4 = *(const f32x4*)(sNK + o), w4 = *(const f32x4*)(sW + o), b4 = *(const f32x4*)(sB + o), kd4 = *(const f32x4*)(sKD + o), r4 = *(const f32x4*)(sR + o);
      const f32x2 v2 = *(const f32x2*)(sV + t * 64 + rbase);
      const f32x2 an[2] = {{an4[0], an4[1]}, {an4[2], an4[3]}}, wv[2] = {{w4[0], w4[1]}, {w4[2], w4[3]}}, bv[2] = {{b4[0], b4[1]}, {b4[2], b4[3]}}, kd[2] = {{kd4[0], kd4[1]}, {kd4[2], kd4[3]}}, rv[2] = {{r4[0], r4[1]}, {r4[2], r4[3]}};
      float sa[2];
#pragma unroll
      for (int r = 0; r < 2; ++r) { const f32x2 t2 = S[r][0] * an[0] + S[r][1] * an[1]; sa[r] = row16_sum(t2.x + t2.y); }
      f32x2 yv;
#pragma unroll
      for (int r = 0; r < 2; ++r) { const f32x2 sav = {sa[r], sa[r]}, vvv = {v2[r], v2[r]};
        S[r][0] = S[r][0] * wv[0] + (sav * bv[0] + vvv * kd[0]); S[r][1] = S[r][1] * wv[1] + (sav * bv[1] + vvv * kd[1]);
        const f32x2 y2 = S[r][0] * rv[0] + S[r][1] * rv[1]; yv[r] = row16_sum(y2.x + y2.y); }
      if (kq == 0) *(f32x2*)(sY + t * 64 + rbase) = yv;
    }
    __syncthreads();
    { const int t = tid >> 4, vv = half * 32 + (tid & 15) * 2; *(f32x2*)(yout + (size_t)(row0 + t0 + t) * 512 + h * 64 + vv) = *(const f32x2*)(sY + t * 64 + vv); }
  }
  __builtin_amdgcn_s_setprio(0);
  if (seq < 32) { float* so = p.out + O_RW + (((((size_t)seq * 2 + l) * 2 + d) * 8 + h) * 64 + rbase) * 64 + kq * 4;
#pragma unroll
    for (int r = 0; r < 2; ++r) *(f32x4*)(so + r * 64) = (f32x4){S[r][0].x, S[r][0].y, S[r][1].x, S[r][1].y}; }
}

DI void qk_scores(const bf16_t* sK, const bf16x8 (&qf)[2], f32x4 (&sacc)[4], int fr, int fq) {
#pragma unroll
  for (int nt = 0; nt < 4; ++nt) { sacc[nt] = (f32x4){0.f, 0.f, 0.f, 0.f};
#pragma unroll
    for (int ks = 0; ks < 2; ++ks) { const bf16x8 kf = *(const bf16x8*)(sK + (nt * 16 + fr) * LDT + ks * 32 + fq * 8); sacc[nt] = MFMA16(kf, qf[ks], sacc[nt]); } }
}
DI void pv_accum(const bf16_t* sVt, const f32x4 (&pacc)[4], f32x4 (&o)[4], int fr, int fq) {
#pragma unroll
  for (int s = 0; s < 2; ++s) {
    bf16x8 pf; { const unsigned a = pack2(pacc[2 * s][0], pacc[2 * s][1]), b = pack2(pacc[2 * s][2], pacc[2 * s][3]), c = pack2(pacc[2 * s + 1][0], pacc[2 * s + 1][1]), dd = pack2(pacc[2 * s + 1][2], pacc[2 * s + 1][3]);
      const u32x4 u = (u32x4){a, b, c, dd}; pf = __builtin_bit_cast(bf16x8, u); }
#pragma unroll
    for (int dt = 0; dt < 4; ++dt) { const u32x2 lo = *(const u32x2*)(sVt + (dt * 16 + fr) * LDT + 32 * s + 4 * fq), hi = *(const u32x2*)(sVt + (dt * 16 + fr) * LDT + 32 * s + 16 + 4 * fq);
      const u32x4 u = (u32x4){lo[0], lo[1], hi[0], hi[1]}; const bf16x8 vf = __builtin_bit_cast(bf16x8, u); o[dt] = MFMA16(vf, pf, o[dt]); }
  }
}
DI void put_kv(bf16_t* sK, bf16_t* sVt, int key, int part, const float (&kf)[8], const float (&vf)[8]) {
  *(u32x4*)(sK + key * LDT + part * 8) = pack8(kf);
#pragma unroll
  for (int e = 0; e < 8; ++e) sVt[(part * 8 + e) * LDT + key] = f2bf(vf[e]);
}
DI void softmax_tile(f32x4 (&sacc)[4], f32x4 (&o)[4], float& mrun, float& lrun) {
  float mx = sacc[0][0];
#pragma unroll
  for (int nt = 0; nt < 4; ++nt)
#pragma unroll
    for (int j = 0; j < 4; ++j) mx = fmaxf(mx, sacc[nt][j]);
  mx = fmaxf(mx, shfl_x(mx, 16)); mx = fmaxf(mx, shfl_x(mx, 32));
  const float mnew = fmaxf(mrun, mx), alpha = exp2f(mrun - mnew); mrun = mnew;
  float ls = 0.f;
#pragma unroll
  for (int nt = 0; nt < 4; ++nt)
#pragma unroll
    for (int j = 0; j < 4; ++j) { const float pv = exp2f(sacc[nt][j] - mnew); sacc[nt][j] = pv; ls += pv; }
  lrun = lrun * alpha + ls;
#pragma unroll
  for (int dt = 0; dt < 4; ++dt) o[dt] *= alpha;
}
constexpr float LOG2E = 1.4426950408889634f;

__device__ void dense_task(const P& p, int b, int h, int qb, char* smem) {
  bf16_t* sK = (bf16_t*)smem; bf16_t* sVt = sK + 64 * LDT;
  const int tid = tidx(), lane = tid & 63, wave = tid >> 6, fr = lane & 15, fq = lane >> 4;
  const bf16_t* zn = (const bf16_t*)(p.ws + WS_ZN); bf16_t* ona = (bf16_t*)(p.ws + WS_ONA);
  const int qrow = b * 256 + qb * 64 + wave * 16 + fr;
  bf16x8 qf[2];
#pragma unroll
  for (int ks = 0; ks < 2; ++ks) qf[ks] = *(const bf16x8*)(zn + (size_t)qrow * NZN + h * 64 + ks * 32 + fq * 8);
  f32x4 o[4]; for (int dt = 0; dt < 4; ++dt) o[dt] = (f32x4){0.f, 0.f, 0.f, 0.f};
  float mrun = -1e30f, lrun = 0.f;
  u32x4 pk[2], pv[2];
#pragma unroll
  for (int i = 0; i < 2; ++i) { const int c = tid + 256 * i, key = c >> 3, part = c & 7; const size_t ro = (size_t)(b * 256 + key) * NZN + h * 64 + part * 8; pk[i] = *(const u32x4*)(zn + ro + 512); pv[i] = *(const u32x4*)(zn + ro + 1024); }
  for (int kt = 0; kt < 4; ++kt) {
    __syncthreads();
#pragma unroll
    for (int i = 0; i < 2; ++i) { const int c = tid + 256 * i, key = c >> 3, part = c & 7; float vf[8]; unpack8(pv[i], vf);
      *(u32x4*)(sK + key * LDT + part * 8) = pk[i];
#pragma unroll
      for (int e = 0; e < 8; ++e) sVt[(part * 8 + e) * LDT + key] = f2bf(vf[e]); }
    __syncthreads();
    { const int kn = kt < 3 ? kt + 1 : 3;
#pragma unroll
      for (int i = 0; i < 2; ++i) { const int c = tid + 256 * i, key = c >> 3, part = c & 7; const size_t ro = (size_t)(b * 256 + kn * 64 + key) * NZN + h * 64 + part * 8; pk[i] = *(const u32x4*)(zn + ro + 512); pv[i] = *(const u32x4*)(zn + ro + 1024); } }
    f32x4 sacc[4]; qk_scores(sK, qf, sacc, fr, fq);
#pragma unroll
    for (int nt = 0; nt < 4; ++nt) sacc[nt] *= (0.125f * LOG2E);
    softmax_tile(sacc, o, mrun, lrun);
    pv_accum(sVt, sacc, o, fr, fq);
  }
  lrun += shfl_x(lrun, 16); lrun += shfl_x(lrun, 32); const float inv = 1.f / lrun;
#pragma unroll
  for (int dt = 0; dt < 4; ++dt) { u32x2 ov; ov.x = pack2(o[dt][0] * inv, o[dt][1] * inv); ov.y = pack2(o[dt][2] * inv, o[dt][3] * inv); *(u32x2*)(ona + (size_t)qrow * LDO + h * 64 + dt * 16 + fq * 4) = ov; }
}

__device__ void na_task(const P& p, int l, int b, int h, int r, char* smem) {
  bf16_t* sK = (bf16_t*)smem; bf16_t* sVt = sK + 64 * LDT; float* sRpb = (float*)(sVt + 64 * LDT);
  const int tid = tidx(), lane = tid & 63, wave = tid >> 6, fr = lane & 15, fq = lane >> 4;
  const bf16_t* zn = (const bf16_t*)(p.ws + WS_ZN); bf16_t* ona = (bf16_t*)(p.ws + WS_ONA);
  const int base = MC + b * 1024, qcol = wave * 16 + fr, qrow = base + r * 64 + qcol;
  int rs = r - 4; rs = rs < 0 ? 0 : (rs > 8 ? 8 : rs);
  int cs = qcol - 8; cs = cs < 0 ? 0 : (cs > 48 ? 48 : cs);
  __syncthreads();
  for (int e = tid; e < 465; e += NT) sRpb[e] = p.na_rpb[((size_t)l * 8 + h) * 465 + e] * LOG2E;
  bf16x8 qf[2];
#pragma unroll
  for (int ks = 0; ks < 2; ++ks) qf[ks] = *(const bf16x8*)(zn + (size_t)qrow * NZN + h * 64 + ks * 32 + fq * 8);
  f32x4 o[4]; for (int dt = 0; dt < 4; ++dt) o[dt] = (f32x4){0.f, 0.f, 0.f, 0.f};
  float mrun = -1e30f, lrun = 0.f;
  u32x4 pre[8];
#define NA_ISSUE(KT) do { const int kt_ = (KT); \
    if (kt_ < 8) { _Pragma("unroll") for (int i = 0; i < 2; ++i) { const int c = tid + 256 * i, key = c >> 3, part = c & 7; const size_t ro = (size_t)(base + (rs + kt_) * 64 + key) * NZN + h * 64 + part * 8; \
        pre[4 * i] = *(const u32x4*)(zn + ro + 512); pre[4 * i + 1] = *(const u32x4*)(zn + ro + 1024); } } \
    else { _Pragma("unroll") for (int i = 0; i < 2; ++i) { const int c = tid + 256 * i, key = c >> 3, part = c & 7; const size_t co = ((((size_t)b * 2 + l) * 8 + h) * 256 + (kt_ - 8) * 64 + key) * 64 + part * 8; \
        pre[4 * i] = *(const u32x4*)(p.cache_k + co); pre[4 * i + 1] = *(const u32x4*)(p.cache_k + co + 4); pre[4 * i + 2] = *(const u32x4*)(p.cache_v + co); pre[4 * i + 3] = *(const u32x4*)(p.cache_v + co + 4); } } } while (0)
  NA_ISSUE(0);
  for (int kt = 0; kt < 12; ++kt) {
    __syncthreads();
    if (kt < 8) {
#pragma unroll
      for (int i = 0; i < 2; ++i) { const int c = tid + 256 * i, key = c >> 3, part = c & 7; float vf[8]; unpack8(pre[4 * i + 1], vf);
        *(u32x4*)(sK + key * LDT + part * 8) = pre[4 * i];
#pragma unroll
        for (int e = 0; e < 8; ++e) sVt[(part * 8 + e) * LDT + key] = f2bf(vf[e]); }
    } else {
#pragma unroll
      for (int i = 0; i < 2; ++i) { const int c = tid + 256 * i, key = c >> 3, part = c & 7;
        const f32x4 k0 = __builtin_bit_cast(f32x4, pre[4 * i]), k1 = __builtin_bit_cast(f32x4, pre[4 * i + 1]), v0 = __builtin_bit_cast(f32x4, pre[4 * i + 2]), v1 = __builtin_bit_cast(f32x4, pre[4 * i + 3]);
        const float kf[8] = {k0[0], k0[1], k0[2], k0[3], k1[0], k1[1], k1[2], k1[3]}; const float vf[8] = {v0[0], v0[1], v0[2], v0[3], v1[0], v1[1], v1[2], v1[3]};
        put_kv(sK, sVt, key, part, kf, vf); }
    }
    __syncthreads();
    NA_ISSUE(kt < 11 ? kt + 1 : 11);
    f32x4 sacc[4]; qk_scores(sK, qf, sacc, fr, fq);
    if (kt < 8) { const int dr = rs + kt - r + 7;
#pragma unroll
      for (int nt = 0; nt < 4; ++nt)
#pragma unroll
        for (int j = 0; j < 4; ++j) { const int kc = nt * 16 + fq * 4 + j; const bool valid = kc >= cs && kc < cs + 16; int dc = kc - qcol; dc = dc < -15 ? -15 : (dc > 15 ? 15 : dc);
          sacc[nt][j] = valid ? sacc[nt][j] * (0.125f * LOG2E) + sRpb[dr * 31 + dc + 15] : -1e30f; }
    } else {
#pragma unroll
      for (int nt = 0; nt < 4; ++nt) sacc[nt] *= (0.125f * LOG2E);
    }
    softmax_tile(sacc, o, mrun, lrun);
    pv_accum(sVt, sacc, o, fr, fq);
  }
#undef NA_ISSUE
  lrun += shfl_x(lrun, 16); lrun += shfl_x(lrun, 32); const float inv = 1.f / lrun;
#pragma unroll
  for (int dt = 0; dt < 4; ++dt) { u32x2 ov; ov.x = pack2(o[dt][0] * inv, o[dt][1] * inv); ov.y = pack2(o[dt][2] * inv, o[dt][3] * inv); *(u32x2*)(ona + (size_t)qrow * LDO + h * 64 + dt * 16 + fq * 4) = ov; }
}

DI void rope8(const float (&own)[8], const float (&par)[8], int part, int n, float (&out)[8]) {
  const float pos = (float)((part >> 2) ? (n & 63) : (n >> 6));
  const bool isx2 = (part & 3) >= 2;
#pragma unroll
  for (int e = 0; e < 8; ++e) { const int i = (part & 1) * 8 + e; const float ang = pos * exp2f(-(float)i * 0.830482023721841f); const float sn = __sinf(ang), cs = __cosf(ang);
    out[e] = isx2 ? par[e] * sn + own[e] * cs : own[e] * cs - par[e] * sn; }
}

__device__ void ret_task(const P& p, int l, int seq, int h, int qb, char* smem) {
  bf16_t* sK = (bf16_t*)smem; bf16_t* sVt = sK + 64 * LDT; bf16_t* sQ = sVt + 64 * LDT;
  const int tid = tidx(), lane = tid & 63, wave = tid >> 6, fr = lane & 15, fq = lane >> 4;
  const bf16_t* zt = (const bf16_t*)(p.ws + WS_ZT); bf16_t* oret = (bf16_t*)(p.ws + WS_ORET);
  const bool lat = seq >= 32;
  const int row0 = lat ? MC + (seq - 32) * 1024 : seq * 256, T = lat ? 1024 : 256, nkt = T >> 6;
  const float xf = p.ret_decay[(l * 2 + 0) * 8 + h], xb = p.ret_decay[(l * 2 + 1) * 8 + h];
  const float lgf = -log1pf(__expf(-xf)) * LOG2E, lgb = -log1pf(__expf(-xb)) * LOG2E;
  __syncthreads();
#pragma unroll
  for (int i = 0; i < 2; ++i) { const int c = tid + 256 * i, qi = c >> 3, part = c & 7; const int n = qb * 64 + qi; const size_t ro = (size_t)(row0 + n) * LZT + h * 64;
    const u32x4 own = *(const u32x4*)(zt + ro + part * 8);
    if (lat) { const u32x4 par = *(const u32x4*)(zt + ro + (part ^ 2) * 8); float fo[8], fp[8], out[8]; unpack8(own, fo); unpack8(par, fp); rope8(fo, fp, part, n, out); *(u32x4*)(sQ + qi * LDT + part * 8) = pack8(out); }
    else *(u32x4*)(sQ + qi * LDT + part * 8) = own; }
  __syncthreads();
  const int qi = wave * 16 + fr, nq = qb * 64 + qi;
  bf16x8 qf[2];
#pragma unroll
  for (int ks = 0; ks < 2; ++ks) qf[ks] = *(const bf16x8*)(sQ + qi * LDT + ks * 32 + fq * 8);
  f32x4 o[4]; for (int dt = 0; dt < 4; ++dt) o[dt] = (f32x4){0.f, 0.f, 0.f, 0.f};
  u32x4 rk[2], rp[2], rv[2];
#define RET_ISSUE(KT) do { _Pragma("unroll") for (int i = 0; i < 2; ++i) { const int c = tid + 256 * i, key = c >> 3, part = c & 7; const size_t ro = (size_t)(row0 + (KT) * 64 + key) * LZT + h * 64; \
    rk[i] = *(const u32x4*)(zt + ro + 512 + part * 8); rp[i] = *(const u32x4*)(zt + ro + 512 + (part ^ 2) * 8); rv[i] = *(const u32x4*)(zt + ro + 1024 + part * 8); } } while (0)
  RET_ISSUE(0);
  for (int kt = 0; kt < nkt; ++kt) {
    __syncthreads();
#pragma unroll
    for (int i = 0; i < 2; ++i) { const int c = tid + 256 * i, key = c >> 3, part = c & 7; const int n = kt * 64 + key;
      float kf[8], vf[8]; unpack8(rk[i], kf); unpack8(rv[i], vf);
      if (lat) { float fp[8], out[8]; unpack8(rp[i], fp); rope8(kf, fp, part, n, out);
#pragma unroll
        for (int e = 0; e < 8; ++e) kf[e] = out[e]; }
#pragma unroll
      for (int e = 0; e < 8; ++e) kf[e] *= 0.125f;
      put_kv(sK, sVt, key, part, kf, vf); }
    __syncthreads();
    RET_ISSUE(kt + 1 < nkt ? kt + 1 : kt);
    f32x4 sacc[4]; qk_scores(sK, qf, sacc, fr, fq);
#pragma unroll
    for (int nt = 0; nt < 4; ++nt)
#pragma unroll
      for (int j = 0; j < 4; ++j) { const int mk = kt * 64 + nt * 16 + fq * 4 + j; const int df = nq - mk;
        const float dec = df > 0 ? exp2f(lgf * (float)df) : (df < 0 ? exp2f(lgb * (float)(-df)) : 2.f); sacc[nt][j] *= dec; }
    pv_accum(sVt, sacc, o, fr, fq);
  }
#undef RET_ISSUE
  if (lat) {
    for (int dir = 0; dir < 2; ++dir) {
      __syncthreads();
      const float* s0 = p.state_ret + ((((size_t)(seq - 32) * 2 + l) * 2 + dir) * 8 + h) * 4096;
#pragma unroll
      for (int i = 0; i < 2; ++i) { const int c = tid + 256 * i, dk = c >> 3, part = c & 7; const float4 a = *(const float4*)(s0 + dk * 64 + part * 8), bq = *(const float4*)(s0 + dk * 64 + part * 8 + 4);
        const float vf[8] = {a.x, a.y, a.z, a.w, bq.x, bq.y, bq.z, bq.w};
#pragma unroll
        for (int e = 0; e < 8; ++e) sVt[(part * 8 + e) * LDT + dk] = f2bf(vf[e]); }
      __syncthreads();
      const float xi = dir == 0 ? exp2f(lgf * (float)(nq + 1)) : exp2f(lgb * (float)(T - nq));
      f32x4 pacc[4];
#pragma unroll
      for (int s = 0; s < 2; ++s)
#pragma unroll
        for (int hh = 0; hh < 2; ++hh)
#pragma unroll
          for (int j = 0; j < 4; ++j) pacc[2 * s + hh][j] = xi * bf2f(sQ[qi * LDT + 32 * s + 16 * hh + 4 * fq + j]);
      pv_accum(sVt, pacc, o, fr, fq);
    }
  }
  float s1 = 0.f;
#pragma unroll
  for (int dt = 0; dt < 4; ++dt)
#pragma unroll
    for (int j = 0; j < 4; ++j) s1 += o[dt][j];
  s1 += shfl_x(s1, 16); s1 += shfl_x(s1, 32); const float mu = s1 * (1.f / 64.f);
  float s2 = 0.f;
#pragma unroll
  for (int dt = 0; dt < 4; ++dt)
#pragma unroll
    for (int j = 0; j < 4; ++j) { const float dlt = o[dt][j] - mu; s2 += dlt * dlt; }
  s2 += shfl_x(s2, 16); s2 += shfl_x(s2, 32); const float rstd = rsqrtf(s2 * (1.f / 64.f) + 1e-5f);
  const size_t qrow = (size_t)(row0 + nq);
#pragma unroll
  for (int dt = 0; dt < 4; ++dt) { const int dv = h * 64 + dt * 16 + fq * 4; const u32x2 gr = *(const u32x2*)(zt + qrow * LZT + 1536 + dv); const float4 gn = *(const float4*)(p.ret_gn + l * 512 + dv);
    const float g0 = bflo(gr.x), g1 = bfhi(gr.x), g2 = bflo(gr.y), g3 = bfhi(gr.y);
    u32x2 ov; ov.x = pack2((o[dt][0] - mu) * rstd * gn.x * g0 * sigmoidf_(g0), (o[dt][1] - mu) * rstd * gn.y * g1 * sigmoidf_(g1));
    ov.y = pack2((o[dt][2] - mu) * rstd * gn.z * g2 * sigmoidf_(g2), (o[dt][3] - mu) * rstd * gn.w * g3 * sigmoidf_(g3));
    *(u32x2*)(oret + qrow * LDO + dv) = ov; }
}

__device__ void retstate_task(const P& p, int l, int b, int h, char* smem) {
  float* sKf = (float*)smem; float* sKb = sKf + 64 * 64; float* sV = sKb + 64 * 64;
  const int tid = tidx(), dk = tid >> 2, dq = tid & 3;
  const bf16_t* zt = (const bf16_t*)(p.ws + WS_ZT);
  const float xf = p.ret_decay[(l * 2 + 0) * 8 + h], xb = p.ret_decay[(l * 2 + 1) * 8 + h];
  const float lgf = -log1pf(__expf(-xf)) * LOG2E, lgb = -log1pf(__expf(-xb)) * LOG2E;
  float af[16], ab[16];
#pragma unroll
  for (int i = 0; i < 16; ++i) { af[i] = 0.f; ab[i] = 0.f; }
  for (int kt = 0; kt < 4; ++kt) {
    __syncthreads();
#pragma unroll
    for (int i = 0; i < 2; ++i) { const int c = tid + 256 * i, key = c >> 3, part = c & 7, m = kt * 64 + key; const size_t ro = (size_t)(b * 256 + m) * LZT + h * 64 + part * 8;
      float kf[8], vf[8]; unpack8(*(const u32x4*)(zt + ro + 512), kf); unpack8(*(const u32x4*)(zt + ro + 1024), vf);
      const float wf = 0.125f * exp2f(lgf * (float)(255 - m)), wb = 0.125f * exp2f(lgb * (float)m);
#pragma unroll
      for (int e = 0; e < 8; ++e) { sKf[key * 64 + part * 8 + e] = kf[e] * wf; sKb[key * 64 + part * 8 + e] = kf[e] * wb; sV[key * 64 + part * 8 + e] = vf[e]; } }
    __syncthreads();
    for (int m = 0; m < 64; ++m) { const float kf = sKf[m * 64 + dk], kb = sKb[m * 64 + dk];
#pragma unroll
      for (int i = 0; i < 4; ++i) { const f32x4 vv = *(const f32x4*)(sV + m * 64 + dq * 16 + i * 4);
#pragma unroll
        for (int j = 0; j < 4; ++j) { af[i * 4 + j] += kf * vv[j]; ab[i * 4 + j] += kb * vv[j]; } } }
  }
  float* of = p.out + O_RT + ((((size_t)b * 2 + l) * 2 + 0) * 8 + h) * 4096 + dk * 64 + dq * 16; float* ob = of + 8 * 4096;
#pragma unroll
  for (int i = 0; i < 16; ++i) { of[i] = af[i]; ob[i] = ab[i]; }
}

constexpr int Q_SCAN_L = 64, Q_SCAN_C = 512, Q_RET_L = 256, Q_NA = 256, Q_DENSE = 512, Q_RET_C = 512, Q_RST = 128;
template <int QMASK> __device__ void phase_mixers(const P& p, int l, char* smem_, int rep = 0) {
  __shared__ int s_task;
  int* ctr = (int*)(p.ws + WS_CTRL) + 64 * (l + 1) + 4 * rep;
  const int vb = vhalf(); char* smem = smem_ + vb * VSMEM;
  if (QMASK & 1) for (;;) {
    __syncthreads();
    if (ptid() == 0) s_task = atomicAdd(ctr, 1);
    __syncthreads();
    const int tk = s_task;
    if (tk >= Q_SCAN_L + Q_SCAN_C) break;
    const bool lat = tk < Q_SCAN_L; const int t2 = lat ? tk : tk - Q_SCAN_L;
    scan_task(p, l, (lat ? 32 : 0) + (t2 >> 4), (t2 >> 1) & 7, t2 & 1, vb, smem);
  }
  if (QMASK & 2) for (;;) {
    __syncthreads();
    if (ptid() == 0) s_task = atomicAdd(ctr + 16, 1);
    __syncthreads();
    const int tk = s_task;
    if (tk >= Q_RET_L + Q_RET_C) break;
    if (tk < Q_RET_L) ret_task(p, l, 32 + (tk >> 6), (tk >> 3) & 7, (tk & 7) * 2 + vb, smem);
    else { const int t2 = tk - Q_RET_L; ret_task(p, l, t2 >> 4, (t2 >> 1) & 7, (t2 & 1) * 2 + vb, smem); }
  }
  if (QMASK & 4) for (;;) {
    __syncthreads();
    if (ptid() == 0) s_task = atomicAdd(ctr + 32, 1);
    __syncthreads();
    int tk = s_task;
    if (tk >= Q_NA + Q_DENSE + Q_RST) break;
    if (tk < Q_NA) { na_task(p, l, tk >> 6, (tk >> 3) & 7, (tk & 7) * 2 + vb, smem); continue; } tk -= Q_NA;
    if (tk < Q_DENSE) { dense_task(p, tk >> 4, (tk >> 1) & 7, (tk & 1) * 2 + vb, smem); continue; } tk -= Q_DENSE;
    retstate_task(p, l, tk >> 2, (tk & 3) * 2 + vb, smem);
  }
}

__device__ void phase_rwkv_post(const P& p, int l, char* smem) {
  const bf16_t* zr = (const bf16_t*)(p.ws + WS_ZR); const float* yf = (const float*)(p.ws + WS_Y); const float* yb = yf + (size_t)MT * 512; bf16_t* oa = (bf16_t*)(p.ws + WS_OA);
  const bf16_t* Gt = (const bf16_t*)(p.ws + WS_WG);
  const int tid = ptid(), lane = tid & 63, wave = tid >> 6, wr = wave >> 2, wc = wave & 3, fr = lane & 15, fq = lane >> 4;
  TileIter ti; int mt, nt; ti.init(96, 2);
  while (ti.next(mt, nt)) {
    const int row0 = mt * 128, n0 = nt * 256;
    f32x4 acc[4][4]; zero_acc<4, 4>(acc);
    TileSrc s{zr + 1664, NZR, row0, Gt, LDG, n0, n0 + 128, 128}; gemm_tile<4, 4>(acc, s, smem);
    const int cb = n0 + wc * 64 + fq * 4;
#pragma unroll
    for (int m = 0; m < 4; ++m) { const size_t row = (size_t)(row0 + wr * 64 + m * 16 + fr);
      f32x4 y[4]; float s1 = 0.f, rk = 0.f; f32x4 vv[4];
#pragma unroll
      for (int n = 0; n < 4; ++n) { const int c = cb + n * 16; y[n] = *(const f32x4*)(yf + row * 512 + c) + *(const f32x4*)(yb + row * 512 + c); s1 += y[n][0] + y[n][1] + y[n][2] + y[n][3];
        const u32x2 rr = *(const u32x2*)(zr + row * NZR + c), kk = *(const u32x2*)(zr + row * NZR + 512 + c), v2 = *(const u32x2*)(zr + row * NZR + 1024 + c); const f32x4 rkw = *(const f32x4*)(p.rwkv_r_k + l * 512 + c);
        rk += bflo(rr.x) * bflo(kk.x) * rkw[0] + bfhi(rr.x) * bfhi(kk.x) * rkw[1] + bflo(rr.y) * bflo(kk.y) * rkw[2] + bfhi(rr.y) * bfhi(kk.y) * rkw[3];
        vv[n] = (f32x4){bflo(v2.x), bfhi(v2.x), bflo(v2.y), bfhi(v2.y)}; }
      s1 += shfl_x(s1, 16); s1 += shfl_x(s1, 32); rk += shfl_x(rk, 16); rk += shfl_x(rk, 32);
      const float mu = s1 * (1.f / 64.f); float s2 = 0.f;
#pragma unroll
      for (int n = 0; n < 4; ++n)
#pragma unroll
        for (int j = 0; j < 4; ++j) { const float dl = y[n][j] - mu; s2 += dl * dl; }
      s2 += shfl_x(s2, 16); s2 += shfl_x(s2, 32); const float rstd = rsqrtf(s2 * (1.f / 64.f) + 64e-5f);
#pragma unroll
      for (int n = 0; n < 4; ++n) { const int c = cb + n * 16; const f32x4 lg = *(const f32x4*)(p.rwkv_ln_g + l * 512 + c), lb = *(const f32x4*)(p.rwkv_ln_b + l * 512 + c);
        float o[4];
#pragma unroll
        for (int j = 0; j < 4; ++j) o[j] = ((y[n][j] - mu) * rstd * lg[j] + lb[j] + rk * vv[n][j]) * acc[m][n][j];
        u32x2 ov; ov.x = pack2(o[0], o[1]); ov.y = pack2(o[2], o[3]); *(u32x2*)(oa + row * LDO + c) = ov; }
    }
  }
}

DI void convert_layer_a(const P& p, int l, char* smem) {
  convert_T(p.w_in + (size_t)l * D * INC, D, INC, (bf16_t*)(p.ws + WS_WIN), LDH, smem);
  convert_T(p.w_o_rwkv + (size_t)l * 512 * D, 512, D, (bf16_t*)(p.ws + WS_WO3), LDO, smem);
  convert_T(p.w_o_na + (size_t)l * 512 * D, 512, D, (bf16_t*)(p.ws + WS_WO3) + (size_t)1024 * LDO, LDO, smem);
  convert_T(p.w_o_ret + (size_t)l * 512 * D, 512, D, (bf16_t*)(p.ws + WS_WO3) + (size_t)2 * 1024 * LDO, LDO, smem);
  convert_T(p.w_out + (size_t)l * D * D, D, D, (bf16_t*)(p.ws + WS_WOUT), LDH, smem);
  convert_T(p.rwkv_g_up + (size_t)l * 128 * 512, 128, 512, (bf16_t*)(p.ws + WS_WG), LDG, smem);
}
DI void convert_layer_b(const P& p, int l, char* smem) {
  convert_T(p.ffn_up + (size_t)l * D * 2 * FF, D, 2 * FF, (bf16_t*)(p.ws + WS_WUP), LDH, smem);
  convert_T(p.ffn_down + (size_t)l * FF * D, FF, D, (bf16_t*)(p.ws + WS_WDN), FF, smem);
}

typedef __attribute__((address_space(4))) const P* KP;
DI KP kargs() { KP k = (KP)__builtin_amdgcn_kernarg_segment_ptr(); asm volatile("" : "+s"(k)); return k; }
template <int PH> DI void run_phase(int l, char* smem) {
#if defined(__HIP_DEVICE_COMPILE__)
  const P p = *kargs();
#else
  const P p{};
#endif
  const float* mod = (const float*)(p.ws + WS_MOD);
  float* xbuf = p.out;
  if (PH == 0) { ada_phase(p, smem); convert_layer_a(p, 0, smem); }
  else if (PH == 1) { norm_phase(p, nullptr, nullptr, nullptr, nullptr, 0, nullptr, p.norm_mix_pre, mod, 0, (bf16_t*)(p.ws + WS_H)); }
  else if (PH == 2) phase_win(p, l, smem);
  else if (PH == 4) phase_mixers<7>(p, l, smem);
  else if (PH == 5) phase_rwkv_post(p, l, smem);
  else if (PH == 6) phase_merge(p, smem);
  else if (PH == 7) { phase_gemm_f32((const bf16_t*)(p.ws + WS_MERGED), LDH, D, (const bf16_t*)(p.ws + WS_WOUT), LDH, (float*)(p.ws + WS_U), smem); }
  else if (PH == 8) { convert_layer_b(p, l, smem);
    norm_phase(p, l == 0 ? nullptr : xbuf, (const float*)(p.ws + WS_U), p.norm_mix_post + l * D, mod + (size_t)l * 5 * 6144, 2, xbuf, p.norm_ffn_pre + l * D, mod + (size_t)l * 5 * 6144, 3, (bf16_t*)(p.ws + WS_H)); }
  else if (PH == 9) phase_ffn_up(p, l, smem);
  else if (PH == 11) { phase_gemm_f32((const bf16_t*)(p.ws + WS_HID), FF, FF, (const bf16_t*)(p.ws + WS_WDN), FF, (float*)(p.ws + WS_F), smem); }
  else if (PH == 12) {
    if (l == 0) { norm_phase(p, xbuf, (const float*)(p.ws + WS_F), p.norm_ffn_post, mod, 5, xbuf, p.norm_mix_pre + D, mod + (size_t)5 * 6144, 0, (bf16_t*)(p.ws + WS_H)); convert_layer_a(p, 1, smem); }
    else norm_phase(p, xbuf, (const float*)(p.ws + WS_F), p.norm_ffn_post + D, mod + (size_t)5 * 6144, 5, xbuf, nullptr, nullptr, 0, nullptr);
  }
}

#if MEGA
__global__ void __launch_bounds__(NTP, 1) mega_kernel(P p_) {
  extern __shared__ __attribute__((aligned(16))) char smem[];
  __shared__ u32x4 xb_words;
  cg::grid_group grid = cg::this_grid();
  if (ptid() == 0) xb_words = (u32x4){0u, 0u, 0u, 0u};
  __syncthreads();
#if defined(__HIP_DEVICE_COMPILE__)
  (void)xcd_barrier_post((unsigned*)(p_.ws + WS_BAR), (volatile LAS unsigned*)&xb_words);
#define GSYNC() do { XcdBarrier xb_; xb_.bar = (unsigned*)(kargs()->ws + WS_BAR); xb_.x = xb_xcc_id(); xb_.st = (volatile LAS unsigned*)&xb_words; xcd_barrier(xb_); } while (0)
#else
#define GSYNC() do { } while (0)
#endif
  run_phase<0>(0, smem); grid.sync();
  run_phase<1>(0, smem); GSYNC();
#pragma unroll
  for (int l = 0; l < 2; ++l) {
    run_phase<2>(l, smem); GSYNC();
    run_phase<4>(l, smem); GSYNC();
    run_phase<5>(l, smem); GSYNC();
    run_phase<6>(l, smem); GSYNC();
    run_phase<7>(l, smem); GSYNC();
    run_phase<8>(l, smem); GSYNC();
    run_phase<9>(l, smem); GSYNC();
    run_phase<11>(l, smem); GSYNC();
    run_phase<12>(l, smem); if (l == 0) GSYNC();
  }
#undef GSYNC
}
#else
template <int PH> __global__ void __launch_bounds__(NTP, 1) phase_kernel(P p, int l) {
  extern __shared__ __attribute__((aligned(16))) char smem[];
  run_phase<PH>(l, smem);
}
#endif

extern "C" void kernel_launch(void* const* d_in, const int* in_sizes, int n_in, void* d_out, int out_size, void* d_ws, size_t ws_size, hipStream_t stream) {
  if (ws_size < WS_END || n_in < 36) { fprintf(stderr, "workspace too small: %zu < %zu\n", ws_size, (size_t)WS_END); return; }
  P p{};
  const float** pp = (const float**)&p;
  for (int i = 0; i < 36; ++i) pp[i] = (const float*)d_in[i];
  p.out = (float*)d_out; p.ws = (char*)d_ws;
  hipMemsetAsync(d_ws, 0, WS_WIN, stream);
#if MEGA
  static int grid_blocks = 0;
  if (!grid_blocks) {
    int dev = 0, cus = 0, per_cu = 0; hipGetDevice(&dev);
    hipDeviceGetAttribute(&cus, hipDeviceAttributeMultiprocessorCount, dev);
    hipFuncSetAttribute((const void*)mega_kernel, hipFuncAttributeMaxDynamicSharedMemorySize, SMEM_BYTES);
    hipOccupancyMaxActiveBlocksPerMultiprocessor(&per_cu, mega_kernel, NTP, SMEM_BYTES);
    if (per_cu > 1) per_cu = 1;
    grid_blocks = cus * per_cu;
  }
  void* args[] = {&p};
  hipError_t e = hipLaunchCooperativeKernel((void*)mega_kernel, dim3(grid_blocks), dim3(NTP), args, SMEM_BYTES, stream);
  if (e != hipSuccess) fprintf(stderr, "cooperative launch failed: %s (grid %d)\n", hipGetErrorString(e), grid_blocks);
#else
  const int G = 512;
#define LAUNCH(PH, L) do { hipFuncSetAttribute((const void*)phase_kernel<PH>, hipFuncAttributeMaxDynamicSharedMemorySize, SMEM_BYTES); phase_kernel<PH><<<G, NT, SMEM_BYTES, stream>>>(p, L); } while (0)
  LAUNCH(0, 0); LAUNCH(1, 0);
  for (int l = 0; l < 2; ++l) { LAUNCH(2, l); LAUNCH(4, l); LAUNCH(5, l); LAUNCH(6, l); LAUNCH(7, l); LAUNCH(8, l); LAUNCH(9, l); LAUNCH(11, l); LAUNCH(12, l); }
#endif
}
```

```cpp
#include <hip/hip_runtime.h>
#include <hip/hip_cooperative_groups.h>
#include <cstdio>
namespace cg = cooperative_groups;

#ifndef MEGA
#define MEGA 1
#endif
#define PROBE_MASK 0

typedef unsigned short bf16_t;
typedef short bf16x8 __attribute__((ext_vector_type(8)));
typedef short bf16x4 __attribute__((ext_vector_type(4)));
typedef float f32x4 __attribute__((ext_vector_type(4)));
typedef float f32x2 __attribute__((ext_vector_type(2)));
typedef unsigned u32x4 __attribute__((ext_vector_type(4)));
typedef unsigned u32x2 __attribute__((ext_vector_type(2)));
#define DI __device__ __forceinline__
#define MFMA16(a, b, c) __builtin_amdgcn_mfma_f32_16x16x32_bf16((a), (b), (c), 0, 0, 0)

constexpr int NT = 256;
constexpr int NTP = 512;
constexpr int VSMEM = 65536;
constexpr int D = 1024, MC = 8192, ML = 4096, MT = 12288;
constexpr int NZR = 1792, NZN = 1536, NZT = 2048, INC = 8448, FF = 2816;
constexpr int LDH = 1088, LDO = 576, LZT = 2112, LDG = 136;
constexpr int LDT = 72;
constexpr int SMEM_BYTES = 131072;
constexpr size_t O_K = 12582912, O_V = 20971520, O_RW = 29360128, O_RT = 33554432;
constexpr size_t WS_CTRL = 0;
constexpr size_t WS_MOD = 4096;
constexpr size_t WS_BAR = 262144;
constexpr size_t WS_CUF = 278528;
constexpr size_t WS_WG = 294912;
constexpr size_t WS_WIN = 434176;
constexpr size_t WS_WUP = WS_WIN;
constexpr size_t WS_WDN = WS_WIN + (size_t)5632 * LDH * 2;
constexpr size_t WS_WO3 = WS_WIN + (size_t)INC * LDH * 2;
constexpr size_t WS_WOUT = WS_WO3 + (size_t)3 * 1024 * LDO * 2;
constexpr size_t WS_H = WS_WOUT + (size_t)1024 * LDH * 2;
constexpr size_t WS_Z = WS_H + (size_t)MT * LDH * 2;
constexpr size_t WS_ZR = WS_Z;
constexpr size_t WS_ZN = WS_ZR + (size_t)MT * NZR * 2;
constexpr size_t WS_ZT = WS_ZN + (size_t)MT * NZN * 2;
constexpr size_t WS_MERGED = WS_ZR;
constexpr size_t WS_OA = WS_ZN;
constexpr size_t WS_U = WS_ZT;
constexpr size_t WS_HID = WS_Z;
constexpr size_t WS_F = WS_ZT;
constexpr size_t WS_Y = WS_ZT + (size_t)MT * LZT * 2;
constexpr size_t WS_ONA = WS_Y + (size_t)2 * MT * 512 * 4;
constexpr size_t WS_ORET = WS_ONA + (size_t)MT * LDO * 2;
constexpr size_t WS_END = WS_ORET + (size_t)MT * LDO * 2;

struct P {
  const float *x_prompt, *x_sample, *cache_k, *cache_v, *state_rwkv, *state_ret, *c, *c_ctx, *ada_w, *ada_b;
  const float *norm_mix_pre, *norm_mix_post, *norm_ffn_pre, *norm_ffn_post, *w_in, *rwkv_conv, *rwkv_w0, *rwkv_w_up, *rwkv_a0, *rwkv_a_up, *rwkv_g_up;
  const float *rwkv_k_k, *rwkv_k_a, *rwkv_r_k, *rwkv_ln_g, *rwkv_ln_b, *na_rpb, *ret_decay, *ret_gn, *w_o_rwkv, *w_o_na, *w_o_ret, *w_out, *ffn_up, *ffn_conv, *ffn_down;
  float* out; char* ws;
};

DI int threadIdx_x_raw() { return (int)__builtin_amdgcn_workitem_id_x(); }
DI int ptid() { int t = threadIdx_x_raw(); asm volatile("" : "+v"(t)); return t; }
DI int tidx() { return ptid() & 255; }
DI int vhalf() { return ptid() >> 8; }
DI int vblk() { return (int)blockIdx.x * 2 + vhalf(); }
DI int vgrid() { return (int)gridDim.x * 2; }
DI bf16_t f2bf(float x) { unsigned u = __float_as_uint(x); u += 0x7fffu + ((u >> 16) & 1u); return (bf16_t)(u >> 16); }
DI float bf2f(bf16_t b) { return __uint_as_float(((unsigned)b) << 16); }
DI unsigned pack2(float a, float b) { return (unsigned)f2bf(a) | ((unsigned)f2bf(b) << 16); }
DI float bflo(unsigned u) { return __uint_as_float(u << 16); }
DI float bfhi(unsigned u) { return __uint_as_float(u & 0xffff0000u); }
DI void unpack8(const u32x4 r, float (&f)[8]) { f[0] = bflo(r[0]); f[1] = bfhi(r[0]); f[2] = bflo(r[1]); f[3] = bfhi(r[1]); f[4] = bflo(r[2]); f[5] = bfhi(r[2]); f[6] = bflo(r[3]); f[7] = bfhi(r[3]); }
DI u32x4 pack8(const float (&f)[8]) { u32x4 r; r[0] = pack2(f[0], f[1]); r[1] = pack2(f[2], f[3]); r[2] = pack2(f[4], f[5]); r[3] = pack2(f[6], f[7]); return r; }
DI float sigmoidf_(float x) { return 1.f / (1.f + __expf(-x)); }
DI float shfl_x(float v, int m) { const int lane = ptid() & 63; return __int_as_float(__builtin_amdgcn_ds_bpermute((lane ^ m) << 2, __float_as_int(v))); }
DI float wave_sum(float v) { for (int o = 32; o > 0; o >>= 1) v += shfl_x(v, o); return v; }
DI void tokinfo(int m, int& t, int& T, int& mi) { if (m < MC) { t = m & 255; T = 256; mi = 0; } else { int q = m - MC; t = q & 1023; T = 1024; mi = 1 + (q >> 10); } }

#define XB_TMO      128
#define XB_XCNT(j)  (256  + 64 * (j))
#define XB_XSUB(j)  (1280 + 64 * (j))
#define XB_XGEN(j)  (2304 + 64 * (j))
#define XB_TOP      3328
#define XB_TOPGEN   3392
#define XB_SPIN_CAP (1u << 20)
#define LAS __attribute__((address_space(3)))
DI unsigned xb_ld(unsigned* p) { return __hip_atomic_load(p, __ATOMIC_RELAXED, __HIP_MEMORY_SCOPE_AGENT); }
DI unsigned xb_add(unsigned* p, unsigned v) { return __hip_atomic_fetch_add(p, v, __ATOMIC_RELAXED, __HIP_MEMORY_SCOPE_AGENT); }
DI unsigned xb_xcc_id() { return (unsigned)__builtin_amdgcn_s_getreg((3 << 11) | 20) & 0xFu; }
#define XB_SPIN(cond, bar) do { unsigned _sp = 0; while (cond) { __builtin_amdgcn_s_sleep(1); \
    if ((++_sp & 255u) == 0u) { if (xb_ld(&(bar)[XB_TMO])) break; if (_sp > XB_SPIN_CAP) { atomicAdd(&(bar)[XB_TMO], 1u); break; } } } } while (0)
struct XcdBarrier { unsigned* bar; unsigned x; volatile LAS unsigned* st; };
DI XcdBarrier xcd_barrier_post(unsigned* bar, volatile LAS unsigned* st) {
  XcdBarrier b; b.bar = bar; b.x = xb_xcc_id(); b.st = st;
  if (ptid() == 0) (void)xb_add(&bar[XB_XCNT(b.x)], 1u);
  return b;
}
DI void xcd_barrier_complete(unsigned* bar, unsigned x, unsigned& nloc, unsigned& nx) {
  const unsigned G = gridDim.x * gridDim.y * gridDim.z;
  unsigned sum, cnt, mine, sp = 0u;
  for (;;) {
    sum = 0u; cnt = 0u; mine = 0u;
#pragma unroll
    for (unsigned j = 0; j < 16; ++j) { const unsigned c = xb_ld(&bar[XB_XCNT(j)]); sum += c; cnt += (c > 0u) ? 1u : 0u; mine = (j == x) ? c : mine; }
    if (sum == G) break;
    __builtin_amdgcn_s_sleep(1);
    if ((++sp & 255u) == 0u) { if (xb_ld(&bar[XB_TMO])) break; if (sp > XB_SPIN_CAP) { atomicAdd(&bar[XB_TMO], 1u); break; } }
  }
  nloc = mine > 0u ? mine : 1u; nx = cnt > 0u ? cnt : 1u;
}
DI void xcd_barrier(const XcdBarrier& b) {
  asm volatile("s_waitcnt vmcnt(0)" ::: "memory");
  __syncthreads();
  if (ptid() == 0) {
    unsigned* bar = b.bar;
    __builtin_amdgcn_s_waitcnt(0);
    unsigned nloc = b.st[0], nx = b.st[1];
    if (nloc == 0u) { xcd_barrier_complete(bar, b.x, nloc, nx); b.st[0] = nloc; b.st[1] = nx; }
    const unsigned old = xb_add(&bar[XB_XSUB(b.x)], 1u);
    const unsigned gen = old / nloc;
    if (old + 1u == (gen + 1u) * nloc) {
      __builtin_amdgcn_fence(__ATOMIC_RELEASE, "agent");
      asm volatile("s_waitcnt vmcnt(0)" ::: "memory");
      const unsigned og = xb_add(&bar[XB_TOP], 1u);
      const unsigned tg = og / nx;
      if (og + 1u == (tg + 1u) * nx) xb_add(&bar[XB_TOPGEN], 1u);
      else XB_SPIN(xb_ld(&bar[XB_TOPGEN]) == tg, bar);
      __builtin_amdgcn_fence(__ATOMIC_ACQUIRE, "agent");
      xb_add(&bar[XB_XGEN(b.x)], 1u);
      asm volatile("s_waitcnt vmcnt(0)" ::: "memory");
    } else {
      XB_SPIN(xb_ld(&bar[XB_XGEN(b.x)]) == gen, bar);
      __builtin_amdgcn_fence(__ATOMIC_ACQUIRE, "agent");
      asm volatile("s_waitcnt vmcnt(0)" ::: "memory");
    }
  }
  __syncthreads();
}

__device__ void convert_T(const float* __restrict__ W, int K, int N, bf16_t* __restrict__ Wt, int ldt, char* smem) {
  float* t = (float*)(smem + vhalf() * VSMEM);
  const int tid = tidx(), ntn = N >> 6, nitems = (K >> 6) * ntn;
  for (int it = vblk(); it < nitems; it += vgrid()) {
    const int k0 = (it / ntn) << 6, n0 = (it % ntn) << 6;
    __syncthreads();
#pragma unroll
    for (int i = 0; i < 4; ++i) { const int k = (tid >> 4) + 16 * i, c4 = (tid & 15) * 4;
      const float4 v = *(const float4*)(W + (size_t)(k0 + k) * N + n0 + c4);
      t[k * 65 + c4] = v.x; t[k * 65 + c4 + 1] = v.y; t[k * 65 + c4 + 2] = v.z; t[k * 65 + c4 + 3] = v.w; }
    __syncthreads();
#pragma unroll
    for (int i = 0; i < 2; ++i) { const int c = tid + 256 * i, n = c >> 3, kc = c & 7; float f[8];
#pragma unroll
      for (int e = 0; e < 8; ++e) f[e] = t[(kc * 8 + e) * 65 + n];
      *(u32x4*)(Wt + (size_t)(n0 + n) * ldt + k0 + kc * 8) = pack8(f); }
  }
}

__device__ void ada_phase(const P& p, char* smem) {
  float* sc = (float*)(smem + vhalf() * VSMEM);
  float* red = sc + 640;
  float* mod = (float*)(p.ws + WS_MOD);
  const int tid = tidx(), kq = tid >> 5, cq = tid & 31;
  for (int it = vblk(); it < 2 * 48 * 8; it += vgrid()) {
    const int l = it / 384, rem = it % 384, nb = rem >> 3, ks = rem & 7;
    const int n0 = nb * 128, k0 = ks * 128;
    __syncthreads();
    for (int e = tid; e < 640; e += NT) { const int i = e >> 7, k = e & 127; const float v = (i == 0) ? p.c_ctx[k0 + k] : p.c[(i - 1) * D + k0 + k]; sc[e] = v * sigmoidf_(v); }
    __syncthreads();
    float acc[5][4];
#pragma unroll
    for (int i = 0; i < 5; ++i)
#pragma unroll
      for (int j = 0; j < 4; ++j) acc[i][j] = 0.f;
    const float* wp = p.ada_w + ((size_t)l * D + k0 + kq * 16) * 6144 + n0 + cq * 4;
#pragma unroll 4
    for (int kk = 0; kk < 16; ++kk) { const float4 w = *(const float4*)(wp + (size_t)kk * 6144);
#pragma unroll
      for (int i = 0; i < 5; ++i) { const float s = sc[i * 128 + kq * 16 + kk]; acc[i][0] += s * w.x; acc[i][1] += s * w.y; acc[i][2] += s * w.z; acc[i][3] += s * w.w; } }
#pragma unroll
    for (int i = 0; i < 5; ++i)
#pragma unroll
      for (int j = 0; j < 4; ++j) red[(kq * 5 + i) * 128 + cq * 4 + j] = acc[i][j];
    __syncthreads();
    for (int e = tid; e < 640; e += NT) { const int i = e >> 7, n = e & 127; float s = 0.f;
#pragma unroll
      for (int q = 0; q < 8; ++q) s += red[(q * 5 + i) * 128 + n];
      if (ks == 0) s += p.ada_b[l * 6144 + n0 + n];
      atomicAdd(mod + ((size_t)l * 5 + i) * 6144 + n0 + n, s); }
  }
}

__device__ void norm_phase(const P& p, const float* xin  , const float* u, const float* gpost, const float* modU, int gate_idx,
                           float* xout, const float* gpre, const float* modN, int shift_idx, bf16_t* hout) {
  const int lane = tidx() & 63, wave = tidx() >> 6, nw = NT / 64;
  for (int m = vblk() * nw + wave; m < MT; m += vgrid() * nw) {
    int t, T, mi; tokinfo(m, t, T, mi);
    const float* xr = xin ? xin + (size_t)m * D : (m < MC ? p.x_prompt + (size_t)m * D : p.x_sample + (size_t)(m - MC) * D);
    float4 x[4];
#pragma unroll
    for (int i = 0; i < 4; ++i) x[i] = *(const float4*)(xr + i * 256 + lane * 4);
    if (u) {
      float4 uu[4]; float ss = 0.f;
#pragma unroll
      for (int i = 0; i < 4; ++i) { uu[i] = *(const float4*)(u + (size_t)m * D + i * 256 + lane * 4); ss += uu[i].x * uu[i].x + uu[i].y * uu[i].y + uu[i].z * uu[i].z + uu[i].w * uu[i].w; }
      ss = wave_sum(ss); const float rs = rsqrtf(ss * (1.f / D) + 1e-6f);
#pragma unroll
      for (int i = 0; i < 4; ++i) { const int c = i * 256 + lane * 4; const float4 g = *(const float4*)(gpost + c); const float4 ga = *(const float4*)(modU + ((size_t)mi * 6 + gate_idx) * D + c);
        x[i].x += ga.x * uu[i].x * rs * g.x; x[i].y += ga.y * uu[i].y * rs * g.y; x[i].z += ga.z * uu[i].z * rs * g.z; x[i].w += ga.w * uu[i].w * rs * g.w; }
    }
    if (xout) {
#pragma unroll
      for (int i = 0; i < 4; ++i) *(float4*)(xout + (size_t)m * D + i * 256 + lane * 4) = x[i];
    }
    if (hout) {
      float ss = 0.f;
#pragma unroll
      for (int i = 0; i < 4; ++i) ss += x[i].x * x[i].x + x[i].y * x[i].y + x[i].z * x[i].z + x[i].w * x[i].w;
      ss = wave_sum(ss); const float rs = rsqrtf(ss * (1.f / D) + 1e-6f);
#pragma unroll
      for (int i = 0; i < 4; ++i) { const int c = i * 256 + lane * 4; const float4 g = *(const float4*)(gpre + c);
        const float4 sh = *(const float4*)(modN + ((size_t)mi * 6 + shift_idx) * D + c); const float4 sc = *(const float4*)(modN + ((size_t)mi * 6 + shift_idx + 1) * D + c);
        u32x2 o; o.x = pack2(x[i].x * rs * g.x * (1.f + sc.x) + sh.x, x[i].y * rs * g.y * (1.f + sc.y) + sh.y); o.y = pack2(x[i].z * rs * g.z * (1.f + sc.z) + sh.z, x[i].w * rs * g.w * (1.f + sc.w) + sh.w);
        *(u32x2*)(hout + (size_t)m * LDH + c) = o; }
    }
  }
}

struct TileSrc { const bf16_t* A; int lda; int arow0; const bf16_t* B; int ldb; int brow0, brow1; int K; };

template <int MM, int NN> DI void zero_acc(f32x4 (&acc)[MM][NN]) {
#pragma unroll
  for (int m = 0; m < MM; ++m)
#pragma unroll
    for (int n = 0; n < NN; ++n) acc[m][n] = (f32x4){0.f, 0.f, 0.f, 0.f};
}

template <int MM, int NN> struct Gemm {
  static constexpr int NA = MM / 2, NB = NN;
  unsigned oa_[NA], ob_[NB]; const bf16_t* A; const bf16_t* B; int nk; u32x4 ra[NA], rb[NB];
#define GT_LOAD(KT) do { const int kn_ = ((KT) < nk ? (KT) : nk - 1) * 64; \
    _Pragma("unroll") for (int i = 0; i < NA; ++i) ra[i] = *(const u32x4*)(A + (oa_[i] + kn_)); \
    _Pragma("unroll") for (int i = 0; i < NB; ++i) rb[i] = *(const u32x4*)(B + (ob_[i] + kn_)); } while (0)
  DI void begin(const TileSrc& s) {
    const int tid = ptid();
#pragma unroll
    for (int i = 0; i < NA; ++i) { const int row = (tid >> 3) + 64 * i, kc = tid & 7;
      int ar = s.arow0 + row; ar = ar < 0 ? 0 : (ar > MT - 1 ? MT - 1 : ar);
      oa_[i] = (unsigned)ar * (unsigned)s.lda + kc * 8; }
#pragma unroll
    for (int i = 0; i < NB; ++i) { const int row = (tid >> 3) + 64 * i, kc = tid & 7;
      const int br = row < 32 * NN ? s.brow0 + row : s.brow1 + row - 32 * NN;
      ob_[i] = (unsigned)br * (unsigned)s.ldb + kc * 8; }
    A = s.A; B = s.B; nk = s.K >> 6;
    GT_LOAD(0);
  }
  DI void run(f32x4 (&acc)[MM][NN], char* smem) {
    bf16_t* sbase = (bf16_t*)smem;
    const int tid = ptid(), lane = tid & 63, wave = tid >> 6, wr = wave >> 2, wc = wave & 3, fr = lane & 15, fq = lane >> 4;
    int wofs; { const int r = tid >> 3, kc = tid & 7, ob = (r & 15) * 64 + (kc & 3) * 16; wofs = (((r >> 4) * 2 + (kc >> 2)) * 1024 + (ob ^ (((ob >> 9) & 1) << 5))) >> 1; }
    int robase; { const int ob = fr * 64 + fq * 16; robase = (ob ^ (((ob >> 9) & 1) << 5)) >> 1; }
#define GT_STORE(ST) do { bf16_t* sA_ = sbase + (ST) * 32768; bf16_t* sB_ = sA_ + 16384; \
    _Pragma("unroll") for (int i = 0; i < NA; ++i) *(u32x4*)(sA_ + wofs + i * 4096) = ra[i]; \
    _Pragma("unroll") for (int i = 0; i < NB; ++i) *(u32x4*)(sB_ + wofs + i * 4096) = rb[i]; } while (0)
#define GT_COMPUTE(ST) do { const bf16_t* sA_ = sbase + (ST) * 32768 + robase; const bf16_t* sB_ = sA_ + 16384; \
    _Pragma("unroll 1") for (int ks = 0; ks < 2; ++ks) { bf16x8 bfr[NN]; \
      _Pragma("unroll") for (int n = 0; n < NN; ++n) bfr[n] = *(const bf16x8*)(sB_ + ((wc * NN + n) * 2 + ks) * 512); \
      _Pragma("unroll") for (int m = 0; m < MM; ++m) { const bf16x8 af = *(const bf16x8*)(sA_ + ((wr * MM + m) * 2 + ks) * 512); \
        _Pragma("unroll") for (int n = 0; n < NN; ++n) acc[m][n] = MFMA16(bfr[n], af, acc[m][n]); } } } while (0)
    __syncthreads();
    GT_STORE(0);
    GT_LOAD(1);
    __syncthreads();
#pragma unroll 1
    for (int kt = 0; kt < nk; kt += 2) {
      GT_STORE(1); GT_LOAD(kt + 2); GT_COMPUTE(0); __syncthreads();
      GT_STORE(0); GT_LOAD(kt + 3); GT_COMPUTE(1); __syncthreads();
    }
  }
#undef GT_LOAD
#undef GT_STORE
#undef GT_COMPUTE
};
template <int MM, int NN> DI void gemm_tile(f32x4 (&acc)[MM][NN], const TileSrc& s, char* smem) { Gemm<MM, NN> g; g.begin(s); g.run(acc, smem); }

DI float gelu_tanh(float x) { const float u = 0.7978845608f * (x + 0.044715f * x * x * x); const float e = __expf(2.f * u); const float th = 1.f - 2.f / (e + 1.f); return 0.5f * x * (1.f + th); }

struct TileIter {
  int m_lo, rows, NTn, G, efull, count, e, stride;
  DI void init(int MTn, int NTn_) { const int x = blockIdx.x & 7; m_lo = (x * MTn) >> 3; rows = (((x + 1) * MTn) >> 3) - m_lo; NTn = NTn_; G = (rows + 1) >> 1;
    efull = (rows / G) * G * NTn; count = rows * NTn; e = blockIdx.x >> 3; stride = gridDim.x >> 3; }
  DI bool next(int& mt, int& nt) { if (e >= count) return false;
    if (e < efull) { const int grp = e / (G * NTn), rem = e - grp * G * NTn; nt = rem / G; mt = m_lo + grp * G + (rem - nt * G); }
    else { const int rem = e - efull, gsz = rows - (rows / G) * G; nt = rem / gsz; mt = m_lo + (rows / G) * G + (rem - nt * gsz); }
    e += stride; return true; }
};

__device__ void phase_win(const P& p, int l, char* smem) {
  const bf16_t* H = (const bf16_t*)(p.ws + WS_H); const bf16_t* Wt = (const bf16_t*)(p.ws + WS_WIN);
  bf16_t* zr = (bf16_t*)(p.ws + WS_ZR); bf16_t* zn = (bf16_t*)(p.ws + WS_ZN); bf16_t* zt = (bf16_t*)(p.ws + WS_ZT);
  const int tid = ptid(), lane = tid & 63, wave = tid >> 6, wr = wave >> 2, wc = wave & 3, fr = lane & 15, fq = lane >> 4;
  Gemm<8, 4> gm;
  TileIter ti; ti.init(48, 14);
  const int x = blockIdx.x & 7, nconv = (343 - x + 7) >> 3, nloc = ti.count + nconv;
  const float* cw = p.rwkv_conv + (size_t)l * 3 * NZR;
  for (int e = (int)(blockIdx.x >> 3); e < nloc; e += (int)(gridDim.x >> 3)) {
    f32x4 acc[8][4]; zero_acc<8, 4>(acc);
    if (e < nconv) {
      const int c = x + 8 * e, mt = c / 7, nt = c - mt * 7;
      const int n0 = nt * 256, arow0 = mt * 254 - 1;
      { TileSrc s{H, LDH, arow0, Wt, LDH, n0, n0 + 128, D}; gm.begin(s); }
      gm.run(acc, smem);
      float* sC = (float*)smem;
#pragma unroll 1
      for (int sl = 0; sl < 4; ++sl) {
        __syncthreads();
        if (wc == sl) {
#pragma unroll
          for (int m = 0; m < 8; ++m)
#pragma unroll
            for (int n = 0; n < 4; ++n) *(f32x4*)(sC + (wr * 128 + m * 16 + fr) * 68 + n * 16 + fq * 4) = acc[m][n];
        }
        __syncthreads();
        const int nb = n0 + sl * 64, c4 = (tid & 15) * 4;
        const float4 w0 = *(const float4*)(cw + nb + c4), w1 = *(const float4*)(cw + NZR + nb + c4), w2 = *(const float4*)(cw + 2 * NZR + nb + c4);
        for (int ee = tid; ee < 254 * 16; ee += NTP) {
          const int tr = 1 + (ee >> 4), g = arow0 + tr;
          if (g < MT) { int t, T, mi; tokinfo(g, t, T, mi);
            const float pm = t > 0 ? 1.f : 0.f, nm = t < T - 1 ? 1.f : 0.f;
            const f32x4 a = *(const f32x4*)(sC + (tr - 1) * 68 + c4), b = *(const f32x4*)(sC + tr * 68 + c4), cc = *(const f32x4*)(sC + (tr + 1) * 68 + c4);
            float r0 = pm * a[0] * w0.x + b[0] * w1.x + nm * cc[0] * w2.x, r1 = pm * a[1] * w0.y + b[1] * w1.y + nm * cc[1] * w2.y;
            float r2 = pm * a[2] * w0.z + b[2] * w1.z + nm * cc[2] * w2.z, r3 = pm * a[3] * w0.w + b[3] * w1.w + nm * cc[3] * w2.w;
            if (nb >= 1664) { r0 = sigmoidf_(r0); r1 = sigmoidf_(r1); r2 = sigmoidf_(r2); r3 = sigmoidf_(r3); }
            u32x2 o; o.x = pack2(r0, r1); o.y = pack2(r2, r3);
            *(u32x2*)(zr + (size_t)g * NZR + nb + c4) = o; }
        }
      }
    } else {
      int mt, nt; ti.e = e - nconv; ti.next(mt, nt);
      const int n0 = nt * 256, row0 = mt * 256;
      { TileSrc s{H, LDH, row0, Wt, LDH, NZR + n0, NZR + n0 + 128, D}; gm.begin(s); }
      gm.run(acc, smem);
#pragma unroll
      for (int m = 0; m < 8; ++m) { const int row = row0 + wr * 128 + m * 16 + fr;
#pragma unroll
        for (int n = 0; n < 4; ++n) { const int col = n0 + wc * 64 + n * 16 + fq * 4; const f32x4 v = acc[m][n];
          u32x2 o; o.x = pack2(v[0], v[1]); o.y = pack2(v[2], v[3]);
          if (col < NZN) {
            *(u32x2*)(zn + (size_t)row * NZN + col) = o;
            if (row < MC && col >= 512) { const int part = col - 512, isv = part >> 9, pp = part & 511, hh = pp >> 6, d = pp & 63, b = row >> 8, t = row & 255;
              float* dst = p.out + (isv ? O_V : O_K) + ((((size_t)b * 2 + l) * 8 + hh) * 256 + t) * 64 + d; *(f32x4*)dst = v; }
          } else { *(u32x2*)(zt + (size_t)row * LZT + (col - NZN)) = o; }
        } }
    }
  }
}

__device__ void phase_merge(const P& p, char* smem) {
  const bf16_t* H = (const bf16_t*)(p.ws + WS_H); const bf16_t* Wt = (const bf16_t*)(p.ws + WS_WIN); const bf16_t* Wo3 = (const bf16_t*)(p.ws + WS_WO3);
  bf16_t* mg = (bf16_t*)(p.ws + WS_MERGED);
  const int tid = ptid(), lane = tid & 63, wave = tid >> 6, wr = wave >> 2, wc = wave & 3, fr = lane & 15, fq = lane >> 4;
  TileIter ti; int mt, nt; ti.init(96, 8);
  while (ti.next(mt, nt)) {
    const int n0 = nt * 128, row0 = mt * 128;
    f32x4 macc[4][2]; zero_acc<4, 2>(macc);
#pragma unroll 1
    for (int i = 0; i < 3; ++i) {
      const bf16_t* O = (const bf16_t*)(p.ws + (i == 0 ? WS_OA : (i == 1 ? WS_ONA : WS_ORET)));
      f32x4 g[4][2]; zero_acc<4, 2>(g);
      { TileSrc s{H, LDH, row0, Wt, LDH, 5376 + i * 1024 + n0, 5376 + i * 1024 + n0 + 64, D}; gemm_tile<4, 2>(g, s, smem); }
      f32x4 a2[4][2]; zero_acc<4, 2>(a2);
      { TileSrc s{O, LDO, row0, Wo3 + (size_t)i * 1024 * LDO, LDO, n0, n0 + 64, 512}; gemm_tile<4, 2>(a2, s, smem); }
#pragma unroll
      for (int m = 0; m < 4; ++m)
#pragma unroll
        for (int n = 0; n < 2; ++n)
#pragma unroll
          for (int j = 0; j < 4; ++j) macc[m][n][j] += sigmoidf_(g[m][n][j]) * a2[m][n][j];
    }
#pragma unroll
    for (int m = 0; m < 4; ++m) { const int row = row0 + wr * 64 + m * 16 + fr;
#pragma unroll
      for (int n = 0; n < 2; ++n) { const int col = n0 + wc * 32 + n * 16 + fq * 4; u32x2 o; o.x = pack2(macc[m][n][0], macc[m][n][1]); o.y = pack2(macc[m][n][2], macc[m][n][3]); *(u32x2*)(mg + (size_t)row * LDH + col) = o; } }
  }
}

__device__ void phase_gemm_f32(const bf16_t* A, int lda, int K, const bf16_t* Bt, int ldb, float* C, char* smem) {
  const int tid = ptid(), lane = tid & 63, wave = tid >> 6, wr = wave >> 2, wc = wave & 3, fr = lane & 15, fq = lane >> 4;
  TileIter ti; int mt, nt; ti.init(48, 4);
  while (ti.next(mt, nt)) {
    const int n0 = nt * 256, row0 = mt * 256;
    f32x4 acc[8][4]; zero_acc<8, 4>(acc);
    TileSrc s{A, lda, row0, Bt, ldb, n0, n0 + 128, K}; gemm_tile<8, 4>(acc, s, smem);
#pragma unroll
    for (int m = 0; m < 8; ++m) { const int row = row0 + wr * 128 + m * 16 + fr;
#pragma unroll
      for (int n = 0; n < 4; ++n) *(f32x4*)(C + (size_t)row * D + n0 + wc * 64 + n * 16 + fq * 4) = acc[m][n]; }
  }
}

__device__ void phase_ffn_up(const P& p, int l, char* smem) {
  const bf16_t* H = (const bf16_t*)(p.ws + WS_H); const bf16_t* Wt = (const bf16_t*)(p.ws + WS_WUP); bf16_t* hid = (bf16_t*)(p.ws + WS_HID);
  const int tid = ptid(), lane = tid & 63, wave = tid >> 6, wr = wave >> 2, wc = wave & 3, fr = lane & 15, fq = lane >> 4;
  const float* cw = p.ffn_conv + (size_t)l * 3 * 2 * FF;
  TileIter ti; int mt, nt; ti.init(49, 22);
  Gemm<8, 4> gm;
  while (ti.next(mt, nt)) {
    const int c0 = nt * 128, arow0 = mt * 254 - 1;
    f32x4 acc[8][4]; zero_acc<8, 4>(acc);
    { TileSrc s{H, LDH, arow0, Wt, LDH, c0, FF + c0, D}; gm.begin(s); }
    gm.run(acc, smem);
    float* sC = (float*)smem;
#pragma unroll
    for (int q = 0; q < 4; ++q) {
      __syncthreads();
      if ((wc & 1) == (q >> 1)) { const int cb = (wc >> 1) * 32;
#pragma unroll
        for (int m = 0; m < 8; ++m)
#pragma unroll
          for (int n = 0; n < 2; ++n) *(f32x4*)(sC + (wr * 128 + m * 16 + fr) * 68 + cb + n * 16 + fq * 4) = acc[m][(q & 1) * 2 + n];
      }
      __syncthreads();
      const int cq = c0 + q * 32, c4 = (tid & 7) * 4;
      const f32x4 v0 = *(const f32x4*)(cw + cq + c4), v1 = *(const f32x4*)(cw + 2 * FF + cq + c4), v2 = *(const f32x4*)(cw + 4 * FF + cq + c4);
      const f32x4 g0 = *(const f32x4*)(cw + FF + cq + c4), g1 = *(const f32x4*)(cw + 3 * FF + cq + c4), g2 = *(const f32x4*)(cw + 5 * FF + cq + c4);
      for (int e = tid; e < 254 * 8; e += NTP) {
        const int tr = 1 + (e >> 3), g = arow0 + tr;
        if (g < MT) { int t, T, mi; tokinfo(g, t, T, mi);
          const float pm = t > 0 ? 1.f : 0.f, nm = t < T - 1 ? 1.f : 0.f;
          const f32x4 va = *(const f32x4*)(sC + (tr - 1) * 68 + c4), vb = *(const f32x4*)(sC + tr * 68 + c4), vc = *(const f32x4*)(sC + (tr + 1) * 68 + c4);
          const f32x4 ga = *(const f32x4*)(sC + (tr - 1) * 68 + 32 + c4), gb = *(const f32x4*)(sC + tr * 68 + 32 + c4), gc = *(const f32x4*)(sC + (tr + 1) * 68 + 32 + c4);
          float r[4];
#pragma unroll
          for (int j = 0; j < 4; ++j) { const float val = pm * va[j] * v0[j] + vb[j] * v1[j] + nm * vc[j] * v2[j]; const float gt = pm * ga[j] * g0[j] + gb[j] * g1[j] + nm * gc[j] * g2[j]; r[j] = gelu_tanh(gt) * val; }
          u32x2 o; o.x = pack2(r[0], r[1]); o.y = pack2(r[2], r[3]);
          *(u32x2*)(hid + (size_t)g * FF + cq + c4) = o; }
      }
    }
  }
}

template <int CTRL> DI float dppf(float v) { return __int_as_float(__builtin_amdgcn_mov_dpp(__float_as_int(v), CTRL, 0xF, 0xF, true)); }
DI float row16_sum(float v) { v += dppf<0xB1>(v); v += dppf<0x4E>(v); v += dppf<0x141>(v); v += dppf<0x140>(v); return v; }

DI float frcp(float x) { return __builtin_amdgcn_rcpf(x); }
DI float fsig(float x) { return frcp(1.f + __expf(-x)); }
__device__ void scan_task(const P& p, int l, int seq, int h, int d, int half, char* smem) {
  float* sR = (float*)smem; float* sW = sR + 1024; float* sKD = sW + 1024; float* sB = sKD + 1024; float* sNK = sB + 1024; float* sV = sNK + 1024; float* sK = sV + 1024; float* sY = sK + 1024;
  float* sKn = sY + 1024; float* sKK = sKn + 16; bf16_t* sWT = (bf16_t*)(sKK + 64); bf16_t* sAL = sWT + 16 * LDT;
  const int tid = tidx(), lane = tid & 63, wave = tid >> 6, fr = lane & 15, fq = lane >> 4;
  const int row0 = seq < 32 ? seq * 256 : MC + (seq - 32) * 1024, T = seq < 32 ? 256 : 1024, nch = T >> 4;
  const bf16_t* zr = (const bf16_t*)(p.ws + WS_ZR);
  float* yout = (float*)(p.ws + WS_Y) + (size_t)d * MT * 512;
  __syncthreads();
  if (tid < 64) sKK[tid] = p.rwkv_k_k[l * 512 + h * 64 + tid];
  const int cc = wave * 16 + fr, gc = h * 64 + cc;
  bf16x8 bw[2], ba[2];
#pragma unroll
  for (int ks = 0; ks < 2; ++ks)
#pragma unroll
    for (int e = 0; e < 8; ++e) { const int k = ks * 32 + fq * 8 + e;
      bw[ks][e] = (short)f2bf(p.rwkv_w_up[((size_t)(l * 2 + d) * 64 + k) * 512 + gc]); ba[ks][e] = (short)f2bf(p.rwkv_a_up[((size_t)(l * 2 + d) * 64 + k) * 512 + gc]); }
  const float w0c = p.rwkv_w0[(l * 2 + d) * 512 + gc], a0c = p.rwkv_a0[(l * 2 + d) * 512 + gc], kac = p.rwkv_k_a[l * 512 + gc];
  const int rg = tid >> 4, kq = tid & 15, rbase = half * 32 + rg * 2;
  f32x2 S[2][2];
  if (seq >= 32) { const float* s0 = p.state_rwkv + (((((size_t)(seq - 32) * 2 + l) * 2 + d) * 8 + h) * 64 + rbase) * 64 + kq * 4;
#pragma unroll
    for (int r = 0; r < 2; ++r) { const f32x4 x = *(const f32x4*)(s0 + r * 64); S[r][0] = (f32x2){x[0], x[1]}; S[r][1] = (f32x2){x[2], x[3]}; } }
  else {
#pragma unroll
    for (int r = 0; r < 2; ++r) { S[r][0] = (f32x2){0.f, 0.f}; S[r][1] = (f32x2){0.f, 0.f}; } }
  if (seq >= 32) __builtin_amdgcn_s_setprio(2);
  const int at = (tid & 127) >> 3, apart = tid & 7, ahi = tid >> 7;
  size_t coff[3];
  { const int sb0 = ahi ? 512 + h * 64 : h * 64, sb1 = ahi ? 1536 : 1024 + h * 64, sb2 = 1600;
    coff[0] = (size_t)at * NZR + sb0 + apart * 8; coff[1] = (size_t)at * NZR + sb1 + apart * 8; coff[2] = (size_t)at * NZR + sb2 + apart * 8; }
  u32x4 pre[3];
  { const int t0 = (d ? nch - 1 : 0) * 16;
#pragma unroll
    for (int i = 0; i < 3; ++i) pre[i] = *(const u32x4*)(zr + (size_t)(row0 + t0) * NZR + coff[i]); }
  __syncthreads();
  for (int ci = 0; ci < nch; ++ci) {
    const int chunk = d ? nch - 1 - ci : ci, t0 = chunk * 16;
    { const int o = at * 64 + apart * 8; float f[8];
      unpack8(pre[0], f);
      if (ahi == 0) { *(f32x4*)(sR + o) = (f32x4){f[0], f[1], f[2], f[3]}; *(f32x4*)(sR + o + 4) = (f32x4){f[4], f[5], f[6], f[7]}; }
      else { *(f32x4*)(sK + o) = (f32x4){f[0], f[1], f[2], f[3]}; *(f32x4*)(sK + o + 4) = (f32x4){f[4], f[5], f[6], f[7]}; float ps = 0.f;
#pragma unroll
        for (int e = 0; e < 8; ++e) { const float kk = f[e] * sKK[apart * 8 + e]; ps += kk * kk; }
        ps += dppf<0xB1>(ps); ps += dppf<0x4E>(ps); ps += dppf<0x141>(ps);
        if (apart == 0) sKn[at] = ps; }
      unpack8(pre[1], f);
      if (ahi == 0) { *(f32x4*)(sV + o) = (f32x4){f[0], f[1], f[2], f[3]}; *(f32x4*)(sV + o + 4) = (f32x4){f[4], f[5], f[6], f[7]}; }
      else { float g[8];
#pragma unroll
        for (int e = 0; e < 8; ++e) g[e] = 1.f - 2.f * frcp(__expf(2.f * f[e]) + 1.f);
        *(u32x4*)(sWT + at * LDT + apart * 8) = pack8(g); }
      if (ahi == 0) *(u32x4*)(sAL + at * LDT + apart * 8) = pre[2];
    }
    __syncthreads();
    {
      f32x4 aw = {0.f, 0.f, 0.f, 0.f}, aa = {0.f, 0.f, 0.f, 0.f};
#pragma unroll
      for (int ks = 0; ks < 2; ++ks) { const bf16x8 fw = *(const bf16x8*)(sWT + fr * LDT + ks * 32 + fq * 8); const bf16x8 fa = *(const bf16x8*)(sAL + fr * LDT + ks * 32 + fq * 8);
        aw = MFMA16(fw, bw[ks], aw); aa = MFMA16(fa, ba[ks], aa); }
      const float kkc = sKK[cc];
#pragma unroll
      for (int j = 0; j < 4; ++j) { const int t = fq * 4 + j, o = t * 64 + cc;
        const float dec = __expf(-0.6065306597f * fsig(w0c + aw[j]));
        const float a = fsig(a0c + aa[j]);
        const float kv = sK[o];
        const float kkv = kv * kkc * __builtin_amdgcn_rsqf(fmaxf(sKn[t], 1e-24f));
        sW[o] = dec; sKD[o] = kv * (1.f + (a - 1.f) * kac); sB[o] = kkv * a; sNK[o] = -kkv; }
    }
    __syncthreads();
    { const int cn = ci + 1 < nch ? ci + 1 : ci; const int nt0 = (d ? nch - 1 - cn : cn) * 16;
#pragma unroll
      for (int i = 0; i < 3; ++i) pre[i] = *(const u32x4*)(zr + (size_t)(row0 + nt0) * NZR + coff[i]); }
#pragma unroll 2
    for (int si = 0; si < 16; ++si) {
      const int t = d ? 15 - si : si, o = t * 64 + kq * 4;
      const f32x4 an4 = *(const f32x4*)(sNK + o), w4 = *(const f32x4*)(sW + o), b4 = *(const f32x4*)(sB + o), kd4 = *(const f32x4*)(sKD + o), r4 = *(const f32x4*)(sR + o);
      const f32x2 v2 = *(const f32x2*)(sV + t * 64 + rbase);
      const f32x2 an[2] = {{an4[0], an4[1]}, {an4[2], an4[3]}}, wv[2] = {{w4[0], w4[1]}, {w4[2], w4[3]}}, bv[2] = {{b4[0], b4[1]}, {b4[2], b4[3]}}, kd[2] = {{kd4[0], kd4[1]}, {kd4[2], kd4[3]}}, rv[2] = {{r4[0], r4[1]}, {r4[2], r4[3]}};
      float sa[2];
#pragma unroll
      for (int r = 0; r < 2; ++r) { const f32x2 t2 = S[r][0] * an[0] + S[r][1] * an[1]; sa[r] = row16_sum(t2.x + t2.y); }
      f32x2 yv;
#pragma unroll
      for (int r = 0; r < 2; ++r) { const f32x2 sav = {sa[r], sa[r]}, vvv = {v2[r], v2[r]};
        S[r][0] = S[r][0] * wv[0] + (sav * bv[0] + vvv * kd[0]); S[r][1] = S[r][1] * wv[1] + (sav * bv[1] + vvv * kd[1]);
        const f32x2 y2 = S[r][0] * rv[0] + S[r][1] * rv[1]; yv[r] = row16_sum(y2.x + y2.y); }
      if (kq == 0) *(f32x2*)(sY + t * 64 + rbase) = yv;
    }
    __syncthreads();
    { const int t = tid >> 4, vv = half * 32 + (tid & 15) * 2; *(f32x2*)(yout + (size_t)(row0 + t0 + t) * 512 + h * 64 + vv) = *(const f32x2*)(sY + t * 64 + vv); }
  }
  __builtin_amdgcn_s_setprio(0);
  if (seq < 32) { float* so = p.out + O_RW + (((((size_t)seq * 2 + l) * 2 + d) * 8 + h) * 64 + rbase) * 64 + kq * 4;
#pragma unroll
    for (int r = 0; r < 2; ++r) *(f32x4*)(so + r * 64) = (f32x4){S[r][0].x, S[r][0].y, S[r][1].x, S[r][1].y}; }
}

DI void qk_scores(const bf16_t* sK, const bf16x8 (&qf)[2], f32x4 (&sacc)[4], int fr, int fq) {
#pragma unroll
  for (int nt = 0; nt < 4; ++nt) { sacc[nt] = (f32x4){0.f, 0.f, 0.f, 0.f};
#pragma unroll
    for (int ks = 0; ks < 2; ++ks) { const bf16x8 kf = *(const bf16x8*)(sK + (nt * 16 + fr) * LDT + ks * 32 + fq * 8); sacc[nt] = MFMA16(kf, qf[ks], sacc[nt]); } }
}
DI void pv_accum(const bf16_t* sVt, const f32x4 (&pacc)[4], f32x4 (&o)[4], int fr, int fq) {
#pragma unroll
  for (int s = 0; s < 2; ++s) {
    bf16x8 pf; { const unsigned a = pack2(pacc[2 * s][0], pacc[2 * s][1]), b = pack2(pacc[2 * s][2], pacc[2 * s][3]), c = pack2(pacc[2 * s + 1][0], pacc[2 * s + 1][1]), dd = pack2(pacc[2 * s + 1][2], pacc[2 * s + 1][3]);
      const u32x4 u = (u32x4){a, b, c, dd}; pf = __builtin_bit_cast(bf16x8, u); }
#pragma unroll
    for (int dt = 0; dt < 4; ++dt) { const u32x2 lo = *(const u32x2*)(sVt + (dt * 16 + fr) * LDT + 32 * s + 4 * fq), hi = *(const u32x2*)(sVt + (dt * 16 + fr) * LDT + 32 * s + 16 + 4 * fq);
      const u32x4 u = (u32x4){lo[0], lo[1], hi[0], hi[1]}; const bf16x8 vf = __builtin_bit_cast(bf16x8, u); o[dt] = MFMA16(vf, pf, o[dt]); }
  }
}
DI void put_kv(bf16_t* sK, bf16_t* sVt, int key, int part, const float (&kf)[8], const float (&vf)[8]) {
  *(u32x4*)(sK + key * LDT + part * 8) = pack8(kf);
#pragma unroll
  for (int e = 0; e < 8; ++e) sVt[(part * 8 + e) * LDT + key] = f2bf(vf[e]);
}
DI void softmax_tile(f32x4 (&sacc)[4], f32x4 (&o)[4], float& mrun, float& lrun) {
  float mx = sacc[0][0];
#pragma unroll
  for (int nt = 0; nt < 4; ++nt)
#pragma unroll
    for (int j = 0; j < 4; ++j) mx = fmaxf(mx, sacc[nt][j]);
  mx = fmaxf(mx, shfl_x(mx, 16)); mx = fmaxf(mx, shfl_x(mx, 32));
  const float mnew = fmaxf(mrun, mx), alpha = exp2f(mrun - mnew); mrun = mnew;
  float ls = 0.f;
#pragma unroll
  for (int nt = 0; nt < 4; ++nt)
#pragma unroll
    for (int j = 0; j < 4; ++j) { const float pv = exp2f(sacc[nt][j] - mnew); sacc[nt][j] = pv; ls += pv; }
  lrun = lrun * alpha + ls;
#pragma unroll
  for (int dt = 0; dt < 4; ++dt) o[dt] *= alpha;
}
constexpr float LOG2E = 1.4426950408889634f;

__device__ void dense_task(const P& p, int b, int h, int qb, char* smem) {
  bf16_t* sK = (bf16_t*)smem; bf16_t* sVt = sK + 64 * LDT;
  const int tid = tidx(), lane = tid & 63, wave = tid >> 6, fr = lane & 15, fq = lane >> 4;
  const bf16_t* zn = (const bf16_t*)(p.ws + WS_ZN); bf16_t* ona = (bf16_t*)(p.ws + WS_ONA);
  const int qrow = b * 256 + qb * 64 + wave * 16 + fr;
  bf16x8 qf[2];
#pragma unroll
  for (int ks = 0; ks < 2; ++ks) qf[ks] = *(const bf16x8*)(zn + (size_t)qrow * NZN + h * 64 + ks * 32 + fq * 8);
  f32x4 o[4]; for (int dt = 0; dt < 4; ++dt) o[dt] = (f32x4){0.f, 0.f, 0.f, 0.f};
  float mrun = -1e30f, lrun = 0.f;
  u32x4 pk[2], pv[2];
#pragma unroll
  for (int i = 0; i < 2; ++i) { const int c = tid + 256 * i, key = c >> 3, part = c & 7; const size_t ro = (size_t)(b * 256 + key) * NZN + h * 64 + part * 8; pk[i] = *(const u32x4*)(zn + ro + 512); pv[i] = *(const u32x4*)(zn + ro + 1024); }
  for (int kt = 0; kt < 4; ++kt) {
    __syncthreads();
#pragma unroll
    for (int i = 0; i < 2; ++i) { const int c = tid + 256 * i, key = c >> 3, part = c & 7; float vf[8]; unpack8(pv[i], vf);
      *(u32x4*)(sK + key * LDT + part * 8) = pk[i];
#pragma unroll
      for (int e = 0; e < 8; ++e) sVt[(part * 8 + e) * LDT + key] = f2bf(vf[e]); }
    __syncthreads();
    { const int kn = kt < 3 ? kt + 1 : 3;
#pragma unroll
      for (int i = 0; i < 2; ++i) { const int c = tid + 256 * i, key = c >> 3, part = c & 7; const size_t ro = (size_t)(b * 256 + kn * 64 + key) * NZN + h * 64 + part * 8; pk[i] = *(const u32x4*)(zn + ro + 512); pv[i] = *(const u32x4*)(zn + ro + 1024); } }
    f32x4 sacc[4]; qk_scores(sK, qf, sacc, fr, fq);
#pragma unroll
    for (int nt = 0; nt < 4; ++nt) sacc[nt] *= (0.125f * LOG2E);
    softmax_tile(sacc, o, mrun, lrun);
    pv_accum(sVt, sacc, o, fr, fq);
  }
  lrun += shfl_x(lrun, 16); lrun += shfl_x(lrun, 32); const float inv = 1.f / lrun;
#pragma unroll
  for (int dt = 0; dt < 4; ++dt) { u32x2 ov; ov.x = pack2(o[dt][0] * inv, o[dt][1] * inv); ov.y = pack2(o[dt][2] * inv, o[dt][3] * inv); *(u32x2*)(ona + (size_t)qrow * LDO + h * 64 + dt * 16 + fq * 4) = ov; }
}

__device__ void na_task(const P& p, int l, int b, int h, int r, char* smem) {
  bf16_t* sK = (bf16_t*)smem; bf16_t* sVt = sK + 64 * LDT; float* sRpb = (float*)(sVt + 64 * LDT);
  const int tid = tidx(), lane = tid & 63, wave = tid >> 6, fr = lane & 15, fq = lane >> 4;
  const bf16_t* zn = (const bf16_t*)(p.ws + WS_ZN); bf16_t* ona = (bf16_t*)(p.ws + WS_ONA);
  const int base = MC + b * 1024, qcol = wave * 16 + fr, qrow = base + r * 64 + qcol;
  int rs = r - 4; rs = rs < 0 ? 0 : (rs > 8 ? 8 : rs);
  int cs = qcol - 8; cs = cs < 0 ? 0 : (cs > 48 ? 48 : cs);
  __syncthreads();
  for (int e = tid; e < 465; e += NT) sRpb[e] = p.na_rpb[((size_t)l * 8 + h) * 465 + e] * LOG2E;
  bf16x8 qf[2];
#pragma unroll
  for (int ks = 0; ks < 2; ++ks) qf[ks] = *(const bf16x8*)(zn + (size_t)qrow * NZN + h * 64 + ks * 32 + fq * 8);
  f32x4 o[4]; for (int dt = 0; dt < 4; ++dt) o[dt] = (f32x4){0.f, 0.f, 0.f, 0.f};
  float mrun = -1e30f, lrun = 0.f;
  u32x4 pre[8];
#define NA_ISSUE(KT) do { const int kt_ = (KT); \
    if (kt_ < 8) { _Pragma("unroll") for (int i = 0; i < 2; ++i) { const int c = tid + 256 * i, key = c >> 3, part = c & 7; const size_t ro = (size_t)(base + (rs + kt_) * 64 + key) * NZN + h * 64 + part * 8; \
        pre[4 * i] = *(const u32x4*)(zn + ro + 512); pre[4 * i + 1] = *(const u32x4*)(zn + ro + 1024); } } \
    else { _Pragma("unroll") for (int i = 0; i < 2; ++i) { const int c = tid + 256 * i, key = c >> 3, part = c & 7; const size_t co = ((((size_t)b * 2 + l) * 8 + h) * 256 + (kt_ - 8) * 64 + key) * 64 + part * 8; \
        pre[4 * i] = *(const u32x4*)(p.cache_k + co); pre[4 * i + 1] = *(const u32x4*)(p.cache_k + co + 4); pre[4 * i + 2] = *(const u32x4*)(p.cache_v + co); pre[4 * i + 3] = *(const u32x4*)(p.cache_v + co + 4); } } } while (0)
  NA_ISSUE(0);
  for (int kt = 0; kt < 12; ++kt) {
    __syncthreads();
    if (kt < 8) {
#pragma unroll
      for (int i = 0; i < 2; ++i) { const int c = tid + 256 * i, key = c >> 3, part = c & 7; float vf[8]; unpack8(pre[4 * i + 1], vf);
        *(u32x4*)(sK + key * LDT + part * 8) = pre[4 * i];
#pragma unroll
        for (int e = 0; e < 8; ++e) sVt[(part * 8 + e) * LDT + key] = f2bf(vf[e]); }
    } else {
#pragma unroll
      for (int i = 0; i < 2; ++i) { const int c = tid + 256 * i, key = c >> 3, part = c & 7;
        const f32x4 k0 = __builtin_bit_cast(f32x4, pre[4 * i]), k1 = __builtin_bit_cast(f32x4, pre[4 * i + 1]), v0 = __builtin_bit_cast(f32x4, pre[4 * i + 2]), v1 = __builtin_bit_cast(f32x4, pre[4 * i + 3]);
        const float kf[8] = {k0[0], k0[1], k0[2], k0[3], k1[0], k1[1], k1[2], k1[3]}; const float vf[8] = {v0[0], v0[1], v0[2], v0[3], v1[0], v1[1], v1[2], v1[3]};
        put_kv(sK, sVt, key, part, kf, vf); }
    }
    __syncthreads();
    NA_ISSUE(kt < 11 ? kt + 1 : 11);
    f32x4 sacc[4]; qk_scores(sK, qf, sacc, fr, fq);
    if (kt < 8) { const int dr = rs + kt - r + 7;
#pragma unroll
      for (int nt = 0; nt < 4; ++nt)
#pragma unroll
        for (int j = 0; j < 4; ++j) { const int kc = nt * 16 + fq * 4 + j; const bool valid = kc >= cs && kc < cs + 16; int dc = kc - qcol; dc = dc < -15 ? -15 : (dc > 15 ? 15 : dc);
          sacc[nt][j] = valid ? sacc[nt][j] * (0.125f * LOG2E) + sRpb[dr * 31 + dc + 15] : -1e30f; }
    } else {
#pragma unroll
      for (int nt = 0; nt < 4; ++nt) sacc[nt] *= (0.125f * LOG2E);
    }
    softmax_tile(sacc, o, mrun, lrun);
    pv_accum(sVt, sacc, o, fr, fq);
  }
#undef NA_ISSUE
  lrun += shfl_x(lrun, 16); lrun += shfl_x(lrun, 32); const float inv = 1.f / lrun;
#pragma unroll
  for (int dt = 0; dt < 4; ++dt) { u32x2 ov; ov.x = pack2(o[dt][0] * inv, o[dt][1] * inv); ov.y = pack2(o[dt][2] * inv, o[dt][3] * inv); *(u32x2*)(ona + (size_t)qrow * LDO + h * 64 + dt * 16 + fq * 4) = ov; }
}

DI void rope8(const float (&own)[8], const float (&par)[8], int part, int n, float (&out)[8]) {
  const float pos = (float)((part >> 2) ? (n & 63) : (n >> 6));
  const bool isx2 = (part & 3) >= 2;
#pragma unroll
  for (int e = 0; e < 8; ++e) { const int i = (part & 1) * 8 + e; const float ang = pos * exp2f(-(float)i * 0.830482023721841f); const float sn = __sinf(ang), cs = __cosf(ang);
    out[e] = isx2 ? par[e] * sn + own[e] * cs : own[e] * cs - par[e] * sn; }
}

__device__ void ret_task(const P& p, int l, int seq, int h, int qb, char* smem) {
  bf16_t* sK = (bf16_t*)smem; bf16_t* sVt = sK + 64 * LDT; bf16_t* sQ = sVt + 64 * LDT;
  const int tid = tidx(), lane = tid & 63, wave = tid >> 6, fr = lane & 15, fq = lane >> 4;
  const bf16_t* zt = (const bf16_t*)(p.ws + WS_ZT); bf16_t* oret = (bf16_t*)(p.ws + WS_ORET);
  const bool lat = seq >= 32;
  const int row0 = lat ? MC + (seq - 32) * 1024 : seq * 256, T = lat ? 1024 : 256, nkt = T >> 6;
  const float xf = p.ret_decay[(l * 2 + 0) * 8 + h], xb = p.ret_decay[(l * 2 + 1) * 8 + h];
  const float lgf = -log1pf(__expf(-xf)) * LOG2E, lgb = -log1pf(__expf(-xb)) * LOG2E;
  __syncthreads();
#pragma unroll
  for (int i = 0; i < 2; ++i) { const int c = tid + 256 * i, qi = c >> 3, part = c & 7; const int n = qb * 64 + qi; const size_t ro = (size_t)(row0 + n) * LZT + h * 64;
    const u32x4 own = *(const u32x4*)(zt + ro + part * 8);
    if (lat) { const u32x4 par = *(const u32x4*)(zt + ro + (part ^ 2) * 8); float fo[8], fp[8], out[8]; unpack8(own, fo); unpack8(par, fp); rope8(fo, fp, part, n, out); *(u32x4*)(sQ + qi * LDT + part * 8) = pack8(out); }
    else *(u32x4*)(sQ + qi * LDT + part * 8) = own; }
  __syncthreads();
  const int qi = wave * 16 + fr, nq = qb * 64 + qi;
  bf16x8 qf[2];
#pragma unroll
  for (int ks = 0; ks < 2; ++ks) qf[ks] = *(const bf16x8*)(sQ + qi * LDT + ks * 32 + fq * 8);
  f32x4 o[4]; for (int dt = 0; dt < 4; ++dt) o[dt] = (f32x4){0.f, 0.f, 0.f, 0.f};
  u32x4 rk[2], rp[2], rv[2];
#define RET_ISSUE(KT) do { _Pragma("unroll") for (int i = 0; i < 2; ++i) { const int c = tid + 256 * i, key = c >> 3, part = c & 7; const size_t ro = (size_t)(row0 + (KT) * 64 + key) * LZT + h * 64; \
    rk[i] = *(const u32x4*)(zt + ro + 512 + part * 8); rp[i] = *(const u32x4*)(zt + ro + 512 + (part ^ 2) * 8); rv[i] = *(const u32x4*)(zt + ro + 1024 + part * 8); } } while (0)
  RET_ISSUE(0);
  for (int kt = 0; kt < nkt; ++kt) {
    __syncthreads();
#pragma unroll
    for (int i = 0; i < 2; ++i) { const int c = tid + 256 * i, key = c >> 3, part = c & 7; const int n = kt * 64 + key;
      float kf[8], vf[8]; unpack8(rk[i], kf); unpack8(rv[i], vf);
      if (lat) { float fp[8], out[8]; unpack8(rp[i], fp); rope8(kf, fp, part, n, out);
#pragma unroll
        for (int e = 0; e < 8; ++e) kf[e] = out[e]; }
#pragma unroll
      for (int e = 0; e < 8; ++e) kf[e] *= 0.125f;
      put_kv(sK, sVt, key, part, kf, vf); }
    __syncthreads();
    RET_ISSUE(kt + 1 < nkt ? kt + 1 : kt);
    f32x4 sacc[4]; qk_scores(sK, qf, sacc, fr, fq);
#pragma unroll
    for (int nt = 0; nt < 4; ++nt)
#pragma unroll
      for (int j = 0; j < 4; ++j) { const int mk = kt * 64 + nt * 16 + fq * 4 + j; const int df = nq - mk;
        const float dec = df > 0 ? exp2f(lgf * (float)df) : (df < 0 ? exp2f(lgb * (float)(-df)) : 2.f); sacc[nt][j] *= dec; }
    pv_accum(sVt, sacc, o, fr, fq);
  }
#undef RET_ISSUE
  if (lat) {
    for (int dir = 0; dir < 2; ++dir) {
      __syncthreads();
      const float* s0 = p.state_ret + ((((size_t)(seq - 32) * 2 + l) * 2 + dir) * 8 + h) * 4096;
#pragma unroll
      for (int i = 0; i < 2; ++i) { const int c = tid + 256 * i, dk = c >> 3, part = c & 7; const float4 a = *(const float4*)(s0 + dk * 64 + part * 8), bq = *(const float4*)(s0 + dk * 64 + part * 8 + 4);
        const float vf[8] = {a.x, a.y, a.z, a.w, bq.x, bq.y, bq.z, bq.w};
#pragma unroll
        for (int e = 0; e < 8; ++e) sVt[(part * 8 + e) * LDT + dk] = f2bf(vf[e]); }
      __syncthreads();
      const float xi = dir == 0 ? exp2f(lgf * (float)(nq + 1)) : exp2f(lgb * (float)(T - nq));
      f32x4 pacc[4];
#pragma unroll
      for (int s = 0; s < 2; ++s)
#pragma unroll
        for (int hh = 0; hh < 2; ++hh)
#pragma unroll
          for (int j = 0; j < 4; ++j) pacc[2 * s + hh][j] = xi * bf2f(sQ[qi * LDT + 32 * s + 16 * hh + 4 * fq + j]);
      pv_accum(sVt, pacc, o, fr, fq);
    }
  }
  float s1 = 0.f;
#pragma unroll
  for (int dt = 0; dt < 4; ++dt)
#pragma unroll
    for (int j = 0; j < 4; ++j) s1 += o[dt][j];
  s1 += shfl_x(s1, 16); s1 += shfl_x(s1, 32); const float mu = s1 * (1.f / 64.f);
  float s2 = 0.f;
#pragma unroll
  for (int dt = 0; dt < 4; ++dt)
#pragma unroll
    for (int j = 0; j < 4; ++j) { const float dlt = o[dt][j] - mu; s2 += dlt * dlt; }
  s2 += shfl_x(s2, 16); s2 += shfl_x(s2, 32); const float rstd = rsqrtf(s2 * (1.f / 64.f) + 1e-5f);
  const size_t qrow = (size_t)(row0 + nq);
#pragma unroll
  for (int dt = 0; dt < 4; ++dt) { const int dv = h * 64 + dt * 16 + fq * 4; const u32x2 gr = *(const u32x2*)(zt + qrow * LZT + 1536 + dv); const float4 gn = *(const float4*)(p.ret_gn + l * 512 + dv);
    const float g0 = bflo(gr.x), g1 = bfhi(gr.x), g2 = bflo(gr.y), g3 = bfhi(gr.y);
    u32x2 ov; ov.x = pack2((o[dt][0] - mu) * rstd * gn.x * g0 * sigmoidf_(g0), (o[dt][1] - mu) * rstd * gn.y * g1 * sigmoidf_(g1));
    ov.y = pack2((o[dt][2] - mu) * rstd * gn.z * g2 * sigmoidf_(g2), (o[dt][3] - mu) * rstd * gn.w * g3 * sigmoidf_(g3));
    *(u32x2*)(oret + qrow * LDO + dv) = ov; }
}

__device__ void retstate_task(const P& p, int l, int b, int h, char* smem) {
  float* sKf = (float*)smem; float* sKb = sKf + 64 * 64; float* sV = sKb + 64 * 64;
  const int tid = tidx(), dk = tid >> 2, dq = tid & 3;
  const bf16_t* zt = (const bf16_t*)(p.ws + WS_ZT);
  const float xf = p.ret_decay[(l * 2 + 0) * 8 + h], xb = p.ret_decay[(l * 2 + 1) * 8 + h];
  const float lgf = -log1pf(__expf(-xf)) * LOG2E, lgb = -log1pf(__expf(-xb)) * LOG2E;
  float af[16], ab[16];
#pragma unroll
  for (int i = 0; i < 16; ++i) { af[i] = 0.f; ab[i] = 0.f; }
  for (int kt = 0; kt < 4; ++kt) {
    __syncthreads();
#pragma unroll
    for (int i = 0; i < 2; ++i) { const int c = tid + 256 * i, key = c >> 3, part = c & 7, m = kt * 64 + key; const size_t ro = (size_t)(b * 256 + m) * LZT + h * 64 + part * 8;
      float kf[8], vf[8]; unpack8(*(const u32x4*)(zt + ro + 512), kf); unpack8(*(const u32x4*)(zt + ro + 1024), vf);
      const float wf = 0.125f * exp2f(lgf * (float)(255 - m)), wb = 0.125f * exp2f(lgb * (float)m);
#pragma unroll
      for (int e = 0; e < 8; ++e) { sKf[key * 64 + part * 8 + e] = kf[e] * wf; sKb[key * 64 + part * 8 + e] = kf[e] * wb; sV[key * 64 + part * 8 + e] = vf[e]; } }
    __syncthreads();
    for (int m = 0; m < 64; ++m) { const float kf = sKf[m * 64 + dk], kb = sKb[m * 64 + dk];
#pragma unroll
      for (int i = 0; i < 4; ++i) { const f32x4 vv = *(const f32x4*)(sV + m * 64 + dq * 16 + i * 4);
#pragma unroll
        for (int j = 0; j < 4; ++j) { af[i * 4 + j] += kf * vv[j]; ab[i * 4 + j] += kb * vv[j]; } } }
  }
  float* of = p.out + O_RT + ((((size_t)b * 2 + l) * 2 + 0) * 8 + h) * 4096 + dk * 64 + dq * 16; float* ob = of + 8 * 4096;
#pragma unroll
  for (int i = 0; i < 16; ++i) { of[i] = af[i]; ob[i] = ab[i]; }
}

constexpr int Q_SCAN_L = 64, Q_SCAN_C = 512, Q_RET_L = 256, Q_NA = 256, Q_DENSE = 512, Q_RET_C = 512, Q_RST = 128;
template <int QMASK> __device__ void phase_mixers(const P& p, int l, char* smem_, int rep = 0) {
  __shared__ int s_task;
  int* ctr = (int*)(p.ws + WS_CTRL) + 64 * (l + 1) + 4 * rep;
  const int vb = vhalf(); char* smem = smem_ + vb * VSMEM;
  if (QMASK & 1) for (;;) {
    __syncthreads();
    if (ptid() == 0) s_task = atomicAdd(ctr, 1);
    __syncthreads();
    const int tk = s_task;
    if (tk >= Q_SCAN_L + Q_SCAN_C) break;
    const bool lat = tk < Q_SCAN_L; const int t2 = lat ? tk : tk - Q_SCAN_L;
    scan_task(p, l, (lat ? 32 : 0) + (t2 >> 4), (t2 >> 1) & 7, t2 & 1, vb, smem);
  }
  if (QMASK & 2) for (;;) {
    __syncthreads();
    if (ptid() == 0) s_task = atomicAdd(ctr + 16, 1);
    __syncthreads();
    const int tk = s_task;
    if (tk >= Q_RET_L + Q_RET_C) break;
    if (tk < Q_RET_L) ret_task(p, l, 32 + (tk >> 6), (tk >> 3) & 7, (tk & 7) * 2 + vb, smem);
    else { const int t2 = tk - Q_RET_L; ret_task(p, l, t2 >> 4, (t2 >> 1) & 7, (t2 & 1) * 2 + vb, smem); }
  }
  if (QMASK & 4) for (;;) {
    __syncthreads();
    if (ptid() == 0) s_task = atomicAdd(ctr + 32, 1);
    __syncthreads();
    int tk = s_task;
    if (tk >= Q_NA + Q_DENSE + Q_RST) break;
    if (tk < Q_NA) { na_task(p, l, tk >> 6, (tk >> 3) & 7, (tk & 7) * 2 + vb, smem); continue; } tk -= Q_NA;
    if (tk < Q_DENSE) { dense_task(p, tk >> 4, (tk >> 1) & 7, (tk & 1) * 2 + vb, smem); continue; } tk -= Q_DENSE;
    retstate_task(p, l, tk >> 2, (tk & 3) * 2 + vb, smem);
  }
}

__device__ void phase_rwkv_post(const P& p, int l, char* smem) {
  const bf16_t* zr = (const bf16_t*)(p.ws + WS_ZR); const float* yf = (const float*)(p.ws + WS_Y); const float* yb = yf + (size_t)MT * 512; bf16_t* oa = (bf16_t*)(p.ws + WS_OA);
  const bf16_t* Gt = (const bf16_t*)(p.ws + WS_WG);
  const int tid = ptid(), lane = tid & 63, wave = tid >> 6, wr = wave >> 2, wc = wave & 3, fr = lane & 15, fq = lane >> 4;
  TileIter ti; int mt, nt; ti.init(96, 2);
  while (ti.next(mt, nt)) {
    const int row0 = mt * 128, n0 = nt * 256;
    f32x4 acc[4][4]; zero_acc<4, 4>(acc);
    TileSrc s{zr + 1664, NZR, row0, Gt, LDG, n0, n0 + 128, 128}; gemm_tile<4, 4>(acc, s, smem);
    const int cb = n0 + wc * 64 + fq * 4;
#pragma unroll
    for (int m = 0; m < 4; ++m) { const size_t row = (size_t)(row0 + wr * 64 + m * 16 + fr);
      f32x4 y[4]; float s1 = 0.f, rk = 0.f; f32x4 vv[4];
#pragma unroll
      for (int n = 0; n < 4; ++n) { const int c = cb + n * 16; y[n] = *(const f32x4*)(yf + row * 512 + c) + *(const f32x4*)(yb + row * 512 + c); s1 += y[n][0] + y[n][1] + y[n][2] + y[n][3];
        const u32x2 rr = *(const u32x2*)(zr + row * NZR + c), kk = *(const u32x2*)(zr + row * NZR + 512 + c), v2 = *(const u32x2*)(zr + row * NZR + 1024 + c); const f32x4 rkw = *(const f32x4*)(p.rwkv_r_k + l * 512 + c);
        rk += bflo(rr.x) * bflo(kk.x) * rkw[0] + bfhi(rr.x) * bfhi(kk.x) * rkw[1] + bflo(rr.y) * bflo(kk.y) * rkw[2] + bfhi(rr.y) * bfhi(kk.y) * rkw[3];
        vv[n] = (f32x4){bflo(v2.x), bfhi(v2.x), bflo(v2.y), bfhi(v2.y)}; }
      s1 += shfl_x(s1, 16); s1 += shfl_x(s1, 32); rk += shfl_x(rk, 16); rk += shfl_x(rk, 32);
      const float mu = s1 * (1.f / 64.f); float s2 = 0.f;
#pragma unroll
      for (int n = 0; n < 4; ++n)
#pragma unroll
        for (int j = 0; j < 4; ++j) { const float dl = y[n][j] - mu; s2 += dl * dl; }
      s2 += shfl_x(s2, 16); s2 += shfl_x(s2, 32); const float rstd = rsqrtf(s2 * (1.f / 64.f) + 64e-5f);
#pragma unroll
      for (int n = 0; n < 4; ++n) { const int c = cb + n * 16; const f32x4 lg = *(const f32x4*)(p.rwkv_ln_g + l * 512 + c), lb = *(const f32x4*)(p.rwkv_ln_b + l * 512 + c);
        float o[4];
#pragma unroll
        for (int j = 0; j < 4; ++j) o[j] = ((y[n][j] - mu) * rstd * lg[j] + lb[j] + rk * vv[n][j]) * acc[m][n][j];
        u32x2 ov; ov.x = pack2(o[0], o[1]); ov.y = pack2(o[2], o[3]); *(u32x2*)(oa + row * LDO + c) = ov; }
    }
  }
}

DI void convert_layer_a(const P& p, int l, char* smem) {
  convert_T(p.w_in + (size_t)l * D * INC, D, INC, (bf16_t*)(p.ws + WS_WIN), LDH, smem);
  convert_T(p.w_o_rwkv + (size_t)l * 512 * D, 512, D, (bf16_t*)(p.ws + WS_WO3), LDO, smem);
  convert_T(p.w_o_na + (size_t)l * 512 * D, 512, D, (bf16_t*)(p.ws + WS_WO3) + (size_t)1024 * LDO, LDO, smem);
  convert_T(p.w_o_ret + (size_t)l * 512 * D, 512, D, (bf16_t*)(p.ws + WS_WO3) + (size_t)2 * 1024 * LDO, LDO, smem);
  convert_T(p.w_out + (size_t)l * D * D, D, D, (bf16_t*)(p.ws + WS_WOUT), LDH, smem);
  convert_T(p.rwkv_g_up + (size_t)l * 128 * 512, 128, 512, (bf16_t*)(p.ws + WS_WG), LDG, smem);
}
DI void convert_layer_b(const P& p, int l, char* smem) {
  convert_T(p.ffn_up + (size_t)l * D * 2 * FF, D, 2 * FF, (bf16_t*)(p.ws + WS_WUP), LDH, smem);
  convert_T(p.ffn_down + (size_t)l * FF * D, FF, D, (bf16_t*)(p.ws + WS_WDN), FF, smem);
}

typedef __attribute__((address_space(4))) const P* KP;
DI KP kargs() { KP k = (KP)__builtin_amdgcn_kernarg_segment_ptr(); asm volatile("" : "+s"(k)); return k; }
template <int PH> DI void run_phase(int l, char* smem) {
#if defined(__HIP_DEVICE_COMPILE__)
  const P p = *kargs();
#else
  const P p{};
#endif
  const float* mod = (const float*)(p.ws + WS_MOD);
  float* xbuf = p.out;
  if (PH == 0) { ada_phase(p, smem); convert_layer_a(p, 0, smem); }
  else if (PH == 1) { norm_phase(p, nullptr, nullptr, nullptr, nullptr, 0, nullptr, p.norm_mix_pre, mod, 0, (bf16_t*)(p.ws + WS_H)); }
  else if (PH == 2) phase_win(p, l, smem);
  else if (PH == 4) phase_mixers<7>(p, l, smem);
  else if (PH == 5) phase_rwkv_post(p, l, smem);
  else if (PH == 6) phase_merge(p, smem);
  else if (PH == 7) { phase_gemm_f32((const bf16_t*)(p.ws + WS_MERGED), LDH, D, (const bf16_t*)(p.ws + WS_WOUT), LDH, (float*)(p.ws + WS_U), smem); }
  else if (PH == 8) { convert_layer_b(p, l, smem);
    norm_phase(p, l == 0 ? nullptr : xbuf, (const float*)(p.ws + WS_U), p.norm_mix_post + l * D, mod + (size_t)l * 5 * 6144, 2, xbuf, p.norm_ffn_pre + l * D, mod + (size_t)l * 5 * 6144, 3, (bf16_t*)(p.ws + WS_H)); }
  else if (PH == 9) phase_ffn_up(p, l, smem);
  else if (PH == 11) { phase_gemm_f32((const bf16_t*)(p.ws + WS_HID), FF, FF, (const bf16_t*)(p.ws + WS_WDN), FF, (float*)(p.ws + WS_F), smem); }
  else if (PH == 12) {
    if (l == 0) { norm_phase(p, xbuf, (const float*)(p.ws + WS_F), p.norm_ffn_post, mod, 5, xbuf, p.norm_mix_pre + D, mod + (size_t)5 * 6144, 0, (bf16_t*)(p.ws + WS_H)); convert_layer_a(p, 1, smem); }
    else norm_phase(p, xbuf, (const float*)(p.ws + WS_F), p.norm_ffn_post + D, mod + (size_t)5 * 6144, 5, xbuf, nullptr, nullptr, 0, nullptr);
  }
}

#if MEGA
__global__ void __launch_bounds__(NTP, 1) mega_kernel(P p_) {
  extern __shared__ __attribute__((aligned(16))) char smem[];
  __shared__ u32x4 xb_words;
  cg::grid_group grid = cg::this_grid();
  if (ptid() == 0) xb_words = (u32x4){0u, 0u, 0u, 0u};
  __syncthreads();
#if defined(__HIP_DEVICE_COMPILE__)
  (void)xcd_barrier_post((unsigned*)(p_.ws + WS_BAR), (volatile LAS unsigned*)&xb_words);
#define GSYNC() do { XcdBarrier xb_; xb_.bar = (unsigned*)(kargs()->ws + WS_BAR); xb_.x = xb_xcc_id(); xb_.st = (volatile LAS unsigned*)&xb_words; xcd_barrier(xb_); } while (0)
#else
#define GSYNC() do { } while (0)
#endif
  run_phase<0>(0, smem); grid.sync();
  run_phase<1>(0, smem); GSYNC();
#pragma unroll
  for (int l = 0; l < 2; ++l) {
    run_phase<2>(l, smem); GSYNC();
    if (PROBE_MASK & 1) { run_phase<2>(l, smem); GSYNC(); }
    run_phase<4>(l, smem); GSYNC();
    run_phase<5>(l, smem); GSYNC();
    run_phase<6>(l, smem); GSYNC();
    if (PROBE_MASK & 8) { run_phase<6>(l, smem); GSYNC(); }
    run_phase<7>(l, smem); GSYNC();
    if (PROBE_MASK & 16) { run_phase<7>(l, smem); GSYNC(); }
    run_phase<8>(l, smem); GSYNC();
    run_phase<9>(l, smem); GSYNC();
    if (PROBE_MASK & 32) { run_phase<9>(l, smem); GSYNC(); }
    run_phase<11>(l, smem); GSYNC();
    if (PROBE_MASK & 64) { run_phase<11>(l, smem); GSYNC(); }
    run_phase<12>(l, smem); if (l == 0) GSYNC();
  }
#undef GSYNC
}
#else
template <int PH> __global__ void __launch_bounds__(NTP, 1) phase_kernel(P p, int l) {
  extern __shared__ __attribute__((aligned(16))) char smem[];
  run_phase<PH>(l, smem);
}
#endif

extern "C" void kernel_launch(void* const* d_in, const int* in_sizes, int n_in, void* d_out, int out_size, void* d_ws, size_t ws_size, hipStream_t stream) {
  if (ws_size < WS_END || n_in < 36) { fprintf(stderr, "workspace too small: %zu < %zu\n", ws_size, (size_t)WS_END); return; }
  P p{};
  const float** pp = (const float**)&p;
  for (int i = 0; i < 36; ++i) pp[i] = (const float*)d_in[i];
  p.out = (float*)d_out; p.ws = (char*)d_ws;
  hipMemsetAsync(d_ws, 0, WS_WIN, stream);
#if MEGA
  static int grid_blocks = 0;
  if (!grid_blocks) {
    int dev = 0, cus = 0, per_cu = 0; hipGetDevice(&dev);
    hipDeviceGetAttribute(&cus, hipDeviceAttributeMultiprocessorCount, dev);
    hipFuncSetAttribute((const void*)mega_kernel, hipFuncAttributeMaxDynamicSharedMemorySize, SMEM_BYTES);
    hipOccupancyMaxActiveBlocksPerMultiprocessor(&per_cu, mega_kernel, NTP, SMEM_BYTES);
    if (per_cu > 1) per_cu = 1;
    grid_blocks = cus * per_cu;
  }
  void* args[] = {&p};
  hipError_t e = hipLaunchCooperativeKernel((void*)mega_kernel, dim3(grid_blocks), dim3(NTP), args, SMEM_BYTES, stream);
  if (e != hipSuccess) fprintf(stderr, "cooperative launch failed: %s (grid %d)\n", hipGetErrorString(e), grid_blocks);
#else
  const int G = 512;
#define LAUNCH(PH, L) do { hipFuncSetAttribute((const void*)phase_kernel<PH>, hipFuncAttributeMaxDynamicSharedMemorySize, SMEM_BYTES); phase_kernel<PH><<<G, NT, SMEM_BYTES, stream>>>(p, L); } while (0)
  LAUNCH(0, 0); LAUNCH(1, 0);
  for (int l = 0; l < 2; ++l) { LAUNCH(2, l); LAUNCH(4, l); LAUNCH(5, l); LAUNCH(6, l); LAUNCH(7, l); LAUNCH(8, l); LAUNCH(9, l); LAUNCH(11, l); LAUNCH(12, l); }
#endif
}
```

```cpp
#include <hip/hip_runtime.h>
#include <hip/hip_cooperative_groups.h>
#include <cstdio>
namespace cg = cooperative_groups;

#ifndef MEGA
#define MEGA 1
#endif
#define PROBE_MASK 0

typedef unsigned short bf16_t;
typedef short bf16x8 __attribute__((ext_vector_type(8)));
typedef short bf16x4 __attribute__((ext_vector_type(4)));
typedef float f32x4 __attribute__((ext_vector_type(4)));
typedef float f32x2 __attribute__((ext_vector_type(2)));
typedef unsigned u32x4 __attribute__((ext_vector_type(4)));
typedef unsigned u32x2 __attribute__((ext_vector_type(2)));
#define DI __device__ __forceinline__
#define MFMA16(a, b, c) __builtin_amdgcn_mfma_f32_16x16x32_bf16((a), (b), (c), 0, 0, 0)

constexpr int NT = 256;
constexpr int NTP = 512;
constexpr int VSMEM = 65536;
constexpr int D = 1024, MC = 8192, ML = 4096, MT = 12288;
constexpr int NZR = 1792, NZN = 1536, NZT = 2048, INC = 8448, FF = 2816;
constexpr int LDH = 1088, LDO = 576, LZT = 2112, LDG = 136;
constexpr int LDT = 72;
constexpr int SMEM_BYTES = 131072;
constexpr size_t O_K = 12582912, O_V = 20971520, O_RW = 29360128, O_RT = 33554432;
constexpr size_t WS_CTRL = 0;
constexpr size_t WS_MOD = 4096;
constexpr size_t WS_BAR = 262144;
constexpr size_t WS_CUF = 278528;
constexpr size_t WS_WG = 294912;
constexpr size_t WS_WIN = 434176;
constexpr size_t WS_WUP = WS_WIN;
constexpr size_t WS_WDN = WS_WIN + (size_t)5632 * LDH * 2;
constexpr size_t WS_WO3 = WS_WIN + (size_t)INC * LDH * 2;
constexpr size_t WS_WOUT = WS_WO3 + (size_t)3 * 1024 * LDO * 2;
constexpr size_t WS_H = WS_WOUT + (size_t)1024 * LDH * 2;
constexpr size_t WS_Z = WS_H + (size_t)MT * LDH * 2;
constexpr size_t WS_ZR = WS_Z;
constexpr size_t WS_ZN = WS_ZR + (size_t)MT * NZR * 2;
constexpr size_t WS_ZT = WS_ZN + (size_t)MT * NZN * 2;
constexpr size_t WS_MERGED = WS_ZR;
constexpr size_t WS_OA = WS_ZN;
constexpr size_t WS_U = WS_ZT;
constexpr size_t WS_HID = WS_Z;
constexpr size_t WS_F = WS_ZT;
constexpr size_t WS_Y = WS_ZT + (size_t)MT * LZT * 2;
constexpr size_t WS_ONA = WS_Y + (size_t)2 * MT * 512 * 4;
constexpr size_t WS_ORET = WS_ONA + (size_t)MT * LDO * 2;
constexpr size_t WS_END = WS_ORET + (size_t)MT * LDO * 2;

struct P {
  const float *x_prompt, *x_sample, *cache_k, *cache_v, *state_rwkv, *state_ret, *c, *c_ctx, *ada_w, *ada_b;
  const float *norm_mix_pre, *norm_mix_post, *norm_ffn_pre, *norm_ffn_post, *w_in, *rwkv_conv, *rwkv_w0, *rwkv_w_up, *rwkv_a0, *rwkv_a_up, *rwkv_g_up;
  const float *rwkv_k_k, *rwkv_k_a, *rwkv_r_k, *rwkv_ln_g, *rwkv_ln_b, *na_rpb, *ret_decay, *ret_gn, *w_o_rwkv, *w_o_na, *w_o_ret, *w_out, *ffn_up, *ffn_conv, *ffn_down;
  float* out; char* ws;
};

DI int threadIdx_x_raw() { return (int)__builtin_amdgcn_workitem_id_x(); }
DI int ptid() { int t = threadIdx_x_raw(); asm volatile("" : "+v"(t)); return t; }
DI int tidx() { return ptid() & 255; }
DI int vhalf() { return ptid() >> 8; }
DI int vblk() { return (int)blockIdx.x * 2 + vhalf(); }
DI int vgrid() { return (int)gridDim.x * 2; }
DI bf16_t f2bf(float x) { unsigned u = __float_as_uint(x); u += 0x7fffu + ((u >> 16) & 1u); return (bf16_t)(u >> 16); }
DI float bf2f(bf16_t b) { return __uint_as_float(((unsigned)b) << 16); }
DI unsigned pack2(float a, float b) { return (unsigned)f2bf(a) | ((unsigned)f2bf(b) << 16); }
DI float bflo(unsigned u) { return __uint_as_float(u << 16); }
DI float bfhi(unsigned u) { return __uint_as_float(u & 0xffff0000u); }
DI void unpack8(const u32x4 r, float (&f)[8]) { f[0] = bflo(r[0]); f[1] = bfhi(r[0]); f[2] = bflo(r[1]); f[3] = bfhi(r[1]); f[4] = bflo(r[2]); f[5] = bfhi(r[2]); f[6] = bflo(r[3]); f[7] = bfhi(r[3]); }
DI u32x4 pack8(const float (&f)[8]) { u32x4 r; r[0] = pack2(f[0], f[1]); r[1] = pack2(f[2], f[3]); r[2] = pack2(f[4], f[5]); r[3] = pack2(f[6], f[7]); return r; }
DI float sigmoidf_(float x) { return 1.f / (1.f + __expf(-x)); }
DI float shfl_x(float v, int m) { const int lane = ptid() & 63; return __int_as_float(__builtin_amdgcn_ds_bpermute((lane ^ m) << 2, __float_as_int(v))); }
DI float wave_sum(float v) { for (int o = 32; o > 0; o >>= 1) v += shfl_x(v, o); return v; }
DI void tokinfo(int m, int& t, int& T, int& mi) { if (m < MC) { t = m & 255; T = 256; mi = 0; } else { int q = m - MC; t = q & 1023; T = 1024; mi = 1 + (q >> 10); } }

#define XB_TMO      128
#define XB_XCNT(j)  (256  + 64 * (j))
#define XB_XSUB(j)  (1280 + 64 * (j))
#define XB_XGEN(j)  (2304 + 64 * (j))
#define XB_TOP      3328
#define XB_TOPGEN   3392
#define XB_SPIN_CAP (1u << 20)
#define LAS __attribute__((address_space(3)))
DI unsigned xb_ld(unsigned* p) { return __hip_atomic_load(p, __ATOMIC_RELAXED, __HIP_MEMORY_SCOPE_AGENT); }
DI unsigned xb_add(unsigned* p, unsigned v) { return __hip_atomic_fetch_add(p, v, __ATOMIC_RELAXED, __HIP_MEMORY_SCOPE_AGENT); }
DI unsigned xb_xcc_id() { return (unsigned)__builtin_amdgcn_s_getreg((3 << 11) | 20) & 0xFu; }
#define XB_SPIN(cond, bar) do { unsigned _sp = 0; while (cond) { __builtin_amdgcn_s_sleep(1); \
    if ((++_sp & 255u) == 0u) { if (xb_ld(&(bar)[XB_TMO])) break; if (_sp > XB_SPIN_CAP) { atomicAdd(&(bar)[XB_TMO], 1u); break; } } } } while (0)
struct XcdBarrier { unsigned* bar; unsigned x; volatile LAS unsigned* st; };
DI XcdBarrier xcd_barrier_post(unsigned* bar, volatile LAS unsigned* st) {
  XcdBarrier b; b.bar = bar; b.x = xb_xcc_id(); b.st = st;
  if (ptid() == 0) (void)xb_add(&bar[XB_XCNT(b.x)], 1u);
  return b;
}
DI void xcd_barrier_complete(unsigned* bar, unsigned x, unsigned& nloc, unsigned& nx) {
  const unsigned G = gridDim.x * gridDim.y * gridDim.z;
  unsigned sum, cnt, mine, sp = 0u;
  for (;;) {
    sum = 0u; cnt = 0u; mine = 0u;
#pragma unroll
    for (unsigned j = 0; j < 16; ++j) { const unsigned c = xb_ld(&bar[XB_XCNT(j)]); sum += c; cnt += (c > 0u) ? 1u : 0u; mine = (j == x) ? c : mine; }
    if (sum == G) break;
    __builtin_amdgcn_s_sleep(1);
    if ((++sp & 255u) == 0u) { if (xb_ld(&bar[XB_TMO])) break; if (sp > XB_SPIN_CAP) { atomicAdd(&bar[XB_TMO], 1u); break; } }
  }
  nloc = mine > 0u ? mine : 1u; nx = cnt > 0u ? cnt : 1u;
}
DI void xcd_barrier(const XcdBarrier& b) {
  asm volatile("s_waitcnt vmcnt(0)" ::: "memory");
  __syncthreads();
  if (ptid() == 0) {
    unsigned* bar = b.bar;
    __builtin_amdgcn_s_waitcnt(0);
    unsigned nloc = b.st[0], nx = b.st[1];
    if (nloc == 0u) { xcd_barrier_complete(bar, b.x, nloc, nx); b.st[0] = nloc; b.st[1] = nx; }
    const unsigned old = xb_add(&bar[XB_XSUB(b.x)], 1u);
    const unsigned gen = old / nloc;
    if (old + 1u == (gen + 1u) * nloc) {
      __builtin_amdgcn_fence(__ATOMIC_RELEASE, "agent");
      asm volatile("s_waitcnt vmcnt(0)" ::: "memory");
      const unsigned og = xb_add(&bar[XB_TOP], 1u);
      const unsigned tg = og / nx;
      if (og + 1u == (tg + 1u) * nx) xb_add(&bar[XB_TOPGEN], 1u);
      else XB_SPIN(xb_ld(&bar[XB_TOPGEN]) == tg, bar);
      __builtin_amdgcn_fence(__ATOMIC_ACQUIRE, "agent");
      xb_add(&bar[XB_XGEN(b.x)], 1u);
      asm volatile("s_waitcnt vmcnt(0)" ::: "memory");
    } else {
      XB_SPIN(xb_ld(&bar[XB_XGEN(b.x)]) == gen, bar);
      __builtin_amdgcn_fence(__ATOMIC_ACQUIRE, "agent");
      asm volatile("s_waitcnt vmcnt(0)" ::: "memory");
    }
  }
  __syncthreads();
}

__device__ void convert_T(const float* __restrict__ W, int K, int N, bf16_t* __restrict__ Wt, int ldt, char* smem) {
  float* t = (float*)(smem + vhalf() * VSMEM);
  const int tid = tidx(), ntn = N >> 6, nitems = (K >> 6) * ntn;
  for (int it = vblk(); it < nitems; it += vgrid()) {
    const int k0 = (it / ntn) << 6, n0 = (it % ntn) << 6;
    __syncthreads();
#pragma unroll
    for (int i = 0; i < 4; ++i) { const int k = (tid >> 4) + 16 * i, c4 = (tid & 15) * 4;
      const float4 v = *(const float4*)(W + (size_t)(k0 + k) * N + n0 + c4);
      t[k * 65 + c4] = v.x; t[k * 65 + c4 + 1] = v.y; t[k * 65 + c4 + 2] = v.z; t[k * 65 + c4 + 3] = v.w; }
    __syncthreads();
#pragma unroll
    for (int i = 0; i < 2; ++i) { const int c = tid + 256 * i, n = c >> 3, kc = c & 7; float f[8];
#pragma unroll
      for (int e = 0; e < 8; ++e) f[e] = t[(kc * 8 + e) * 65 + n];
      *(u32x4*)(Wt + (size_t)(n0 + n) * ldt + k0 + kc * 8) = pack8(f); }
  }
}

__device__ void ada_phase(const P& p, char* smem) {
  float* sc = (float*)(smem + vhalf() * VSMEM);
  float* red = sc + 640;
  float* mod = (float*)(p.ws + WS_MOD);
  const int tid = tidx(), kq = tid >> 5, cq = tid & 31;
  for (int it = vblk(); it < 2 * 48 * 8; it += vgrid()) {
    const int l = it / 384, rem = it % 384, nb = rem >> 3, ks = rem & 7;
    const int n0 = nb * 128, k0 = ks * 128;
    __syncthreads();
    for (int e = tid; e < 640; e += NT) { const int i = e >> 7, k = e & 127; const float v = (i == 0) ? p.c_ctx[k0 + k] : p.c[(i - 1) * D + k0 + k]; sc[e] = v * sigmoidf_(v); }
    __syncthreads();
    float acc[5][4];
#pragma unroll
    for (int i = 0; i < 5; ++i)
#pragma unroll
      for (int j = 0; j < 4; ++j) acc[i][j] = 0.f;
    const float* wp = p.ada_w + ((size_t)l * D + k0 + kq * 16) * 6144 + n0 + cq * 4;
#pragma unroll 4
    for (int kk = 0; kk < 16; ++kk) { const float4 w = *(const float4*)(wp + (size_t)kk * 6144);
#pragma unroll
      for (int i = 0; i < 5; ++i) { const float s = sc[i * 128 + kq * 16 + kk]; acc[i][0] += s * w.x; acc[i][1] += s * w.y; acc[i][2] += s * w.z; acc[i][3] += s * w.w; } }
#pragma unroll
    for (int i = 0; i < 5; ++i)
#pragma unroll
      for (int j = 0; j < 4; ++j) red[(kq * 5 + i) * 128 + cq * 4 + j] = acc[i][j];
    __syncthreads();
    for (int e = tid; e < 640; e += NT) { const int i = e >> 7, n = e & 127; float s = 0.f;
#pragma unroll
      for (int q = 0; q < 8; ++q) s += red[(q * 5 + i) * 128 + n];
      if (ks == 0) s += p.ada_b[l * 6144 + n0 + n];
      atomicAdd(mod + ((size_t)l * 5 + i) * 6144 + n0 + n, s); }
  }
}

__device__ void norm_phase(const P& p, const float* xin  , const float* u, const float* gpost, const float* modU, int gate_idx,
                           float* xout, const float* gpre, const float* modN, int shift_idx, bf16_t* hout) {
  const int lane = tidx() & 63, wave = tidx() >> 6, nw = NT / 64;
  for (int m = vblk() * nw + wave; m < MT; m += vgrid() * nw) {
    int t, T, mi; tokinfo(m, t, T, mi);
    const float* xr = xin ? xin + (size_t)m * D : (m < MC ? p.x_prompt + (size_t)m * D : p.x_sample + (size_t)(m - MC) * D);
    float4 x[4];
#pragma unroll
    for (int i = 0; i < 4; ++i) x[i] = *(const float4*)(xr + i * 256 + lane * 4);
    if (u) {
      float4 uu[4]; float ss = 0.f;
#pragma unroll
      for (int i = 0; i < 4; ++i) { uu[i] = *(const float4*)(u + (size_t)m * D + i * 256 + lane * 4); ss += uu[i].x * uu[i].x + uu[i].y * uu[i].y + uu[i].z * uu[i].z + uu[i].w * uu[i].w; }
      ss = wave_sum(ss); const float rs = rsqrtf(ss * (1.f / D) + 1e-6f);
#pragma unroll
      for (int i = 0; i < 4; ++i) { const int c = i * 256 + lane * 4; const float4 g = *(const float4*)(gpost + c); const float4 ga = *(const float4*)(modU + ((size_t)mi * 6 + gate_idx) * D + c);
        x[i].x += ga.x * uu[i].x * rs * g.x; x[i].y += ga.y * uu[i].y * rs * g.y; x[i].z += ga.z * uu[i].z * rs * g.z; x[i].w += ga.w * uu[i].w * rs * g.w; }
    }
    if (xout) {
#pragma unroll
      for (int i = 0; i < 4; ++i) *(float4*)(xout + (size_t)m * D + i * 256 + lane * 4) = x[i];
    }
    if (hout) {
      float ss = 0.f;
#pragma unroll
      for (int i = 0; i < 4; ++i) ss += x[i].x * x[i].x + x[i].y * x[i].y + x[i].z * x[i].z + x[i].w * x[i].w;
      ss = wave_sum(ss); const float rs = rsqrtf(ss * (1.f / D) + 1e-6f);
#pragma unroll
      for (int i = 0; i < 4; ++i) { const int c = i * 256 + lane * 4; const float4 g = *(const float4*)(gpre + c);
        const float4 sh = *(const float4*)(modN + ((size_t)mi * 6 + shift_idx) * D + c); const float4 sc = *(const float4*)(modN + ((size_t)mi * 6 + shift_idx + 1) * D + c);
        u32x2 o; o.x = pack2(x[i].x * rs * g.x * (1.f + sc.x) + sh.x, x[i].y * rs * g.y * (1.f + sc.y) + sh.y); o.y = pack2(x[i].z * rs * g.z * (1.f + sc.z) + sh.z, x[i].w * rs * g.w * (1.f + sc.w) + sh.w);
        *(u32x2*)(hout + (size_t)m * LDH + c) = o; }
    }
  }
}

struct TileSrc { const bf16_t* A; int lda; int arow0; const bf16_t* B; int ldb; int brow0, brow1; int K; };

template <int MM, int NN> DI void zero_acc(f32x4 (&acc)[MM][NN]) {
#pragma unroll
  for (int m = 0; m < MM; ++m)
#pragma unroll
    for (int n = 0; n < NN; ++n) acc[m][n] = (f32x4){0.f, 0.f, 0.f, 0.f};
}

template <int MM, int NN> struct Gemm {
  static constexpr int NA = MM / 2, NB = NN;
  unsigned oa_[NA], ob_[NB]; const bf16_t* A; const bf16_t* B; int nk; u32x4 ra[NA], rb[NB];
#define GT_LOAD(KT) do { const int kn_ = ((KT) < nk ? (KT) : nk - 1) * 64; \
    _Pragma("unroll") for (int i = 0; i < NA; ++i) ra[i] = *(const u32x4*)(A + (oa_[i] + kn_)); \
    _Pragma("unroll") for (int i = 0; i < NB; ++i) rb[i] = *(const u32x4*)(B + (ob_[i] + kn_)); } while (0)
  DI void begin(const TileSrc& s) {
    const int tid = ptid();
#pragma unroll
    for (int i = 0; i < NA; ++i) { const int row = (tid >> 3) + 64 * i, kc = tid & 7;
      int ar = s.arow0 + row; ar = ar < 0 ? 0 : (ar > MT - 1 ? MT - 1 : ar);
      oa_[i] = (unsigned)ar * (unsigned)s.lda + kc * 8; }
#pragma unroll
    for (int i = 0; i < NB; ++i) { const int row = (tid >> 3) + 64 * i, kc = tid & 7;
      const int br = row < 32 * NN ? s.brow0 + row : s.brow1 + row - 32 * NN;
      ob_[i] = (unsigned)br * (unsigned)s.ldb + kc * 8; }
    A = s.A; B = s.B; nk = s.K >> 6;
    GT_LOAD(0);
  }
  DI void run(f32x4 (&acc)[MM][NN], char* smem) {
    bf16_t* sbase = (bf16_t*)smem;
    const int tid = ptid(), lane = tid & 63, wave = tid >> 6, wr = wave >> 2, wc = wave & 3, fr = lane & 15, fq = lane >> 4;
    int wofs; { const int r = tid >> 3, kc = tid & 7, ob = (r & 15) * 64 + (kc & 3) * 16; wofs = (((r >> 4) * 2 + (kc >> 2)) * 1024 + (ob ^ (((ob >> 9) & 1) << 5))) >> 1; }
    int robase; { const int ob = fr * 64 + fq * 16; robase = (ob ^ (((ob >> 9) & 1) << 5)) >> 1; }
#define GT_STORE(ST) do { bf16_t* sA_ = sbase + (ST) * 32768; bf16_t* sB_ = sA_ + 16384; \
    _Pragma("unroll") for (int i = 0; i < NA; ++i) *(u32x4*)(sA_ + wofs + i * 4096) = ra[i]; \
    _Pragma("unroll") for (int i = 0; i < NB; ++i) *(u32x4*)(sB_ + wofs + i * 4096) = rb[i]; } while (0)
#define GT_COMPUTE(ST) do { const bf16_t* sA_ = sbase + (ST) * 32768 + robase; const bf16_t* sB_ = sA_ + 16384; \
    _Pragma("unroll 1") for (int ks = 0; ks < 2; ++ks) { bf16x8 bfr[NN]; \
      _Pragma("unroll") for (int n = 0; n < NN; ++n) bfr[n] = *(const bf16x8*)(sB_ + ((wc * NN + n) * 2 + ks) * 512); \
      _Pragma("unroll") for (int m = 0; m < MM; ++m) { const bf16x8 af = *(const bf16x8*)(sA_ + ((wr * MM + m) * 2 + ks) * 512); \
        _Pragma("unroll") for (int n = 0; n < NN; ++n) acc[m][n] = MFMA16(bfr[n], af, acc[m][n]); } } } while (0)
    __syncthreads();
    GT_STORE(0);
    GT_LOAD(1);
    __syncthreads();
#pragma unroll 1
    for (int kt = 0; kt < nk; kt += 2) {
      GT_STORE(1); GT_LOAD(kt + 2); GT_COMPUTE(0); __syncthreads();
      GT_STORE(0); GT_LOAD(kt + 3); GT_COMPUTE(1); __syncthreads();
    }
  }
#undef GT_LOAD
#undef GT_STORE
#undef GT_COMPUTE
};
template <int MM, int NN> DI void gemm_tile(f32x4 (&acc)[MM][NN], const TileSrc& s, char* smem) { Gemm<MM, NN> g; g.begin(s); g.run(acc, smem); }

DI float gelu_tanh(float x) { const float u = 0.7978845608f * (x + 0.044715f * x * x * x); const float e = __expf(2.f * u); const float th = 1.f - 2.f / (e + 1.f); return 0.5f * x * (1.f + th); }

struct TileIter {
  int m_lo, rows, NTn, G, efull, count, e, stride;
  DI void init(int MTn, int NTn_) { const int x = blockIdx.x & 7; m_lo = (x * MTn) >> 3; rows = (((x + 1) * MTn) >> 3) - m_lo; NTn = NTn_; G = (rows + 1) >> 1;
    efull = (rows / G) * G * NTn; count = rows * NTn; e = blockIdx.x >> 3; stride = gridDim.x >> 3; }
  DI bool next(int& mt, int& nt) { if (e >= count) return false;
    if (e < efull) { const int grp = e / (G * NTn), rem = e - grp * G * NTn; nt = rem / G; mt = m_lo + grp * G + (rem - nt * G); }
    else { const int rem = e - efull, gsz = rows - (rows / G) * G; nt = rem / gsz; mt = m_lo + (rows / G) * G + (rem - nt * gsz); }
    e += stride; return true; }
};

__device__ void phase_win(const P& p, int l, char* smem) {
  const bf16_t* H = (const bf16_t*)(p.ws + WS_H); const bf16_t* Wt = (const bf16_t*)(p.ws + WS_WIN);
  bf16_t* zr = (bf16_t*)(p.ws + WS_ZR); bf16_t* zn = (bf16_t*)(p.ws + WS_ZN); bf16_t* zt = (bf16_t*)(p.ws + WS_ZT);
  const int tid = ptid(), lane = tid & 63, wave = tid >> 6, wr = wave >> 2, wc = wave & 3, fr = lane & 15, fq = lane >> 4;
  Gemm<8, 4> gm;
  TileIter ti; ti.init(48, 14);
  const int x = blockIdx.x & 7, nconv = (343 - x + 7) >> 3, nloc = ti.count + nconv;
  const float* cw = p.rwkv_conv + (size_t)l * 3 * NZR;
  for (int e = (int)(blockIdx.x >> 3); e < nloc; e += (int)(gridDim.x >> 3)) {
    f32x4 acc[8][4]; zero_acc<8, 4>(acc);
    if (e < nconv) {
      const int c = x + 8 * e, mt = c / 7, nt = c - mt * 7;
      const int n0 = nt * 256, arow0 = mt * 254 - 1;
      { TileSrc s{H, LDH, arow0, Wt, LDH, n0, n0 + 128, D}; gm.begin(s); }
      gm.run(acc, smem);
      float* sC = (float*)smem;
#pragma unroll 1
      for (int sl = 0; sl < 4; ++sl) {
        __syncthreads();
        if (wc == sl) {
#pragma unroll
          for (int m = 0; m < 8; ++m)
#pragma unroll
            for (int n = 0; n < 4; ++n) *(f32x4*)(sC + (wr * 128 + m * 16 + fr) * 68 + n * 16 + fq * 4) = acc[m][n];
        }
        __syncthreads();
        const int nb = n0 + sl * 64, c4 = (tid & 15) * 4;
        const float4 w0 = *(const float4*)(cw + nb + c4), w1 = *(const float4*)(cw + NZR + nb + c4), w2 = *(const float4*)(cw + 2 * NZR + nb + c4);
        for (int ee = tid; ee < 254 * 16; ee += NTP) {
          const int tr = 1 + (ee >> 4), g = arow0 + tr;
          if (g < MT) { int t, T, mi; tokinfo(g, t, T, mi);
            const float pm = t > 0 ? 1.f : 0.f, nm = t < T - 1 ? 1.f : 0.f;
            const f32x4 a = *(const f32x4*)(sC + (tr - 1) * 68 + c4), b = *(const f32x4*)(sC + tr * 68 + c4), cc = *(const f32x4*)(sC + (tr + 1) * 68 + c4);
            float r0 = pm * a[0] * w0.x + b[0] * w1.x + nm * cc[0] * w2.x, r1 = pm * a[1] * w0.y + b[1] * w1.y + nm * cc[1] * w2.y;
            float r2 = pm * a[2] * w0.z + b[2] * w1.z + nm * cc[2] * w2.z, r3 = pm * a[3] * w0.w + b[3] * w1.w + nm * cc[3] * w2.w;
            if (nb >= 1664) { r0 = sigmoidf_(r0); r1 = sigmoidf_(r1); r2 = sigmoidf_(r2); r3 = sigmoidf_(r3); }
            u32x2 o; o.x = pack2(r0, r1); o.y = pack2(r2, r3);
            *(u32x2*)(zr + (size_t)g * NZR + nb + c4) = o; }
        }
      }
    } else {
      int mt, nt; ti.e = e - nconv; ti.next(mt, nt);
      const int n0 = nt * 256, row0 = mt * 256;
      { TileSrc s{H, LDH, row0, Wt, LDH, NZR + n0, NZR + n0 + 128, D}; gm.begin(s); }
      gm.run(acc, smem);
#pragma unroll
      for (int m = 0; m < 8; ++m) { const int row = row0 + wr * 128 + m * 16 + fr;
#pragma unroll
        for (int n = 0; n < 4; ++n) { const int col = n0 + wc * 64 + n * 16 + fq * 4; const f32x4 v = acc[m][n];
          u32x2 o; o.x = pack2(v[0], v[1]); o.y = pack2(v[2], v[3]);
          if (col < NZN) {
            *(u32x2*)(zn + (size_t)row * NZN + col) = o;
            if (row < MC && col >= 512) { const int part = col - 512, isv = part >> 9, pp = part & 511, hh = pp >> 6, d = pp & 63, b = row >> 8, t = row & 255;
              float* dst = p.out + (isv ? O_V : O_K) + ((((size_t)b * 2 + l) * 8 + hh) * 256 + t) * 64 + d; *(f32x4*)dst = v; }
          } else { *(u32x2*)(zt + (size_t)row * LZT + (col - NZN)) = o; }
        } }
    }
  }
}

__device__ void phase_merge(const P& p, char* smem) {
  const bf16_t* H = (const bf16_t*)(p.ws + WS_H); const bf16_t* Wt = (const bf16_t*)(p.ws + WS_WIN); const bf16_t* Wo3 = (const bf16_t*)(p.ws + WS_WO3);
  bf16_t* mg = (bf16_t*)(p.ws + WS_MERGED);
  const int tid = ptid(), lane = tid & 63, wave = tid >> 6, wr = wave >> 2, wc = wave & 3, fr = lane & 15, fq = lane >> 4;
  TileIter ti; int mt, nt; ti.init(96, 8);
  while (ti.next(mt, nt)) {
    const int n0 = nt * 128, row0 = mt * 128;
    f32x4 macc[4][2]; zero_acc<4, 2>(macc);
#pragma unroll 1
    for (int i = 0; i < 3; ++i) {
      const bf16_t* O = (const bf16_t*)(p.ws + (i == 0 ? WS_OA : (i == 1 ? WS_ONA : WS_ORET)));
      f32x4 g[4][2]; zero_acc<4, 2>(g);
      { TileSrc s{H, LDH, row0, Wt, LDH, 5376 + i * 1024 + n0, 5376 + i * 1024 + n0 + 64, D}; gemm_tile<4, 2>(g, s, smem); }
      f32x4 a2[4][2]; zero_acc<4, 2>(a2);
      { TileSrc s{O, LDO, row0, Wo3 + (size_t)i * 1024 * LDO, LDO, n0, n0 + 64, 512}; gemm_tile<4, 2>(a2, s, smem); }
#pragma unroll
      for (int m = 0; m < 4; ++m)
#pragma unroll
        for (int n = 0; n < 2; ++n)
#pragma unroll
          for (int j = 0; j < 4; ++j) macc[m][n][j] += sigmoidf_(g[m][n][j]) * a2[m][n][j];
    }
#pragma unroll
    for (int m = 0; m < 4; ++m) { const int row = row0 + wr * 64 + m * 16 + fr;
#pragma unroll
      for (int n = 0; n < 2; ++n) { const int col = n0 + wc * 32 + n * 16 + fq * 4; u32x2 o; o.x = pack2(macc[m][n][0], macc[m][n][1]); o.y = pack2(macc[m][n][2], macc[m][n][3]); *(u32x2*)(mg + (size_t)row * LDH + col) = o; } }
  }
}

__device__ void phase_gemm_f32(const bf16_t* A, int lda, int K, const bf16_t* Bt, int ldb, float* C, char* smem) {
  const int tid = ptid(), lane = tid & 63, wave = tid >> 6, wr = wave >> 2, wc = wave & 3, fr = lane & 15, fq = lane >> 4;
  TileIter ti; int mt, nt; ti.init(48, 4);
  while (ti.next(mt, nt)) {
    const int n0 = nt * 256, row0 = mt * 256;
    f32x4 acc[8][4]; zero_acc<8, 4>(acc);
    TileSrc s{A, lda, row0, Bt, ldb, n0, n0 + 128, K}; gemm_tile<8, 4>(acc, s, smem);
#pragma unroll
    for (int m = 0; m < 8; ++m) { const int row = row0 + wr * 128 + m * 16 + fr;
#pragma unroll
      for (int n = 0; n < 4; ++n) *(f32x4*)(C + (size_t)row * D + n0 + wc * 64 + n * 16 + fq * 4) = acc[m][n]; }
  }
}

__device__ void phase_ffn_up(const P& p, int l, char* smem) {
  const bf16_t* H = (const bf16_t*)(p.ws + WS_H); const bf16_t* Wt = (const bf16_t*)(p.ws + WS_WUP); bf16_t* hid = (bf16_t*)(p.ws + WS_HID);
  const int tid = ptid(), lane = tid & 63, wave = tid >> 6, wr = wave >> 2, wc = wave & 3, fr = lane & 15, fq = lane >> 4;
  const float* cw = p.ffn_conv + (size_t)l * 3 * 2 * FF;
  TileIter ti; int mt, nt; ti.init(49, 22);
  Gemm<8, 4> gm;
  while (ti.next(mt, nt)) {
    const int c0 = nt * 128, arow0 = mt * 254 - 1;
    f32x4 acc[8][4]; zero_acc<8, 4>(acc);
    { TileSrc s{H, LDH, arow0, Wt, LDH, c0, FF + c0, D}; gm.begin(s); }
    gm.run(acc, smem);
    float* sC = (float*)smem;
#pragma unroll
    for (int q = 0; q < 4; ++q) {
      __syncthreads();
      if ((wc & 1) == (q >> 1)) { const int cb = (wc >> 1) * 32;
#pragma unroll
        for (int m = 0; m < 8; ++m)
#pragma unroll
          for (int n = 0; n < 2; ++n) *(f32x4*)(sC + (wr * 128 + m * 16 + fr) * 68 + cb + n * 16 + fq * 4) = acc[m][(q & 1) * 2 + n];
      }
      __syncthreads();
      const int cq = c0 + q * 32, c4 = (tid & 7) * 4;
      const f32x4 v0 = *(const f32x4*)(cw + cq + c4), v1 = *(const f32x4*)(cw + 2 * FF + cq + c4), v2 = *(const f32x4*)(cw + 4 * FF + cq + c4);
      const f32x4 g0 = *(const f32x4*)(cw + FF + cq + c4), g1 = *(const f32x4*)(cw + 3 * FF + cq + c4), g2 = *(const f32x4*)(cw + 5 * FF + cq + c4);
      for (int e = tid; e < 254 * 8; e += NTP) {
        const int tr = 1 + (e >> 3), g = arow0 + tr;
        if (g < MT) { int t, T, mi; tokinfo(g, t, T, mi);
          const float pm = t > 0 ? 1.f : 0.f, nm = t < T - 1 ? 1.f : 0.f;
          const f32x4 va = *(const f32x4*)(sC + (tr - 1) * 68 + c4), vb = *(const f32x4*)(sC + tr * 68 + c4), vc = *(const f32x4*)(sC + (tr + 1) * 68 + c4);
          const f32x4 ga = *(const f32x4*)(sC + (tr - 1) * 68 + 32 + c4), gb = *(const f32x4*)(sC + tr * 68 + 32 + c4), gc = *(const f32x4*)(sC + (tr + 1) * 68 + 32 + c4);
          float r[4];
#pragma unroll
          for (int j = 0; j < 4; ++j) { const float val = pm * va[j] * v0[j] + vb[j] * v1[j] + nm * vc[j] * v2[j]; const float gt = pm * ga[j] * g0[j] + gb[j] * g1[j] + nm * gc[j] * g2[j]; r[j] = gelu_tanh(gt) * val; }
          u32x2 o; o.x = pack2(r[0], r[1]); o.y = pack2(r[2], r[3]);
          *(u32x2*)(hid + (size_t)g * FF + cq + c4) = o; }
      }
    }
  }
}

template <int CTRL> DI float dppf(float v) { return __int_as_float(__builtin_amdgcn_mov_dpp(__float_as_int(v), CTRL, 0xF, 0xF, true)); }
DI float row16_sum(float v) { v += dppf<0xB1>(v); v += dppf<0x4E>(v); v += dppf<0x141>(v); v += dppf<0x140>(v); return v; }

DI float frcp(float x) { return __builtin_amdgcn_rcpf(x); }
DI float fsig(float x) { return frcp(1.f + __expf(-x)); }
__device__ void scan_task(const P& p, int l, int seq, int h, int d, int half, char* smem) {
  float* sR = (float*)smem; float* sW = sR + 1024; float* sKD = sW + 1024; float* sB = sKD + 1024; float* sNK = sB + 1024; float* sV = sNK + 1024; float* sK = sV + 1024; float* sY = sK + 1024;
  float* sKn = sY + 1024; float* sKK = sKn + 16; bf16_t* sWT = (bf16_t*)(sKK + 64); bf16_t* sAL = sWT + 16 * LDT;
  const int tid = tidx(), lane = tid & 63, wave = tid >> 6, fr = lane & 15, fq = lane >> 4;
  const int row0 = seq < 32 ? seq * 256 : MC + (seq - 32) * 1024, T = seq < 32 ? 256 : 1024, nch = T >> 4;
  const bf16_t* zr = (const bf16_t*)(p.ws + WS_ZR);
  float* yout = (float*)(p.ws + WS_Y) + (size_t)d * MT * 512;
  __syncthreads();
  if (tid < 64) sKK[tid] = p.rwkv_k_k[l * 512 + h * 64 + tid];
  const int cc = wave * 16 + fr, gc = h * 64 + cc;
  bf16x8 bw[2], ba[2];
#pragma unroll
  for (int ks = 0; ks < 2; ++ks)
#pragma unroll
    for (int e = 0; e < 8; ++e) { const int k = ks * 32 + fq * 8 + e;
      bw[ks][e] = (short)f2bf(p.rwkv_w_up[((size_t)(l * 2 + d) * 64 + k) * 512 + gc]); ba[ks][e] = (short)f2bf(p.rwkv_a_up[((size_t)(l * 2 + d) * 64 + k) * 512 + gc]); }
  const float w0c = p.rwkv_w0[(l * 2 + d) * 512 + gc], a0c = p.rwkv_a0[(l * 2 + d) * 512 + gc], kac = p.rwkv_k_a[l * 512 + gc];
  const int rg = tid >> 4, kq = tid & 15, rbase = half * 32 + rg * 2;
  f32x2 S[2][2];
  if (seq >= 32) { const float* s0 = p.state_rwkv + (((((size_t)(seq - 32) * 2 + l) * 2 + d) * 8 + h) * 64 + rbase) * 64 + kq * 4;
#pragma unroll
    for (int r = 0; r < 2; ++r) { const f32x4 x = *(const f32x4*)(s0 + r * 64); S[r][0] = (f32x2){x[0], x[1]}; S[r][1] = (f32x2){x[2], x[3]}; } }
  else {
#pragma unroll
    for (int r = 0; r < 2; ++r) { S[r][0] = (f32x2){0.f, 0.f}; S[r][1] = (f32x2){0.f, 0.f}; } }
  if (seq >= 32) __builtin_amdgcn_s_setprio(2);
  const int at = (tid & 127) >> 3, apart = tid & 7, ahi = tid >> 7;
  size_t coff[3];
  { const int sb0 = ahi ? 512 + h * 64 : h * 64, sb1 = ahi ? 1536 : 1024 + h * 64, sb2 = 1600;
    coff[0] = (size_t)at * NZR + sb0 + apart * 8; coff[1] = (size_t)at * NZR + sb1 + apart * 8; coff[2] = (size_t)at * NZR + sb2 + apart * 8; }
  u32x4 pre[3];
  { const int t0 = (d ? nch - 1 : 0) * 16;
#pragma unroll
    for (int i = 0; i < 3; ++i) pre[i] = *(const u32x4*)(zr + (size_t)(row0 + t0) * NZR + coff[i]); }
  __syncthreads();
  for (int ci = 0; ci < nch; ++ci) {
    const int chunk = d ? nch - 1 - ci : ci, t0 = chunk * 16;
    { const int o = at * 64 + apart * 8; float f[8];
      unpack8(pre[0], f);
      if (ahi == 0) { *(f32x4*)(sR + o) = (f32x4){f[0], f[1], f[2], f[3]}; *(f32x4*)(sR + o + 4) = (f32x4){f[4], f[5], f[6], f[7]}; }
      else { *(f32x4*)(sK + o) = (f32x4){f[0], f[1], f[2], f[3]}; *(f32x4*)(sK + o + 4) = (f32x4){f[4], f[5], f[6], f[7]}; float ps = 0.f;
#pragma unroll
        for (int e = 0; e < 8; ++e) { const float kk = f[e] * sKK[apart * 8 + e]; ps += kk * kk; }
        ps += dppf<0xB1>(ps); ps += dppf<0x4E>(ps); ps += dppf<0x141>(ps);
        if (apart == 0) sKn[at] = ps; }
      unpack8(pre[1], f);
      if (ahi == 0) { *(f32x4*)(sV + o) = (f32x4){f[0], f[1], f[2], f[3]}; *(f32x4*)(sV + o + 4) = (f32x4){f[4], f[5], f[6], f[7]}; }
      else { float g[8];
#pragma unroll
        for (int e = 0; e < 8; ++e) g[e] = 1.f - 2.f * frcp(__expf(2.f * f[e]) + 1.f);
        *(u32x4*)(sWT + at * LDT + apart * 8) = pack8(g); }
      if (ahi == 0) *(u32x4*)(sAL + at * LDT + apart * 8) = pre[2];
    }
    __syncthreads();
    {
      f32x4 aw = {0.f, 0.f, 0.f, 0.f}, aa = {0.f, 0.f, 0.f, 0.f};
#pragma unroll
      for (int ks = 0; ks < 2; ++ks) { const bf16x8 fw = *(const bf16x8*)(sWT + fr * LDT + ks * 32 + fq * 8); const bf16x8 fa = *(const bf16x8*)(sAL + fr * LDT + ks * 32 + fq * 8);
        aw = MFMA16(fw, bw[ks], aw); aa = MFMA16(fa, ba[ks], aa); }
      const float kkc = sKK[cc];
#pragma unroll
      for (int j = 0; j < 4; ++j) { const int t = fq * 4 + j, o = t * 64 + cc;
        const float dec = __expf(-0.6065306597f * fsig(w0c + aw[j]));
        const float a = fsig(a0c + aa[j]);
        const float kv = sK[o];
        const float kkv = kv * kkc * __builtin_amdgcn_rsqf(fmaxf(sKn[t], 1e-24f));
        sW[o] = dec; sKD[o] = kv * (1.f + (a - 1.f) * kac); sB[o] = kkv * a; sNK[o] = -kkv; }
    }
    __syncthreads();
    { const int cn = ci + 1 < nch ? ci + 1 : ci; const int nt0 = (d ? nch - 1 - cn : cn) * 16;
#pragma unroll
      for (int i = 0; i < 3; ++i) pre[i] = *(const u32x4*)(zr + (size_t)(row0 + nt0) * NZR + coff[i]); }
#pragma unroll 2
    for (int si = 0; si < 16; ++si) {
      const int t = d ? 15 - si : si, o = t * 64 + kq * 4;
      const f32x4 an4 = *(const f32x4*)(sNK + o), w4 = *(const f32x4*)(sW + o), b4 = *(const f32x4*)(sB + o), kd4 = *(const f32x4*)(sKD + o), r4 = *(const f32x4*)(sR + o);
      const f32x2 v2 = *(const f32x2*)(sV + t * 64 + rbase);
      const f32x2 an[2] = {{an4[0], an4[1]}, {an4[2], an4[3]}}, wv[2] = {{w4[0], w4[1]}, {w4[2], w4[3]}}, bv[2] = {{b4[0], b4[1]}, {b4[2], b4[3]}}, kd[2] = {{kd4[0], kd4[1]}, {kd4[2], kd4[3]}}, rv[2] = {{r4[0], r4[1]}, {r4[2], r4[3]}};
      float sa[2];
#pragma unroll
      for (int r = 0; r < 2; ++r) { const f32x2 t2 = S[r][0] * an[0] + S[r][1] * an[1]; sa[r] = row16_sum(t2.x + t2.y); }
      f32x2 yv;
#pragma unroll
      for (int r = 0; r < 2; ++r) { const f32x2 sav = {sa[r], sa[r]}, vvv = {v2[r], v2[r]};
        S[r][0] = S[r][0] * wv[0] + (sav * bv[0] + vvv * kd[0]); S[r][1] = S[r][1] * wv[1] + (sav * bv[1] + vvv * kd[1]);
        const f32x2 y2 = S[r][0] * rv[0] + S[r][1] * rv[1]; yv[r] = row16_sum(y2.x + y2.y); }
      if (kq == 0) *(f32x2*)(sY + t * 64 + rbase) = yv;
    }
    __syncthreads();
    { const int t = tid >> 4, vv = half * 32 + (tid & 15) * 2; *(f32x2*)(yout + (size_t)(row0 + t0 + t) * 512 + h * 64 + vv) = *(const f32x2*)(sY + t * 64 + vv); }
  }
  __builtin_amdgcn_s_setprio(0);
  if (seq < 32) { float* so = p.out + O_RW + (((((size_t)seq * 2 + l) * 2 + d) * 8 + h) * 64 + rbase) * 64 + kq * 4;
#pragma unroll
    for (int r = 0; r < 2; ++r) *(f32x4*)(so + r * 64) = (f32x4){S[r][0].x, S[r][0].y, S[r][1].x, S[r][1].y}; }
}

DI void qk_scores(const bf16_t* sK, const bf16x8 (&qf)[2], f32x4 (&sacc)[4], int fr, int fq) {
#pragma unroll
  for (int nt = 0; nt < 4; ++nt) { sacc[nt] = (f32x4){0.f, 0.f, 0.f, 0.f};
#pragma unroll
    for (int ks = 0; ks < 2; ++ks) { const bf16x8 kf = *(const bf16x8*)(sK + (nt * 16 + fr) * LDT + ks * 32 + fq * 8); sacc[nt] = MFMA16(kf, qf[ks], sacc[nt]); } }
}
DI void pv_accum(const bf16_t* sVt, const f32x4 (&pacc)[4], f32x4 (&o)[4], int fr, int fq) {
#pragma unroll
  for (int s = 0; s < 2; ++s) {
    bf16x8 pf; { const unsigned a = pack2(pacc[2 * s][0], pacc[2 * s][1]), b = pack2(pacc[2 * s][2], pacc[2 * s][3]), c = pack2(pacc[2 * s + 1][0], pacc[2 * s + 1][1]), dd = pack2(pacc[2 * s + 1][2], pacc[2 * s + 1][3]);
      const u32x4 u = (u32x4){a, b, c, dd}; pf = __builtin_bit_cast(bf16x8, u); }
#pragma unroll
    for (int dt = 0; dt < 4; ++dt) { const u32x2 lo = *(const u32x2*)(sVt + (dt * 16 + fr) * LDT + 32 * s + 4 * fq), hi = *(const u32x2*)(sVt + (dt * 16 + fr) * LDT + 32 * s + 16 + 4 * fq);
      const u32x4 u = (u32x4){lo[0], lo[1], hi[0], hi[1]}; const bf16x8 vf = __builtin_bit_cast(bf16x8, u); o[dt] = MFMA16(vf, pf, o[dt]); }
  }
}
DI void put_kv(bf16_t* sK, bf16_t* sVt, int key, int part, const float (&kf)[8], int vkey, int vpart, const float (&vf)[8]) {
  *(u32x4*)(sK + key * LDT + part * 8) = pack8(kf);
#pragma unroll
  for (int e = 0; e < 8; ++e) sVt[(vpart * 8 + e) * LDT + vkey] = f2bf(vf[e]);
}
DI void softmax_tile(f32x4 (&sacc)[4], f32x4 (&o)[4], float& mrun, float& lrun) {
  float mx = sacc[0][0];
#pragma unroll
  for (int nt = 0; nt < 4; ++nt)
#pragma unroll
    for (int j = 0; j < 4; ++j) mx = fmaxf(mx, sacc[nt][j]);
  mx = fmaxf(mx, shfl_x(mx, 16)); mx = fmaxf(mx, shfl_x(mx, 32));
  const float mnew = fmaxf(mrun, mx), alpha = exp2f(mrun - mnew); mrun = mnew;
  float ls = 0.f;
#pragma unroll
  for (int nt = 0; nt < 4; ++nt)
#pragma unroll
    for (int j = 0; j < 4; ++j) { const float pv = exp2f(sacc[nt][j] - mnew); sacc[nt][j] = pv; ls += pv; }
  lrun = lrun * alpha + ls;
#pragma unroll
  for (int dt = 0; dt < 4; ++dt) o[dt] *= alpha;
}
constexpr float LOG2E = 1.4426950408889634f;

__device__ void dense_task(const P& p, int b, int h, int qb, char* smem) {
  bf16_t* sK = (bf16_t*)smem; bf16_t* sVt = sK + 64 * LDT;
  const int tid = tidx(), lane = tid & 63, wave = tid >> 6, fr = lane & 15, fq = lane >> 4;
  const bf16_t* zn = (const bf16_t*)(p.ws + WS_ZN); bf16_t* ona = (bf16_t*)(p.ws + WS_ONA);
  const int qrow = b * 256 + qb * 64 + wave * 16 + fr;
  bf16x8 qf[2];
#pragma unroll
  for (int ks = 0; ks < 2; ++ks) qf[ks] = *(const bf16x8*)(zn + (size_t)qrow * NZN + h * 64 + ks * 32 + fq * 8);
  f32x4 o[4]; for (int dt = 0; dt < 4; ++dt) o[dt] = (f32x4){0.f, 0.f, 0.f, 0.f};
  float mrun = -1e30f, lrun = 0.f;
  u32x4 pk[2], pv[2];
#pragma unroll
  for (int i = 0; i < 2; ++i) { const int c = tid + 256 * i, key = c >> 3, part = c & 7, vkey = c & 63, vpart = c >> 6; pk[i] = *(const u32x4*)(zn + (size_t)(b * 256 + key) * NZN + h * 64 + part * 8 + 512); pv[i] = *(const u32x4*)(zn + (size_t)(b * 256 + vkey) * NZN + h * 64 + vpart * 8 + 1024); }
  for (int kt = 0; kt < 4; ++kt) {
    __syncthreads();
#pragma unroll
    for (int i = 0; i < 2; ++i) { const int c = tid + 256 * i, key = c >> 3, part = c & 7, vkey = c & 63, vpart = c >> 6; float vf[8]; unpack8(pv[i], vf);
      *(u32x4*)(sK + key * LDT + part * 8) = pk[i];
#pragma unroll
      for (int e = 0; e < 8; ++e) sVt[(vpart * 8 + e) * LDT + vkey] = f2bf(vf[e]); }
    __syncthreads();
    { const int kn = kt < 3 ? kt + 1 : 3;
#pragma unroll
      for (int i = 0; i < 2; ++i) { const int c = tid + 256 * i, key = c >> 3, part = c & 7, vkey = c & 63, vpart = c >> 6; pk[i] = *(const u32x4*)(zn + (size_t)(b * 256 + kn * 64 + key) * NZN + h * 64 + part * 8 + 512); pv[i] = *(const u32x4*)(zn + (size_t)(b * 256 + kn * 64 + vkey) * NZN + h * 64 + vpart * 8 + 1024); } }
    f32x4 sacc[4]; qk_scores(sK, qf, sacc, fr, fq);
#pragma unroll
    for (int nt = 0; nt < 4; ++nt) sacc[nt] *= (0.125f * LOG2E);
    softmax_tile(sacc, o, mrun, lrun);
    pv_accum(sVt, sacc, o, fr, fq);
  }
  lrun += shfl_x(lrun, 16); lrun += shfl_x(lrun, 32); const float inv = 1.f / lrun;
#pragma unroll
  for (int dt = 0; dt < 4; ++dt) { u32x2 ov; ov.x = pack2(o[dt][0] * inv, o[dt][1] * inv); ov.y = pack2(o[dt][2] * inv, o[dt][3] * inv); *(u32x2*)(ona + (size_t)qrow * LDO + h * 64 + dt * 16 + fq * 4) = ov; }
}

__device__ void na_task(const P& p, int l, int b, int h, int r, char* smem) {
  bf16_t* sK = (bf16_t*)smem; bf16_t* sVt = sK + 64 * LDT; float* sRpb = (float*)(sVt + 64 * LDT);
  const int tid = tidx(), lane = tid & 63, wave = tid >> 6, fr = lane & 15, fq = lane >> 4;
  const bf16_t* zn = (const bf16_t*)(p.ws + WS_ZN); bf16_t* ona = (bf16_t*)(p.ws + WS_ONA);
  const int base = MC + b * 1024, qcol = wave * 16 + fr, qrow = base + r * 64 + qcol;
  int rs = r - 4; rs = rs < 0 ? 0 : (rs > 8 ? 8 : rs);
  int cs = qcol - 8; cs = cs < 0 ? 0 : (cs > 48 ? 48 : cs);
  __syncthreads();
  for (int e = tid; e < 465; e += NT) sRpb[e] = p.na_rpb[((size_t)l * 8 + h) * 465 + e] * LOG2E;
  bf16x8 qf[2];
#pragma unroll
  for (int ks = 0; ks < 2; ++ks) qf[ks] = *(const bf16x8*)(zn + (size_t)qrow * NZN + h * 64 + ks * 32 + fq * 8);
  f32x4 o[4]; for (int dt = 0; dt < 4; ++dt) o[dt] = (f32x4){0.f, 0.f, 0.f, 0.f};
  float mrun = -1e30f, lrun = 0.f;
  u32x4 pre[8];
#define NA_ISSUE(KT) do { const int kt_ = (KT); \
    if (kt_ < 8) { _Pragma("unroll") for (int i = 0; i < 2; ++i) { const int c = tid + 256 * i, key = c >> 3, part = c & 7, vkey = c & 63, vpart = c >> 6; \
        pre[4 * i] = *(const u32x4*)(zn + (size_t)(base + (rs + kt_) * 64 + key) * NZN + h * 64 + part * 8 + 512); pre[4 * i + 1] = *(const u32x4*)(zn + (size_t)(base + (rs + kt_) * 64 + vkey) * NZN + h * 64 + vpart * 8 + 1024); } } \
    else { _Pragma("unroll") for (int i = 0; i < 2; ++i) { const int c = tid + 256 * i, key = c >> 3, part = c & 7, vkey = c & 63, vpart = c >> 6; const size_t cb_ = (((size_t)b * 2 + l) * 8 + h) * 256 + (kt_ - 8) * 64; const size_t co = (cb_ + key) * 64 + part * 8, cv = (cb_ + vkey) * 64 + vpart * 8; \
        pre[4 * i] = *(const u32x4*)(p.cache_k + co); pre[4 * i + 1] = *(const u32x4*)(p.cache_k + co + 4); pre[4 * i + 2] = *(const u32x4*)(p.cache_v + cv); pre[4 * i + 3] = *(const u32x4*)(p.cache_v + cv + 4); } } } while (0)
  NA_ISSUE(0);
  for (int kt = 0; kt < 12; ++kt) {
    __syncthreads();
    if (kt < 8) {
#pragma unroll
      for (int i = 0; i < 2; ++i) { const int c = tid + 256 * i, key = c >> 3, part = c & 7, vkey = c & 63, vpart = c >> 6; float vf[8]; unpack8(pre[4 * i + 1], vf);
        *(u32x4*)(sK + key * LDT + part * 8) = pre[4 * i];
#pragma unroll
        for (int e = 0; e < 8; ++e) sVt[(vpart * 8 + e) * LDT + vkey] = f2bf(vf[e]); }
    } else {
#pragma unroll
      for (int i = 0; i < 2; ++i) { const int c = tid + 256 * i, key = c >> 3, part = c & 7, vkey = c & 63, vpart = c >> 6;
        const f32x4 k0 = __builtin_bit_cast(f32x4, pre[4 * i]), k1 = __builtin_bit_cast(f32x4, pre[4 * i + 1]), v0 = __builtin_bit_cast(f32x4, pre[4 * i + 2]), v1 = __builtin_bit_cast(f32x4, pre[4 * i + 3]);
        const float kf[8] = {k0[0], k0[1], k0[2], k0[3], k1[0], k1[1], k1[2], k1[3]}; const float vf[8] = {v0[0], v0[1], v0[2], v0[3], v1[0], v1[1], v1[2], v1[3]};
        put_kv(sK, sVt, key, part, kf, vkey, vpart, vf); }
    }
    __syncthreads();
    NA_ISSUE(kt < 11 ? kt + 1 : 11);
    f32x4 sacc[4]; qk_scores(sK, qf, sacc, fr, fq);
    if (kt < 8) { const int dr = rs + kt - r + 7;
#pragma unroll
      for (int nt = 0; nt < 4; ++nt)
#pragma unroll
        for (int j = 0; j < 4; ++j) { const int kc = nt * 16 + fq * 4 + j; const bool valid = kc >= cs && kc < cs + 16; int dc = kc - qcol; dc = dc < -15 ? -15 : (dc > 15 ? 15 : dc);
          sacc[nt][j] = valid ? sacc[nt][j] * (0.125f * LOG2E) + sRpb[dr * 31 + dc + 15] : -1e30f; }
    } else {
#pragma unroll
      for (int nt = 0; nt < 4; ++nt) sacc[nt] *= (0.125f * LOG2E);
    }
    softmax_tile(sacc, o, mrun, lrun);
    pv_accum(sVt, sacc, o, fr, fq);
  }
#undef NA_ISSUE
  lrun += shfl_x(lrun, 16); lrun += shfl_x(lrun, 32); const float inv = 1.f / lrun;
#pragma unroll
  for (int dt = 0; dt < 4; ++dt) { u32x2 ov; ov.x = pack2(o[dt][0] * inv, o[dt][1] * inv); ov.y = pack2(o[dt][2] * inv, o[dt][3] * inv); *(u32x2*)(ona + (size_t)qrow * LDO + h * 64 + dt * 16 + fq * 4) = ov; }
}

DI void rope8(const float (&own)[8], const float (&par)[8], int part, int n, float (&out)[8]) {
  const float pos = (float)((part >> 2) ? (n & 63) : (n >> 6));
  const bool isx2 = (part & 3) >= 2;
#pragma unroll
  for (int e = 0; e < 8; ++e) { const int i = (part & 1) * 8 + e; const float ang = pos * exp2f(-(float)i * 0.830482023721841f); const float sn = __sinf(ang), cs = __cosf(ang);
    out[e] = isx2 ? par[e] * sn + own[e] * cs : own[e] * cs - par[e] * sn; }
}

__device__ void ret_task(const P& p, int l, int seq, int h, int qb, char* smem) {
  bf16_t* sK = (bf16_t*)smem; bf16_t* sVt = sK + 64 * LDT; bf16_t* sQ = sVt + 64 * LDT;
  const int tid = tidx(), lane = tid & 63, wave = tid >> 6, fr = lane & 15, fq = lane >> 4;
  const bf16_t* zt = (const bf16_t*)(p.ws + WS_ZT); bf16_t* oret = (bf16_t*)(p.ws + WS_ORET);
  const bool lat = seq >= 32;
  const int row0 = lat ? MC + (seq - 32) * 1024 : seq * 256, T = lat ? 1024 : 256, nkt = T >> 6;
  const float xf = p.ret_decay[(l * 2 + 0) * 8 + h], xb = p.ret_decay[(l * 2 + 1) * 8 + h];
  const float lgf = -log1pf(__expf(-xf)) * LOG2E, lgb = -log1pf(__expf(-xb)) * LOG2E;
  __syncthreads();
#pragma unroll
  for (int i = 0; i < 2; ++i) { const int c = tid + 256 * i, qi = c >> 3, part = c & 7; const int n = qb * 64 + qi; const size_t ro = (size_t)(row0 + n) * LZT + h * 64;
    const u32x4 own = *(const u32x4*)(zt + ro + part * 8);
    if (lat) { const u32x4 par = *(const u32x4*)(zt + ro + (part ^ 2) * 8); float fo[8], fp[8], out[8]; unpack8(own, fo); unpack8(par, fp); rope8(fo, fp, part, n, out); *(u32x4*)(sQ + qi * LDT + part * 8) = pack8(out); }
    else *(u32x4*)(sQ + qi * LDT + part * 8) = own; }
  __syncthreads();
  const int qi = wave * 16 + fr, nq = qb * 64 + qi;
  bf16x8 qf[2];
#pragma unroll
  for (int ks = 0; ks < 2; ++ks) qf[ks] = *(const bf16x8*)(sQ + qi * LDT + ks * 32 + fq * 8);
  f32x4 o[4]; for (int dt = 0; dt < 4; ++dt) o[dt] = (f32x4){0.f, 0.f, 0.f, 0.f};
  u32x4 rk[2], rp[2], rv[2];
#define RET_ISSUE(KT) do { _Pragma("unroll") for (int i = 0; i < 2; ++i) { const int c = tid + 256 * i, key = c >> 3, part = c & 7, vkey = c & 63, vpart = c >> 6; const size_t ro = (size_t)(row0 + (KT) * 64 + key) * LZT + h * 64; \
    rk[i] = *(const u32x4*)(zt + ro + 512 + part * 8); rp[i] = *(const u32x4*)(zt + ro + 512 + (part ^ 2) * 8); rv[i] = *(const u32x4*)(zt + (size_t)(row0 + (KT) * 64 + vkey) * LZT + h * 64 + 1024 + vpart * 8); } } while (0)
  RET_ISSUE(0);
  for (int kt = 0; kt < nkt; ++kt) {
    __syncthreads();
#pragma unroll
    for (int i = 0; i < 2; ++i) { const int c = tid + 256 * i, key = c >> 3, part = c & 7, vkey = c & 63, vpart = c >> 6; const int n = kt * 64 + key;
      float kf[8], vf[8]; unpack8(rk[i], kf); unpack8(rv[i], vf);
      if (lat) { float fp[8], out[8]; unpack8(rp[i], fp); rope8(kf, fp, part, n, out);
#pragma unroll
        for (int e = 0; e < 8; ++e) kf[e] = out[e]; }
#pragma unroll
      for (int e = 0; e < 8; ++e) kf[e] *= 0.125f;
      put_kv(sK, sVt, key, part, kf, vkey, vpart, vf); }
    __syncthreads();
    RET_ISSUE(kt + 1 < nkt ? kt + 1 : kt);
    f32x4 sacc[4]; qk_scores(sK, qf, sacc, fr, fq);
#pragma unroll
    for (int nt = 0; nt < 4; ++nt)
#pragma unroll
      for (int j = 0; j < 4; ++j) { const int mk = kt * 64 + nt * 16 + fq * 4 + j; const int df = nq - mk;
        const float dec = df > 0 ? exp2f(lgf * (float)df) : (df < 0 ? exp2f(lgb * (float)(-df)) : 2.f); sacc[nt][j] *= dec; }
    pv_accum(sVt, sacc, o, fr, fq);
  }
#undef RET_ISSUE
  if (lat) {
    for (int dir = 0; dir < 2; ++dir) {
      __syncthreads();
      const float* s0 = p.state_ret + ((((size_t)(seq - 32) * 2 + l) * 2 + dir) * 8 + h) * 4096;
#pragma unroll
      for (int i = 0; i < 2; ++i) { const int c = tid + 256 * i, dk = c & 63, part = c >> 6; const float4 a = *(const float4*)(s0 + dk * 64 + part * 8), bq = *(const float4*)(s0 + dk * 64 + part * 8 + 4);
        const float vf[8] = {a.x, a.y, a.z, a.w, bq.x, bq.y, bq.z, bq.w};
#pragma unroll
        for (int e = 0; e < 8; ++e) sVt[(part * 8 + e) * LDT + dk] = f2bf(vf[e]); }
      __syncthreads();
      const float xi = dir == 0 ? exp2f(lgf * (float)(nq + 1)) : exp2f(lgb * (float)(T - nq));
      f32x4 pacc[4];
#pragma unroll
      for (int s = 0; s < 2; ++s)
#pragma unroll
        for (int hh = 0; hh < 2; ++hh)
#pragma unroll
          for (int j = 0; j < 4; ++j) pacc[2 * s + hh][j] = xi * bf2f(sQ[qi * LDT + 32 * s + 16 * hh + 4 * fq + j]);
      pv_accum(sVt, pacc, o, fr, fq);
    }
  }
  float s1 = 0.f;
#pragma unroll
  for (int dt = 0; dt < 4; ++dt)
#pragma unroll
    for (int j = 0; j < 4; ++j) s1 += o[dt][j];
  s1 += shfl_x(s1, 16); s1 += shfl_x(s1, 32); const float mu = s1 * (1.f / 64.f);
  float s2 = 0.f;
#pragma unroll
  for (int dt = 0; dt < 4; ++dt)
#pragma unroll
    for (int j = 0; j < 4; ++j) { const float dlt = o[dt][j] - mu; s2 += dlt * dlt; }
  s2 += shfl_x(s2, 16); s2 += shfl_x(s2, 32); const float rstd = rsqrtf(s2 * (1.f / 64.f) + 1e-5f);
  const size_t qrow = (size_t)(row0 + nq);
#pragma unroll
  for (int dt = 0; dt < 4; ++dt) { const int dv = h * 64 + dt * 16 + fq * 4; const u32x2 gr = *(const u32x2*)(zt + qrow * LZT + 1536 + dv); const float4 gn = *(const float4*)(p.ret_gn + l * 512 + dv);
    const float g0 = bflo(gr.x), g1 = bfhi(gr.x), g2 = bflo(gr.y), g3 = bfhi(gr.y);
    u32x2 ov; ov.x = pack2((o[dt][0] - mu) * rstd * gn.x * g0 * sigmoidf_(g0), (o[dt][1] - mu) * rstd * gn.y * g1 * sigmoidf_(g1));
    ov.y = pack2((o[dt][2] - mu) * rstd * gn.z * g2 * sigmoidf_(g2), (o[dt][3] - mu) * rstd * gn.w * g3 * sigmoidf_(g3));
    *(u32x2*)(oret + qrow * LDO + dv) = ov; }
}

__device__ void retstate_task(const P& p, int l, int b, int h, char* smem) {
  float* sKf = (float*)smem; float* sKb = sKf + 64 * 64; float* sV = sKb + 64 * 64;
  const int tid = tidx(), dk = tid >> 2, dq = tid & 3;
  const bf16_t* zt = (const bf16_t*)(p.ws + WS_ZT);
  const float xf = p.ret_decay[(l * 2 + 0) * 8 + h], xb = p.ret_decay[(l * 2 + 1) * 8 + h];
  const float lgf = -log1pf(__expf(-xf)) * LOG2E, lgb = -log1pf(__expf(-xb)) * LOG2E;
  float af[16], ab[16];
#pragma unroll
  for (int i = 0; i < 16; ++i) { af[i] = 0.f; ab[i] = 0.f; }
  for (int kt = 0; kt < 4; ++kt) {
    __syncthreads();
#pragma unroll
    for (int i = 0; i < 2; ++i) { const int c = tid + 256 * i, key = c >> 3, part = c & 7, m = kt * 64 + key; const size_t ro = (size_t)(b * 256 + m) * LZT + h * 64 + part * 8;
      float kf[8], vf[8]; unpack8(*(const u32x4*)(zt + ro + 512), kf); unpack8(*(const u32x4*)(zt + ro + 1024), vf);
      const float wf = 0.125f * exp2f(lgf * (float)(255 - m)), wb = 0.125f * exp2f(lgb * (float)m);
#pragma unroll
      for (int e = 0; e < 8; ++e) { sKf[key * 64 + part * 8 + e] = kf[e] * wf; sKb[key * 64 + part * 8 + e] = kf[e] * wb; sV[key * 64 + part * 8 + e] = vf[e]; } }
    __syncthreads();
    for (int m = 0; m < 64; ++m) { const float kf = sKf[m * 64 + dk], kb = sKb[m * 64 + dk];
#pragma unroll
      for (int i = 0; i < 4; ++i) { const f32x4 vv = *(const f32x4*)(sV + m * 64 + dq * 16 + i * 4);
#pragma unroll
        for (int j = 0; j < 4; ++j) { af[i * 4 + j] += kf * vv[j]; ab[i * 4 + j] += kb * vv[j]; } } }
  }
  float* of = p.out + O_RT + ((((size_t)b * 2 + l) * 2 + 0) * 8 + h) * 4096 + dk * 64 + dq * 16; float* ob = of + 8 * 4096;
#pragma unroll
  for (int i = 0; i < 16; ++i) { of[i] = af[i]; ob[i] = ab[i]; }
}

constexpr int Q_SCAN_L = 64, Q_SCAN_C = 512, Q_RET_L = 256, Q_NA = 256, Q_DENSE = 512, Q_RET_C = 512, Q_RST = 128;
template <int QMASK> __device__ void phase_mixers(const P& p, int l, char* smem_, int rep = 0) {
  __shared__ int s_task;
  int* ctr = (int*)(p.ws + WS_CTRL) + 64 * (l + 1) + 4 * rep;
  const int vb = vhalf(); char* smem = smem_ + vb * VSMEM;
  if (QMASK & 1) for (;;) {
    __syncthreads();
    if (ptid() == 0) s_task = atomicAdd(ctr, 1);
    __syncthreads();
    const int tk = s_task;
    if (tk >= Q_SCAN_L + Q_SCAN_C) break;
    const bool lat = tk < Q_SCAN_L; const int t2 = lat ? tk : tk - Q_SCAN_L;
    scan_task(p, l, (lat ? 32 : 0) + (t2 >> 4), (t2 >> 1) & 7, t2 & 1, vb, smem);
  }
  if (QMASK & 2) for (;;) {
    __syncthreads();
    if (ptid() == 0) s_task = atomicAdd(ctr + 16, 1);
    __syncthreads();
    const int tk = s_task;
    if (tk >= Q_RET_L + Q_RET_C) break;
    if (tk < Q_RET_L) ret_task(p, l, 32 + (tk >> 6), (tk >> 3) & 7, (tk & 7) * 2 + vb, smem);
    else { const int t2 = tk - Q_RET_L; ret_task(p, l, t2 >> 4, (t2 >> 1) & 7, (t2 & 1) * 2 + vb, smem); }
  }
  if (QMASK & 4) for (;;) {
    __syncthreads();
    if (ptid() == 0) s_task = atomicAdd(ctr + 32, 1);
    __syncthreads();
    int tk = s_task;
    if (tk >= Q_NA + Q_DENSE + Q_RST) break;
    if (tk < Q_NA) { na_task(p, l, tk >> 6, (tk >> 3) & 7, (tk & 7) * 2 + vb, smem); continue; } tk -= Q_NA;
    if (tk < Q_DENSE) { dense_task(p, tk >> 4, (tk >> 1) & 7, (tk & 1) * 2 + vb, smem); continue; } tk -= Q_DENSE;
    retstate_task(p, l, tk >> 2, (tk & 3) * 2 + vb, smem);
  }
}

__device__ void phase_rwkv_post(const P& p, int l, char* smem) {
  const bf16_t* zr = (const bf16_t*)(p.ws + WS_ZR); const float* yf = (const float*)(p.ws + WS_Y); const float* yb = yf + (size_t)MT * 512; bf16_t* oa = (bf16_t*)(p.ws + WS_OA);
  const bf16_t* Gt = (const bf16_t*)(p.ws + WS_WG);
  const int tid = ptid(), lane = tid & 63, wave = tid >> 6, wr = wave >> 2, wc = wave & 3, fr = lane & 15, fq = lane >> 4;
  TileIter ti; int mt, nt; ti.init(96, 2);
  while (ti.next(mt, nt)) {
    const int row0 = mt * 128, n0 = nt * 256;
    f32x4 acc[4][4]; zero_acc<4, 4>(acc);
    TileSrc s{zr + 1664, NZR, row0, Gt, LDG, n0, n0 + 128, 128}; gemm_tile<4, 4>(acc, s, smem);
    const int cb = n0 + wc * 64 + fq * 4;
#pragma unroll
    for (int m = 0; m < 4; ++m) { const size_t row = (size_t)(row0 + wr * 64 + m * 16 + fr);
      f32x4 y[4]; float s1 = 0.f, rk = 0.f; f32x4 vv[4];
#pragma unroll
      for (int n = 0; n < 4; ++n) { const int c = cb + n * 16; y[n] = *(const f32x4*)(yf + row * 512 + c) + *(const f32x4*)(yb + row * 512 + c); s1 += y[n][0] + y[n][1] + y[n][2] + y[n][3];
        const u32x2 rr = *(const u32x2*)(zr + row * NZR + c), kk = *(const u32x2*)(zr + row * NZR + 512 + c), v2 = *(const u32x2*)(zr + row * NZR + 1024 + c); const f32x4 rkw = *(const f32x4*)(p.rwkv_r_k + l * 512 + c);
        rk += bflo(rr.x) * bflo(kk.x) * rkw[0] + bfhi(rr.x) * bfhi(kk.x) * rkw[1] + bflo(rr.y) * bflo(kk.y) * rkw[2] + bfhi(rr.y) * bfhi(kk.y) * rkw[3];
        vv[n] = (f32x4){bflo(v2.x), bfhi(v2.x), bflo(v2.y), bfhi(v2.y)}; }
      s1 += shfl_x(s1, 16); s1 += shfl_x(s1, 32); rk += shfl_x(rk, 16); rk += shfl_x(rk, 32);
      const float mu = s1 * (1.f / 64.f); float s2 = 0.f;
#pragma unroll
      for (int n = 0; n < 4; ++n)
#pragma unroll
        for (int j = 0; j < 4; ++j) { const float dl = y[n][j] - mu; s2 += dl * dl; }
      s2 += shfl_x(s2, 16); s2 += shfl_x(s2, 32); const float rstd = rsqrtf(s2 * (1.f / 64.f) + 64e-5f);
#pragma unroll
      for (int n = 0; n < 4; ++n) { const int c = cb + n * 16; const f32x4 lg = *(const f32x4*)(p.rwkv_ln_g + l * 512 + c), lb = *(const f32x4*)(p.rwkv_ln_b + l * 512 + c);
        float o[4];
#pragma unroll
        for (int j = 0; j < 4; ++j) o[j] = ((y[n][j] - mu) * rstd * lg[j] + lb[j] + rk * vv[n][j]) * acc[m][n][j];
        u32x2 ov; ov.x = pack2(o[0], o[1]); ov.y = pack2(o[2], o[3]); *(u32x2*)(oa + row * LDO + c) = ov; }
    }
  }
}

DI void convert_layer_a(const P& p, int l, char* smem) {
  convert_T(p.w_in + (size_t)l * D * INC, D, INC, (bf16_t*)(p.ws + WS_WIN), LDH, smem);
  convert_T(p.w_o_rwkv + (size_t)l * 512 * D, 512, D, (bf16_t*)(p.ws + WS_WO3), LDO, smem);
  convert_T(p.w_o_na + (size_t)l * 512 * D, 512, D, (bf16_t*)(p.ws + WS_WO3) + (size_t)1024 * LDO, LDO, smem);
  convert_T(p.w_o_ret + (size_t)l * 512 * D, 512, D, (bf16_t*)(p.ws + WS_WO3) + (size_t)2 * 1024 * LDO, LDO, smem);
  convert_T(p.w_out + (size_t)l * D * D, D, D, (bf16_t*)(p.ws + WS_WOUT), LDH, smem);
  convert_T(p.rwkv_g_up + (size_t)l * 128 * 512, 128, 512, (bf16_t*)(p.ws + WS_WG), LDG, smem);
}
DI void convert_layer_b(const P& p, int l, char* smem) {
  convert_T(p.ffn_up + (size_t)l * D * 2 * FF, D, 2 * FF, (bf16_t*)(p.ws + WS_WUP), LDH, smem);
  convert_T(p.ffn_down + (size_t)l * FF * D, FF, D, (bf16_t*)(p.ws + WS_WDN), FF, smem);
}

typedef __attribute__((address_space(4))) const P* KP;
DI KP kargs() { KP k = (KP)__builtin_amdgcn_kernarg_segment_ptr(); asm volatile("" : "+s"(k)); return k; }
template <int PH> DI void run_phase(int l, char* smem) {
#if defined(__HIP_DEVICE_COMPILE__)
  const P p = *kargs();
#else
  const P p{};
#endif
  const float* mod = (const float*)(p.ws + WS_MOD);
  float* xbuf = p.out;
  if (PH == 0) { ada_phase(p, smem); convert_layer_a(p, 0, smem); }
  else if (PH == 1) { norm_phase(p, nullptr, nullptr, nullptr, nullptr, 0, nullptr, p.norm_mix_pre, mod, 0, (bf16_t*)(p.ws + WS_H)); }
  else if (PH == 2) phase_win(p, l, smem);
  else if (PH == 4) phase_mixers<7>(p, l, smem);
  else if (PH == 5) phase_rwkv_post(p, l, smem);
  else if (PH == 6) phase_merge(p, smem);
  else if (PH == 7) { phase_gemm_f32((const bf16_t*)(p.ws + WS_MERGED), LDH, D, (const bf16_t*)(p.ws + WS_WOUT), LDH, (float*)(p.ws + WS_U), smem); }
  else if (PH == 8) { convert_layer_b(p, l, smem);
    norm_phase(p, l == 0 ? nullptr : xbuf, (const float*)(p.ws + WS_U), p.norm_mix_post + l * D, mod + (size_t)l * 5 * 6144, 2, xbuf, p.norm_ffn_pre + l * D, mod + (size_t)l * 5 * 6144, 3, (bf16_t*)(p.ws + WS_H)); }
  else if (PH == 9) phase_ffn_up(p, l, smem);
  else if (PH == 11) { phase_gemm_f32((const bf16_t*)(p.ws + WS_HID), FF, FF, (const bf16_t*)(p.ws + WS_WDN), FF, (float*)(p.ws + WS_F), smem); }
  else if (PH == 12) {
    if (l == 0) { norm_phase(p, xbuf, (const float*)(p.ws + WS_F), p.norm_ffn_post, mod, 5, xbuf, p.norm_mix_pre + D, mod + (size_t)5 * 6144, 0, (bf16_t*)(p.ws + WS_H)); convert_layer_a(p, 1, smem); }
    else norm_phase(p, xbuf, (const float*)(p.ws + WS_F), p.norm_ffn_post + D, mod + (size_t)5 * 6144, 5, xbuf, nullptr, nullptr, 0, nullptr);
  }
}

#if MEGA
__global__ void __launch_bounds__(NTP, 1) mega_kernel(P p_) {
  extern __shared__ __attribute__((aligned(16))) char smem[];
  __shared__ u32x4 xb_words;
  cg::grid_group grid = cg::this_grid();
  if (ptid() == 0) xb_words = (u32x4){0u, 0u, 0u, 0u};
  __syncthreads();
#if defined(__HIP_DEVICE_COMPILE__)
  (void)xcd_barrier_post((unsigned*)(p_.ws + WS_BAR), (volatile LAS unsigned*)&xb_words);
#define GSYNC() do { XcdBarrier xb_; xb_.bar = (unsigned*)(kargs()->ws + WS_BAR); xb_.x = xb_xcc_id(); xb_.st = (volatile LAS unsigned*)&xb_words; xcd_barrier(xb_); } while (0)
#else
#define GSYNC() do { } while (0)
#endif
  run_phase<0>(0, smem); grid.sync();
  run_phase<1>(0, smem); GSYNC();
#pragma unroll
  for (int l = 0; l < 2; ++l) {
    run_phase<2>(l, smem); GSYNC();
    if (PROBE_MASK & 1) { run_phase<2>(l, smem); GSYNC(); }
    run_phase<4>(l, smem); GSYNC();
    run_phase<5>(l, smem); GSYNC();
    run_phase<6>(l, smem); GSYNC();
    if (PROBE_MASK & 8) { run_phase<6>(l, smem); GSYNC(); }
    run_phase<7>(l, smem); GSYNC();
    if (PROBE_MASK & 16) { run_phase<7>(l, smem); GSYNC(); }
    run_phase<8>(l, smem); GSYNC();
    run_phase<9>(l, smem); GSYNC();
    if (PROBE_MASK & 32) { run_phase<9>(l, smem); GSYNC(); }
    run_phase<11>(l, smem); GSYNC();
    if (PROBE_MASK & 64) { run_phase<11>(l, smem); GSYNC(); }
    run_phase<12>(l, smem); if (l == 0) GSYNC();
  }
#undef GSYNC
}
#else
template <int PH> __global__ void __launch_bounds__(NTP, 1) phase_kernel(P p, int l) {
  extern __shared__ __attribute__((aligned(16))) char smem[];
  run_phase<PH>(l, smem);
}
#endif

extern "C" void kernel_launch(void* const* d_in, const int* in_sizes, int n_in, void* d_out, int out_size, void* d_ws, size_t ws_size, hipStream_t stream) {
  if (ws_size < WS_END || n_in < 36) { fprintf(stderr, "workspace too small: %zu < %zu\n", ws_size, (size_t)WS_END); return; }
  P p{};
  const float** pp = (const float**)&p;
  for (int i = 0; i < 36; ++i) pp[i] = (const float*)d_in[i];
  p.out = (float*)d_out; p.ws = (char*)d_ws;
  hipMemsetAsync(d_ws, 0, WS_WIN, stream);
#if MEGA
  static int grid_blocks = 0;
  if (!grid_blocks) {
    int dev = 0, cus = 0, per_cu = 0; hipGetDevice(&dev);
    hipDeviceGetAttribute(&cus, hipDeviceAttributeMultiprocessorCount, dev);
    hipFuncSetAttribute((const void*)mega_kernel, hipFuncAttributeMaxDynamicSharedMemorySize, SMEM_BYTES);
    hipOccupancyMaxActiveBlocksPerMultiprocessor(&per_cu, mega_kernel, NTP, SMEM_BYTES);
    if (per_cu > 1) per_cu = 1;
    grid_blocks = cus * per_cu;
  }
  void* args[] = {&p};
  hipError_t e = hipLaunchCooperativeKernel((void*)mega_kernel, dim3(grid_blocks), dim3(NTP), args, SMEM_BYTES, stream);
  if (e != hipSuccess) fprintf(stderr, "cooperative launch failed: %s (grid %d)\n", hipGetErrorString(e), grid_blocks);
#else
  const int G = 512;
#define LAUNCH(PH, L) do { hipFuncSetAttribute((const void*)phase_kernel<PH>, hipFuncAttributeMaxDynamicSharedMemorySize, SMEM_BYTES); phase_kernel<PH><<<G, NT, SMEM_BYTES, stream>>>(p, L); } while (0)
  LAUNCH(0, 0); LAUNCH(1, 0);
  for (int l = 0; l < 2; ++l) { LAUNCH(2, l); LAUNCH(4, l); LAUNCH(5, l); LAUNCH(6, l); LAUNCH(7, l); LAUNCH(8, l); LAUNCH(9, l); LAUNCH(11, l); LAUNCH(12, l); }
#endif
}
```

```cpp
#include <hip/hip_runtime.h>
#include <hip/hip_cooperative_groups.h>
#include <cstdio>
namespace cg = cooperative_groups;

#ifndef MEGA
#define MEGA 1
#endif
#define PROBE_MASK 0

typedef unsigned short bf16_t;
typedef short bf16x8 __attribute__((ext_vector_type(8)));
typedef short bf16x4 __attribute__((ext_vector_type(4)));
typedef float f32x4 __attribute__((ext_vector_type(4)));
typedef float f32x2 __attribute__((ext_vector_type(2)));
typedef unsigned u32x4 __attribute__((ext_vector_type(4)));
typedef unsigned u32x2 __attribute__((ext_vector_type(2)));
#define DI __device__ __forceinline__
#define MFMA16(a, b, c) __builtin_amdgcn_mfma_f32_16x16x32_bf16((a), (b), (c), 0, 0, 0)

constexpr int NT = 256;
constexpr int NTP = 512;
constexpr int VSMEM = 65536;
constexpr int D = 1024, MC = 8192, ML = 4096, MT = 12288;
constexpr int NZR = 1792, NZN = 1536, NZT = 2048, INC = 8448, FF = 2816;
constexpr int LDH = 1088, LDO = 576, LZT = 2112, LDG = 136;
constexpr int LDT = 72;
constexpr int SMEM_BYTES = 131072;
constexpr size_t O_K = 12582912, O_V = 20971520, O_RW = 29360128, O_RT = 33554432;
constexpr size_t WS_CTRL = 0;
constexpr size_t WS_MOD = 4096;
constexpr size_t WS_BAR = 262144;
constexpr size_t WS_CUF = 278528;
constexpr size_t WS_WG = 294912;
constexpr size_t WS_WIN = 434176;
constexpr size_t WS_WUP = WS_WIN;
constexpr size_t WS_WDN = WS_WIN + (size_t)5632 * LDH * 2;
constexpr size_t WS_WO3 = WS_WIN + (size_t)INC * LDH * 2;
constexpr size_t WS_WOUT = WS_WO3 + (size_t)3 * 1024 * LDO * 2;
constexpr size_t WS_H = WS_WOUT + (size_t)1024 * LDH * 2;
constexpr size_t WS_Z = WS_H + (size_t)MT * LDH * 2;
constexpr size_t WS_ZR = WS_Z;
constexpr size_t WS_ZN = WS_ZR + (size_t)MT * NZR * 2;
constexpr size_t WS_ZT = WS_ZN + (size_t)MT * NZN * 2;
constexpr size_t WS_MERGED = WS_ZR;
constexpr size_t WS_OA = WS_ZN;
constexpr size_t WS_U = WS_ZT;
constexpr size_t WS_HID = WS_Z;
constexpr size_t WS_F = WS_ZT;
constexpr size_t WS_Y = WS_ZT + (size_t)MT * LZT * 2;
constexpr size_t WS_ONA = WS_Y + (size_t)2 * MT * 512 * 4;
constexpr size_t WS_ORET = WS_ONA + (size_t)MT * LDO * 2;
constexpr size_t WS_END = WS_ORET + (size_t)MT * LDO * 2;

struct P {
  const float *x_prompt, *x_sample, *cache_k, *cache_v, *state_rwkv, *state_ret, *c, *c_ctx, *ada_w, *ada_b;
  const float *norm_mix_pre, *norm_mix_post, *norm_ffn_pre, *norm_ffn_post, *w_in, *rwkv_conv, *rwkv_w0, *rwkv_w_up, *rwkv_a0, *rwkv_a_up, *rwkv_g_up;
  const float *rwkv_k_k, *rwkv_k_a, *rwkv_r_k, *rwkv_ln_g, *rwkv_ln_b, *na_rpb, *ret_decay, *ret_gn, *w_o_rwkv, *w_o_na, *w_o_ret, *w_out, *ffn_up, *ffn_conv, *ffn_down;
  float* out; char* ws;
};

DI int threadIdx_x_raw() { return (int)__builtin_amdgcn_workitem_id_x(); }
DI int ptid() { int t = threadIdx_x_raw(); asm volatile("" : "+v"(t)); return t; }
DI int tidx() { return ptid() & 255; }
DI int vhalf() { return ptid() >> 8; }
DI int vblk() { return (int)blockIdx.x * 2 + vhalf(); }
DI int vgrid() { return (int)gridDim.x * 2; }
DI unsigned cvt_pk_bf16(float lo, float hi) { unsigned r; asm("v_cvt_pk_bf16_f32 %0, %1, %2" : "=v"(r) : "v"(lo), "v"(hi)); return r; }
DI bf16_t f2bf(float x) { return (bf16_t)(cvt_pk_bf16(x, 0.f) & 0xffffu); }
DI float bf2f(bf16_t b) { return __uint_as_float(((unsigned)b) << 16); }
DI unsigned pack2(float a, float b) { return cvt_pk_bf16(a, b); }
DI float bflo(unsigned u) { return __uint_as_float(u << 16); }
DI float bfhi(unsigned u) { return __uint_as_float(u & 0xffff0000u); }
DI void unpack8(const u32x4 r, float (&f)[8]) { f[0] = bflo(r[0]); f[1] = bfhi(r[0]); f[2] = bflo(r[1]); f[3] = bfhi(r[1]); f[4] = bflo(r[2]); f[5] = bfhi(r[2]); f[6] = bflo(r[3]); f[7] = bfhi(r[3]); }
DI u32x4 pack8(const float (&f)[8]) { u32x4 r; r[0] = pack2(f[0], f[1]); r[1] = pack2(f[2], f[3]); r[2] = pack2(f[4], f[5]); r[3] = pack2(f[6], f[7]); return r; }
DI float sigmoidf_(float x) { return 1.f / (1.f + __expf(-x)); }
DI float shfl_x(float v, int m) { const int lane = ptid() & 63; return __int_as_float(__builtin_amdgcn_ds_bpermute((lane ^ m) << 2, __float_as_int(v))); }
DI float wave_sum(float v) { for (int o = 32; o > 0; o >>= 1) v += shfl_x(v, o); return v; }
DI void tokinfo(int m, int& t, int& T, int& mi) { if (m < MC) { t = m & 255; T = 256; mi = 0; } else { int q = m - MC; t = q & 1023; T = 1024; mi = 1 + (q >> 10); } }

#define XB_TMO      128
#define XB_XCNT(j)  (256  + 64 * (j))
#define XB_XSUB(j)  (1280 + 64 * (j))
#define XB_XGEN(j)  (2304 + 64 * (j))
#define XB_TOP      3328
#define XB_TOPGEN   3392
#define XB_SPIN_CAP (1u << 20)
#define LAS __attribute__((address_space(3)))
DI unsigned xb_ld(unsigned* p) { return __hip_atomic_load(p, __ATOMIC_RELAXED, __HIP_MEMORY_SCOPE_AGENT); }
DI unsigned xb_add(unsigned* p, unsigned v) { return __hip_atomic_fetch_add(p, v, __ATOMIC_RELAXED, __HIP_MEMORY_SCOPE_AGENT); }
DI unsigned xb_xcc_id() { return (unsigned)__builtin_amdgcn_s_getreg((3 << 11) | 20) & 0xFu; }
#define XB_SPIN(cond, bar) do { unsigned _sp = 0; while (cond) { __builtin_amdgcn_s_sleep(1); \
    if ((++_sp & 255u) == 0u) { if (xb_ld(&(bar)[XB_TMO])) break; if (_sp > XB_SPIN_CAP) { atomicAdd(&(bar)[XB_TMO], 1u); break; } } } } while (0)
struct XcdBarrier { unsigned* bar; unsigned x; volatile LAS unsigned* st; };
DI XcdBarrier xcd_barrier_post(unsigned* bar, volatile LAS unsigned* st) {
  XcdBarrier b; b.bar = bar; b.x = xb_xcc_id(); b.st = st;
  if (ptid() == 0) (void)xb_add(&bar[XB_XCNT(b.x)], 1u);
  return b;
}
DI void xcd_barrier_complete(unsigned* bar, unsigned x, unsigned& nloc, unsigned& nx) {
  const unsigned G = gridDim.x * gridDim.y * gridDim.z;
  unsigned sum, cnt, mine, sp = 0u;
  for (;;) {
    sum = 0u; cnt = 0u; mine = 0u;
#pragma unroll
    for (unsigned j = 0; j < 16; ++j) { const unsigned c = xb_ld(&bar[XB_XCNT(j)]); sum += c; cnt += (c > 0u) ? 1u : 0u; mine = (j == x) ? c : mine; }
    if (sum == G) break;
    __builtin_amdgcn_s_sleep(1);
    if ((++sp & 255u) == 0u) { if (xb_ld(&bar[XB_TMO])) break; if (sp > XB_SPIN_CAP) { atomicAdd(&bar[XB_TMO], 1u); break; } }
  }
  nloc = mine > 0u ? mine : 1u; nx = cnt > 0u ? cnt : 1u;
}
DI void xcd_barrier(const XcdBarrier& b) {
  asm volatile("s_waitcnt vmcnt(0)" ::: "memory");
  __syncthreads();
  if (ptid() == 0) {
    unsigned* bar = b.bar;
    __builtin_amdgcn_s_waitcnt(0);
    unsigned nloc = b.st[0], nx = b.st[1];
    if (nloc == 0u) { xcd_barrier_complete(bar, b.x, nloc, nx); b.st[0] = nloc; b.st[1] = nx; }
    const unsigned old = xb_add(&bar[XB_XSUB(b.x)], 1u);
    const unsigned gen = old / nloc;
    if (old + 1u == (gen + 1u) * nloc) {
      __builtin_amdgcn_fence(__ATOMIC_RELEASE, "agent");
      asm volatile("s_waitcnt vmcnt(0)" ::: "memory");
      const unsigned og = xb_add(&bar[XB_TOP], 1u);
      const unsigned tg = og / nx;
      if (og + 1u == (tg + 1u) * nx) xb_add(&bar[XB_TOPGEN], 1u);
      else XB_SPIN(xb_ld(&bar[XB_TOPGEN]) == tg, bar);
      __builtin_amdgcn_fence(__ATOMIC_ACQUIRE, "agent");
      xb_add(&bar[XB_XGEN(b.x)], 1u);
      asm volatile("s_waitcnt vmcnt(0)" ::: "memory");
    } else {
      XB_SPIN(xb_ld(&bar[XB_XGEN(b.x)]) == gen, bar);
      __builtin_amdgcn_fence(__ATOMIC_ACQUIRE, "agent");
      asm volatile("s_waitcnt vmcnt(0)" ::: "memory");
    }
  }
  __syncthreads();
}

__device__ void convert_T(const float* __restrict__ W, int K, int N, bf16_t* __restrict__ Wt, int ldt, char* smem) {
  float* t = (float*)(smem + vhalf() * VSMEM);
  const int tid = tidx(), ntn = N >> 6, nitems = (K >> 6) * ntn;
  const int kr = tid >> 4, c4 = (tid & 15) * 4;
  f32x4 v[4];
  { const int it = vblk() < nitems ? vblk() : 0; const int k0 = (it / ntn) << 6, n0 = (it % ntn) << 6;
#pragma unroll
    for (int i = 0; i < 4; ++i) v[i] = *(const f32x4*)(W + (size_t)(k0 + kr + 16 * i) * N + n0 + c4); }
  for (int it = vblk(); it < nitems; it += vgrid()) {
    const int k0 = (it / ntn) << 6, n0 = (it % ntn) << 6;
    __syncthreads();
#pragma unroll
    for (int i = 0; i < 4; ++i) { const int k = kr + 16 * i; t[k * 65 + c4] = v[i][0]; t[k * 65 + c4 + 1] = v[i][1]; t[k * 65 + c4 + 2] = v[i][2]; t[k * 65 + c4 + 3] = v[i][3]; }
    __syncthreads();
    { const int itn = it + vgrid() < nitems ? it + vgrid() : it; const int k1 = (itn / ntn) << 6, n1 = (itn % ntn) << 6;
#pragma unroll
      for (int i = 0; i < 4; ++i) v[i] = *(const f32x4*)(W + (size_t)(k1 + kr + 16 * i) * N + n1 + c4); }
#pragma unroll
    for (int i = 0; i < 2; ++i) { const int c = tid + 256 * i, n = c >> 3, kc = c & 7; float f[8];
#pragma unroll
      for (int e = 0; e < 8; ++e) f[e] = t[(kc * 8 + e) * 65 + n];
      *(u32x4*)(Wt + (size_t)(n0 + n) * ldt + k0 + kc * 8) = pack8(f); }
  }
}

__device__ void ada_phase(const P& p, char* smem) {
  float* sc = (float*)(smem + vhalf() * VSMEM);
  float* red = sc + 640;
  float* mod = (float*)(p.ws + WS_MOD);
  const int tid = tidx(), kq = tid >> 5, cq = tid & 31;
  for (int it = vblk(); it < 2 * 48 * 8; it += vgrid()) {
    const int l = it / 384, rem = it % 384, nb = rem >> 3, ks = rem & 7;
    const int n0 = nb * 128, k0 = ks * 128;
    __syncthreads();
    for (int e = tid; e < 640; e += NT) { const int i = e >> 7, k = e & 127; const float v = (i == 0) ? p.c_ctx[k0 + k] : p.c[(i - 1) * D + k0 + k]; sc[e] = v * sigmoidf_(v); }
    __syncthreads();
    float acc[5][4];
#pragma unroll
    for (int i = 0; i < 5; ++i)
#pragma unroll
      for (int j = 0; j < 4; ++j) acc[i][j] = 0.f;
    const float* wp = p.ada_w + ((size_t)l * D + k0 + kq * 16) * 6144 + n0 + cq * 4;
#pragma unroll 4
    for (int kk = 0; kk < 16; ++kk) { const float4 w = *(const float4*)(wp + (size_t)kk * 6144);
#pragma unroll
      for (int i = 0; i < 5; ++i) { const float s = sc[i * 128 + kq * 16 + kk]; acc[i][0] += s * w.x; acc[i][1] += s * w.y; acc[i][2] += s * w.z; acc[i][3] += s * w.w; } }
#pragma unroll
    for (int i = 0; i < 5; ++i)
#pragma unroll
      for (int j = 0; j < 4; ++j) red[(kq * 5 + i) * 128 + cq * 4 + j] = acc[i][j];
    __syncthreads();
    for (int e = tid; e < 640; e += NT) { const int i = e >> 7, n = e & 127; float s = 0.f;
#pragma unroll
      for (int q = 0; q < 8; ++q) s += red[(q * 5 + i) * 128 + n];
      if (ks == 0) s += p.ada_b[l * 6144 + n0 + n];
      atomicAdd(mod + ((size_t)l * 5 + i) * 6144 + n0 + n, s); }
  }
}

__device__ void norm_phase(const P& p, const float* xin  , const float* u, const float* gpost, const float* modU, int gate_idx,
                           float* xout, const float* gpre, const float* modN, int shift_idx, bf16_t* hout) {
  const int lane = tidx() & 63, wave = tidx() >> 6, nw = NT / 64;
  for (int m = vblk() * nw + wave; m < MT; m += vgrid() * nw) {
    int t, T, mi; tokinfo(m, t, T, mi);
    const float* xr = xin ? xin + (size_t)m * D : (m < MC ? p.x_prompt + (size_t)m * D : p.x_sample + (size_t)(m - MC) * D);
    float4 x[4];
#pragma unroll
    for (int i = 0; i < 4; ++i) x[i] = *(const float4*)(xr + i * 256 + lane * 4);
    if (u) {
      float4 uu[4]; float ss = 0.f;
#pragma unroll
      for (int i = 0; i < 4; ++i) { uu[i] = *(const float4*)(u + (size_t)m * D + i * 256 + lane * 4); ss += uu[i].x * uu[i].x + uu[i].y * uu[i].y + uu[i].z * uu[i].z + uu[i].w * uu[i].w; }
      ss = wave_sum(ss); const float rs = rsqrtf(ss * (1.f / D) + 1e-6f);
#pragma unroll
      for (int i = 0; i < 4; ++i) { const int c = i * 256 + lane * 4; const float4 g = *(const float4*)(gpost + c); const float4 ga = *(const float4*)(modU + ((size_t)mi * 6 + gate_idx) * D + c);
        x[i].x += ga.x * uu[i].x * rs * g.x; x[i].y += ga.y * uu[i].y * rs * g.y; x[i].z += ga.z * uu[i].z * rs * g.z; x[i].w += ga.w * uu[i].w * rs * g.w; }
    }
    if (xout) {
#pragma unroll
      for (int i = 0; i < 4; ++i) *(float4*)(xout + (size_t)m * D + i * 256 + lane * 4) = x[i];
    }
    if (hout) {
      float ss = 0.f;
#pragma unroll
      for (int i = 0; i < 4; ++i) ss += x[i].x * x[i].x + x[i].y * x[i].y + x[i].z * x[i].z + x[i].w * x[i].w;
      ss = wave_sum(ss); const float rs = rsqrtf(ss * (1.f / D) + 1e-6f);
#pragma unroll
      for (int i = 0; i < 4; ++i) { const int c = i * 256 + lane * 4; const float4 g = *(const float4*)(gpre + c);
        const float4 sh = *(const float4*)(modN + ((size_t)mi * 6 + shift_idx) * D + c); const float4 sc = *(const float4*)(modN + ((size_t)mi * 6 + shift_idx + 1) * D + c);
        u32x2 o; o.x = pack2(x[i].x * rs * g.x * (1.f + sc.x) + sh.x, x[i].y * rs * g.y * (1.f + sc.y) + sh.y); o.y = pack2(x[i].z * rs * g.z * (1.f + sc.z) + sh.z, x[i].w * rs * g.w * (1.f + sc.w) + sh.w);
        *(u32x2*)(hout + (size_t)m * LDH + c) = o; }
    }
  }
}

struct TileSrc { const bf16_t* A; int lda; int arow0; const bf16_t* B; int ldb; int brow0, brow1; int K; };

template <int MM, int NN> DI void zero_acc(f32x4 (&acc)[MM][NN]) {
#pragma unroll
  for (int m = 0; m < MM; ++m)
#pragma unroll
    for (int n = 0; n < NN; ++n) acc[m][n] = (f32x4){0.f, 0.f, 0.f, 0.f};
}

template <int MM, int NN> struct Gemm {
  static constexpr int NA = MM / 2, NB = NN;
  unsigned oa_[NA], ob_[NB]; const bf16_t* A; const bf16_t* B; int nk; u32x4 ra[NA], rb[NB];
#define GT_LOAD(KT) do { const int kn_ = ((KT) < nk ? (KT) : nk - 1) * 64; \
    _Pragma("unroll") for (int i = 0; i < NA; ++i) ra[i] = *(const u32x4*)(A + (oa_[i] + kn_)); \
    _Pragma("unroll") for (int i = 0; i < NB; ++i) rb[i] = *(const u32x4*)(B + (ob_[i] + kn_)); } while (0)
  DI void begin(const TileSrc& s) {
    const int tid = ptid();
#pragma unroll
    for (int i = 0; i < NA; ++i) { const int row = (tid >> 3) + 64 * i, kc = tid & 7;
      int ar = s.arow0 + row; ar = ar < 0 ? 0 : (ar > MT - 1 ? MT - 1 : ar);
      oa_[i] = (unsigned)ar * (unsigned)s.lda + kc * 8; }
#pragma unroll
    for (int i = 0; i < NB; ++i) { const int row = (tid >> 3) + 64 * i, kc = tid & 7;
      const int br = row < 32 * NN ? s.brow0 + row : s.brow1 + row - 32 * NN;
      ob_[i] = (unsigned)br * (unsigned)s.ldb + kc * 8; }
    A = s.A; B = s.B; nk = s.K >> 6;
    GT_LOAD(0);
  }
  DI void run(f32x4 (&acc)[MM][NN], char* smem) {
    bf16_t* sbase = (bf16_t*)smem;
    const int tid = ptid(), lane = tid & 63, wave = tid >> 6, wr = wave >> 2, wc = wave & 3, fr = lane & 15, fq = lane >> 4;
    int wofs; { const int r = tid >> 3, kc = tid & 7, ob = (r & 15) * 64 + (kc & 3) * 16; wofs = (((r >> 4) * 2 + (kc >> 2)) * 1024 + (ob ^ (((ob >> 9) & 1) << 5))) >> 1; }
    int robase; { const int ob = fr * 64 + fq * 16; robase = (ob ^ (((ob >> 9) & 1) << 5)) >> 1; }
#define GT_STORE(ST) do { bf16_t* sA_ = sbase + (ST) * 32768; bf16_t* sB_ = sA_ + 16384; \
    _Pragma("unroll") for (int i = 0; i < NA; ++i) *(u32x4*)(sA_ + wofs + i * 4096) = ra[i]; \
    _Pragma("unroll") for (int i = 0; i < NB; ++i) *(u32x4*)(sB_ + wofs + i * 4096) = rb[i]; } while (0)
#define GT_COMPUTE(ST) do { const bf16_t* sA_ = sbase + (ST) * 32768 + robase; const bf16_t* sB_ = sA_ + 16384; __builtin_amdgcn_s_setprio(1); \
    _Pragma("unroll 1") for (int ks = 0; ks < 2; ++ks) { bf16x8 bfr[NN]; \
      _Pragma("unroll") for (int n = 0; n < NN; ++n) bfr[n] = *(const bf16x8*)(sB_ + ((wc * NN + n) * 2 + ks) * 512); \
      _Pragma("unroll") for (int m = 0; m < MM; ++m) { const bf16x8 af = *(const bf16x8*)(sA_ + ((wr * MM + m) * 2 + ks) * 512); \
        _Pragma("unroll") for (int n = 0; n < NN; ++n) acc[m][n] = MFMA16(bfr[n], af, acc[m][n]); } } __builtin_amdgcn_s_setprio(0); } while (0)
    __syncthreads();
    GT_STORE(0);
    GT_LOAD(1);
    __syncthreads();
#pragma unroll 1
    for (int kt = 0; kt < nk; kt += 2) {
      GT_STORE(1); GT_LOAD(kt + 2); GT_COMPUTE(0); __syncthreads();
      GT_STORE(0); GT_LOAD(kt + 3); GT_COMPUTE(1); __syncthreads();
    }
  }
#undef GT_LOAD
#undef GT_STORE
#undef GT_COMPUTE
};
template <int MM, int NN> DI void gemm_tile(f32x4 (&acc)[MM][NN], const TileSrc& s, char* smem) { Gemm<MM, NN> g; g.begin(s); g.run(acc, smem); }

DI float gelu_tanh(float x) { const float u = 0.7978845608f * (x + 0.044715f * x * x * x); const float e = __expf(2.f * u); const float th = 1.f - 2.f / (e + 1.f); return 0.5f * x * (1.f + th); }

struct TileIter {
  int m_lo, rows, NTn, G, efull, count, e, stride;
  DI void init(int MTn, int NTn_) { const int x = blockIdx.x & 7; m_lo = (x * MTn) >> 3; rows = (((x + 1) * MTn) >> 3) - m_lo; NTn = NTn_; G = (rows + 1) >> 1;
    efull = (rows / G) * G * NTn; count = rows * NTn; e = blockIdx.x >> 3; stride = gridDim.x >> 3; }
  DI bool next(int& mt, int& nt) { if (e >= count) return false;
    if (e < efull) { const int grp = e / (G * NTn), rem = e - grp * G * NTn; nt = rem / G; mt = m_lo + grp * G + (rem - nt * G); }
    else { const int rem = e - efull, gsz = rows - (rows / G) * G; nt = rem / gsz; mt = m_lo + (rows / G) * G + (rem - nt * gsz); }
    e += stride; return true; }
};

__device__ void phase_win(const P& p, int l, char* smem) {
  const bf16_t* H = (const bf16_t*)(p.ws + WS_H); const bf16_t* Wt = (const bf16_t*)(p.ws + WS_WIN);
  bf16_t* zr = (bf16_t*)(p.ws + WS_ZR); bf16_t* zn = (bf16_t*)(p.ws + WS_ZN); bf16_t* zt = (bf16_t*)(p.ws + WS_ZT);
  const int tid = ptid(), lane = tid & 63, wave = tid >> 6, wr = wave >> 2, wc = wave & 3, fr = lane & 15, fq = lane >> 4;
  Gemm<8, 4> gm;
  TileIter ti; ti.init(48, 14);
  const int x = blockIdx.x & 7, nconv = (343 - x + 7) >> 3, nloc = ti.count + nconv;
  const float* cw = p.rwkv_conv + (size_t)l * 3 * NZR;
  for (int e = (int)(blockIdx.x >> 3); e < nloc; e += (int)(gridDim.x >> 3)) {
    f32x4 acc[8][4]; zero_acc<8, 4>(acc);
    if (e < nconv) {
      const int c = x + 8 * e, mt = c / 7, nt = c - mt * 7;
      const int n0 = nt * 256, arow0 = mt * 254 - 1;
      { TileSrc s{H, LDH, arow0, Wt, LDH, n0, n0 + 128, D}; gm.begin(s); }
      gm.run(acc, smem);
      float* sC = (float*)smem;
#pragma unroll 1
      for (int sl = 0; sl < 4; ++sl) {
        __syncthreads();
        if (wc == sl) {
#pragma unroll
          for (int m = 0; m < 8; ++m)
#pragma unroll
            for (int n = 0; n < 4; ++n) *(f32x4*)(sC + (wr * 128 + m * 16 + fr) * 68 + n * 16 + fq * 4) = acc[m][n];
        }
        __syncthreads();
        const int nb = n0 + sl * 64, c4 = (tid & 15) * 4;
        const float4 w0 = *(const float4*)(cw + nb + c4), w1 = *(const float4*)(cw + NZR + nb + c4), w2 = *(const float4*)(cw + 2 * NZR + nb + c4);
        for (int ee = tid; ee < 254 * 16; ee += NTP) {
          const int tr = 1 + (ee >> 4), g = arow0 + tr;
          if (g < MT) { int t, T, mi; tokinfo(g, t, T, mi);
            const float pm = t > 0 ? 1.f : 0.f, nm = t < T - 1 ? 1.f : 0.f;
            const f32x4 a = *(const f32x4*)(sC + (tr - 1) * 68 + c4), b = *(const f32x4*)(sC + tr * 68 + c4), cc = *(const f32x4*)(sC + (tr + 1) * 68 + c4);
            float r0 = pm * a[0] * w0.x + b[0] * w1.x + nm * cc[0] * w2.x, r1 = pm * a[1] * w0.y + b[1] * w1.y + nm * cc[1] * w2.y;
            float r2 = pm * a[2] * w0.z + b[2] * w1.z + nm * cc[2] * w2.z, r3 = pm * a[3] * w0.w + b[3] * w1.w + nm * cc[3] * w2.w;
            if (nb >= 1664) { r0 = sigmoidf_(r0); r1 = sigmoidf_(r1); r2 = sigmoidf_(r2); r3 = sigmoidf_(r3); }
            u32x2 o; o.x = pack2(r0, r1); o.y = pack2(r2, r3);
            *(u32x2*)(zr + (size_t)g * NZR + nb + c4) = o; }
        }
      }
    } else {
      int mt, nt; ti.e = e - nconv; ti.next(mt, nt);
      const int n0 = nt * 256, row0 = mt * 256;
      { TileSrc s{H, LDH, row0, Wt, LDH, NZR + n0, NZR + n0 + 128, D}; gm.begin(s); }
      gm.run(acc, smem);
#pragma unroll
      for (int m = 0; m < 8; ++m) { const int row = row0 + wr * 128 + m * 16 + fr;
#pragma unroll
        for (int n = 0; n < 4; ++n) { const int col = n0 + wc * 64 + n * 16 + fq * 4; const f32x4 v = acc[m][n];
          u32x2 o; o.x = pack2(v[0], v[1]); o.y = pack2(v[2], v[3]);
          if (col < NZN) {
            *(u32x2*)(zn + (size_t)row * NZN + col) = o;
            if (row < MC && col >= 512) { const int part = col - 512, isv = part >> 9, pp = part & 511, hh = pp >> 6, d = pp & 63, b = row >> 8, t = row & 255;
              float* dst = p.out + (isv ? O_V : O_K) + ((((size_t)b * 2 + l) * 8 + hh) * 256 + t) * 64 + d; *(f32x4*)dst = v; }
          } else { *(u32x2*)(zt + (size_t)row * LZT + (col - NZN)) = o; }
        } }
    }
  }
}

__device__ void phase_merge(const P& p, char* smem) {
  const bf16_t* H = (const bf16_t*)(p.ws + WS_H); const bf16_t* Wt = (const bf16_t*)(p.ws + WS_WIN); const bf16_t* Wo3 = (const bf16_t*)(p.ws + WS_WO3);
  bf16_t* mg = (bf16_t*)(p.ws + WS_MERGED);
  const int tid = ptid(), lane = tid & 63, wave = tid >> 6, wr = wave >> 2, wc = wave & 3, fr = lane & 15, fq = lane >> 4;
  TileIter ti; int mt, nt; ti.init(96, 8);
  while (ti.next(mt, nt)) {
    const int n0 = nt * 128, row0 = mt * 128;
    f32x4 macc[4][2]; zero_acc<4, 2>(macc);
#pragma unroll 1
    for (int i = 0; i < 3; ++i) {
      const bf16_t* O = (const bf16_t*)(p.ws + (i == 0 ? WS_OA : (i == 1 ? WS_ONA : WS_ORET)));
      f32x4 g[4][2]; zero_acc<4, 2>(g);
      { TileSrc s{H, LDH, row0, Wt, LDH, 5376 + i * 1024 + n0, 5376 + i * 1024 + n0 + 64, D}; gemm_tile<4, 2>(g, s, smem); }
      f32x4 a2[4][2]; zero_acc<4, 2>(a2);
      { TileSrc s{O, LDO, row0, Wo3 + (size_t)i * 1024 * LDO, LDO, n0, n0 + 64, 512}; gemm_tile<4, 2>(a2, s, smem); }
#pragma unroll
      for (int m = 0; m < 4; ++m)
#pragma unroll
        for (int n = 0; n < 2; ++n)
#pragma unroll
          for (int j = 0; j < 4; ++j) macc[m][n][j] += sigmoidf_(g[m][n][j]) * a2[m][n][j];
    }
#pragma unroll
    for (int m = 0; m < 4; ++m) { const int row = row0 + wr * 64 + m * 16 + fr;
#pragma unroll
      for (int n = 0; n < 2; ++n) { const int col = n0 + wc * 32 + n * 16 + fq * 4; u32x2 o; o.x = pack2(macc[m][n][0], macc[m][n][1]); o.y = pack2(macc[m][n][2], macc[m][n][3]); *(u32x2*)(mg + (size_t)row * LDH + col) = o; } }
  }
}

__device__ void phase_gemm_f32(const bf16_t* A, int lda, int K, const bf16_t* Bt, int ldb, float* C, char* smem) {
  const int tid = ptid(), lane = tid & 63, wave = tid >> 6, wr = wave >> 2, wc = wave & 3, fr = lane & 15, fq = lane >> 4;
  TileIter ti; int mt, nt; ti.init(48, 4);
  while (ti.next(mt, nt)) {
    const int n0 = nt * 256, row0 = mt * 256;
    f32x4 acc[8][4]; zero_acc<8, 4>(acc);
    TileSrc s{A, lda, row0, Bt, ldb, n0, n0 + 128, K}; gemm_tile<8, 4>(acc, s, smem);
#pragma unroll
    for (int m = 0; m < 8; ++m) { const int row = row0 + wr * 128 + m * 16 + fr;
#pragma unroll
      for (int n = 0; n < 4; ++n) *(f32x4*)(C + (size_t)row * D + n0 + wc * 64 + n * 16 + fq * 4) = acc[m][n]; }
  }
}

__device__ void phase_ffn_up(const P& p, int l, char* smem) {
  const bf16_t* H = (const bf16_t*)(p.ws + WS_H); const bf16_t* Wt = (const bf16_t*)(p.ws + WS_WUP); bf16_t* hid = (bf16_t*)(p.ws + WS_HID);
  const int tid = ptid(), lane = tid & 63, wave = tid >> 6, wr = wave >> 2, wc = wave & 3, fr = lane & 15, fq = lane >> 4;
  const float* cw = p.ffn_conv + (size_t)l * 3 * 2 * FF;
  TileIter ti; int mt, nt; ti.init(49, 22);
  Gemm<8, 4> gm;
  while (ti.next(mt, nt)) {
    const int c0 = nt * 128, arow0 = mt * 254 - 1;
    f32x4 acc[8][4]; zero_acc<8, 4>(acc);
    { TileSrc s{H, LDH, arow0, Wt, LDH, c0, FF + c0, D}; gm.begin(s); }
    gm.run(acc, smem);
    float* sC = (float*)smem;
#pragma unroll
    for (int q = 0; q < 4; ++q) {
      __syncthreads();
      if ((wc & 1) == (q >> 1)) { const int cb = (wc >> 1) * 32;
#pragma unroll
        for (int m = 0; m < 8; ++m)
#pragma unroll
          for (int n = 0; n < 2; ++n) *(f32x4*)(sC + (wr * 128 + m * 16 + fr) * 68 + cb + n * 16 + fq * 4) = acc[m][(q & 1) * 2 + n];
      }
      __syncthreads();
      const int cq = c0 + q * 32, c4 = (tid & 7) * 4;
      const f32x4 v0 = *(const f32x4*)(cw + cq + c4), v1 = *(const f32x4*)(cw + 2 * FF + cq + c4), v2 = *(const f32x4*)(cw + 4 * FF + cq + c4);
      const f32x4 g0 = *(const f32x4*)(cw + FF + cq + c4), g1 = *(const f32x4*)(cw + 3 * FF + cq + c4), g2 = *(const f32x4*)(cw + 5 * FF + cq + c4);
      for (int e = tid; e < 254 * 8; e += NTP) {
        const int tr = 1 + (e >> 3), g = arow0 + tr;
        if (g < MT) { int t, T, mi; tokinfo(g, t, T, mi);
          const float pm = t > 0 ? 1.f : 0.f, nm = t < T - 1 ? 1.f : 0.f;
          const f32x4 va = *(const f32x4*)(sC + (tr - 1) * 68 + c4), vb = *(const f32x4*)(sC + tr * 68 + c4), vc = *(const f32x4*)(sC + (tr + 1) * 68 + c4);
          const f32x4 ga = *(const f32x4*)(sC + (tr - 1) * 68 + 32 + c4), gb = *(const f32x4*)(sC + tr * 68 + 32 + c4), gc = *(const f32x4*)(sC + (tr + 1) * 68 + 32 + c4);
          float r[4];
#pragma unroll
          for (int j = 0; j < 4; ++j) { const float val = pm * va[j] * v0[j] + vb[j] * v1[j] + nm * vc[j] * v2[j]; const float gt = pm * ga[j] * g0[j] + gb[j] * g1[j] + nm * gc[j] * g2[j]; r[j] = gelu_tanh(gt) * val; }
          u32x2 o; o.x = pack2(r[0], r[1]); o.y = pack2(r[2], r[3]);
          *(u32x2*)(hid + (size_t)g * FF + cq + c4) = o; }
      }
    }
  }
}

template <int CTRL> DI float dppf(float v) { return __int_as_float(__builtin_amdgcn_mov_dpp(__float_as_int(v), CTRL, 0xF, 0xF, true)); }
DI float row16_sum(float v) { v += dppf<0xB1>(v); v += dppf<0x4E>(v); v += dppf<0x141>(v); v += dppf<0x140>(v); return v; }

DI float frcp(float x) { return __builtin_amdgcn_rcpf(x); }
DI float fsig(float x) { return frcp(1.f + __expf(-x)); }
__device__ void scan_task(const P& p, int l, int seq, int h, int d, int half, char* smem) {
  float* sR = (float*)smem; float* sW = sR + 1024; float* sKD = sW + 1024; float* sB = sKD + 1024; float* sNK = sB + 1024; float* sV = sNK + 1024; float* sK = sV + 1024; float* sY = sK + 1024;
  float* sKn = sY + 1024; float* sKK = sKn + 16; bf16_t* sWT = (bf16_t*)(sKK + 64); bf16_t* sAL = sWT + 16 * LDT;
  const int tid = tidx(), lane = tid & 63, wave = tid >> 6, fr = lane & 15, fq = lane >> 4;
  const int row0 = seq < 32 ? seq * 256 : MC + (seq - 32) * 1024, T = seq < 32 ? 256 : 1024, nch = T >> 4;
  const bf16_t* zr = (const bf16_t*)(p.ws + WS_ZR);
  float* yout = (float*)(p.ws + WS_Y) + (size_t)d * MT * 512;
  __syncthreads();
  if (tid < 64) sKK[tid] = p.rwkv_k_k[l * 512 + h * 64 + tid];
  const int cc = wave * 16 + fr, gc = h * 64 + cc;
  bf16x8 bw[2], ba[2];
#pragma unroll
  for (int ks = 0; ks < 2; ++ks)
#pragma unroll
    for (int e = 0; e < 8; ++e) { const int k = ks * 32 + fq * 8 + e;
      bw[ks][e] = (short)f2bf(p.rwkv_w_up[((size_t)(l * 2 + d) * 64 + k) * 512 + gc]); ba[ks][e] = (short)f2bf(p.rwkv_a_up[((size_t)(l * 2 + d) * 64 + k) * 512 + gc]); }
  const float w0c = p.rwkv_w0[(l * 2 + d) * 512 + gc], a0c = p.rwkv_a0[(l * 2 + d) * 512 + gc], kac = p.rwkv_k_a[l * 512 + gc];
  const int rg = tid >> 4, kq = tid & 15, rbase = half * 32 + rg * 2;
  f32x2 S[2][2];
  if (seq >= 32) { const float* s0 = p.state_rwkv + (((((size_t)(seq - 32) * 2 + l) * 2 + d) * 8 + h) * 64 + rbase) * 64 + kq * 4;
#pragma unroll
    for (int r = 0; r < 2; ++r) { const f32x4 x = *(const f32x4*)(s0 + r * 64); S[r][0] = (f32x2){x[0], x[1]}; S[r][1] = (f32x2){x[2], x[3]}; } }
  else {
#pragma unroll
    for (int r = 0; r < 2; ++r) { S[r][0] = (f32x2){0.f, 0.f}; S[r][1] = (f32x2){0.f, 0.f}; } }
  if (seq >= 32) __builtin_amdgcn_s_setprio(2);
  const int at = (tid & 127) >> 3, apart = tid & 7, ahi = tid >> 7;
  size_t coff[3];
  { const int sb0 = ahi ? 512 + h * 64 : h * 64, sb1 = ahi ? 1536 : 1024 + h * 64, sb2 = 1600;
    coff[0] = (size_t)at * NZR + sb0 + apart * 8; coff[1] = (size_t)at * NZR + sb1 + apart * 8; coff[2] = (size_t)at * NZR + sb2 + apart * 8; }
  u32x4 pre[3];
  { const int t0 = (d ? nch - 1 : 0) * 16;
#pragma unroll
    for (int i = 0; i < 3; ++i) pre[i] = *(const u32x4*)(zr + (size_t)(row0 + t0) * NZR + coff[i]); }
  __syncthreads();
  for (int ci = 0; ci < nch; ++ci) {
    const int chunk = d ? nch - 1 - ci : ci, t0 = chunk * 16;
    { const int o = at * 64 + apart * 8; float f[8];
      unpack8(pre[0], f);
      if (ahi == 0) { *(f32x4*)(sR + o) = (f32x4){f[0], f[1], f[2], f[3]}; *(f32x4*)(sR + o + 4) = (f32x4){f[4], f[5], f[6], f[7]}; }
      else { *(f32x4*)(sK + o) = (f32x4){f[0], f[1], f[2], f[3]}; *(f32x4*)(sK + o + 4) = (f32x4){f[4], f[5], f[6], f[7]}; float ps = 0.f;
#pragma unroll
        for (int e = 0; e < 8; ++e) { const float kk = f[e] * sKK[apart * 8 + e]; ps += kk * kk; }
        ps += dppf<0xB1>(ps); ps += dppf<0x4E>(ps); ps += dppf<0x141>(ps);
        if (apart == 0) sKn[at] = ps; }
      unpack8(pre[1], f);
      if (ahi == 0) { *(f32x4*)(sV + o) = (f32x4){f[0], f[1], f[2], f[3]}; *(f32x4*)(sV + o + 4) = (f32x4){f[4], f[5], f[6], f[7]}; }
      else { float g[8];
#pragma unroll
        for (int e = 0; e < 8; ++e) g[e] = 1.f - 2.f * frcp(__expf(2.f * f[e]) + 1.f);
        *(u32x4*)(sWT + at * LDT + apart * 8) = pack8(g); }
      if (ahi == 0) *(u32x4*)(sAL + at * LDT + apart * 8) = pre[2];
    }
    __syncthreads();
    {
      f32x4 aw = {0.f, 0.f, 0.f, 0.f}, aa = {0.f, 0.f, 0.f, 0.f};
#pragma unroll
      for (int ks = 0; ks < 2; ++ks) { const bf16x8 fw = *(const bf16x8*)(sWT + fr * LDT + ks * 32 + fq * 8); const bf16x8 fa = *(const bf16x8*)(sAL + fr * LDT + ks * 32 + fq * 8);
        aw = MFMA16(fw, bw[ks], aw); aa = MFMA16(fa, ba[ks], aa); }
      const float kkc = sKK[cc];
#pragma unroll
      for (int j = 0; j < 4; ++j) { const int t = fq * 4 + j, o = t * 64 + cc;
        const float dec = __expf(-0.6065306597f * fsig(w0c + aw[j]));
        const float a = fsig(a0c + aa[j]);
        const float kv = sK[o];
        const float kkv = kv * kkc * __builtin_amdgcn_rsqf(fmaxf(sKn[t], 1e-24f));
        sW[o] = dec; sKD[o] = kv * (1.f + (a - 1.f) * kac); sB[o] = kkv * a; sNK[o] = -kkv; }
    }
    __syncthreads();
    { const int cn = ci + 1 < nch ? ci + 1 : ci; const int nt0 = (d ? nch - 1 - cn : cn) * 16;
#pragma unroll
      for (int i = 0; i < 3; ++i) pre[i] = *(const u32x4*)(zr + (size_t)(row0 + nt0) * NZR + coff[i]); }
#pragma unroll 2
    for (int si = 0; si < 16; ++si) {
      const int t = d ? 15 - si : si, o = t * 64 + kq * 4;
      const f32x4 an4 = *(const f32x4*)(sNK + o), w4 = *(const f32x4*)(sW + o), b4 = *(const f32x4*)(sB + o), kd4 = *(const f32x4*)(sKD + o), r4 = *(const f32x4*)(sR + o);
      const f32x2 v2 = *(const f32x2*)(sV + t * 64 + rbase);
      const f32x2 an[2] = {{an4[0], an4[1]}, {an4[2], an4[3]}}, wv[2] = {{w4[0], w4[1]}, {w4[2], w4[3]}}, bv[2] = {{b4[0], b4[1]}, {b4[2], b4[3]}}, kd[2] = {{kd4[0], kd4[1]}, {kd4[2], kd4[3]}}, rv[2] = {{r4[0], r4[1]}, {r4[2], r4[3]}};
      float sa[2];
#pragma unroll
      for (int r = 0; r < 2; ++r) { const f32x2 t2 = S[r][0] * an[0] + S[r][1] * an[1]; sa[r] = row16_sum(t2.x + t2.y); }
      f32x2 yv;
#pragma unroll
      for (int r = 0; r < 2; ++r) { const f32x2 sav = {sa[r], sa[r]}, vvv = {v2[r], v2[r]};
        S[r][0] = S[r][0] * wv[0] + (sav * bv[0] + vvv * kd[0]); S[r][1] = S[r][1] * wv[1] + (sav * bv[1] + vvv * kd[1]);
        const f32x2 y2 = S[r][0] * rv[0] + S[r][1] * rv[1]; yv[r] = row16_sum(y2.x + y2.y); }
      if (kq == 0) *(f32x2*)(sY + t * 64 + rbase) = yv;
    }
    __syncthreads();
    { const int t = tid >> 4, vv = half * 32 + (tid & 15) * 2; *(f32x2*)(yout + (size_t)(row0 + t0 + t) * 512 + h * 64 + vv) = *(const f32x2*)(sY + t * 64 + vv); }
  }
  __builtin_amdgcn_s_setprio(0);
  if (seq < 32) { float* so = p.out + O_RW + (((((size_t)seq * 2 + l) * 2 + d) * 8 + h) * 64 + rbase) * 64 + kq * 4;
#pragma unroll
    for (int r = 0; r < 2; ++r) *(f32x4*)(so + r * 64) = (f32x4){S[r][0].x, S[r][0].y, S[r][1].x, S[r][1].y}; }
}

DI void qk_scores(const bf16_t* sK, const bf16x8 (&qf)[2], f32x4 (&sacc)[4], int fr, int fq) {
#pragma unroll
  for (int nt = 0; nt < 4; ++nt) { sacc[nt] = (f32x4){0.f, 0.f, 0.f, 0.f};
#pragma unroll
    for (int ks = 0; ks < 2; ++ks) { const bf16x8 kf = *(const bf16x8*)(sK + (nt * 16 + fr) * LDT + ks * 32 + fq * 8); sacc[nt] = MFMA16(kf, qf[ks], sacc[nt]); } }
}
DI void pv_accum(const bf16_t* sVt, const f32x4 (&pacc)[4], f32x4 (&o)[4], int fr, int fq) {
#pragma unroll
  for (int s = 0; s < 2; ++s) {
    bf16x8 pf; { const unsigned a = pack2(pacc[2 * s][0], pacc[2 * s][1]), b = pack2(pacc[2 * s][2], pacc[2 * s][3]), c = pack2(pacc[2 * s + 1][0], pacc[2 * s + 1][1]), dd = pack2(pacc[2 * s + 1][2], pacc[2 * s + 1][3]);
      const u32x4 u = (u32x4){a, b, c, dd}; pf = __builtin_bit_cast(bf16x8, u); }
#pragma unroll
    for (int dt = 0; dt < 4; ++dt) { const u32x2 lo = *(const u32x2*)(sVt + (dt * 16 + fr) * LDT + 32 * s + 4 * fq), hi = *(const u32x2*)(sVt + (dt * 16 + fr) * LDT + 32 * s + 16 + 4 * fq);
      const u32x4 u = (u32x4){lo[0], lo[1], hi[0], hi[1]}; const bf16x8 vf = __builtin_bit_cast(bf16x8, u); o[dt] = MFMA16(vf, pf, o[dt]); }
  }
}
DI void put_kv(bf16_t* sK, bf16_t* sVt, int key, int part, const float (&kf)[8], int vkey, int vpart, const float (&vf)[8]) {
  *(u32x4*)(sK + key * LDT + part * 8) = pack8(kf);
#pragma unroll
  for (int e = 0; e < 8; ++e) sVt[(vpart * 8 + e) * LDT + vkey] = f2bf(vf[e]);
}
DI void softmax_tile(f32x4 (&sacc)[4], f32x4 (&o)[4], float& mrun, float& lrun) {
  float mx = sacc[0][0];
#pragma unroll
  for (int nt = 0; nt < 4; ++nt)
#pragma unroll
    for (int j = 0; j < 4; ++j) mx = fmaxf(mx, sacc[nt][j]);
  mx = fmaxf(mx, shfl_x(mx, 16)); mx = fmaxf(mx, shfl_x(mx, 32));
  const float mnew = fmaxf(mrun, mx), alpha = exp2f(mrun - mnew); mrun = mnew;
  float ls = 0.f;
#pragma unroll
  for (int nt = 0; nt < 4; ++nt)
#pragma unroll
    for (int j = 0; j < 4; ++j) { const float pv = exp2f(sacc[nt][j] - mnew); sacc[nt][j] = pv; ls += pv; }
  lrun = lrun * alpha + ls;
#pragma unroll
  for (int dt = 0; dt < 4; ++dt) o[dt] *= alpha;
}
constexpr float LOG2E = 1.4426950408889634f;

__device__ void dense_task(const P& p, int b, int h, int qb, char* smem) {
  bf16_t* sK = (bf16_t*)smem; bf16_t* sVt = sK + 64 * LDT;
  const int tid = tidx(), lane = tid & 63, wave = tid >> 6, fr = lane & 15, fq = lane >> 4;
  const bf16_t* zn = (const bf16_t*)(p.ws + WS_ZN); bf16_t* ona = (bf16_t*)(p.ws + WS_ONA);
  const int qrow = b * 256 + qb * 64 + wave * 16 + fr;
  bf16x8 qf[2];
#pragma unroll
  for (int ks = 0; ks < 2; ++ks) qf[ks] = *(const bf16x8*)(zn + (size_t)qrow * NZN + h * 64 + ks * 32 + fq * 8);
  f32x4 o[4]; for (int dt = 0; dt < 4; ++dt) o[dt] = (f32x4){0.f, 0.f, 0.f, 0.f};
  float mrun = -1e30f, lrun = 0.f;
  u32x4 pk[2], pv[2];
#pragma unroll
  for (int i = 0; i < 2; ++i) { const int c = tid + 256 * i, key = c >> 3, part = c & 7, vkey = c & 63, vpart = c >> 6; pk[i] = *(const u32x4*)(zn + (size_t)(b * 256 + key) * NZN + h * 64 + part * 8 + 512); pv[i] = *(const u32x4*)(zn + (size_t)(b * 256 + vkey) * NZN + h * 64 + vpart * 8 + 1024); }
  for (int kt = 0; kt < 4; ++kt) {
    __syncthreads();
#pragma unroll
    for (int i = 0; i < 2; ++i) { const int c = tid + 256 * i, key = c >> 3, part = c & 7, vkey = c & 63, vpart = c >> 6; float vf[8]; unpack8(pv[i], vf);
      *(u32x4*)(sK + key * LDT + part * 8) = pk[i];
#pragma unroll
      for (int e = 0; e < 8; ++e) sVt[(vpart * 8 + e) * LDT + vkey] = f2bf(vf[e]); }
    __syncthreads();
    { const int kn = kt < 3 ? kt + 1 : 3;
#pragma unroll
      for (int i = 0; i < 2; ++i) { const int c = tid + 256 * i, key = c >> 3, part = c & 7, vkey = c & 63, vpart = c >> 6; pk[i] = *(const u32x4*)(zn + (size_t)(b * 256 + kn * 64 + key) * NZN + h * 64 + part * 8 + 512); pv[i] = *(const u32x4*)(zn + (size_t)(b * 256 + kn * 64 + vkey) * NZN + h * 64 + vpart * 8 + 1024); } }
    f32x4 sacc[4]; qk_scores(sK, qf, sacc, fr, fq);
#pragma unroll
    for (int nt = 0; nt < 4; ++nt) sacc[nt] *= (0.125f * LOG2E);
    softmax_tile(sacc, o, mrun, lrun);
    pv_accum(sVt, sacc, o, fr, fq);
  }
  lrun += shfl_x(lrun, 16); lrun += shfl_x(lrun, 32); const float inv = 1.f / lrun;
#pragma unroll
  for (int dt = 0; dt < 4; ++dt) { u32x2 ov; ov.x = pack2(o[dt][0] * inv, o[dt][1] * inv); ov.y = pack2(o[dt][2] * inv, o[dt][3] * inv); *(u32x2*)(ona + (size_t)qrow * LDO + h * 64 + dt * 16 + fq * 4) = ov; }
}

__device__ void na_task(const P& p, int l, int b, int h, int r, char* smem) {
  bf16_t* sK = (bf16_t*)smem; bf16_t* sVt = sK + 64 * LDT; float* sRpb = (float*)(sVt + 64 * LDT);
  const int tid = tidx(), lane = tid & 63, wave = tid >> 6, fr = lane & 15, fq = lane >> 4;
  const bf16_t* zn = (const bf16_t*)(p.ws + WS_ZN); bf16_t* ona = (bf16_t*)(p.ws + WS_ONA);
  const int base = MC + b * 1024, qcol = wave * 16 + fr, qrow = base + r * 64 + qcol;
  int rs = r - 4; rs = rs < 0 ? 0 : (rs > 8 ? 8 : rs);
  int cs = qcol - 8; cs = cs < 0 ? 0 : (cs > 48 ? 48 : cs);
  __syncthreads();
  for (int e = tid; e < 465; e += NT) sRpb[e] = p.na_rpb[((size_t)l * 8 + h) * 465 + e] * LOG2E;
  bf16x8 qf[2];
#pragma unroll
  for (int ks = 0; ks < 2; ++ks) qf[ks] = *(const bf16x8*)(zn + (size_t)qrow * NZN + h * 64 + ks * 32 + fq * 8);
  f32x4 o[4]; for (int dt = 0; dt < 4; ++dt) o[dt] = (f32x4){0.f, 0.f, 0.f, 0.f};
  float mrun = -1e30f, lrun = 0.f;
  u32x4 pre[8];
#define NA_ISSUE(KT) do { const int kt_ = (KT); \
    if (kt_ < 8) { _Pragma("unroll") for (int i = 0; i < 2; ++i) { const int c = tid + 256 * i, key = c >> 3, part = c & 7, vkey = c & 63, vpart = c >> 6; \
        pre[4 * i] = *(const u32x4*)(zn + (size_t)(base + (rs + kt_) * 64 + key) * NZN + h * 64 + part * 8 + 512); pre[4 * i + 1] = *(const u32x4*)(zn + (size_t)(base + (rs + kt_) * 64 + vkey) * NZN + h * 64 + vpart * 8 + 1024); } } \
    else { _Pragma("unroll") for (int i = 0; i < 2; ++i) { const int c = tid + 256 * i, key = c >> 3, part = c & 7, vkey = c & 63, vpart = c >> 6; const size_t cb_ = (((size_t)b * 2 + l) * 8 + h) * 256 + (kt_ - 8) * 64; const size_t co = (cb_ + key) * 64 + part * 8, cv = (cb_ + vkey) * 64 + vpart * 8; \
        pre[4 * i] = *(const u32x4*)(p.cache_k + co); pre[4 * i + 1] = *(const u32x4*)(p.cache_k + co + 4); pre[4 * i + 2] = *(const u32x4*)(p.cache_v + cv); pre[4 * i + 3] = *(const u32x4*)(p.cache_v + cv + 4); } } } while (0)
  NA_ISSUE(0);
  for (int kt = 0; kt < 12; ++kt) {
    __syncthreads();
    if (kt < 8) {
#pragma unroll
      for (int i = 0; i < 2; ++i) { const int c = tid + 256 * i, key = c >> 3, part = c & 7, vkey = c & 63, vpart = c >> 6; float vf[8]; unpack8(pre[4 * i + 1], vf);
        *(u32x4*)(sK + key * LDT + part * 8) = pre[4 * i];
#pragma unroll
        for (int e = 0; e < 8; ++e) sVt[(vpart * 8 + e) * LDT + vkey] = f2bf(vf[e]); }
    } else {
#pragma unroll
      for (int i = 0; i < 2; ++i) { const int c = tid + 256 * i, key = c >> 3, part = c & 7, vkey = c & 63, vpart = c >> 6;
        const f32x4 k0 = __builtin_bit_cast(f32x4, pre[4 * i]), k1 = __builtin_bit_cast(f32x4, pre[4 * i + 1]), v0 = __builtin_bit_cast(f32x4, pre[4 * i + 2]), v1 = __builtin_bit_cast(f32x4, pre[4 * i + 3]);
        const float kf[8] = {k0[0], k0[1], k0[2], k0[3], k1[0], k1[1], k1[2], k1[3]}; const float vf[8] = {v0[0], v0[1], v0[2], v0[3], v1[0], v1[1], v1[2], v1[3]};
        put_kv(sK, sVt, key, part, kf, vkey, vpart, vf); }
    }
    __syncthreads();
    NA_ISSUE(kt < 11 ? kt + 1 : 11);
    f32x4 sacc[4]; qk_scores(sK, qf, sacc, fr, fq);
    if (kt < 8) { const int dr = rs + kt - r + 7;
#pragma unroll
      for (int nt = 0; nt < 4; ++nt)
#pragma unroll
        for (int j = 0; j < 4; ++j) { const int kc = nt * 16 + fq * 4 + j; const bool valid = kc >= cs && kc < cs + 16; int dc = kc - qcol; dc = dc < -15 ? -15 : (dc > 15 ? 15 : dc);
          sacc[nt][j] = valid ? sacc[nt][j] * (0.125f * LOG2E) + sRpb[dr * 31 + dc + 15] : -1e30f; }
    } else {
#pragma unroll
      for (int nt = 0; nt < 4; ++nt) sacc[nt] *= (0.125f * LOG2E);
    }
    softmax_tile(sacc, o, mrun, lrun);
    pv_accum(sVt, sacc, o, fr, fq);
  }
#undef NA_ISSUE
  lrun += shfl_x(lrun, 16); lrun += shfl_x(lrun, 32); const float inv = 1.f / lrun;
#pragma unroll
  for (int dt = 0; dt < 4; ++dt) { u32x2 ov; ov.x = pack2(o[dt][0] * inv, o[dt][1] * inv); ov.y = pack2(o[dt][2] * inv, o[dt][3] * inv); *(u32x2*)(ona + (size_t)qrow * LDO + h * 64 + dt * 16 + fq * 4) = ov; }
}

DI void rope8(const float (&own)[8], const float (&par)[8], int part, int n, float (&out)[8]) {
  const float pos = (float)((part >> 2) ? (n & 63) : (n >> 6));
  const bool isx2 = (part & 3) >= 2;
#pragma unroll
  for (int e = 0; e < 8; ++e) { const int i = (part & 1) * 8 + e; const float ang = pos * exp2f(-(float)i * 0.830482023721841f); const float sn = __sinf(ang), cs = __cosf(ang);
    out[e] = isx2 ? par[e] * sn + own[e] * cs : own[e] * cs - par[e] * sn; }
}

__device__ void ret_task(const P& p, int l, int seq, int h, int qb, char* smem) {
  bf16_t* sK = (bf16_t*)smem; bf16_t* sVt = sK + 64 * LDT; bf16_t* sQ = sVt + 64 * LDT;
  const int tid = tidx(), lane = tid & 63, wave = tid >> 6, fr = lane & 15, fq = lane >> 4;
  const bf16_t* zt = (const bf16_t*)(p.ws + WS_ZT); bf16_t* oret = (bf16_t*)(p.ws + WS_ORET);
  const bool lat = seq >= 32;
  const int row0 = lat ? MC + (seq - 32) * 1024 : seq * 256, T = lat ? 1024 : 256, nkt = T >> 6;
  const float xf = p.ret_decay[(l * 2 + 0) * 8 + h], xb = p.ret_decay[(l * 2 + 1) * 8 + h];
  const float lgf = -log1pf(__expf(-xf)) * LOG2E, lgb = -log1pf(__expf(-xb)) * LOG2E;
  __syncthreads();
#pragma unroll
  for (int i = 0; i < 2; ++i) { const int c = tid + 256 * i, qi = c >> 3, part = c & 7; const int n = qb * 64 + qi; const size_t ro = (size_t)(row0 + n) * LZT + h * 64;
    const u32x4 own = *(const u32x4*)(zt + ro + part * 8);
    if (lat) { const u32x4 par = *(const u32x4*)(zt + ro + (part ^ 2) * 8); float fo[8], fp[8], out[8]; unpack8(own, fo); unpack8(par, fp); rope8(fo, fp, part, n, out); *(u32x4*)(sQ + qi * LDT + part * 8) = pack8(out); }
    else *(u32x4*)(sQ + qi * LDT + part * 8) = own; }
  __syncthreads();
  const int qi = wave * 16 + fr, nq = qb * 64 + qi;
  bf16x8 qf[2];
#pragma unroll
  for (int ks = 0; ks < 2; ++ks) qf[ks] = *(const bf16x8*)(sQ + qi * LDT + ks * 32 + fq * 8);
  f32x4 o[4]; for (int dt = 0; dt < 4; ++dt) o[dt] = (f32x4){0.f, 0.f, 0.f, 0.f};
  u32x4 rk[2], rp[2], rv[2];
#define RET_ISSUE(KT) do { _Pragma("unroll") for (int i = 0; i < 2; ++i) { const int c = tid + 256 * i, key = c >> 3, part = c & 7, vkey = c & 63, vpart = c >> 6; const size_t ro = (size_t)(row0 + (KT) * 64 + key) * LZT + h * 64; \
    rk[i] = *(const u32x4*)(zt + ro + 512 + part * 8); rp[i] = *(const u32x4*)(zt + ro + 512 + (part ^ 2) * 8); rv[i] = *(const u32x4*)(zt + (size_t)(row0 + (KT) * 64 + vkey) * LZT + h * 64 + 1024 + vpart * 8); } } while (0)
  RET_ISSUE(0);
  for (int kt = 0; kt < nkt; ++kt) {
    __syncthreads();
#pragma unroll
    for (int i = 0; i < 2; ++i) { const int c = tid + 256 * i, key = c >> 3, part = c & 7, vkey = c & 63, vpart = c >> 6; const int n = kt * 64 + key;
      float kf[8], vf[8]; unpack8(rk[i], kf); unpack8(rv[i], vf);
      if (lat) { float fp[8], out[8]; unpack8(rp[i], fp); rope8(kf, fp, part, n, out);
#pragma unroll
        for (int e = 0; e < 8; ++e) kf[e] = out[e]; }
#pragma unroll
      for (int e = 0; e < 8; ++e) kf[e] *= 0.125f;
      put_kv(sK, sVt, key, part, kf, vkey, vpart, vf); }
    __syncthreads();
    RET_ISSUE(kt + 1 < nkt ? kt + 1 : kt);
    f32x4 sacc[4]; qk_scores(sK, qf, sacc, fr, fq);
#pragma unroll
    for (int nt = 0; nt < 4; ++nt)
#pragma unroll
      for (int j = 0; j < 4; ++j) { const int mk = kt * 64 + nt * 16 + fq * 4 + j; const int df = nq - mk;
        const float dec = df > 0 ? exp2f(lgf * (float)df) : (df < 0 ? exp2f(lgb * (float)(-df)) : 2.f); sacc[nt][j] *= dec; }
    pv_accum(sVt, sacc, o, fr, fq);
  }
#undef RET_ISSUE
  if (lat) {
    for (int dir = 0; dir < 2; ++dir) {
      __syncthreads();
      const float* s0 = p.state_ret + ((((size_t)(seq - 32) * 2 + l) * 2 + dir) * 8 + h) * 4096;
#pragma unroll
      for (int i = 0; i < 2; ++i) { const int c = tid + 256 * i, dk = c & 63, part = c >> 6; const float4 a = *(const float4*)(s0 + dk * 64 + part * 8), bq = *(const float4*)(s0 + dk * 64 + part * 8 + 4);
        const float vf[8] = {a.x, a.y, a.z, a.w, bq.x, bq.y, bq.z, bq.w};
#pragma unroll
        for (int e = 0; e < 8; ++e) sVt[(part * 8 + e) * LDT + dk] = f2bf(vf[e]); }
      __syncthreads();
      const float xi = dir == 0 ? exp2f(lgf * (float)(nq + 1)) : exp2f(lgb * (float)(T - nq));
      f32x4 pacc[4];
#pragma unroll
      for (int s = 0; s < 2; ++s)
#pragma unroll
        for (int hh = 0; hh < 2; ++hh)
#pragma unroll
          for (int j = 0; j < 4; ++j) pacc[2 * s + hh][j] = xi * bf2f(sQ[qi * LDT + 32 * s + 16 * hh + 4 * fq + j]);
      pv_accum(sVt, pacc, o, fr, fq);
    }
  }
  float s1 = 0.f;
#pragma unroll
  for (int dt = 0; dt < 4; ++dt)
#pragma unroll
    for (int j = 0; j < 4; ++j) s1 += o[dt][j];
  s1 += shfl_x(s1, 16); s1 += shfl_x(s1, 32); const float mu = s1 * (1.f / 64.f);
  float s2 = 0.f;
#pragma unroll
  for (int dt = 0; dt < 4; ++dt)
#pragma unroll
    for (int j = 0; j < 4; ++j) { const float dlt = o[dt][j] - mu; s2 += dlt * dlt; }
  s2 += shfl_x(s2, 16); s2 += shfl_x(s2, 32); const float rstd = rsqrtf(s2 * (1.f / 64.f) + 1e-5f);
  const size_t qrow = (size_t)(row0 + nq);
#pragma unroll
  for (int dt = 0; dt < 4; ++dt) { const int dv = h * 64 + dt * 16 + fq * 4; const u32x2 gr = *(const u32x2*)(zt + qrow * LZT + 1536 + dv); const float4 gn = *(const float4*)(p.ret_gn + l * 512 + dv);
    const float g0 = bflo(gr.x), g1 = bfhi(gr.x), g2 = bflo(gr.y), g3 = bfhi(gr.y);
    u32x2 ov; ov.x = pack2((o[dt][0] - mu) * rstd * gn.x * g0 * sigmoidf_(g0), (o[dt][1] - mu) * rstd * gn.y * g1 * sigmoidf_(g1));
    ov.y = pack2((o[dt][2] - mu) * rstd * gn.z * g2 * sigmoidf_(g2), (o[dt][3] - mu) * rstd * gn.w * g3 * sigmoidf_(g3));
    *(u32x2*)(oret + qrow * LDO + dv) = ov; }
}

__device__ void retstate_task(const P& p, int l, int b, int h, char* smem) {
  float* sKf = (float*)smem; float* sKb = sKf + 64 * 64; float* sV = sKb + 64 * 64;
  const int tid = tidx(), dk = tid >> 2, dq = tid & 3;
  const bf16_t* zt = (const bf16_t*)(p.ws + WS_ZT);
  const float xf = p.ret_decay[(l * 2 + 0) * 8 + h], xb = p.ret_decay[(l * 2 + 1) * 8 + h];
  const float lgf = -log1pf(__expf(-xf)) * LOG2E, lgb = -log1pf(__expf(-xb)) * LOG2E;
  float af[16], ab[16];
#pragma unroll
  for (int i = 0; i < 16; ++i) { af[i] = 0.f; ab[i] = 0.f; }
  for (int kt = 0; kt < 4; ++kt) {
    __syncthreads();
#pragma unroll
    for (int i = 0; i < 2; ++i) { const int c = tid + 256 * i, key = c >> 3, part = c & 7, m = kt * 64 + key; const size_t ro = (size_t)(b * 256 + m) * LZT + h * 64 + part * 8;
      float kf[8], vf[8]; unpack8(*(const u32x4*)(zt + ro + 512), kf); unpack8(*(const u32x4*)(zt + ro + 1024), vf);
      const float wf = 0.125f * exp2f(lgf * (float)(255 - m)), wb = 0.125f * exp2f(lgb * (float)m);
#pragma unroll
      for (int e = 0; e < 8; ++e) { sKf[key * 64 + part * 8 + e] = kf[e] * wf; sKb[key * 64 + part * 8 + e] = kf[e] * wb; sV[key * 64 + part * 8 + e] = vf[e]; } }
    __syncthreads();
    for (int m = 0; m < 64; ++m) { const float kf = sKf[m * 64 + dk], kb = sKb[m * 64 + dk];
#pragma unroll
      for (int i = 0; i < 4; ++i) { const f32x4 vv = *(const f32x4*)(sV + m * 64 + dq * 16 + i * 4);
#pragma unroll
        for (int j = 0; j < 4; ++j) { af[i * 4 + j] += kf * vv[j]; ab[i * 4 + j] += kb * vv[j]; } } }
  }
  float* of = p.out + O_RT + ((((size_t)b * 2 + l) * 2 + 0) * 8 + h) * 4096 + dk * 64 + dq * 16; float* ob = of + 8 * 4096;
#pragma unroll
  for (int i = 0; i < 16; ++i) { of[i] = af[i]; ob[i] = ab[i]; }
}

constexpr int Q_SCAN_L = 64, Q_SCAN_C = 512, Q_RET_L = 256, Q_NA = 256, Q_DENSE = 512, Q_RET_C = 512, Q_RST = 128;
template <int QMASK> __device__ void phase_mixers(const P& p, int l, char* smem_, int rep = 0) {
  __shared__ int s_task;
  int* ctr = (int*)(p.ws + WS_CTRL) + 64 * (l + 1) + 4 * rep;
  const int vb = vhalf(); char* smem = smem_ + vb * VSMEM;
  if (QMASK & 1) for (;;) {
    __syncthreads();
    if (ptid() == 0) s_task = atomicAdd(ctr, 1);
    __syncthreads();
    const int tk = s_task;
    if (tk >= Q_SCAN_L + Q_SCAN_C) break;
    const bool lat = tk < Q_SCAN_L; const int t2 = lat ? tk : tk - Q_SCAN_L;
    scan_task(p, l, (lat ? 32 : 0) + (t2 >> 4), (t2 >> 1) & 7, t2 & 1, vb, smem);
  }
  if (QMASK & 2) for (;;) {
    __syncthreads();
    if (ptid() == 0) s_task = atomicAdd(ctr + 16, 1);
    __syncthreads();
    const int tk = s_task;
    if (tk >= Q_RET_L + Q_RET_C) break;
    if (tk < Q_RET_L) ret_task(p, l, 32 + (tk >> 6), (tk >> 3) & 7, (tk & 7) * 2 + vb, smem);
    else { const int t2 = tk - Q_RET_L; ret_task(p, l, t2 >> 4, (t2 >> 1) & 7, (t2 & 1) * 2 + vb, smem); }
  }
  if (QMASK & 4) for (;;) {
    __syncthreads();
    if (ptid() == 0) s_task = atomicAdd(ctr + 32, 1);
    __syncthreads();
    int tk = s_task;
    if (tk >= Q_NA + Q_DENSE + Q_RST) break;
    if (tk < Q_NA) { na_task(p, l, tk >> 6, (tk >> 3) & 7, (tk & 7) * 2 + vb, smem); continue; } tk -= Q_NA;
    if (tk < Q_DENSE) { dense_task(p, tk >> 4, (tk >> 1) & 7, (tk & 1) * 2 + vb, smem); continue; } tk -= Q_DENSE;
    retstate_task(p, l, tk >> 2, (tk & 3) * 2 + vb, smem);
  }
}

__device__ void phase_rwkv_post(const P& p, int l, char* smem) {
  const bf16_t* zr = (const bf16_t*)(p.ws + WS_ZR); const float* yf = (const float*)(p.ws + WS_Y); const float* yb = yf + (size_t)MT * 512; bf16_t* oa = (bf16_t*)(p.ws + WS_OA);
  const bf16_t* Gt = (const bf16_t*)(p.ws + WS_WG);
  const int tid = ptid(), lane = tid & 63, wave = tid >> 6, wr = wave >> 2, wc = wave & 3, fr = lane & 15, fq = lane >> 4;
  TileIter ti; int mt, nt; ti.init(96, 2);
  while (ti.next(mt, nt)) {
    const int row0 = mt * 128, n0 = nt * 256;
    f32x4 acc[4][4]; zero_acc<4, 4>(acc);
    TileSrc s{zr + 1664, NZR, row0, Gt, LDG, n0, n0 + 128, 128}; gemm_tile<4, 4>(acc, s, smem);
    const int cb = n0 + wc * 64 + fq * 4;
#pragma unroll
    for (int m = 0; m < 4; ++m) { const size_t row = (size_t)(row0 + wr * 64 + m * 16 + fr);
      f32x4 y[4]; float s1 = 0.f, rk = 0.f; f32x4 vv[4];
#pragma unroll
      for (int n = 0; n < 4; ++n) { const int c = cb + n * 16; y[n] = *(const f32x4*)(yf + row * 512 + c) + *(const f32x4*)(yb + row * 512 + c); s1 += y[n][0] + y[n][1] + y[n][2] + y[n][3];
        const u32x2 rr = *(const u32x2*)(zr + row * NZR + c), kk = *(const u32x2*)(zr + row * NZR + 512 + c), v2 = *(const u32x2*)(zr + row * NZR + 1024 + c); const f32x4 rkw = *(const f32x4*)(p.rwkv_r_k + l * 512 + c);
        rk += bflo(rr.x) * bflo(kk.x) * rkw[0] + bfhi(rr.x) * bfhi(kk.x) * rkw[1] + bflo(rr.y) * bflo(kk.y) * rkw[2] + bfhi(rr.y) * bfhi(kk.y) * rkw[3];
        vv[n] = (f32x4){bflo(v2.x), bfhi(v2.x), bflo(v2.y), bfhi(v2.y)}; }
      s1 += shfl_x(s1, 16); s1 += shfl_x(s1, 32); rk += shfl_x(rk, 16); rk += shfl_x(rk, 32);
      const float mu = s1 * (1.f / 64.f); float s2 = 0.f;
#pragma unroll
      for (int n = 0; n < 4; ++n)
#pragma unroll
        for (int j = 0; j < 4; ++j) { const float dl = y[n][j] - mu; s2 += dl * dl; }
      s2 += shfl_x(s2, 16); s2 += shfl_x(s2, 32); const float rstd = rsqrtf(s2 * (1.f / 64.f) + 64e-5f);
#pragma unroll
      for (int n = 0; n < 4; ++n) { const int c = cb + n * 16; const f32x4 lg = *(const f32x4*)(p.rwkv_ln_g + l * 512 + c), lb = *(const f32x4*)(p.rwkv_ln_b + l * 512 + c);
        float o[4];
#pragma unroll
        for (int j = 0; j < 4; ++j) o[j] = ((y[n][j] - mu) * rstd * lg[j] + lb[j] + rk * vv[n][j]) * acc[m][n][j];
        u32x2 ov; ov.x = pack2(o[0], o[1]); ov.y = pack2(o[2], o[3]); *(u32x2*)(oa + row * LDO + c) = ov; }
    }
  }
}

DI void convert_layer_a(const P& p, int l, char* smem) {
  convert_T(p.w_in + (size_t)l * D * INC, D, INC, (bf16_t*)(p.ws + WS_WIN), LDH, smem);
  convert_T(p.w_o_rwkv + (size_t)l * 512 * D, 512, D, (bf16_t*)(p.ws + WS_WO3), LDO, smem);
  convert_T(p.w_o_na + (size_t)l * 512 * D, 512, D, (bf16_t*)(p.ws + WS_WO3) + (size_t)1024 * LDO, LDO, smem);
  convert_T(p.w_o_ret + (size_t)l * 512 * D, 512, D, (bf16_t*)(p.ws + WS_WO3) + (size_t)2 * 1024 * LDO, LDO, smem);
  convert_T(p.w_out + (size_t)l * D * D, D, D, (bf16_t*)(p.ws + WS_WOUT), LDH, smem);
  convert_T(p.rwkv_g_up + (size_t)l * 128 * 512, 128, 512, (bf16_t*)(p.ws + WS_WG), LDG, smem);
}
DI void convert_layer_b(const P& p, int l, char* smem) {
  convert_T(p.ffn_up + (size_t)l * D * 2 * FF, D, 2 * FF, (bf16_t*)(p.ws + WS_WUP), LDH, smem);
  convert_T(p.ffn_down + (size_t)l * FF * D, FF, D, (bf16_t*)(p.ws + WS_WDN), FF, smem);
}

typedef __attribute__((address_space(4))) const P* KP;
DI KP kargs() { KP k = (KP)__builtin_amdgcn_kernarg_segment_ptr(); asm volatile("" : "+s"(k)); return k; }
template <int PH> DI void run_phase(int l, char* smem) {
#if defined(__HIP_DEVICE_COMPILE__)
  const P p = *kargs();
#else
  const P p{};
#endif
  const float* mod = (const float*)(p.ws + WS_MOD);
  float* xbuf = p.out;
  if (PH == 0) { ada_phase(p, smem); convert_layer_a(p, 0, smem); }
  else if (PH == 1) { norm_phase(p, nullptr, nullptr, nullptr, nullptr, 0, nullptr, p.norm_mix_pre, mod, 0, (bf16_t*)(p.ws + WS_H)); }
  else if (PH == 2) phase_win(p, l, smem);
  else if (PH == 4) phase_mixers<7>(p, l, smem);
  else if (PH == 5) phase_rwkv_post(p, l, smem);
  else if (PH == 6) phase_merge(p, smem);
  else if (PH == 7) { phase_gemm_f32((const bf16_t*)(p.ws + WS_MERGED), LDH, D, (const bf16_t*)(p.ws + WS_WOUT), LDH, (float*)(p.ws + WS_U), smem); }
  else if (PH == 8) { convert_layer_b(p, l, smem);
    norm_phase(p, l == 0 ? nullptr : xbuf, (const float*)(p.ws + WS_U), p.norm_mix_post + l * D, mod + (size_t)l * 5 * 6144, 2, xbuf, p.norm_ffn_pre + l * D, mod + (size_t)l * 5 * 6144, 3, (bf16_t*)(p.ws + WS_H)); }
  else if (PH == 9) phase_ffn_up(p, l, smem);
  else if (PH == 11) { phase_gemm_f32((const bf16_t*)(p.ws + WS_HID), FF, FF, (const bf16_t*)(p.ws + WS_WDN), FF, (float*)(p.ws + WS_F), smem); }
  else if (PH == 12) {
    if (l == 0) { norm_phase(p, xbuf, (const float*)(p.ws + WS_F), p.norm_ffn_post, mod, 5, xbuf, p.norm_mix_pre + D, mod + (size_t)5 * 6144, 0, (bf16_t*)(p.ws + WS_H)); convert_layer_a(p, 1, smem); }
    else norm_phase(p, xbuf, (const float*)(p.ws + WS_F), p.norm_ffn_post + D, mod + (size_t)5 * 6144, 5, xbuf, nullptr, nullptr, 0, nullptr);
  }
}

#if MEGA
__global__ void __launch_bounds__(NTP, 1) mega_kernel(P p_) {
  extern __shared__ __attribute__((aligned(16))) char smem[];
  __shared__ u32x4 xb_words;
  cg::grid_group grid = cg::this_grid();
  if (ptid() == 0) xb_words = (u32x4){0u, 0u, 0u, 0u};
  __syncthreads();
#if defined(__HIP_DEVICE_COMPILE__)
  (void)xcd_barrier_post((unsigned*)(p_.ws + WS_BAR), (volatile LAS unsigned*)&xb_words);
#define GSYNC() do { XcdBarrier xb_; xb_.bar = (unsigned*)(kargs()->ws + WS_BAR); xb_.x = xb_xcc_id(); xb_.st = (volatile LAS unsigned*)&xb_words; xcd_barrier(xb_); } while (0)
#else
#define GSYNC() do { } while (0)
#endif
  run_phase<0>(0, smem); grid.sync();
  run_phase<1>(0, smem); GSYNC();
#pragma unroll
  for (int l = 0; l < 2; ++l) {
    run_phase<2>(l, smem); GSYNC();
    if (PROBE_MASK & 1) { run_phase<2>(l, smem); GSYNC(); }
    run_phase<4>(l, smem); GSYNC();
    run_phase<5>(l, smem); GSYNC();
    run_phase<6>(l, smem); GSYNC();
    if (PROBE_MASK & 8) { run_phase<6>(l, smem); GSYNC(); }
    run_phase<7>(l, smem); GSYNC();
    if (PROBE_MASK & 16) { run_phase<7>(l, smem); GSYNC(); }
    run_phase<8>(l, smem); GSYNC();
    run_phase<9>(l, smem); GSYNC();
    if (PROBE_MASK & 32) { run_phase<9>(l, smem); GSYNC(); }
    run_phase<11>(l, smem); GSYNC();
    if (PROBE_MASK & 64) { run_phase<11>(l, smem); GSYNC(); }
    run_phase<12>(l, smem); if (l == 0) GSYNC();
  }
#undef GSYNC
}
#else
template <int PH> __global__ void __launch_bounds__(NTP, 1) phase_kernel(P p, int l) {
  extern __shared__ __attribute__((aligned(16))) char smem[];
  run_phase<PH>(l, smem);
}
#endif

extern "C" void kernel_launch(void* const* d_in, const int* in_sizes, int n_in, void* d_out, int out_size, void* d_ws, size_t ws_size, hipStream_t stream) {
  if (ws_size < WS_END || n_in < 36) { fprintf(stderr, "workspace too small: %zu < %zu\n", ws_size, (size_t)WS_END); return; }
  P p{};
  const float** pp = (const float**)&p;
  for (int i = 0; i < 36; ++i) pp[i] = (const float*)d_in[i];
  p.out = (float*)d_out; p.ws = (char*)d_ws;
  hipMemsetAsync(d_ws, 0, WS_WIN, stream);
#if MEGA
  static int grid_blocks = 0;
  if (!grid_blocks) {
    int dev = 0, cus = 0, per_cu = 0; hipGetDevice(&dev);
    hipDeviceGetAttribute(&cus, hipDeviceAttributeMultiprocessorCount, dev);
    hipFuncSetAttribute((const void*)mega_kernel, hipFuncAttributeMaxDynamicSharedMemorySize, SMEM_BYTES);
    hipOccupancyMaxActiveBlocksPerMultiprocessor(&per_cu, mega_kernel, NTP, SMEM_BYTES);
    if (per_cu > 1) per_cu = 1;
    grid_blocks = cus * per_cu;
  }
  void* args[] = {&p};
  hipError_t e = hipLaunchCooperativeKernel((void*)mega_kernel, dim3(grid_blocks), dim3(NTP), args, SMEM_BYTES, stream);
  if (e != hipSuccess) fprintf(stderr, "cooperative launch failed: %s (grid %d)\n", hipGetErrorString(e), grid_blocks);
#else
  const int G = 512;
#define LAUNCH(PH, L) do { hipFuncSetAttribute((const void*)phase_kernel<PH>, hipFuncAttributeMaxDynamicSharedMemorySize, SMEM_BYTES); phase_kernel<PH><<<G, NT, SMEM_BYTES, stream>>>(p, L); } while (0)
  LAUNCH(0, 0); LAUNCH(1, 0);
  for (int l = 0; l < 2; ++l) { LAUNCH(2, l); LAUNCH(4, l); LAUNCH(5, l); LAUNCH(6, l); LAUNCH(7, l); LAUNCH(8, l); LAUNCH(9, l); LAUNCH(11, l); LAUNCH(12, l); }
#endif
}
```

```cpp
#include <hip/hip_runtime.h>
#include <hip/hip_cooperative_groups.h>
#include <cstdio>
namespace cg = cooperative_groups;

#ifndef MEGA
#define MEGA 1
#endif
#define PROBE_MASK 0

typedef unsigned short bf16_t;
typedef short bf16x8 __attribute__((ext_vector_type(8)));
typedef short bf16x4 __attribute__((ext_vector_type(4)));
typedef float f32x4 __attribute__((ext_vector_type(4)));
typedef float f32x2 __attribute__((ext_vector_type(2)));
typedef unsigned u32x4 __attribute__((ext_vector_type(4)));
typedef unsigned u32x2 __attribute__((ext_vector_type(2)));
#define DI __device__ __forceinline__
#define MFMA16(a, b, c) __builtin_amdgcn_mfma_f32_16x16x32_bf16((a), (b), (c), 0, 0, 0)

constexpr int NT = 256;
constexpr int NTP = 512;
constexpr int VSMEM = 65536;
constexpr int D = 1024, MC = 8192, ML = 4096, MT = 12288;
constexpr int NZR = 1792, NZN = 1536, NZT = 2048, INC = 8448, FF = 2816;
constexpr int LDH = 1088, LDO = 576, LZT = 2112, LDG = 136;
constexpr int LDT = 72;
constexpr int SMEM_BYTES = 131072;
constexpr size_t O_K = 12582912, O_V = 20971520, O_RW = 29360128, O_RT = 33554432;
constexpr size_t WS_CTRL = 0;
constexpr size_t WS_MOD = 4096;
constexpr size_t WS_BAR = 262144;
constexpr size_t WS_CUF = 278528;
constexpr size_t WS_WG = 294912;
constexpr size_t WS_WIN = 434176;
constexpr size_t WS_WUP = WS_WIN;
constexpr size_t WS_WDN = WS_WIN + (size_t)5632 * LDH * 2;
constexpr size_t WS_WO3 = WS_WIN + (size_t)INC * LDH * 2;
constexpr size_t WS_WOUT = WS_WO3 + (size_t)3 * 1024 * LDO * 2;
constexpr size_t WS_H = WS_WOUT + (size_t)1024 * LDH * 2;
constexpr size_t WS_Z = WS_H + (size_t)MT * LDH * 2;
constexpr size_t WS_ZR = WS_Z;
constexpr size_t WS_ZN = WS_ZR + (size_t)MT * NZR * 2;
constexpr size_t WS_ZT = WS_ZN + (size_t)MT * NZN * 2;
constexpr size_t WS_MERGED = WS_ZR;
constexpr size_t WS_OA = WS_ZN;
constexpr size_t WS_U = WS_ZT;
constexpr size_t WS_HID = WS_Z;
constexpr size_t WS_F = WS_ZT;
constexpr size_t WS_Y = WS_ZT + (size_t)MT * LZT * 2;
constexpr size_t WS_ONA = WS_Y + (size_t)2 * MT * 512 * 4;
constexpr size_t WS_ORET = WS_ONA + (size_t)MT * LDO * 2;
constexpr size_t WS_END = WS_ORET + (size_t)MT * LDO * 2;

struct P {
  const float *x_prompt, *x_sample, *cache_k, *cache_v, *state_rwkv, *state_ret, *c, *c_ctx, *ada_w, *ada_b;
  const float *norm_mix_pre, *norm_mix_post, *norm_ffn_pre, *norm_ffn_post, *w_in, *rwkv_conv, *rwkv_w0, *rwkv_w_up, *rwkv_a0, *rwkv_a_up, *rwkv_g_up;
  const float *rwkv_k_k, *rwkv_k_a, *rwkv_r_k, *rwkv_ln_g, *rwkv_ln_b, *na_rpb, *ret_decay, *ret_gn, *w_o_rwkv, *w_o_na, *w_o_ret, *w_out, *ffn_up, *ffn_conv, *ffn_down;
  float* out; char* ws;
};

DI int threadIdx_x_raw() { return (int)__builtin_amdgcn_workitem_id_x(); }
DI int ptid() { int t = threadIdx_x_raw(); asm volatile("" : "+v"(t)); return t; }
DI int tidx() { return ptid() & 255; }
DI int vhalf() { return ptid() >> 8; }
DI int vblk() { return (int)blockIdx.x * 2 + vhalf(); }
DI int vgrid() { return (int)gridDim.x * 2; }
DI unsigned cvt_pk_bf16(float lo, float hi) { unsigned r; asm("v_cvt_pk_bf16_f32 %0, %1, %2" : "=v"(r) : "v"(lo), "v"(hi)); return r; }
DI bf16_t f2bf(float x) { return (bf16_t)(cvt_pk_bf16(x, 0.f) & 0xffffu); }
DI float bf2f(bf16_t b) { return __uint_as_float(((unsigned)b) << 16); }
DI unsigned pack2(float a, float b) { return cvt_pk_bf16(a, b); }
DI float bflo(unsigned u) { return __uint_as_float(u << 16); }
DI float bfhi(unsigned u) { return __uint_as_float(u & 0xffff0000u); }
DI void unpack8(const u32x4 r, float (&f)[8]) { f[0] = bflo(r[0]); f[1] = bfhi(r[0]); f[2] = bflo(r[1]); f[3] = bfhi(r[1]); f[4] = bflo(r[2]); f[5] = bfhi(r[2]); f[6] = bflo(r[3]); f[7] = bfhi(r[3]); }
DI u32x4 pack8(const float (&f)[8]) { u32x4 r; r[0] = pack2(f[0], f[1]); r[1] = pack2(f[2], f[3]); r[2] = pack2(f[4], f[5]); r[3] = pack2(f[6], f[7]); return r; }
DI float sigmoidf_(float x) { return __builtin_amdgcn_rcpf(1.f + __expf(-x)); }
DI float shfl_x(float v, int m) { const int lane = ptid() & 63; return __int_as_float(__builtin_amdgcn_ds_bpermute((lane ^ m) << 2, __float_as_int(v))); }
DI float wave_sum(float v) { for (int o = 32; o > 0; o >>= 1) v += shfl_x(v, o); return v; }
DI void tokinfo(int m, int& t, int& T, int& mi) { if (m < MC) { t = m & 255; T = 256; mi = 0; } else { int q = m - MC; t = q & 1023; T = 1024; mi = 1 + (q >> 10); } }

#define XB_TMO      128
#define XB_XCNT(j)  (256  + 64 * (j))
#define XB_XSUB(j)  (1280 + 64 * (j))
#define XB_XGEN(j)  (2304 + 64 * (j))
#define XB_TOP      3328
#define XB_TOPGEN   3392
#define XB_SPIN_CAP (1u << 20)
#define LAS __attribute__((address_space(3)))
DI unsigned xb_ld(unsigned* p) { return __hip_atomic_load(p, __ATOMIC_RELAXED, __HIP_MEMORY_SCOPE_AGENT); }
DI unsigned xb_add(unsigned* p, unsigned v) { return __hip_atomic_fetch_add(p, v, __ATOMIC_RELAXED, __HIP_MEMORY_SCOPE_AGENT); }
DI unsigned xb_xcc_id() { return (unsigned)__builtin_amdgcn_s_getreg((3 << 11) | 20) & 0xFu; }
#define XB_SPIN(cond, bar) do { unsigned _sp = 0; while (cond) { __builtin_amdgcn_s_sleep(1); \
    if ((++_sp & 255u) == 0u) { if (xb_ld(&(bar)[XB_TMO])) break; if (_sp > XB_SPIN_CAP) { atomicAdd(&(bar)[XB_TMO], 1u); break; } } } } while (0)
struct XcdBarrier { unsigned* bar; unsigned x; volatile LAS unsigned* st; };
DI XcdBarrier xcd_barrier_post(unsigned* bar, volatile LAS unsigned* st) {
  XcdBarrier b; b.bar = bar; b.x = xb_xcc_id(); b.st = st;
  if (ptid() == 0) (void)xb_add(&bar[XB_XCNT(b.x)], 1u);
  return b;
}
DI void xcd_barrier_complete(unsigned* bar, unsigned x, unsigned& nloc, unsigned& nx) {
  const unsigned G = gridDim.x * gridDim.y * gridDim.z;
  unsigned sum, cnt, mine, sp = 0u;
  for (;;) {
    sum = 0u; cnt = 0u; mine = 0u;
#pragma unroll
    for (unsigned j = 0; j < 16; ++j) { const unsigned c = xb_ld(&bar[XB_XCNT(j)]); sum += c; cnt += (c > 0u) ? 1u : 0u; mine = (j == x) ? c : mine; }
    if (sum == G) break;
    __builtin_amdgcn_s_sleep(1);
    if ((++sp & 255u) == 0u) { if (xb_ld(&bar[XB_TMO])) break; if (sp > XB_SPIN_CAP) { atomicAdd(&bar[XB_TMO], 1u); break; } }
  }
  nloc = mine > 0u ? mine : 1u; nx = cnt > 0u ? cnt : 1u;
}
DI void xcd_barrier(const XcdBarrier& b) {
  asm volatile("s_waitcnt vmcnt(0)" ::: "memory");
  __syncthreads();
  if (ptid() == 0) {
    unsigned* bar = b.bar;
    __builtin_amdgcn_s_waitcnt(0);
    unsigned nloc = b.st[0], nx = b.st[1];
    if (nloc == 0u) { xcd_barrier_complete(bar, b.x, nloc, nx); b.st[0] = nloc; b.st[1] = nx; }
    const unsigned old = xb_add(&bar[XB_XSUB(b.x)], 1u);
    const unsigned gen = old / nloc;
    if (old + 1u == (gen + 1u) * nloc) {
      __builtin_amdgcn_fence(__ATOMIC_RELEASE, "agent");
      asm volatile("s_waitcnt vmcnt(0)" ::: "memory");
      const unsigned og = xb_add(&bar[XB_TOP], 1u);
      const unsigned tg = og / nx;
      if (og + 1u == (tg + 1u) * nx) xb_add(&bar[XB_TOPGEN], 1u);
      else XB_SPIN(xb_ld(&bar[XB_TOPGEN]) == tg, bar);
      __builtin_amdgcn_fence(__ATOMIC_ACQUIRE, "agent");
      xb_add(&bar[XB_XGEN(b.x)], 1u);
      asm volatile("s_waitcnt vmcnt(0)" ::: "memory");
    } else {
      XB_SPIN(xb_ld(&bar[XB_XGEN(b.x)]) == gen, bar);
      __builtin_amdgcn_fence(__ATOMIC_ACQUIRE, "agent");
      asm volatile("s_waitcnt vmcnt(0)" ::: "memory");
    }
  }
  __syncthreads();
}

__device__ void convert_T(const float* __restrict__ W, int K, int N, bf16_t* __restrict__ Wt, int ldt, char* smem) {
  float* t = (float*)(smem + vhalf() * VSMEM);
  const int tid = tidx(), ntn = N >> 6, nitems = (K >> 6) * ntn;
  const int kr = tid >> 4, c4 = (tid & 15) * 4;
  f32x4 v[4];
  { const int it = vblk() < nitems ? vblk() : 0; const int k0 = (it / ntn) << 6, n0 = (it % ntn) << 6;
#pragma unroll
    for (int i = 0; i < 4; ++i) v[i] = *(const f32x4*)(W + (size_t)(k0 + kr + 16 * i) * N + n0 + c4); }
  for (int it = vblk(); it < nitems; it += vgrid()) {
    const int k0 = (it / ntn) << 6, n0 = (it % ntn) << 6;
    __syncthreads();
#pragma unroll
    for (int i = 0; i < 4; ++i) { const int k = kr + 16 * i; t[k * 65 + c4] = v[i][0]; t[k * 65 + c4 + 1] = v[i][1]; t[k * 65 + c4 + 2] = v[i][2]; t[k * 65 + c4 + 3] = v[i][3]; }
    __syncthreads();
    { const int itn = it + vgrid() < nitems ? it + vgrid() : it; const int k1 = (itn / ntn) << 6, n1 = (itn % ntn) << 6;
#pragma unroll
      for (int i = 0; i < 4; ++i) v[i] = *(const f32x4*)(W + (size_t)(k1 + kr + 16 * i) * N + n1 + c4); }
#pragma unroll
    for (int i = 0; i < 2; ++i) { const int c = tid + 256 * i, n = c >> 3, kc = c & 7; float f[8];
#pragma unroll
      for (int e = 0; e < 8; ++e) f[e] = t[(kc * 8 + e) * 65 + n];
      *(u32x4*)(Wt + (size_t)(n0 + n) * ldt + k0 + kc * 8) = pack8(f); }
  }
}

__device__ void ada_phase(const P& p, char* smem) {
  float* sc = (float*)(smem + vhalf() * VSMEM);
  float* red = sc + 640;
  float* mod = (float*)(p.ws + WS_MOD);
  const int tid = tidx(), kq = tid >> 5, cq = tid & 31;
  for (int it = vblk(); it < 2 * 48 * 8; it += vgrid()) {
    const int l = it / 384, rem = it % 384, nb = rem >> 3, ks = rem & 7;
    const int n0 = nb * 128, k0 = ks * 128;
    __syncthreads();
    for (int e = tid; e < 640; e += NT) { const int i = e >> 7, k = e & 127; const float v = (i == 0) ? p.c_ctx[k0 + k] : p.c[(i - 1) * D + k0 + k]; sc[e] = v * sigmoidf_(v); }
    __syncthreads();
    float acc[5][4];
#pragma unroll
    for (int i = 0; i < 5; ++i)
#pragma unroll
      for (int j = 0; j < 4; ++j) acc[i][j] = 0.f;
    const float* wp = p.ada_w + ((size_t)l * D + k0 + kq * 16) * 6144 + n0 + cq * 4;
#pragma unroll 4
    for (int kk = 0; kk < 16; ++kk) { const float4 w = *(const float4*)(wp + (size_t)kk * 6144);
#pragma unroll
      for (int i = 0; i < 5; ++i) { const float s = sc[i * 128 + kq * 16 + kk]; acc[i][0] += s * w.x; acc[i][1] += s * w.y; acc[i][2] += s * w.z; acc[i][3] += s * w.w; } }
#pragma unroll
    for (int i = 0; i < 5; ++i)
#pragma unroll
      for (int j = 0; j < 4; ++j) red[(kq * 5 + i) * 128 + cq * 4 + j] = acc[i][j];
    __syncthreads();
    for (int e = tid; e < 640; e += NT) { const int i = e >> 7, n = e & 127; float s = 0.f;
#pragma unroll
      for (int q = 0; q < 8; ++q) s += red[(q * 5 + i) * 128 + n];
      if (ks == 0) s += p.ada_b[l * 6144 + n0 + n];
      atomicAdd(mod + ((size_t)l * 5 + i) * 6144 + n0 + n, s); }
  }
}

__device__ void norm_phase(const P& p, const float* xin  , const float* u, const float* gpost, const float* modU, int gate_idx,
                           float* xout, const float* gpre, const float* modN, int shift_idx, bf16_t* hout) {
  const int lane = tidx() & 63, wave = tidx() >> 6, nw = NT / 64;
  for (int m = vblk() * nw + wave; m < MT; m += vgrid() * nw) {
    int t, T, mi; tokinfo(m, t, T, mi);
    const float* xr = xin ? xin + (size_t)m * D : (m < MC ? p.x_prompt + (size_t)m * D : p.x_sample + (size_t)(m - MC) * D);
    float4 x[4];
#pragma unroll
    for (int i = 0; i < 4; ++i) x[i] = *(const float4*)(xr + i * 256 + lane * 4);
    if (u) {
      float4 uu[4]; float ss = 0.f;
#pragma unroll
      for (int i = 0; i < 4; ++i) { uu[i] = *(const float4*)(u + (size_t)m * D + i * 256 + lane * 4); ss += uu[i].x * uu[i].x + uu[i].y * uu[i].y + uu[i].z * uu[i].z + uu[i].w * uu[i].w; }
      ss = wave_sum(ss); const float rs = rsqrtf(ss * (1.f / D) + 1e-6f);
#pragma unroll
      for (int i = 0; i < 4; ++i) { const int c = i * 256 + lane * 4; const float4 g = *(const float4*)(gpost + c); const float4 ga = *(const float4*)(modU + ((size_t)mi * 6 + gate_idx) * D + c);
        x[i].x += ga.x * uu[i].x * rs * g.x; x[i].y += ga.y * uu[i].y * rs * g.y; x[i].z += ga.z * uu[i].z * rs * g.z; x[i].w += ga.w * uu[i].w * rs * g.w; }
    }
    if (xout) {
#pragma unroll
      for (int i = 0; i < 4; ++i) *(float4*)(xout + (size_t)m * D + i * 256 + lane * 4) = x[i];
    }
    if (hout) {
      float ss = 0.f;
#pragma unroll
      for (int i = 0; i < 4; ++i) ss += x[i].x * x[i].x + x[i].y * x[i].y + x[i].z * x[i].z + x[i].w * x[i].w;
      ss = wave_sum(ss); const float rs = rsqrtf(ss * (1.f / D) + 1e-6f);
#pragma unroll
      for (int i = 0; i < 4; ++i) { const int c = i * 256 + lane * 4; const float4 g = *(const float4*)(gpre + c);
        const float4 sh = *(const float4*)(modN + ((size_t)mi * 6 + shift_idx) * D + c); const float4 sc = *(const float4*)(modN + ((size_t)mi * 6 + shift_idx + 1) * D + c);
        u32x2 o; o.x = pack2(x[i].x * rs * g.x * (1.f + sc.x) + sh.x, x[i].y * rs * g.y * (1.f + sc.y) + sh.y); o.y = pack2(x[i].z * rs * g.z * (1.f + sc.z) + sh.z, x[i].w * rs * g.w * (1.f + sc.w) + sh.w);
        *(u32x2*)(hout + (size_t)m * LDH + c) = o; }
    }
  }
}

struct TileSrc { const bf16_t* A; int lda; int arow0; const bf16_t* B; int ldb; int brow0, brow1; int K; };

template <int MM, int NN> DI void zero_acc(f32x4 (&acc)[MM][NN]) {
#pragma unroll
  for (int m = 0; m < MM; ++m)
#pragma unroll
    for (int n = 0; n < NN; ++n) acc[m][n] = (f32x4){0.f, 0.f, 0.f, 0.f};
}

template <int MM, int NN> struct Gemm {
  static constexpr int NA = MM / 2, NB = NN;
  unsigned oa_[NA], ob_[NB]; const bf16_t* A; const bf16_t* B; int nk; u32x4 ra[NA], rb[NB];
#define GT_LOAD(KT) do { const int kn_ = ((KT) < nk ? (KT) : nk - 1) * 64; \
    _Pragma("unroll") for (int i = 0; i < NA; ++i) ra[i] = *(const u32x4*)(A + (oa_[i] + kn_)); \
    _Pragma("unroll") for (int i = 0; i < NB; ++i) rb[i] = *(const u32x4*)(B + (ob_[i] + kn_)); } while (0)
  DI void begin(const TileSrc& s) {
    const int tid = ptid();
#pragma unroll
    for (int i = 0; i < NA; ++i) { const int row = (tid >> 3) + 64 * i, kc = tid & 7;
      int ar = s.arow0 + row; ar = ar < 0 ? 0 : (ar > MT - 1 ? MT - 1 : ar);
      oa_[i] = (unsigned)ar * (unsigned)s.lda + kc * 8; }
#pragma unroll
    for (int i = 0; i < NB; ++i) { const int row = (tid >> 3) + 64 * i, kc = tid & 7;
      const int br = row < 32 * NN ? s.brow0 + row : s.brow1 + row - 32 * NN;
      ob_[i] = (unsigned)br * (unsigned)s.ldb + kc * 8; }
    A = s.A; B = s.B; nk = s.K >> 6;
    GT_LOAD(0);
  }
  DI void run(f32x4 (&acc)[MM][NN], char* smem) {
    bf16_t* sbase = (bf16_t*)smem;
    const int tid = ptid(), lane = tid & 63, wave = tid >> 6, wr = wave >> 2, wc = wave & 3, fr = lane & 15, fq = lane >> 4;
    int wofs; { const int r = tid >> 3, kc = tid & 7, ob = (r & 15) * 64 + (kc & 3) * 16; wofs = (((r >> 4) * 2 + (kc >> 2)) * 1024 + (ob ^ (((ob >> 9) & 1) << 5))) >> 1; }
    int robase; { const int ob = fr * 64 + fq * 16; robase = (ob ^ (((ob >> 9) & 1) << 5)) >> 1; }
#define GT_STORE(ST) do { bf16_t* sA_ = sbase + (ST) * 32768; bf16_t* sB_ = sA_ + 16384; \
    _Pragma("unroll") for (int i = 0; i < NA; ++i) *(u32x4*)(sA_ + wofs + i * 4096) = ra[i]; \
    _Pragma("unroll") for (int i = 0; i < NB; ++i) *(u32x4*)(sB_ + wofs + i * 4096) = rb[i]; } while (0)
#define GT_COMPUTE(ST) do { const bf16_t* sA_ = sbase + (ST) * 32768 + robase; const bf16_t* sB_ = sA_ + 16384; __builtin_amdgcn_s_setprio(1); \
    _Pragma("unroll 1") for (int ks = 0; ks < 2; ++ks) { bf16x8 bfr[NN]; \
      _Pragma("unroll") for (int n = 0; n < NN; ++n) bfr[n] = *(const bf16x8*)(sB_ + ((wc * NN + n) * 2 + ks) * 512); \
      _Pragma("unroll") for (int m = 0; m < MM; ++m) { const bf16x8 af = *(const bf16x8*)(sA_ + ((wr * MM + m) * 2 + ks) * 512); \
        _Pragma("unroll") for (int n = 0; n < NN; ++n) acc[m][n] = MFMA16(bfr[n], af, acc[m][n]); } } __builtin_amdgcn_s_setprio(0); } while (0)
    __syncthreads();
    GT_STORE(0);
    GT_LOAD(1);
    __syncthreads();
#pragma unroll 1
    for (int kt = 0; kt < nk; kt += 2) {
      GT_STORE(1); GT_LOAD(kt + 2); GT_COMPUTE(0); __syncthreads();
      GT_STORE(0); GT_LOAD(kt + 3); GT_COMPUTE(1); __syncthreads();
    }
  }
#undef GT_LOAD
#undef GT_STORE
#undef GT_COMPUTE
};
template <int MM, int NN> DI void gemm_tile(f32x4 (&acc)[MM][NN], const TileSrc& s, char* smem) { Gemm<MM, NN> g; g.begin(s); g.run(acc, smem); }

DI float gelu_tanh(float x) { const float u = 0.7978845608f * (x + 0.044715f * x * x * x); const float e = __expf(2.f * u); const float th = 1.f - 2.f * __builtin_amdgcn_rcpf(e + 1.f); return 0.5f * x * (1.f + th); }

struct TileIter {
  int m_lo, rows, NTn, G, efull, count, e, stride;
  DI void init(int MTn, int NTn_) { const int x = blockIdx.x & 7; m_lo = (x * MTn) >> 3; rows = (((x + 1) * MTn) >> 3) - m_lo; NTn = NTn_; G = (rows + 1) >> 1;
    efull = (rows / G) * G * NTn; count = rows * NTn; e = blockIdx.x >> 3; stride = gridDim.x >> 3; }
  DI bool next(int& mt, int& nt) { if (e >= count) return false;
    if (e < efull) { const int grp = e / (G * NTn), rem = e - grp * G * NTn; nt = rem / G; mt = m_lo + grp * G + (rem - nt * G); }
    else { const int rem = e - efull, gsz = rows - (rows / G) * G; nt = rem / gsz; mt = m_lo + (rows / G) * G + (rem - nt * gsz); }
    e += stride; return true; }
};

__device__ void phase_win(const P& p, int l, char* smem) {
  const bf16_t* H = (const bf16_t*)(p.ws + WS_H); const bf16_t* Wt = (const bf16_t*)(p.ws + WS_WIN);
  bf16_t* zr = (bf16_t*)(p.ws + WS_ZR); bf16_t* zn = (bf16_t*)(p.ws + WS_ZN); bf16_t* zt = (bf16_t*)(p.ws + WS_ZT);
  const int tid = ptid(), lane = tid & 63, wave = tid >> 6, wr = wave >> 2, wc = wave & 3, fr = lane & 15, fq = lane >> 4;
  Gemm<8, 4> gm;
  TileIter ti; ti.init(48, 14);
  const int x = blockIdx.x & 7, nconv = (343 - x + 7) >> 3, nloc = ti.count + nconv;
  const float* cw = p.rwkv_conv + (size_t)l * 3 * NZR;
  for (int e = (int)(blockIdx.x >> 3); e < nloc; e += (int)(gridDim.x >> 3)) {
    f32x4 acc[8][4]; zero_acc<8, 4>(acc);
    if (e < nconv) {
      const int c = x + 8 * e, mt = c / 7, nt = c - mt * 7;
      const int n0 = nt * 256, arow0 = mt * 254 - 1;
      { TileSrc s{H, LDH, arow0, Wt, LDH, n0, n0 + 128, D}; gm.begin(s); }
      gm.run(acc, smem);
      float* sC = (float*)smem;
#pragma unroll 1
      for (int sl = 0; sl < 4; ++sl) {
        __syncthreads();
        if (wc == sl) {
#pragma unroll
          for (int m = 0; m < 8; ++m)
#pragma unroll
            for (int n = 0; n < 4; ++n) *(f32x4*)(sC + (wr * 128 + m * 16 + fr) * 68 + n * 16 + fq * 4) = acc[m][n];
        }
        __syncthreads();
        const int nb = n0 + sl * 64, c4 = (tid & 15) * 4;
        const float4 w0 = *(const float4*)(cw + nb + c4), w1 = *(const float4*)(cw + NZR + nb + c4), w2 = *(const float4*)(cw + 2 * NZR + nb + c4);
        for (int ee = tid; ee < 254 * 16; ee += NTP) {
          const int tr = 1 + (ee >> 4), g = arow0 + tr;
          if (g < MT) { int t, T, mi; tokinfo(g, t, T, mi);
            const float pm = t > 0 ? 1.f : 0.f, nm = t < T - 1 ? 1.f : 0.f;
            const f32x4 a = *(const f32x4*)(sC + (tr - 1) * 68 + c4), b = *(const f32x4*)(sC + tr * 68 + c4), cc = *(const f32x4*)(sC + (tr + 1) * 68 + c4);
            float r0 = pm * a[0] * w0.x + b[0] * w1.x + nm * cc[0] * w2.x, r1 = pm * a[1] * w0.y + b[1] * w1.y + nm * cc[1] * w2.y;
            float r2 = pm * a[2] * w0.z + b[2] * w1.z + nm * cc[2] * w2.z, r3 = pm * a[3] * w0.w + b[3] * w1.w + nm * cc[3] * w2.w;
            if (nb >= 1664) { r0 = sigmoidf_(r0); r1 = sigmoidf_(r1); r2 = sigmoidf_(r2); r3 = sigmoidf_(r3); }
            u32x2 o; o.x = pack2(r0, r1); o.y = pack2(r2, r3);
            *(u32x2*)(zr + (size_t)g * NZR + nb + c4) = o; }
        }
      }
    } else {
      int mt, nt; ti.e = e - nconv; ti.next(mt, nt);
      const int n0 = nt * 256, row0 = mt * 256;
      { TileSrc s{H, LDH, row0, Wt, LDH, NZR + n0, NZR + n0 + 128, D}; gm.begin(s); }
      gm.run(acc, smem);
#pragma unroll
      for (int m = 0; m < 8; ++m) { const int row = row0 + wr * 128 + m * 16 + fr;
#pragma unroll
        for (int n = 0; n < 4; ++n) { const int col = n0 + wc * 64 + n * 16 + fq * 4; const f32x4 v = acc[m][n];
          u32x2 o; o.x = pack2(v[0], v[1]); o.y = pack2(v[2], v[3]);
          if (col < NZN) {
            *(u32x2*)(zn + (size_t)row * NZN + col) = o;
            if (row < MC && col >= 512) { const int part = col - 512, isv = part >> 9, pp = part & 511, hh = pp >> 6, d = pp & 63, b = row >> 8, t = row & 255;
              float* dst = p.out + (isv ? O_V : O_K) + ((((size_t)b * 2 + l) * 8 + hh) * 256 + t) * 64 + d; *(f32x4*)dst = v; }
          } else { *(u32x2*)(zt + (size_t)row * LZT + (col - NZN)) = o; }
        } }
    }
  }
}

__device__ void phase_merge(const P& p, char* smem) {
  const bf16_t* H = (const bf16_t*)(p.ws + WS_H); const bf16_t* Wt = (const bf16_t*)(p.ws + WS_WIN); const bf16_t* Wo3 = (const bf16_t*)(p.ws + WS_WO3);
  bf16_t* mg = (bf16_t*)(p.ws + WS_MERGED);
  const int tid = ptid(), lane = tid & 63, wave = tid >> 6, wr = wave >> 2, wc = wave & 3, fr = lane & 15, fq = lane >> 4;
  TileIter ti; int mt, nt; ti.init(96, 8);
  while (ti.next(mt, nt)) {
    const int n0 = nt * 128, row0 = mt * 128;
    f32x4 macc[4][2]; zero_acc<4, 2>(macc);
#pragma unroll 1
    for (int i = 0; i < 3; ++i) {
      const bf16_t* O = (const bf16_t*)(p.ws + (i == 0 ? WS_OA : (i == 1 ? WS_ONA : WS_ORET)));
      f32x4 g[4][2]; zero_acc<4, 2>(g);
      { TileSrc s{H, LDH, row0, Wt, LDH, 5376 + i * 1024 + n0, 5376 + i * 1024 + n0 + 64, D}; gemm_tile<4, 2>(g, s, smem); }
      f32x4 a2[4][2]; zero_acc<4, 2>(a2);
      { TileSrc s{O, LDO, row0, Wo3 + (size_t)i * 1024 * LDO, LDO, n0, n0 + 64, 512}; gemm_tile<4, 2>(a2, s, smem); }
#pragma unroll
      for (int m = 0; m < 4; ++m)
#pragma unroll
        for (int n = 0; n < 2; ++n)
#pragma unroll
          for (int j = 0; j < 4; ++j) macc[m][n][j] += sigmoidf_(g[m][n][j]) * a2[m][n][j];
    }
#pragma unroll
    for (int m = 0; m < 4; ++m) { const int row = row0 + wr * 64 + m * 16 + fr;
#pragma unroll
      for (int n = 0; n < 2; ++n) { const int col = n0 + wc * 32 + n * 16 + fq * 4; u32x2 o; o.x = pack2(macc[m][n][0], macc[m][n][1]); o.y = pack2(macc[m][n][2], macc[m][n][3]); *(u32x2*)(mg + (size_t)row * LDH + col) = o; } }
  }
}

__device__ void phase_gemm_f32(const bf16_t* A, int lda, int K, const bf16_t* Bt, int ldb, float* C, char* smem) {
  const int tid = ptid(), lane = tid & 63, wave = tid >> 6, wr = wave >> 2, wc = wave & 3, fr = lane & 15, fq = lane >> 4;
  TileIter ti; int mt, nt; ti.init(48, 4);
  while (ti.next(mt, nt)) {
    const int n0 = nt * 256, row0 = mt * 256;
    f32x4 acc[8][4]; zero_acc<8, 4>(acc);
    TileSrc s{A, lda, row0, Bt, ldb, n0, n0 + 128, K}; gemm_tile<8, 4>(acc, s, smem);
#pragma unroll
    for (int m = 0; m < 8; ++m) { const int row = row0 + wr * 128 + m * 16 + fr;
#pragma unroll
      for (int n = 0; n < 4; ++n) *(f32x4*)(C + (size_t)row * D + n0 + wc * 64 + n * 16 + fq * 4) = acc[m][n]; }
  }
}

__device__ void phase_ffn_up(const P& p, int l, char* smem) {
  const bf16_t* H = (const bf16_t*)(p.ws + WS_H); const bf16_t* Wt = (const bf16_t*)(p.ws + WS_WUP); bf16_t* hid = (bf16_t*)(p.ws + WS_HID);
  const int tid = ptid(), lane = tid & 63, wave = tid >> 6, wr = wave >> 2, wc = wave & 3, fr = lane & 15, fq = lane >> 4;
  const float* cw = p.ffn_conv + (size_t)l * 3 * 2 * FF;
  TileIter ti; int mt, nt; ti.init(49, 22);
  Gemm<8, 4> gm;
  while (ti.next(mt, nt)) {
    const int c0 = nt * 128, arow0 = mt * 254 - 1;
    f32x4 acc[8][4]; zero_acc<8, 4>(acc);
    { TileSrc s{H, LDH, arow0, Wt, LDH, c0, FF + c0, D}; gm.begin(s); }
    gm.run(acc, smem);
    float* sC = (float*)smem;
#pragma unroll
    for (int q = 0; q < 4; ++q) {
      __syncthreads();
      if ((wc & 1) == (q >> 1)) { const int cb = (wc >> 1) * 32;
#pragma unroll
        for (int m = 0; m < 8; ++m)
#pragma unroll
          for (int n = 0; n < 2; ++n) *(f32x4*)(sC + (wr * 128 + m * 16 + fr) * 68 + cb + n * 16 + fq * 4) = acc[m][(q & 1) * 2 + n];
      }
      __syncthreads();
      const int cq = c0 + q * 32, c4 = (tid & 7) * 4;
      const f32x4 v0 = *(const f32x4*)(cw + cq + c4), v1 = *(const f32x4*)(cw + 2 * FF + cq + c4), v2 = *(const f32x4*)(cw + 4 * FF + cq + c4);
      const f32x4 g0 = *(const f32x4*)(cw + FF + cq + c4), g1 = *(const f32x4*)(cw + 3 * FF + cq + c4), g2 = *(const f32x4*)(cw + 5 * FF + cq + c4);
      for (int e = tid; e < 254 * 8; e += NTP) {
        const int tr = 1 + (e >> 3), g = arow0 + tr;
        if (g < MT) { int t, T, mi; tokinfo(g, t, T, mi);
          const float pm = t > 0 ? 1.f : 0.f, nm = t < T - 1 ? 1.f : 0.f;
          const f32x4 va = *(const f32x4*)(sC + (tr - 1) * 68 + c4), vb = *(const f32x4*)(sC + tr * 68 + c4), vc = *(const f32x4*)(sC + (tr + 1) * 68 + c4);
          const f32x4 ga = *(const f32x4*)(sC + (tr - 1) * 68 + 32 + c4), gb = *(const f32x4*)(sC + tr * 68 + 32 + c4), gc = *(const f32x4*)(sC + (tr + 1) * 68 + 32 + c4);
          float r[4];
#pragma unroll
          for (int j = 0; j < 4; ++j) { const float val = pm * va[j] * v0[j] + vb[j] * v1[j] + nm * vc[j] * v2[j]; const float gt = pm * ga[j] * g0[j] + gb[j] * g1[j] + nm * gc[j] * g2[j]; r[j] = gelu_tanh(gt) * val; }
          u32x2 o; o.x = pack2(r[0], r[1]); o.y = pack2(r[2], r[3]);
          *(u32x2*)(hid + (size_t)g * FF + cq + c4) = o; }
      }
    }
  }
}

template <int CTRL> DI float dppf(float v) { return __int_as_float(__builtin_amdgcn_mov_dpp(__float_as_int(v), CTRL, 0xF, 0xF, true)); }
DI float row16_sum(float v) { v += dppf<0xB1>(v); v += dppf<0x4E>(v); v += dppf<0x141>(v); v += dppf<0x140>(v); return v; }

DI float frcp(float x) { return __builtin_amdgcn_rcpf(x); }
DI float fsig(float x) { return frcp(1.f + __expf(-x)); }
__device__ void scan_task(const P& p, int l, int seq, int h, int d, int half, char* smem) {
  float* sR = (float*)smem; float* sW = sR + 1024; float* sKD = sW + 1024; float* sB = sKD + 1024; float* sNK = sB + 1024; float* sV = sNK + 1024; float* sK = sV + 1024; float* sY = sK + 1024;
  float* sKn = sY + 1024; float* sKK = sKn + 16; bf16_t* sWT = (bf16_t*)(sKK + 64); bf16_t* sAL = sWT + 16 * LDT;
  const int tid = tidx(), lane = tid & 63, wave = tid >> 6, fr = lane & 15, fq = lane >> 4;
  const int row0 = seq < 32 ? seq * 256 : MC + (seq - 32) * 1024, T = seq < 32 ? 256 : 1024, nch = T >> 4;
  const bf16_t* zr = (const bf16_t*)(p.ws + WS_ZR);
  float* yout = (float*)(p.ws + WS_Y) + (size_t)d * MT * 512;
  __syncthreads();
  if (tid < 64) sKK[tid] = p.rwkv_k_k[l * 512 + h * 64 + tid];
  const int cc = wave * 16 + fr, gc = h * 64 + cc;
  bf16x8 bw[2], ba[2];
#pragma unroll
  for (int ks = 0; ks < 2; ++ks)
#pragma unroll
    for (int e = 0; e < 8; ++e) { const int k = ks * 32 + fq * 8 + e;
      bw[ks][e] = (short)f2bf(p.rwkv_w_up[((size_t)(l * 2 + d) * 64 + k) * 512 + gc]); ba[ks][e] = (short)f2bf(p.rwkv_a_up[((size_t)(l * 2 + d) * 64 + k) * 512 + gc]); }
  const float w0c = p.rwkv_w0[(l * 2 + d) * 512 + gc], a0c = p.rwkv_a0[(l * 2 + d) * 512 + gc], kac = p.rwkv_k_a[l * 512 + gc];
  const int rg = tid >> 4, kq = tid & 15, rbase = half * 32 + rg * 2;
  f32x2 S[2][2];
  if (seq >= 32) { const float* s0 = p.state_rwkv + (((((size_t)(seq - 32) * 2 + l) * 2 + d) * 8 + h) * 64 + rbase) * 64 + kq * 4;
#pragma unroll
    for (int r = 0; r < 2; ++r) { const f32x4 x = *(const f32x4*)(s0 + r * 64); S[r][0] = (f32x2){x[0], x[1]}; S[r][1] = (f32x2){x[2], x[3]}; } }
  else {
#pragma unroll
    for (int r = 0; r < 2; ++r) { S[r][0] = (f32x2){0.f, 0.f}; S[r][1] = (f32x2){0.f, 0.f}; } }
  if (seq >= 32) __builtin_amdgcn_s_setprio(2);
  const int at = (tid & 127) >> 3, apart = tid & 7, ahi = tid >> 7;
  size_t coff[3];
  { const int sb0 = ahi ? 512 + h * 64 : h * 64, sb1 = ahi ? 1536 : 1024 + h * 64, sb2 = 1600;
    coff[0] = (size_t)at * NZR + sb0 + apart * 8; coff[1] = (size_t)at * NZR + sb1 + apart * 8; coff[2] = (size_t)at * NZR + sb2 + apart * 8; }
  u32x4 pre[3];
  { const int t0 = (d ? nch - 1 : 0) * 16;
#pragma unroll
    for (int i = 0; i < 3; ++i) pre[i] = *(const u32x4*)(zr + (size_t)(row0 + t0) * NZR + coff[i]); }
  __syncthreads();
  for (int ci = 0; ci < nch; ++ci) {
    const int chunk = d ? nch - 1 - ci : ci, t0 = chunk * 16;
    { const int o = at * 64 + apart * 8; float f[8];
      unpack8(pre[0], f);
      if (ahi == 0) { *(f32x4*)(sR + o) = (f32x4){f[0], f[1], f[2], f[3]}; *(f32x4*)(sR + o + 4) = (f32x4){f[4], f[5], f[6], f[7]}; }
      else { *(f32x4*)(sK + o) = (f32x4){f[0], f[1], f[2], f[3]}; *(f32x4*)(sK + o + 4) = (f32x4){f[4], f[5], f[6], f[7]}; float ps = 0.f;
#pragma unroll
        for (int e = 0; e < 8; ++e) { const float kk = f[e] * sKK[apart * 8 + e]; ps += kk * kk; }
        ps += dppf<0xB1>(ps); ps += dppf<0x4E>(ps); ps += dppf<0x141>(ps);
        if (apart == 0) sKn[at] = ps; }
      unpack8(pre[1], f);
      if (ahi == 0) { *(f32x4*)(sV + o) = (f32x4){f[0], f[1], f[2], f[3]}; *(f32x4*)(sV + o + 4) = (f32x4){f[4], f[5], f[6], f[7]}; }
      else { float g[8];
#pragma unroll
        for (int e = 0; e < 8; ++e) g[e] = 1.f - 2.f * frcp(__expf(2.f * f[e]) + 1.f);
        *(u32x4*)(sWT + at * LDT + apart * 8) = pack8(g); }
      if (ahi == 0) *(u32x4*)(sAL + at * LDT + apart * 8) = pre[2];
    }
    __syncthreads();
    {
      f32x4 aw = {0.f, 0.f, 0.f, 0.f}, aa = {0.f, 0.f, 0.f, 0.f};
#pragma unroll
      for (int ks = 0; ks < 2; ++ks) { const bf16x8 fw = *(const bf16x8*)(sWT + fr * LDT + ks * 32 + fq * 8); const bf16x8 fa = *(const bf16x8*)(sAL + fr * LDT + ks * 32 + fq * 8);
        aw = MFMA16(fw, bw[ks], aw); aa = MFMA16(fa, ba[ks], aa); }
      const float kkc = sKK[cc];
#pragma unroll
      for (int j = 0; j < 4; ++j) { const int t = fq * 4 + j, o = t * 64 + cc;
        const float dec = __expf(-0.6065306597f * fsig(w0c + aw[j]));
        const float a = fsig(a0c + aa[j]);
        const float kv = sK[o];
        const float kkv = kv * kkc * __builtin_amdgcn_rsqf(fmaxf(sKn[t], 1e-24f));
        sW[o] = dec; sKD[o] = kv * (1.f + (a - 1.f) * kac); sB[o] = kkv * a; sNK[o] = -kkv; }
    }
    __syncthreads();
    { const int cn = ci + 1 < nch ? ci + 1 : ci; const int nt0 = (d ? nch - 1 - cn : cn) * 16;
#pragma unroll
      for (int i = 0; i < 3; ++i) pre[i] = *(const u32x4*)(zr + (size_t)(row0 + nt0) * NZR + coff[i]); }
#pragma unroll 2
    for (int si = 0; si < 16; ++si) {
      const int t = d ? 15 - si : si, o = t * 64 + kq * 4;
      const f32x4 an4 = *(const f32x4*)(sNK + o), w4 = *(const f32x4*)(sW + o), b4 = *(const f32x4*)(sB + o), kd4 = *(const f32x4*)(sKD + o), r4 = *(const f32x4*)(sR + o);
      const f32x2 v2 = *(const f32x2*)(sV + t * 64 + rbase);
      const f32x2 an[2] = {{an4[0], an4[1]}, {an4[2], an4[3]}}, wv[2] = {{w4[0], w4[1]}, {w4[2], w4[3]}}, bv[2] = {{b4[0], b4[1]}, {b4[2], b4[3]}}, kd[2] = {{kd4[0], kd4[1]}, {kd4[2], kd4[3]}}, rv[2] = {{r4[0], r4[1]}, {r4[2], r4[3]}};
      float sa[2];
#pragma unroll
      for (int r = 0; r < 2; ++r) { const f32x2 t2 = S[r][0] * an[0] + S[r][1] * an[1]; sa[r] = row16_sum(t2.x + t2.y); }
      f32x2 yv;
#pragma unroll
      for (int r = 0; r < 2; ++r) { const f32x2 sav = {sa[r], sa[r]}, vvv = {v2[r], v2[r]};
        S[r][0] = S[r][0] * wv[0] + (sav * bv[0] + vvv * kd[0]); S[r][1] = S[r][1] * wv[1] + (sav * bv[1] + vvv * kd[1]);
        const f32x2 y2 = S[r][0] * rv[0] + S[r][1] * rv[1]; yv[r] = row16_sum(y2.x + y2.y); }
      if (kq == 0) *(f32x2*)(sY + t * 64 + rbase) = yv;
    }
    __syncthreads();
    { const int t = tid >> 4, vv = half * 32 + (tid & 15) * 2; *(f32x2*)(yout + (size_t)(row0 + t0 + t) * 512 + h * 64 + vv) = *(const f32x2*)(sY + t * 64 + vv); }
  }
  __builtin_amdgcn_s_setprio(0);
  if (seq < 32) { float* so = p.out + O_RW + (((((size_t)seq * 2 + l) * 2 + d) * 8 + h) * 64 + rbase) * 64 + kq * 4;
#pragma unroll
    for (int r = 0; r < 2; ++r) *(f32x4*)(so + r * 64) = (f32x4){S[r][0].x, S[r][0].y, S[r][1].x, S[r][1].y}; }
}

DI void qk_scores(const bf16_t* sK, const bf16x8 (&qf)[2], f32x4 (&sacc)[4], int fr, int fq) {
#pragma unroll
  for (int nt = 0; nt < 4; ++nt) { sacc[nt] = (f32x4){0.f, 0.f, 0.f, 0.f};
#pragma unroll
    for (int ks = 0; ks < 2; ++ks) { const bf16x8 kf = *(const bf16x8*)(sK + (nt * 16 + fr) * LDT + ks * 32 + fq * 8); sacc[nt] = MFMA16(kf, qf[ks], sacc[nt]); } }
}
DI void pv_accum(const bf16_t* sVt, const f32x4 (&pacc)[4], f32x4 (&o)[4], int fr, int fq) {
#pragma unroll
  for (int s = 0; s < 2; ++s) {
    bf16x8 pf; { const unsigned a = pack2(pacc[2 * s][0], pacc[2 * s][1]), b = pack2(pacc[2 * s][2], pacc[2 * s][3]), c = pack2(pacc[2 * s + 1][0], pacc[2 * s + 1][1]), dd = pack2(pacc[2 * s + 1][2], pacc[2 * s + 1][3]);
      const u32x4 u = (u32x4){a, b, c, dd}; pf = __builtin_bit_cast(bf16x8, u); }
#pragma unroll
    for (int dt = 0; dt < 4; ++dt) { const u32x2 lo = *(const u32x2*)(sVt + (dt * 16 + fr) * LDT + 32 * s + 4 * fq), hi = *(const u32x2*)(sVt + (dt * 16 + fr) * LDT + 32 * s + 16 + 4 * fq);
      const u32x4 u = (u32x4){lo[0], lo[1], hi[0], hi[1]}; const bf16x8 vf = __builtin_bit_cast(bf16x8, u); o[dt] = MFMA16(vf, pf, o[dt]); }
  }
}
DI void put_kv(bf16_t* sK, bf16_t* sVt, int key, int part, const float (&kf)[8], int vkey, int vpart, const float (&vf)[8]) {
  *(u32x4*)(sK + key * LDT + part * 8) = pack8(kf);
#pragma unroll
  for (int e = 0; e < 8; ++e) sVt[(vpart * 8 + e) * LDT + vkey] = f2bf(vf[e]);
}
DI void softmax_tile(f32x4 (&sacc)[4], f32x4 (&o)[4], float& mrun, float& lrun) {
  float mx = sacc[0][0];
#pragma unroll
  for (int nt = 0; nt < 4; ++nt)
#pragma unroll
    for (int j = 0; j < 4; ++j) mx = fmaxf(mx, sacc[nt][j]);
  mx = fmaxf(mx, shfl_x(mx, 16)); mx = fmaxf(mx, shfl_x(mx, 32));
  const float mnew = fmaxf(mrun, mx), alpha = __builtin_amdgcn_exp2f(mrun - mnew); mrun = mnew;
  float ls = 0.f;
#pragma unroll
  for (int nt = 0; nt < 4; ++nt)
#pragma unroll
    for (int j = 0; j < 4; ++j) { const float pv = __builtin_amdgcn_exp2f(sacc[nt][j] - mnew); sacc[nt][j] = pv; ls += pv; }
  lrun = lrun * alpha + ls;
#pragma unroll
  for (int dt = 0; dt < 4; ++dt) o[dt] *= alpha;
}
constexpr float LOG2E = 1.4426950408889634f;

__device__ void dense_task(const P& p, int b, int h, int qb, char* smem) {
  bf16_t* sK = (bf16_t*)smem; bf16_t* sVt = sK + 64 * LDT;
  const int tid = tidx(), lane = tid & 63, wave = tid >> 6, fr = lane & 15, fq = lane >> 4;
  const bf16_t* zn = (const bf16_t*)(p.ws + WS_ZN); bf16_t* ona = (bf16_t*)(p.ws + WS_ONA);
  const int qrow = b * 256 + qb * 64 + wave * 16 + fr;
  bf16x8 qf[2];
#pragma unroll
  for (int ks = 0; ks < 2; ++ks) qf[ks] = *(const bf16x8*)(zn + (size_t)qrow * NZN + h * 64 + ks * 32 + fq * 8);
  f32x4 o[4]; for (int dt = 0; dt < 4; ++dt) o[dt] = (f32x4){0.f, 0.f, 0.f, 0.f};
  float mrun = -1e30f, lrun = 0.f;
  u32x4 pk[2], pv[2];
#pragma unroll
  for (int i = 0; i < 2; ++i) { const int c = tid + 256 * i, key = c >> 3, part = c & 7, vkey = c & 63, vpart = c >> 6; pk[i] = *(const u32x4*)(zn + (size_t)(b * 256 + key) * NZN + h * 64 + part * 8 + 512); pv[i] = *(const u32x4*)(zn + (size_t)(b * 256 + vkey) * NZN + h * 64 + vpart * 8 + 1024); }
  for (int kt = 0; kt < 4; ++kt) {
    __syncthreads();
#pragma unroll
    for (int i = 0; i < 2; ++i) { const int c = tid + 256 * i, key = c >> 3, part = c & 7, vkey = c & 63, vpart = c >> 6; float vf[8]; unpack8(pv[i], vf);
      *(u32x4*)(sK + key * LDT + part * 8) = pk[i];
#pragma unroll
      for (int e = 0; e < 8; ++e) sVt[(vpart * 8 + e) * LDT + vkey] = f2bf(vf[e]); }
    __syncthreads();
    { const int kn = kt < 3 ? kt + 1 : 3;
#pragma unroll
      for (int i = 0; i < 2; ++i) { const int c = tid + 256 * i, key = c >> 3, part = c & 7, vkey = c & 63, vpart = c >> 6; pk[i] = *(const u32x4*)(zn + (size_t)(b * 256 + kn * 64 + key) * NZN + h * 64 + part * 8 + 512); pv[i] = *(const u32x4*)(zn + (size_t)(b * 256 + kn * 64 + vkey) * NZN + h * 64 + vpart * 8 + 1024); } }
    f32x4 sacc[4]; qk_scores(sK, qf, sacc, fr, fq);
#pragma unroll
    for (int nt = 0; nt < 4; ++nt) sacc[nt] *= (0.125f * LOG2E);
    softmax_tile(sacc, o, mrun, lrun);
    pv_accum(sVt, sacc, o, fr, fq);
  }
  lrun += shfl_x(lrun, 16); lrun += shfl_x(lrun, 32); const float inv = 1.f / lrun;
#pragma unroll
  for (int dt = 0; dt < 4; ++dt) { u32x2 ov; ov.x = pack2(o[dt][0] * inv, o[dt][1] * inv); ov.y = pack2(o[dt][2] * inv, o[dt][3] * inv); *(u32x2*)(ona + (size_t)qrow * LDO + h * 64 + dt * 16 + fq * 4) = ov; }
}

__device__ void na_task(const P& p, int l, int b, int h, int r, char* smem) {
  bf16_t* sK = (bf16_t*)smem; bf16_t* sVt = sK + 64 * LDT; float* sRpb = (float*)(sVt + 64 * LDT);
  const int tid = tidx(), lane = tid & 63, wave = tid >> 6, fr = lane & 15, fq = lane >> 4;
  const bf16_t* zn = (const bf16_t*)(p.ws + WS_ZN); bf16_t* ona = (bf16_t*)(p.ws + WS_ONA);
  const int base = MC + b * 1024, qcol = wave * 16 + fr, qrow = base + r * 64 + qcol;
  int rs = r - 4; rs = rs < 0 ? 0 : (rs > 8 ? 8 : rs);
  int cs = qcol - 8; cs = cs < 0 ? 0 : (cs > 48 ? 48 : cs);
  __syncthreads();
  for (int e = tid; e < 465; e += NT) sRpb[e] = p.na_rpb[((size_t)l * 8 + h) * 465 + e] * LOG2E;
  bf16x8 qf[2];
#pragma unroll
  for (int ks = 0; ks < 2; ++ks) qf[ks] = *(const bf16x8*)(zn + (size_t)qrow * NZN + h * 64 + ks * 32 + fq * 8);
  f32x4 o[4]; for (int dt = 0; dt < 4; ++dt) o[dt] = (f32x4){0.f, 0.f, 0.f, 0.f};
  float mrun = -1e30f, lrun = 0.f;
  u32x4 pre[8];
#define NA_ISSUE(KT) do { const int kt_ = (KT); \
    if (kt_ < 8) { _Pragma("unroll") for (int i = 0; i < 2; ++i) { const int c = tid + 256 * i, key = c >> 3, part = c & 7, vkey = c & 63, vpart = c >> 6; \
        pre[4 * i] = *(const u32x4*)(zn + (size_t)(base + (rs + kt_) * 64 + key) * NZN + h * 64 + part * 8 + 512); pre[4 * i + 1] = *(const u32x4*)(zn + (size_t)(base + (rs + kt_) * 64 + vkey) * NZN + h * 64 + vpart * 8 + 1024); } } \
    else { _Pragma("unroll") for (int i = 0; i < 2; ++i) { const int c = tid + 256 * i, key = c >> 3, part = c & 7, vkey = c & 63, vpart = c >> 6; const size_t cb_ = (((size_t)b * 2 + l) * 8 + h) * 256 + (kt_ - 8) * 64; const size_t co = (cb_ + key) * 64 + part * 8, cv = (cb_ + vkey) * 64 + vpart * 8; \
        pre[4 * i] = *(const u32x4*)(p.cache_k + co); pre[4 * i + 1] = *(const u32x4*)(p.cache_k + co + 4); pre[4 * i + 2] = *(const u32x4*)(p.cache_v + cv); pre[4 * i + 3] = *(const u32x4*)(p.cache_v + cv + 4); } } } while (0)
  NA_ISSUE(0);
  for (int kt = 0; kt < 12; ++kt) {
    __syncthreads();
    if (kt < 8) {
#pragma unroll
      for (int i = 0; i < 2; ++i) { const int c = tid + 256 * i, key = c >> 3, part = c & 7, vkey = c & 63, vpart = c >> 6; float vf[8]; unpack8(pre[4 * i + 1], vf);
        *(u32x4*)(sK + key * LDT + part * 8) = pre[4 * i];
#pragma unroll
        for (int e = 0; e < 8; ++e) sVt[(vpart * 8 + e) * LDT + vkey] = f2bf(vf[e]); }
    } else {
#pragma unroll
      for (int i = 0; i < 2; ++i) { const int c = tid + 256 * i, key = c >> 3, part = c & 7, vkey = c & 63, vpart = c >> 6;
        const f32x4 k0 = __builtin_bit_cast(f32x4, pre[4 * i]), k1 = __builtin_bit_cast(f32x4, pre[4 * i + 1]), v0 = __builtin_bit_cast(f32x4, pre[4 * i + 2]), v1 = __builtin_bit_cast(f32x4, pre[4 * i + 3]);
        const float kf[8] = {k0[0], k0[1], k0[2], k0[3], k1[0], k1[1], k1[2], k1[3]}; const float vf[8] = {v0[0], v0[1], v0[2], v0[3], v1[0], v1[1], v1[2], v1[3]};
        put_kv(sK, sVt, key, part, kf, vkey, vpart, vf); }
    }
    __syncthreads();
    NA_ISSUE(kt < 11 ? kt + 1 : 11);
    f32x4 sacc[4]; qk_scores(sK, qf, sacc, fr, fq);
    if (kt < 8) { const int dr = rs + kt - r + 7;
#pragma unroll
      for (int nt = 0; nt < 4; ++nt)
#pragma unroll
        for (int j = 0; j < 4; ++j) { const int kc = nt * 16 + fq * 4 + j; const bool valid = kc >= cs && kc < cs + 16; int dc = kc - qcol; dc = dc < -15 ? -15 : (dc > 15 ? 15 : dc);
          sacc[nt][j] = valid ? sacc[nt][j] * (0.125f * LOG2E) + sRpb[dr * 31 + dc + 15] : -1e30f; }
    } else {
#pragma unroll
      for (int nt = 0; nt < 4; ++nt) sacc[nt] *= (0.125f * LOG2E);
    }
    softmax_tile(sacc, o, mrun, lrun);
    pv_accum(sVt, sacc, o, fr, fq);
  }
#undef NA_ISSUE
  lrun += shfl_x(lrun, 16); lrun += shfl_x(lrun, 32); const float inv = 1.f / lrun;
#pragma unroll
  for (int dt = 0; dt < 4; ++dt) { u32x2 ov; ov.x = pack2(o[dt][0] * inv, o[dt][1] * inv); ov.y = pack2(o[dt][2] * inv, o[dt][3] * inv); *(u32x2*)(ona + (size_t)qrow * LDO + h * 64 + dt * 16 + fq * 4) = ov; }
}

DI void rope8(const float (&own)[8], const float (&par)[8], int part, int n, float (&out)[8]) {
  const float pos = (float)((part >> 2) ? (n & 63) : (n >> 6));
  const bool isx2 = (part & 3) >= 2;
#pragma unroll
  for (int e = 0; e < 8; ++e) { const int i = (part & 1) * 8 + e; const float ang = pos * __builtin_amdgcn_exp2f(-(float)i * 0.830482023721841f); const float sn = __sinf(ang), cs = __cosf(ang);
    out[e] = isx2 ? par[e] * sn + own[e] * cs : own[e] * cs - par[e] * sn; }
}

__device__ void ret_task(const P& p, int l, int seq, int h, int qb, char* smem) {
  bf16_t* sK = (bf16_t*)smem; bf16_t* sVt = sK + 64 * LDT; bf16_t* sQ = sVt + 64 * LDT;
  const int tid = tidx(), lane = tid & 63, wave = tid >> 6, fr = lane & 15, fq = lane >> 4;
  const bf16_t* zt = (const bf16_t*)(p.ws + WS_ZT); bf16_t* oret = (bf16_t*)(p.ws + WS_ORET);
  const bool lat = seq >= 32;
  const int row0 = lat ? MC + (seq - 32) * 1024 : seq * 256, T = lat ? 1024 : 256, nkt = T >> 6;
  const float xf = p.ret_decay[(l * 2 + 0) * 8 + h], xb = p.ret_decay[(l * 2 + 1) * 8 + h];
  const float lgf = -log1pf(__expf(-xf)) * LOG2E, lgb = -log1pf(__expf(-xb)) * LOG2E;
  __syncthreads();
#pragma unroll
  for (int i = 0; i < 2; ++i) { const int c = tid + 256 * i, qi = c >> 3, part = c & 7; const int n = qb * 64 + qi; const size_t ro = (size_t)(row0 + n) * LZT + h * 64;
    const u32x4 own = *(const u32x4*)(zt + ro + part * 8);
    if (lat) { const u32x4 par = *(const u32x4*)(zt + ro + (part ^ 2) * 8); float fo[8], fp[8], out[8]; unpack8(own, fo); unpack8(par, fp); rope8(fo, fp, part, n, out); *(u32x4*)(sQ + qi * LDT + part * 8) = pack8(out); }
    else *(u32x4*)(sQ + qi * LDT + part * 8) = own; }
  __syncthreads();
  const int qi = wave * 16 + fr, nq = qb * 64 + qi;
  bf16x8 qf[2];
#pragma unroll
  for (int ks = 0; ks < 2; ++ks) qf[ks] = *(const bf16x8*)(sQ + qi * LDT + ks * 32 + fq * 8);
  f32x4 o[4]; for (int dt = 0; dt < 4; ++dt) o[dt] = (f32x4){0.f, 0.f, 0.f, 0.f};
  u32x4 rk[2], rp[2], rv[2];
#define RET_ISSUE(KT) do { _Pragma("unroll") for (int i = 0; i < 2; ++i) { const int c = tid + 256 * i, key = c >> 3, part = c & 7, vkey = c & 63, vpart = c >> 6; const size_t ro = (size_t)(row0 + (KT) * 64 + key) * LZT + h * 64; \
    rk[i] = *(const u32x4*)(zt + ro + 512 + part * 8); rp[i] = *(const u32x4*)(zt + ro + 512 + (part ^ 2) * 8); rv[i] = *(const u32x4*)(zt + (size_t)(row0 + (KT) * 64 + vkey) * LZT + h * 64 + 1024 + vpart * 8); } } while (0)
  RET_ISSUE(0);
  for (int kt = 0; kt < nkt; ++kt) {
    __syncthreads();
#pragma unroll
    for (int i = 0; i < 2; ++i) { const int c = tid + 256 * i, key = c >> 3, part = c & 7, vkey = c & 63, vpart = c >> 6; const int n = kt * 64 + key;
      float kf[8], vf[8]; unpack8(rk[i], kf); unpack8(rv[i], vf);
      if (lat) { float fp[8], out[8]; unpack8(rp[i], fp); rope8(kf, fp, part, n, out);
#pragma unroll
        for (int e = 0; e < 8; ++e) kf[e] = out[e]; }
#pragma unroll
      for (int e = 0; e < 8; ++e) kf[e] *= 0.125f;
      put_kv(sK, sVt, key, part, kf, vkey, vpart, vf); }
    __syncthreads();
    RET_ISSUE(kt + 1 < nkt ? kt + 1 : kt);
    f32x4 sacc[4]; qk_scores(sK, qf, sacc, fr, fq);
#pragma unroll
    for (int nt = 0; nt < 4; ++nt)
#pragma unroll
      for (int j = 0; j < 4; ++j) { const int mk = kt * 64 + nt * 16 + fq * 4 + j; const int df = nq - mk;
        const float ex = __builtin_amdgcn_exp2f((df > 0 ? lgf : -lgb) * (float)df); sacc[nt][j] *= (df == 0 ? 2.f : ex); }
    pv_accum(sVt, sacc, o, fr, fq);
  }
#undef RET_ISSUE
  if (lat) {
    for (int dir = 0; dir < 2; ++dir) {
      __syncthreads();
      const float* s0 = p.state_ret + ((((size_t)(seq - 32) * 2 + l) * 2 + dir) * 8 + h) * 4096;
#pragma unroll
      for (int i = 0; i < 2; ++i) { const int c = tid + 256 * i, dk = c & 63, part = c >> 6; const float4 a = *(const float4*)(s0 + dk * 64 + part * 8), bq = *(const float4*)(s0 + dk * 64 + part * 8 + 4);
        const float vf[8] = {a.x, a.y, a.z, a.w, bq.x, bq.y, bq.z, bq.w};
#pragma unroll
        for (int e = 0; e < 8; ++e) sVt[(part * 8 + e) * LDT + dk] = f2bf(vf[e]); }
      __syncthreads();
      const float xi = dir == 0 ? exp2f(lgf * (float)(nq + 1)) : exp2f(lgb * (float)(T - nq));
      f32x4 pacc[4];
#pragma unroll
      for (int s = 0; s < 2; ++s)
#pragma unroll
        for (int hh = 0; hh < 2; ++hh)
#pragma unroll
          for (int j = 0; j < 4; ++j) pacc[2 * s + hh][j] = xi * bf2f(sQ[qi * LDT + 32 * s + 16 * hh + 4 * fq + j]);
      pv_accum(sVt, pacc, o, fr, fq);
    }
  }
  float s1 = 0.f;
#pragma unroll
  for (int dt = 0; dt < 4; ++dt)
#pragma unroll
    for (int j = 0; j < 4; ++j) s1 += o[dt][j];
  s1 += shfl_x(s1, 16); s1 += shfl_x(s1, 32); const float mu = s1 * (1.f / 64.f);
  float s2 = 0.f;
#pragma unroll
  for (int dt = 0; dt < 4; ++dt)
#pragma unroll
    for (int j = 0; j < 4; ++j) { const float dlt = o[dt][j] - mu; s2 += dlt * dlt; }
  s2 += shfl_x(s2, 16); s2 += shfl_x(s2, 32); const float rstd = rsqrtf(s2 * (1.f / 64.f) + 1e-5f);
  const size_t qrow = (size_t)(row0 + nq);
#pragma unroll
  for (int dt = 0; dt < 4; ++dt) { const int dv = h * 64 + dt * 16 + fq * 4; const u32x2 gr = *(const u32x2*)(zt + qrow * LZT + 1536 + dv); const float4 gn = *(const float4*)(p.ret_gn + l * 512 + dv);
    const float g0 = bflo(gr.x), g1 = bfhi(gr.x), g2 = bflo(gr.y), g3 = bfhi(gr.y);
    u32x2 ov; ov.x = pack2((o[dt][0] - mu) * rstd * gn.x * g0 * sigmoidf_(g0), (o[dt][1] - mu) * rstd * gn.y * g1 * sigmoidf_(g1));
    ov.y = pack2((o[dt][2] - mu) * rstd * gn.z * g2 * sigmoidf_(g2), (o[dt][3] - mu) * rstd * gn.w * g3 * sigmoidf_(g3));
    *(u32x2*)(oret + qrow * LDO + dv) = ov; }
}

__device__ void retstate_task(const P& p, int l, int b, int h, char* smem) {
  float* sKf = (float*)smem; float* sKb = sKf + 64 * 64; float* sV = sKb + 64 * 64;
  const int tid = tidx(), dk = tid >> 2, dq = tid & 3;
  const bf16_t* zt = (const bf16_t*)(p.ws + WS_ZT);
  const float xf = p.ret_decay[(l * 2 + 0) * 8 + h], xb = p.ret_decay[(l * 2 + 1) * 8 + h];
  const float lgf = -log1pf(__expf(-xf)) * LOG2E, lgb = -log1pf(__expf(-xb)) * LOG2E;
  float af[16], ab[16];
#pragma unroll
  for (int i = 0; i < 16; ++i) { af[i] = 0.f; ab[i] = 0.f; }
  for (int kt = 0; kt < 4; ++kt) {
    __syncthreads();
#pragma unroll
    for (int i = 0; i < 2; ++i) { const int c = tid + 256 * i, key = c >> 3, part = c & 7, m = kt * 64 + key; const size_t ro = (size_t)(b * 256 + m) * LZT + h * 64 + part * 8;
      float kf[8], vf[8]; unpack8(*(const u32x4*)(zt + ro + 512), kf); unpack8(*(const u32x4*)(zt + ro + 1024), vf);
      const float wf = 0.125f * exp2f(lgf * (float)(255 - m)), wb = 0.125f * exp2f(lgb * (float)m);
#pragma unroll
      for (int e = 0; e < 8; ++e) { sKf[key * 64 + part * 8 + e] = kf[e] * wf; sKb[key * 64 + part * 8 + e] = kf[e] * wb; sV[key * 64 + part * 8 + e] = vf[e]; } }
    __syncthreads();
    for (int m = 0; m < 64; ++m) { const float kf = sKf[m * 64 + dk], kb = sKb[m * 64 + dk];
#pragma unroll
      for (int i = 0; i < 4; ++i) { const f32x4 vv = *(const f32x4*)(sV + m * 64 + dq * 16 + i * 4);
#pragma unroll
        for (int j = 0; j < 4; ++j) { af[i * 4 + j] += kf * vv[j]; ab[i * 4 + j] += kb * vv[j]; } } }
  }
  float* of = p.out + O_RT + ((((size_t)b * 2 + l) * 2 + 0) * 8 + h) * 4096 + dk * 64 + dq * 16; float* ob = of + 8 * 4096;
#pragma unroll
  for (int i = 0; i < 16; ++i) { of[i] = af[i]; ob[i] = ab[i]; }
}

constexpr int Q_SCAN_L = 64, Q_SCAN_C = 512, Q_RET_L = 256, Q_NA = 256, Q_DENSE = 512, Q_RET_C = 512, Q_RST = 128;
template <int QMASK> __device__ void phase_mixers(const P& p, int l, char* smem_, int rep = 0) {
  __shared__ int s_task;
  int* ctr = (int*)(p.ws + WS_CTRL) + 64 * (l + 1) + 4 * rep;
  const int vb = vhalf(); char* smem = smem_ + vb * VSMEM;
  if (QMASK & 1) for (;;) {
    __syncthreads();
    if (ptid() == 0) s_task = atomicAdd(ctr, 1);
    __syncthreads();
    const int tk = s_task;
    if (tk >= Q_SCAN_L + Q_SCAN_C) break;
    const bool lat = tk < Q_SCAN_L; const int t2 = lat ? tk : tk - Q_SCAN_L;
    scan_task(p, l, (lat ? 32 : 0) + (t2 >> 4), (t2 >> 1) & 7, t2 & 1, vb, smem);
  }
  if (QMASK & 2) for (;;) {
    __syncthreads();
    if (ptid() == 0) s_task = atomicAdd(ctr + 16, 1);
    __syncthreads();
    const int tk = s_task;
    if (tk >= Q_RET_L + Q_RET_C) break;
    if (tk < Q_RET_L) ret_task(p, l, 32 + (tk >> 6), (tk >> 3) & 7, (tk & 7) * 2 + vb, smem);
    else { const int t2 = tk - Q_RET_L; ret_task(p, l, t2 >> 4, (t2 >> 1) & 7, (t2 & 1) * 2 + vb, smem); }
  }
  if (QMASK & 4) for (;;) {
    __syncthreads();
    if (ptid() == 0) s_task = atomicAdd(ctr + 32, 1);
    __syncthreads();
    int tk = s_task;
    if (tk >= Q_NA + Q_DENSE + Q_RST) break;
    if (tk < Q_NA) { na_task(p, l, tk >> 6, (tk >> 3) & 7, (tk & 7) * 2 + vb, smem); continue; } tk -= Q_NA;
    if (tk < Q_DENSE) { dense_task(p, tk >> 4, (tk >> 1) & 7, (tk & 1) * 2 + vb, smem); continue; } tk -= Q_DENSE;
    retstate_task(p, l, tk >> 2, (tk & 3) * 2 + vb, smem);
  }
}

__device__ void phase_rwkv_post(const P& p, int l, char* smem) {
  const bf16_t* zr = (const bf16_t*)(p.ws + WS_ZR); const float* yf = (const float*)(p.ws + WS_Y); const float* yb = yf + (size_t)MT * 512; bf16_t* oa = (bf16_t*)(p.ws + WS_OA);
  const bf16_t* Gt = (const bf16_t*)(p.ws + WS_WG);
  const int tid = ptid(), lane = tid & 63, wave = tid >> 6, wr = wave >> 2, wc = wave & 3, fr = lane & 15, fq = lane >> 4;
  TileIter ti; int mt, nt; ti.init(96, 2);
  while (ti.next(mt, nt)) {
    const int row0 = mt * 128, n0 = nt * 256;
    f32x4 acc[4][4]; zero_acc<4, 4>(acc);
    TileSrc s{zr + 1664, NZR, row0, Gt, LDG, n0, n0 + 128, 128}; gemm_tile<4, 4>(acc, s, smem);
    const int cb = n0 + wc * 64 + fq * 4;
#pragma unroll
    for (int m = 0; m < 4; ++m) { const size_t row = (size_t)(row0 + wr * 64 + m * 16 + fr);
      f32x4 y[4]; float s1 = 0.f, rk = 0.f; f32x4 vv[4];
#pragma unroll
      for (int n = 0; n < 4; ++n) { const int c = cb + n * 16; y[n] = *(const f32x4*)(yf + row * 512 + c) + *(const f32x4*)(yb + row * 512 + c); s1 += y[n][0] + y[n][1] + y[n][2] + y[n][3];
        const u32x2 rr = *(const u32x2*)(zr + row * NZR + c), kk = *(const u32x2*)(zr + row * NZR + 512 + c), v2 = *(const u32x2*)(zr + row * NZR + 1024 + c); const f32x4 rkw = *(const f32x4*)(p.rwkv_r_k + l * 512 + c);
        rk += bflo(rr.x) * bflo(kk.x) * rkw[0] + bfhi(rr.x) * bfhi(kk.x) * rkw[1] + bflo(rr.y) * bflo(kk.y) * rkw[2] + bfhi(rr.y) * bfhi(kk.y) * rkw[3];
        vv[n] = (f32x4){bflo(v2.x), bfhi(v2.x), bflo(v2.y), bfhi(v2.y)}; }
      s1 += shfl_x(s1, 16); s1 += shfl_x(s1, 32); rk += shfl_x(rk, 16); rk += shfl_x(rk, 32);
      const float mu = s1 * (1.f / 64.f); float s2 = 0.f;
#pragma unroll
      for (int n = 0; n < 4; ++n)
#pragma unroll
        for (int j = 0; j < 4; ++j) { const float dl = y[n][j] - mu; s2 += dl * dl; }
      s2 += shfl_x(s2, 16); s2 += shfl_x(s2, 32); const float rstd = rsqrtf(s2 * (1.f / 64.f) + 64e-5f);
#pragma unroll
      for (int n = 0; n < 4; ++n) { const int c = cb + n * 16; const f32x4 lg = *(const f32x4*)(p.rwkv_ln_g + l * 512 + c), lb = *(const f32x4*)(p.rwkv_ln_b + l * 512 + c);
        float o[4];
#pragma unroll
        for (int j = 0; j < 4; ++j) o[j] = ((y[n][j] - mu) * rstd * lg[j] + lb[j] + rk * vv[n][j]) * acc[m][n][j];
        u32x2 ov; ov.x = pack2(o[0], o[1]); ov.y = pack2(o[2], o[3]); *(u32x2*)(oa + row * LDO + c) = ov; }
    }
  }
}

DI void convert_layer_a(const P& p, int l, char* smem) {
  convert_T(p.w_in + (size_t)l * D * INC, D, INC, (bf16_t*)(p.ws + WS_WIN), LDH, smem);
  convert_T(p.w_o_rwkv + (size_t)l * 512 * D, 512, D, (bf16_t*)(p.ws + WS_WO3), LDO, smem);
  convert_T(p.w_o_na + (size_t)l * 512 * D, 512, D, (bf16_t*)(p.ws + WS_WO3) + (size_t)1024 * LDO, LDO, smem);
  convert_T(p.w_o_ret + (size_t)l * 512 * D, 512, D, (bf16_t*)(p.ws + WS_WO3) + (size_t)2 * 1024 * LDO, LDO, smem);
  convert_T(p.w_out + (size_t)l * D * D, D, D, (bf16_t*)(p.ws + WS_WOUT), LDH, smem);
  convert_T(p.rwkv_g_up + (size_t)l * 128 * 512, 128, 512, (bf16_t*)(p.ws + WS_WG), LDG, smem);
}
DI void convert_layer_b(const P& p, int l, char* smem) {
  convert_T(p.ffn_up + (size_t)l * D * 2 * FF, D, 2 * FF, (bf16_t*)(p.ws + WS_WUP), LDH, smem);
  convert_T(p.ffn_down + (size_t)l * FF * D, FF, D, (bf16_t*)(p.ws + WS_WDN), FF, smem);
}

typedef __attribute__((address_space(4))) const P* KP;
DI KP kargs() { KP k = (KP)__builtin_amdgcn_kernarg_segment_ptr(); asm volatile("" : "+s"(k)); return k; }
template <int PH> DI void run_phase(int l, char* smem) {
#if defined(__HIP_DEVICE_COMPILE__)
  const P p = *kargs();
#else
  const P p{};
#endif
  const float* mod = (const float*)(p.ws + WS_MOD);
  float* xbuf = p.out;
  if (PH == 0) { ada_phase(p, smem); convert_layer_a(p, 0, smem); }
  else if (PH == 1) { norm_phase(p, nullptr, nullptr, nullptr, nullptr, 0, nullptr, p.norm_mix_pre, mod, 0, (bf16_t*)(p.ws + WS_H)); }
  else if (PH == 2) phase_win(p, l, smem);
  else if (PH == 4) phase_mixers<7>(p, l, smem);
  else if (PH == 5) phase_rwkv_post(p, l, smem);
  else if (PH == 6) phase_merge(p, smem);
  else if (PH == 7) { phase_gemm_f32((const bf16_t*)(p.ws + WS_MERGED), LDH, D, (const bf16_t*)(p.ws + WS_WOUT), LDH, (float*)(p.ws + WS_U), smem); }
  else if (PH == 8) { convert_layer_b(p, l, smem);
    norm_phase(p, l == 0 ? nullptr : xbuf, (const float*)(p.ws + WS_U), p.norm_mix_post + l * D, mod + (size_t)l * 5 * 6144, 2, xbuf, p.norm_ffn_pre + l * D, mod + (size_t)l * 5 * 6144, 3, (bf16_t*)(p.ws + WS_H)); }
  else if (PH == 9) phase_ffn_up(p, l, smem);
  else if (PH == 11) { phase_gemm_f32((const bf16_t*)(p.ws + WS_HID), FF, FF, (const bf16_t*)(p.ws + WS_WDN), FF, (float*)(p.ws + WS_F), smem); }
  else if (PH == 12) {
    if (l == 0) { norm_phase(p, xbuf, (const float*)(p.ws + WS_F), p.norm_ffn_post, mod, 5, xbuf, p.norm_mix_pre + D, mod + (size_t)5 * 6144, 0, (bf16_t*)(p.ws + WS_H)); convert_layer_a(p, 1, smem); }
    else norm_phase(p, xbuf, (const float*)(p.ws + WS_F), p.norm_ffn_post + D, mod + (size_t)5 * 6144, 5, xbuf, nullptr, nullptr, 0, nullptr);
  }
}

#if MEGA
__global__ void __launch_bounds__(NTP, 1) mega_kernel(P p_) {
  extern __shared__ __attribute__((aligned(16))) char smem[];
  __shared__ u32x4 xb_words;
  cg::grid_group grid = cg::this_grid();
  if (ptid() == 0) xb_words = (u32x4){0u, 0u, 0u, 0u};
  __syncthreads();
#if defined(__HIP_DEVICE_COMPILE__)
  (void)xcd_barrier_post((unsigned*)(p_.ws + WS_BAR), (volatile LAS unsigned*)&xb_words);
#define GSYNC() do { XcdBarrier xb_; xb_.bar = (unsigned*)(kargs()->ws + WS_BAR); xb_.x = xb_xcc_id(); xb_.st = (volatile LAS unsigned*)&xb_words; xcd_barrier(xb_); } while (0)
#else
#define GSYNC() do { } while (0)
#endif
  run_phase<0>(0, smem); grid.sync();
  run_phase<1>(0, smem); GSYNC();
#pragma unroll
  for (int l = 0; l < 2; ++l) {
    run_phase<2>(l, smem); GSYNC();
    if (PROBE_MASK & 1) { run_phase<2>(l, smem); GSYNC(); }
    run_phase<4>(l, smem); GSYNC();
    run_phase<5>(l, smem); GSYNC();
    run_phase<6>(l, smem); GSYNC();
    if (PROBE_MASK & 8) { run_phase<6>(l, smem); GSYNC(); }
    run_phase<7>(l, smem); GSYNC();
    if (PROBE_MASK & 16) { run_phase<7>(l, smem); GSYNC(); }
    run_phase<8>(l, smem); GSYNC();
    run_phase<9>(l, smem); GSYNC();
    if (PROBE_MASK & 32) { run_phase<9>(l, smem); GSYNC(); }
    run_phase<11>(l, smem); GSYNC();
    if (PROBE_MASK & 64) { run_phase<11>(l, smem); GSYNC(); }
    run_phase<12>(l, smem); if (l == 0) GSYNC();
  }
#undef GSYNC
}
#else
template <int PH> __global__ void __launch_bounds__(NTP, 1) phase_kernel(P p, int l) {
  extern __shared__ __attribute__((aligned(16))) char smem[];
  run_phase<PH>(l, smem);
}
#endif

extern "C" void kernel_launch(void* const* d_in, const int* in_sizes, int n_in, void* d_out, int out_size, void* d_ws, size_t ws_size, hipStream_t stream) {
  if (ws_size < WS_END || n_in < 36) { fprintf(stderr, "workspace too small: %zu < %zu\n", ws_size, (size_t)WS_END); return; }
  P p{};
  const float** pp = (const float**)&p;
  for (int i = 0; i < 36; ++i) pp[i] = (const float*)d_in[i];
  p.out = (float*)d_out; p.ws = (char*)d_ws;
  hipMemsetAsync(d_ws, 0, WS_WIN, stream);
#if MEGA
  static int grid_blocks = 0;
  if (!grid_blocks) {
    int dev = 0, cus = 0, per_cu = 0; hipGetDevice(&dev);
    hipDeviceGetAttribute(&cus, hipDeviceAttributeMultiprocessorCount, dev);
    hipFuncSetAttribute((const void*)mega_kernel, hipFuncAttributeMaxDynamicSharedMemorySize, SMEM_BYTES);
    hipOccupancyMaxActiveBlocksPerMultiprocessor(&per_cu, mega_kernel, NTP, SMEM_BYTES);
    if (per_cu > 1) per_cu = 1;
    grid_blocks = cus * per_cu;
  }
  void* args[] = {&p};
  hipError_t e = hipLaunchCooperativeKernel((void*)mega_kernel, dim3(grid_blocks), dim3(NTP), args, SMEM_BYTES, stream);
  if (e != hipSuccess) fprintf(stderr, "cooperative launch failed: %s (grid %d)\n", hipGetErrorString(e), grid_blocks);
#else
  const int G = 512;
#define LAUNCH(PH, L) do { hipFuncSetAttribute((const void*)phase_kernel<PH>, hipFuncAttributeMaxDynamicSharedMemorySize, SMEM_BYTES); phase_kernel<PH><<<G, NT, SMEM_BYTES, stream>>>(p, L); } while (0)
  LAUNCH(0, 0); LAUNCH(1, 0);
  for (int l = 0; l < 2; ++l) { LAUNCH(2, l); LAUNCH(4, l); LAUNCH(5, l); LAUNCH(6, l); LAUNCH(7, l); LAUNCH(8, l); LAUNCH(9, l); LAUNCH(11, l); LAUNCH(12, l); }
#endif
}
```

```cpp
#include <hip/hip_runtime.h>
#include <hip/hip_cooperative_groups.h>
#include <cstdio>
namespace cg = cooperative_groups;

#ifndef MEGA
#define MEGA 1
#endif
#define PROBE_MASK 0

typedef unsigned short bf16_t;
typedef short bf16x8 __attribute__((ext_vector_type(8)));
typedef short bf16x4 __attribute__((ext_vector_type(4)));
typedef float f32x4 __attribute__((ext_vector_type(4)));
typedef float f32x2 __attribute__((ext_vector_type(2)));
typedef unsigned u32x4 __attribute__((ext_vector_type(4)));
typedef unsigned u32x2 __attribute__((ext_vector_type(2)));
#define DI __device__ __forceinline__
#define MFMA16(a, b, c) __builtin_amdgcn_mfma_f32_16x16x32_bf16((a), (b), (c), 0, 0, 0)

constexpr int NT = 256;
constexpr int NTP = 512;
constexpr int VSMEM = 65536;
constexpr int D = 1024, MC = 8192, ML = 4096, MT = 12288;
constexpr int NZR = 1792, NZN = 1536, NZT = 2048, INC = 8448, FF = 2816;
constexpr int LDH = 1088, LDO = 576, LZT = 2112, LDG = 136;
constexpr int LDT = 72;
constexpr int SMEM_BYTES = 131072;
constexpr size_t O_K = 12582912, O_V = 20971520, O_RW = 29360128, O_RT = 33554432;
constexpr size_t WS_CTRL = 0;
constexpr size_t WS_MOD = 4096;
constexpr size_t WS_BAR = 262144;
constexpr size_t WS_CUF = 278528;
constexpr size_t WS_WG = 294912;
constexpr size_t WS_WIN = 434176;
constexpr size_t WS_WUP = WS_WIN;
constexpr size_t WS_WDN = WS_WIN + (size_t)5632 * LDH * 2;
constexpr size_t WS_WO3 = WS_WIN + (size_t)INC * LDH * 2;
constexpr size_t WS_WOUT = WS_WO3 + (size_t)3 * 1024 * LDO * 2;
constexpr size_t WS_H = WS_WOUT + (size_t)1024 * LDH * 2;
constexpr size_t WS_Z = WS_H + (size_t)MT * LDH * 2;
constexpr size_t WS_ZR = WS_Z;
constexpr size_t WS_ZN = WS_ZR + (size_t)MT * NZR * 2;
constexpr size_t WS_ZT = WS_ZN + (size_t)MT * NZN * 2;
constexpr size_t WS_MERGED = WS_ZR;
constexpr size_t WS_OA = WS_ZN;
constexpr size_t WS_U = WS_ZT;
constexpr size_t WS_HID = WS_Z;
constexpr size_t WS_F = WS_ZT;
constexpr size_t WS_Y = WS_ZT + (size_t)MT * LZT * 2;
constexpr size_t WS_ONA = WS_Y + (size_t)2 * MT * 512 * 4;
constexpr size_t WS_ORET = WS_ONA + (size_t)MT * LDO * 2;
constexpr size_t WS_END = WS_ORET + (size_t)MT * LDO * 2;

struct P {
  const float *x_prompt, *x_sample, *cache_k, *cache_v, *state_rwkv, *state_ret, *c, *c_ctx, *ada_w, *ada_b;
  const float *norm_mix_pre, *norm_mix_post, *norm_ffn_pre, *norm_ffn_post, *w_in, *rwkv_conv, *rwkv_w0, *rwkv_w_up, *rwkv_a0, *rwkv_a_up, *rwkv_g_up;
  const float *rwkv_k_k, *rwkv_k_a, *rwkv_r_k, *rwkv_ln_g, *rwkv_ln_b, *na_rpb, *ret_decay, *ret_gn, *w_o_rwkv, *w_o_na, *w_o_ret, *w_out, *ffn_up, *ffn_conv, *ffn_down;
  float* out; char* ws;
};

DI int threadIdx_x_raw() { return (int)__builtin_amdgcn_workitem_id_x(); }
DI int ptid() { int t = threadIdx_x_raw(); asm volatile("" : "+v"(t)); return t; }
DI int tidx() { return ptid() & 255; }
DI int vhalf() { return ptid() >> 8; }
DI int vblk() { return (int)blockIdx.x * 2 + vhalf(); }
DI int vgrid() { return (int)gridDim.x * 2; }
DI unsigned cvt_pk_bf16(float lo, float hi) { unsigned r; asm("v_cvt_pk_bf16_f32 %0, %1, %2" : "=v"(r) : "v"(lo), "v"(hi)); return r; }
DI bf16_t f2bf(float x) { return (bf16_t)(cvt_pk_bf16(x, 0.f) & 0xffffu); }
DI float bf2f(bf16_t b) { return __uint_as_float(((unsigned)b) << 16); }
DI unsigned pack2(float a, float b) { return cvt_pk_bf16(a, b); }
DI float bflo(unsigned u) { return __uint_as_float(u << 16); }
DI float bfhi(unsigned u) { return __uint_as_float(u & 0xffff0000u); }
DI void unpack8(const u32x4 r, float (&f)[8]) { f[0] = bflo(r[0]); f[1] = bfhi(r[0]); f[2] = bflo(r[1]); f[3] = bfhi(r[1]); f[4] = bflo(r[2]); f[5] = bfhi(r[2]); f[6] = bflo(r[3]); f[7] = bfhi(r[3]); }
DI u32x4 pack8(const float (&f)[8]) { u32x4 r; r[0] = pack2(f[0], f[1]); r[1] = pack2(f[2], f[3]); r[2] = pack2(f[4], f[5]); r[3] = pack2(f[6], f[7]); return r; }
DI float sigmoidf_(float x) { return __builtin_amdgcn_rcpf(1.f + __expf(-x)); }
DI float shfl_x(float v, int m) { const int lane = ptid() & 63; return __int_as_float(__builtin_amdgcn_ds_bpermute((lane ^ m) << 2, __float_as_int(v))); }
DI float wave_sum(float v) { for (int o = 32; o > 0; o >>= 1) v += shfl_x(v, o); return v; }
DI void tokinfo(int m, int& t, int& T, int& mi) { if (m < MC) { t = m & 255; T = 256; mi = 0; } else { int q = m - MC; t = q & 1023; T = 1024; mi = 1 + (q >> 10); } }

#define XB_TMO      128
#define XB_XCNT(j)  (256  + 64 * (j))
#define XB_XSUB(j)  (1280 + 64 * (j))
#define XB_XGEN(j)  (2304 + 64 * (j))
#define XB_TOP      3328
#define XB_TOPGEN   3392
#define XB_SPIN_CAP (1u << 20)
#define LAS __attribute__((address_space(3)))
DI unsigned xb_ld(unsigned* p) { return __hip_atomic_load(p, __ATOMIC_RELAXED, __HIP_MEMORY_SCOPE_AGENT); }
DI unsigned xb_add(unsigned* p, unsigned v) { return __hip_atomic_fetch_add(p, v, __ATOMIC_RELAXED, __HIP_MEMORY_SCOPE_AGENT); }
DI unsigned xb_xcc_id() { return (unsigned)__builtin_amdgcn_s_getreg((3 << 11) | 20) & 0xFu; }
#define XB_SPIN(cond, bar) do { unsigned _sp = 0; while (cond) { __builtin_amdgcn_s_sleep(1); \
    if ((++_sp & 255u) == 0u) { if (xb_ld(&(bar)[XB_TMO])) break; if (_sp > XB_SPIN_CAP) { atomicAdd(&(bar)[XB_TMO], 1u); break; } } } } while (0)
struct XcdBarrier { unsigned* bar; unsigned x; volatile LAS unsigned* st; };
DI XcdBarrier xcd_barrier_post(unsigned* bar, volatile LAS unsigned* st) {
  XcdBarrier b; b.bar = bar; b.x = xb_xcc_id(); b.st = st;
  if (ptid() == 0) (void)xb_add(&bar[XB_XCNT(b.x)], 1u);
  return b;
}
DI void xcd_barrier_complete(unsigned* bar, unsigned x, unsigned& nloc, unsigned& nx) {
  const unsigned G = gridDim.x * gridDim.y * gridDim.z;
  unsigned sum, cnt, mine, sp = 0u;
  for (;;) {
    sum = 0u; cnt = 0u; mine = 0u;
#pragma unroll
    for (unsigned j = 0; j < 16; ++j) { const unsigned c = xb_ld(&bar[XB_XCNT(j)]); sum += c; cnt += (c > 0u) ? 1u : 0u; mine = (j == x) ? c : mine; }
    if (sum == G) break;
    __builtin_amdgcn_s_sleep(1);
    if ((++sp & 255u) == 0u) { if (xb_ld(&bar[XB_TMO])) break; if (sp > XB_SPIN_CAP) { atomicAdd(&bar[XB_TMO], 1u); break; } }
  }
  nloc = mine > 0u ? mine : 1u; nx = cnt > 0u ? cnt : 1u;
}
DI void xcd_barrier(const XcdBarrier& b) {
  asm volatile("s_waitcnt vmcnt(0)" ::: "memory");
  __syncthreads();
  if (ptid() == 0) {
    unsigned* bar = b.bar;
    __builtin_amdgcn_s_waitcnt(0);
    unsigned nloc = b.st[0], nx = b.st[1];
    if (nloc == 0u) { xcd_barrier_complete(bar, b.x, nloc, nx); b.st[0] = nloc; b.st[1] = nx; }
    const unsigned old = xb_add(&bar[XB_XSUB(b.x)], 1u);
    const unsigned gen = old / nloc;
    if (old + 1u == (gen + 1u) * nloc) {
      __builtin_amdgcn_fence(__ATOMIC_RELEASE, "agent");
      asm volatile("s_waitcnt vmcnt(0)" ::: "memory");
      const unsigned og = xb_add(&bar[XB_TOP], 1u);
      const unsigned tg = og / nx;
      if (og + 1u == (tg + 1u) * nx) xb_add(&bar[XB_TOPGEN], 1u);
      else XB_SPIN(xb_ld(&bar[XB_TOPGEN]) == tg, bar);
      __builtin_amdgcn_fence(__ATOMIC_ACQUIRE, "agent");
      xb_add(&bar[XB_XGEN(b.x)], 1u);
      asm volatile("s_waitcnt vmcnt(0)" ::: "memory");
    } else {
      XB_SPIN(xb_ld(&bar[XB_XGEN(b.x)]) == gen, bar);
      __builtin_amdgcn_fence(__ATOMIC_ACQUIRE, "agent");
      asm volatile("s_waitcnt vmcnt(0)" ::: "memory");
    }
  }
  __syncthreads();
}

__device__ void convert_T(const float* __restrict__ W, int K, int N, bf16_t* __restrict__ Wt, int ldt, char* smem) {
  float* t = (float*)(smem + vhalf() * VSMEM);
  const int tid = tidx(), ntn = N >> 6, nitems = (K >> 6) * ntn;
  const int kr = tid >> 4, c4 = (tid & 15) * 4;
  f32x4 v[4];
  { const int it = vblk() < nitems ? vblk() : 0; const int k0 = (it / ntn) << 6, n0 = (it % ntn) << 6;
#pragma unroll
    for (int i = 0; i < 4; ++i) v[i] = *(const f32x4*)(W + (size_t)(k0 + kr + 16 * i) * N + n0 + c4); }
  for (int it = vblk(); it < nitems; it += vgrid()) {
    const int k0 = (it / ntn) << 6, n0 = (it % ntn) << 6;
    __syncthreads();
#pragma unroll
    for (int i = 0; i < 4; ++i) { const int k = kr + 16 * i; t[k * 65 + c4] = v[i][0]; t[k * 65 + c4 + 1] = v[i][1]; t[k * 65 + c4 + 2] = v[i][2]; t[k * 65 + c4 + 3] = v[i][3]; }
    __syncthreads();
    { const int itn = it + vgrid() < nitems ? it + vgrid() : it; const int k1 = (itn / ntn) << 6, n1 = (itn % ntn) << 6;
#pragma unroll
      for (int i = 0; i < 4; ++i) v[i] = *(const f32x4*)(W + (size_t)(k1 + kr + 16 * i) * N + n1 + c4); }
#pragma unroll
    for (int i = 0; i < 2; ++i) { const int c = tid + 256 * i, n = c >> 3, kc = c & 7; float f[8];
#pragma unroll
      for (int e = 0; e < 8; ++e) f[e] = t[(kc * 8 + e) * 65 + n];
      *(u32x4*)(Wt + (size_t)(n0 + n) * ldt + k0 + kc * 8) = pack8(f); }
  }
}

__device__ void ada_phase(const P& p, char* smem) {
  float* sc = (float*)(smem + vhalf() * VSMEM);
  float* red = sc + 640;
  float* mod = (float*)(p.ws + WS_MOD);
  const int tid = tidx(), kq = tid >> 5, cq = tid & 31;
  for (int it = vblk(); it < 2 * 48 * 8; it += vgrid()) {
    const int l = it / 384, rem = it % 384, nb = rem >> 3, ks = rem & 7;
    const int n0 = nb * 128, k0 = ks * 128;
    __syncthreads();
    for (int e = tid; e < 640; e += NT) { const int i = e >> 7, k = e & 127; const float v = (i == 0) ? p.c_ctx[k0 + k] : p.c[(i - 1) * D + k0 + k]; sc[e] = v * sigmoidf_(v); }
    __syncthreads();
    float acc[5][4];
#pragma unroll
    for (int i = 0; i < 5; ++i)
#pragma unroll
      for (int j = 0; j < 4; ++j) acc[i][j] = 0.f;
    const float* wp = p.ada_w + ((size_t)l * D + k0 + kq * 16) * 6144 + n0 + cq * 4;
#pragma unroll 4
    for (int kk = 0; kk < 16; ++kk) { const float4 w = *(const float4*)(wp + (size_t)kk * 6144);
#pragma unroll
      for (int i = 0; i < 5; ++i) { const float s = sc[i * 128 + kq * 16 + kk]; acc[i][0] += s * w.x; acc[i][1] += s * w.y; acc[i][2] += s * w.z; acc[i][3] += s * w.w; } }
#pragma unroll
    for (int i = 0; i < 5; ++i)
#pragma unroll
      for (int j = 0; j < 4; ++j) red[(kq * 5 + i) * 128 + cq * 4 + j] = acc[i][j];
    __syncthreads();
    for (int e = tid; e < 640; e += NT) { const int i = e >> 7, n = e & 127; float s = 0.f;
#pragma unroll
      for (int q = 0; q < 8; ++q) s += red[(q * 5 + i) * 128 + n];
      if (ks == 0) s += p.ada_b[l * 6144 + n0 + n];
      atomicAdd(mod + ((size_t)l * 5 + i) * 6144 + n0 + n, s); }
  }
}

__device__ void norm_phase(const P& p, const float* xin  , const float* u, const float* gpost, const float* modU, int gate_idx,
                           float* xout, const float* gpre, const float* modN, int shift_idx, bf16_t* hout) {
  const int lane = tidx() & 63, wave = tidx() >> 6, nw = NT / 64;
  for (int m = vblk() * nw + wave; m < MT; m += vgrid() * nw) {
    int t, T, mi; tokinfo(m, t, T, mi);
    const float* xr = xin ? xin + (size_t)m * D : (m < MC ? p.x_prompt + (size_t)m * D : p.x_sample + (size_t)(m - MC) * D);
    float4 x[4];
#pragma unroll
    for (int i = 0; i < 4; ++i) x[i] = *(const float4*)(xr + i * 256 + lane * 4);
    if (u) {
      float4 uu[4]; float ss = 0.f;
#pragma unroll
      for (int i = 0; i < 4; ++i) { uu[i] = *(const float4*)(u + (size_t)m * D + i * 256 + lane * 4); ss += uu[i].x * uu[i].x + uu[i].y * uu[i].y + uu[i].z * uu[i].z + uu[i].w * uu[i].w; }
      ss = wave_sum(ss); const float rs = rsqrtf(ss * (1.f / D) + 1e-6f);
#pragma unroll
      for (int i = 0; i < 4; ++i) { const int c = i * 256 + lane * 4; const float4 g = *(const float4*)(gpost + c); const float4 ga = *(const float4*)(modU + ((size_t)mi * 6 + gate_idx) * D + c);
        x[i].x += ga.x * uu[i].x * rs * g.x; x[i].y += ga.y * uu[i].y * rs * g.y; x[i].z += ga.z * uu[i].z * rs * g.z; x[i].w += ga.w * uu[i].w * rs * g.w; }
    }
    if (xout) {
#pragma unroll
      for (int i = 0; i < 4; ++i) *(float4*)(xout + (size_t)m * D + i * 256 + lane * 4) = x[i];
    }
    if (hout) {
      float ss = 0.f;
#pragma unroll
      for (int i = 0; i < 4; ++i) ss += x[i].x * x[i].x + x[i].y * x[i].y + x[i].z * x[i].z + x[i].w * x[i].w;
      ss = wave_sum(ss); const float rs = rsqrtf(ss * (1.f / D) + 1e-6f);
#pragma unroll
      for (int i = 0; i < 4; ++i) { const int c = i * 256 + lane * 4; const float4 g = *(const float4*)(gpre + c);
        const float4 sh = *(const float4*)(modN + ((size_t)mi * 6 + shift_idx) * D + c); const float4 sc = *(const float4*)(modN + ((size_t)mi * 6 + shift_idx + 1) * D + c);
        u32x2 o; o.x = pack2(x[i].x * rs * g.x * (1.f + sc.x) + sh.x, x[i].y * rs * g.y * (1.f + sc.y) + sh.y); o.y = pack2(x[i].z * rs * g.z * (1.f + sc.z) + sh.z, x[i].w * rs * g.w * (1.f + sc.w) + sh.w);
        *(u32x2*)(hout + (size_t)m * LDH + c) = o; }
    }
  }
}

struct TileSrc { const bf16_t* A; int lda; int arow0; const bf16_t* B; int ldb; int brow0, brow1; int K; };

template <int MM, int NN> DI void zero_acc(f32x4 (&acc)[MM][NN]) {
#pragma unroll
  for (int m = 0; m < MM; ++m)
#pragma unroll
    for (int n = 0; n < NN; ++n) acc[m][n] = (f32x4){0.f, 0.f, 0.f, 0.f};
}

template <int MM, int NN> struct Gemm {
  static constexpr int NA = MM / 2, NB = NN;
  unsigned oa_[NA], ob_[NB]; const bf16_t* A; const bf16_t* B; int nk; u32x4 ra[NA], rb[NB];
#define GT_LOAD(KT) do { const int kn_ = ((KT) < nk ? (KT) : nk - 1) * 64; \
    _Pragma("unroll") for (int i = 0; i < NA; ++i) ra[i] = *(const u32x4*)(A + (oa_[i] + kn_)); \
    _Pragma("unroll") for (int i = 0; i < NB; ++i) rb[i] = *(const u32x4*)(B + (ob_[i] + kn_)); } while (0)
  DI void begin(const TileSrc& s) {
    const int tid = ptid();
#pragma unroll
    for (int i = 0; i < NA; ++i) { const int row = (tid >> 3) + 64 * i, kc = tid & 7;
      int ar = s.arow0 + row; ar = ar < 0 ? 0 : (ar > MT - 1 ? MT - 1 : ar);
      oa_[i] = (unsigned)ar * (unsigned)s.lda + kc * 8; }
#pragma unroll
    for (int i = 0; i < NB; ++i) { const int row = (tid >> 3) + 64 * i, kc = tid & 7;
      const int br = row < 32 * NN ? s.brow0 + row : s.brow1 + row - 32 * NN;
      ob_[i] = (unsigned)br * (unsigned)s.ldb + kc * 8; }
    A = s.A; B = s.B; nk = s.K >> 6;
    GT_LOAD(0);
  }
  DI void run(f32x4 (&acc)[MM][NN], char* smem) {
    bf16_t* sbase = (bf16_t*)smem;
    const int tid = ptid(), lane = tid & 63, wave = tid >> 6, wr = wave >> 2, wc = wave & 3, fr = lane & 15, fq = lane >> 4;
    int wofs; { const int r = tid >> 3, kc = tid & 7, ob = (r & 15) * 64 + (kc & 3) * 16; wofs = (((r >> 4) * 2 + (kc >> 2)) * 1024 + (ob ^ (((ob >> 9) & 1) << 5))) >> 1; }
    int robase; { const int ob = fr * 64 + fq * 16; robase = (ob ^ (((ob >> 9) & 1) << 5)) >> 1; }
#define GT_STORE(ST) do { bf16_t* sA_ = sbase + (ST) * 32768; bf16_t* sB_ = sA_ + 16384; \
    _Pragma("unroll") for (int i = 0; i < NA; ++i) *(u32x4*)(sA_ + wofs + i * 4096) = ra[i]; \
    _Pragma("unroll") for (int i = 0; i < NB; ++i) *(u32x4*)(sB_ + wofs + i * 4096) = rb[i]; } while (0)
#define GT_COMPUTE(ST) do { const bf16_t* sA_ = sbase + (ST) * 32768 + robase; const bf16_t* sB_ = sA_ + 16384; __builtin_amdgcn_s_setprio(1); \
    _Pragma("unroll 1") for (int ks = 0; ks < 2; ++ks) { bf16x8 bfr[NN]; \
      _Pragma("unroll") for (int n = 0; n < NN; ++n) bfr[n] = *(const bf16x8*)(sB_ + ((wc * NN + n) * 2 + ks) * 512); \
      _Pragma("unroll") for (int m = 0; m < MM; ++m) { const bf16x8 af = *(const bf16x8*)(sA_ + ((wr * MM + m) * 2 + ks) * 512); \
        _Pragma("unroll") for (int n = 0; n < NN; ++n) acc[m][n] = MFMA16(bfr[n], af, acc[m][n]); } } __builtin_amdgcn_s_setprio(0); } while (0)
    __syncthreads();
    GT_STORE(0);
    GT_LOAD(1);
    __syncthreads();
#pragma unroll 1
    for (int kt = 0; kt < nk; kt += 2) {
      GT_STORE(1); GT_LOAD(kt + 2); GT_COMPUTE(0); __syncthreads();
      GT_STORE(0); GT_LOAD(kt + 3); GT_COMPUTE(1); __syncthreads();
    }
  }
#undef GT_LOAD
#undef GT_STORE
#undef GT_COMPUTE
};
template <int MM, int NN> DI void gemm_tile(f32x4 (&acc)[MM][NN], const TileSrc& s, char* smem) { Gemm<MM, NN> g; g.begin(s); g.run(acc, smem); }

DI float gelu_tanh(float x) { const float u = 0.7978845608f * (x + 0.044715f * x * x * x); const float e = __expf(2.f * u); const float th = 1.f - 2.f * __builtin_amdgcn_rcpf(e + 1.f); return 0.5f * x * (1.f + th); }

struct TileIter {
  int m_lo, rows, NTn, G, efull, count, e, stride;
  DI void init(int MTn, int NTn_) { const int x = blockIdx.x & 7; m_lo = (x * MTn) >> 3; rows = (((x + 1) * MTn) >> 3) - m_lo; NTn = NTn_; G = (rows + 1) >> 1;
    efull = (rows / G) * G * NTn; count = rows * NTn; e = blockIdx.x >> 3; stride = gridDim.x >> 3; }
  DI bool next(int& mt, int& nt) { if (e >= count) return false;
    if (e < efull) { const int grp = e / (G * NTn), rem = e - grp * G * NTn; nt = rem / G; mt = m_lo + grp * G + (rem - nt * G); }
    else { const int rem = e - efull, gsz = rows - (rows / G) * G; nt = rem / gsz; mt = m_lo + (rows / G) * G + (rem - nt * gsz); }
    e += stride; return true; }
};

__device__ void phase_win(const P& p, int l, char* smem) {
  const bf16_t* H = (const bf16_t*)(p.ws + WS_H); const bf16_t* Wt = (const bf16_t*)(p.ws + WS_WIN);
  bf16_t* zr = (bf16_t*)(p.ws + WS_ZR); bf16_t* zn = (bf16_t*)(p.ws + WS_ZN); bf16_t* zt = (bf16_t*)(p.ws + WS_ZT);
  const int tid = ptid(), lane = tid & 63, wave = tid >> 6, wr = wave >> 2, wc = wave & 3, fr = lane & 15, fq = lane >> 4;
  Gemm<8, 4> gm;
  TileIter ti; ti.init(48, 14);
  const int x = blockIdx.x & 7, nconv = (343 - x + 7) >> 3, nloc = ti.count + nconv;
  const float* cw = p.rwkv_conv + (size_t)l * 3 * NZR;
  for (int e = (int)(blockIdx.x >> 3); e < nloc; e += (int)(gridDim.x >> 3)) {
    f32x4 acc[8][4]; zero_acc<8, 4>(acc);
    if (e < nconv) {
      const int c = x + 8 * e, mt = c / 7, nt = c - mt * 7;
      const int n0 = nt * 256, arow0 = mt * 254 - 1;
      { TileSrc s{H, LDH, arow0, Wt, LDH, n0, n0 + 128, D}; gm.begin(s); }
      gm.run(acc, smem);
      float* sC = (float*)smem;
#pragma unroll 1
      for (int sl = 0; sl < 4; ++sl) {
        __syncthreads();
        if (wc == sl) {
#pragma unroll
          for (int m = 0; m < 8; ++m)
#pragma unroll
            for (int n = 0; n < 4; ++n) *(f32x4*)(sC + (wr * 128 + m * 16 + fr) * 68 + n * 16 + fq * 4) = acc[m][n];
        }
        __syncthreads();
        const int nb = n0 + sl * 64, c4 = (tid & 15) * 4;
        const float4 w0 = *(const float4*)(cw + nb + c4), w1 = *(const float4*)(cw + NZR + nb + c4), w2 = *(const float4*)(cw + 2 * NZR + nb + c4);
        for (int ee = tid; ee < 254 * 16; ee += NTP) {
          const int tr = 1 + (ee >> 4), g = arow0 + tr;
          if (g < MT) { int t, T, mi; tokinfo(g, t, T, mi);
            const float pm = t > 0 ? 1.f : 0.f, nm = t < T - 1 ? 1.f : 0.f;
            const f32x4 a = *(const f32x4*)(sC + (tr - 1) * 68 + c4), b = *(const f32x4*)(sC + tr * 68 + c4), cc = *(const f32x4*)(sC + (tr + 1) * 68 + c4);
            float r0 = pm * a[0] * w0.x + b[0] * w1.x + nm * cc[0] * w2.x, r1 = pm * a[1] * w0.y + b[1] * w1.y + nm * cc[1] * w2.y;
            float r2 = pm * a[2] * w0.z + b[2] * w1.z + nm * cc[2] * w2.z, r3 = pm * a[3] * w0.w + b[3] * w1.w + nm * cc[3] * w2.w;
            if (nb >= 1664) { r0 = sigmoidf_(r0); r1 = sigmoidf_(r1); r2 = sigmoidf_(r2); r3 = sigmoidf_(r3); }
            u32x2 o; o.x = pack2(r0, r1); o.y = pack2(r2, r3);
            *(u32x2*)(zr + (size_t)g * NZR + nb + c4) = o; }
        }
      }
    } else {
      int mt, nt; ti.e = e - nconv; ti.next(mt, nt);
      const int n0 = nt * 256, row0 = mt * 256;
      { TileSrc s{H, LDH, row0, Wt, LDH, NZR + n0, NZR + n0 + 128, D}; gm.begin(s); }
      gm.run(acc, smem);
#pragma unroll
      for (int m = 0; m < 8; ++m) { const int row = row0 + wr * 128 + m * 16 + fr;
#pragma unroll
        for (int n = 0; n < 4; ++n) { const int col = n0 + wc * 64 + n * 16 + fq * 4; const f32x4 v = acc[m][n];
          u32x2 o; o.x = pack2(v[0], v[1]); o.y = pack2(v[2], v[3]);
          if (col < NZN) {
            *(u32x2*)(zn + (size_t)row * NZN + col) = o;
            if (row < MC && col >= 512) { const int part = col - 512, isv = part >> 9, pp = part & 511, hh = pp >> 6, d = pp & 63, b = row >> 8, t = row & 255;
              float* dst = p.out + (isv ? O_V : O_K) + ((((size_t)b * 2 + l) * 8 + hh) * 256 + t) * 64 + d; *(f32x4*)dst = v; }
          } else { *(u32x2*)(zt + (size_t)row * LZT + (col - NZN)) = o; }
        } }
    }
  }
}

__device__ void phase_merge(const P& p, char* smem) {
  const bf16_t* H = (const bf16_t*)(p.ws + WS_H); const bf16_t* Wt = (const bf16_t*)(p.ws + WS_WIN); const bf16_t* Wo3 = (const bf16_t*)(p.ws + WS_WO3);
  bf16_t* mg = (bf16_t*)(p.ws + WS_MERGED);
  const int tid = ptid(), lane = tid & 63, wave = tid >> 6, wr = wave >> 2, wc = wave & 3, fr = lane & 15, fq = lane >> 4;
  TileIter ti; int mt, nt; ti.init(96, 8);
  while (ti.next(mt, nt)) {
    const int n0 = nt * 128, row0 = mt * 128;
    f32x4 macc[4][2]; zero_acc<4, 2>(macc);
#pragma unroll 1
    for (int i = 0; i < 3; ++i) {
      const bf16_t* O = (const bf16_t*)(p.ws + (i == 0 ? WS_OA : (i == 1 ? WS_ONA : WS_ORET)));
      f32x4 g[4][2]; zero_acc<4, 2>(g);
      { TileSrc s{H, LDH, row0, Wt, LDH, 5376 + i * 1024 + n0, 5376 + i * 1024 + n0 + 64, D}; gemm_tile<4, 2>(g, s, smem); }
      f32x4 a2[4][2]; zero_acc<4, 2>(a2);
      { TileSrc s{O, LDO, row0, Wo3 + (size_t)i * 1024 * LDO, LDO, n0, n0 + 64, 512}; gemm_tile<4, 2>(a2, s, smem); }
#pragma unroll
      for (int m = 0; m < 4; ++m)
#pragma unroll
        for (int n = 0; n < 2; ++n)
#pragma unroll
          for (int j = 0; j < 4; ++j) macc[m][n][j] += sigmoidf_(g[m][n][j]) * a2[m][n][j];
    }
#pragma unroll
    for (int m = 0; m < 4; ++m) { const int row = row0 + wr * 64 + m * 16 + fr;
#pragma unroll
      for (int n = 0; n < 2; ++n) { const int col = n0 + wc * 32 + n * 16 + fq * 4; u32x2 o; o.x = pack2(macc[m][n][0], macc[m][n][1]); o.y = pack2(macc[m][n][2], macc[m][n][3]); *(u32x2*)(mg + (size_t)row * LDH + col) = o; } }
  }
}

__device__ void phase_gemm_f32(const bf16_t* A, int lda, int K, const bf16_t* Bt, int ldb, float* C, char* smem) {
  const int tid = ptid(), lane = tid & 63, wave = tid >> 6, wr = wave >> 2, wc = wave & 3, fr = lane & 15, fq = lane >> 4;
  TileIter ti; int mt, nt; ti.init(48, 4);
  while (ti.next(mt, nt)) {
    const int n0 = nt * 256, row0 = mt * 256;
    f32x4 acc[8][4]; zero_acc<8, 4>(acc);
    TileSrc s{A, lda, row0, Bt, ldb, n0, n0 + 128, K}; gemm_tile<8, 4>(acc, s, smem);
#pragma unroll
    for (int m = 0; m < 8; ++m) { const int row = row0 + wr * 128 + m * 16 + fr;
#pragma unroll
      for (int n = 0; n < 4; ++n) *(f32x4*)(C + (size_t)row * D + n0 + wc * 64 + n * 16 + fq * 4) = acc[m][n]; }
  }
}

__device__ void phase_ffn_up(const P& p, int l, char* smem) {
  const bf16_t* H = (const bf16_t*)(p.ws + WS_H); const bf16_t* Wt = (const bf16_t*)(p.ws + WS_WUP); bf16_t* hid = (bf16_t*)(p.ws + WS_HID);
  const int tid = ptid(), lane = tid & 63, wave = tid >> 6, wr = wave >> 2, wc = wave & 3, fr = lane & 15, fq = lane >> 4;
  const float* cw = p.ffn_conv + (size_t)l * 3 * 2 * FF;
  TileIter ti; int mt, nt; ti.init(49, 22);
  Gemm<8, 4> gm;
  while (ti.next(mt, nt)) {
    const int c0 = nt * 128, arow0 = mt * 254 - 1;
    f32x4 acc[8][4]; zero_acc<8, 4>(acc);
    { TileSrc s{H, LDH, arow0, Wt, LDH, c0, FF + c0, D}; gm.begin(s); }
    gm.run(acc, smem);
    float* sC = (float*)smem;
#pragma unroll
    for (int q = 0; q < 4; ++q) {
      __syncthreads();
      if ((wc & 1) == (q >> 1)) { const int cb = (wc >> 1) * 32;
#pragma unroll
        for (int m = 0; m < 8; ++m)
#pragma unroll
          for (int n = 0; n < 2; ++n) *(f32x4*)(sC + (wr * 128 + m * 16 + fr) * 68 + cb + n * 16 + fq * 4) = acc[m][(q & 1) * 2 + n];
      }
      __syncthreads();
      const int cq = c0 + q * 32, c4 = (tid & 7) * 4;
      const f32x4 v0 = *(const f32x4*)(cw + cq + c4), v1 = *(const f32x4*)(cw + 2 * FF + cq + c4), v2 = *(const f32x4*)(cw + 4 * FF + cq + c4);
      const f32x4 g0 = *(const f32x4*)(cw + FF + cq + c4), g1 = *(const f32x4*)(cw + 3 * FF + cq + c4), g2 = *(const f32x4*)(cw + 5 * FF + cq + c4);
      for (int e = tid; e < 254 * 8; e += NTP) {
        const int tr = 1 + (e >> 3), g = arow0 + tr;
        if (g < MT) { int t, T, mi; tokinfo(g, t, T, mi);
          const float pm = t > 0 ? 1.f : 0.f, nm = t < T - 1 ? 1.f : 0.f;
          const f32x4 va = *(const f32x4*)(sC + (tr - 1) * 68 + c4), vb = *(const f32x4*)(sC + tr * 68 + c4), vc = *(const f32x4*)(sC + (tr + 1) * 68 + c4);
          const f32x4 ga = *(const f32x4*)(sC + (tr - 1) * 68 + 32 + c4), gb = *(const f32x4*)(sC + tr * 68 + 32 + c4), gc = *(const f32x4*)(sC + (tr + 1) * 68 + 32 + c4);
          float r[4];
#pragma unroll
          for (int j = 0; j < 4; ++j) { const float val = pm * va[j] * v0[j] + vb[j] * v1[j] + nm * vc[j] * v2[j]; const float gt = pm * ga[j] * g0[j] + gb[j] * g1[j] + nm * gc[j] * g2[j]; r[j] = gelu_tanh(gt) * val; }
          u32x2 o; o.x = pack2(r[0], r[1]); o.y = pack2(r[2], r[3]);
          *(u32x2*)(hid + (size_t)g * FF + cq + c4) = o; }
      }
    }
  }
}

template <int CTRL> DI float dppf(float v) { return __int_as_float(__builtin_amdgcn_mov_dpp(__float_as_int(v), CTRL, 0xF, 0xF, true)); }
DI float row16_sum(float v) { v += dppf<0xB1>(v); v += dppf<0x4E>(v); v += dppf<0x141>(v); v += dppf<0x140>(v); return v; }

DI float frcp(float x) { return __builtin_amdgcn_rcpf(x); }
DI float fsig(float x) { return frcp(1.f + __expf(-x)); }
__device__ void scan_task(const P& p, int l, int seq, int h, int d, int half, char* smem) {
  float* sR = (float*)smem; float* sW = sR + 1024; float* sKD = sW + 1024; float* sB = sKD + 1024; float* sNK = sB + 1024; float* sV = sNK + 1024; float* sK = sV + 1024; float* sY = sK + 1024;
  float* sKn = sY + 2048; float* sKK = sKn + 16; bf16_t* sWT = (bf16_t*)(sKK + 64); bf16_t* sAL = sWT + 16 * LDT;
  const int tid = tidx(), lane = tid & 63, wave = tid >> 6, fr = lane & 15, fq = lane >> 4;
  const int row0 = seq < 32 ? seq * 256 : MC + (seq - 32) * 1024, T = seq < 32 ? 256 : 1024, nch = T >> 4;
  const bf16_t* zr = (const bf16_t*)(p.ws + WS_ZR);
  float* yout = (float*)(p.ws + WS_Y) + (size_t)d * MT * 512;
  __syncthreads();
  if (tid < 64) sKK[tid] = p.rwkv_k_k[l * 512 + h * 64 + tid];
  const int cc = wave * 16 + fr, gc = h * 64 + cc;
  bf16x8 bw[2], ba[2];
#pragma unroll
  for (int ks = 0; ks < 2; ++ks)
#pragma unroll
    for (int e = 0; e < 8; ++e) { const int k = ks * 32 + fq * 8 + e;
      bw[ks][e] = (short)f2bf(p.rwkv_w_up[((size_t)(l * 2 + d) * 64 + k) * 512 + gc]); ba[ks][e] = (short)f2bf(p.rwkv_a_up[((size_t)(l * 2 + d) * 64 + k) * 512 + gc]); }
  const float w0c = p.rwkv_w0[(l * 2 + d) * 512 + gc], a0c = p.rwkv_a0[(l * 2 + d) * 512 + gc], kac = p.rwkv_k_a[l * 512 + gc];
  const int rg = tid >> 4, kq = tid & 15, rbase = half * 32 + rg * 2;
  f32x2 S[2][2];
  if (seq >= 32) { const float* s0 = p.state_rwkv + (((((size_t)(seq - 32) * 2 + l) * 2 + d) * 8 + h) * 64 + rbase) * 64 + kq * 4;
#pragma unroll
    for (int r = 0; r < 2; ++r) { const f32x4 x = *(const f32x4*)(s0 + r * 64); S[r][0] = (f32x2){x[0], x[1]}; S[r][1] = (f32x2){x[2], x[3]}; } }
  else {
#pragma unroll
    for (int r = 0; r < 2; ++r) { S[r][0] = (f32x2){0.f, 0.f}; S[r][1] = (f32x2){0.f, 0.f}; } }
  if (seq >= 32) __builtin_amdgcn_s_setprio(2);
  const int at = (tid & 127) >> 3, apart = tid & 7, ahi = tid >> 7;
  size_t coff[3];
  { const int sb0 = ahi ? 512 + h * 64 : h * 64, sb1 = ahi ? 1536 : 1024 + h * 64, sb2 = 1600;
    coff[0] = (size_t)at * NZR + sb0 + apart * 8; coff[1] = (size_t)at * NZR + sb1 + apart * 8; coff[2] = (size_t)at * NZR + sb2 + apart * 8; }
  u32x4 pre[3];
  { const int t0 = (d ? nch - 1 : 0) * 16;
#pragma unroll
    for (int i = 0; i < 3; ++i) pre[i] = *(const u32x4*)(zr + (size_t)(row0 + t0) * NZR + coff[i]); }
  __syncthreads();
  for (int ci = 0; ci < nch; ++ci) {
    const int chunk = d ? nch - 1 - ci : ci, t0 = chunk * 16;
    { const int o = at * 64 + apart * 8; float f[8];
      unpack8(pre[0], f);
      if (ahi == 0) { *(f32x4*)(sR + o) = (f32x4){f[0], f[1], f[2], f[3]}; *(f32x4*)(sR + o + 4) = (f32x4){f[4], f[5], f[6], f[7]}; }
      else { *(f32x4*)(sK + o) = (f32x4){f[0], f[1], f[2], f[3]}; *(f32x4*)(sK + o + 4) = (f32x4){f[4], f[5], f[6], f[7]}; float ps = 0.f;
#pragma unroll
        for (int e = 0; e < 8; ++e) { const float kk = f[e] * sKK[apart * 8 + e]; ps += kk * kk; }
        ps += dppf<0xB1>(ps); ps += dppf<0x4E>(ps); ps += dppf<0x141>(ps);
        if (apart == 0) sKn[at] = ps; }
      unpack8(pre[1], f);
      if (ahi == 0) { *(f32x4*)(sV + o) = (f32x4){f[0], f[1], f[2], f[3]}; *(f32x4*)(sV + o + 4) = (f32x4){f[4], f[5], f[6], f[7]}; }
      else { float g[8];
#pragma unroll
        for (int e = 0; e < 8; ++e) g[e] = 1.f - 2.f * frcp(__expf(2.f * f[e]) + 1.f);
        *(u32x4*)(sWT + at * LDT + apart * 8) = pack8(g); }
      if (ahi == 0) *(u32x4*)(sAL + at * LDT + apart * 8) = pre[2];
    }
    __syncthreads();
    {
      f32x4 aw = {0.f, 0.f, 0.f, 0.f}, aa = {0.f, 0.f, 0.f, 0.f};
#pragma unroll
      for (int ks = 0; ks < 2; ++ks) { const bf16x8 fw = *(const bf16x8*)(sWT + fr * LDT + ks * 32 + fq * 8); const bf16x8 fa = *(const bf16x8*)(sAL + fr * LDT + ks * 32 + fq * 8);
        aw = MFMA16(fw, bw[ks], aw); aa = MFMA16(fa, ba[ks], aa); }
      const float kkc = sKK[cc];
#pragma unroll
      for (int j = 0; j < 4; ++j) { const int t = fq * 4 + j, o = t * 64 + cc;
        const float dec = __expf(-0.6065306597f * fsig(w0c + aw[j]));
        const float a = fsig(a0c + aa[j]);
        const float kv = sK[o];
        const float kkv = kv * kkc * __builtin_amdgcn_rsqf(fmaxf(sKn[t], 1e-24f));
        sW[o] = dec; sKD[o] = kv * (1.f + (a - 1.f) * kac); sB[o] = kkv * a; sNK[o] = -kkv; }
    }
    __syncthreads();
    { const int cn = ci + 1 < nch ? ci + 1 : ci; const int nt0 = (d ? nch - 1 - cn : cn) * 16;
#pragma unroll
      for (int i = 0; i < 3; ++i) pre[i] = *(const u32x4*)(zr + (size_t)(row0 + nt0) * NZR + coff[i]); }
#pragma unroll 8
    for (int si = 0; si < 16; ++si) {
      const int t = d ? 15 - si : si, o = t * 64 + kq * 4;
      const f32x4 an4 = *(const f32x4*)(sNK + o), w4 = *(const f32x4*)(sW + o), b4 = *(const f32x4*)(sB + o), kd4 = *(const f32x4*)(sKD + o), r4 = *(const f32x4*)(sR + o);
      const f32x2 v2 = *(const f32x2*)(sV + t * 64 + rbase);
      const f32x2 an[2] = {{an4[0], an4[1]}, {an4[2], an4[3]}}, wv[2] = {{w4[0], w4[1]}, {w4[2], w4[3]}}, bv[2] = {{b4[0], b4[1]}, {b4[2], b4[3]}}, kd[2] = {{kd4[0], kd4[1]}, {kd4[2], kd4[3]}}, rv[2] = {{r4[0], r4[1]}, {r4[2], r4[3]}};
      float sa[2];
#pragma unroll
      for (int r = 0; r < 2; ++r) { const f32x2 t2 = S[r][0] * an[0] + S[r][1] * an[1]; sa[r] = row16_sum(t2.x + t2.y); }
      f32x2 yv;
#pragma unroll
      for (int r = 0; r < 2; ++r) { const f32x2 sav = {sa[r], sa[r]}, vvv = {v2[r], v2[r]};
        S[r][0] = S[r][0] * wv[0] + (sav * bv[0] + vvv * kd[0]); S[r][1] = S[r][1] * wv[1] + (sav * bv[1] + vvv * kd[1]);
        const f32x2 y2 = S[r][0] * rv[0] + S[r][1] * rv[1]; float yp = y2.x + y2.y; yp += dppf<0xB1>(yp); yp += dppf<0x4E>(yp); yv[r] = yp; }
      if ((kq & 3) == 0) { sY[((t * 32 + rg * 2) * 4) + (kq >> 2)] = yv[0]; sY[((t * 32 + rg * 2 + 1) * 4) + (kq >> 2)] = yv[1]; }
    }
    __syncthreads();
    { const int t = tid >> 4, lr = (tid & 15) * 2; const f32x4 p0 = *(const f32x4*)(sY + (t * 32 + lr) * 4), p1 = *(const f32x4*)(sY + (t * 32 + lr + 1) * 4);
      *(f32x2*)(yout + (size_t)(row0 + t0 + t) * 512 + h * 64 + half * 32 + lr) = (f32x2){p0[0] + p0[1] + p0[2] + p0[3], p1[0] + p1[1] + p1[2] + p1[3]}; }
  }
  __builtin_amdgcn_s_setprio(0);
  if (seq < 32) { float* so = p.out + O_RW + (((((size_t)seq * 2 + l) * 2 + d) * 8 + h) * 64 + rbase) * 64 + kq * 4;
#pragma unroll
    for (int r = 0; r < 2; ++r) *(f32x4*)(so + r * 64) = (f32x4){S[r][0].x, S[r][0].y, S[r][1].x, S[r][1].y}; }
}

DI void qk_scores(const bf16_t* sK, const bf16x8 (&qf)[2], f32x4 (&sacc)[4], int fr, int fq) {
#pragma unroll
  for (int nt = 0; nt < 4; ++nt) { sacc[nt] = (f32x4){0.f, 0.f, 0.f, 0.f};
#pragma unroll
    for (int ks = 0; ks < 2; ++ks) { const bf16x8 kf = *(const bf16x8*)(sK + (nt * 16 + fr) * LDT + ks * 32 + fq * 8); sacc[nt] = MFMA16(kf, qf[ks], sacc[nt]); } }
}
DI void pv_accum(const bf16_t* sVt, const f32x4 (&pacc)[4], f32x4 (&o)[4], int fr, int fq) {
#pragma unroll
  for (int s = 0; s < 2; ++s) {
    bf16x8 pf; { const unsigned a = pack2(pacc[2 * s][0], pacc[2 * s][1]), b = pack2(pacc[2 * s][2], pacc[2 * s][3]), c = pack2(pacc[2 * s + 1][0], pacc[2 * s + 1][1]), dd = pack2(pacc[2 * s + 1][2], pacc[2 * s + 1][3]);
      const u32x4 u = (u32x4){a, b, c, dd}; pf = __builtin_bit_cast(bf16x8, u); }
#pragma unroll
    for (int dt = 0; dt < 4; ++dt) { const u32x2 lo = *(const u32x2*)(sVt + (dt * 16 + fr) * LDT + 32 * s + 4 * fq), hi = *(const u32x2*)(sVt + (dt * 16 + fr) * LDT + 32 * s + 16 + 4 * fq);
      const u32x4 u = (u32x4){lo[0], lo[1], hi[0], hi[1]}; const bf16x8 vf = __builtin_bit_cast(bf16x8, u); o[dt] = MFMA16(vf, pf, o[dt]); }
  }
}
DI void put_kv(bf16_t* sK, bf16_t* sVt, int key, int part, const float (&kf)[8], int vkey, int vpart, const float (&vf)[8]) {
  *(u32x4*)(sK + key * LDT + part * 8) = pack8(kf);
#pragma unroll
  for (int e = 0; e < 8; ++e) sVt[(vpart * 8 + e) * LDT + vkey] = f2bf(vf[e]);
}
DI void softmax_tile(f32x4 (&sacc)[4], f32x4 (&o)[4], float& mrun, float& lrun) {
  float mx = sacc[0][0];
#pragma unroll
  for (int nt = 0; nt < 4; ++nt)
#pragma unroll
    for (int j = 0; j < 4; ++j) mx = fmaxf(mx, sacc[nt][j]);
  mx = fmaxf(mx, shfl_x(mx, 16)); mx = fmaxf(mx, shfl_x(mx, 32));
  const float mnew = fmaxf(mrun, mx), alpha = __builtin_amdgcn_exp2f(mrun - mnew); mrun = mnew;
  float ls = 0.f;
#pragma unroll
  for (int nt = 0; nt < 4; ++nt)
#pragma unroll
    for (int j = 0; j < 4; ++j) { const float pv = __builtin_amdgcn_exp2f(sacc[nt][j] - mnew); sacc[nt][j] = pv; ls += pv; }
  lrun = lrun * alpha + ls;
#pragma unroll
  for (int dt = 0; dt < 4; ++dt) o[dt] *= alpha;
}
constexpr float LOG2E = 1.4426950408889634f;

__device__ void dense_task(const P& p, int b, int h, int qb, char* smem) {
  bf16_t* sK = (bf16_t*)smem; bf16_t* sVt = sK + 64 * LDT;
  const int tid = tidx(), lane = tid & 63, wave = tid >> 6, fr = lane & 15, fq = lane >> 4;
  const bf16_t* zn = (const bf16_t*)(p.ws + WS_ZN); bf16_t* ona = (bf16_t*)(p.ws + WS_ONA);
  const int qrow = b * 256 + qb * 64 + wave * 16 + fr;
  bf16x8 qf[2];
#pragma unroll
  for (int ks = 0; ks < 2; ++ks) qf[ks] = *(const bf16x8*)(zn + (size_t)qrow * NZN + h * 64 + ks * 32 + fq * 8);
  f32x4 o[4]; for (int dt = 0; dt < 4; ++dt) o[dt] = (f32x4){0.f, 0.f, 0.f, 0.f};
  float mrun = -1e30f, lrun = 0.f;
  u32x4 pk[2], pv[2];
#pragma unroll
  for (int i = 0; i < 2; ++i) { const int c = tid + 256 * i, key = c >> 3, part = c & 7, vkey = c & 63, vpart = c >> 6; pk[i] = *(const u32x4*)(zn + (size_t)(b * 256 + key) * NZN + h * 64 + part * 8 + 512); pv[i] = *(const u32x4*)(zn + (size_t)(b * 256 + vkey) * NZN + h * 64 + vpart * 8 + 1024); }
  for (int kt = 0; kt < 4; ++kt) {
    __syncthreads();
#pragma unroll
    for (int i = 0; i < 2; ++i) { const int c = tid + 256 * i, key = c >> 3, part = c & 7, vkey = c & 63, vpart = c >> 6; float vf[8]; unpack8(pv[i], vf);
      *(u32x4*)(sK + key * LDT + part * 8) = pk[i];
#pragma unroll
      for (int e = 0; e < 8; ++e) sVt[(vpart * 8 + e) * LDT + vkey] = f2bf(vf[e]); }
    __syncthreads();
    { const int kn = kt < 3 ? kt + 1 : 3;
#pragma unroll
      for (int i = 0; i < 2; ++i) { const int c = tid + 256 * i, key = c >> 3, part = c & 7, vkey = c & 63, vpart = c >> 6; pk[i] = *(const u32x4*)(zn + (size_t)(b * 256 + kn * 64 + key) * NZN + h * 64 + part * 8 + 512); pv[i] = *(const u32x4*)(zn + (size_t)(b * 256 + kn * 64 + vkey) * NZN + h * 64 + vpart * 8 + 1024); } }
    f32x4 sacc[4]; qk_scores(sK, qf, sacc, fr, fq);
#pragma unroll
    for (int nt = 0; nt < 4; ++nt) sacc[nt] *= (0.125f * LOG2E);
    softmax_tile(sacc, o, mrun, lrun);
    pv_accum(sVt, sacc, o, fr, fq);
  }
  lrun += shfl_x(lrun, 16); lrun += shfl_x(lrun, 32); const float inv = 1.f / lrun;
#pragma unroll
  for (int dt = 0; dt < 4; ++dt) { u32x2 ov; ov.x = pack2(o[dt][0] * inv, o[dt][1] * inv); ov.y = pack2(o[dt][2] * inv, o[dt][3] * inv); *(u32x2*)(ona + (size_t)qrow * LDO + h * 64 + dt * 16 + fq * 4) = ov; }
}

__device__ void na_task(const P& p, int l, int b, int h, int r, char* smem) {
  bf16_t* sK = (bf16_t*)smem; bf16_t* sVt = sK + 64 * LDT; float* sRpb = (float*)(sVt + 64 * LDT);
  const int tid = tidx(), lane = tid & 63, wave = tid >> 6, fr = lane & 15, fq = lane >> 4;
  const bf16_t* zn = (const bf16_t*)(p.ws + WS_ZN); bf16_t* ona = (bf16_t*)(p.ws + WS_ONA);
  const int base = MC + b * 1024, qcol = wave * 16 + fr, qrow = base + r * 64 + qcol;
  int rs = r - 4; rs = rs < 0 ? 0 : (rs > 8 ? 8 : rs);
  int cs = qcol - 8; cs = cs < 0 ? 0 : (cs > 48 ? 48 : cs);
  __syncthreads();
  for (int e = tid; e < 465; e += NT) sRpb[e] = p.na_rpb[((size_t)l * 8 + h) * 465 + e] * LOG2E;
  bf16x8 qf[2];
#pragma unroll
  for (int ks = 0; ks < 2; ++ks) qf[ks] = *(const bf16x8*)(zn + (size_t)qrow * NZN + h * 64 + ks * 32 + fq * 8);
  f32x4 o[4]; for (int dt = 0; dt < 4; ++dt) o[dt] = (f32x4){0.f, 0.f, 0.f, 0.f};
  float mrun = -1e30f, lrun = 0.f;
  u32x4 pre[8];
#define NA_ISSUE(KT) do { const int kt_ = (KT); \
    if (kt_ < 8) { _Pragma("unroll") for (int i = 0; i < 2; ++i) { const int c = tid + 256 * i, key = c >> 3, part = c & 7, vkey = c & 63, vpart = c >> 6; \
        pre[4 * i] = *(const u32x4*)(zn + (size_t)(base + (rs + kt_) * 64 + key) * NZN + h * 64 + part * 8 + 512); pre[4 * i + 1] = *(const u32x4*)(zn + (size_t)(base + (rs + kt_) * 64 + vkey) * NZN + h * 64 + vpart * 8 + 1024); } } \
    else { _Pragma("unroll") for (int i = 0; i < 2; ++i) { const int c = tid + 256 * i, key = c >> 3, part = c & 7, vkey = c & 63, vpart = c >> 6; const size_t cb_ = (((size_t)b * 2 + l) * 8 + h) * 256 + (kt_ - 8) * 64; const size_t co = (cb_ + key) * 64 + part * 8, cv = (cb_ + vkey) * 64 + vpart * 8; \
        pre[4 * i] = *(const u32x4*)(p.cache_k + co); pre[4 * i + 1] = *(const u32x4*)(p.cache_k + co + 4); pre[4 * i + 2] = *(const u32x4*)(p.cache_v + cv); pre[4 * i + 3] = *(const u32x4*)(p.cache_v + cv + 4); } } } while (0)
  NA_ISSUE(0);
  for (int kt = 0; kt < 12; ++kt) {
    __syncthreads();
    if (kt < 8) {
#pragma unroll
      for (int i = 0; i < 2; ++i) { const int c = tid + 256 * i, key = c >> 3, part = c & 7, vkey = c & 63, vpart = c >> 6; float vf[8]; unpack8(pre[4 * i + 1], vf);
        *(u32x4*)(sK + key * LDT + part * 8) = pre[4 * i];
#pragma unroll
        for (int e = 0; e < 8; ++e) sVt[(vpart * 8 + e) * LDT + vkey] = f2bf(vf[e]); }
    } else {
#pragma unroll
      for (int i = 0; i < 2; ++i) { const int c = tid + 256 * i, key = c >> 3, part = c & 7, vkey = c & 63, vpart = c >> 6;
        const f32x4 k0 = __builtin_bit_cast(f32x4, pre[4 * i]), k1 = __builtin_bit_cast(f32x4, pre[4 * i + 1]), v0 = __builtin_bit_cast(f32x4, pre[4 * i + 2]), v1 = __builtin_bit_cast(f32x4, pre[4 * i + 3]);
        const float kf[8] = {k0[0], k0[1], k0[2], k0[3], k1[0], k1[1], k1[2], k1[3]}; const float vf[8] = {v0[0], v0[1], v0[2], v0[3], v1[0], v1[1], v1[2], v1[3]};
        put_kv(sK, sVt, key, part, kf, vkey, vpart, vf); }
    }
    __syncthreads();
    NA_ISSUE(kt < 11 ? kt + 1 : 11);
    f32x4 sacc[4]; qk_scores(sK, qf, sacc, fr, fq);
    if (kt < 8) { const int dr = rs + kt - r + 7;
#pragma unroll
      for (int nt = 0; nt < 4; ++nt)
#pragma unroll
        for (int j = 0; j < 4; ++j) { const int kc = nt * 16 + fq * 4 + j; const bool valid = kc >= cs && kc < cs + 16; int dc = kc - qcol; dc = dc < -15 ? -15 : (dc > 15 ? 15 : dc);
          sacc[nt][j] = valid ? sacc[nt][j] * (0.125f * LOG2E) + sRpb[dr * 31 + dc + 15] : -1e30f; }
    } else {
#pragma unroll
      for (int nt = 0; nt < 4; ++nt) sacc[nt] *= (0.125f * LOG2E);
    }
    softmax_tile(sacc, o, mrun, lrun);
    pv_accum(sVt, sacc, o, fr, fq);
  }
#undef NA_ISSUE
  lrun += shfl_x(lrun, 16); lrun += shfl_x(lrun, 32); const float inv = 1.f / lrun;
#pragma unroll
  for (int dt = 0; dt < 4; ++dt) { u32x2 ov; ov.x = pack2(o[dt][0] * inv, o[dt][1] * inv); ov.y = pack2(o[dt][2] * inv, o[dt][3] * inv); *(u32x2*)(ona + (size_t)qrow * LDO + h * 64 + dt * 16 + fq * 4) = ov; }
}

DI void rope8(const float (&own)[8], const float (&par)[8], int part, int n, float (&out)[8]) {
  const float pos = (float)((part >> 2) ? (n & 63) : (n >> 6));
  const bool isx2 = (part & 3) >= 2;
#pragma unroll
  for (int e = 0; e < 8; ++e) { const int i = (part & 1) * 8 + e; const float ang = pos * __builtin_amdgcn_exp2f(-(float)i * 0.830482023721841f); const float sn = __sinf(ang), cs = __cosf(ang);
    out[e] = isx2 ? par[e] * sn + own[e] * cs : own[e] * cs - par[e] * sn; }
}

__device__ void ret_task(const P& p, int l, int seq, int h, int qb, char* smem) {
  bf16_t* sK = (bf16_t*)smem; bf16_t* sVt = sK + 64 * LDT; bf16_t* sQ = sVt + 64 * LDT;
  const int tid = tidx(), lane = tid & 63, wave = tid >> 6, fr = lane & 15, fq = lane >> 4;
  const bf16_t* zt = (const bf16_t*)(p.ws + WS_ZT); bf16_t* oret = (bf16_t*)(p.ws + WS_ORET);
  const bool lat = seq >= 32;
  const int row0 = lat ? MC + (seq - 32) * 1024 : seq * 256, T = lat ? 1024 : 256, nkt = T >> 6;
  const float xf = p.ret_decay[(l * 2 + 0) * 8 + h], xb = p.ret_decay[(l * 2 + 1) * 8 + h];
  const float lgf = -log1pf(__expf(-xf)) * LOG2E, lgb = -log1pf(__expf(-xb)) * LOG2E;
  __syncthreads();
#pragma unroll
  for (int i = 0; i < 2; ++i) { const int c = tid + 256 * i, qi = c >> 3, part = c & 7; const int n = qb * 64 + qi; const size_t ro = (size_t)(row0 + n) * LZT + h * 64;
    const u32x4 own = *(const u32x4*)(zt + ro + part * 8);
    if (lat) { const u32x4 par = *(const u32x4*)(zt + ro + (part ^ 2) * 8); float fo[8], fp[8], out[8]; unpack8(own, fo); unpack8(par, fp); rope8(fo, fp, part, n, out); *(u32x4*)(sQ + qi * LDT + part * 8) = pack8(out); }
    else *(u32x4*)(sQ + qi * LDT + part * 8) = own; }
  __syncthreads();
  const int qi = wave * 16 + fr, nq = qb * 64 + qi;
  bf16x8 qf[2];
#pragma unroll
  for (int ks = 0; ks < 2; ++ks) qf[ks] = *(const bf16x8*)(sQ + qi * LDT + ks * 32 + fq * 8);
  f32x4 o[4]; for (int dt = 0; dt < 4; ++dt) o[dt] = (f32x4){0.f, 0.f, 0.f, 0.f};
  u32x4 rk[2], rp[2], rv[2];
#define RET_ISSUE(KT) do { _Pragma("unroll") for (int i = 0; i < 2; ++i) { const int c = tid + 256 * i, key = c >> 3, part = c & 7, vkey = c & 63, vpart = c >> 6; const size_t ro = (size_t)(row0 + (KT) * 64 + key) * LZT + h * 64; \
    rk[i] = *(const u32x4*)(zt + ro + 512 + part * 8); rp[i] = *(const u32x4*)(zt + ro + 512 + (part ^ 2) * 8); rv[i] = *(const u32x4*)(zt + (size_t)(row0 + (KT) * 64 + vkey) * LZT + h * 64 + 1024 + vpart * 8); } } while (0)
  RET_ISSUE(0);
  for (int kt = 0; kt < nkt; ++kt) {
    __syncthreads();
#pragma unroll
    for (int i = 0; i < 2; ++i) { const int c = tid + 256 * i, key = c >> 3, part = c & 7, vkey = c & 63, vpart = c >> 6; const int n = kt * 64 + key;
      float kf[8], vf[8]; unpack8(rk[i], kf); unpack8(rv[i], vf);
      if (lat) { float fp[8], out[8]; unpack8(rp[i], fp); rope8(kf, fp, part, n, out);
#pragma unroll
        for (int e = 0; e < 8; ++e) kf[e] = out[e]; }
#pragma unroll
      for (int e = 0; e < 8; ++e) kf[e] *= 0.125f;
      put_kv(sK, sVt, key, part, kf, vkey, vpart, vf); }
    __syncthreads();
    RET_ISSUE(kt + 1 < nkt ? kt + 1 : kt);
    f32x4 sacc[4]; qk_scores(sK, qf, sacc, fr, fq);
#pragma unroll
    for (int nt = 0; nt < 4; ++nt)
#pragma unroll
      for (int j = 0; j < 4; ++j) { const int mk = kt * 64 + nt * 16 + fq * 4 + j; const int df = nq - mk;
        const float ex = __builtin_amdgcn_exp2f((df > 0 ? lgf : -lgb) * (float)df); sacc[nt][j] *= (df == 0 ? 2.f : ex); }
    pv_accum(sVt, sacc, o, fr, fq);
  }
#undef RET_ISSUE
  if (lat) {
    for (int dir = 0; dir < 2; ++dir) {
      __syncthreads();
      const float* s0 = p.state_ret + ((((size_t)(seq - 32) * 2 + l) * 2 + dir) * 8 + h) * 4096;
#pragma unroll
      for (int i = 0; i < 2; ++i) { const int c = tid + 256 * i, dk = c & 63, part = c >> 6; const float4 a = *(const float4*)(s0 + dk * 64 + part * 8), bq = *(const float4*)(s0 + dk * 64 + part * 8 + 4);
        const float vf[8] = {a.x, a.y, a.z, a.w, bq.x, bq.y, bq.z, bq.w};
#pragma unroll
        for (int e = 0; e < 8; ++e) sVt[(part * 8 + e) * LDT + dk] = f2bf(vf[e]); }
      __syncthreads();
      const float xi = dir == 0 ? exp2f(lgf * (float)(nq + 1)) : exp2f(lgb * (float)(T - nq));
      f32x4 pacc[4];
#pragma unroll
      for (int s = 0; s < 2; ++s)
#pragma unroll
        for (int hh = 0; hh < 2; ++hh)
#pragma unroll
          for (int j = 0; j < 4; ++j) pacc[2 * s + hh][j] = xi * bf2f(sQ[qi * LDT + 32 * s + 16 * hh + 4 * fq + j]);
      pv_accum(sVt, pacc, o, fr, fq);
    }
  }
  float s1 = 0.f;
#pragma unroll
  for (int dt = 0; dt < 4; ++dt)
#pragma unroll
    for (int j = 0; j < 4; ++j) s1 += o[dt][j];
  s1 += shfl_x(s1, 16); s1 += shfl_x(s1, 32); const float mu = s1 * (1.f / 64.f);
  float s2 = 0.f;
#pragma unroll
  for (int dt = 0; dt < 4; ++dt)
#pragma unroll
    for (int j = 0; j < 4; ++j) { const float dlt = o[dt][j] - mu; s2 += dlt * dlt; }
  s2 += shfl_x(s2, 16); s2 += shfl_x(s2, 32); const float rstd = rsqrtf(s2 * (1.f / 64.f) + 1e-5f);
  const size_t qrow = (size_t)(row0 + nq);
#pragma unroll
  for (int dt = 0; dt < 4; ++dt) { const int dv = h * 64 + dt * 16 + fq * 4; const u32x2 gr = *(const u32x2*)(zt + qrow * LZT + 1536 + dv); const float4 gn = *(const float4*)(p.ret_gn + l * 512 + dv);
    const float g0 = bflo(gr.x), g1 = bfhi(gr.x), g2 = bflo(gr.y), g3 = bfhi(gr.y);
    u32x2 ov; ov.x = pack2((o[dt][0] - mu) * rstd * gn.x * g0 * sigmoidf_(g0), (o[dt][1] - mu) * rstd * gn.y * g1 * sigmoidf_(g1));
    ov.y = pack2((o[dt][2] - mu) * rstd * gn.z * g2 * sigmoidf_(g2), (o[dt][3] - mu) * rstd * gn.w * g3 * sigmoidf_(g3));
    *(u32x2*)(oret + qrow * LDO + dv) = ov; }
}

__device__ void retstate_task(const P& p, int l, int b, int h, char* smem) {
  float* sKf = (float*)smem; float* sKb = sKf + 64 * 64; float* sV = sKb + 64 * 64;
  const int tid = tidx(), dk = tid >> 2, dq = tid & 3;
  const bf16_t* zt = (const bf16_t*)(p.ws + WS_ZT);
  const float xf = p.ret_decay[(l * 2 + 0) * 8 + h], xb = p.ret_decay[(l * 2 + 1) * 8 + h];
  const float lgf = -log1pf(__expf(-xf)) * LOG2E, lgb = -log1pf(__expf(-xb)) * LOG2E;
  float af[16], ab[16];
#pragma unroll
  for (int i = 0; i < 16; ++i) { af[i] = 0.f; ab[i] = 0.f; }
  for (int kt = 0; kt < 4; ++kt) {
    __syncthreads();
#pragma unroll
    for (int i = 0; i < 2; ++i) { const int c = tid + 256 * i, key = c >> 3, part = c & 7, m = kt * 64 + key; const size_t ro = (size_t)(b * 256 + m) * LZT + h * 64 + part * 8;
      float kf[8], vf[8]; unpack8(*(const u32x4*)(zt + ro + 512), kf); unpack8(*(const u32x4*)(zt + ro + 1024), vf);
      const float wf = 0.125f * exp2f(lgf * (float)(255 - m)), wb = 0.125f * exp2f(lgb * (float)m);
#pragma unroll
      for (int e = 0; e < 8; ++e) { sKf[key * 64 + part * 8 + e] = kf[e] * wf; sKb[key * 64 + part * 8 + e] = kf[e] * wb; sV[key * 64 + part * 8 + e] = vf[e]; } }
    __syncthreads();
    for (int m = 0; m < 64; ++m) { const float kf = sKf[m * 64 + dk], kb = sKb[m * 64 + dk];
#pragma unroll
      for (int i = 0; i < 4; ++i) { const f32x4 vv = *(const f32x4*)(sV + m * 64 + dq * 16 + i * 4);
#pragma unroll
        for (int j = 0; j < 4; ++j) { af[i * 4 + j] += kf * vv[j]; ab[i * 4 + j] += kb * vv[j]; } } }
  }
  float* of = p.out + O_RT + ((((size_t)b * 2 + l) * 2 + 0) * 8 + h) * 4096 + dk * 64 + dq * 16; float* ob = of + 8 * 4096;
#pragma unroll
  for (int i = 0; i < 16; ++i) { of[i] = af[i]; ob[i] = ab[i]; }
}

constexpr int Q_SCAN_L = 64, Q_SCAN_C = 512, Q_RET_L = 256, Q_NA = 256, Q_DENSE = 512, Q_RET_C = 512, Q_RST = 128;
template <int QMASK> __device__ void phase_mixers(const P& p, int l, char* smem_, int rep = 0) {
  __shared__ int s_task;
  int* ctr = (int*)(p.ws + WS_CTRL) + 64 * (l + 1) + 4 * rep;
  const int vb = vhalf(); char* smem = smem_ + vb * VSMEM;
  if (QMASK & 1) for (;;) {
    __syncthreads();
    if (ptid() == 0) s_task = atomicAdd(ctr, 1);
    __syncthreads();
    const int tk = s_task;
    if (tk >= Q_SCAN_L + Q_SCAN_C) break;
    const bool lat = tk < Q_SCAN_L; const int t2 = lat ? tk : tk - Q_SCAN_L;
    scan_task(p, l, (lat ? 32 : 0) + (t2 >> 4), (t2 >> 1) & 7, t2 & 1, vb, smem);
  }
  if (QMASK & 2) for (;;) {
    __syncthreads();
    if (ptid() == 0) s_task = atomicAdd(ctr + 16, 1);
    __syncthreads();
    const int tk = s_task;
    if (tk >= Q_RET_L + Q_RET_C) break;
    if (tk < Q_RET_L) ret_task(p, l, 32 + (tk >> 6), (tk >> 3) & 7, (tk & 7) * 2 + vb, smem);
    else { const int t2 = tk - Q_RET_L; ret_task(p, l, t2 >> 4, (t2 >> 1) & 7, (t2 & 1) * 2 + vb, smem); }
  }
  if (QMASK & 4) for (;;) {
    __syncthreads();
    if (ptid() == 0) s_task = atomicAdd(ctr + 32, 1);
    __syncthreads();
    int tk = s_task;
    if (tk >= Q_NA + Q_DENSE + Q_RST) break;
    if (tk < Q_NA) { na_task(p, l, tk >> 6, (tk >> 3) & 7, (tk & 7) * 2 + vb, smem); continue; } tk -= Q_NA;
    if (tk < Q_DENSE) { dense_task(p, tk >> 4, (tk >> 1) & 7, (tk & 1) * 2 + vb, smem); continue; } tk -= Q_DENSE;
    retstate_task(p, l, tk >> 2, (tk & 3) * 2 + vb, smem);
  }
}

__device__ void phase_rwkv_post(const P& p, int l, char* smem) {
  const bf16_t* zr = (const bf16_t*)(p.ws + WS_ZR); const float* yf = (const float*)(p.ws + WS_Y); const float* yb = yf + (size_t)MT * 512; bf16_t* oa = (bf16_t*)(p.ws + WS_OA);
  const bf16_t* Gt = (const bf16_t*)(p.ws + WS_WG);
  const int tid = ptid(), lane = tid & 63, wave = tid >> 6, wr = wave >> 2, wc = wave & 3, fr = lane & 15, fq = lane >> 4;
  TileIter ti; int mt, nt; ti.init(96, 2);
  while (ti.next(mt, nt)) {
    const int row0 = mt * 128, n0 = nt * 256;
    f32x4 acc[4][4]; zero_acc<4, 4>(acc);
    TileSrc s{zr + 1664, NZR, row0, Gt, LDG, n0, n0 + 128, 128}; gemm_tile<4, 4>(acc, s, smem);
    const int cb = n0 + wc * 64 + fq * 4;
#pragma unroll
    for (int m = 0; m < 4; ++m) { const size_t row = (size_t)(row0 + wr * 64 + m * 16 + fr);
      f32x4 y[4]; float s1 = 0.f, rk = 0.f; f32x4 vv[4];
#pragma unroll
      for (int n = 0; n < 4; ++n) { const int c = cb + n * 16; y[n] = *(const f32x4*)(yf + row * 512 + c) + *(const f32x4*)(yb + row * 512 + c); s1 += y[n][0] + y[n][1] + y[n][2] + y[n][3];
        const u32x2 rr = *(const u32x2*)(zr + row * NZR + c), kk = *(const u32x2*)(zr + row * NZR + 512 + c), v2 = *(const u32x2*)(zr + row * NZR + 1024 + c); const f32x4 rkw = *(const f32x4*)(p.rwkv_r_k + l * 512 + c);
        rk += bflo(rr.x) * bflo(kk.x) * rkw[0] + bfhi(rr.x) * bfhi(kk.x) * rkw[1] + bflo(rr.y) * bflo(kk.y) * rkw[2] + bfhi(rr.y) * bfhi(kk.y) * rkw[3];
        vv[n] = (f32x4){bflo(v2.x), bfhi(v2.x), bflo(v2.y), bfhi(v2.y)}; }
      s1 += shfl_x(s1, 16); s1 += shfl_x(s1, 32); rk += shfl_x(rk, 16); rk += shfl_x(rk, 32);
      const float mu = s1 * (1.f / 64.f); float s2 = 0.f;
#pragma unroll
      for (int n = 0; n < 4; ++n)
#pragma unroll
        for (int j = 0; j < 4; ++j) { const float dl = y[n][j] - mu; s2 += dl * dl; }
      s2 += shfl_x(s2, 16); s2 += shfl_x(s2, 32); const float rstd = rsqrtf(s2 * (1.f / 64.f) + 64e-5f);
#pragma unroll
      for (int n = 0; n < 4; ++n) { const int c = cb + n * 16; const f32x4 lg = *(const f32x4*)(p.rwkv_ln_g + l * 512 + c), lb = *(const f32x4*)(p.rwkv_ln_b + l * 512 + c);
        float o[4];
#pragma unroll
        for (int j = 0; j < 4; ++j) o[j] = ((y[n][j] - mu) * rstd * lg[j] + lb[j] + rk * vv[n][j]) * acc[m][n][j];
        u32x2 ov; ov.x = pack2(o[0], o[1]); ov.y = pack2(o[2], o[3]); *(u32x2*)(oa + row * LDO + c) = ov; }
    }
  }
}

DI void convert_layer_a(const P& p, int l, char* smem) {
  convert_T(p.w_in + (size_t)l * D * INC, D, INC, (bf16_t*)(p.ws + WS_WIN), LDH, smem);
  convert_T(p.w_o_rwkv + (size_t)l * 512 * D, 512, D, (bf16_t*)(p.ws + WS_WO3), LDO, smem);
  convert_T(p.w_o_na + (size_t)l * 512 * D, 512, D, (bf16_t*)(p.ws + WS_WO3) + (size_t)1024 * LDO, LDO, smem);
  convert_T(p.w_o_ret + (size_t)l * 512 * D, 512, D, (bf16_t*)(p.ws + WS_WO3) + (size_t)2 * 1024 * LDO, LDO, smem);
  convert_T(p.w_out + (size_t)l * D * D, D, D, (bf16_t*)(p.ws + WS_WOUT), LDH, smem);
  convert_T(p.rwkv_g_up + (size_t)l * 128 * 512, 128, 512, (bf16_t*)(p.ws + WS_WG), LDG, smem);
}
DI void convert_layer_b(const P& p, int l, char* smem) {
  convert_T(p.ffn_up + (size_t)l * D * 2 * FF, D, 2 * FF, (bf16_t*)(p.ws + WS_WUP), LDH, smem);
  convert_T(p.ffn_down + (size_t)l * FF * D, FF, D, (bf16_t*)(p.ws + WS_WDN), FF, smem);
}

typedef __attribute__((address_space(4))) const P* KP;
DI KP kargs() { KP k = (KP)__builtin_amdgcn_kernarg_segment_ptr(); asm volatile("" : "+s"(k)); return k; }
template <int PH> DI void run_phase(int l, char* smem) {
#if defined(__HIP_DEVICE_COMPILE__)
  const P p = *kargs();
#else
  const P p{};
#endif
  const float* mod = (const float*)(p.ws + WS_MOD);
  float* xbuf = p.out;
  if (PH == 0) { ada_phase(p, smem); convert_layer_a(p, 0, smem); }
  else if (PH == 1) { norm_phase(p, nullptr, nullptr, nullptr, nullptr, 0, nullptr, p.norm_mix_pre, mod, 0, (bf16_t*)(p.ws + WS_H)); }
  else if (PH == 2) phase_win(p, l, smem);
  else if (PH == 4) phase_mixers<7>(p, l, smem);
  else if (PH == 5) phase_rwkv_post(p, l, smem);
  else if (PH == 6) phase_merge(p, smem);
  else if (PH == 7) { phase_gemm_f32((const bf16_t*)(p.ws + WS_MERGED), LDH, D, (const bf16_t*)(p.ws + WS_WOUT), LDH, (float*)(p.ws + WS_U), smem); }
  else if (PH == 8) { convert_layer_b(p, l, smem);
    norm_phase(p, l == 0 ? nullptr : xbuf, (const float*)(p.ws + WS_U), p.norm_mix_post + l * D, mod + (size_t)l * 5 * 6144, 2, xbuf, p.norm_ffn_pre + l * D, mod + (size_t)l * 5 * 6144, 3, (bf16_t*)(p.ws + WS_H)); }
  else if (PH == 9) phase_ffn_up(p, l, smem);
  else if (PH == 11) { phase_gemm_f32((const bf16_t*)(p.ws + WS_HID), FF, FF, (const bf16_t*)(p.ws + WS_WDN), FF, (float*)(p.ws + WS_F), smem); }
  else if (PH == 12) {
    if (l == 0) { norm_phase(p, xbuf, (const float*)(p.ws + WS_F), p.norm_ffn_post, mod, 5, xbuf, p.norm_mix_pre + D, mod + (size_t)5 * 6144, 0, (bf16_t*)(p.ws + WS_H)); convert_layer_a(p, 1, smem); }
    else norm_phase(p, xbuf, (const float*)(p.ws + WS_F), p.norm_ffn_post + D, mod + (size_t)5 * 6144, 5, xbuf, nullptr, nullptr, 0, nullptr);
  }
}

#if MEGA
__global__ void __launch_bounds__(NTP, 1) mega_kernel(P p_) {
  extern __shared__ __attribute__((aligned(16))) char smem[];
  __shared__ u32x4 xb_words;
  cg::grid_group grid = cg::this_grid();
  if (ptid() == 0) xb_words = (u32x4){0u, 0u, 0u, 0u};
  __syncthreads();
#if defined(__HIP_DEVICE_COMPILE__)
  (void)xcd_barrier_post((unsigned*)(p_.ws + WS_BAR), (volatile LAS unsigned*)&xb_words);
#define GSYNC() do { XcdBarrier xb_; xb_.bar = (unsigned*)(kargs()->ws + WS_BAR); xb_.x = xb_xcc_id(); xb_.st = (volatile LAS unsigned*)&xb_words; xcd_barrier(xb_); } while (0)
#else
#define GSYNC() do { } while (0)
#endif
  run_phase<0>(0, smem); grid.sync();
  run_phase<1>(0, smem); GSYNC();
#pragma unroll
  for (int l = 0; l < 2; ++l) {
    run_phase<2>(l, smem); GSYNC();
    if (PROBE_MASK & 1) { run_phase<2>(l, smem); GSYNC(); }
    run_phase<4>(l, smem); GSYNC();
    run_phase<5>(l, smem); GSYNC();
    run_phase<6>(l, smem); GSYNC();
    if (PROBE_MASK & 8) { run_phase<6>(l, smem); GSYNC(); }
    run_phase<7>(l, smem); GSYNC();
    if (PROBE_MASK & 16) { run_phase<7>(l, smem); GSYNC(); }
    run_phase<8>(l, smem); GSYNC();
    run_phase<9>(l, smem); GSYNC();
    if (PROBE_MASK & 32) { run_phase<9>(l, smem); GSYNC(); }
    run_phase<11>(l, smem); GSYNC();
    if (PROBE_MASK & 64) { run_phase<11>(l, smem); GSYNC(); }
    run_phase<12>(l, smem); if (l == 0) GSYNC();
  }
#undef GSYNC
}
#else
template <int PH> __global__ void __launch_bounds__(NTP, 1) phase_kernel(P p, int l) {
  extern __shared__ __attribute__((aligned(16))) char smem[];
  run_phase<PH>(l, smem);
}
#endif

extern "C" void kernel_launch(void* const* d_in, const int* in_sizes, int n_in, void* d_out, int out_size, void* d_ws, size_t ws_size, hipStream_t stream) {
  if (ws_size < WS_END || n_in < 36) { fprintf(stderr, "workspace too small: %zu < %zu\n", ws_size, (size_t)WS_END); return; }
  P p{};
  const float** pp = (const float**)&p;
  for (int i = 0; i < 36; ++i) pp[i] = (const float*)d_in[i];
  p.out = (float*)d_out; p.ws = (char*)d_ws;
  hipMemsetAsync(d_ws, 0, WS_WIN, stream);
#if MEGA
  static int grid_blocks = 0;
  if (!grid_blocks) {
    int dev = 0, cus = 0, per_cu = 0; hipGetDevice(&dev);
    hipDeviceGetAttribute(&cus, hipDeviceAttributeMultiprocessorCount, dev);
    hipFuncSetAttribute((const void*)mega_kernel, hipFuncAttributeMaxDynamicSharedMemorySize, SMEM_BYTES);
    hipOccupancyMaxActiveBlocksPerMultiprocessor(&per_cu, mega_kernel, NTP, SMEM_BYTES);
    if (per_cu > 1) per_cu = 1;
    grid_blocks = cus * per_cu;
  }
  void* args[] = {&p};
  hipError_t e = hipLaunchCooperativeKernel((void*)mega_kernel, dim3(grid_blocks), dim3(NTP), args, SMEM_BYTES, stream);
  if (e != hipSuccess) fprintf(stderr, "cooperative launch failed: %s (grid %d)\n", hipGetErrorString(e), grid_blocks);
#else
  const int G = 512;
#define LAUNCH(PH, L) do { hipFuncSetAttribute((const void*)phase_kernel<PH>, hipFuncAttributeMaxDynamicSharedMemorySize, SMEM_BYTES); phase_kernel<PH><<<G, NT, SMEM_BYTES, stream>>>(p, L); } while (0)
  LAUNCH(0, 0); LAUNCH(1, 0);
  for (int l = 0; l < 2; ++l) { LAUNCH(2, l); LAUNCH(4, l); LAUNCH(5, l); LAUNCH(6, l); LAUNCH(7, l); LAUNCH(8, l); LAUNCH(9, l); LAUNCH(11, l); LAUNCH(12, l); }
#endif
}
```

```cpp
#include <hip/hip_runtime.h>
#include <hip/hip_cooperative_groups.h>
#include <cstdio>
namespace cg = cooperative_groups;

#ifndef MEGA
#define MEGA 1
#endif
#define PROBE_MASK 0

typedef unsigned short bf16_t;
typedef short bf16x8 __attribute__((ext_vector_type(8)));
typedef short bf16x4 __attribute__((ext_vector_type(4)));
typedef float f32x4 __attribute__((ext_vector_type(4)));
typedef float f32x2 __attribute__((ext_vector_type(2)));
typedef unsigned u32x4 __attribute__((ext_vector_type(4)));
typedef unsigned u32x2 __attribute__((ext_vector_type(2)));
#define DI __device__ __forceinline__
#define MFMA16(a, b, c) __builtin_amdgcn_mfma_f32_16x16x32_bf16((a), (b), (c), 0, 0, 0)

constexpr int NT = 256;
constexpr int NTP = 512;
constexpr int VSMEM = 65536;
constexpr int D = 1024, MC = 8192, ML = 4096, MT = 12288;
constexpr int NZR = 1792, NZN = 1536, NZT = 2048, INC = 8448, FF = 2816;
constexpr int LDH = 1088, LDO = 576, LZT = 2112, LDG = 136;
constexpr int LDT = 72;
constexpr int SMEM_BYTES = 131072;
constexpr size_t O_K = 12582912, O_V = 20971520, O_RW = 29360128, O_RT = 33554432;
constexpr size_t WS_CTRL = 0;
constexpr size_t WS_MOD = 4096;
constexpr size_t WS_BAR = 262144;
constexpr size_t WS_CUF = 278528;
constexpr size_t WS_WG = 294912;
constexpr size_t WS_WIN = 434176;
constexpr size_t WS_WUP = WS_WIN;
constexpr size_t WS_WDN = WS_WIN + (size_t)5632 * LDH * 2;
constexpr size_t WS_WO3 = WS_WIN + (size_t)INC * LDH * 2;
constexpr size_t WS_WOUT = WS_WO3 + (size_t)3 * 1024 * LDO * 2;
constexpr size_t WS_H = WS_WOUT + (size_t)1024 * LDH * 2;
constexpr size_t WS_Z = WS_H + (size_t)MT * LDH * 2;
constexpr size_t WS_ZR = WS_Z;
constexpr size_t WS_ZN = WS_ZR + (size_t)MT * NZR * 2;
constexpr size_t WS_ZT = WS_ZN + (size_t)MT * NZN * 2;
constexpr size_t WS_MERGED = WS_ZR;
constexpr size_t WS_OA = WS_ZN;
constexpr size_t WS_U = WS_ZT;
constexpr size_t WS_HID = WS_Z;
constexpr size_t WS_F = WS_ZT;
constexpr size_t WS_Y = WS_ZT + (size_t)MT * LZT * 2;
constexpr size_t WS_ONA = WS_Y + (size_t)2 * MT * 512 * 4;
constexpr size_t WS_ORET = WS_ONA + (size_t)MT * LDO * 2;
constexpr size_t WS_END = WS_ORET + (size_t)MT * LDO * 2;

struct P {
  const float *x_prompt, *x_sample, *cache_k, *cache_v, *state_rwkv, *state_ret, *c, *c_ctx, *ada_w, *ada_b;
  const float *norm_mix_pre, *norm_mix_post, *norm_ffn_pre, *norm_ffn_post, *w_in, *rwkv_conv, *rwkv_w0, *rwkv_w_up, *rwkv_a0, *rwkv_a_up, *rwkv_g_up;
  const float *rwkv_k_k, *rwkv_k_a, *rwkv_r_k, *rwkv_ln_g, *rwkv_ln_b, *na_rpb, *ret_decay, *ret_gn, *w_o_rwkv, *w_o_na, *w_o_ret, *w_out, *ffn_up, *ffn_conv, *ffn_down;
  float* out; char* ws;
};

DI int threadIdx_x_raw() { return (int)__builtin_amdgcn_workitem_id_x(); }
DI int ptid() { int t = threadIdx_x_raw(); asm volatile("" : "+v"(t)); return t; }
DI int tidx() { return ptid() & 255; }
DI int vhalf() { return ptid() >> 8; }
DI int vblk() { return (int)blockIdx.x * 2 + vhalf(); }
DI int vgrid() { return (int)gridDim.x * 2; }
DI unsigned cvt_pk_bf16(float lo, float hi) { unsigned r; asm("v_cvt_pk_bf16_f32 %0, %1, %2" : "=v"(r) : "v"(lo), "v"(hi)); return r; }
DI bf16_t f2bf(float x) { return (bf16_t)(cvt_pk_bf16(x, 0.f) & 0xffffu); }
DI float bf2f(bf16_t b) { return __uint_as_float(((unsigned)b) << 16); }
DI unsigned pack2(float a, float b) { return cvt_pk_bf16(a, b); }
DI float bflo(unsigned u) { return __uint_as_float(u << 16); }
DI float bfhi(unsigned u) { return __uint_as_float(u & 0xffff0000u); }
DI void unpack8(const u32x4 r, float (&f)[8]) { f[0] = bflo(r[0]); f[1] = bfhi(r[0]); f[2] = bflo(r[1]); f[3] = bfhi(r[1]); f[4] = bflo(r[2]); f[5] = bfhi(r[2]); f[6] = bflo(r[3]); f[7] = bfhi(r[3]); }
DI u32x4 pack8(const float (&f)[8]) { u32x4 r; r[0] = pack2(f[0], f[1]); r[1] = pack2(f[2], f[3]); r[2] = pack2(f[4], f[5]); r[3] = pack2(f[6], f[7]); return r; }
DI float sigmoidf_(float x) { return __builtin_amdgcn_rcpf(1.f + __expf(-x)); }
DI float shfl_x(float v, int m) { const int lane = ptid() & 63; return __int_as_float(__builtin_amdgcn_ds_bpermute((lane ^ m) << 2, __float_as_int(v))); }
DI float wave_sum(float v) { for (int o = 32; o > 0; o >>= 1) v += shfl_x(v, o); return v; }
DI void tokinfo(int m, int& t, int& T, int& mi) { if (m < MC) { t = m & 255; T = 256; mi = 0; } else { int q = m - MC; t = q & 1023; T = 1024; mi = 1 + (q >> 10); } }

#define XB_TMO      128
#define XB_XCNT(j)  (256  + 64 * (j))
#define XB_XSUB(j)  (1280 + 64 * (j))
#define XB_XGEN(j)  (2304 + 64 * (j))
#define XB_TOP      3328
#define XB_TOPGEN   3392
#define XB_SPIN_CAP (1u << 20)
#define LAS __attribute__((address_space(3)))
DI unsigned xb_ld(unsigned* p) { return __hip_atomic_load(p, __ATOMIC_RELAXED, __HIP_MEMORY_SCOPE_AGENT); }
DI unsigned xb_add(unsigned* p, unsigned v) { return __hip_atomic_fetch_add(p, v, __ATOMIC_RELAXED, __HIP_MEMORY_SCOPE_AGENT); }
DI unsigned xb_xcc_id() { return (unsigned)__builtin_amdgcn_s_getreg((3 << 11) | 20) & 0xFu; }
#define XB_SPIN(cond, bar) do { unsigned _sp = 0; while (cond) { __builtin_amdgcn_s_sleep(1); \
    if ((++_sp & 255u) == 0u) { if (xb_ld(&(bar)[XB_TMO])) break; if (_sp > XB_SPIN_CAP) { atomicAdd(&(bar)[XB_TMO], 1u); break; } } } } while (0)
struct XcdBarrier { unsigned* bar; unsigned x; volatile LAS unsigned* st; };
DI XcdBarrier xcd_barrier_post(unsigned* bar, volatile LAS unsigned* st) {
  XcdBarrier b; b.bar = bar; b.x = xb_xcc_id(); b.st = st;
  if (ptid() == 0) (void)xb_add(&bar[XB_XCNT(b.x)], 1u);
  return b;
}
DI void xcd_barrier_complete(unsigned* bar, unsigned x, unsigned& nloc, unsigned& nx) {
  const unsigned G = gridDim.x * gridDim.y * gridDim.z;
  unsigned sum, cnt, mine, sp = 0u;
  for (;;) {
    sum = 0u; cnt = 0u; mine = 0u;
#pragma unroll
    for (unsigned j = 0; j < 16; ++j) { const unsigned c = xb_ld(&bar[XB_XCNT(j)]); sum += c; cnt += (c > 0u) ? 1u : 0u; mine = (j == x) ? c : mine; }
    if (sum == G) break;
    __builtin_amdgcn_s_sleep(1);
    if ((++sp & 255u) == 0u) { if (xb_ld(&bar[XB_TMO])) break; if (sp > XB_SPIN_CAP) { atomicAdd(&bar[XB_TMO], 1u); break; } }
  }
  nloc = mine > 0u ? mine : 1u; nx = cnt > 0u ? cnt : 1u;
}
DI void xcd_barrier(const XcdBarrier& b) {
  asm volatile("s_waitcnt vmcnt(0)" ::: "memory");
  __syncthreads();
  if (ptid() == 0) {
    unsigned* bar = b.bar;
    __builtin_amdgcn_s_waitcnt(0);
    unsigned nloc = b.st[0], nx = b.st[1];
    if (nloc == 0u) { xcd_barrier_complete(bar, b.x, nloc, nx); b.st[0] = nloc; b.st[1] = nx; }
    const unsigned old = xb_add(&bar[XB_XSUB(b.x)], 1u);
    const unsigned gen = old / nloc;
    if (old + 1u == (gen + 1u) * nloc) {
      __builtin_amdgcn_fence(__ATOMIC_RELEASE, "agent");
      asm volatile("s_waitcnt vmcnt(0)" ::: "memory");
      const unsigned og = xb_add(&bar[XB_TOP], 1u);
      const unsigned tg = og / nx;
      if (og + 1u == (tg + 1u) * nx) xb_add(&bar[XB_TOPGEN], 1u);
      else XB_SPIN(xb_ld(&bar[XB_TOPGEN]) == tg, bar);
      __builtin_amdgcn_fence(__ATOMIC_ACQUIRE, "agent");
      xb_add(&bar[XB_XGEN(b.x)], 1u);
      asm volatile("s_waitcnt vmcnt(0)" ::: "memory");
    } else {
      XB_SPIN(xb_ld(&bar[XB_XGEN(b.x)]) == gen, bar);
      __builtin_amdgcn_fence(__ATOMIC_ACQUIRE, "agent");
      asm volatile("s_waitcnt vmcnt(0)" ::: "memory");
    }
  }
  __syncthreads();
}

__device__ void convert_T(const float* __restrict__ W, int K, int N, bf16_t* __restrict__ Wt, int ldt, char* smem) {
  float* t = (float*)(smem + vhalf() * VSMEM);
  const int tid = tidx(), ntn = N >> 6, nitems = (K >> 6) * ntn;
  const int kr = tid >> 4, c4 = (tid & 15) * 4;
  f32x4 v[4];
  { const int it = vblk() < nitems ? vblk() : 0; const int k0 = (it / ntn) << 6, n0 = (it % ntn) << 6;
#pragma unroll
    for (int i = 0; i < 4; ++i) v[i] = *(const f32x4*)(W + (size_t)(k0 + kr + 16 * i) * N + n0 + c4); }
  for (int it = vblk(); it < nitems; it += vgrid()) {
    const int k0 = (it / ntn) << 6, n0 = (it % ntn) << 6;
    __syncthreads();
#pragma unroll
    for (int i = 0; i < 4; ++i) { const int k = kr + 16 * i; t[k * 65 + c4] = v[i][0]; t[k * 65 + c4 + 1] = v[i][1]; t[k * 65 + c4 + 2] = v[i][2]; t[k * 65 + c4 + 3] = v[i][3]; }
    __syncthreads();
    { const int itn = it + vgrid() < nitems ? it + vgrid() : it; const int k1 = (itn / ntn) << 6, n1 = (itn % ntn) << 6;
#pragma unroll
      for (int i = 0; i < 4; ++i) v[i] = *(const f32x4*)(W + (size_t)(k1 + kr + 16 * i) * N + n1 + c4); }
#pragma unroll
    for (int i = 0; i < 2; ++i) { const int c = tid + 256 * i, n = c >> 3, kc = c & 7; float f[8];
#pragma unroll
      for (int e = 0; e < 8; ++e) f[e] = t[(kc * 8 + e) * 65 + n];
      *(u32x4*)(Wt + (size_t)(n0 + n) * ldt + k0 + kc * 8) = pack8(f); }
  }
}

__device__ void ada_phase(const P& p, char* smem) {
  float* sc = (float*)(smem + vhalf() * VSMEM);
  float* red = sc + 640;
  float* mod = (float*)(p.ws + WS_MOD);
  const int tid = tidx(), kq = tid >> 5, cq = tid & 31;
  for (int it = vblk(); it < 2 * 48 * 8; it += vgrid()) {
    const int l = it / 384, rem = it % 384, nb = rem >> 3, ks = rem & 7;
    const int n0 = nb * 128, k0 = ks * 128;
    __syncthreads();
    for (int e = tid; e < 640; e += NT) { const int i = e >> 7, k = e & 127; const float v = (i == 0) ? p.c_ctx[k0 + k] : p.c[(i - 1) * D + k0 + k]; sc[e] = v * sigmoidf_(v); }
    __syncthreads();
    float acc[5][4];
#pragma unroll
    for (int i = 0; i < 5; ++i)
#pragma unroll
      for (int j = 0; j < 4; ++j) acc[i][j] = 0.f;
    const float* wp = p.ada_w + ((size_t)l * D + k0 + kq * 16) * 6144 + n0 + cq * 4;
#pragma unroll 4
    for (int kk = 0; kk < 16; ++kk) { const float4 w = *(const float4*)(wp + (size_t)kk * 6144);
#pragma unroll
      for (int i = 0; i < 5; ++i) { const float s = sc[i * 128 + kq * 16 + kk]; acc[i][0] += s * w.x; acc[i][1] += s * w.y; acc[i][2] += s * w.z; acc[i][3] += s * w.w; } }
#pragma unroll
    for (int i = 0; i < 5; ++i)
#pragma unroll
      for (int j = 0; j < 4; ++j) red[(kq * 5 + i) * 128 + cq * 4 + j] = acc[i][j];
    __syncthreads();
    for (int e = tid; e < 640; e += NT) { const int i = e >> 7, n = e & 127; float s = 0.f;
#pragma unroll
      for (int q = 0; q < 8; ++q) s += red[(q * 5 + i) * 128 + n];
      if (ks == 0) s += p.ada_b[l * 6144 + n0 + n];
      atomicAdd(mod + ((size_t)l * 5 + i) * 6144 + n0 + n, s); }
  }
}

__device__ void norm_phase(const P& p, const float* xin  , const float* u, const float* gpost, const float* modU, int gate_idx,
                           float* xout, const float* gpre, const float* modN, int shift_idx, bf16_t* hout) {
  const int lane = tidx() & 63, wave = tidx() >> 6, nw = NT / 64;
  for (int m = vblk() * nw + wave; m < MT; m += vgrid() * nw) {
    int t, T, mi; tokinfo(m, t, T, mi);
    const float* xr = xin ? xin + (size_t)m * D : (m < MC ? p.x_prompt + (size_t)m * D : p.x_sample + (size_t)(m - MC) * D);
    float4 x[4];
#pragma unroll
    for (int i = 0; i < 4; ++i) x[i] = *(const float4*)(xr + i * 256 + lane * 4);
    if (u) {
      float4 uu[4]; float ss = 0.f;
#pragma unroll
      for (int i = 0; i < 4; ++i) { uu[i] = *(const float4*)(u + (size_t)m * D + i * 256 + lane * 4); ss += uu[i].x * uu[i].x + uu[i].y * uu[i].y + uu[i].z * uu[i].z + uu[i].w * uu[i].w; }
      ss = wave_sum(ss); const float rs = rsqrtf(ss * (1.f / D) + 1e-6f);
#pragma unroll
      for (int i = 0; i < 4; ++i) { const int c = i * 256 + lane * 4; const float4 g = *(const float4*)(gpost + c); const float4 ga = *(const float4*)(modU + ((size_t)mi * 6 + gate_idx) * D + c);
        x[i].x += ga.x * uu[i].x * rs * g.x; x[i].y += ga.y * uu[i].y * rs * g.y; x[i].z += ga.z * uu[i].z * rs * g.z; x[i].w += ga.w * uu[i].w * rs * g.w; }
    }
    if (xout) {
#pragma unroll
      for (int i = 0; i < 4; ++i) *(float4*)(xout + (size_t)m * D + i * 256 + lane * 4) = x[i];
    }
    if (hout) {
      float ss = 0.f;
#pragma unroll
      for (int i = 0; i < 4; ++i) ss += x[i].x * x[i].x + x[i].y * x[i].y + x[i].z * x[i].z + x[i].w * x[i].w;
      ss = wave_sum(ss); const float rs = rsqrtf(ss * (1.f / D) + 1e-6f);
#pragma unroll
      for (int i = 0; i < 4; ++i) { const int c = i * 256 + lane * 4; const float4 g = *(const float4*)(gpre + c);
        const float4 sh = *(const float4*)(modN + ((size_t)mi * 6 + shift_idx) * D + c); const float4 sc = *(const float4*)(modN + ((size_t)mi * 6 + shift_idx + 1) * D + c);
        u32x2 o; o.x = pack2(x[i].x * rs * g.x * (1.f + sc.x) + sh.x, x[i].y * rs * g.y * (1.f + sc.y) + sh.y); o.y = pack2(x[i].z * rs * g.z * (1.f + sc.z) + sh.z, x[i].w * rs * g.w * (1.f + sc.w) + sh.w);
        *(u32x2*)(hout + (size_t)m * LDH + c) = o; }
    }
  }
}

struct TileSrc { const bf16_t* A; int lda; int arow0; const bf16_t* B; int ldb; int brow0, brow1; int K; };

template <int MM, int NN> DI void zero_acc(f32x4 (&acc)[MM][NN]) {
#pragma unroll
  for (int m = 0; m < MM; ++m)
#pragma unroll
    for (int n = 0; n < NN; ++n) acc[m][n] = (f32x4){0.f, 0.f, 0.f, 0.f};
}

template <int MM, int NN, int KU = 0> struct Gemm {
  static constexpr int NA = MM / 2, NB = NN;
  unsigned oa_[NA], ob_[NB]; const bf16_t* A; const bf16_t* B; int nk; u32x4 ra[NA], rb[NB];
#define GT_LOAD(KT) do { const int kn_ = ((KT) < nk ? (KT) : nk - 1) * 64; \
    _Pragma("unroll") for (int i = 0; i < NA; ++i) ra[i] = *(const u32x4*)(A + (oa_[i] + kn_)); \
    _Pragma("unroll") for (int i = 0; i < NB; ++i) rb[i] = *(const u32x4*)(B + (ob_[i] + kn_)); } while (0)
  DI void begin(const TileSrc& s) {
    const int tid = ptid();
#pragma unroll
    for (int i = 0; i < NA; ++i) { const int row = (tid >> 3) + 64 * i, kc = tid & 7;
      int ar = s.arow0 + row; ar = ar < 0 ? 0 : (ar > MT - 1 ? MT - 1 : ar);
      oa_[i] = (unsigned)ar * (unsigned)s.lda + kc * 8; }
#pragma unroll
    for (int i = 0; i < NB; ++i) { const int row = (tid >> 3) + 64 * i, kc = tid & 7;
      const int br = row < 32 * NN ? s.brow0 + row : s.brow1 + row - 32 * NN;
      ob_[i] = (unsigned)br * (unsigned)s.ldb + kc * 8; }
    A = s.A; B = s.B; nk = s.K >> 6;
    GT_LOAD(0);
  }
  DI void run(f32x4 (&acc)[MM][NN], char* smem) {
    bf16_t* sbase = (bf16_t*)smem;
    const int tid = ptid(), lane = tid & 63, wave = tid >> 6, wr = wave >> 2, wc = wave & 3, fr = lane & 15, fq = lane >> 4;
    int wofs; { const int r = tid >> 3, kc = tid & 7, ob = (r & 15) * 64 + (kc & 3) * 16; wofs = (((r >> 4) * 2 + (kc >> 2)) * 1024 + (ob ^ (((ob >> 9) & 1) << 5))) >> 1; }
    int robase; { const int ob = fr * 64 + fq * 16; robase = (ob ^ (((ob >> 9) & 1) << 5)) >> 1; }
#define GT_STORE(ST) do { bf16_t* sA_ = sbase + (ST) * 32768; bf16_t* sB_ = sA_ + 16384; \
    _Pragma("unroll") for (int i = 0; i < NA; ++i) *(u32x4*)(sA_ + wofs + i * 4096) = ra[i]; \
    _Pragma("unroll") for (int i = 0; i < NB; ++i) *(u32x4*)(sB_ + wofs + i * 4096) = rb[i]; } while (0)
#define GT_KSTEP(ks) do { bf16x8 bfr[NN]; \
      _Pragma("unroll") for (int n = 0; n < NN; ++n) bfr[n] = *(const bf16x8*)(sB_ + ((wc * NN + n) * 2 + (ks)) * 512); \
      _Pragma("unroll") for (int m = 0; m < MM; ++m) { const bf16x8 af = *(const bf16x8*)(sA_ + ((wr * MM + m) * 2 + (ks)) * 512); \
        _Pragma("unroll") for (int n = 0; n < NN; ++n) acc[m][n] = MFMA16(bfr[n], af, acc[m][n]); } } while (0)
#define GT_COMPUTE(ST) do { const bf16_t* sA_ = sbase + (ST) * 32768 + robase; const bf16_t* sB_ = sA_ + 16384; __builtin_amdgcn_s_setprio(1); \
    if (KU) { GT_KSTEP(0); GT_KSTEP(1); } else { _Pragma("unroll 1") for (int ks = 0; ks < 2; ++ks) GT_KSTEP(ks); } \
    __builtin_amdgcn_s_setprio(0); } while (0)
    __syncthreads();
    GT_STORE(0);
    GT_LOAD(1);
    __syncthreads();
#pragma unroll 1
    for (int kt = 0; kt < nk; kt += 2) {
      GT_STORE(1); GT_LOAD(kt + 2); GT_COMPUTE(0); __syncthreads();
      GT_STORE(0); GT_LOAD(kt + 3); GT_COMPUTE(1); __syncthreads();
    }
  }
#undef GT_LOAD
#undef GT_STORE
#undef GT_COMPUTE
#undef GT_KSTEP
};
template <int MM, int NN> DI void gemm_tile(f32x4 (&acc)[MM][NN], const TileSrc& s, char* smem) { Gemm<MM, NN> g; g.begin(s); g.run(acc, smem); }

DI float gelu_tanh(float x) { const float u = 0.7978845608f * (x + 0.044715f * x * x * x); const float e = __expf(2.f * u); const float th = 1.f - 2.f * __builtin_amdgcn_rcpf(e + 1.f); return 0.5f * x * (1.f + th); }

struct TileIter {
  int m_lo, rows, NTn, G, efull, count, e, stride;
  DI void init(int MTn, int NTn_) { const int x = blockIdx.x & 7; m_lo = (x * MTn) >> 3; rows = (((x + 1) * MTn) >> 3) - m_lo; NTn = NTn_; G = (rows + 1) >> 1;
    efull = (rows / G) * G * NTn; count = rows * NTn; e = blockIdx.x >> 3; stride = gridDim.x >> 3; }
  DI bool next(int& mt, int& nt) { if (e >= count) return false;
    if (e < efull) { const int grp = e / (G * NTn), rem = e - grp * G * NTn; nt = rem / G; mt = m_lo + grp * G + (rem - nt * G); }
    else { const int rem = e - efull, gsz = rows - (rows / G) * G; nt = rem / gsz; mt = m_lo + (rows / G) * G + (rem - nt * gsz); }
    e += stride; return true; }
};

__device__ void phase_win(const P& p, int l, char* smem) {
  const bf16_t* H = (const bf16_t*)(p.ws + WS_H); const bf16_t* Wt = (const bf16_t*)(p.ws + WS_WIN);
  bf16_t* zr = (bf16_t*)(p.ws + WS_ZR); bf16_t* zn = (bf16_t*)(p.ws + WS_ZN); bf16_t* zt = (bf16_t*)(p.ws + WS_ZT);
  const int tid = ptid(), lane = tid & 63, wave = tid >> 6, wr = wave >> 2, wc = wave & 3, fr = lane & 15, fq = lane >> 4;
  Gemm<8, 4> gm;
  TileIter ti; ti.init(48, 14);
  const int x = blockIdx.x & 7, nconv = (343 - x + 7) >> 3, nloc = ti.count + nconv;
  const float* cw = p.rwkv_conv + (size_t)l * 3 * NZR;
  for (int e = (int)(blockIdx.x >> 3); e < nloc; e += (int)(gridDim.x >> 3)) {
    f32x4 acc[8][4]; zero_acc<8, 4>(acc);
    if (e < nconv) {
      const int c = x + 8 * e, mt = c / 7, nt = c - mt * 7;
      const int n0 = nt * 256, arow0 = mt * 254 - 1;
      { TileSrc s{H, LDH, arow0, Wt, LDH, n0, n0 + 128, D}; gm.begin(s); }
      gm.run(acc, smem);
      float* sC = (float*)smem;
#pragma unroll 1
      for (int sl = 0; sl < 4; ++sl) {
        __syncthreads();
        if (wc == sl) {
#pragma unroll
          for (int m = 0; m < 8; ++m)
#pragma unroll
            for (int n = 0; n < 4; ++n) *(f32x4*)(sC + (wr * 128 + m * 16 + fr) * 68 + n * 16 + fq * 4) = acc[m][n];
        }
        __syncthreads();
        const int nb = n0 + sl * 64, c4 = (tid & 15) * 4;
        const float4 w0 = *(const float4*)(cw + nb + c4), w1 = *(const float4*)(cw + NZR + nb + c4), w2 = *(const float4*)(cw + 2 * NZR + nb + c4);
        for (int ee = tid; ee < 254 * 16; ee += NTP) {
          const int tr = 1 + (ee >> 4), g = arow0 + tr;
          if (g < MT) { int t, T, mi; tokinfo(g, t, T, mi);
            const float pm = t > 0 ? 1.f : 0.f, nm = t < T - 1 ? 1.f : 0.f;
            const f32x4 a = *(const f32x4*)(sC + (tr - 1) * 68 + c4), b = *(const f32x4*)(sC + tr * 68 + c4), cc = *(const f32x4*)(sC + (tr + 1) * 68 + c4);
            float r0 = pm * a[0] * w0.x + b[0] * w1.x + nm * cc[0] * w2.x, r1 = pm * a[1] * w0.y + b[1] * w1.y + nm * cc[1] * w2.y;
            float r2 = pm * a[2] * w0.z + b[2] * w1.z + nm * cc[2] * w2.z, r3 = pm * a[3] * w0.w + b[3] * w1.w + nm * cc[3] * w2.w;
            if (nb >= 1664) { r0 = sigmoidf_(r0); r1 = sigmoidf_(r1); r2 = sigmoidf_(r2); r3 = sigmoidf_(r3); }
            u32x2 o; o.x = pack2(r0, r1); o.y = pack2(r2, r3);
            *(u32x2*)(zr + (size_t)g * NZR + nb + c4) = o; }
        }
      }
    } else {
      int mt, nt; ti.e = e - nconv; ti.next(mt, nt);
      const int n0 = nt * 256, row0 = mt * 256;
      { TileSrc s{H, LDH, row0, Wt, LDH, NZR + n0, NZR + n0 + 128, D}; gm.begin(s); }
      gm.run(acc, smem);
#pragma unroll
      for (int m = 0; m < 8; ++m) { const int row = row0 + wr * 128 + m * 16 + fr;
#pragma unroll
        for (int n = 0; n < 4; ++n) { const int col = n0 + wc * 64 + n * 16 + fq * 4; const f32x4 v = acc[m][n];
          u32x2 o; o.x = pack2(v[0], v[1]); o.y = pack2(v[2], v[3]);
          if (col < NZN) {
            *(u32x2*)(zn + (size_t)row * NZN + col) = o;
            if (row < MC && col >= 512) { const int part = col - 512, isv = part >> 9, pp = part & 511, hh = pp >> 6, d = pp & 63, b = row >> 8, t = row & 255;
              float* dst = p.out + (isv ? O_V : O_K) + ((((size_t)b * 2 + l) * 8 + hh) * 256 + t) * 64 + d; *(f32x4*)dst = v; }
          } else { *(u32x2*)(zt + (size_t)row * LZT + (col - NZN)) = o; }
        } }
    }
  }
}

__device__ void phase_merge(const P& p, char* smem) {
  const bf16_t* H = (const bf16_t*)(p.ws + WS_H); const bf16_t* Wt = (const bf16_t*)(p.ws + WS_WIN); const bf16_t* Wo3 = (const bf16_t*)(p.ws + WS_WO3);
  bf16_t* mg = (bf16_t*)(p.ws + WS_MERGED);
  const int tid = ptid(), lane = tid & 63, wave = tid >> 6, wr = wave >> 2, wc = wave & 3, fr = lane & 15, fq = lane >> 4;
  TileIter ti; int mt, nt; ti.init(96, 8);
  while (ti.next(mt, nt)) {
    const int n0 = nt * 128, row0 = mt * 128;
    f32x4 macc[4][2]; zero_acc<4, 2>(macc);
#pragma unroll 1
    for (int i = 0; i < 3; ++i) {
      const bf16_t* O = (const bf16_t*)(p.ws + (i == 0 ? WS_OA : (i == 1 ? WS_ONA : WS_ORET)));
      f32x4 g[4][2]; zero_acc<4, 2>(g);
      { TileSrc s{H, LDH, row0, Wt, LDH, 5376 + i * 1024 + n0, 5376 + i * 1024 + n0 + 64, D}; { Gemm<4, 2, 1> gm; gm.begin(s); gm.run(g, smem); } }
      f32x4 a2[4][2]; zero_acc<4, 2>(a2);
      { TileSrc s{O, LDO, row0, Wo3 + (size_t)i * 1024 * LDO, LDO, n0, n0 + 64, 512}; { Gemm<4, 2, 1> gm; gm.begin(s); gm.run(a2, smem); } }
#pragma unroll
      for (int m = 0; m < 4; ++m)
#pragma unroll
        for (int n = 0; n < 2; ++n)
#pragma unroll
          for (int j = 0; j < 4; ++j) macc[m][n][j] += sigmoidf_(g[m][n][j]) * a2[m][n][j];
    }
#pragma unroll
    for (int m = 0; m < 4; ++m) { const int row = row0 + wr * 64 + m * 16 + fr;
#pragma unroll
      for (int n = 0; n < 2; ++n) { const int col = n0 + wc * 32 + n * 16 + fq * 4; u32x2 o; o.x = pack2(macc[m][n][0], macc[m][n][1]); o.y = pack2(macc[m][n][2], macc[m][n][3]); *(u32x2*)(mg + (size_t)row * LDH + col) = o; } }
  }
}

__device__ void phase_gemm_f32(const bf16_t* A, int lda, int K, const bf16_t* Bt, int ldb, float* C, char* smem) {
  const int tid = ptid(), lane = tid & 63, wave = tid >> 6, wr = wave >> 2, wc = wave & 3, fr = lane & 15, fq = lane >> 4;
  TileIter ti; int mt, nt; ti.init(48, 4);
  while (ti.next(mt, nt)) {
    const int n0 = nt * 256, row0 = mt * 256;
    f32x4 acc[8][4]; zero_acc<8, 4>(acc);
    TileSrc s{A, lda, row0, Bt, ldb, n0, n0 + 128, K}; gemm_tile<8, 4>(acc, s, smem);
#pragma unroll
    for (int m = 0; m < 8; ++m) { const int row = row0 + wr * 128 + m * 16 + fr;
#pragma unroll
      for (int n = 0; n < 4; ++n) *(f32x4*)(C + (size_t)row * D + n0 + wc * 64 + n * 16 + fq * 4) = acc[m][n]; }
  }
}

__device__ void phase_ffn_up(const P& p, int l, char* smem) {
  const bf16_t* H = (const bf16_t*)(p.ws + WS_H); const bf16_t* Wt = (const bf16_t*)(p.ws + WS_WUP); bf16_t* hid = (bf16_t*)(p.ws + WS_HID);
  const int tid = ptid(), lane = tid & 63, wave = tid >> 6, wr = wave >> 2, wc = wave & 3, fr = lane & 15, fq = lane >> 4;
  const float* cw = p.ffn_conv + (size_t)l * 3 * 2 * FF;
  TileIter ti; int mt, nt; ti.init(49, 22);
  Gemm<8, 4> gm;
  while (ti.next(mt, nt)) {
    const int c0 = nt * 128, arow0 = mt * 254 - 1;
    f32x4 acc[8][4]; zero_acc<8, 4>(acc);
    { TileSrc s{H, LDH, arow0, Wt, LDH, c0, FF + c0, D}; gm.begin(s); }
    gm.run(acc, smem);
    float* sC = (float*)smem;
#pragma unroll
    for (int q = 0; q < 4; ++q) {
      __syncthreads();
      if ((wc & 1) == (q >> 1)) { const int cb = (wc >> 1) * 32;
#pragma unroll
        for (int m = 0; m < 8; ++m)
#pragma unroll
          for (int n = 0; n < 2; ++n) *(f32x4*)(sC + (wr * 128 + m * 16 + fr) * 68 + cb + n * 16 + fq * 4) = acc[m][(q & 1) * 2 + n];
      }
      __syncthreads();
      const int cq = c0 + q * 32, c4 = (tid & 7) * 4;
      const f32x4 v0 = *(const f32x4*)(cw + cq + c4), v1 = *(const f32x4*)(cw + 2 * FF + cq + c4), v2 = *(const f32x4*)(cw + 4 * FF + cq + c4);
      const f32x4 g0 = *(const f32x4*)(cw + FF + cq + c4), g1 = *(const f32x4*)(cw + 3 * FF + cq + c4), g2 = *(const f32x4*)(cw + 5 * FF + cq + c4);
      for (int e = tid; e < 254 * 8; e += NTP) {
        const int tr = 1 + (e >> 3), g = arow0 + tr;
        if (g < MT) { int t, T, mi; tokinfo(g, t, T, mi);
          const float pm = t > 0 ? 1.f : 0.f, nm = t < T - 1 ? 1.f : 0.f;
          const f32x4 va = *(const f32x4*)(sC + (tr - 1) * 68 + c4), vb = *(const f32x4*)(sC + tr * 68 + c4), vc = *(const f32x4*)(sC + (tr + 1) * 68 + c4);
          const f32x4 ga = *(const f32x4*)(sC + (tr - 1) * 68 + 32 + c4), gb = *(const f32x4*)(sC + tr * 68 + 32 + c4), gc = *(const f32x4*)(sC + (tr + 1) * 68 + 32 + c4);
          float r[4];
#pragma unroll
          for (int j = 0; j < 4; ++j) { const float val = pm * va[j] * v0[j] + vb[j] * v1[j] + nm * vc[j] * v2[j]; const float gt = pm * ga[j] * g0[j] + gb[j] * g1[j] + nm * gc[j] * g2[j]; r[j] = gelu_tanh(gt) * val; }
          u32x2 o; o.x = pack2(r[0], r[1]); o.y = pack2(r[2], r[3]);
          *(u32x2*)(hid + (size_t)g * FF + cq + c4) = o; }
      }
    }
  }
}

template <int CTRL> DI float dppf(float v) { return __int_as_float(__builtin_amdgcn_mov_dpp(__float_as_int(v), CTRL, 0xF, 0xF, true)); }
DI float row16_sum(float v) { v += dppf<0xB1>(v); v += dppf<0x4E>(v); v += dppf<0x141>(v); v += dppf<0x140>(v); return v; }

DI float frcp(float x) { return __builtin_amdgcn_rcpf(x); }
DI float fsig(float x) { return frcp(1.f + __expf(-x)); }
__device__ void scan_task(const P& p, int l, int seq, int h, int d, int half, char* smem) {
  float* sR = (float*)smem; float* sW = sR + 1024; float* sKD = sW + 1024; float* sB = sKD + 1024; float* sNK = sB + 1024; float* sV = sNK + 1024; float* sK = sV + 1024; float* sY = sK + 1024;
  float* sKn = sY + 2048; float* sKK = sKn + 16; bf16_t* sWT = (bf16_t*)(sKK + 64); bf16_t* sAL = sWT + 16 * LDT;
  const int tid = tidx(), lane = tid & 63, wave = tid >> 6, fr = lane & 15, fq = lane >> 4;
  const int row0 = seq < 32 ? seq * 256 : MC + (seq - 32) * 1024, T = seq < 32 ? 256 : 1024, nch = T >> 4;
  const bf16_t* zr = (const bf16_t*)(p.ws + WS_ZR);
  float* yout = (float*)(p.ws + WS_Y) + (size_t)d * MT * 512;
  __syncthreads();
  if (tid < 64) sKK[tid] = p.rwkv_k_k[l * 512 + h * 64 + tid];
  const int cc = wave * 16 + fr, gc = h * 64 + cc;
  bf16x8 bw[2], ba[2];
#pragma unroll
  for (int ks = 0; ks < 2; ++ks)
#pragma unroll
    for (int e = 0; e < 8; ++e) { const int k = ks * 32 + fq * 8 + e;
      bw[ks][e] = (short)f2bf(p.rwkv_w_up[((size_t)(l * 2 + d) * 64 + k) * 512 + gc]); ba[ks][e] = (short)f2bf(p.rwkv_a_up[((size_t)(l * 2 + d) * 64 + k) * 512 + gc]); }
  const float w0c = p.rwkv_w0[(l * 2 + d) * 512 + gc], a0c = p.rwkv_a0[(l * 2 + d) * 512 + gc], kac = p.rwkv_k_a[l * 512 + gc];
  const int rg = tid >> 4, kq = tid & 15, rbase = half * 32 + rg * 2;
  f32x2 S[2][2];
  if (seq >= 32) { const float* s0 = p.state_rwkv + (((((size_t)(seq - 32) * 2 + l) * 2 + d) * 8 + h) * 64 + rbase) * 64 + kq * 4;
#pragma unroll
    for (int r = 0; r < 2; ++r) { const f32x4 x = *(const f32x4*)(s0 + r * 64); S[r][0] = (f32x2){x[0], x[1]}; S[r][1] = (f32x2){x[2], x[3]}; } }
  else {
#pragma unroll
    for (int r = 0; r < 2; ++r) { S[r][0] = (f32x2){0.f, 0.f}; S[r][1] = (f32x2){0.f, 0.f}; } }
  if (seq >= 32) __builtin_amdgcn_s_setprio(2);
  const int at = (tid & 127) >> 3, apart = tid & 7, ahi = tid >> 7;
  size_t coff[3];
  { const int sb0 = ahi ? 512 + h * 64 : h * 64, sb1 = ahi ? 1536 : 1024 + h * 64, sb2 = 1600;
    coff[0] = (size_t)at * NZR + sb0 + apart * 8; coff[1] = (size_t)at * NZR + sb1 + apart * 8; coff[2] = (size_t)at * NZR + sb2 + apart * 8; }
  u32x4 pre[3];
  { const int t0 = (d ? nch - 1 : 0) * 16;
#pragma unroll
    for (int i = 0; i < 3; ++i) pre[i] = *(const u32x4*)(zr + (size_t)(row0 + t0) * NZR + coff[i]); }
  __syncthreads();
  for (int ci = 0; ci < nch; ++ci) {
    const int chunk = d ? nch - 1 - ci : ci, t0 = chunk * 16;
    { const int o = at * 64 + apart * 8; float f[8];
      unpack8(pre[0], f);
      if (ahi == 0) { *(f32x4*)(sR + o) = (f32x4){f[0], f[1], f[2], f[3]}; *(f32x4*)(sR + o + 4) = (f32x4){f[4], f[5], f[6], f[7]}; }
      else { *(f32x4*)(sK + o) = (f32x4){f[0], f[1], f[2], f[3]}; *(f32x4*)(sK + o + 4) = (f32x4){f[4], f[5], f[6], f[7]}; float ps = 0.f;
#pragma unroll
        for (int e = 0; e < 8; ++e) { const float kk = f[e] * sKK[apart * 8 + e]; ps += kk * kk; }
        ps += dppf<0xB1>(ps); ps += dppf<0x4E>(ps); ps += dppf<0x141>(ps);
        if (apart == 0) sKn[at] = ps; }
      unpack8(pre[1], f);
      if (ahi == 0) { *(f32x4*)(sV + o) = (f32x4){f[0], f[1], f[2], f[3]}; *(f32x4*)(sV + o + 4) = (f32x4){f[4], f[5], f[6], f[7]}; }
      else { float g[8];
#pragma unroll
        for (int e = 0; e < 8; ++e) g[e] = 1.f - 2.f * frcp(__expf(2.f * f[e]) + 1.f);
        *(u32x4*)(sWT + at * LDT + apart * 8) = pack8(g); }
      if (ahi == 0) *(u32x4*)(sAL + at * LDT + apart * 8) = pre[2];
    }
    __syncthreads();
    {
      f32x4 aw = {0.f, 0.f, 0.f, 0.f}, aa = {0.f, 0.f, 0.f, 0.f};
#pragma unroll
      for (int ks = 0; ks < 2; ++ks) { const bf16x8 fw = *(const bf16x8*)(sWT + fr * LDT + ks * 32 + fq * 8); const bf16x8 fa = *(const bf16x8*)(sAL + fr * LDT + ks * 32 + fq * 8);
        aw = MFMA16(fw, bw[ks], aw); aa = MFMA16(fa, ba[ks], aa); }
      const float kkc = sKK[cc];
#pragma unroll
      for (int j = 0; j < 4; ++j) { const int t = fq * 4 + j, o = t * 64 + cc;
        const float dec = __expf(-0.6065306597f * fsig(w0c + aw[j]));
        const float a = fsig(a0c + aa[j]);
        const float kv = sK[o];
        const float kkv = kv * kkc * __builtin_amdgcn_rsqf(fmaxf(sKn[t], 1e-24f));
        sW[o] = dec; sKD[o] = kv * (1.f + (a - 1.f) * kac); sB[o] = kkv * a; sNK[o] = -kkv; }
    }
    __syncthreads();
    { const int cn = ci + 1 < nch ? ci + 1 : ci; const int nt0 = (d ? nch - 1 - cn : cn) * 16;
#pragma unroll
      for (int i = 0; i < 3; ++i) pre[i] = *(const u32x4*)(zr + (size_t)(row0 + nt0) * NZR + coff[i]); }
#pragma unroll 8
    for (int si = 0; si < 16; ++si) {
      const int t = d ? 15 - si : si, o = t * 64 + kq * 4;
      const f32x4 an4 = *(const f32x4*)(sNK + o), w4 = *(const f32x4*)(sW + o), b4 = *(const f32x4*)(sB + o), kd4 = *(const f32x4*)(sKD + o), r4 = *(const f32x4*)(sR + o);
      const f32x2 v2 = *(const f32x2*)(sV + t * 64 + rbase);
      const f32x2 an[2] = {{an4[0], an4[1]}, {an4[2], an4[3]}}, wv[2] = {{w4[0], w4[1]}, {w4[2], w4[3]}}, bv[2] = {{b4[0], b4[1]}, {b4[2], b4[3]}}, kd[2] = {{kd4[0], kd4[1]}, {kd4[2], kd4[3]}}, rv[2] = {{r4[0], r4[1]}, {r4[2], r4[3]}};
      float sa[2];
#pragma unroll
      for (int r = 0; r < 2; ++r) { const f32x2 t2 = S[r][0] * an[0] + S[r][1] * an[1]; sa[r] = row16_sum(t2.x + t2.y); }
      f32x2 yv;
#pragma unroll
      for (int r = 0; r < 2; ++r) { const f32x2 sav = {sa[r], sa[r]}, vvv = {v2[r], v2[r]};
        S[r][0] = S[r][0] * wv[0] + (sav * bv[0] + vvv * kd[0]); S[r][1] = S[r][1] * wv[1] + (sav * bv[1] + vvv * kd[1]);
        const f32x2 y2 = S[r][0] * rv[0] + S[r][1] * rv[1]; float yp = y2.x + y2.y; yp += dppf<0xB1>(yp); yp += dppf<0x4E>(yp); yv[r] = yp; }
      if ((kq & 3) == 0) { sY[((t * 32 + rg * 2) * 4) + (kq >> 2)] = yv[0]; sY[((t * 32 + rg * 2 + 1) * 4) + (kq >> 2)] = yv[1]; }
    }
    __syncthreads();
    { const int t = tid >> 4, lr = (tid & 15) * 2; const f32x4 p0 = *(const f32x4*)(sY + (t * 32 + lr) * 4), p1 = *(const f32x4*)(sY + (t * 32 + lr + 1) * 4);
      *(f32x2*)(yout + (size_t)(row0 + t0 + t) * 512 + h * 64 + half * 32 + lr) = (f32x2){p0[0] + p0[1] + p0[2] + p0[3], p1[0] + p1[1] + p1[2] + p1[3]}; }
  }
  __builtin_amdgcn_s_setprio(0);
  if (seq < 32) { float* so = p.out + O_RW + (((((size_t)seq * 2 + l) * 2 + d) * 8 + h) * 64 + rbase) * 64 + kq * 4;
#pragma unroll
    for (int r = 0; r < 2; ++r) *(f32x4*)(so + r * 64) = (f32x4){S[r][0].x, S[r][0].y, S[r][1].x, S[r][1].y}; }
}

DI void qk_scores(const bf16_t* sK, const bf16x8 (&qf)[2], f32x4 (&sacc)[4], int fr, int fq) {
#pragma unroll
  for (int nt = 0; nt < 4; ++nt) { sacc[nt] = (f32x4){0.f, 0.f, 0.f, 0.f};
#pragma unroll
    for (int ks = 0; ks < 2; ++ks) { const bf16x8 kf = *(const bf16x8*)(sK + (nt * 16 + fr) * LDT + ks * 32 + fq * 8); sacc[nt] = MFMA16(kf, qf[ks], sacc[nt]); } }
}
DI void pv_accum(const bf16_t* sVt, const f32x4 (&pacc)[4], f32x4 (&o)[4], int fr, int fq) {
#pragma unroll
  for (int s = 0; s < 2; ++s) {
    bf16x8 pf; { const unsigned a = pack2(pacc[2 * s][0], pacc[2 * s][1]), b = pack2(pacc[2 * s][2], pacc[2 * s][3]), c = pack2(pacc[2 * s + 1][0], pacc[2 * s + 1][1]), dd = pack2(pacc[2 * s + 1][2], pacc[2 * s + 1][3]);
      const u32x4 u = (u32x4){a, b, c, dd}; pf = __builtin_bit_cast(bf16x8, u); }
#pragma unroll
    for (int dt = 0; dt < 4; ++dt) { const u32x2 lo = *(const u32x2*)(sVt + (dt * 16 + fr) * LDT + 32 * s + 4 * fq), hi = *(const u32x2*)(sVt + (dt * 16 + fr) * LDT + 32 * s + 16 + 4 * fq);
      const u32x4 u = (u32x4){lo[0], lo[1], hi[0], hi[1]}; const bf16x8 vf = __builtin_bit_cast(bf16x8, u); o[dt] = MFMA16(vf, pf, o[dt]); }
  }
}
DI void put_kv(bf16_t* sK, bf16_t* sVt, int key, int part, const float (&kf)[8], int vkey, int vpart, const float (&vf)[8]) {
  *(u32x4*)(sK + key * LDT + part * 8) = pack8(kf);
#pragma unroll
  for (int e = 0; e < 8; ++e) sVt[(vpart * 8 + e) * LDT + vkey] = f2bf(vf[e]);
}
DI void softmax_tile(f32x4 (&sacc)[4], f32x4 (&o)[4], float& mrun, float& lrun) {
  float mx = sacc[0][0];
#pragma unroll
  for (int nt = 0; nt < 4; ++nt)
#pragma unroll
    for (int j = 0; j < 4; ++j) mx = fmaxf(mx, sacc[nt][j]);
  mx = fmaxf(mx, shfl_x(mx, 16)); mx = fmaxf(mx, shfl_x(mx, 32));
  const float mnew = fmaxf(mrun, mx), alpha = __builtin_amdgcn_exp2f(mrun - mnew); mrun = mnew;
  float ls = 0.f;
#pragma unroll
  for (int nt = 0; nt < 4; ++nt)
#pragma unroll
    for (int j = 0; j < 4; ++j) { const float pv = __builtin_amdgcn_exp2f(sacc[nt][j] - mnew); sacc[nt][j] = pv; ls += pv; }
  lrun = lrun * alpha + ls;
#pragma unroll
  for (int dt = 0; dt < 4; ++dt) o[dt] *= alpha;
}
constexpr float LOG2E = 1.4426950408889634f;

__device__ void dense_task(const P& p, int b, int h, int qb, char* smem) {
  bf16_t* sK = (bf16_t*)smem; bf16_t* sVt = sK + 64 * LDT;
  const int tid = tidx(), lane = tid & 63, wave = tid >> 6, fr = lane & 15, fq = lane >> 4;
  const bf16_t* zn = (const bf16_t*)(p.ws + WS_ZN); bf16_t* ona = (bf16_t*)(p.ws + WS_ONA);
  const int qrow = b * 256 + qb * 64 + wave * 16 + fr;
  bf16x8 qf[2];
#pragma unroll
  for (int ks = 0; ks < 2; ++ks) qf[ks] = *(const bf16x8*)(zn + (size_t)qrow * NZN + h * 64 + ks * 32 + fq * 8);
  f32x4 o[4]; for (int dt = 0; dt < 4; ++dt) o[dt] = (f32x4){0.f, 0.f, 0.f, 0.f};
  float mrun = -1e30f, lrun = 0.f;
  u32x4 pk[2], pv[2];
#pragma unroll
  for (int i = 0; i < 2; ++i) { const int c = tid + 256 * i, key = c >> 3, part = c & 7, vkey = c & 63, vpart = c >> 6; pk[i] = *(const u32x4*)(zn + (size_t)(b * 256 + key) * NZN + h * 64 + part * 8 + 512); pv[i] = *(const u32x4*)(zn + (size_t)(b * 256 + vkey) * NZN + h * 64 + vpart * 8 + 1024); }
  for (int kt = 0; kt < 4; ++kt) {
    __syncthreads();
#pragma unroll
    for (int i = 0; i < 2; ++i) { const int c = tid + 256 * i, key = c >> 3, part = c & 7, vkey = c & 63, vpart = c >> 6; float vf[8]; unpack8(pv[i], vf);
      *(u32x4*)(sK + key * LDT + part * 8) = pk[i];
#pragma unroll
      for (int e = 0; e < 8; ++e) sVt[(vpart * 8 + e) * LDT + vkey] = f2bf(vf[e]); }
    __syncthreads();
    { const int kn = kt < 3 ? kt + 1 : 3;
#pragma unroll
      for (int i = 0; i < 2; ++i) { const int c = tid + 256 * i, key = c >> 3, part = c & 7, vkey = c & 63, vpart = c >> 6; pk[i] = *(const u32x4*)(zn + (size_t)(b * 256 + kn * 64 + key) * NZN + h * 64 + part * 8 + 512); pv[i] = *(const u32x4*)(zn + (size_t)(b * 256 + kn * 64 + vkey) * NZN + h * 64 + vpart * 8 + 1024); } }
    f32x4 sacc[4]; qk_scores(sK, qf, sacc, fr, fq);
#pragma unroll
    for (int nt = 0; nt < 4; ++nt) sacc[nt] *= (0.125f * LOG2E);
    softmax_tile(sacc, o, mrun, lrun);
    pv_accum(sVt, sacc, o, fr, fq);
  }
  lrun += shfl_x(lrun, 16); lrun += shfl_x(lrun, 32); const float inv = 1.f / lrun;
#pragma unroll
  for (int dt = 0; dt < 4; ++dt) { u32x2 ov; ov.x = pack2(o[dt][0] * inv, o[dt][1] * inv); ov.y = pack2(o[dt][2] * inv, o[dt][3] * inv); *(u32x2*)(ona + (size_t)qrow * LDO + h * 64 + dt * 16 + fq * 4) = ov; }
}

__device__ void na_task(const P& p, int l, int b, int h, int r, char* smem) {
  bf16_t* sK = (bf16_t*)smem; bf16_t* sVt = sK + 64 * LDT; float* sRpb = (float*)(sVt + 64 * LDT);
  const int tid = tidx(), lane = tid & 63, wave = tid >> 6, fr = lane & 15, fq = lane >> 4;
  const bf16_t* zn = (const bf16_t*)(p.ws + WS_ZN); bf16_t* ona = (bf16_t*)(p.ws + WS_ONA);
  const int base = MC + b * 1024, qcol = wave * 16 + fr, qrow = base + r * 64 + qcol;
  int rs = r - 4; rs = rs < 0 ? 0 : (rs > 8 ? 8 : rs);
  int cs = qcol - 8; cs = cs < 0 ? 0 : (cs > 48 ? 48 : cs);
  __syncthreads();
  for (int e = tid; e < 465; e += NT) sRpb[e] = p.na_rpb[((size_t)l * 8 + h) * 465 + e] * LOG2E;
  bf16x8 qf[2];
#pragma unroll
  for (int ks = 0; ks < 2; ++ks) qf[ks] = *(const bf16x8*)(zn + (size_t)qrow * NZN + h * 64 + ks * 32 + fq * 8);
  f32x4 o[4]; for (int dt = 0; dt < 4; ++dt) o[dt] = (f32x4){0.f, 0.f, 0.f, 0.f};
  float mrun = -1e30f, lrun = 0.f;
  u32x4 pre[8];
#define NA_ISSUE(KT) do { const int kt_ = (KT); \
    if (kt_ < 8) { _Pragma("unroll") for (int i = 0; i < 2; ++i) { const int c = tid + 256 * i, key = c >> 3, part = c & 7, vkey = c & 63, vpart = c >> 6; \
        pre[4 * i] = *(const u32x4*)(zn + (size_t)(base + (rs + kt_) * 64 + key) * NZN + h * 64 + part * 8 + 512); pre[4 * i + 1] = *(const u32x4*)(zn + (size_t)(base + (rs + kt_) * 64 + vkey) * NZN + h * 64 + vpart * 8 + 1024); } } \
    else { _Pragma("unroll") for (int i = 0; i < 2; ++i) { const int c = tid + 256 * i, key = c >> 3, part = c & 7, vkey = c & 63, vpart = c >> 6; const size_t cb_ = (((size_t)b * 2 + l) * 8 + h) * 256 + (kt_ - 8) * 64; const size_t co = (cb_ + key) * 64 + part * 8, cv = (cb_ + vkey) * 64 + vpart * 8; \
        pre[4 * i] = *(const u32x4*)(p.cache_k + co); pre[4 * i + 1] = *(const u32x4*)(p.cache_k + co + 4); pre[4 * i + 2] = *(const u32x4*)(p.cache_v + cv); pre[4 * i + 3] = *(const u32x4*)(p.cache_v + cv + 4); } } } while (0)
  NA_ISSUE(0);
  for (int kt = 0; kt < 12; ++kt) {
    __syncthreads();
    if (kt < 8) {
#pragma unroll
      for (int i = 0; i < 2; ++i) { const int c = tid + 256 * i, key = c >> 3, part = c & 7, vkey = c & 63, vpart = c >> 6; float vf[8]; unpack8(pre[4 * i + 1], vf);
        *(u32x4*)(sK + key * LDT + part * 8) = pre[4 * i];
#pragma unroll
        for (int e = 0; e < 8; ++e) sVt[(vpart * 8 + e) * LDT + vkey] = f2bf(vf[e]); }
    } else {
#pragma unroll
      for (int i = 0; i < 2; ++i) { const int c = tid + 256 * i, key = c >> 3, part = c & 7, vkey = c & 63, vpart = c >> 6;
        const f32x4 k0 = __builtin_bit_cast(f32x4, pre[4 * i]), k1 = __builtin_bit_cast(f32x4, pre[4 * i + 1]), v0 = __builtin_bit_cast(f32x4, pre[4 * i + 2]), v1 = __builtin_bit_cast(f32x4, pre[4 * i + 3]);
        const float kf[8] = {k0[0], k0[1], k0[2], k0[3], k1[0], k1[1], k1[2], k1[3]}; const float vf[8] = {v0[0], v0[1], v0[2], v0[3], v1[0], v1[1], v1[2], v1[3]};
        put_kv(sK, sVt, key, part, kf, vkey, vpart, vf); }
    }
    __syncthreads();
    NA_ISSUE(kt < 11 ? kt + 1 : 11);
    f32x4 sacc[4]; qk_scores(sK, qf, sacc, fr, fq);
    if (kt < 8) { const int dr = rs + kt - r + 7;
#pragma unroll
      for (int nt = 0; nt < 4; ++nt)
#pragma unroll
        for (int j = 0; j < 4; ++j) { const int kc = nt * 16 + fq * 4 + j; const bool valid = kc >= cs && kc < cs + 16; int dc = kc - qcol; dc = dc < -15 ? -15 : (dc > 15 ? 15 : dc);
          sacc[nt][j] = valid ? sacc[nt][j] * (0.125f * LOG2E) + sRpb[dr * 31 + dc + 15] : -1e30f; }
    } else {
#pragma unroll
      for (int nt = 0; nt < 4; ++nt) sacc[nt] *= (0.125f * LOG2E);
    }
    softmax_tile(sacc, o, mrun, lrun);
    pv_accum(sVt, sacc, o, fr, fq);
  }
#undef NA_ISSUE
  lrun += shfl_x(lrun, 16); lrun += shfl_x(lrun, 32); const float inv = 1.f / lrun;
#pragma unroll
  for (int dt = 0; dt < 4; ++dt) { u32x2 ov; ov.x = pack2(o[dt][0] * inv, o[dt][1] * inv); ov.y = pack2(o[dt][2] * inv, o[dt][3] * inv); *(u32x2*)(ona + (size_t)qrow * LDO + h * 64 + dt * 16 + fq * 4) = ov; }
}

DI void rope8(const float (&own)[8], const float (&par)[8], int part, int n, float (&out)[8]) {
  const float pos = (float)((part >> 2) ? (n & 63) : (n >> 6));
  const bool isx2 = (part & 3) >= 2;
#pragma unroll
  for (int e = 0; e < 8; ++e) { const int i = (part & 1) * 8 + e; const float ang = pos * __builtin_amdgcn_exp2f(-(float)i * 0.830482023721841f); const float sn = __sinf(ang), cs = __cosf(ang);
    out[e] = isx2 ? par[e] * sn + own[e] * cs : own[e] * cs - par[e] * sn; }
}

__device__ void ret_task(const P& p, int l, int seq, int h, int qb, char* smem) {
  bf16_t* sK = (bf16_t*)smem; bf16_t* sVt = sK + 64 * LDT; bf16_t* sQ = sVt + 64 * LDT;
  const int tid = tidx(), lane = tid & 63, wave = tid >> 6, fr = lane & 15, fq = lane >> 4;
  const bf16_t* zt = (const bf16_t*)(p.ws + WS_ZT); bf16_t* oret = (bf16_t*)(p.ws + WS_ORET);
  const bool lat = seq >= 32;
  const int row0 = lat ? MC + (seq - 32) * 1024 : seq * 256, T = lat ? 1024 : 256, nkt = T >> 6;
  const float xf = p.ret_decay[(l * 2 + 0) * 8 + h], xb = p.ret_decay[(l * 2 + 1) * 8 + h];
  const float lgf = -log1pf(__expf(-xf)) * LOG2E, lgb = -log1pf(__expf(-xb)) * LOG2E;
  __syncthreads();
#pragma unroll
  for (int i = 0; i < 2; ++i) { const int c = tid + 256 * i, qi = c >> 3, part = c & 7; const int n = qb * 64 + qi; const size_t ro = (size_t)(row0 + n) * LZT + h * 64;
    const u32x4 own = *(const u32x4*)(zt + ro + part * 8);
    if (lat) { const u32x4 par = *(const u32x4*)(zt + ro + (part ^ 2) * 8); float fo[8], fp[8], out[8]; unpack8(own, fo); unpack8(par, fp); rope8(fo, fp, part, n, out); *(u32x4*)(sQ + qi * LDT + part * 8) = pack8(out); }
    else *(u32x4*)(sQ + qi * LDT + part * 8) = own; }
  __syncthreads();
  const int qi = wave * 16 + fr, nq = qb * 64 + qi;
  bf16x8 qf[2];
#pragma unroll
  for (int ks = 0; ks < 2; ++ks) qf[ks] = *(const bf16x8*)(sQ + qi * LDT + ks * 32 + fq * 8);
  f32x4 o[4]; for (int dt = 0; dt < 4; ++dt) o[dt] = (f32x4){0.f, 0.f, 0.f, 0.f};
  u32x4 rk[2], rp[2], rv[2];
#define RET_ISSUE(KT) do { _Pragma("unroll") for (int i = 0; i < 2; ++i) { const int c = tid + 256 * i, key = c >> 3, part = c & 7, vkey = c & 63, vpart = c >> 6; const size_t ro = (size_t)(row0 + (KT) * 64 + key) * LZT + h * 64; \
    rk[i] = *(const u32x4*)(zt + ro + 512 + part * 8); rp[i] = *(const u32x4*)(zt + ro + 512 + (part ^ 2) * 8); rv[i] = *(const u32x4*)(zt + (size_t)(row0 + (KT) * 64 + vkey) * LZT + h * 64 + 1024 + vpart * 8); } } while (0)
  RET_ISSUE(0);
  for (int kt = 0; kt < nkt; ++kt) {
    __syncthreads();
#pragma unroll
    for (int i = 0; i < 2; ++i) { const int c = tid + 256 * i, key = c >> 3, part = c & 7, vkey = c & 63, vpart = c >> 6; const int n = kt * 64 + key;
      float kf[8], vf[8]; unpack8(rk[i], kf); unpack8(rv[i], vf);
      if (lat) { float fp[8], out[8]; unpack8(rp[i], fp); rope8(kf, fp, part, n, out);
#pragma unroll
        for (int e = 0; e < 8; ++e) kf[e] = out[e]; }
#pragma unroll
      for (int e = 0; e < 8; ++e) kf[e] *= 0.125f;
      put_kv(sK, sVt, key, part, kf, vkey, vpart, vf); }
    __syncthreads();
    RET_ISSUE(kt + 1 < nkt ? kt + 1 : kt);
    f32x4 sacc[4]; qk_scores(sK, qf, sacc, fr, fq);
#pragma unroll
    for (int nt = 0; nt < 4; ++nt)
#pragma unroll
      for (int j = 0; j < 4; ++j) { const int mk = kt * 64 + nt * 16 + fq * 4 + j; const int df = nq - mk;
        const float ex = __builtin_amdgcn_exp2f((df > 0 ? lgf : -lgb) * (float)df); sacc[nt][j] *= (df == 0 ? 2.f : ex); }
    pv_accum(sVt, sacc, o, fr, fq);
  }
#undef RET_ISSUE
  if (lat) {
    for (int dir = 0; dir < 2; ++dir) {
      __syncthreads();
      const float* s0 = p.state_ret + ((((size_t)(seq - 32) * 2 + l) * 2 + dir) * 8 + h) * 4096;
#pragma unroll
      for (int i = 0; i < 2; ++i) { const int c = tid + 256 * i, dk = c & 63, part = c >> 6; const float4 a = *(const float4*)(s0 + dk * 64 + part * 8), bq = *(const float4*)(s0 + dk * 64 + part * 8 + 4);
        const float vf[8] = {a.x, a.y, a.z, a.w, bq.x, bq.y, bq.z, bq.w};
#pragma unroll
        for (int e = 0; e < 8; ++e) sVt[(part * 8 + e) * LDT + dk] = f2bf(vf[e]); }
      __syncthreads();
      const float xi = dir == 0 ? exp2f(lgf * (float)(nq + 1)) : exp2f(lgb * (float)(T - nq));
      f32x4 pacc[4];
#pragma unroll
      for (int s = 0; s < 2; ++s)
#pragma unroll
        for (int hh = 0; hh < 2; ++hh)
#pragma unroll
          for (int j = 0; j < 4; ++j) pacc[2 * s + hh][j] = xi * bf2f(sQ[qi * LDT + 32 * s + 16 * hh + 4 * fq + j]);
      pv_accum(sVt, pacc, o, fr, fq);
    }
  }
  float s1 = 0.f;
#pragma unroll
  for (int dt = 0; dt < 4; ++dt)
#pragma unroll
    for (int j = 0; j < 4; ++j) s1 += o[dt][j];
  s1 += shfl_x(s1, 16); s1 += shfl_x(s1, 32); const float mu = s1 * (1.f / 64.f);
  float s2 = 0.f;
#pragma unroll
  for (int dt = 0; dt < 4; ++dt)
#pragma unroll
    for (int j = 0; j < 4; ++j) { const float dlt = o[dt][j] - mu; s2 += dlt * dlt; }
  s2 += shfl_x(s2, 16); s2 += shfl_x(s2, 32); const float rstd = rsqrtf(s2 * (1.f / 64.f) + 1e-5f);
  const size_t qrow = (size_t)(row0 + nq);
#pragma unroll
  for (int dt = 0; dt < 4; ++dt) { const int dv = h * 64 + dt * 16 + fq * 4; const u32x2 gr = *(const u32x2*)(zt + qrow * LZT + 1536 + dv); const float4 gn = *(const float4*)(p.ret_gn + l * 512 + dv);
    const float g0 = bflo(gr.x), g1 = bfhi(gr.x), g2 = bflo(gr.y), g3 = bfhi(gr.y);
    u32x2 ov; ov.x = pack2((o[dt][0] - mu) * rstd * gn.x * g0 * sigmoidf_(g0), (o[dt][1] - mu) * rstd * gn.y * g1 * sigmoidf_(g1));
    ov.y = pack2((o[dt][2] - mu) * rstd * gn.z * g2 * sigmoidf_(g2), (o[dt][3] - mu) * rstd * gn.w * g3 * sigmoidf_(g3));
    *(u32x2*)(oret + qrow * LDO + dv) = ov; }
}

__device__ void retstate_task(const P& p, int l, int b, int h, char* smem) {
  float* sKf = (float*)smem; float* sKb = sKf + 64 * 64; float* sV = sKb + 64 * 64;
  const int tid = tidx(), dk = tid >> 2, dq = tid & 3;
  const bf16_t* zt = (const bf16_t*)(p.ws + WS_ZT);
  const float xf = p.ret_decay[(l * 2 + 0) * 8 + h], xb = p.ret_decay[(l * 2 + 1) * 8 + h];
  const float lgf = -log1pf(__expf(-xf)) * LOG2E, lgb = -log1pf(__expf(-xb)) * LOG2E;
  float af[16], ab[16];
#pragma unroll
  for (int i = 0; i < 16; ++i) { af[i] = 0.f; ab[i] = 0.f; }
  for (int kt = 0; kt < 4; ++kt) {
    __syncthreads();
#pragma unroll
    for (int i = 0; i < 2; ++i) { const int c = tid + 256 * i, key = c >> 3, part = c & 7, m = kt * 64 + key; const size_t ro = (size_t)(b * 256 + m) * LZT + h * 64 + part * 8;
      float kf[8], vf[8]; unpack8(*(const u32x4*)(zt + ro + 512), kf); unpack8(*(const u32x4*)(zt + ro + 1024), vf);
      const float wf = 0.125f * exp2f(lgf * (float)(255 - m)), wb = 0.125f * exp2f(lgb * (float)m);
#pragma unroll
      for (int e = 0; e < 8; ++e) { sKf[key * 64 + part * 8 + e] = kf[e] * wf; sKb[key * 64 + part * 8 + e] = kf[e] * wb; sV[key * 64 + part * 8 + e] = vf[e]; } }
    __syncthreads();
    for (int m = 0; m < 64; ++m) { const float kf = sKf[m * 64 + dk], kb = sKb[m * 64 + dk];
#pragma unroll
      for (int i = 0; i < 4; ++i) { const f32x4 vv = *(const f32x4*)(sV + m * 64 + dq * 16 + i * 4);
#pragma unroll
        for (int j = 0; j < 4; ++j) { af[i * 4 + j] += kf * vv[j]; ab[i * 4 + j] += kb * vv[j]; } } }
  }
  float* of = p.out + O_RT + ((((size_t)b * 2 + l) * 2 + 0) * 8 + h) * 4096 + dk * 64 + dq * 16; float* ob = of + 8 * 4096;
#pragma unroll
  for (int i = 0; i < 16; ++i) { of[i] = af[i]; ob[i] = ab[i]; }
}

constexpr int Q_SCAN_L = 64, Q_SCAN_C = 512, Q_RET_L = 256, Q_NA = 256, Q_DENSE = 512, Q_RET_C = 512, Q_RST = 128;
template <int QMASK> __device__ void phase_mixers(const P& p, int l, char* smem_, int rep = 0) {
  __shared__ int s_task;
  int* ctr = (int*)(p.ws + WS_CTRL) + 64 * (l + 1) + 4 * rep;
  const int vb = vhalf(); char* smem = smem_ + vb * VSMEM;
  if (QMASK & 1) for (;;) {
    __syncthreads();
    if (ptid() == 0) s_task = atomicAdd(ctr, 1);
    __syncthreads();
    const int tk = s_task;
    if (tk >= Q_SCAN_L + Q_SCAN_C) break;
    const bool lat = tk < Q_SCAN_L; const int t2 = lat ? tk : tk - Q_SCAN_L;
    scan_task(p, l, (lat ? 32 : 0) + (t2 >> 4), (t2 >> 1) & 7, t2 & 1, vb, smem);
  }
  if (QMASK & 2) for (;;) {
    __syncthreads();
    if (ptid() == 0) s_task = atomicAdd(ctr + 16, 1);
    __syncthreads();
    const int tk = s_task;
    if (tk >= Q_RET_L + Q_RET_C) break;
    if (tk < Q_RET_L) ret_task(p, l, 32 + (tk >> 6), (tk >> 3) & 7, (tk & 7) * 2 + vb, smem);
    else { const int t2 = tk - Q_RET_L; ret_task(p, l, t2 >> 4, (t2 >> 1) & 7, (t2 & 1) * 2 + vb, smem); }
  }
  if (QMASK & 4) for (;;) {
    __syncthreads();
    if (ptid() == 0) s_task = atomicAdd(ctr + 32, 1);
    __syncthreads();
    int tk = s_task;
    if (tk >= Q_NA + Q_DENSE + Q_RST) break;
    if (tk < Q_NA) { na_task(p, l, tk >> 6, (tk >> 3) & 7, (tk & 7) * 2 + vb, smem); continue; } tk -= Q_NA;
    if (tk < Q_DENSE) { dense_task(p, tk >> 4, (tk >> 1) & 7, (tk & 1) * 2 + vb, smem); continue; } tk -= Q_DENSE;
    retstate_task(p, l, tk >> 2, (tk & 3) * 2 + vb, smem);
  }
}

__device__ void phase_rwkv_post(const P& p, int l, char* smem) {
  const bf16_t* zr = (const bf16_t*)(p.ws + WS_ZR); const float* yf = (const float*)(p.ws + WS_Y); const float* yb = yf + (size_t)MT * 512; bf16_t* oa = (bf16_t*)(p.ws + WS_OA);
  const bf16_t* Gt = (const bf16_t*)(p.ws + WS_WG);
  const int tid = ptid(), lane = tid & 63, wave = tid >> 6, wr = wave >> 2, wc = wave & 3, fr = lane & 15, fq = lane >> 4;
  TileIter ti; int mt, nt; ti.init(96, 2);
  while (ti.next(mt, nt)) {
    const int row0 = mt * 128, n0 = nt * 256;
    f32x4 acc[4][4]; zero_acc<4, 4>(acc);
    TileSrc s{zr + 1664, NZR, row0, Gt, LDG, n0, n0 + 128, 128}; { Gemm<4, 4, 1> gm; gm.begin(s); gm.run(acc, smem); }
    const int cb = n0 + wc * 64 + fq * 4;
#pragma unroll
    for (int m = 0; m < 4; ++m) { const size_t row = (size_t)(row0 + wr * 64 + m * 16 + fr);
      f32x4 y[4]; float s1 = 0.f, rk = 0.f; f32x4 vv[4];
#pragma unroll
      for (int n = 0; n < 4; ++n) { const int c = cb + n * 16; y[n] = *(const f32x4*)(yf + row * 512 + c) + *(const f32x4*)(yb + row * 512 + c); s1 += y[n][0] + y[n][1] + y[n][2] + y[n][3];
        const u32x2 rr = *(const u32x2*)(zr + row * NZR + c), kk = *(const u32x2*)(zr + row * NZR + 512 + c), v2 = *(const u32x2*)(zr + row * NZR + 1024 + c); const f32x4 rkw = *(const f32x4*)(p.rwkv_r_k + l * 512 + c);
        rk += bflo(rr.x) * bflo(kk.x) * rkw[0] + bfhi(rr.x) * bfhi(kk.x) * rkw[1] + bflo(rr.y) * bflo(kk.y) * rkw[2] + bfhi(rr.y) * bfhi(kk.y) * rkw[3];
        vv[n] = (f32x4){bflo(v2.x), bfhi(v2.x), bflo(v2.y), bfhi(v2.y)}; }
      s1 += shfl_x(s1, 16); s1 += shfl_x(s1, 32); rk += shfl_x(rk, 16); rk += shfl_x(rk, 32);
      const float mu = s1 * (1.f / 64.f); float s2 = 0.f;
#pragma unroll
      for (int n = 0; n < 4; ++n)
#pragma unroll
        for (int j = 0; j < 4; ++j) { const float dl = y[n][j] - mu; s2 += dl * dl; }
      s2 += shfl_x(s2, 16); s2 += shfl_x(s2, 32); const float rstd = rsqrtf(s2 * (1.f / 64.f) + 64e-5f);
#pragma unroll
      for (int n = 0; n < 4; ++n) { const int c = cb + n * 16; const f32x4 lg = *(const f32x4*)(p.rwkv_ln_g + l * 512 + c), lb = *(const f32x4*)(p.rwkv_ln_b + l * 512 + c);
        float o[4];
#pragma unroll
        for (int j = 0; j < 4; ++j) o[j] = ((y[n][j] - mu) * rstd * lg[j] + lb[j] + rk * vv[n][j]) * acc[m][n][j];
        u32x2 ov; ov.x = pack2(o[0], o[1]); ov.y = pack2(o[2], o[3]); *(u32x2*)(oa + row * LDO + c) = ov; }
    }
  }
}

DI void convert_layer_a(const P& p, int l, char* smem) {
  convert_T(p.w_in + (size_t)l * D * INC, D, INC, (bf16_t*)(p.ws + WS_WIN), LDH, smem);
  convert_T(p.w_o_rwkv + (size_t)l * 512 * D, 512, D, (bf16_t*)(p.ws + WS_WO3), LDO, smem);
  convert_T(p.w_o_na + (size_t)l * 512 * D, 512, D, (bf16_t*)(p.ws + WS_WO3) + (size_t)1024 * LDO, LDO, smem);
  convert_T(p.w_o_ret + (size_t)l * 512 * D, 512, D, (bf16_t*)(p.ws + WS_WO3) + (size_t)2 * 1024 * LDO, LDO, smem);
  convert_T(p.w_out + (size_t)l * D * D, D, D, (bf16_t*)(p.ws + WS_WOUT), LDH, smem);
  convert_T(p.rwkv_g_up + (size_t)l * 128 * 512, 128, 512, (bf16_t*)(p.ws + WS_WG), LDG, smem);
}
DI void convert_layer_b(const P& p, int l, char* smem) {
  convert_T(p.ffn_up + (size_t)l * D * 2 * FF, D, 2 * FF, (bf16_t*)(p.ws + WS_WUP), LDH, smem);
  convert_T(p.ffn_down + (size_t)l * FF * D, FF, D, (bf16_t*)(p.ws + WS_WDN), FF, smem);
}

typedef __attribute__((address_space(4))) const P* KP;
DI KP kargs() { KP k = (KP)__builtin_amdgcn_kernarg_segment_ptr(); asm volatile("" : "+s"(k)); return k; }
template <int PH> DI void run_phase(int l, char* smem) {
#if defined(__HIP_DEVICE_COMPILE__)
  const P p = *kargs();
#else
  const P p{};
#endif
  const float* mod = (const float*)(p.ws + WS_MOD);
  float* xbuf = p.out;
  if (PH == 0) { ada_phase(p, smem); convert_layer_a(p, 0, smem); }
  else if (PH == 1) { norm_phase(p, nullptr, nullptr, nullptr, nullptr, 0, nullptr, p.norm_mix_pre, mod, 0, (bf16_t*)(p.ws + WS_H)); }
  else if (PH == 2) phase_win(p, l, smem);
  else if (PH == 4) phase_mixers<7>(p, l, smem);
  else if (PH == 5) phase_rwkv_post(p, l, smem);
  else if (PH == 6) phase_merge(p, smem);
  else if (PH == 7) { phase_gemm_f32((const bf16_t*)(p.ws + WS_MERGED), LDH, D, (const bf16_t*)(p.ws + WS_WOUT), LDH, (float*)(p.ws + WS_U), smem); }
  else if (PH == 8) { convert_layer_b(p, l, smem);
    norm_phase(p, l == 0 ? nullptr : xbuf, (const float*)(p.ws + WS_U), p.norm_mix_post + l * D, mod + (size_t)l * 5 * 6144, 2, xbuf, p.norm_ffn_pre + l * D, mod + (size_t)l * 5 * 6144, 3, (bf16_t*)(p.ws + WS_H)); }
  else if (PH == 9) phase_ffn_up(p, l, smem);
  else if (PH == 11) { phase_gemm_f32((const bf16_t*)(p.ws + WS_HID), FF, FF, (const bf16_t*)(p.ws + WS_WDN), FF, (float*)(p.ws + WS_F), smem); }
  else if (PH == 12) {
    if (l == 0) { norm_phase(p, xbuf, (const float*)(p.ws + WS_F), p.norm_ffn_post, mod, 5, xbuf, p.norm_mix_pre + D, mod + (size_t)5 * 6144, 0, (bf16_t*)(p.ws + WS_H)); convert_layer_a(p, 1, smem); }
    else norm_phase(p, xbuf, (const float*)(p.ws + WS_F), p.norm_ffn_post + D, mod + (size_t)5 * 6144, 5, xbuf, nullptr, nullptr, 0, nullptr);
  }
}

#if MEGA
__global__ void __launch_bounds__(NTP, 1) mega_kernel(P p_) {
  extern __shared__ __attribute__((aligned(16))) char smem[];
  __shared__ u32x4 xb_words;
  cg::grid_group grid = cg::this_grid();
  if (ptid() == 0) xb_words = (u32x4){0u, 0u, 0u, 0u};
  __syncthreads();
#if defined(__HIP_DEVICE_COMPILE__)
  (void)xcd_barrier_post((unsigned*)(p_.ws + WS_BAR), (volatile LAS unsigned*)&xb_words);
#define GSYNC() do { XcdBarrier xb_; xb_.bar = (unsigned*)(kargs()->ws + WS_BAR); xb_.x = xb_xcc_id(); xb_.st = (volatile LAS unsigned*)&xb_words; xcd_barrier(xb_); } while (0)
#else
#define GSYNC() do { } while (0)
#endif
  run_phase<0>(0, smem); grid.sync();
  run_phase<1>(0, smem); GSYNC();
#pragma unroll
  for (int l = 0; l < 2; ++l) {
    run_phase<2>(l, smem); GSYNC();
    if (PROBE_MASK & 1) { run_phase<2>(l, smem); GSYNC(); }
    run_phase<4>(l, smem); GSYNC();
    run_phase<5>(l, smem); GSYNC();
    run_phase<6>(l, smem); GSYNC();
    if (PROBE_MASK & 8) { run_phase<6>(l, smem); GSYNC(); }
    run_phase<7>(l, smem); GSYNC();
    if (PROBE_MASK & 16) { run_phase<7>(l, smem); GSYNC(); }
    run_phase<8>(l, smem); GSYNC();
    run_phase<9>(l, smem); GSYNC();
    if (PROBE_MASK & 32) { run_phase<9>(l, smem); GSYNC(); }
    run_phase<11>(l, smem); GSYNC();
    if (PROBE_MASK & 64) { run_phase<11>(l, smem); GSYNC(); }
    run_phase<12>(l, smem); if (l == 0) GSYNC();
  }
#undef GSYNC
}
#else
template <int PH> __global__ void __launch_bounds__(NTP, 1) phase_kernel(P p, int l) {
  extern __shared__ __attribute__((aligned(16))) char smem[];
  run_phase<PH>(l, smem);
}
#endif

extern "C" void kernel_launch(void* const* d_in, const int* in_sizes, int n_in, void* d_out, int out_size, void* d_ws, size_t ws_size, hipStream_t stream) {
  if (ws_size < WS_END || n_in < 36) { fprintf(stderr, "workspace too small: %zu < %zu\n", ws_size, (size_t)WS_END); return; }
  P p{};
  const float** pp = (const float**)&p;
  for (int i = 0; i < 36; ++i) pp[i] = (const float*)d_in[i];
  p.out = (float*)d_out; p.ws = (char*)d_ws;
  hipMemsetAsync(d_ws, 0, WS_WIN, stream);
#if MEGA
  static int grid_blocks = 0;
  if (!grid_blocks) {
    int dev = 0, cus = 0, per_cu = 0; hipGetDevice(&dev);
    hipDeviceGetAttribute(&cus, hipDeviceAttributeMultiprocessorCount, dev);
    hipFuncSetAttribute((const void*)mega_kernel, hipFuncAttributeMaxDynamicSharedMemorySize, SMEM_BYTES);
    hipOccupancyMaxActiveBlocksPerMultiprocessor(&per_cu, mega_kernel, NTP, SMEM_BYTES);
    if (per_cu > 1) per_cu = 1;
    grid_blocks = cus * per_cu;
  }
  void* args[] = {&p};
  hipError_t e = hipLaunchCooperativeKernel((void*)mega_kernel, dim3(grid_blocks), dim3(NTP), args, SMEM_BYTES, stream);
  if (e != hipSuccess) fprintf(stderr, "cooperative launch failed: %s (grid %d)\n", hipGetErrorString(e), grid_blocks);
#else
  const int G = 512;
#define LAUNCH(PH, L) do { hipFuncSetAttribute((const void*)phase_kernel<PH>, hipFuncAttributeMaxDynamicSharedMemorySize, SMEM_BYTES); phase_kernel<PH><<<G, NT, SMEM_BYTES, stream>>>(p, L); } while (0)
  LAUNCH(0, 0); LAUNCH(1, 0);
  for (int l = 0; l < 2; ++l) { LAUNCH(2, l); LAUNCH(4, l); LAUNCH(5, l); LAUNCH(6, l); LAUNCH(7, l); LAUNCH(8, l); LAUNCH(9, l); LAUNCH(11, l); LAUNCH(12, l); }
#endif
}
```

```cpp
#include <hip/hip_runtime.h>
#include <hip/hip_cooperative_groups.h>
#include <cstdio>
namespace cg = cooperative_groups;

#ifndef MEGA
#define MEGA 1
#endif
#define PROBE_MASK 0

typedef unsigned short bf16_t;
typedef short bf16x8 __attribute__((ext_vector_type(8)));
typedef short bf16x4 __attribute__((ext_vector_type(4)));
typedef float f32x4 __attribute__((ext_vector_type(4)));
typedef float f32x2 __attribute__((ext_vector_type(2)));
typedef unsigned u32x4 __attribute__((ext_vector_type(4)));
typedef unsigned u32x2 __attribute__((ext_vector_type(2)));
#define DI __device__ __forceinline__
#define MFMA16(a, b, c) __builtin_amdgcn_mfma_f32_16x16x32_bf16((a), (b), (c), 0, 0, 0)

constexpr int NT = 256;
constexpr int NTP = 512;
constexpr int VSMEM = 65536;
constexpr int D = 1024, MC = 8192, ML = 4096, MT = 12288;
constexpr int NZR = 1792, NZN = 1536, NZT = 2048, INC = 8448, FF = 2816;
constexpr int LDH = 1088, LDO = 576, LZT = 2112, LDG = 136;
constexpr int LDT = 72;
constexpr int SMEM_BYTES = 139264;
constexpr int SMEM_BYTES_GEMM_ = 131072;
constexpr size_t O_K = 12582912, O_V = 20971520, O_RW = 29360128, O_RT = 33554432;
constexpr size_t WS_CTRL = 0;
constexpr size_t WS_MOD = 4096;
constexpr size_t WS_BAR = 262144;
constexpr size_t WS_CUF = 278528;
constexpr size_t WS_WG = 294912;
constexpr size_t WS_WIN = 434176;
constexpr size_t WS_WUP = WS_WIN;
constexpr size_t WS_WDN = WS_WIN + (size_t)5632 * LDH * 2;
constexpr size_t WS_WO3 = WS_WIN + (size_t)INC * LDH * 2;
constexpr size_t WS_WOUT = WS_WO3 + (size_t)3 * 1024 * LDO * 2;
constexpr size_t WS_H = WS_WOUT + (size_t)1024 * LDH * 2;
constexpr size_t WS_Z = WS_H + (size_t)MT * LDH * 2;
constexpr size_t WS_ZR = WS_Z;
constexpr size_t WS_ZN = WS_ZR + (size_t)MT * NZR * 2;
constexpr size_t WS_ZT = WS_ZN + (size_t)MT * NZN * 2;
constexpr size_t WS_MERGED = WS_ZR;
constexpr size_t WS_OA = WS_ZN;
constexpr size_t WS_U = WS_ZT;
constexpr size_t WS_HID = WS_Z;
constexpr size_t WS_F = WS_ZT;
constexpr size_t WS_Y = WS_ZT + (size_t)MT * LZT * 2;
constexpr size_t WS_ONA = WS_Y + (size_t)2 * MT * 512 * 4;
constexpr size_t WS_ORET = WS_ONA + (size_t)MT * LDO * 2;
constexpr size_t WS_END = WS_ORET + (size_t)MT * LDO * 2;

struct P {
  const float *x_prompt, *x_sample, *cache_k, *cache_v, *state_rwkv, *state_ret, *c, *c_ctx, *ada_w, *ada_b;
  const float *norm_mix_pre, *norm_mix_post, *norm_ffn_pre, *norm_ffn_post, *w_in, *rwkv_conv, *rwkv_w0, *rwkv_w_up, *rwkv_a0, *rwkv_a_up, *rwkv_g_up;
  const float *rwkv_k_k, *rwkv_k_a, *rwkv_r_k, *rwkv_ln_g, *rwkv_ln_b, *na_rpb, *ret_decay, *ret_gn, *w_o_rwkv, *w_o_na, *w_o_ret, *w_out, *ffn_up, *ffn_conv, *ffn_down;
  float* out; char* ws;
};

DI int threadIdx_x_raw() { return (int)__builtin_amdgcn_workitem_id_x(); }
DI int ptid() { int t = threadIdx_x_raw(); asm volatile("" : "+v"(t)); return t; }
DI int tidx() { return ptid() & 255; }
DI int vhalf() { return ptid() >> 8; }
DI int vblk() { return (int)blockIdx.x * 2 + vhalf(); }
DI int vgrid() { return (int)gridDim.x * 2; }
DI unsigned cvt_pk_bf16(float lo, float hi) { unsigned r; asm("v_cvt_pk_bf16_f32 %0, %1, %2" : "=v"(r) : "v"(lo), "v"(hi)); return r; }
DI bf16_t f2bf(float x) { return (bf16_t)(cvt_pk_bf16(x, 0.f) & 0xffffu); }
DI float bf2f(bf16_t b) { return __uint_as_float(((unsigned)b) << 16); }
DI unsigned pack2(float a, float b) { return cvt_pk_bf16(a, b); }
DI float bflo(unsigned u) { return __uint_as_float(u << 16); }
DI float bfhi(unsigned u) { return __uint_as_float(u & 0xffff0000u); }
DI void unpack8(const u32x4 r, float (&f)[8]) { f[0] = bflo(r[0]); f[1] = bfhi(r[0]); f[2] = bflo(r[1]); f[3] = bfhi(r[1]); f[4] = bflo(r[2]); f[5] = bfhi(r[2]); f[6] = bflo(r[3]); f[7] = bfhi(r[3]); }
DI u32x4 pack8(const float (&f)[8]) { u32x4 r; r[0] = pack2(f[0], f[1]); r[1] = pack2(f[2], f[3]); r[2] = pack2(f[4], f[5]); r[3] = pack2(f[6], f[7]); return r; }
DI float sigmoidf_(float x) { return __builtin_amdgcn_rcpf(1.f + __expf(-x)); }
DI float shfl_x(float v, int m) { const int lane = ptid() & 63; return __int_as_float(__builtin_amdgcn_ds_bpermute((lane ^ m) << 2, __float_as_int(v))); }
DI float wave_sum(float v) { for (int o = 32; o > 0; o >>= 1) v += shfl_x(v, o); return v; }
DI void tokinfo(int m, int& t, int& T, int& mi) { if (m < MC) { t = m & 255; T = 256; mi = 0; } else { int q = m - MC; t = q & 1023; T = 1024; mi = 1 + (q >> 10); } }

#define XB_TMO      128
#define XB_XCNT(j)  (256  + 64 * (j))
#define XB_XSUB(j)  (1280 + 64 * (j))
#define XB_XGEN(j)  (2304 + 64 * (j))
#define XB_TOP      3328
#define XB_TOPGEN   3392
#define XB_SPIN_CAP (1u << 20)
#define LAS __attribute__((address_space(3)))
DI unsigned xb_ld(unsigned* p) { return __hip_atomic_load(p, __ATOMIC_RELAXED, __HIP_MEMORY_SCOPE_AGENT); }
DI unsigned xb_add(unsigned* p, unsigned v) { return __hip_atomic_fetch_add(p, v, __ATOMIC_RELAXED, __HIP_MEMORY_SCOPE_AGENT); }
DI unsigned xb_xcc_id() { return (unsigned)__builtin_amdgcn_s_getreg((3 << 11) | 20) & 0xFu; }
#define XB_SPIN(cond, bar) do { unsigned _sp = 0; while (cond) { __builtin_amdgcn_s_sleep(1); \
    if ((++_sp & 255u) == 0u) { if (xb_ld(&(bar)[XB_TMO])) break; if (_sp > XB_SPIN_CAP) { atomicAdd(&(bar)[XB_TMO], 1u); break; } } } } while (0)
struct XcdBarrier { unsigned* bar; unsigned x; volatile LAS unsigned* st; };
DI XcdBarrier xcd_barrier_post(unsigned* bar, volatile LAS unsigned* st) {
  XcdBarrier b; b.bar = bar; b.x = xb_xcc_id(); b.st = st;
  if (ptid() == 0) (void)xb_add(&bar[XB_XCNT(b.x)], 1u);
  return b;
}
DI void xcd_barrier_complete(unsigned* bar, unsigned x, unsigned& nloc, unsigned& nx) {
  const unsigned G = gridDim.x * gridDim.y * gridDim.z;
  unsigned sum, cnt, mine, sp = 0u;
  for (;;) {
    sum = 0u; cnt = 0u; mine = 0u;
#pragma unroll
    for (unsigned j = 0; j < 16; ++j) { const unsigned c = xb_ld(&bar[XB_XCNT(j)]); sum += c; cnt += (c > 0u) ? 1u : 0u; mine = (j == x) ? c : mine; }
    if (sum == G) break;
    __builtin_amdgcn_s_sleep(1);
    if ((++sp & 255u) == 0u) { if (xb_ld(&bar[XB_TMO])) break; if (sp > XB_SPIN_CAP) { atomicAdd(&bar[XB_TMO], 1u); break; } }
  }
  nloc = mine > 0u ? mine : 1u; nx = cnt > 0u ? cnt : 1u;
}
DI void xcd_barrier(const XcdBarrier& b) {
  asm volatile("s_waitcnt vmcnt(0)" ::: "memory");
  __syncthreads();
  if (ptid() == 0) {
    unsigned* bar = b.bar;
    __builtin_amdgcn_s_waitcnt(0);
    unsigned nloc = b.st[0], nx = b.st[1];
    if (nloc == 0u) { xcd_barrier_complete(bar, b.x, nloc, nx); b.st[0] = nloc; b.st[1] = nx; }
    const unsigned old = xb_add(&bar[XB_XSUB(b.x)], 1u);
    const unsigned gen = old / nloc;
    if (old + 1u == (gen + 1u) * nloc) {
      __builtin_amdgcn_fence(__ATOMIC_RELEASE, "agent");
      asm volatile("s_waitcnt vmcnt(0)" ::: "memory");
      const unsigned og = xb_add(&bar[XB_TOP], 1u);
      const unsigned tg = og / nx;
      if (og + 1u == (tg + 1u) * nx) xb_add(&bar[XB_TOPGEN], 1u);
      else XB_SPIN(xb_ld(&bar[XB_TOPGEN]) == tg, bar);
      __builtin_amdgcn_fence(__ATOMIC_ACQUIRE, "agent");
      xb_add(&bar[XB_XGEN(b.x)], 1u);
      asm volatile("s_waitcnt vmcnt(0)" ::: "memory");
    } else {
      XB_SPIN(xb_ld(&bar[XB_XGEN(b.x)]) == gen, bar);
      __builtin_amdgcn_fence(__ATOMIC_ACQUIRE, "agent");
      asm volatile("s_waitcnt vmcnt(0)" ::: "memory");
    }
  }
  __syncthreads();
}

__device__ void convert_T(const float* __restrict__ W, int K, int N, bf16_t* __restrict__ Wt, int ldt, char* smem) {
  float* t = (float*)(smem + vhalf() * VSMEM);
  const int tid = tidx(), ntn = N >> 6, nitems = (K >> 6) * ntn;
  const int kr = tid >> 4, c4 = (tid & 15) * 4;
  f32x4 v[4];
  { const int it = vblk() < nitems ? vblk() : 0; const int k0 = (it / ntn) << 6, n0 = (it % ntn) << 6;
#pragma unroll
    for (int i = 0; i < 4; ++i) v[i] = *(const f32x4*)(W + (size_t)(k0 + kr + 16 * i) * N + n0 + c4); }
  for (int it = vblk(); it < nitems; it += vgrid()) {
    const int k0 = (it / ntn) << 6, n0 = (it % ntn) << 6;
    __syncthreads();
#pragma unroll
    for (int i = 0; i < 4; ++i) { const int k = kr + 16 * i; t[k * 65 + c4] = v[i][0]; t[k * 65 + c4 + 1] = v[i][1]; t[k * 65 + c4 + 2] = v[i][2]; t[k * 65 + c4 + 3] = v[i][3]; }
    __syncthreads();
    { const int itn = it + vgrid() < nitems ? it + vgrid() : it; const int k1 = (itn / ntn) << 6, n1 = (itn % ntn) << 6;
#pragma unroll
      for (int i = 0; i < 4; ++i) v[i] = *(const f32x4*)(W + (size_t)(k1 + kr + 16 * i) * N + n1 + c4); }
#pragma unroll
    for (int i = 0; i < 2; ++i) { const int c = tid + 256 * i, n = c >> 3, kc = c & 7; float f[8];
#pragma unroll
      for (int e = 0; e < 8; ++e) f[e] = t[(kc * 8 + e) * 65 + n];
      *(u32x4*)(Wt + (size_t)(n0 + n) * ldt + k0 + kc * 8) = pack8(f); }
  }
}

__device__ void ada_phase(const P& p, char* smem) {
  float* sc = (float*)(smem + vhalf() * VSMEM);
  float* red = sc + 640;
  float* mod = (float*)(p.ws + WS_MOD);
  const int tid = tidx(), kq = tid >> 5, cq = tid & 31;
  for (int it = vblk(); it < 2 * 48 * 8; it += vgrid()) {
    const int l = it / 384, rem = it % 384, nb = rem >> 3, ks = rem & 7;
    const int n0 = nb * 128, k0 = ks * 128;
    __syncthreads();
    for (int e = tid; e < 640; e += NT) { const int i = e >> 7, k = e & 127; const float v = (i == 0) ? p.c_ctx[k0 + k] : p.c[(i - 1) * D + k0 + k]; sc[e] = v * sigmoidf_(v); }
    __syncthreads();
    float acc[5][4];
#pragma unroll
    for (int i = 0; i < 5; ++i)
#pragma unroll
      for (int j = 0; j < 4; ++j) acc[i][j] = 0.f;
    const float* wp = p.ada_w + ((size_t)l * D + k0 + kq * 16) * 6144 + n0 + cq * 4;
#pragma unroll 4
    for (int kk = 0; kk < 16; ++kk) { const float4 w = *(const float4*)(wp + (size_t)kk * 6144);
#pragma unroll
      for (int i = 0; i < 5; ++i) { const float s = sc[i * 128 + kq * 16 + kk]; acc[i][0] += s * w.x; acc[i][1] += s * w.y; acc[i][2] += s * w.z; acc[i][3] += s * w.w; } }
#pragma unroll
    for (int i = 0; i < 5; ++i)
#pragma unroll
      for (int j = 0; j < 4; ++j) red[(kq * 5 + i) * 128 + cq * 4 + j] = acc[i][j];
    __syncthreads();
    for (int e = tid; e < 640; e += NT) { const int i = e >> 7, n = e & 127; float s = 0.f;
#pragma unroll
      for (int q = 0; q < 8; ++q) s += red[(q * 5 + i) * 128 + n];
      if (ks == 0) s += p.ada_b[l * 6144 + n0 + n];
      atomicAdd(mod + ((size_t)l * 5 + i) * 6144 + n0 + n, s); }
  }
}

__device__ void norm_phase(const P& p, const float* xin  , const float* u, const float* gpost, const float* modU, int gate_idx,
                           float* xout, const float* gpre, const float* modN, int shift_idx, bf16_t* hout) {
  const int lane = tidx() & 63, wave = tidx() >> 6, nw = NT / 64;
  for (int m = vblk() * nw + wave; m < MT; m += vgrid() * nw) {
    int t, T, mi; tokinfo(m, t, T, mi);
    const float* xr = xin ? xin + (size_t)m * D : (m < MC ? p.x_prompt + (size_t)m * D : p.x_sample + (size_t)(m - MC) * D);
    float4 x[4];
#pragma unroll
    for (int i = 0; i < 4; ++i) x[i] = *(const float4*)(xr + i * 256 + lane * 4);
    if (u) {
      float4 uu[4]; float ss = 0.f;
#pragma unroll
      for (int i = 0; i < 4; ++i) { uu[i] = *(const float4*)(u + (size_t)m * D + i * 256 + lane * 4); ss += uu[i].x * uu[i].x + uu[i].y * uu[i].y + uu[i].z * uu[i].z + uu[i].w * uu[i].w; }
      ss = wave_sum(ss); const float rs = rsqrtf(ss * (1.f / D) + 1e-6f);
#pragma unroll
      for (int i = 0; i < 4; ++i) { const int c = i * 256 + lane * 4; const float4 g = *(const float4*)(gpost + c); const float4 ga = *(const float4*)(modU + ((size_t)mi * 6 + gate_idx) * D + c);
        x[i].x += ga.x * uu[i].x * rs * g.x; x[i].y += ga.y * uu[i].y * rs * g.y; x[i].z += ga.z * uu[i].z * rs * g.z; x[i].w += ga.w * uu[i].w * rs * g.w; }
    }
    if (xout) {
#pragma unroll
      for (int i = 0; i < 4; ++i) *(float4*)(xout + (size_t)m * D + i * 256 + lane * 4) = x[i];
    }
    if (hout) {
      float ss = 0.f;
#pragma unroll
      for (int i = 0; i < 4; ++i) ss += x[i].x * x[i].x + x[i].y * x[i].y + x[i].z * x[i].z + x[i].w * x[i].w;
      ss = wave_sum(ss); const float rs = rsqrtf(ss * (1.f / D) + 1e-6f);
#pragma unroll
      for (int i = 0; i < 4; ++i) { const int c = i * 256 + lane * 4; const float4 g = *(const float4*)(gpre + c);
        const float4 sh = *(const float4*)(modN + ((size_t)mi * 6 + shift_idx) * D + c); const float4 sc = *(const float4*)(modN + ((size_t)mi * 6 + shift_idx + 1) * D + c);
        u32x2 o; o.x = pack2(x[i].x * rs * g.x * (1.f + sc.x) + sh.x, x[i].y * rs * g.y * (1.f + sc.y) + sh.y); o.y = pack2(x[i].z * rs * g.z * (1.f + sc.z) + sh.z, x[i].w * rs * g.w * (1.f + sc.w) + sh.w);
        *(u32x2*)(hout + (size_t)m * LDH + c) = o; }
    }
  }
}

struct TileSrc { const bf16_t* A; int lda; int arow0; const bf16_t* B; int ldb; int brow0, brow1; int K; };

template <int MM, int NN> DI void zero_acc(f32x4 (&acc)[MM][NN]) {
#pragma unroll
  for (int m = 0; m < MM; ++m)
#pragma unroll
    for (int n = 0; n < NN; ++n) acc[m][n] = (f32x4){0.f, 0.f, 0.f, 0.f};
}

template <int MM, int NN, int KU = 0> struct Gemm {
  static constexpr int NA = MM / 2, NB = NN;
  unsigned oa_[NA], ob_[NB]; const bf16_t* A; const bf16_t* B; int nk; u32x4 ra[NA], rb[NB];
#define GT_LOAD(KT) do { const int kn_ = ((KT) < nk ? (KT) : nk - 1) * 64; \
    _Pragma("unroll") for (int i = 0; i < NA; ++i) ra[i] = *(const u32x4*)(A + (oa_[i] + kn_)); \
    _Pragma("unroll") for (int i = 0; i < NB; ++i) rb[i] = *(const u32x4*)(B + (ob_[i] + kn_)); } while (0)
  DI void begin(const TileSrc& s, const bool perm = false) {
    const int tid = ptid();
#pragma unroll
    for (int i = 0; i < NA; ++i) { const int row = (tid >> 3) + 64 * i, kc = tid & 7;
      int ar = s.arow0 + row; ar = ar < 0 ? 0 : (ar > MT - 1 ? MT - 1 : ar);
      oa_[i] = (unsigned)ar * (unsigned)s.lda + kc * 8; }
#pragma unroll
    for (int i = 0; i < NB; ++i) { const int row = (tid >> 3) + 64 * i, kc = tid & 7;
      const int rr = perm ? ((row & ~31) | (8 * ((row & 15) >> 2) + 4 * ((row >> 4) & 1) + (row & 3))) : row;
      const int br = rr < 32 * NN ? s.brow0 + rr : s.brow1 + rr - 32 * NN;
      ob_[i] = (unsigned)br * (unsigned)s.ldb + kc * 8; }
    A = s.A; B = s.B; nk = s.K >> 6;
    GT_LOAD(0);
  }
  DI void run(f32x4 (&acc)[MM][NN], char* smem) {
    bf16_t* sbase = (bf16_t*)smem;
    const int tid = ptid(), lane = tid & 63, wave = tid >> 6, wr = wave >> 2, wc = wave & 3, fr = lane & 15, fq = lane >> 4;
    int wofs; { const int r = tid >> 3, kc = tid & 7, ob = (r & 15) * 64 + (kc & 3) * 16; wofs = (((r >> 4) * 2 + (kc >> 2)) * 1024 + (ob ^ (((ob >> 9) & 1) << 5))) >> 1; }
    int robase; { const int ob = fr * 64 + fq * 16; robase = (ob ^ (((ob >> 9) & 1) << 5)) >> 1; }
#define GT_STORE(ST) do { bf16_t* sA_ = sbase + (ST) * 32768; bf16_t* sB_ = sA_ + 16384; \
    _Pragma("unroll") for (int i = 0; i < NA; ++i) *(u32x4*)(sA_ + wofs + i * 4096) = ra[i]; \
    _Pragma("unroll") for (int i = 0; i < NB; ++i) *(u32x4*)(sB_ + wofs + i * 4096) = rb[i]; } while (0)
#define GT_KSTEP(ks) do { bf16x8 bfr[NN]; \
      _Pragma("unroll") for (int n = 0; n < NN; ++n) bfr[n] = *(const bf16x8*)(sB_ + ((wc * NN + n) * 2 + (ks)) * 512); \
      _Pragma("unroll") for (int m = 0; m < MM; ++m) { const bf16x8 af = *(const bf16x8*)(sA_ + ((wr * MM + m) * 2 + (ks)) * 512); \
        _Pragma("unroll") for (int n = 0; n < NN; ++n) acc[m][n] = MFMA16(bfr[n], af, acc[m][n]); } } while (0)
#define GT_COMPUTE(ST) do { const bf16_t* sA_ = sbase + (ST) * 32768 + robase; const bf16_t* sB_ = sA_ + 16384; __builtin_amdgcn_s_setprio(1); \
    if (KU) { GT_KSTEP(0); GT_KSTEP(1); } else { _Pragma("unroll 1") for (int ks = 0; ks < 2; ++ks) GT_KSTEP(ks); } \
    __builtin_amdgcn_s_setprio(0); } while (0)
    __syncthreads();
    GT_STORE(0);
    GT_LOAD(1);
    __syncthreads();
#pragma unroll 1
    for (int kt = 0; kt < nk; kt += 2) {
      GT_STORE(1); GT_LOAD(kt + 2); GT_COMPUTE(0); __syncthreads();
      GT_STORE(0); GT_LOAD(kt + 3); GT_COMPUTE(1); __syncthreads();
    }
  }
#undef GT_LOAD
#undef GT_STORE
#undef GT_COMPUTE
#undef GT_KSTEP
};
template <int MM, int NN> DI void gemm_tile(f32x4 (&acc)[MM][NN], const TileSrc& s, char* smem) { Gemm<MM, NN> g; g.begin(s); g.run(acc, smem); }

DI float gelu_tanh(float x) { const float u = 0.7978845608f * (x + 0.044715f * x * x * x); const float e = __expf(2.f * u); const float th = 1.f - 2.f * __builtin_amdgcn_rcpf(e + 1.f); return 0.5f * x * (1.f + th); }

struct TileIter {
  int m_lo, rows, NTn, G, efull, count, e, stride;
  DI void init(int MTn, int NTn_) { const int x = blockIdx.x & 7; m_lo = (x * MTn) >> 3; rows = (((x + 1) * MTn) >> 3) - m_lo; NTn = NTn_; G = (rows + 1) >> 1;
    efull = (rows / G) * G * NTn; count = rows * NTn; e = blockIdx.x >> 3; stride = gridDim.x >> 3; }
  DI bool next(int& mt, int& nt) { if (e >= count) return false;
    if (e < efull) { const int grp = e / (G * NTn), rem = e - grp * G * NTn; nt = rem / G; mt = m_lo + grp * G + (rem - nt * G); }
    else { const int rem = e - efull, gsz = rows - (rows / G) * G; nt = rem / gsz; mt = m_lo + (rows / G) * G + (rem - nt * gsz); }
    e += stride; return true; }
};

__device__ void phase_win(const P& p, int l, char* smem) {
  const bf16_t* H = (const bf16_t*)(p.ws + WS_H); const bf16_t* Wt = (const bf16_t*)(p.ws + WS_WIN);
  bf16_t* zr = (bf16_t*)(p.ws + WS_ZR); bf16_t* zn = (bf16_t*)(p.ws + WS_ZN); bf16_t* zt = (bf16_t*)(p.ws + WS_ZT);
  const int tid = ptid(), lane = tid & 63, wave = tid >> 6, wr = wave >> 2, wc = wave & 3, fr = lane & 15, fq = lane >> 4;
  Gemm<8, 4> gm;
  TileIter ti; ti.init(48, 14);
  const int x = blockIdx.x & 7, nconv = (343 - x + 7) >> 3, nloc = ti.count + nconv;
  const float* cw = p.rwkv_conv + (size_t)l * 3 * NZR;
  for (int e = (int)(blockIdx.x >> 3); e < nloc; e += (int)(gridDim.x >> 3)) {
    f32x4 acc[8][4]; zero_acc<8, 4>(acc);
    if (e < nconv) {
      const int c = x + 8 * e, mt = c / 7, nt = c - mt * 7;
      const int n0 = nt * 256, arow0 = mt * 254 - 1;
      { TileSrc s{H, LDH, arow0, Wt, LDH, n0, n0 + 128, D}; gm.begin(s); }
      gm.run(acc, smem);
      float* sC = (float*)smem;
#pragma unroll 1
      for (int sl = 0; sl < 2; ++sl) {
        __syncthreads();
        if ((wc >> 1) == sl) {
#pragma unroll
          for (int m = 0; m < 8; ++m)
#pragma unroll
            for (int n = 0; n < 4; ++n) *(f32x4*)(sC + (wr * 128 + m * 16 + fr) * 132 + (wc & 1) * 64 + n * 16 + fq * 4) = acc[m][n];
        }
        __syncthreads();
        const int nb = n0 + sl * 128, c8 = (tid & 15) * 8;
        const f32x4 w0a = *(const f32x4*)(cw + nb + c8), w0b = *(const f32x4*)(cw + nb + c8 + 4), w1a = *(const f32x4*)(cw + NZR + nb + c8), w1b = *(const f32x4*)(cw + NZR + nb + c8 + 4),
                    w2a = *(const f32x4*)(cw + 2 * NZR + nb + c8), w2b = *(const f32x4*)(cw + 2 * NZR + nb + c8 + 4);
        const bool sg = nb + c8 >= 1664;
        for (int ee = tid; ee < 254 * 16; ee += NTP) {
          const int tr = 1 + (ee >> 4), g = arow0 + tr;
          if (g < MT) { int t, T, mi; tokinfo(g, t, T, mi);
            const float pm = t > 0 ? 1.f : 0.f, nm = t < T - 1 ? 1.f : 0.f;
            const float* r0 = sC + (tr - 1) * 132 + c8; const float* r1 = r0 + 132; const float* r2 = r1 + 132;
            f32x4 ya = (*(const f32x4*)r0 * w0a) * pm + *(const f32x4*)r1 * w1a + (*(const f32x4*)r2 * w2a) * nm;
            f32x4 yb = (*(const f32x4*)(r0 + 4) * w0b) * pm + *(const f32x4*)(r1 + 4) * w1b + (*(const f32x4*)(r2 + 4) * w2b) * nm;
            if (sg) {
#pragma unroll
              for (int j = 0; j < 4; ++j) { ya[j] = sigmoidf_(ya[j]); yb[j] = sigmoidf_(yb[j]); } }
            const u32x4 o = {pack2(ya[0], ya[1]), pack2(ya[2], ya[3]), pack2(yb[0], yb[1]), pack2(yb[2], yb[3])};
            *(u32x4*)(zr + (size_t)g * NZR + nb + c8) = o; }
        }
      }
    } else {
      int mt, nt; ti.e = e - nconv; ti.next(mt, nt);
      const int n0 = nt * 256, row0 = mt * 256;
      { TileSrc s{H, LDH, row0, Wt, LDH, NZR + n0, NZR + n0 + 128, D}; gm.begin(s, true); }
      gm.run(acc, smem);
#pragma unroll
      for (int m = 0; m < 8; ++m) { const int row = row0 + wr * 128 + m * 16 + fr;
#pragma unroll
        for (int g = 0; g < 2; ++g) { const int col = n0 + wc * 64 + g * 32 + fq * 8; const f32x4 v0 = acc[m][2 * g], v1 = acc[m][2 * g + 1];
          const u32x4 o = {pack2(v0[0], v0[1]), pack2(v0[2], v0[3]), pack2(v1[0], v1[1]), pack2(v1[2], v1[3])};
          if (col < NZN) {
            *(u32x4*)(zn + (size_t)row * NZN + col) = o;
            if (row < MC && col >= 512) { const int part = col - 512, isv = part >> 9, pp = part & 511, hh = pp >> 6, d = pp & 63, b = row >> 8, t = row & 255;
              float* dst = p.out + (isv ? O_V : O_K) + ((((size_t)b * 2 + l) * 8 + hh) * 256 + t) * 64 + d; *(f32x4*)dst = v0; *(f32x4*)(dst + 4) = v1; }
          } else { *(u32x4*)(zt + (size_t)row * LZT + (col - NZN)) = o; }
        } }
    }
  }
}

__device__ void phase_merge(const P& p, char* smem) {
  const bf16_t* H = (const bf16_t*)(p.ws + WS_H); const bf16_t* Wt = (const bf16_t*)(p.ws + WS_WIN); const bf16_t* Wo3 = (const bf16_t*)(p.ws + WS_WO3);
  bf16_t* mg = (bf16_t*)(p.ws + WS_MERGED);
  const int tid = ptid(), lane = tid & 63, wave = tid >> 6, wr = wave >> 2, wc = wave & 3, fr = lane & 15, fq = lane >> 4;
  TileIter ti; int mt, nt; ti.init(96, 8);
  while (ti.next(mt, nt)) {
    const int n0 = nt * 128, row0 = mt * 128;
    f32x4 macc[4][2]; zero_acc<4, 2>(macc);
#pragma unroll 1
    for (int i = 0; i < 3; ++i) {
      const bf16_t* O = (const bf16_t*)(p.ws + (i == 0 ? WS_OA : (i == 1 ? WS_ONA : WS_ORET)));
      f32x4 g[4][2]; zero_acc<4, 2>(g);
      { TileSrc s{H, LDH, row0, Wt, LDH, 5376 + i * 1024 + n0, 5376 + i * 1024 + n0 + 64, D}; { Gemm<4, 2, 1> gm; gm.begin(s, true); gm.run(g, smem); } }
      f32x4 a2[4][2]; zero_acc<4, 2>(a2);
      { TileSrc s{O, LDO, row0, Wo3 + (size_t)i * 1024 * LDO, LDO, n0, n0 + 64, 512}; { Gemm<4, 2, 1> gm; gm.begin(s, true); gm.run(a2, smem); } }
#pragma unroll
      for (int m = 0; m < 4; ++m)
#pragma unroll
        for (int n = 0; n < 2; ++n)
#pragma unroll
          for (int j = 0; j < 4; ++j) macc[m][n][j] += sigmoidf_(g[m][n][j]) * a2[m][n][j];
    }
#pragma unroll
    for (int m = 0; m < 4; ++m) { const int row = row0 + wr * 64 + m * 16 + fr;
      { const int col = n0 + wc * 32 + fq * 8; const u32x4 o = {pack2(macc[m][0][0], macc[m][0][1]), pack2(macc[m][0][2], macc[m][0][3]), pack2(macc[m][1][0], macc[m][1][1]), pack2(macc[m][1][2], macc[m][1][3])}; *(u32x4*)(mg + (size_t)row * LDH + col) = o; } }
  }
}

__device__ void phase_gemm_f32(const bf16_t* A, int lda, int K, const bf16_t* Bt, int ldb, float* C, char* smem) {
  const int tid = ptid(), lane = tid & 63, wave = tid >> 6, wr = wave >> 2, wc = wave & 3, fr = lane & 15, fq = lane >> 4;
  TileIter ti; int mt, nt; ti.init(48, 4);
  while (ti.next(mt, nt)) {
    const int n0 = nt * 256, row0 = mt * 256;
    f32x4 acc[8][4]; zero_acc<8, 4>(acc);
    TileSrc s{A, lda, row0, Bt, ldb, n0, n0 + 128, K}; { Gemm<8, 4> gm; gm.begin(s, true); gm.run(acc, smem); }
#pragma unroll
    for (int m = 0; m < 8; ++m) { const int row = row0 + wr * 128 + m * 16 + fr;
#pragma unroll
      for (int g = 0; g < 2; ++g) { float* dst = C + (size_t)row * D + n0 + wc * 64 + g * 32 + fq * 8; *(f32x4*)dst = acc[m][2 * g]; *(f32x4*)(dst + 4) = acc[m][2 * g + 1]; } }
  }
}

__device__ void phase_ffn_up(const P& p, int l, char* smem) {
  const bf16_t* H = (const bf16_t*)(p.ws + WS_H); const bf16_t* Wt = (const bf16_t*)(p.ws + WS_WUP); bf16_t* hid = (bf16_t*)(p.ws + WS_HID);
  const int tid = ptid(), lane = tid & 63, wave = tid >> 6, wr = wave >> 2, wc = wave & 3, fr = lane & 15, fq = lane >> 4;
  const float* cw = p.ffn_conv + (size_t)l * 3 * 2 * FF;
  TileIter ti; int mt, nt; ti.init(49, 22);
  Gemm<8, 4> gm;
  while (ti.next(mt, nt)) {
    const int c0 = nt * 128, arow0 = mt * 254 - 1;
    f32x4 acc[8][4]; zero_acc<8, 4>(acc);
    { TileSrc s{H, LDH, arow0, Wt, LDH, c0, FF + c0, D}; gm.begin(s); }
    gm.run(acc, smem);
    float* sC = (float*)smem;
#pragma unroll 1
    for (int sl = 0; sl < 2; ++sl) {
      __syncthreads();
      if ((wc & 1) == sl) { const int cb = (wc >> 1) * 64;
#pragma unroll
        for (int m = 0; m < 8; ++m)
#pragma unroll
          for (int n = 0; n < 4; ++n) *(f32x4*)(sC + (wr * 128 + m * 16 + fr) * 132 + cb + n * 16 + fq * 4) = acc[m][n];
      }
      __syncthreads();
      const int cq = c0 + sl * 64, c4 = (tid & 15) * 4;
      const f32x4 v0 = *(const f32x4*)(cw + cq + c4), v1 = *(const f32x4*)(cw + 2 * FF + cq + c4), v2 = *(const f32x4*)(cw + 4 * FF + cq + c4);
      const f32x4 g0 = *(const f32x4*)(cw + FF + cq + c4), g1 = *(const f32x4*)(cw + 3 * FF + cq + c4), g2 = *(const f32x4*)(cw + 5 * FF + cq + c4);
      for (int e = tid; e < 254 * 16; e += NTP) {
        const int tr = 1 + (e >> 4), g = arow0 + tr;
        if (g < MT) { int t, T, mi; tokinfo(g, t, T, mi);
          const float pm = t > 0 ? 1.f : 0.f, nm = t < T - 1 ? 1.f : 0.f;
          const f32x4 va = *(const f32x4*)(sC + (tr - 1) * 132 + c4), vb = *(const f32x4*)(sC + tr * 132 + c4), vc = *(const f32x4*)(sC + (tr + 1) * 132 + c4);
          const f32x4 ga = *(const f32x4*)(sC + (tr - 1) * 132 + 64 + c4), gb = *(const f32x4*)(sC + tr * 132 + 64 + c4), gc = *(const f32x4*)(sC + (tr + 1) * 132 + 64 + c4);
          float r[4];
#pragma unroll
          for (int j = 0; j < 4; ++j) { const float val = pm * va[j] * v0[j] + vb[j] * v1[j] + nm * vc[j] * v2[j]; const float gt = pm * ga[j] * g0[j] + gb[j] * g1[j] + nm * gc[j] * g2[j]; r[j] = gelu_tanh(gt) * val; }
          u32x2 o; o.x = pack2(r[0], r[1]); o.y = pack2(r[2], r[3]);
          *(u32x2*)(hid + (size_t)g * FF + cq + c4) = o; }
      }
    }
  }
}

template <int CTRL> DI float dppf(float v) { return __int_as_float(__builtin_amdgcn_mov_dpp(__float_as_int(v), CTRL, 0xF, 0xF, true)); }
DI float row16_sum(float v) { v += dppf<0xB1>(v); v += dppf<0x4E>(v); v += dppf<0x141>(v); v += dppf<0x140>(v); return v; }

DI float frcp(float x) { return __builtin_amdgcn_rcpf(x); }
DI float fsig(float x) { return frcp(1.f + __expf(-x)); }
__device__ void scan_task(const P& p, int l, int seq, int h, int d, int half, char* smem) {
  float* sR = (float*)smem; float* sW = sR + 1024; float* sKD = sW + 1024; float* sB = sKD + 1024; float* sNK = sB + 1024; float* sV = sNK + 1024; float* sK = sV + 1024; float* sY = sK + 1024;
  float* sKn = sY + 2048; float* sKK = sKn + 16; bf16_t* sWT = (bf16_t*)(sKK + 64); bf16_t* sAL = sWT + 16 * LDT;
  const int tid = tidx(), lane = tid & 63, wave = tid >> 6, fr = lane & 15, fq = lane >> 4;
  const int row0 = seq < 32 ? seq * 256 : MC + (seq - 32) * 1024, T = seq < 32 ? 256 : 1024, nch = T >> 4;
  const bf16_t* zr = (const bf16_t*)(p.ws + WS_ZR);
  float* yout = (float*)(p.ws + WS_Y) + (size_t)d * MT * 512;
  __syncthreads();
  if (tid < 64) sKK[tid] = p.rwkv_k_k[l * 512 + h * 64 + tid];
  const int cc = wave * 16 + fr, gc = h * 64 + cc;
  bf16x8 bw[2], ba[2];
#pragma unroll
  for (int ks = 0; ks < 2; ++ks)
#pragma unroll
    for (int e = 0; e < 8; ++e) { const int k = ks * 32 + fq * 8 + e;
      bw[ks][e] = (short)f2bf(p.rwkv_w_up[((size_t)(l * 2 + d) * 64 + k) * 512 + gc]); ba[ks][e] = (short)f2bf(p.rwkv_a_up[((size_t)(l * 2 + d) * 64 + k) * 512 + gc]); }
  const float w0c = p.rwkv_w0[(l * 2 + d) * 512 + gc], a0c = p.rwkv_a0[(l * 2 + d) * 512 + gc], kac = p.rwkv_k_a[l * 512 + gc];
  const int rg = tid >> 4, kq = tid & 15, rbase = half * 32 + rg * 2;
  f32x2 S[2][2];
  if (seq >= 32) { const float* s0 = p.state_rwkv + (((((size_t)(seq - 32) * 2 + l) * 2 + d) * 8 + h) * 64 + rbase) * 64 + kq * 4;
#pragma unroll
    for (int r = 0; r < 2; ++r) { const f32x4 x = *(const f32x4*)(s0 + r * 64); S[r][0] = (f32x2){x[0], x[1]}; S[r][1] = (f32x2){x[2], x[3]}; } }
  else {
#pragma unroll
    for (int r = 0; r < 2; ++r) { S[r][0] = (f32x2){0.f, 0.f}; S[r][1] = (f32x2){0.f, 0.f}; } }
  if (seq >= 32) __builtin_amdgcn_s_setprio(2);
  const int at = (tid & 127) >> 3, apart = tid & 7, ahi = tid >> 7;
  size_t coff[3];
  { const int sb0 = ahi ? 512 + h * 64 : h * 64, sb1 = ahi ? 1536 : 1024 + h * 64, sb2 = 1600;
    coff[0] = (size_t)at * NZR + sb0 + apart * 8; coff[1] = (size_t)at * NZR + sb1 + apart * 8; coff[2] = (size_t)at * NZR + sb2 + apart * 8; }
  u32x4 pre[3];
  { const int t0 = (d ? nch - 1 : 0) * 16;
#pragma unroll
    for (int i = 0; i < 3; ++i) pre[i] = *(const u32x4*)(zr + (size_t)(row0 + t0) * NZR + coff[i]); }
  __syncthreads();
  for (int ci = 0; ci < nch; ++ci) {
    const int chunk = d ? nch - 1 - ci : ci, t0 = chunk * 16;
    { const int o = at * 64 + apart * 8; float f[8];
      unpack8(pre[0], f);
      if (ahi == 0) { *(f32x4*)(sR + o) = (f32x4){f[0], f[1], f[2], f[3]}; *(f32x4*)(sR + o + 4) = (f32x4){f[4], f[5], f[6], f[7]}; }
      else { *(f32x4*)(sK + o) = (f32x4){f[0], f[1], f[2], f[3]}; *(f32x4*)(sK + o + 4) = (f32x4){f[4], f[5], f[6], f[7]}; float ps = 0.f;
#pragma unroll
        for (int e = 0; e < 8; ++e) { const float kk = f[e] * sKK[apart * 8 + e]; ps += kk * kk; }
        ps += dppf<0xB1>(ps); ps += dppf<0x4E>(ps); ps += dppf<0x141>(ps);
        if (apart == 0) sKn[at] = ps; }
      unpack8(pre[1], f);
      if (ahi == 0) { *(f32x4*)(sV + o) = (f32x4){f[0], f[1], f[2], f[3]}; *(f32x4*)(sV + o + 4) = (f32x4){f[4], f[5], f[6], f[7]}; }
      else { float g[8];
#pragma unroll
        for (int e = 0; e < 8; ++e) g[e] = 1.f - 2.f * frcp(__expf(2.f * f[e]) + 1.f);
        *(u32x4*)(sWT + at * LDT + apart * 8) = pack8(g); }
      if (ahi == 0) *(u32x4*)(sAL + at * LDT + apart * 8) = pre[2];
    }
    __syncthreads();
    {
      f32x4 aw = {0.f, 0.f, 0.f, 0.f}, aa = {0.f, 0.f, 0.f, 0.f};
#pragma unroll
      for (int ks = 0; ks < 2; ++ks) { const bf16x8 fw = *(const bf16x8*)(sWT + fr * LDT + ks * 32 + fq * 8); const bf16x8 fa = *(const bf16x8*)(sAL + fr * LDT + ks * 32 + fq * 8);
        aw = MFMA16(fw, bw[ks], aw); aa = MFMA16(fa, ba[ks], aa); }
      const float kkc = sKK[cc];
#pragma unroll
      for (int j = 0; j < 4; ++j) { const int t = fq * 4 + j, o = t * 64 + cc;
        const float dec = __expf(-0.6065306597f * fsig(w0c + aw[j]));
        const float a = fsig(a0c + aa[j]);
        const float kv = sK[o];
        const float kkv = kv * kkc * __builtin_amdgcn_rsqf(fmaxf(sKn[t], 1e-24f));
        sW[o] = dec; sKD[o] = kv * (1.f + (a - 1.f) * kac); sB[o] = kkv * a; sNK[o] = -kkv; }
    }
    __syncthreads();
    { const int cn = ci + 1 < nch ? ci + 1 : ci; const int nt0 = (d ? nch - 1 - cn : cn) * 16;
#pragma unroll
      for (int i = 0; i < 3; ++i) pre[i] = *(const u32x4*)(zr + (size_t)(row0 + nt0) * NZR + coff[i]); }
#pragma unroll 8
    for (int si = 0; si < 16; ++si) {
      const int t = d ? 15 - si : si, o = t * 64 + kq * 4;
      const f32x4 an4 = *(const f32x4*)(sNK + o), w4 = *(const f32x4*)(sW + o), b4 = *(const f32x4*)(sB + o), kd4 = *(const f32x4*)(sKD + o), r4 = *(const f32x4*)(sR + o);
      const f32x2 v2 = *(const f32x2*)(sV + t * 64 + rbase);
      const f32x2 an[2] = {{an4[0], an4[1]}, {an4[2], an4[3]}}, wv[2] = {{w4[0], w4[1]}, {w4[2], w4[3]}}, bv[2] = {{b4[0], b4[1]}, {b4[2], b4[3]}}, kd[2] = {{kd4[0], kd4[1]}, {kd4[2], kd4[3]}}, rv[2] = {{r4[0], r4[1]}, {r4[2], r4[3]}};
      float sa[2];
#pragma unroll
      for (int r = 0; r < 2; ++r) { const f32x2 t2 = S[r][0] * an[0] + S[r][1] * an[1]; sa[r] = row16_sum(t2.x + t2.y); }
      f32x2 yv;
#pragma unroll
      for (int r = 0; r < 2; ++r) { const f32x2 sav = {sa[r], sa[r]}, vvv = {v2[r], v2[r]};
        S[r][0] = S[r][0] * wv[0] + (sav * bv[0] + vvv * kd[0]); S[r][1] = S[r][1] * wv[1] + (sav * bv[1] + vvv * kd[1]);
        const f32x2 y2 = S[r][0] * rv[0] + S[r][1] * rv[1]; float yp = y2.x + y2.y; yp += dppf<0xB1>(yp); yp += dppf<0x4E>(yp); yv[r] = yp; }
      if ((kq & 3) == 0) { sY[((t * 32 + rg * 2) * 4) + (kq >> 2)] = yv[0]; sY[((t * 32 + rg * 2 + 1) * 4) + (kq >> 2)] = yv[1]; }
    }
    __syncthreads();
    { const int t = tid >> 4, lr = (tid & 15) * 2; const f32x4 p0 = *(const f32x4*)(sY + (t * 32 + lr) * 4), p1 = *(const f32x4*)(sY + (t * 32 + lr + 1) * 4);
      *(f32x2*)(yout + (size_t)(row0 + t0 + t) * 512 + h * 64 + half * 32 + lr) = (f32x2){p0[0] + p0[1] + p0[2] + p0[3], p1[0] + p1[1] + p1[2] + p1[3]}; }
  }
  __builtin_amdgcn_s_setprio(0);
  if (seq < 32) { float* so = p.out + O_RW + (((((size_t)seq * 2 + l) * 2 + d) * 8 + h) * 64 + rbase) * 64 + kq * 4;
#pragma unroll
    for (int r = 0; r < 2; ++r) *(f32x4*)(so + r * 64) = (f32x4){S[r][0].x, S[r][0].y, S[r][1].x, S[r][1].y}; }
}

DI void qk_scores(const bf16_t* sK, const bf16x8 (&qf)[2], f32x4 (&sacc)[4], int fr, int fq) {
#pragma unroll
  for (int nt = 0; nt < 4; ++nt) { sacc[nt] = (f32x4){0.f, 0.f, 0.f, 0.f};
#pragma unroll
    for (int ks = 0; ks < 2; ++ks) { const bf16x8 kf = *(const bf16x8*)(sK + (nt * 16 + fr) * LDT + ks * 32 + fq * 8); sacc[nt] = MFMA16(kf, qf[ks], sacc[nt]); } }
}
DI void pv_accum(const bf16_t* sVt, const f32x4 (&pacc)[4], f32x4 (&o)[4], int fr, int fq) {
#pragma unroll
  for (int s = 0; s < 2; ++s) {
    bf16x8 pf; { const unsigned a = pack2(pacc[2 * s][0], pacc[2 * s][1]), b = pack2(pacc[2 * s][2], pacc[2 * s][3]), c = pack2(pacc[2 * s + 1][0], pacc[2 * s + 1][1]), dd = pack2(pacc[2 * s + 1][2], pacc[2 * s + 1][3]);
      const u32x4 u = (u32x4){a, b, c, dd}; pf = __builtin_bit_cast(bf16x8, u); }
#pragma unroll
    for (int dt = 0; dt < 4; ++dt) { const u32x2 lo = *(const u32x2*)(sVt + (dt * 16 + fr) * LDT + 32 * s + 4 * fq), hi = *(const u32x2*)(sVt + (dt * 16 + fr) * LDT + 32 * s + 16 + 4 * fq);
      const u32x4 u = (u32x4){lo[0], lo[1], hi[0], hi[1]}; const bf16x8 vf = __builtin_bit_cast(bf16x8, u); o[dt] = MFMA16(vf, pf, o[dt]); }
  }
}
DI void put_kv(bf16_t* sK, bf16_t* sVt, int key, int part, const float (&kf)[8], int vkey, int vpart, const float (&vf)[8]) {
  *(u32x4*)(sK + key * LDT + part * 8) = pack8(kf);
#pragma unroll
  for (int e = 0; e < 8; ++e) sVt[(vpart * 8 + e) * LDT + vkey] = f2bf(vf[e]);
}
DI void softmax_tile(f32x4 (&sacc)[4], f32x4 (&o)[4], float& mrun, float& lrun) {
  float mx = sacc[0][0];
#pragma unroll
  for (int nt = 0; nt < 4; ++nt)
#pragma unroll
    for (int j = 0; j < 4; ++j) mx = fmaxf(mx, sacc[nt][j]);
  mx = fmaxf(mx, shfl_x(mx, 16)); mx = fmaxf(mx, shfl_x(mx, 32));
  const float mnew = fmaxf(mrun, mx), alpha = __builtin_amdgcn_exp2f(mrun - mnew); mrun = mnew;
  float ls = 0.f;
#pragma unroll
  for (int nt = 0; nt < 4; ++nt)
#pragma unroll
    for (int j = 0; j < 4; ++j) { const float pv = __builtin_amdgcn_exp2f(sacc[nt][j] - mnew); sacc[nt][j] = pv; ls += pv; }
  lrun = lrun * alpha + ls;
#pragma unroll
  for (int dt = 0; dt < 4; ++dt) o[dt] *= alpha;
}
constexpr float LOG2E = 1.4426950408889634f;

__device__ void dense_task(const P& p, int b, int h, int qb, char* smem) {
  bf16_t* sK = (bf16_t*)smem; bf16_t* sVt = sK + 64 * LDT;
  const int tid = tidx(), lane = tid & 63, wave = tid >> 6, fr = lane & 15, fq = lane >> 4;
  const bf16_t* zn = (const bf16_t*)(p.ws + WS_ZN); bf16_t* ona = (bf16_t*)(p.ws + WS_ONA);
  const int qrow = b * 256 + qb * 64 + wave * 16 + fr;
  bf16x8 qf[2];
#pragma unroll
  for (int ks = 0; ks < 2; ++ks) qf[ks] = *(const bf16x8*)(zn + (size_t)qrow * NZN + h * 64 + ks * 32 + fq * 8);
  f32x4 o[4]; for (int dt = 0; dt < 4; ++dt) o[dt] = (f32x4){0.f, 0.f, 0.f, 0.f};
  float mrun = -1e30f, lrun = 0.f;
  u32x4 pk[2], pv[2];
#pragma unroll
  for (int i = 0; i < 2; ++i) { const int c = tid + 256 * i, key = c >> 3, part = c & 7, vkey = c & 63, vpart = c >> 6; pk[i] = *(const u32x4*)(zn + (size_t)(b * 256 + key) * NZN + h * 64 + part * 8 + 512); pv[i] = *(const u32x4*)(zn + (size_t)(b * 256 + vkey) * NZN + h * 64 + vpart * 8 + 1024); }
  for (int kt = 0; kt < 4; ++kt) {
    __syncthreads();
#pragma unroll
    for (int i = 0; i < 2; ++i) { const int c = tid + 256 * i, key = c >> 3, part = c & 7, vkey = c & 63, vpart = c >> 6; float vf[8]; unpack8(pv[i], vf);
      *(u32x4*)(sK + key * LDT + part * 8) = pk[i];
#pragma unroll
      for (int e = 0; e < 8; ++e) sVt[(vpart * 8 + e) * LDT + vkey] = f2bf(vf[e]); }
    __syncthreads();
    { const int kn = kt < 3 ? kt + 1 : 3;
#pragma unroll
      for (int i = 0; i < 2; ++i) { const int c = tid + 256 * i, key = c >> 3, part = c & 7, vkey = c & 63, vpart = c >> 6; pk[i] = *(const u32x4*)(zn + (size_t)(b * 256 + kn * 64 + key) * NZN + h * 64 + part * 8 + 512); pv[i] = *(const u32x4*)(zn + (size_t)(b * 256 + kn * 64 + vkey) * NZN + h * 64 + vpart * 8 + 1024); } }
    f32x4 sacc[4]; qk_scores(sK, qf, sacc, fr, fq);
#pragma unroll
    for (int nt = 0; nt < 4; ++nt) sacc[nt] *= (0.125f * LOG2E);
    softmax_tile(sacc, o, mrun, lrun);
    pv_accum(sVt, sacc, o, fr, fq);
  }
  lrun += shfl_x(lrun, 16); lrun += shfl_x(lrun, 32); const float inv = 1.f / lrun;
#pragma unroll
  for (int dt = 0; dt < 4; ++dt) { u32x2 ov; ov.x = pack2(o[dt][0] * inv, o[dt][1] * inv); ov.y = pack2(o[dt][2] * inv, o[dt][3] * inv); *(u32x2*)(ona + (size_t)qrow * LDO + h * 64 + dt * 16 + fq * 4) = ov; }
}

__device__ void na_task(const P& p, int l, int b, int h, int r, char* smem) {
  bf16_t* sK = (bf16_t*)smem; bf16_t* sVt = sK + 64 * LDT; float* sRpb = (float*)(sVt + 64 * LDT);
  const int tid = tidx(), lane = tid & 63, wave = tid >> 6, fr = lane & 15, fq = lane >> 4;
  const bf16_t* zn = (const bf16_t*)(p.ws + WS_ZN); bf16_t* ona = (bf16_t*)(p.ws + WS_ONA);
  const int base = MC + b * 1024, qcol = wave * 16 + fr, qrow = base + r * 64 + qcol;
  int rs = r - 4; rs = rs < 0 ? 0 : (rs > 8 ? 8 : rs);
  int cs = qcol - 8; cs = cs < 0 ? 0 : (cs > 48 ? 48 : cs);
  __syncthreads();
  for (int e = tid; e < 465; e += NT) sRpb[e] = p.na_rpb[((size_t)l * 8 + h) * 465 + e] * LOG2E;
  bf16x8 qf[2];
#pragma unroll
  for (int ks = 0; ks < 2; ++ks) qf[ks] = *(const bf16x8*)(zn + (size_t)qrow * NZN + h * 64 + ks * 32 + fq * 8);
  f32x4 o[4]; for (int dt = 0; dt < 4; ++dt) o[dt] = (f32x4){0.f, 0.f, 0.f, 0.f};
  float mrun = -1e30f, lrun = 0.f;
  u32x4 pre[8];
#define NA_ISSUE(KT) do { const int kt_ = (KT); \
    if (kt_ < 8) { _Pragma("unroll") for (int i = 0; i < 2; ++i) { const int c = tid + 256 * i, key = c >> 3, part = c & 7, vkey = c & 63, vpart = c >> 6; \
        pre[4 * i] = *(const u32x4*)(zn + (size_t)(base + (rs + kt_) * 64 + key) * NZN + h * 64 + part * 8 + 512); pre[4 * i + 1] = *(const u32x4*)(zn + (size_t)(base + (rs + kt_) * 64 + vkey) * NZN + h * 64 + vpart * 8 + 1024); } } \
    else { _Pragma("unroll") for (int i = 0; i < 2; ++i) { const int c = tid + 256 * i, key = c >> 3, part = c & 7, vkey = c & 63, vpart = c >> 6; const size_t cb_ = (((size_t)b * 2 + l) * 8 + h) * 256 + (kt_ - 8) * 64; const size_t co = (cb_ + key) * 64 + part * 8, cv = (cb_ + vkey) * 64 + vpart * 8; \
        pre[4 * i] = *(const u32x4*)(p.cache_k + co); pre[4 * i + 1] = *(const u32x4*)(p.cache_k + co + 4); pre[4 * i + 2] = *(const u32x4*)(p.cache_v + cv); pre[4 * i + 3] = *(const u32x4*)(p.cache_v + cv + 4); } } } while (0)
  NA_ISSUE(0);
  for (int kt = 0; kt < 12; ++kt) {
    __syncthreads();
    if (kt < 8) {
#pragma unroll
      for (int i = 0; i < 2; ++i) { const int c = tid + 256 * i, key = c >> 3, part = c & 7, vkey = c & 63, vpart = c >> 6; float vf[8]; unpack8(pre[4 * i + 1], vf);
        *(u32x4*)(sK + key * LDT + part * 8) = pre[4 * i];
#pragma unroll
        for (int e = 0; e < 8; ++e) sVt[(vpart * 8 + e) * LDT + vkey] = f2bf(vf[e]); }
    } else {
#pragma unroll
      for (int i = 0; i < 2; ++i) { const int c = tid + 256 * i, key = c >> 3, part = c & 7, vkey = c & 63, vpart = c >> 6;
        const f32x4 k0 = __builtin_bit_cast(f32x4, pre[4 * i]), k1 = __builtin_bit_cast(f32x4, pre[4 * i + 1]), v0 = __builtin_bit_cast(f32x4, pre[4 * i + 2]), v1 = __builtin_bit_cast(f32x4, pre[4 * i + 3]);
        const float kf[8] = {k0[0], k0[1], k0[2], k0[3], k1[0], k1[1], k1[2], k1[3]}; const float vf[8] = {v0[0], v0[1], v0[2], v0[3], v1[0], v1[1], v1[2], v1[3]};
        put_kv(sK, sVt, key, part, kf, vkey, vpart, vf); }
    }
    __syncthreads();
    NA_ISSUE(kt < 11 ? kt + 1 : 11);
    f32x4 sacc[4]; qk_scores(sK, qf, sacc, fr, fq);
    if (kt < 8) { const int dr = rs + kt - r + 7;
#pragma unroll
      for (int nt = 0; nt < 4; ++nt)
#pragma unroll
        for (int j = 0; j < 4; ++j) { const int kc = nt * 16 + fq * 4 + j; const bool valid = kc >= cs && kc < cs + 16; int dc = kc - qcol; dc = dc < -15 ? -15 : (dc > 15 ? 15 : dc);
          sacc[nt][j] = valid ? sacc[nt][j] * (0.125f * LOG2E) + sRpb[dr * 31 + dc + 15] : -1e30f; }
    } else {
#pragma unroll
      for (int nt = 0; nt < 4; ++nt) sacc[nt] *= (0.125f * LOG2E);
    }
    softmax_tile(sacc, o, mrun, lrun);
    pv_accum(sVt, sacc, o, fr, fq);
  }
#undef NA_ISSUE
  lrun += shfl_x(lrun, 16); lrun += shfl_x(lrun, 32); const float inv = 1.f / lrun;
#pragma unroll
  for (int dt = 0; dt < 4; ++dt) { u32x2 ov; ov.x = pack2(o[dt][0] * inv, o[dt][1] * inv); ov.y = pack2(o[dt][2] * inv, o[dt][3] * inv); *(u32x2*)(ona + (size_t)qrow * LDO + h * 64 + dt * 16 + fq * 4) = ov; }
}

DI void rope8(const float (&own)[8], const float (&par)[8], int part, int n, float (&out)[8]) {
  const float pos = (float)((part >> 2) ? (n & 63) : (n >> 6));
  const bool isx2 = (part & 3) >= 2;
#pragma unroll
  for (int e = 0; e < 8; ++e) { const int i = (part & 1) * 8 + e; const float ang = pos * __builtin_amdgcn_exp2f(-(float)i * 0.830482023721841f); const float sn = __sinf(ang), cs = __cosf(ang);
    out[e] = isx2 ? par[e] * sn + own[e] * cs : own[e] * cs - par[e] * sn; }
}

__device__ void ret_task(const P& p, int l, int seq, int h, int qb, char* smem) {
  bf16_t* sK = (bf16_t*)smem; bf16_t* sVt = sK + 64 * LDT; bf16_t* sQ = sVt + 64 * LDT;
  const int tid = tidx(), lane = tid & 63, wave = tid >> 6, fr = lane & 15, fq = lane >> 4;
  const bf16_t* zt = (const bf16_t*)(p.ws + WS_ZT); bf16_t* oret = (bf16_t*)(p.ws + WS_ORET);
  const bool lat = seq >= 32;
  const int row0 = lat ? MC + (seq - 32) * 1024 : seq * 256, T = lat ? 1024 : 256, nkt = T >> 6;
  const float xf = p.ret_decay[(l * 2 + 0) * 8 + h], xb = p.ret_decay[(l * 2 + 1) * 8 + h];
  const float lgf = -log1pf(__expf(-xf)) * LOG2E, lgb = -log1pf(__expf(-xb)) * LOG2E;
  __syncthreads();
#pragma unroll
  for (int i = 0; i < 2; ++i) { const int c = tid + 256 * i, qi = c >> 3, part = c & 7; const int n = qb * 64 + qi; const size_t ro = (size_t)(row0 + n) * LZT + h * 64;
    const u32x4 own = *(const u32x4*)(zt + ro + part * 8);
    if (lat) { const u32x4 par = *(const u32x4*)(zt + ro + (part ^ 2) * 8); float fo[8], fp[8], out[8]; unpack8(own, fo); unpack8(par, fp); rope8(fo, fp, part, n, out); *(u32x4*)(sQ + qi * LDT + part * 8) = pack8(out); }
    else *(u32x4*)(sQ + qi * LDT + part * 8) = own; }
  __syncthreads();
  const int qi = wave * 16 + fr, nq = qb * 64 + qi;
  bf16x8 qf[2];
#pragma unroll
  for (int ks = 0; ks < 2; ++ks) qf[ks] = *(const bf16x8*)(sQ + qi * LDT + ks * 32 + fq * 8);
  f32x4 o[4]; for (int dt = 0; dt < 4; ++dt) o[dt] = (f32x4){0.f, 0.f, 0.f, 0.f};
  u32x4 rk[2], rp[2], rv[2];
#define RET_ISSUE(KT) do { _Pragma("unroll") for (int i = 0; i < 2; ++i) { const int c = tid + 256 * i, key = c >> 3, part = c & 7, vkey = c & 63, vpart = c >> 6; const size_t ro = (size_t)(row0 + (KT) * 64 + key) * LZT + h * 64; \
    rk[i] = *(const u32x4*)(zt + ro + 512 + part * 8); rp[i] = *(const u32x4*)(zt + ro + 512 + (part ^ 2) * 8); rv[i] = *(const u32x4*)(zt + (size_t)(row0 + (KT) * 64 + vkey) * LZT + h * 64 + 1024 + vpart * 8); } } while (0)
  RET_ISSUE(0);
  for (int kt = 0; kt < nkt; ++kt) {
    __syncthreads();
#pragma unroll
    for (int i = 0; i < 2; ++i) { const int c = tid + 256 * i, key = c >> 3, part = c & 7, vkey = c & 63, vpart = c >> 6; const int n = kt * 64 + key;
      float kf[8], vf[8]; unpack8(rk[i], kf); unpack8(rv[i], vf);
      if (lat) { float fp[8], out[8]; unpack8(rp[i], fp); rope8(kf, fp, part, n, out);
#pragma unroll
        for (int e = 0; e < 8; ++e) kf[e] = out[e]; }
#pragma unroll
      for (int e = 0; e < 8; ++e) kf[e] *= 0.125f;
      put_kv(sK, sVt, key, part, kf, vkey, vpart, vf); }
    __syncthreads();
    RET_ISSUE(kt + 1 < nkt ? kt + 1 : kt);
    f32x4 sacc[4]; qk_scores(sK, qf, sacc, fr, fq);
#pragma unroll
    for (int nt = 0; nt < 4; ++nt)
#pragma unroll
      for (int j = 0; j < 4; ++j) { const int mk = kt * 64 + nt * 16 + fq * 4 + j; const int df = nq - mk;
        const float ex = __builtin_amdgcn_exp2f((df > 0 ? lgf : -lgb) * (float)df); sacc[nt][j] *= (df == 0 ? 2.f : ex); }
    pv_accum(sVt, sacc, o, fr, fq);
  }
#undef RET_ISSUE
  if (lat) {
    for (int dir = 0; dir < 2; ++dir) {
      __syncthreads();
      const float* s0 = p.state_ret + ((((size_t)(seq - 32) * 2 + l) * 2 + dir) * 8 + h) * 4096;
#pragma unroll
      for (int i = 0; i < 2; ++i) { const int c = tid + 256 * i, dk = c & 63, part = c >> 6; const float4 a = *(const float4*)(s0 + dk * 64 + part * 8), bq = *(const float4*)(s0 + dk * 64 + part * 8 + 4);
        const float vf[8] = {a.x, a.y, a.z, a.w, bq.x, bq.y, bq.z, bq.w};
#pragma unroll
        for (int e = 0; e < 8; ++e) sVt[(part * 8 + e) * LDT + dk] = f2bf(vf[e]); }
      __syncthreads();
      const float xi = dir == 0 ? exp2f(lgf * (float)(nq + 1)) : exp2f(lgb * (float)(T - nq));
      f32x4 pacc[4];
#pragma unroll
      for (int s = 0; s < 2; ++s)
#pragma unroll
        for (int hh = 0; hh < 2; ++hh)
#pragma unroll
          for (int j = 0; j < 4; ++j) pacc[2 * s + hh][j] = xi * bf2f(sQ[qi * LDT + 32 * s + 16 * hh + 4 * fq + j]);
      pv_accum(sVt, pacc, o, fr, fq);
    }
  }
  float s1 = 0.f;
#pragma unroll
  for (int dt = 0; dt < 4; ++dt)
#pragma unroll
    for (int j = 0; j < 4; ++j) s1 += o[dt][j];
  s1 += shfl_x(s1, 16); s1 += shfl_x(s1, 32); const float mu = s1 * (1.f / 64.f);
  float s2 = 0.f;
#pragma unroll
  for (int dt = 0; dt < 4; ++dt)
#pragma unroll
    for (int j = 0; j < 4; ++j) { const float dlt = o[dt][j] - mu; s2 += dlt * dlt; }
  s2 += shfl_x(s2, 16); s2 += shfl_x(s2, 32); const float rstd = rsqrtf(s2 * (1.f / 64.f) + 1e-5f);
  const size_t qrow = (size_t)(row0 + nq);
#pragma unroll
  for (int dt = 0; dt < 4; ++dt) { const int dv = h * 64 + dt * 16 + fq * 4; const u32x2 gr = *(const u32x2*)(zt + qrow * LZT + 1536 + dv); const float4 gn = *(const float4*)(p.ret_gn + l * 512 + dv);
    const float g0 = bflo(gr.x), g1 = bfhi(gr.x), g2 = bflo(gr.y), g3 = bfhi(gr.y);
    u32x2 ov; ov.x = pack2((o[dt][0] - mu) * rstd * gn.x * g0 * sigmoidf_(g0), (o[dt][1] - mu) * rstd * gn.y * g1 * sigmoidf_(g1));
    ov.y = pack2((o[dt][2] - mu) * rstd * gn.z * g2 * sigmoidf_(g2), (o[dt][3] - mu) * rstd * gn.w * g3 * sigmoidf_(g3));
    *(u32x2*)(oret + qrow * LDO + dv) = ov; }
}

__device__ void retstate_task(const P& p, int l, int b, int h, char* smem) {
  float* sKf = (float*)smem; float* sKb = sKf + 64 * 64; float* sV = sKb + 64 * 64;
  const int tid = tidx(), dk = tid >> 2, dq = tid & 3;
  const bf16_t* zt = (const bf16_t*)(p.ws + WS_ZT);
  const float xf = p.ret_decay[(l * 2 + 0) * 8 + h], xb = p.ret_decay[(l * 2 + 1) * 8 + h];
  const float lgf = -log1pf(__expf(-xf)) * LOG2E, lgb = -log1pf(__expf(-xb)) * LOG2E;
  float af[16], ab[16];
#pragma unroll
  for (int i = 0; i < 16; ++i) { af[i] = 0.f; ab[i] = 0.f; }
  for (int kt = 0; kt < 4; ++kt) {
    __syncthreads();
#pragma unroll
    for (int i = 0; i < 2; ++i) { const int c = tid + 256 * i, key = c >> 3, part = c & 7, m = kt * 64 + key; const size_t ro = (size_t)(b * 256 + m) * LZT + h * 64 + part * 8;
      float kf[8], vf[8]; unpack8(*(const u32x4*)(zt + ro + 512), kf); unpack8(*(const u32x4*)(zt + ro + 1024), vf);
      const float wf = 0.125f * exp2f(lgf * (float)(255 - m)), wb = 0.125f * exp2f(lgb * (float)m);
#pragma unroll
      for (int e = 0; e < 8; ++e) { sKf[key * 64 + part * 8 + e] = kf[e] * wf; sKb[key * 64 + part * 8 + e] = kf[e] * wb; sV[key * 64 + part * 8 + e] = vf[e]; } }
    __syncthreads();
    for (int m = 0; m < 64; ++m) { const float kf = sKf[m * 64 + dk], kb = sKb[m * 64 + dk];
#pragma unroll
      for (int i = 0; i < 4; ++i) { const f32x4 vv = *(const f32x4*)(sV + m * 64 + dq * 16 + i * 4);
#pragma unroll
        for (int j = 0; j < 4; ++j) { af[i * 4 + j] += kf * vv[j]; ab[i * 4 + j] += kb * vv[j]; } } }
  }
  float* of = p.out + O_RT + ((((size_t)b * 2 + l) * 2 + 0) * 8 + h) * 4096 + dk * 64 + dq * 16; float* ob = of + 8 * 4096;
#pragma unroll
  for (int i = 0; i < 16; ++i) { of[i] = af[i]; ob[i] = ab[i]; }
}

constexpr int Q_SCAN_L = 64, Q_SCAN_C = 512, Q_RET_L = 256, Q_NA = 256, Q_DENSE = 512, Q_RET_C = 512, Q_RST = 128;
template <int QMASK> __device__ void phase_mixers(const P& p, int l, char* smem_, int rep = 0) {
  __shared__ int s_task;
  int* ctr = (int*)(p.ws + WS_CTRL) + 64 * (l + 1) + 4 * rep;
  const int vb = vhalf(); char* smem = smem_ + vb * VSMEM;
  if (QMASK & 1) for (;;) {
    __syncthreads();
    if (ptid() == 0) s_task = atomicAdd(ctr, 1);
    __syncthreads();
    const int tk = s_task;
    if (tk >= Q_SCAN_L + Q_SCAN_C) break;
    const bool lat = tk < Q_SCAN_L; const int t2 = lat ? tk : tk - Q_SCAN_L;
    scan_task(p, l, (lat ? 32 : 0) + (t2 >> 4), (t2 >> 1) & 7, t2 & 1, vb, smem);
  }
  if (QMASK & 2) for (;;) {
    __syncthreads();
    if (ptid() == 0) s_task = atomicAdd(ctr + 16, 1);
    __syncthreads();
    const int tk = s_task;
    if (tk >= Q_RET_L + Q_RET_C) break;
    if (tk < Q_RET_L) ret_task(p, l, 32 + (tk >> 6), (tk >> 3) & 7, (tk & 7) * 2 + vb, smem);
    else { const int t2 = tk - Q_RET_L; ret_task(p, l, t2 >> 4, (t2 >> 1) & 7, (t2 & 1) * 2 + vb, smem); }
  }
  if (QMASK & 4) for (;;) {
    __syncthreads();
    if (ptid() == 0) s_task = atomicAdd(ctr + 32, 1);
    __syncthreads();
    int tk = s_task;
    if (tk >= Q_NA + Q_DENSE + Q_RST) break;
    if (tk < Q_NA) { na_task(p, l, tk >> 6, (tk >> 3) & 7, (tk & 7) * 2 + vb, smem); continue; } tk -= Q_NA;
    if (tk < Q_DENSE) { dense_task(p, tk >> 4, (tk >> 1) & 7, (tk & 1) * 2 + vb, smem); continue; } tk -= Q_DENSE;
    retstate_task(p, l, tk >> 2, (tk & 3) * 2 + vb, smem);
  }
}

__device__ void phase_rwkv_post(const P& p, int l, char* smem) {
  const bf16_t* zr = (const bf16_t*)(p.ws + WS_ZR); const float* yf = (const float*)(p.ws + WS_Y); const float* yb = yf + (size_t)MT * 512; bf16_t* oa = (bf16_t*)(p.ws + WS_OA);
  const bf16_t* Gt = (const bf16_t*)(p.ws + WS_WG);
  const int tid = ptid(), lane = tid & 63, wave = tid >> 6, wr = wave >> 2, wc = wave & 3, fr = lane & 15, fq = lane >> 4;
  TileIter ti; int mt, nt; ti.init(96, 2);
  while (ti.next(mt, nt)) {
    const int row0 = mt * 128, n0 = nt * 256;
    f32x4 acc[4][4]; zero_acc<4, 4>(acc);
    TileSrc s{zr + 1664, NZR, row0, Gt, LDG, n0, n0 + 128, 128}; { Gemm<4, 4, 1> gm; gm.begin(s, true); gm.run(acc, smem); }
    const int cb = n0 + wc * 64 + fq * 8;
#pragma unroll
    for (int m = 0; m < 4; ++m) { const size_t row = (size_t)(row0 + wr * 64 + m * 16 + fr);
      f32x4 y[4]; float s1 = 0.f, rk = 0.f; f32x4 vv[4];
#pragma unroll
      for (int n = 0; n < 4; ++n) { const int c = cb + 32 * (n >> 1) + 4 * (n & 1); y[n] = *(const f32x4*)(yf + row * 512 + c) + *(const f32x4*)(yb + row * 512 + c); s1 += y[n][0] + y[n][1] + y[n][2] + y[n][3];
        const u32x2 rr = *(const u32x2*)(zr + row * NZR + c), kk = *(const u32x2*)(zr + row * NZR + 512 + c), v2 = *(const u32x2*)(zr + row * NZR + 1024 + c); const f32x4 rkw = *(const f32x4*)(p.rwkv_r_k + l * 512 + c);
        rk += bflo(rr.x) * bflo(kk.x) * rkw[0] + bfhi(rr.x) * bfhi(kk.x) * rkw[1] + bflo(rr.y) * bflo(kk.y) * rkw[2] + bfhi(rr.y) * bfhi(kk.y) * rkw[3];
        vv[n] = (f32x4){bflo(v2.x), bfhi(v2.x), bflo(v2.y), bfhi(v2.y)}; }
      s1 += shfl_x(s1, 16); s1 += shfl_x(s1, 32); rk += shfl_x(rk, 16); rk += shfl_x(rk, 32);
      const float mu = s1 * (1.f / 64.f); float s2 = 0.f;
#pragma unroll
      for (int n = 0; n < 4; ++n)
#pragma unroll
        for (int j = 0; j < 4; ++j) { const float dl = y[n][j] - mu; s2 += dl * dl; }
      s2 += shfl_x(s2, 16); s2 += shfl_x(s2, 32); const float rstd = rsqrtf(s2 * (1.f / 64.f) + 64e-5f);
#pragma unroll
      for (int n = 0; n < 4; ++n) { const int c = cb + 32 * (n >> 1) + 4 * (n & 1); const f32x4 lg = *(const f32x4*)(p.rwkv_ln_g + l * 512 + c), lb = *(const f32x4*)(p.rwkv_ln_b + l * 512 + c);
        float o[4];
#pragma unroll
        for (int j = 0; j < 4; ++j) o[j] = ((y[n][j] - mu) * rstd * lg[j] + lb[j] + rk * vv[n][j]) * acc[m][n][j];
        u32x2 ov; ov.x = pack2(o[0], o[1]); ov.y = pack2(o[2], o[3]); *(u32x2*)(oa + row * LDO + c) = ov; }
    }
  }
}

DI void convert_layer_a(const P& p, int l, char* smem) {
  convert_T(p.w_in + (size_t)l * D * INC, D, INC, (bf16_t*)(p.ws + WS_WIN), LDH, smem);
  convert_T(p.w_o_rwkv + (size_t)l * 512 * D, 512, D, (bf16_t*)(p.ws + WS_WO3), LDO, smem);
  convert_T(p.w_o_na + (size_t)l * 512 * D, 512, D, (bf16_t*)(p.ws + WS_WO3) + (size_t)1024 * LDO, LDO, smem);
  convert_T(p.w_o_ret + (size_t)l * 512 * D, 512, D, (bf16_t*)(p.ws + WS_WO3) + (size_t)2 * 1024 * LDO, LDO, smem);
  convert_T(p.w_out + (size_t)l * D * D, D, D, (bf16_t*)(p.ws + WS_WOUT), LDH, smem);
  convert_T(p.rwkv_g_up + (size_t)l * 128 * 512, 128, 512, (bf16_t*)(p.ws + WS_WG), LDG, smem);
}
DI void convert_layer_b(const P& p, int l, char* smem) {
  convert_T(p.ffn_up + (size_t)l * D * 2 * FF, D, 2 * FF, (bf16_t*)(p.ws + WS_WUP), LDH, smem);
  convert_T(p.ffn_down + (size_t)l * FF * D, FF, D, (bf16_t*)(p.ws + WS_WDN), FF, smem);
}

typedef __attribute__((address_space(4))) const P* KP;
DI KP kargs() { KP k = (KP)__builtin_amdgcn_kernarg_segment_ptr(); asm volatile("" : "+s"(k)); return k; }
template <int PH> DI void run_phase(int l, char* smem) {
#if defined(__HIP_DEVICE_COMPILE__)
  const P p = *kargs();
#else
  const P p{};
#endif
  const float* mod = (const float*)(p.ws + WS_MOD);
  float* xbuf = p.out;
  if (PH == 0) { ada_phase(p, smem); convert_layer_a(p, 0, smem); }
  else if (PH == 1) { norm_phase(p, nullptr, nullptr, nullptr, nullptr, 0, nullptr, p.norm_mix_pre, mod, 0, (bf16_t*)(p.ws + WS_H)); }
  else if (PH == 2) phase_win(p, l, smem);
  else if (PH == 4) phase_mixers<7>(p, l, smem);
  else if (PH == 5) phase_rwkv_post(p, l, smem);
  else if (PH == 6) phase_merge(p, smem);
  else if (PH == 7) { phase_gemm_f32((const bf16_t*)(p.ws + WS_MERGED), LDH, D, (const bf16_t*)(p.ws + WS_WOUT), LDH, (float*)(p.ws + WS_U), smem); }
  else if (PH == 8) { convert_layer_b(p, l, smem);
    norm_phase(p, l == 0 ? nullptr : xbuf, (const float*)(p.ws + WS_U), p.norm_mix_post + l * D, mod + (size_t)l * 5 * 6144, 2, xbuf, p.norm_ffn_pre + l * D, mod + (size_t)l * 5 * 6144, 3, (bf16_t*)(p.ws + WS_H)); }
  else if (PH == 9) phase_ffn_up(p, l, smem);
  else if (PH == 11) { phase_gemm_f32((const bf16_t*)(p.ws + WS_HID), FF, FF, (const bf16_t*)(p.ws + WS_WDN), FF, (float*)(p.ws + WS_F), smem); }
  else if (PH == 12) {
    if (l == 0) { norm_phase(p, xbuf, (const float*)(p.ws + WS_F), p.norm_ffn_post, mod, 5, xbuf, p.norm_mix_pre + D, mod + (size_t)5 * 6144, 0, (bf16_t*)(p.ws + WS_H)); convert_layer_a(p, 1, smem); }
    else norm_phase(p, xbuf, (const float*)(p.ws + WS_F), p.norm_ffn_post + D, mod + (size_t)5 * 6144, 5, xbuf, nullptr, nullptr, 0, nullptr);
  }
}

#if MEGA
__global__ void __launch_bounds__(NTP, 1) mega_kernel(P p_) {
  extern __shared__ __attribute__((aligned(16))) char smem[];
  __shared__ u32x4 xb_words;
  cg::grid_group grid = cg::this_grid();
  if (ptid() == 0) xb_words = (u32x4){0u, 0u, 0u, 0u};
  __syncthreads();
#if defined(__HIP_DEVICE_COMPILE__)
  (void)xcd_barrier_post((unsigned*)(p_.ws + WS_BAR), (volatile LAS unsigned*)&xb_words);
#define GSYNC() do { XcdBarrier xb_; xb_.bar = (unsigned*)(kargs()->ws + WS_BAR); xb_.x = xb_xcc_id(); xb_.st = (volatile LAS unsigned*)&xb_words; xcd_barrier(xb_); } while (0)
#else
#define GSYNC() do { } while (0)
#endif
  run_phase<0>(0, smem); grid.sync();
  run_phase<1>(0, smem); GSYNC();
#pragma unroll
  for (int l = 0; l < 2; ++l) {
    run_phase<2>(l, smem); GSYNC();
    if (PROBE_MASK & 1) { run_phase<2>(l, smem); GSYNC(); }
    run_phase<4>(l, smem); GSYNC();
    run_phase<5>(l, smem); GSYNC();
    run_phase<6>(l, smem); GSYNC();
    if (PROBE_MASK & 8) { run_phase<6>(l, smem); GSYNC(); }
    run_phase<7>(l, smem); GSYNC();
    if (PROBE_MASK & 16) { run_phase<7>(l, smem); GSYNC(); }
    run_phase<8>(l, smem); GSYNC();
    run_phase<9>(l, smem); GSYNC();
    if (PROBE_MASK & 32) { run_phase<9>(l, smem); GSYNC(); }
    run_phase<11>(l, smem); GSYNC();
    if (PROBE_MASK & 64) { run_phase<11>(l, smem); GSYNC(); }
    run_phase<12>(l, smem); if (l == 0) GSYNC();
  }
#undef GSYNC
}
#else
template <int PH> __global__ void __launch_bounds__(NTP, 1) phase_kernel(P p, int l) {
  extern __shared__ __attribute__((aligned(16))) char smem[];
  run_phase<PH>(l, smem);
}
#endif

extern "C" void kernel_launch(void* const* d_in, const int* in_sizes, int n_in, void* d_out, int out_size, void* d_ws, size_t ws_size, hipStream_t stream) {
  if (ws_size < WS_END || n_in < 36) { fprintf(stderr, "workspace too small: %zu < %zu\n", ws_size, (size_t)WS_END); return; }
  P p{};
  const float** pp = (const float**)&p;
  for (int i = 0; i < 36; ++i) pp[i] = (const float*)d_in[i];
  p.out = (float*)d_out; p.ws = (char*)d_ws;
  hipMemsetAsync(d_ws, 0, WS_WIN, stream);
#if MEGA
  static int grid_blocks = 0;
  if (!grid_blocks) {
    int dev = 0, cus = 0, per_cu = 0; hipGetDevice(&dev);
    hipDeviceGetAttribute(&cus, hipDeviceAttributeMultiprocessorCount, dev);
    hipFuncSetAttribute((const void*)mega_kernel, hipFuncAttributeMaxDynamicSharedMemorySize, SMEM_BYTES);
    hipOccupancyMaxActiveBlocksPerMultiprocessor(&per_cu, mega_kernel, NTP, SMEM_BYTES);
    if (per_cu > 1) per_cu = 1;
    grid_blocks = cus * per_cu;
  }
  void* args[] = {&p};
  hipError_t e = hipLaunchCooperativeKernel((void*)mega_kernel, dim3(grid_blocks), dim3(NTP), args, SMEM_BYTES, stream);
  if (e != hipSuccess) fprintf(stderr, "cooperative launch failed: %s (grid %d)\n", hipGetErrorString(e), grid_blocks);
#else
  const int G = 512;
#define LAUNCH(PH, L) do { hipFuncSetAttribute((const void*)phase_kernel<PH>, hipFuncAttributeMaxDynamicSharedMemorySize, SMEM_BYTES); phase_kernel<PH><<<G, NT, SMEM_BYTES, stream>>>(p, L); } while (0)
  LAUNCH(0, 0); LAUNCH(1, 0);
  for (int l = 0; l < 2; ++l) { LAUNCH(2, l); LAUNCH(4, l); LAUNCH(5, l); LAUNCH(6, l); LAUNCH(7, l); LAUNCH(8, l); LAUNCH(9, l); LAUNCH(11, l); LAUNCH(12, l); }
#endif
}
```

```cpp
#include <hip/hip_runtime.h>
#include <hip/hip_cooperative_groups.h>
#include <cstdio>
namespace cg = cooperative_groups;

#ifndef MEGA
#define MEGA 1
#endif
#define PROBE_MASK 0

typedef unsigned short bf16_t;
typedef short bf16x8 __attribute__((ext_vector_type(8)));
typedef short bf16x4 __attribute__((ext_vector_type(4)));
typedef float f32x4 __attribute__((ext_vector_type(4)));
typedef float f32x2 __attribute__((ext_vector_type(2)));
typedef unsigned u32x4 __attribute__((ext_vector_type(4)));
typedef unsigned u32x2 __attribute__((ext_vector_type(2)));
#define DI __device__ __forceinline__
#define MFMA16(a, b, c) __builtin_amdgcn_mfma_f32_16x16x32_bf16((a), (b), (c), 0, 0, 0)

constexpr int NT = 256;
constexpr int NTP = 512;
constexpr int VSMEM = 65536;
constexpr int D = 1024, MC = 8192, ML = 4096, MT = 12288;
constexpr int NZR = 1792, NZN = 1536, NZT = 2048, INC = 8448, FF = 2816;
constexpr int LDH = 1088, LDO = 576, LZT = 2112, LDG = 136;
constexpr int LDT = 72;
constexpr int SMEM_BYTES = 139264;
constexpr int SMEM_BYTES_GEMM_ = 131072;
constexpr size_t O_K = 12582912, O_V = 20971520, O_RW = 29360128, O_RT = 33554432;
constexpr size_t WS_CTRL = 0;
constexpr size_t WS_MOD = 4096;
constexpr size_t WS_BAR = 262144;
constexpr size_t WS_CUF = 278528;
constexpr size_t WS_WG = 294912;
constexpr size_t WS_WIN = 434176;
constexpr size_t WS_WUP = WS_WIN;
constexpr size_t WS_WDN = WS_WIN + (size_t)5632 * LDH * 2;
constexpr size_t WS_WO3 = WS_WIN + (size_t)INC * LDH * 2;
constexpr size_t WS_WOUT = WS_WO3 + (size_t)3 * 1024 * LDO * 2;
constexpr size_t WS_H = WS_WOUT + (size_t)1024 * LDH * 2;
constexpr size_t WS_Z = WS_H + (size_t)MT * LDH * 2;
constexpr size_t WS_ZR = WS_Z;
constexpr size_t WS_ZN = WS_ZR + (size_t)MT * NZR * 2;
constexpr size_t WS_ZT = WS_ZN + (size_t)MT * NZN * 2;
constexpr size_t WS_MERGED = WS_ZR;
constexpr size_t WS_OA = WS_ZN;
constexpr size_t WS_U = WS_ZT;
constexpr size_t WS_HID = WS_Z;
constexpr size_t WS_F = WS_ZT;
constexpr size_t WS_Y = WS_ZT + (size_t)MT * LZT * 2;
constexpr size_t WS_ONA = WS_Y + (size_t)2 * MT * 512 * 4;
constexpr size_t WS_ORET = WS_ONA + (size_t)MT * LDO * 2;
constexpr size_t WS_END = WS_ORET + (size_t)MT * LDO * 2;

struct P {
  const float *x_prompt, *x_sample, *cache_k, *cache_v, *state_rwkv, *state_ret, *c, *c_ctx, *ada_w, *ada_b;
  const float *norm_mix_pre, *norm_mix_post, *norm_ffn_pre, *norm_ffn_post, *w_in, *rwkv_conv, *rwkv_w0, *rwkv_w_up, *rwkv_a0, *rwkv_a_up, *rwkv_g_up;
  const float *rwkv_k_k, *rwkv_k_a, *rwkv_r_k, *rwkv_ln_g, *rwkv_ln_b, *na_rpb, *ret_decay, *ret_gn, *w_o_rwkv, *w_o_na, *w_o_ret, *w_out, *ffn_up, *ffn_conv, *ffn_down;
  float* out; char* ws;
};

DI int threadIdx_x_raw() { return (int)__builtin_amdgcn_workitem_id_x(); }
DI int ptid() { int t = threadIdx_x_raw(); asm volatile("" : "+v"(t)); return t; }
DI int tidx() { return ptid() & 255; }
DI int vhalf() { return ptid() >> 8; }
DI int vblk() { return (int)blockIdx.x * 2 + vhalf(); }
DI int vgrid() { return (int)gridDim.x * 2; }
DI unsigned cvt_pk_bf16(float lo, float hi) { unsigned r; asm("v_cvt_pk_bf16_f32 %0, %1, %2" : "=v"(r) : "v"(lo), "v"(hi)); return r; }
DI bf16_t f2bf(float x) { return (bf16_t)(cvt_pk_bf16(x, 0.f) & 0xffffu); }
DI float bf2f(bf16_t b) { return __uint_as_float(((unsigned)b) << 16); }
DI unsigned pack2(float a, float b) { return cvt_pk_bf16(a, b); }
DI float bflo(unsigned u) { return __uint_as_float(u << 16); }
DI float bfhi(unsigned u) { return __uint_as_float(u & 0xffff0000u); }
DI void unpack8(const u32x4 r, float (&f)[8]) { f[0] = bflo(r[0]); f[1] = bfhi(r[0]); f[2] = bflo(r[1]); f[3] = bfhi(r[1]); f[4] = bflo(r[2]); f[5] = bfhi(r[2]); f[6] = bflo(r[3]); f[7] = bfhi(r[3]); }
DI u32x4 pack8(const float (&f)[8]) { u32x4 r; r[0] = pack2(f[0], f[1]); r[1] = pack2(f[2], f[3]); r[2] = pack2(f[4], f[5]); r[3] = pack2(f[6], f[7]); return r; }
DI float sigmoidf_(float x) { return __builtin_amdgcn_rcpf(1.f + __expf(-x)); }
DI float shfl_x(float v, int m) { const int lane = ptid() & 63; return __int_as_float(__builtin_amdgcn_ds_bpermute((lane ^ m) << 2, __float_as_int(v))); }
DI float wave_sum(float v) { for (int o = 32; o > 0; o >>= 1) v += shfl_x(v, o); return v; }
DI void tokinfo(int m, int& t, int& T, int& mi) { if (m < MC) { t = m & 255; T = 256; mi = 0; } else { int q = m - MC; t = q & 1023; T = 1024; mi = 1 + (q >> 10); } }

#define XB_TMO      128
#define XB_XCNT(j)  (256  + 64 * (j))
#define XB_XSUB(j)  (1280 + 64 * (j))
#define XB_XGEN(j)  (2304 + 64 * (j))
#define XB_TOP      3328
#define XB_TOPGEN   3392
#define XB_SPIN_CAP (1u << 20)
#define LAS __attribute__((address_space(3)))
DI unsigned xb_ld(unsigned* p) { return __hip_atomic_load(p, __ATOMIC_RELAXED, __HIP_MEMORY_SCOPE_AGENT); }
DI unsigned xb_add(unsigned* p, unsigned v) { return __hip_atomic_fetch_add(p, v, __ATOMIC_RELAXED, __HIP_MEMORY_SCOPE_AGENT); }
DI unsigned xb_xcc_id() { return (unsigned)__builtin_amdgcn_s_getreg((3 << 11) | 20) & 0xFu; }
#define XB_SPIN(cond, bar) do { unsigned _sp = 0; while (cond) { __builtin_amdgcn_s_sleep(1); \
    if ((++_sp & 255u) == 0u) { if (xb_ld(&(bar)[XB_TMO])) break; if (_sp > XB_SPIN_CAP) { atomicAdd(&(bar)[XB_TMO], 1u); break; } } } } while (0)
struct XcdBarrier { unsigned* bar; unsigned x; volatile LAS unsigned* st; };
DI XcdBarrier xcd_barrier_post(unsigned* bar, volatile LAS unsigned* st) {
  XcdBarrier b; b.bar = bar; b.x = xb_xcc_id(); b.st = st;
  if (ptid() == 0) (void)xb_add(&bar[XB_XCNT(b.x)], 1u);
  return b;
}
DI void xcd_barrier_complete(unsigned* bar, unsigned x, unsigned& nloc, unsigned& nx) {
  const unsigned G = gridDim.x * gridDim.y * gridDim.z;
  unsigned sum, cnt, mine, sp = 0u;
  for (;;) {
    sum = 0u; cnt = 0u; mine = 0u;
#pragma unroll
    for (unsigned j = 0; j < 16; ++j) { const unsigned c = xb_ld(&bar[XB_XCNT(j)]); sum += c; cnt += (c > 0u) ? 1u : 0u; mine = (j == x) ? c : mine; }
    if (sum == G) break;
    __builtin_amdgcn_s_sleep(1);
    if ((++sp & 255u) == 0u) { if (xb_ld(&bar[XB_TMO])) break; if (sp > XB_SPIN_CAP) { atomicAdd(&bar[XB_TMO], 1u); break; } }
  }
  nloc = mine > 0u ? mine : 1u; nx = cnt > 0u ? cnt : 1u;
}
DI void xcd_barrier(const XcdBarrier& b) {
  asm volatile("s_waitcnt vmcnt(0)" ::: "memory");
  __syncthreads();
  if (ptid() == 0) {
    unsigned* bar = b.bar;
    __builtin_amdgcn_s_waitcnt(0);
    unsigned nloc = b.st[0], nx = b.st[1];
    if (nloc == 0u) { xcd_barrier_complete(bar, b.x, nloc, nx); b.st[0] = nloc; b.st[1] = nx; }
    const unsigned old = xb_add(&bar[XB_XSUB(b.x)], 1u);
    const unsigned gen = old / nloc;
    if (old + 1u == (gen + 1u) * nloc) {
      __builtin_amdgcn_fence(__ATOMIC_RELEASE, "agent");
      asm volatile("s_waitcnt vmcnt(0)" ::: "memory");
      const unsigned og = xb_add(&bar[XB_TOP], 1u);
      const unsigned tg = og / nx;
      if (og + 1u == (tg + 1u) * nx) xb_add(&bar[XB_TOPGEN], 1u);
      else XB_SPIN(xb_ld(&bar[XB_TOPGEN]) == tg, bar);
      __builtin_amdgcn_fence(__ATOMIC_ACQUIRE, "agent");
      xb_add(&bar[XB_XGEN(b.x)], 1u);
      asm volatile("s_waitcnt vmcnt(0)" ::: "memory");
    } else {
      XB_SPIN(xb_ld(&bar[XB_XGEN(b.x)]) == gen, bar);
      __builtin_amdgcn_fence(__ATOMIC_ACQUIRE, "agent");
      asm volatile("s_waitcnt vmcnt(0)" ::: "memory");
    }
  }
  __syncthreads();
}

__device__ void convert_T(const float* __restrict__ W, int K, int N, bf16_t* __restrict__ Wt, int ldt, char* smem) {
  float* t = (float*)(smem + vhalf() * VSMEM);
  const int tid = tidx(), ntn = N >> 6, nitems = (K >> 6) * ntn;
  const int kr = tid >> 4, c4 = (tid & 15) * 4;
  f32x4 v[4];
  { const int it = vblk() < nitems ? vblk() : 0; const int k0 = (it / ntn) << 6, n0 = (it % ntn) << 6;
#pragma unroll
    for (int i = 0; i < 4; ++i) v[i] = *(const f32x4*)(W + (size_t)(k0 + kr + 16 * i) * N + n0 + c4); }
  for (int it = vblk(); it < nitems; it += vgrid()) {
    const int k0 = (it / ntn) << 6, n0 = (it % ntn) << 6;
    __syncthreads();
#pragma unroll
    for (int i = 0; i < 4; ++i) { const int k = kr + 16 * i; t[k * 65 + c4] = v[i][0]; t[k * 65 + c4 + 1] = v[i][1]; t[k * 65 + c4 + 2] = v[i][2]; t[k * 65 + c4 + 3] = v[i][3]; }
    __syncthreads();
    { const int itn = it + vgrid() < nitems ? it + vgrid() : it; const int k1 = (itn / ntn) << 6, n1 = (itn % ntn) << 6;
#pragma unroll
      for (int i = 0; i < 4; ++i) v[i] = *(const f32x4*)(W + (size_t)(k1 + kr + 16 * i) * N + n1 + c4); }
#pragma unroll
    for (int i = 0; i < 2; ++i) { const int c = tid + 256 * i, n = c >> 3, kc = c & 7; float f[8];
#pragma unroll
      for (int e = 0; e < 8; ++e) f[e] = t[(kc * 8 + e) * 65 + n];
      *(u32x4*)(Wt + (size_t)(n0 + n) * ldt + k0 + kc * 8) = pack8(f); }
  }
}

__device__ void ada_phase(const P& p, char* smem) {
  float* sc = (float*)(smem + vhalf() * VSMEM);
  float* red = sc + 640;
  float* mod = (float*)(p.ws + WS_MOD);
  const int tid = tidx(), kq = tid >> 5, cq = tid & 31;
  for (int it = vblk(); it < 2 * 48 * 8; it += vgrid()) {
    const int l = it / 384, rem = it % 384, nb = rem >> 3, ks = rem & 7;
    const int n0 = nb * 128, k0 = ks * 128;
    __syncthreads();
    for (int e = tid; e < 640; e += NT) { const int i = e >> 7, k = e & 127; const float v = (i == 0) ? p.c_ctx[k0 + k] : p.c[(i - 1) * D + k0 + k]; sc[e] = v * sigmoidf_(v); }
    __syncthreads();
    float acc[5][4];
#pragma unroll
    for (int i = 0; i < 5; ++i)
#pragma unroll
      for (int j = 0; j < 4; ++j) acc[i][j] = 0.f;
    const float* wp = p.ada_w + ((size_t)l * D + k0 + kq * 16) * 6144 + n0 + cq * 4;
#pragma unroll 4
    for (int kk = 0; kk < 16; ++kk) { const float4 w = *(const float4*)(wp + (size_t)kk * 6144);
#pragma unroll
      for (int i = 0; i < 5; ++i) { const float s = sc[i * 128 + kq * 16 + kk]; acc[i][0] += s * w.x; acc[i][1] += s * w.y; acc[i][2] += s * w.z; acc[i][3] += s * w.w; } }
#pragma unroll
    for (int i = 0; i < 5; ++i)
#pragma unroll
      for (int j = 0; j < 4; ++j) red[(kq * 5 + i) * 128 + cq * 4 + j] = acc[i][j];
    __syncthreads();
    for (int e = tid; e < 640; e += NT) { const int i = e >> 7, n = e & 127; float s = 0.f;
#pragma unroll
      for (int q = 0; q < 8; ++q) s += red[(q * 5 + i) * 128 + n];
      if (ks == 0) s += p.ada_b[l * 6144 + n0 + n];
      atomicAdd(mod + ((size_t)l * 5 + i) * 6144 + n0 + n, s); }
  }
}

__device__ void norm_phase(const P& p, const float* xin  , const float* u, const float* gpost, const float* modU, int gate_idx,
                           float* xout, const float* gpre, const float* modN, int shift_idx, bf16_t* hout) {
  const int lane = tidx() & 63, wave = tidx() >> 6, nw = NT / 64;
  for (int m = vblk() * nw + wave; m < MT; m += vgrid() * nw) {
    int t, T, mi; tokinfo(m, t, T, mi);
    const float* xr = xin ? xin + (size_t)m * D : (m < MC ? p.x_prompt + (size_t)m * D : p.x_sample + (size_t)(m - MC) * D);
    float4 x[4];
#pragma unroll
    for (int i = 0; i < 4; ++i) x[i] = *(const float4*)(xr + i * 256 + lane * 4);
    if (u) {
      float4 uu[4]; float ss = 0.f;
#pragma unroll
      for (int i = 0; i < 4; ++i) { uu[i] = *(const float4*)(u + (size_t)m * D + i * 256 + lane * 4); ss += uu[i].x * uu[i].x + uu[i].y * uu[i].y + uu[i].z * uu[i].z + uu[i].w * uu[i].w; }
      ss = wave_sum(ss); const float rs = rsqrtf(ss * (1.f / D) + 1e-6f);
#pragma unroll
      for (int i = 0; i < 4; ++i) { const int c = i * 256 + lane * 4; const float4 g = *(const float4*)(gpost + c); const float4 ga = *(const float4*)(modU + ((size_t)mi * 6 + gate_idx) * D + c);
        x[i].x += ga.x * uu[i].x * rs * g.x; x[i].y += ga.y * uu[i].y * rs * g.y; x[i].z += ga.z * uu[i].z * rs * g.z; x[i].w += ga.w * uu[i].w * rs * g.w; }
    }
    if (xout) {
#pragma unroll
      for (int i = 0; i < 4; ++i) *(float4*)(xout + (size_t)m * D + i * 256 + lane * 4) = x[i];
    }
    if (hout) {
      float ss = 0.f;
#pragma unroll
      for (int i = 0; i < 4; ++i) ss += x[i].x * x[i].x + x[i].y * x[i].y + x[i].z * x[i].z + x[i].w * x[i].w;
      ss = wave_sum(ss); const float rs = rsqrtf(ss * (1.f / D) + 1e-6f);
#pragma unroll
      for (int i = 0; i < 4; ++i) { const int c = i * 256 + lane * 4; const float4 g = *(const float4*)(gpre + c);
        const float4 sh = *(const float4*)(modN + ((size_t)mi * 6 + shift_idx) * D + c); const float4 sc = *(const float4*)(modN + ((size_t)mi * 6 + shift_idx + 1) * D + c);
        u32x2 o; o.x = pack2(x[i].x * rs * g.x * (1.f + sc.x) + sh.x, x[i].y * rs * g.y * (1.f + sc.y) + sh.y); o.y = pack2(x[i].z * rs * g.z * (1.f + sc.z) + sh.z, x[i].w * rs * g.w * (1.f + sc.w) + sh.w);
        *(u32x2*)(hout + (size_t)m * LDH + c) = o; }
    }
  }
}

struct TileSrc { const bf16_t* A; int lda; int arow0; const bf16_t* B; int ldb; int brow0, brow1; int K; };

template <int MM, int NN> DI void zero_acc(f32x4 (&acc)[MM][NN]) {
#pragma unroll
  for (int m = 0; m < MM; ++m)
#pragma unroll
    for (int n = 0; n < NN; ++n) acc[m][n] = (f32x4){0.f, 0.f, 0.f, 0.f};
}

template <int MM, int NN, int KU = 0> struct Gemm {
  static constexpr int NA = MM / 2, NB = NN;
  unsigned oa_[NA], ob_[NB]; const bf16_t* A; const bf16_t* B; int nk; u32x4 ra[NA], rb[NB];
#define GT_LOAD(KT) do { const int kn_ = ((KT) < nk ? (KT) : nk - 1) * 64; \
    _Pragma("unroll") for (int i = 0; i < NA; ++i) ra[i] = *(const u32x4*)(A + (oa_[i] + kn_)); \
    _Pragma("unroll") for (int i = 0; i < NB; ++i) rb[i] = *(const u32x4*)(B + (ob_[i] + kn_)); } while (0)
  DI void begin(const TileSrc& s, const bool perm = false) {
    const int tid = ptid();
#pragma unroll
    for (int i = 0; i < NA; ++i) { const int row = (tid >> 3) + 64 * i, kc = tid & 7;
      int ar = s.arow0 + row; ar = ar < 0 ? 0 : (ar > MT - 1 ? MT - 1 : ar);
      oa_[i] = (unsigned)ar * (unsigned)s.lda + kc * 8; }
#pragma unroll
    for (int i = 0; i < NB; ++i) { const int row = (tid >> 3) + 64 * i, kc = tid & 7;
      const int rr = perm ? ((row & ~31) | (8 * ((row & 15) >> 2) + 4 * ((row >> 4) & 1) + (row & 3))) : row;
      const int br = rr < 32 * NN ? s.brow0 + rr : s.brow1 + rr - 32 * NN;
      ob_[i] = (unsigned)br * (unsigned)s.ldb + kc * 8; }
    A = s.A; B = s.B; nk = s.K >> 6;
    GT_LOAD(0);
  }
  DI void run(f32x4 (&acc)[MM][NN], char* smem) {
    bf16_t* sbase = (bf16_t*)smem;
    const int tid = ptid(), lane = tid & 63, wave = tid >> 6, wr = wave >> 2, wc = wave & 3, fr = lane & 15, fq = lane >> 4;
    int wofs; { const int r = tid >> 3, kc = tid & 7, ob = (r & 15) * 64 + (kc & 3) * 16; wofs = (((r >> 4) * 2 + (kc >> 2)) * 1024 + (ob ^ (((ob >> 9) & 1) << 5))) >> 1; }
    int robase; { const int ob = fr * 64 + fq * 16; robase = (ob ^ (((ob >> 9) & 1) << 5)) >> 1; }
#define GT_STORE(ST) do { bf16_t* sA_ = sbase + (ST) * 32768; bf16_t* sB_ = sA_ + 16384; \
    _Pragma("unroll") for (int i = 0; i < NA; ++i) *(u32x4*)(sA_ + wofs + i * 4096) = ra[i]; \
    _Pragma("unroll") for (int i = 0; i < NB; ++i) *(u32x4*)(sB_ + wofs + i * 4096) = rb[i]; } while (0)
#define GT_KSTEP(ks) do { bf16x8 bfr[NN]; \
      _Pragma("unroll") for (int n = 0; n < NN; ++n) bfr[n] = *(const bf16x8*)(sB_ + ((wc * NN + n) * 2 + (ks)) * 512); \
      _Pragma("unroll") for (int m = 0; m < MM; ++m) { const bf16x8 af = *(const bf16x8*)(sA_ + ((wr * MM + m) * 2 + (ks)) * 512); \
        _Pragma("unroll") for (int n = 0; n < NN; ++n) acc[m][n] = MFMA16(bfr[n], af, acc[m][n]); } } while (0)
#define GT_COMPUTE(ST) do { const bf16_t* sA_ = sbase + (ST) * 32768 + robase; const bf16_t* sB_ = sA_ + 16384; __builtin_amdgcn_s_setprio(1); \
    if (KU) { GT_KSTEP(0); GT_KSTEP(1); } else { _Pragma("unroll 1") for (int ks = 0; ks < 2; ++ks) GT_KSTEP(ks); } \
    __builtin_amdgcn_s_setprio(0); } while (0)
    __syncthreads();
    GT_STORE(0);
    GT_LOAD(1);
    __syncthreads();
#pragma unroll 1
    for (int kt = 0; kt < nk; kt += 2) {
      GT_STORE(1); GT_LOAD(kt + 2); GT_COMPUTE(0); __syncthreads();
      GT_STORE(0); GT_LOAD(kt + 3); GT_COMPUTE(1); __syncthreads();
    }
  }
#undef GT_LOAD
#undef GT_STORE
#undef GT_COMPUTE
#undef GT_KSTEP
};
template <int MM, int NN> DI void gemm_tile(f32x4 (&acc)[MM][NN], const TileSrc& s, char* smem) { Gemm<MM, NN> g; g.begin(s); g.run(acc, smem); }

DI float gelu_tanh(float x) { const float u = 0.7978845608f * (x + 0.044715f * x * x * x); const float e = __expf(2.f * u); const float th = 1.f - 2.f * __builtin_amdgcn_rcpf(e + 1.f); return 0.5f * x * (1.f + th); }

struct TileIter {
  int m_lo, rows, NTn, G, efull, count, e, stride;
  DI void init(int MTn, int NTn_) { const int x = blockIdx.x & 7; m_lo = (x * MTn) >> 3; rows = (((x + 1) * MTn) >> 3) - m_lo; NTn = NTn_; G = (rows + 1) >> 1;
    efull = (rows / G) * G * NTn; count = rows * NTn; e = blockIdx.x >> 3; stride = gridDim.x >> 3; }
  DI bool next(int& mt, int& nt) { if (e >= count) return false;
    if (e < efull) { const int grp = e / (G * NTn), rem = e - grp * G * NTn; nt = rem / G; mt = m_lo + grp * G + (rem - nt * G); }
    else { const int rem = e - efull, gsz = rows - (rows / G) * G; nt = rem / gsz; mt = m_lo + (rows / G) * G + (rem - nt * gsz); }
    e += stride; return true; }
};

__device__ void phase_win(const P& p, int l, char* smem) {
  const bf16_t* H = (const bf16_t*)(p.ws + WS_H); const bf16_t* Wt = (const bf16_t*)(p.ws + WS_WIN);
  bf16_t* zr = (bf16_t*)(p.ws + WS_ZR); bf16_t* zn = (bf16_t*)(p.ws + WS_ZN); bf16_t* zt = (bf16_t*)(p.ws + WS_ZT);
  const int tid = ptid(), lane = tid & 63, wave = tid >> 6, wr = wave >> 2, wc = wave & 3, fr = lane & 15, fq = lane >> 4;
  Gemm<8, 4> gm;
  TileIter ti; ti.init(48, 14);
  const int x = blockIdx.x & 7, nconv = (343 - x + 7) >> 3, nloc = ti.count + nconv;
  const float* cw = p.rwkv_conv + (size_t)l * 3 * NZR;
  for (int e = (int)(blockIdx.x >> 3); e < nloc; e += (int)(gridDim.x >> 3)) {
    f32x4 acc[8][4]; zero_acc<8, 4>(acc);
    if (e < nconv) {
      const int c = x + 8 * e, mt = c / 7, nt = c - mt * 7;
      const int n0 = nt * 256, arow0 = mt * 254 - 1;
      { TileSrc s{H, LDH, arow0, Wt, LDH, n0, n0 + 128, D}; gm.begin(s); }
      gm.run(acc, smem);
      float* sC = (float*)smem;
#pragma unroll 1
      for (int sl = 0; sl < 2; ++sl) {
        __syncthreads();
        if ((wc >> 1) == sl) {
#pragma unroll
          for (int m = 0; m < 8; ++m)
#pragma unroll
            for (int n = 0; n < 4; ++n) *(f32x4*)(sC + (wr * 128 + m * 16 + fr) * 132 + (wc & 1) * 64 + n * 16 + fq * 4) = acc[m][n];
        }
        __syncthreads();
        const int nb = n0 + sl * 128, c8 = (tid & 15) * 8;
        const f32x4 w0a = *(const f32x4*)(cw + nb + c8), w0b = *(const f32x4*)(cw + nb + c8 + 4), w1a = *(const f32x4*)(cw + NZR + nb + c8), w1b = *(const f32x4*)(cw + NZR + nb + c8 + 4),
                    w2a = *(const f32x4*)(cw + 2 * NZR + nb + c8), w2b = *(const f32x4*)(cw + 2 * NZR + nb + c8 + 4);
        const bool sg = nb + c8 >= 1664;
        for (int ee = tid; ee < 254 * 16; ee += NTP) {
          const int tr = 1 + (ee >> 4), g = arow0 + tr;
          if (g < MT) { int t, T, mi; tokinfo(g, t, T, mi);
            const float pm = t > 0 ? 1.f : 0.f, nm = t < T - 1 ? 1.f : 0.f;
            const float* r0 = sC + (tr - 1) * 132 + c8; const float* r1 = r0 + 132; const float* r2 = r1 + 132;
            f32x4 ya = (*(const f32x4*)r0 * w0a) * pm + *(const f32x4*)r1 * w1a + (*(const f32x4*)r2 * w2a) * nm;
            f32x4 yb = (*(const f32x4*)(r0 + 4) * w0b) * pm + *(const f32x4*)(r1 + 4) * w1b + (*(const f32x4*)(r2 + 4) * w2b) * nm;
            if (sg) {
#pragma unroll
              for (int j = 0; j < 4; ++j) { ya[j] = sigmoidf_(ya[j]); yb[j] = sigmoidf_(yb[j]); } }
            const u32x4 o = {pack2(ya[0], ya[1]), pack2(ya[2], ya[3]), pack2(yb[0], yb[1]), pack2(yb[2], yb[3])};
            *(u32x4*)(zr + (size_t)g * NZR + nb + c8) = o; }
        }
      }
    } else {
      int mt, nt; ti.e = e - nconv; ti.next(mt, nt);
      const int n0 = nt * 256, row0 = mt * 256;
      { TileSrc s{H, LDH, row0, Wt, LDH, NZR + n0, NZR + n0 + 128, D}; gm.begin(s, true); }
      gm.run(acc, smem);
#pragma unroll
      for (int m = 0; m < 8; ++m) { const int row = row0 + wr * 128 + m * 16 + fr;
#pragma unroll
        for (int g = 0; g < 2; ++g) { const int col = n0 + wc * 64 + g * 32 + fq * 8; const f32x4 v0 = acc[m][2 * g], v1 = acc[m][2 * g + 1];
          const u32x4 o = {pack2(v0[0], v0[1]), pack2(v0[2], v0[3]), pack2(v1[0], v1[1]), pack2(v1[2], v1[3])};
          if (col < NZN) {
            *(u32x4*)(zn + (size_t)row * NZN + col) = o;
            if (row < MC && col >= 512) { const int part = col - 512, isv = part >> 9, pp = part & 511, hh = pp >> 6, d = pp & 63, b = row >> 8, t = row & 255;
              float* dst = p.out + (isv ? O_V : O_K) + ((((size_t)b * 2 + l) * 8 + hh) * 256 + t) * 64 + d; *(f32x4*)dst = v0; *(f32x4*)(dst + 4) = v1; }
          } else { *(u32x4*)(zt + (size_t)row * LZT + (col - NZN)) = o; }
        } }
    }
  }
}

__device__ void phase_merge(const P& p, char* smem) {
  const bf16_t* H = (const bf16_t*)(p.ws + WS_H); const bf16_t* Wt = (const bf16_t*)(p.ws + WS_WIN); const bf16_t* Wo3 = (const bf16_t*)(p.ws + WS_WO3);
  bf16_t* mg = (bf16_t*)(p.ws + WS_MERGED);
  const int tid = ptid(), lane = tid & 63, wave = tid >> 6, wr = wave >> 2, wc = wave & 3, fr = lane & 15, fq = lane >> 4;
  TileIter ti; int mt, nt; ti.init(96, 8);
  while (ti.next(mt, nt)) {
    const int n0 = nt * 128, row0 = mt * 128;
    f32x4 macc[4][2]; zero_acc<4, 2>(macc);
#pragma unroll 1
    for (int i = 0; i < 3; ++i) {
      const bf16_t* O = (const bf16_t*)(p.ws + (i == 0 ? WS_OA : (i == 1 ? WS_ONA : WS_ORET)));
      f32x4 g[4][2]; zero_acc<4, 2>(g);
      { TileSrc s{H, LDH, row0, Wt, LDH, 5376 + i * 1024 + n0, 5376 + i * 1024 + n0 + 64, D}; { Gemm<4, 2, 1> gm; gm.begin(s, true); gm.run(g, smem); } }
      f32x4 a2[4][2]; zero_acc<4, 2>(a2);
      { TileSrc s{O, LDO, row0, Wo3 + (size_t)i * 1024 * LDO, LDO, n0, n0 + 64, 512}; { Gemm<4, 2, 1> gm; gm.begin(s, true); gm.run(a2, smem); } }
#pragma unroll
      for (int m = 0; m < 4; ++m)
#pragma unroll
        for (int n = 0; n < 2; ++n)
#pragma unroll
          for (int j = 0; j < 4; ++j) macc[m][n][j] += sigmoidf_(g[m][n][j]) * a2[m][n][j];
    }
#pragma unroll
    for (int m = 0; m < 4; ++m) { const int row = row0 + wr * 64 + m * 16 + fr;
      { const int col = n0 + wc * 32 + fq * 8; const u32x4 o = {pack2(macc[m][0][0], macc[m][0][1]), pack2(macc[m][0][2], macc[m][0][3]), pack2(macc[m][1][0], macc[m][1][1]), pack2(macc[m][1][2], macc[m][1][3])}; *(u32x4*)(mg + (size_t)row * LDH + col) = o; } }
  }
}

__device__ void phase_gemm_f32(const bf16_t* A, int lda, int K, const bf16_t* Bt, int ldb, float* C, char* smem) {
  const int tid = ptid(), lane = tid & 63, wave = tid >> 6, wr = wave >> 2, wc = wave & 3, fr = lane & 15, fq = lane >> 4;
  TileIter ti; int mt, nt; ti.init(48, 4);
  while (ti.next(mt, nt)) {
    const int n0 = nt * 256, row0 = mt * 256;
    f32x4 acc[8][4]; zero_acc<8, 4>(acc);
    TileSrc s{A, lda, row0, Bt, ldb, n0, n0 + 128, K}; { Gemm<8, 4> gm; gm.begin(s, true); gm.run(acc, smem); }
#pragma unroll
    for (int m = 0; m < 8; ++m) { const int row = row0 + wr * 128 + m * 16 + fr;
#pragma unroll
      for (int g = 0; g < 2; ++g) { float* dst = C + (size_t)row * D + n0 + wc * 64 + g * 32 + fq * 8; *(f32x4*)dst = acc[m][2 * g]; *(f32x4*)(dst + 4) = acc[m][2 * g + 1]; } }
  }
}

__device__ void phase_ffn_up(const P& p, int l, char* smem) {
  const bf16_t* H = (const bf16_t*)(p.ws + WS_H); const bf16_t* Wt = (const bf16_t*)(p.ws + WS_WUP); bf16_t* hid = (bf16_t*)(p.ws + WS_HID);
  const int tid = ptid(), lane = tid & 63, wave = tid >> 6, wr = wave >> 2, wc = wave & 3, fr = lane & 15, fq = lane >> 4;
  const float* cw = p.ffn_conv + (size_t)l * 3 * 2 * FF;
  TileIter ti; int mt, nt; ti.init(49, 22);
  Gemm<8, 4> gm;
  while (ti.next(mt, nt)) {
    const int c0 = nt * 128, arow0 = mt * 254 - 1;
    f32x4 acc[8][4]; zero_acc<8, 4>(acc);
    { TileSrc s{H, LDH, arow0, Wt, LDH, c0, FF + c0, D}; gm.begin(s); }
    gm.run(acc, smem);
    float* sC = (float*)smem;
#pragma unroll 1
    for (int sl = 0; sl < 2; ++sl) {
      __syncthreads();
      if ((wc & 1) == sl) { const int cb = (wc >> 1) * 64;
#pragma unroll
        for (int m = 0; m < 8; ++m)
#pragma unroll
          for (int n = 0; n < 4; ++n) *(f32x4*)(sC + (wr * 128 + m * 16 + fr) * 132 + cb + n * 16 + fq * 4) = acc[m][n];
      }
      __syncthreads();
      const int cq = c0 + sl * 64, c4 = (tid & 15) * 4;
      const f32x4 v0 = *(const f32x4*)(cw + cq + c4), v1 = *(const f32x4*)(cw + 2 * FF + cq + c4), v2 = *(const f32x4*)(cw + 4 * FF + cq + c4);
      const f32x4 g0 = *(const f32x4*)(cw + FF + cq + c4), g1 = *(const f32x4*)(cw + 3 * FF + cq + c4), g2 = *(const f32x4*)(cw + 5 * FF + cq + c4);
      for (int e = tid; e < 254 * 16; e += NTP) {
        const int tr = 1 + (e >> 4), g = arow0 + tr;
        if (g < MT) { int t, T, mi; tokinfo(g, t, T, mi);
          const float pm = t > 0 ? 1.f : 0.f, nm = t < T - 1 ? 1.f : 0.f;
          const f32x4 va = *(const f32x4*)(sC + (tr - 1) * 132 + c4), vb = *(const f32x4*)(sC + tr * 132 + c4), vc = *(const f32x4*)(sC + (tr + 1) * 132 + c4);
          const f32x4 ga = *(const f32x4*)(sC + (tr - 1) * 132 + 64 + c4), gb = *(const f32x4*)(sC + tr * 132 + 64 + c4), gc = *(const f32x4*)(sC + (tr + 1) * 132 + 64 + c4);
          float r[4];
#pragma unroll
          for (int j = 0; j < 4; ++j) { const float val = pm * va[j] * v0[j] + vb[j] * v1[j] + nm * vc[j] * v2[j]; const float gt = pm * ga[j] * g0[j] + gb[j] * g1[j] + nm * gc[j] * g2[j]; r[j] = gelu_tanh(gt) * val; }
          u32x2 o; o.x = pack2(r[0], r[1]); o.y = pack2(r[2], r[3]);
          *(u32x2*)(hid + (size_t)g * FF + cq + c4) = o; }
      }
    }
  }
}

template <int CTRL> DI float dppf(float v) { return __int_as_float(__builtin_amdgcn_mov_dpp(__float_as_int(v), CTRL, 0xF, 0xF, true)); }
DI float row16_sum(float v) { v += dppf<0xB1>(v); v += dppf<0x4E>(v); v += dppf<0x141>(v); v += dppf<0x140>(v); return v; }

DI float frcp(float x) { return __builtin_amdgcn_rcpf(x); }
DI float fsig(float x) { return frcp(1.f + __expf(-x)); }
__device__ void scan_task(const P& p, int l, int seq, int h, int d, int half, char* smem) {
  float* sR = (float*)smem; float* sW = sR + 1024; float* sKD = sW + 1024; float* sB = sKD + 1024; float* sNK = sB + 1024; float* sV = sNK + 1024; float* sK = sV + 1024; float* sY = sK + 1024;
  float* sKn = sY + 2048; float* sKK = sKn + 16; bf16_t* sWT = (bf16_t*)(sKK + 64); bf16_t* sAL = sWT + 16 * LDT;
  const int tid = tidx(), lane = tid & 63, wave = tid >> 6, fr = lane & 15, fq = lane >> 4;
  const int row0 = seq < 32 ? seq * 256 : MC + (seq - 32) * 1024, T = seq < 32 ? 256 : 1024, nch = T >> 4;
  const bf16_t* zr = (const bf16_t*)(p.ws + WS_ZR);
  float* yout = (float*)(p.ws + WS_Y) + (size_t)d * MT * 512;
  __syncthreads();
  if (tid < 64) sKK[tid] = p.rwkv_k_k[l * 512 + h * 64 + tid];
  const int cc = wave * 16 + fr, gc = h * 64 + cc;
  bf16x8 bw[2], ba[2];
#pragma unroll
  for (int ks = 0; ks < 2; ++ks)
#pragma unroll
    for (int e = 0; e < 8; ++e) { const int k = ks * 32 + fq * 8 + e;
      bw[ks][e] = (short)f2bf(p.rwkv_w_up[((size_t)(l * 2 + d) * 64 + k) * 512 + gc]); ba[ks][e] = (short)f2bf(p.rwkv_a_up[((size_t)(l * 2 + d) * 64 + k) * 512 + gc]); }
  const float w0c = p.rwkv_w0[(l * 2 + d) * 512 + gc], a0c = p.rwkv_a0[(l * 2 + d) * 512 + gc], kac = p.rwkv_k_a[l * 512 + gc];
  const int rg = tid >> 4, kq = tid & 15, rbase = half * 32 + rg * 2;
  f32x2 S[2][2];
  if (seq >= 32) { const float* s0 = p.state_rwkv + (((((size_t)(seq - 32) * 2 + l) * 2 + d) * 8 + h) * 64 + rbase) * 64 + kq * 4;
#pragma unroll
    for (int r = 0; r < 2; ++r) { const f32x4 x = *(const f32x4*)(s0 + r * 64); S[r][0] = (f32x2){x[0], x[1]}; S[r][1] = (f32x2){x[2], x[3]}; } }
  else {
#pragma unroll
    for (int r = 0; r < 2; ++r) { S[r][0] = (f32x2){0.f, 0.f}; S[r][1] = (f32x2){0.f, 0.f}; } }
  if (seq >= 32) __builtin_amdgcn_s_setprio(2);
  const int at = (tid & 127) >> 3, apart = tid & 7, ahi = tid >> 7;
  size_t coff[3];
  { const int sb0 = ahi ? 512 + h * 64 : h * 64, sb1 = ahi ? 1536 : 1024 + h * 64, sb2 = 1600;
    coff[0] = (size_t)at * NZR + sb0 + apart * 8; coff[1] = (size_t)at * NZR + sb1 + apart * 8; coff[2] = (size_t)at * NZR + sb2 + apart * 8; }
  u32x4 pre[3];
  { const int t0 = (d ? nch - 1 : 0) * 16;
#pragma unroll
    for (int i = 0; i < 3; ++i) pre[i] = *(const u32x4*)(zr + (size_t)(row0 + t0) * NZR + coff[i]); }
  __syncthreads();
  for (int ci = 0; ci < nch; ++ci) {
    const int chunk = d ? nch - 1 - ci : ci, t0 = chunk * 16;
    { const int o = at * 64 + apart * 8; float f[8];
      unpack8(pre[0], f);
      if (ahi == 0) { *(f32x4*)(sR + o) = (f32x4){f[0], f[1], f[2], f[3]}; *(f32x4*)(sR + o + 4) = (f32x4){f[4], f[5], f[6], f[7]}; }
      else { *(f32x4*)(sK + o) = (f32x4){f[0], f[1], f[2], f[3]}; *(f32x4*)(sK + o + 4) = (f32x4){f[4], f[5], f[6], f[7]}; float ps = 0.f;
#pragma unroll
        for (int e = 0; e < 8; ++e) { const float kk = f[e] * sKK[apart * 8 + e]; ps += kk * kk; }
        ps += dppf<0xB1>(ps); ps += dppf<0x4E>(ps); ps += dppf<0x141>(ps);
        if (apart == 0) sKn[at] = ps; }
      unpack8(pre[1], f);
      if (ahi == 0) { *(f32x4*)(sV + o) = (f32x4){f[0], f[1], f[2], f[3]}; *(f32x4*)(sV + o + 4) = (f32x4){f[4], f[5], f[6], f[7]}; }
      else { float g[8];
#pragma unroll
        for (int e = 0; e < 8; ++e) g[e] = 1.f - 2.f * frcp(__expf(2.f * f[e]) + 1.f);
        *(u32x4*)(sWT + at * LDT + apart * 8) = pack8(g); }
      if (ahi == 0) *(u32x4*)(sAL + at * LDT + apart * 8) = pre[2];
    }
    __syncthreads();
    {
      f32x4 aw = {0.f, 0.f, 0.f, 0.f}, aa = {0.f, 0.f, 0.f, 0.f};
#pragma unroll
      for (int ks = 0; ks < 2; ++ks) { const bf16x8 fw = *(const bf16x8*)(sWT + fr * LDT + ks * 32 + fq * 8); const bf16x8 fa = *(const bf16x8*)(sAL + fr * LDT + ks * 32 + fq * 8);
        aw = MFMA16(fw, bw[ks], aw); aa = MFMA16(fa, ba[ks], aa); }
      const float kkc = sKK[cc];
#pragma unroll
      for (int j = 0; j < 4; ++j) { const int t = fq * 4 + j, o = t * 64 + cc;
        const float dec = __expf(-0.6065306597f * fsig(w0c + aw[j]));
        const float a = fsig(a0c + aa[j]);
        const float kv = sK[o];
        const float kkv = kv * kkc * __builtin_amdgcn_rsqf(fmaxf(sKn[t], 1e-24f));
        sW[o] = dec; sKD[o] = kv * (1.f + (a - 1.f) * kac); sB[o] = kkv * a; sNK[o] = -kkv; }
    }
    __syncthreads();
    { const int cn = ci + 1 < nch ? ci + 1 : ci; const int nt0 = (d ? nch - 1 - cn : cn) * 16;
#pragma unroll
      for (int i = 0; i < 3; ++i) pre[i] = *(const u32x4*)(zr + (size_t)(row0 + nt0) * NZR + coff[i]); }
#pragma unroll 8
    for (int si = 0; si < 16; ++si) {
      const int t = d ? 15 - si : si, o = t * 64 + kq * 4;
      const f32x4 an4 = *(const f32x4*)(sNK + o), w4 = *(const f32x4*)(sW + o), b4 = *(const f32x4*)(sB + o), kd4 = *(const f32x4*)(sKD + o), r4 = *(const f32x4*)(sR + o);
      const f32x2 v2 = *(const f32x2*)(sV + t * 64 + rbase);
      const f32x2 an[2] = {{an4[0], an4[1]}, {an4[2], an4[3]}}, wv[2] = {{w4[0], w4[1]}, {w4[2], w4[3]}}, bv[2] = {{b4[0], b4[1]}, {b4[2], b4[3]}}, kd[2] = {{kd4[0], kd4[1]}, {kd4[2], kd4[3]}}, rv[2] = {{r4[0], r4[1]}, {r4[2], r4[3]}};
      float sa[2];
#pragma unroll
      for (int r = 0; r < 2; ++r) { const f32x2 t2 = S[r][0] * an[0] + S[r][1] * an[1]; sa[r] = row16_sum(t2.x + t2.y); }
      f32x2 yv;
#pragma unroll
      for (int r = 0; r < 2; ++r) { const f32x2 sav = {sa[r], sa[r]}, vvv = {v2[r], v2[r]};
        S[r][0] = S[r][0] * wv[0] + (sav * bv[0] + vvv * kd[0]); S[r][1] = S[r][1] * wv[1] + (sav * bv[1] + vvv * kd[1]);
        const f32x2 y2 = S[r][0] * rv[0] + S[r][1] * rv[1]; float yp = y2.x + y2.y; yp += dppf<0xB1>(yp); yp += dppf<0x4E>(yp); yv[r] = yp; }
      if ((kq & 3) == 0) { sY[((t * 32 + rg * 2) * 4) + (kq >> 2)] = yv[0]; sY[((t * 32 + rg * 2 + 1) * 4) + (kq >> 2)] = yv[1]; }
    }
    __syncthreads();
    { const int t = tid >> 4, lr = (tid & 15) * 2; const f32x4 p0 = *(const f32x4*)(sY + (t * 32 + lr) * 4), p1 = *(const f32x4*)(sY + (t * 32 + lr + 1) * 4);
      *(f32x2*)(yout + (size_t)(row0 + t0 + t) * 512 + h * 64 + half * 32 + lr) = (f32x2){p0[0] + p0[1] + p0[2] + p0[3], p1[0] + p1[1] + p1[2] + p1[3]}; }
  }
  __builtin_amdgcn_s_setprio(0);
  if (seq < 32) { float* so = p.out + O_RW + (((((size_t)seq * 2 + l) * 2 + d) * 8 + h) * 64 + rbase) * 64 + kq * 4;
#pragma unroll
    for (int r = 0; r < 2; ++r) *(f32x4*)(so + r * 64) = (f32x4){S[r][0].x, S[r][0].y, S[r][1].x, S[r][1].y}; }
}

DI void qk_scores(const bf16_t* sK, const bf16x8 (&qf)[2], f32x4 (&sacc)[4], int fr, int fq) {
#pragma unroll
  for (int nt = 0; nt < 4; ++nt) { sacc[nt] = (f32x4){0.f, 0.f, 0.f, 0.f};
#pragma unroll
    for (int ks = 0; ks < 2; ++ks) { const bf16x8 kf = *(const bf16x8*)(sK + (nt * 16 + fr) * LDT + ks * 32 + fq * 8); sacc[nt] = MFMA16(kf, qf[ks], sacc[nt]); } }
}
DI void pv_accum(const bf16_t* sVt, const f32x4 (&pacc)[4], f32x4 (&o)[4], int fr, int fq) {
#pragma unroll
  for (int s = 0; s < 2; ++s) {
    bf16x8 pf; { const unsigned a = pack2(pacc[2 * s][0], pacc[2 * s][1]), b = pack2(pacc[2 * s][2], pacc[2 * s][3]), c = pack2(pacc[2 * s + 1][0], pacc[2 * s + 1][1]), dd = pack2(pacc[2 * s + 1][2], pacc[2 * s + 1][3]);
      const u32x4 u = (u32x4){a, b, c, dd}; pf = __builtin_bit_cast(bf16x8, u); }
#pragma unroll
    for (int dt = 0; dt < 4; ++dt) { const u32x2 lo = *(const u32x2*)(sVt + (dt * 16 + fr) * LDT + 32 * s + 4 * fq), hi = *(const u32x2*)(sVt + (dt * 16 + fr) * LDT + 32 * s + 16 + 4 * fq);
      const u32x4 u = (u32x4){lo[0], lo[1], hi[0], hi[1]}; const bf16x8 vf = __builtin_bit_cast(bf16x8, u); o[dt] = MFMA16(vf, pf, o[dt]); }
  }
}
DI void put_kv(bf16_t* sK, bf16_t* sVt, int key, int part, const float (&kf)[8], int vkey, int vpart, const float (&vf)[8]) {
  *(u32x4*)(sK + key * LDT + part * 8) = pack8(kf);
#pragma unroll
  for (int e = 0; e < 8; ++e) sVt[(vpart * 8 + e) * LDT + vkey] = f2bf(vf[e]);
}
DI void softmax_tile(f32x4 (&sacc)[4], f32x4 (&o)[4], float& mrun, float& lrun) {
  float mx = sacc[0][0];
#pragma unroll
  for (int nt = 0; nt < 4; ++nt)
#pragma unroll
    for (int j = 0; j < 4; ++j) mx = fmaxf(mx, sacc[nt][j]);
  mx = fmaxf(mx, shfl_x(mx, 16)); mx = fmaxf(mx, shfl_x(mx, 32));
  const float mnew = fmaxf(mrun, mx), alpha = __builtin_amdgcn_exp2f(mrun - mnew); mrun = mnew;
  float ls = 0.f;
#pragma unroll
  for (int nt = 0; nt < 4; ++nt)
#pragma unroll
    for (int j = 0; j < 4; ++j) { const float pv = __builtin_amdgcn_exp2f(sacc[nt][j] - mnew); sacc[nt][j] = pv; ls += pv; }
  lrun = lrun * alpha + ls;
#pragma unroll
  for (int dt = 0; dt < 4; ++dt) o[dt] *= alpha;
}
constexpr float LOG2E = 1.4426950408889634f;

__device__ void dense_task(const P& p, int b, int h, int qb, char* smem) {
  bf16_t* sK = (bf16_t*)smem; bf16_t* sVt = sK + 64 * LDT;
  const int tid = tidx(), lane = tid & 63, wave = tid >> 6, fr = lane & 15, fq = lane >> 4;
  const bf16_t* zn = (const bf16_t*)(p.ws + WS_ZN); bf16_t* ona = (bf16_t*)(p.ws + WS_ONA);
  const int qrow = b * 256 + qb * 64 + wave * 16 + fr;
  bf16x8 qf[2];
#pragma unroll
  for (int ks = 0; ks < 2; ++ks) qf[ks] = *(const bf16x8*)(zn + (size_t)qrow * NZN + h * 64 + ks * 32 + fq * 8);
  f32x4 o[4]; for (int dt = 0; dt < 4; ++dt) o[dt] = (f32x4){0.f, 0.f, 0.f, 0.f};
  float mrun = -1e30f, lrun = 0.f;
  u32x4 pk[2], pv[2];
#pragma unroll
  for (int i = 0; i < 2; ++i) { const int c = tid + 256 * i, key = c >> 3, part = c & 7, vkey = c & 63, vpart = c >> 6; pk[i] = *(const u32x4*)(zn + (size_t)(b * 256 + key) * NZN + h * 64 + part * 8 + 512); pv[i] = *(const u32x4*)(zn + (size_t)(b * 256 + vkey) * NZN + h * 64 + vpart * 8 + 1024); }
  for (int kt = 0; kt < 4; ++kt) {
    __syncthreads();
#pragma unroll
    for (int i = 0; i < 2; ++i) { const int c = tid + 256 * i, key = c >> 3, part = c & 7, vkey = c & 63, vpart = c >> 6;
      *(u32x4*)(sK + key * LDT + part * 8) = pk[i];
#pragma unroll
      for (int e = 0; e < 4; ++e) { sVt[(vpart * 8 + 2 * e) * LDT + vkey] = (bf16_t)(pv[i][e] & 0xffffu); sVt[(vpart * 8 + 2 * e + 1) * LDT + vkey] = (bf16_t)(pv[i][e] >> 16); } }
    __syncthreads();
    { const int kn = kt < 3 ? kt + 1 : 3;
#pragma unroll
      for (int i = 0; i < 2; ++i) { const int c = tid + 256 * i, key = c >> 3, part = c & 7, vkey = c & 63, vpart = c >> 6; pk[i] = *(const u32x4*)(zn + (size_t)(b * 256 + kn * 64 + key) * NZN + h * 64 + part * 8 + 512); pv[i] = *(const u32x4*)(zn + (size_t)(b * 256 + kn * 64 + vkey) * NZN + h * 64 + vpart * 8 + 1024); } }
    f32x4 sacc[4]; qk_scores(sK, qf, sacc, fr, fq);
#pragma unroll
    for (int nt = 0; nt < 4; ++nt) sacc[nt] *= (0.125f * LOG2E);
    softmax_tile(sacc, o, mrun, lrun);
    pv_accum(sVt, sacc, o, fr, fq);
  }
  lrun += shfl_x(lrun, 16); lrun += shfl_x(lrun, 32); const float inv = 1.f / lrun;
#pragma unroll
  for (int dt = 0; dt < 4; ++dt) { u32x2 ov; ov.x = pack2(o[dt][0] * inv, o[dt][1] * inv); ov.y = pack2(o[dt][2] * inv, o[dt][3] * inv); *(u32x2*)(ona + (size_t)qrow * LDO + h * 64 + dt * 16 + fq * 4) = ov; }
}

__device__ void na_task(const P& p, int l, int b, int h, int r, char* smem) {
  bf16_t* sK = (bf16_t*)smem; bf16_t* sVt = sK + 64 * LDT; float* sRpb = (float*)(sVt + 64 * LDT);
  const int tid = tidx(), lane = tid & 63, wave = tid >> 6, fr = lane & 15, fq = lane >> 4;
  const bf16_t* zn = (const bf16_t*)(p.ws + WS_ZN); bf16_t* ona = (bf16_t*)(p.ws + WS_ONA);
  const int base = MC + b * 1024, qcol = wave * 16 + fr, qrow = base + r * 64 + qcol;
  int rs = r - 4; rs = rs < 0 ? 0 : (rs > 8 ? 8 : rs);
  int cs = qcol - 8; cs = cs < 0 ? 0 : (cs > 48 ? 48 : cs);
  __syncthreads();
  for (int e = tid; e < 465; e += NT) sRpb[e] = p.na_rpb[((size_t)l * 8 + h) * 465 + e] * LOG2E;
  bf16x8 qf[2];
#pragma unroll
  for (int ks = 0; ks < 2; ++ks) qf[ks] = *(const bf16x8*)(zn + (size_t)qrow * NZN + h * 64 + ks * 32 + fq * 8);
  f32x4 o[4]; for (int dt = 0; dt < 4; ++dt) o[dt] = (f32x4){0.f, 0.f, 0.f, 0.f};
  float mrun = -1e30f, lrun = 0.f;
  u32x4 pre[8];
#define NA_ISSUE(KT) do { const int kt_ = (KT); \
    if (kt_ < 8) { _Pragma("unroll") for (int i = 0; i < 2; ++i) { const int c = tid + 256 * i, key = c >> 3, part = c & 7, vkey = c & 63, vpart = c >> 6; \
        pre[4 * i] = *(const u32x4*)(zn + (size_t)(base + (rs + kt_) * 64 + key) * NZN + h * 64 + part * 8 + 512); pre[4 * i + 1] = *(const u32x4*)(zn + (size_t)(base + (rs + kt_) * 64 + vkey) * NZN + h * 64 + vpart * 8 + 1024); } } \
    else { _Pragma("unroll") for (int i = 0; i < 2; ++i) { const int c = tid + 256 * i, key = c >> 3, part = c & 7, vkey = c & 63, vpart = c >> 6; const size_t cb_ = (((size_t)b * 2 + l) * 8 + h) * 256 + (kt_ - 8) * 64; const size_t co = (cb_ + key) * 64 + part * 8, cv = (cb_ + vkey) * 64 + vpart * 8; \
        pre[4 * i] = *(const u32x4*)(p.cache_k + co); pre[4 * i + 1] = *(const u32x4*)(p.cache_k + co + 4); pre[4 * i + 2] = *(const u32x4*)(p.cache_v + cv); pre[4 * i + 3] = *(const u32x4*)(p.cache_v + cv + 4); } } } while (0)
  NA_ISSUE(0);
  for (int kt = 0; kt < 12; ++kt) {
    __syncthreads();
    if (kt < 8) {
#pragma unroll
      for (int i = 0; i < 2; ++i) { const int c = tid + 256 * i, key = c >> 3, part = c & 7, vkey = c & 63, vpart = c >> 6;
        *(u32x4*)(sK + key * LDT + part * 8) = pre[4 * i];
#pragma unroll
        for (int e = 0; e < 4; ++e) { sVt[(vpart * 8 + 2 * e) * LDT + vkey] = (bf16_t)(pre[4 * i + 1][e] & 0xffffu); sVt[(vpart * 8 + 2 * e + 1) * LDT + vkey] = (bf16_t)(pre[4 * i + 1][e] >> 16); } }
    } else {
#pragma unroll
      for (int i = 0; i < 2; ++i) { const int c = tid + 256 * i, key = c >> 3, part = c & 7, vkey = c & 63, vpart = c >> 6;
        const f32x4 k0 = __builtin_bit_cast(f32x4, pre[4 * i]), k1 = __builtin_bit_cast(f32x4, pre[4 * i + 1]), v0 = __builtin_bit_cast(f32x4, pre[4 * i + 2]), v1 = __builtin_bit_cast(f32x4, pre[4 * i + 3]);
        const float kf[8] = {k0[0], k0[1], k0[2], k0[3], k1[0], k1[1], k1[2], k1[3]}; const float vf[8] = {v0[0], v0[1], v0[2], v0[3], v1[0], v1[1], v1[2], v1[3]};
        put_kv(sK, sVt, key, part, kf, vkey, vpart, vf); }
    }
    __syncthreads();
    NA_ISSUE(kt < 11 ? kt + 1 : 11);
    f32x4 sacc[4]; qk_scores(sK, qf, sacc, fr, fq);
    if (kt < 8) { const int dr = rs + kt - r + 7;
#pragma unroll
      for (int nt = 0; nt < 4; ++nt)
#pragma unroll
        for (int j = 0; j < 4; ++j) { const int kc = nt * 16 + fq * 4 + j; const bool valid = kc >= cs && kc < cs + 16; int dc = kc - qcol; dc = dc < -15 ? -15 : (dc > 15 ? 15 : dc);
          sacc[nt][j] = valid ? sacc[nt][j] * (0.125f * LOG2E) + sRpb[dr * 31 + dc + 15] : -1e30f; }
    } else {
#pragma unroll
      for (int nt = 0; nt < 4; ++nt) sacc[nt] *= (0.125f * LOG2E);
    }
    softmax_tile(sacc, o, mrun, lrun);
    pv_accum(sVt, sacc, o, fr, fq);
  }
#undef NA_ISSUE
  lrun += shfl_x(lrun, 16); lrun += shfl_x(lrun, 32); const float inv = 1.f / lrun;
#pragma unroll
  for (int dt = 0; dt < 4; ++dt) { u32x2 ov; ov.x = pack2(o[dt][0] * inv, o[dt][1] * inv); ov.y = pack2(o[dt][2] * inv, o[dt][3] * inv); *(u32x2*)(ona + (size_t)qrow * LDO + h * 64 + dt * 16 + fq * 4) = ov; }
}

DI void rope8(const float (&own)[8], const float (&par)[8], int part, int n, float (&out)[8]) {
  const float pos = (float)((part >> 2) ? (n & 63) : (n >> 6));
  const bool isx2 = (part & 3) >= 2;
#pragma unroll
  for (int e = 0; e < 8; ++e) { const int i = (part & 1) * 8 + e; const float ang = pos * __builtin_amdgcn_exp2f(-(float)i * 0.830482023721841f); const float sn = __sinf(ang), cs = __cosf(ang);
    out[e] = isx2 ? par[e] * sn + own[e] * cs : own[e] * cs - par[e] * sn; }
}

DI void rope8t(const float (&own)[8], const float (&par)[8], int part, int n, const float* tab, float (&out)[8]) {
  const int pos = (part >> 2) ? (n & 63) : (n >> 6);
  const bool isx2 = (part & 3) >= 2;
  const float* tb = tab + (pos * 16 + (part & 1) * 8) * 2;
#pragma unroll
  for (int e = 0; e < 8; e += 2) { const f32x4 cssn = *(const f32x4*)(tb + 2 * e);
    out[e] = isx2 ? par[e] * cssn[1] + own[e] * cssn[0] : own[e] * cssn[0] - par[e] * cssn[1];
    out[e + 1] = isx2 ? par[e + 1] * cssn[3] + own[e + 1] * cssn[2] : own[e + 1] * cssn[2] - par[e + 1] * cssn[3]; }
}

__device__ void ret_task(const P& p, int l, int seq, int h, int qb, char* smem) {
  bf16_t* sK = (bf16_t*)smem; bf16_t* sVt = sK + 64 * LDT; bf16_t* sQ = sVt + 64 * LDT; float* sRope = (float*)(sQ + 64 * LDT);
  const int tid = tidx(), lane = tid & 63, wave = tid >> 6, fr = lane & 15, fq = lane >> 4;
  const bf16_t* zt = (const bf16_t*)(p.ws + WS_ZT); bf16_t* oret = (bf16_t*)(p.ws + WS_ORET);
  const bool lat = seq >= 32;
  const int row0 = lat ? MC + (seq - 32) * 1024 : seq * 256, T = lat ? 1024 : 256, nkt = T >> 6;
  const float xf = p.ret_decay[(l * 2 + 0) * 8 + h], xb = p.ret_decay[(l * 2 + 1) * 8 + h];
  const float lgf = -log1pf(__expf(-xf)) * LOG2E, lgb = -log1pf(__expf(-xb)) * LOG2E;
  __syncthreads();
  if (lat) {
#pragma unroll
    for (int j = 0; j < 4; ++j) { const int e = tid + 256 * j; const float ang = (float)(e >> 4) * __builtin_amdgcn_exp2f(-(float)(e & 15) * 0.830482023721841f); sRope[2 * e] = __cosf(ang); sRope[2 * e + 1] = __sinf(ang); }
    __syncthreads();
  }
#pragma unroll
  for (int i = 0; i < 2; ++i) { const int c = tid + 256 * i, qi = c >> 3, part = c & 7; const int n = qb * 64 + qi; const size_t ro = (size_t)(row0 + n) * LZT + h * 64;
    const u32x4 own = *(const u32x4*)(zt + ro + part * 8);
    if (lat) { const u32x4 par = *(const u32x4*)(zt + ro + (part ^ 2) * 8); float fo[8], fp[8], out[8]; unpack8(own, fo); unpack8(par, fp); rope8t(fo, fp, part, n, sRope, out); *(u32x4*)(sQ + qi * LDT + part * 8) = pack8(out); }
    else *(u32x4*)(sQ + qi * LDT + part * 8) = own; }
  __syncthreads();
  const int qi = wave * 16 + fr, nq = qb * 64 + qi;
  bf16x8 qf[2];
#pragma unroll
  for (int ks = 0; ks < 2; ++ks) qf[ks] = *(const bf16x8*)(sQ + qi * LDT + ks * 32 + fq * 8);
  f32x4 o[4]; for (int dt = 0; dt < 4; ++dt) o[dt] = (f32x4){0.f, 0.f, 0.f, 0.f};
  u32x4 rk[2], rp[2], rv[2];
#define RET_ISSUE(KT) do { _Pragma("unroll") for (int i = 0; i < 2; ++i) { const int c = tid + 256 * i, key = c >> 3, part = c & 7, vkey = c & 63, vpart = c >> 6; const size_t ro = (size_t)(row0 + (KT) * 64 + key) * LZT + h * 64; \
    rk[i] = *(const u32x4*)(zt + ro + 512 + part * 8); rp[i] = *(const u32x4*)(zt + ro + 512 + (part ^ 2) * 8); rv[i] = *(const u32x4*)(zt + (size_t)(row0 + (KT) * 64 + vkey) * LZT + h * 64 + 1024 + vpart * 8); } } while (0)
  RET_ISSUE(0);
  for (int kt = 0; kt < nkt; ++kt) {
    __syncthreads();
#pragma unroll
    for (int i = 0; i < 2; ++i) { const int c = tid + 256 * i, key = c >> 3, part = c & 7, vkey = c & 63, vpart = c >> 6; const int n = kt * 64 + key;
      float kf[8]; unpack8(rk[i], kf);
      if (lat) { float fp[8], out[8]; unpack8(rp[i], fp); rope8t(kf, fp, part, n, sRope, out);
#pragma unroll
        for (int e = 0; e < 8; ++e) kf[e] = out[e]; }
#pragma unroll
      for (int e = 0; e < 8; ++e) kf[e] *= 0.125f;
      *(u32x4*)(sK + key * LDT + part * 8) = pack8(kf);
#pragma unroll
      for (int e = 0; e < 4; ++e) { sVt[(vpart * 8 + 2 * e) * LDT + vkey] = (bf16_t)(rv[i][e] & 0xffffu); sVt[(vpart * 8 + 2 * e + 1) * LDT + vkey] = (bf16_t)(rv[i][e] >> 16); } }
    __syncthreads();
    RET_ISSUE(kt + 1 < nkt ? kt + 1 : kt);
    f32x4 sacc[4]; qk_scores(sK, qf, sacc, fr, fq);
#pragma unroll
    for (int nt = 0; nt < 4; ++nt)
#pragma unroll
      for (int j = 0; j < 4; ++j) { const int mk = kt * 64 + nt * 16 + fq * 4 + j; const int df = nq - mk;
        const float ex = __builtin_amdgcn_exp2f((df > 0 ? lgf : -lgb) * (float)df); sacc[nt][j] *= (df == 0 ? 2.f : ex); }
    pv_accum(sVt, sacc, o, fr, fq);
  }
#undef RET_ISSUE
  if (lat) {
    for (int dir = 0; dir < 2; ++dir) {
      __syncthreads();
      const float* s0 = p.state_ret + ((((size_t)(seq - 32) * 2 + l) * 2 + dir) * 8 + h) * 4096;
#pragma unroll
      for (int i = 0; i < 2; ++i) { const int c = tid + 256 * i, dk = c & 63, part = c >> 6; const float4 a = *(const float4*)(s0 + dk * 64 + part * 8), bq = *(const float4*)(s0 + dk * 64 + part * 8 + 4);
        const float vf[8] = {a.x, a.y, a.z, a.w, bq.x, bq.y, bq.z, bq.w};
#pragma unroll
        for (int e = 0; e < 8; ++e) sVt[(part * 8 + e) * LDT + dk] = f2bf(vf[e]); }
      __syncthreads();
      const float xi = dir == 0 ? exp2f(lgf * (float)(nq + 1)) : exp2f(lgb * (float)(T - nq));
      f32x4 pacc[4];
#pragma unroll
      for (int s = 0; s < 2; ++s)
#pragma unroll
        for (int hh = 0; hh < 2; ++hh)
#pragma unroll
          for (int j = 0; j < 4; ++j) pacc[2 * s + hh][j] = xi * bf2f(sQ[qi * LDT + 32 * s + 16 * hh + 4 * fq + j]);
      pv_accum(sVt, pacc, o, fr, fq);
    }
  }
  float s1 = 0.f;
#pragma unroll
  for (int dt = 0; dt < 4; ++dt)
#pragma unroll
    for (int j = 0; j < 4; ++j) s1 += o[dt][j];
  s1 += shfl_x(s1, 16); s1 += shfl_x(s1, 32); const float mu = s1 * (1.f / 64.f);
  float s2 = 0.f;
#pragma unroll
  for (int dt = 0; dt < 4; ++dt)
#pragma unroll
    for (int j = 0; j < 4; ++j) { const float dlt = o[dt][j] - mu; s2 += dlt * dlt; }
  s2 += shfl_x(s2, 16); s2 += shfl_x(s2, 32); const float rstd = rsqrtf(s2 * (1.f / 64.f) + 1e-5f);
  const size_t qrow = (size_t)(row0 + nq);
#pragma unroll
  for (int dt = 0; dt < 4; ++dt) { const int dv = h * 64 + dt * 16 + fq * 4; const u32x2 gr = *(const u32x2*)(zt + qrow * LZT + 1536 + dv); const float4 gn = *(const float4*)(p.ret_gn + l * 512 + dv);
    const float g0 = bflo(gr.x), g1 = bfhi(gr.x), g2 = bflo(gr.y), g3 = bfhi(gr.y);
    u32x2 ov; ov.x = pack2((o[dt][0] - mu) * rstd * gn.x * g0 * sigmoidf_(g0), (o[dt][1] - mu) * rstd * gn.y * g1 * sigmoidf_(g1));
    ov.y = pack2((o[dt][2] - mu) * rstd * gn.z * g2 * sigmoidf_(g2), (o[dt][3] - mu) * rstd * gn.w * g3 * sigmoidf_(g3));
    *(u32x2*)(oret + qrow * LDO + dv) = ov; }
}

__device__ void retstate_task(const P& p, int l, int b, int h, char* smem) {
  float* sKf = (float*)smem; float* sKb = sKf + 64 * 64; float* sV = sKb + 64 * 64;
  const int tid = tidx(), dk = tid >> 2, dq = tid & 3;
  const bf16_t* zt = (const bf16_t*)(p.ws + WS_ZT);
  const float xf = p.ret_decay[(l * 2 + 0) * 8 + h], xb = p.ret_decay[(l * 2 + 1) * 8 + h];
  const float lgf = -log1pf(__expf(-xf)) * LOG2E, lgb = -log1pf(__expf(-xb)) * LOG2E;
  float af[16], ab[16];
#pragma unroll
  for (int i = 0; i < 16; ++i) { af[i] = 0.f; ab[i] = 0.f; }
  for (int kt = 0; kt < 4; ++kt) {
    __syncthreads();
#pragma unroll
    for (int i = 0; i < 2; ++i) { const int c = tid + 256 * i, key = c >> 3, part = c & 7, m = kt * 64 + key; const size_t ro = (size_t)(b * 256 + m) * LZT + h * 64 + part * 8;
      float kf[8], vf[8]; unpack8(*(const u32x4*)(zt + ro + 512), kf); unpack8(*(const u32x4*)(zt + ro + 1024), vf);
      const float wf = 0.125f * exp2f(lgf * (float)(255 - m)), wb = 0.125f * exp2f(lgb * (float)m);
#pragma unroll
      for (int e = 0; e < 8; ++e) { sKf[key * 64 + part * 8 + e] = kf[e] * wf; sKb[key * 64 + part * 8 + e] = kf[e] * wb; sV[key * 64 + part * 8 + e] = vf[e]; } }
    __syncthreads();
    for (int m = 0; m < 64; ++m) { const float kf = sKf[m * 64 + dk], kb = sKb[m * 64 + dk];
#pragma unroll
      for (int i = 0; i < 4; ++i) { const f32x4 vv = *(const f32x4*)(sV + m * 64 + dq * 16 + i * 4);
#pragma unroll
        for (int j = 0; j < 4; ++j) { af[i * 4 + j] += kf * vv[j]; ab[i * 4 + j] += kb * vv[j]; } } }
  }
  float* of = p.out + O_RT + ((((size_t)b * 2 + l) * 2 + 0) * 8 + h) * 4096 + dk * 64 + dq * 16; float* ob = of + 8 * 4096;
#pragma unroll
  for (int i = 0; i < 16; ++i) { of[i] = af[i]; ob[i] = ab[i]; }
}

constexpr int Q_SCAN_L = 64, Q_SCAN_C = 512, Q_RET_L = 256, Q_NA = 256, Q_DENSE = 512, Q_RET_C = 512, Q_RST = 128;
template <int QMASK> __device__ void phase_mixers(const P& p, int l, char* smem_, int rep = 0) {
  __shared__ int s_task;
  int* ctr = (int*)(p.ws + WS_CTRL) + 64 * (l + 1) + 4 * rep;
  const int vb = vhalf(); char* smem = smem_ + vb * VSMEM;
  if (QMASK & 1) for (;;) {
    __syncthreads();
    if (ptid() == 0) s_task = atomicAdd(ctr, 1);
    __syncthreads();
    const int tk = s_task;
    if (tk >= Q_SCAN_L + Q_SCAN_C) break;
    const bool lat = tk < Q_SCAN_L; const int t2 = lat ? tk : tk - Q_SCAN_L;
    scan_task(p, l, (lat ? 32 : 0) + (t2 >> 4), (t2 >> 1) & 7, t2 & 1, vb, smem);
  }
  if (QMASK & 2) for (;;) {
    __syncthreads();
    if (ptid() == 0) s_task = atomicAdd(ctr + 16, 1);
    __syncthreads();
    const int tk = s_task;
    if (tk >= Q_RET_L + Q_RET_C) break;
    if (tk < Q_RET_L) ret_task(p, l, 32 + (tk >> 6), (tk >> 3) & 7, (tk & 7) * 2 + vb, smem);
    else { const int t2 = tk - Q_RET_L; ret_task(p, l, t2 >> 4, (t2 >> 1) & 7, (t2 & 1) * 2 + vb, smem); }
  }
  if (QMASK & 4) for (;;) {
    __syncthreads();
    if (ptid() == 0) s_task = atomicAdd(ctr + 32, 1);
    __syncthreads();
    int tk = s_task;
    if (tk >= Q_NA + Q_DENSE + Q_RST) break;
    if (tk < Q_NA) { na_task(p, l, tk >> 6, (tk >> 3) & 7, (tk & 7) * 2 + vb, smem); continue; } tk -= Q_NA;
    if (tk < Q_DENSE) { dense_task(p, tk >> 4, (tk >> 1) & 7, (tk & 1) * 2 + vb, smem); continue; } tk -= Q_DENSE;
    retstate_task(p, l, tk >> 2, (tk & 3) * 2 + vb, smem);
  }
}

__device__ void phase_rwkv_post(const P& p, int l, char* smem) {
  const bf16_t* zr = (const bf16_t*)(p.ws + WS_ZR); const float* yf = (const float*)(p.ws + WS_Y); const float* yb = yf + (size_t)MT * 512; bf16_t* oa = (bf16_t*)(p.ws + WS_OA);
  const bf16_t* Gt = (const bf16_t*)(p.ws + WS_WG);
  const int tid = ptid(), lane = tid & 63, wave = tid >> 6, wr = wave >> 2, wc = wave & 3, fr = lane & 15, fq = lane >> 4;
  TileIter ti; int mt, nt; ti.init(96, 2);
  while (ti.next(mt, nt)) {
    const int row0 = mt * 128, n0 = nt * 256;
    f32x4 acc[4][4]; zero_acc<4, 4>(acc);
    TileSrc s{zr + 1664, NZR, row0, Gt, LDG, n0, n0 + 128, 128}; { Gemm<4, 4, 1> gm; gm.begin(s, true); gm.run(acc, smem); }
    const int cb = n0 + wc * 64 + fq * 8;
#pragma unroll
    for (int m = 0; m < 4; ++m) { const size_t row = (size_t)(row0 + wr * 64 + m * 16 + fr);
      f32x4 y[4]; float s1 = 0.f, rk = 0.f; f32x4 vv[4];
#pragma unroll
      for (int n = 0; n < 4; ++n) { const int c = cb + 32 * (n >> 1) + 4 * (n & 1); y[n] = *(const f32x4*)(yf + row * 512 + c) + *(const f32x4*)(yb + row * 512 + c); s1 += y[n][0] + y[n][1] + y[n][2] + y[n][3];
        const u32x2 rr = *(const u32x2*)(zr + row * NZR + c), kk = *(const u32x2*)(zr + row * NZR + 512 + c), v2 = *(const u32x2*)(zr + row * NZR + 1024 + c); const f32x4 rkw = *(const f32x4*)(p.rwkv_r_k + l * 512 + c);
        rk += bflo(rr.x) * bflo(kk.x) * rkw[0] + bfhi(rr.x) * bfhi(kk.x) * rkw[1] + bflo(rr.y) * bflo(kk.y) * rkw[2] + bfhi(rr.y) * bfhi(kk.y) * rkw[3];
        vv[n] = (f32x4){bflo(v2.x), bfhi(v2.x), bflo(v2.y), bfhi(v2.y)}; }
      s1 += shfl_x(s1, 16); s1 += shfl_x(s1, 32); rk += shfl_x(rk, 16); rk += shfl_x(rk, 32);
      const float mu = s1 * (1.f / 64.f); float s2 = 0.f;
#pragma unroll
      for (int n = 0; n < 4; ++n)
#pragma unroll
        for (int j = 0; j < 4; ++j) { const float dl = y[n][j] - mu; s2 += dl * dl; }
      s2 += shfl_x(s2, 16); s2 += shfl_x(s2, 32); const float rstd = rsqrtf(s2 * (1.f / 64.f) + 64e-5f);
#pragma unroll
      for (int n = 0; n < 4; ++n) { const int c = cb + 32 * (n >> 1) + 4 * (n & 1); const f32x4 lg = *(const f32x4*)(p.rwkv_ln_g + l * 512 + c), lb = *(const f32x4*)(p.rwkv_ln_b + l * 512 + c);
        float o[4];
#pragma unroll
        for (int j = 0; j < 4; ++j) o[j] = ((y[n][j] - mu) * rstd * lg[j] + lb[j] + rk * vv[n][j]) * acc[m][n][j];
        u32x2 ov; ov.x = pack2(o[0], o[1]); ov.y = pack2(o[2], o[3]); *(u32x2*)(oa + row * LDO + c) = ov; }
    }
  }
}

DI void convert_layer_a(const P& p, int l, char* smem) {
  convert_T(p.w_in + (size_t)l * D * INC, D, INC, (bf16_t*)(p.ws + WS_WIN), LDH, smem);
  convert_T(p.w_o_rwkv + (size_t)l * 512 * D, 512, D, (bf16_t*)(p.ws + WS_WO3), LDO, smem);
  convert_T(p.w_o_na + (size_t)l * 512 * D, 512, D, (bf16_t*)(p.ws + WS_WO3) + (size_t)1024 * LDO, LDO, smem);
  convert_T(p.w_o_ret + (size_t)l * 512 * D, 512, D, (bf16_t*)(p.ws + WS_WO3) + (size_t)2 * 1024 * LDO, LDO, smem);
  convert_T(p.w_out + (size_t)l * D * D, D, D, (bf16_t*)(p.ws + WS_WOUT), LDH, smem);
  convert_T(p.rwkv_g_up + (size_t)l * 128 * 512, 128, 512, (bf16_t*)(p.ws + WS_WG), LDG, smem);
}
DI void convert_layer_b(const P& p, int l, char* smem) {
  convert_T(p.ffn_up + (size_t)l * D * 2 * FF, D, 2 * FF, (bf16_t*)(p.ws + WS_WUP), LDH, smem);
  convert_T(p.ffn_down + (size_t)l * FF * D, FF, D, (bf16_t*)(p.ws + WS_WDN), FF, smem);
}

typedef __attribute__((address_space(4))) const P* KP;
DI KP kargs() { KP k = (KP)__builtin_amdgcn_kernarg_segment_ptr(); asm volatile("" : "+s"(k)); return k; }
template <int PH> DI void run_phase(int l, char* smem) {
#if defined(__HIP_DEVICE_COMPILE__)
  const P p = *kargs();
#else
  const P p{};
#endif
  const float* mod = (const float*)(p.ws + WS_MOD);
  float* xbuf = p.out;
  if (PH == 0) { ada_phase(p, smem); convert_layer_a(p, 0, smem); }
  else if (PH == 1) { norm_phase(p, nullptr, nullptr, nullptr, nullptr, 0, nullptr, p.norm_mix_pre, mod, 0, (bf16_t*)(p.ws + WS_H)); }
  else if (PH == 2) phase_win(p, l, smem);
  else if (PH == 4) phase_mixers<7>(p, l, smem);
  else if (PH == 5) phase_rwkv_post(p, l, smem);
  else if (PH == 6) phase_merge(p, smem);
  else if (PH == 7) { phase_gemm_f32((const bf16_t*)(p.ws + WS_MERGED), LDH, D, (const bf16_t*)(p.ws + WS_WOUT), LDH, (float*)(p.ws + WS_U), smem); }
  else if (PH == 8) { convert_layer_b(p, l, smem);
    norm_phase(p, l == 0 ? nullptr : xbuf, (const float*)(p.ws + WS_U), p.norm_mix_post + l * D, mod + (size_t)l * 5 * 6144, 2, xbuf, p.norm_ffn_pre + l * D, mod + (size_t)l * 5 * 6144, 3, (bf16_t*)(p.ws + WS_H)); }
  else if (PH == 9) phase_ffn_up(p, l, smem);
  else if (PH == 11) { phase_gemm_f32((const bf16_t*)(p.ws + WS_HID), FF, FF, (const bf16_t*)(p.ws + WS_WDN), FF, (float*)(p.ws + WS_F), smem); }
  else if (PH == 12) {
    if (l == 0) { norm_phase(p, xbuf, (const float*)(p.ws + WS_F), p.norm_ffn_post, mod, 5, xbuf, p.norm_mix_pre + D, mod + (size_t)5 * 6144, 0, (bf16_t*)(p.ws + WS_H)); convert_layer_a(p, 1, smem); }
    else norm_phase(p, xbuf, (const float*)(p.ws + WS_F), p.norm_ffn_post + D, mod + (size_t)5 * 6144, 5, xbuf, nullptr, nullptr, 0, nullptr);
  }
}

#if MEGA
__global__ void __launch_bounds__(NTP, 1) mega_kernel(P p_) {
  extern __shared__ __attribute__((aligned(16))) char smem[];
  __shared__ u32x4 xb_words;
  cg::grid_group grid = cg::this_grid();
  if (ptid() == 0) xb_words = (u32x4){0u, 0u, 0u, 0u};
  __syncthreads();
#if defined(__HIP_DEVICE_COMPILE__)
  (void)xcd_barrier_post((unsigned*)(p_.ws + WS_BAR), (volatile LAS unsigned*)&xb_words);
#define GSYNC() do { XcdBarrier xb_; xb_.bar = (unsigned*)(kargs()->ws + WS_BAR); xb_.x = xb_xcc_id(); xb_.st = (volatile LAS unsigned*)&xb_words; xcd_barrier(xb_); } while (0)
#else
#define GSYNC() do { } while (0)
#endif
  run_phase<0>(0, smem); grid.sync();
  run_phase<1>(0, smem); GSYNC();
#pragma unroll
  for (int l = 0; l < 2; ++l) {
    run_phase<2>(l, smem); GSYNC();
    if (PROBE_MASK & 1) { run_phase<2>(l, smem); GSYNC(); }
    run_phase<4>(l, smem); GSYNC();
    run_phase<5>(l, smem); GSYNC();
    run_phase<6>(l, smem); GSYNC();
    if (PROBE_MASK & 8) { run_phase<6>(l, smem); GSYNC(); }
    run_phase<7>(l, smem); GSYNC();
    if (PROBE_MASK & 16) { run_phase<7>(l, smem); GSYNC(); }
    run_phase<8>(l, smem); GSYNC();
    run_phase<9>(l, smem); GSYNC();
    if (PROBE_MASK & 32) { run_phase<9>(l, smem); GSYNC(); }
    run_phase<11>(l, smem); GSYNC();
    if (PROBE_MASK & 64) { run_phase<11>(l, smem); GSYNC(); }
    run_phase<12>(l, smem); if (l == 0) GSYNC();
  }
#undef GSYNC
}
#else
template <int PH> __global__ void __launch_bounds__(NTP, 1) phase_kernel(P p, int l) {
  extern __shared__ __attribute__((aligned(16))) char smem[];
  run_phase<PH>(l, smem);
}
#endif

extern "C" void kernel_launch(void* const* d_in, const int* in_sizes, int n_in, void* d_out, int out_size, void* d_ws, size_t ws_size, hipStream_t stream) {
  if (ws_size < WS_END || n_in < 36) { fprintf(stderr, "workspace too small: %zu < %zu\n", ws_size, (size_t)WS_END); return; }
  P p{};
  const float** pp = (const float**)&p;
  for (int i = 0; i < 36; ++i) pp[i] = (const float*)d_in[i];
  p.out = (float*)d_out; p.ws = (char*)d_ws;
  hipMemsetAsync(d_ws, 0, WS_WIN, stream);
#if MEGA
  static int grid_blocks = 0;
  if (!grid_blocks) {
    int dev = 0, cus = 0, per_cu = 0; hipGetDevice(&dev);
    hipDeviceGetAttribute(&cus, hipDeviceAttributeMultiprocessorCount, dev);
    hipFuncSetAttribute((const void*)mega_kernel, hipFuncAttributeMaxDynamicSharedMemorySize, SMEM_BYTES);
    hipOccupancyMaxActiveBlocksPerMultiprocessor(&per_cu, mega_kernel, NTP, SMEM_BYTES);
    if (per_cu > 1) per_cu = 1;
    grid_blocks = cus * per_cu;
  }
  void* args[] = {&p};
  hipError_t e = hipLaunchCooperativeKernel((void*)mega_kernel, dim3(grid_blocks), dim3(NTP), args, SMEM_BYTES, stream);
  if (e != hipSuccess) fprintf(stderr, "cooperative launch failed: %s (grid %d)\n", hipGetErrorString(e), grid_blocks);
#else
  const int G = 512;
#define LAUNCH(PH, L) do { hipFuncSetAttribute((const void*)phase_kernel<PH>, hipFuncAttributeMaxDynamicSharedMemorySize, SMEM_BYTES); phase_kernel<PH><<<G, NT, SMEM_BYTES, stream>>>(p, L); } while (0)
  LAUNCH(0, 0); LAUNCH(1, 0);
  for (int l = 0; l < 2; ++l) { LAUNCH(2, l); LAUNCH(4, l); LAUNCH(5, l); LAUNCH(6, l); LAUNCH(7, l); LAUNCH(8, l); LAUNCH(9, l); LAUNCH(11, l); LAUNCH(12, l); }
#endif
}
```

```cpp
#include <hip/hip_runtime.h>
#include <hip/hip_cooperative_groups.h>
#include <cstdio>
namespace cg = cooperative_groups;

#ifndef MEGA
#define MEGA 1
#endif
#define PROBE_MASK 0
#define GEMM_F32_KU 1

typedef unsigned short bf16_t;
typedef short bf16x8 __attribute__((ext_vector_type(8)));
typedef short bf16x4 __attribute__((ext_vector_type(4)));
typedef float f32x4 __attribute__((ext_vector_type(4)));
typedef float f32x2 __attribute__((ext_vector_type(2)));
typedef unsigned u32x4 __attribute__((ext_vector_type(4)));
typedef unsigned u32x2 __attribute__((ext_vector_type(2)));
#define DI __device__ __forceinline__
#define MFMA16(a, b, c) __builtin_amdgcn_mfma_f32_16x16x32_bf16((a), (b), (c), 0, 0, 0)

constexpr int NT = 256;
constexpr int NTP = 512;
constexpr int VSMEM = 65536;
constexpr int D = 1024, MC = 8192, ML = 4096, MT = 12288;
constexpr int NZR = 1792, NZN = 1536, NZT = 2048, INC = 8448, FF = 2816;
constexpr int LDH = 1088, LDO = 576, LZT = 2112, LDG = 136;
constexpr int LDT = 72;
constexpr int SMEM_BYTES = 139264;
constexpr int SMEM_BYTES_GEMM_ = 131072;
constexpr size_t O_K = 12582912, O_V = 20971520, O_RW = 29360128, O_RT = 33554432;
constexpr size_t WS_CTRL = 0;
constexpr size_t WS_MOD = 4096;
constexpr size_t WS_BAR = 262144;
constexpr size_t WS_CUF = 278528;
constexpr size_t WS_WG = 294912;
constexpr size_t WS_WIN = 434176;
constexpr size_t WS_WUP = WS_WIN;
constexpr size_t WS_WDN = WS_WIN + (size_t)5632 * LDH * 2;
constexpr size_t WS_WO3 = WS_WIN + (size_t)INC * LDH * 2;
constexpr size_t WS_WOUT = WS_WO3 + (size_t)3 * 1024 * LDO * 2;
constexpr size_t WS_H = WS_WOUT + (size_t)1024 * LDH * 2;
constexpr size_t WS_Z = WS_H + (size_t)MT * LDH * 2;
constexpr size_t WS_ZR = WS_Z;
constexpr size_t WS_ZN = WS_ZR + (size_t)MT * NZR * 2;
constexpr size_t WS_ZT = WS_ZN + (size_t)MT * NZN * 2;
constexpr size_t WS_MERGED = WS_ZR;
constexpr size_t WS_OA = WS_ZN;
constexpr size_t WS_U = WS_ZT;
constexpr size_t WS_HID = WS_Z;
constexpr size_t WS_F = WS_ZT;
constexpr size_t WS_Y = WS_ZT + (size_t)MT * LZT * 2;
constexpr size_t WS_ONA = WS_Y + (size_t)2 * MT * 512 * 4;
constexpr size_t WS_ORET = WS_ONA + (size_t)MT * LDO * 2;
constexpr size_t WS_END = WS_ORET + (size_t)MT * LDO * 2;

struct P {
  const float *x_prompt, *x_sample, *cache_k, *cache_v, *state_rwkv, *state_ret, *c, *c_ctx, *ada_w, *ada_b;
  const float *norm_mix_pre, *norm_mix_post, *norm_ffn_pre, *norm_ffn_post, *w_in, *rwkv_conv, *rwkv_w0, *rwkv_w_up, *rwkv_a0, *rwkv_a_up, *rwkv_g_up;
  const float *rwkv_k_k, *rwkv_k_a, *rwkv_r_k, *rwkv_ln_g, *rwkv_ln_b, *na_rpb, *ret_decay, *ret_gn, *w_o_rwkv, *w_o_na, *w_o_ret, *w_out, *ffn_up, *ffn_conv, *ffn_down;
  float* out; char* ws;
};

DI int threadIdx_x_raw() { return (int)__builtin_amdgcn_workitem_id_x(); }
DI int ptid() { int t = threadIdx_x_raw(); asm volatile("" : "+v"(t)); return t; }
DI int tidx() { return ptid() & 255; }
DI int vhalf() { return ptid() >> 8; }
DI int vblk() { return (int)blockIdx.x * 2 + vhalf(); }
DI int vgrid() { return (int)gridDim.x * 2; }
DI unsigned cvt_pk_bf16(float lo, float hi) { unsigned r; asm("v_cvt_pk_bf16_f32 %0, %1, %2" : "=v"(r) : "v"(lo), "v"(hi)); return r; }
DI bf16_t f2bf(float x) { return (bf16_t)(cvt_pk_bf16(x, 0.f) & 0xffffu); }
DI float bf2f(bf16_t b) { return __uint_as_float(((unsigned)b) << 16); }
DI unsigned pack2(float a, float b) { return cvt_pk_bf16(a, b); }
DI float bflo(unsigned u) { return __uint_as_float(u << 16); }
DI float bfhi(unsigned u) { return __uint_as_float(u & 0xffff0000u); }
DI void unpack8(const u32x4 r, float (&f)[8]) { f[0] = bflo(r[0]); f[1] = bfhi(r[0]); f[2] = bflo(r[1]); f[3] = bfhi(r[1]); f[4] = bflo(r[2]); f[5] = bfhi(r[2]); f[6] = bflo(r[3]); f[7] = bfhi(r[3]); }
DI u32x4 pack8(const float (&f)[8]) { u32x4 r; r[0] = pack2(f[0], f[1]); r[1] = pack2(f[2], f[3]); r[2] = pack2(f[4], f[5]); r[3] = pack2(f[6], f[7]); return r; }
DI float sigmoidf_(float x) { return __builtin_amdgcn_rcpf(1.f + __expf(-x)); }
DI float shfl_x(float v, int m) { const int lane = ptid() & 63; return __int_as_float(__builtin_amdgcn_ds_bpermute((lane ^ m) << 2, __float_as_int(v))); }
DI float wave_sum(float v) { for (int o = 32; o > 0; o >>= 1) v += shfl_x(v, o); return v; }
DI void tokinfo(int m, int& t, int& T, int& mi) { if (m < MC) { t = m & 255; T = 256; mi = 0; } else { int q = m - MC; t = q & 1023; T = 1024; mi = 1 + (q >> 10); } }

#define XB_TMO      128
#define XB_XCNT(j)  (256  + 64 * (j))
#define XB_XSUB(j)  (1280 + 64 * (j))
#define XB_XGEN(j)  (2304 + 64 * (j))
#define XB_TOP      3328
#define XB_TOPGEN   3392
#define XB_SPIN_CAP (1u << 20)
#define LAS __attribute__((address_space(3)))
DI unsigned xb_ld(unsigned* p) { return __hip_atomic_load(p, __ATOMIC_RELAXED, __HIP_MEMORY_SCOPE_AGENT); }
DI unsigned xb_add(unsigned* p, unsigned v) { return __hip_atomic_fetch_add(p, v, __ATOMIC_RELAXED, __HIP_MEMORY_SCOPE_AGENT); }
DI unsigned xb_xcc_id() { return (unsigned)__builtin_amdgcn_s_getreg((3 << 11) | 20) & 0xFu; }
#define XB_SPIN(cond, bar) do { unsigned _sp = 0; while (cond) { __builtin_amdgcn_s_sleep(1); \
    if ((++_sp & 255u) == 0u) { if (xb_ld(&(bar)[XB_TMO])) break; if (_sp > XB_SPIN_CAP) { atomicAdd(&(bar)[XB_TMO], 1u); break; } } } } while (0)
struct XcdBarrier { unsigned* bar; unsigned x; volatile LAS unsigned* st; };
DI XcdBarrier xcd_barrier_post(unsigned* bar, volatile LAS unsigned* st) {
  XcdBarrier b; b.bar = bar; b.x = xb_xcc_id(); b.st = st;
  if (ptid() == 0) (void)xb_add(&bar[XB_XCNT(b.x)], 1u);
  return b;
}
DI void xcd_barrier_complete(unsigned* bar, unsigned x, unsigned& nloc, unsigned& nx) {
  const unsigned G = gridDim.x * gridDim.y * gridDim.z;
  unsigned sum, cnt, mine, sp = 0u;
  for (;;) {
    sum = 0u; cnt = 0u; mine = 0u;
#pragma unroll
    for (unsigned j = 0; j < 16; ++j) { const unsigned c = xb_ld(&bar[XB_XCNT(j)]); sum += c; cnt += (c > 0u) ? 1u : 0u; mine = (j == x) ? c : mine; }
    if (sum == G) break;
    __builtin_amdgcn_s_sleep(1);
    if ((++sp & 255u) == 0u) { if (xb_ld(&bar[XB_TMO])) break; if (sp > XB_SPIN_CAP) { atomicAdd(&bar[XB_TMO], 1u); break; } }
  }
  nloc = mine > 0u ? mine : 1u; nx = cnt > 0u ? cnt : 1u;
}
DI void xcd_barrier(const XcdBarrier& b) {
  asm volatile("s_waitcnt vmcnt(0)" ::: "memory");
  __syncthreads();
  if (ptid() == 0) {
    unsigned* bar = b.bar;
    __builtin_amdgcn_s_waitcnt(0);
    unsigned nloc = b.st[0], nx = b.st[1];
    if (nloc == 0u) { xcd_barrier_complete(bar, b.x, nloc, nx); b.st[0] = nloc; b.st[1] = nx; }
    const unsigned old = xb_add(&bar[XB_XSUB(b.x)], 1u);
    const unsigned gen = old / nloc;
    if (old + 1u == (gen + 1u) * nloc) {
      __builtin_amdgcn_fence(__ATOMIC_RELEASE, "agent");
      asm volatile("s_waitcnt vmcnt(0)" ::: "memory");
      const unsigned og = xb_add(&bar[XB_TOP], 1u);
      const unsigned tg = og / nx;
      if (og + 1u == (tg + 1u) * nx) xb_add(&bar[XB_TOPGEN], 1u);
      else XB_SPIN(xb_ld(&bar[XB_TOPGEN]) == tg, bar);
      __builtin_amdgcn_fence(__ATOMIC_ACQUIRE, "agent");
      xb_add(&bar[XB_XGEN(b.x)], 1u);
      asm volatile("s_waitcnt vmcnt(0)" ::: "memory");
    } else {
      XB_SPIN(xb_ld(&bar[XB_XGEN(b.x)]) == gen, bar);
      __builtin_amdgcn_fence(__ATOMIC_ACQUIRE, "agent");
      asm volatile("s_waitcnt vmcnt(0)" ::: "memory");
    }
  }
  __syncthreads();
}

__device__ void convert_T(const float* __restrict__ W, int K, int N, bf16_t* __restrict__ Wt, int ldt, char* smem) {
  float* t = (float*)(smem + vhalf() * VSMEM);
  const int tid = tidx(), ntn = N >> 6, nitems = (K >> 6) * ntn;
  const int kr = tid >> 4, c4 = (tid & 15) * 4;
  f32x4 v[4];
  { const int it = vblk() < nitems ? vblk() : 0; const int k0 = (it / ntn) << 6, n0 = (it % ntn) << 6;
#pragma unroll
    for (int i = 0; i < 4; ++i) v[i] = *(const f32x4*)(W + (size_t)(k0 + kr + 16 * i) * N + n0 + c4); }
  for (int it = vblk(); it < nitems; it += vgrid()) {
    const int k0 = (it / ntn) << 6, n0 = (it % ntn) << 6;
    __syncthreads();
#pragma unroll
    for (int i = 0; i < 4; ++i) { const int k = kr + 16 * i; t[k * 65 + c4] = v[i][0]; t[k * 65 + c4 + 1] = v[i][1]; t[k * 65 + c4 + 2] = v[i][2]; t[k * 65 + c4 + 3] = v[i][3]; }
    __syncthreads();
    { const int itn = it + vgrid() < nitems ? it + vgrid() : it; const int k1 = (itn / ntn) << 6, n1 = (itn % ntn) << 6;
#pragma unroll
      for (int i = 0; i < 4; ++i) v[i] = *(const f32x4*)(W + (size_t)(k1 + kr + 16 * i) * N + n1 + c4); }
#pragma unroll
    for (int i = 0; i < 2; ++i) { const int c = tid + 256 * i, n = c >> 3, kc = c & 7; float f[8];
#pragma unroll
      for (int e = 0; e < 8; ++e) f[e] = t[(kc * 8 + e) * 65 + n];
      *(u32x4*)(Wt + (size_t)(n0 + n) * ldt + k0 + kc * 8) = pack8(f); }
  }
}

__device__ void ada_phase(const P& p, char* smem) {
  float* sc = (float*)(smem + vhalf() * VSMEM);
  float* red = sc + 640;
  float* mod = (float*)(p.ws + WS_MOD);
  const int tid = tidx(), kq = tid >> 5, cq = tid & 31;
  for (int it = vblk(); it < 2 * 48 * 8; it += vgrid()) {
    const int l = it / 384, rem = it % 384, nb = rem >> 3, ks = rem & 7;
    const int n0 = nb * 128, k0 = ks * 128;
    __syncthreads();
    for (int e = tid; e < 640; e += NT) { const int i = e >> 7, k = e & 127; const float v = (i == 0) ? p.c_ctx[k0 + k] : p.c[(i - 1) * D + k0 + k]; sc[e] = v * sigmoidf_(v); }
    __syncthreads();
    float acc[5][4];
#pragma unroll
    for (int i = 0; i < 5; ++i)
#pragma unroll
      for (int j = 0; j < 4; ++j) acc[i][j] = 0.f;
    const float* wp = p.ada_w + ((size_t)l * D + k0 + kq * 16) * 6144 + n0 + cq * 4;
#pragma unroll 4
    for (int kk = 0; kk < 16; ++kk) { const float4 w = *(const float4*)(wp + (size_t)kk * 6144);
#pragma unroll
      for (int i = 0; i < 5; ++i) { const float s = sc[i * 128 + kq * 16 + kk]; acc[i][0] += s * w.x; acc[i][1] += s * w.y; acc[i][2] += s * w.z; acc[i][3] += s * w.w; } }
#pragma unroll
    for (int i = 0; i < 5; ++i)
#pragma unroll
      for (int j = 0; j < 4; ++j) red[(kq * 5 + i) * 128 + cq * 4 + j] = acc[i][j];
    __syncthreads();
    for (int e = tid; e < 640; e += NT) { const int i = e >> 7, n = e & 127; float s = 0.f;
#pragma unroll
      for (int q = 0; q < 8; ++q) s += red[(q * 5 + i) * 128 + n];
      if (ks == 0) s += p.ada_b[l * 6144 + n0 + n];
      atomicAdd(mod + ((size_t)l * 5 + i) * 6144 + n0 + n, s); }
  }
}

__device__ void norm_phase(const P& p, const float* xin  , const float* u, const float* gpost, const float* modU, int gate_idx,
                           float* xout, const float* gpre, const float* modN, int shift_idx, bf16_t* hout) {
  const int lane = tidx() & 63, wave = tidx() >> 6, nw = NT / 64;
  for (int m = vblk() * nw + wave; m < MT; m += vgrid() * nw) {
    int t, T, mi; tokinfo(m, t, T, mi);
    const float* xr = xin ? xin + (size_t)m * D : (m < MC ? p.x_prompt + (size_t)m * D : p.x_sample + (size_t)(m - MC) * D);
    float4 x[4];
#pragma unroll
    for (int i = 0; i < 4; ++i) x[i] = *(const float4*)(xr + i * 256 + lane * 4);
    if (u) {
      float4 uu[4]; float ss = 0.f;
#pragma unroll
      for (int i = 0; i < 4; ++i) { uu[i] = *(const float4*)(u + (size_t)m * D + i * 256 + lane * 4); ss += uu[i].x * uu[i].x + uu[i].y * uu[i].y + uu[i].z * uu[i].z + uu[i].w * uu[i].w; }
      ss = wave_sum(ss); const float rs = rsqrtf(ss * (1.f / D) + 1e-6f);
#pragma unroll
      for (int i = 0; i < 4; ++i) { const int c = i * 256 + lane * 4; const float4 g = *(const float4*)(gpost + c); const float4 ga = *(const float4*)(modU + ((size_t)mi * 6 + gate_idx) * D + c);
        x[i].x += ga.x * uu[i].x * rs * g.x; x[i].y += ga.y * uu[i].y * rs * g.y; x[i].z += ga.z * uu[i].z * rs * g.z; x[i].w += ga.w * uu[i].w * rs * g.w; }
    }
    if (xout) {
#pragma unroll
      for (int i = 0; i < 4; ++i) *(float4*)(xout + (size_t)m * D + i * 256 + lane * 4) = x[i];
    }
    if (hout) {
      float ss = 0.f;
#pragma unroll
      for (int i = 0; i < 4; ++i) ss += x[i].x * x[i].x + x[i].y * x[i].y + x[i].z * x[i].z + x[i].w * x[i].w;
      ss = wave_sum(ss); const float rs = rsqrtf(ss * (1.f / D) + 1e-6f);
#pragma unroll
      for (int i = 0; i < 4; ++i) { const int c = i * 256 + lane * 4; const float4 g = *(const float4*)(gpre + c);
        const float4 sh = *(const float4*)(modN + ((size_t)mi * 6 + shift_idx) * D + c); const float4 sc = *(const float4*)(modN + ((size_t)mi * 6 + shift_idx + 1) * D + c);
        u32x2 o; o.x = pack2(x[i].x * rs * g.x * (1.f + sc.x) + sh.x, x[i].y * rs * g.y * (1.f + sc.y) + sh.y); o.y = pack2(x[i].z * rs * g.z * (1.f + sc.z) + sh.z, x[i].w * rs * g.w * (1.f + sc.w) + sh.w);
        *(u32x2*)(hout + (size_t)m * LDH + c) = o; }
    }
  }
}

struct TileSrc { const bf16_t* A; int lda; int arow0; const bf16_t* B; int ldb; int brow0, brow1; int K; };

template <int MM, int NN> DI void zero_acc(f32x4 (&acc)[MM][NN]) {
#pragma unroll
  for (int m = 0; m < MM; ++m)
#pragma unroll
    for (int n = 0; n < NN; ++n) acc[m][n] = (f32x4){0.f, 0.f, 0.f, 0.f};
}

template <int MM, int NN, int KU = 0> struct Gemm {
  static constexpr int NA = MM / 2, NB = NN;
  unsigned oa_[NA], ob_[NB]; const bf16_t* A; const bf16_t* B; int nk; u32x4 ra[NA], rb[NB];
#define GT_LOAD(KT) do { const int kn_ = ((KT) < nk ? (KT) : nk - 1) * 64; \
    _Pragma("unroll") for (int i = 0; i < NA; ++i) ra[i] = *(const u32x4*)(A + (oa_[i] + kn_)); \
    _Pragma("unroll") for (int i = 0; i < NB; ++i) rb[i] = *(const u32x4*)(B + (ob_[i] + kn_)); } while (0)
  DI void begin(const TileSrc& s, const bool perm = false) {
    const int tid = ptid();
#pragma unroll
    for (int i = 0; i < NA; ++i) { const int row = (tid >> 3) + 64 * i, kc = tid & 7;
      int ar = s.arow0 + row; ar = ar < 0 ? 0 : (ar > MT - 1 ? MT - 1 : ar);
      oa_[i] = (unsigned)ar * (unsigned)s.lda + kc * 8; }
#pragma unroll
    for (int i = 0; i < NB; ++i) { const int row = (tid >> 3) + 64 * i, kc = tid & 7;
      const int rr = perm ? ((row & ~31) | (8 * ((row & 15) >> 2) + 4 * ((row >> 4) & 1) + (row & 3))) : row;
      const int br = rr < 32 * NN ? s.brow0 + rr : s.brow1 + rr - 32 * NN;
      ob_[i] = (unsigned)br * (unsigned)s.ldb + kc * 8; }
    A = s.A; B = s.B; nk = s.K >> 6;
    GT_LOAD(0);
  }
  DI void run(f32x4 (&acc)[MM][NN], char* smem) {
    bf16_t* sbase = (bf16_t*)smem;
    const int tid = ptid(), lane = tid & 63, wave = tid >> 6, wr = wave >> 2, wc = wave & 3, fr = lane & 15, fq = lane >> 4;
    int wofs; { const int r = tid >> 3, kc = tid & 7, ob = (r & 15) * 64 + (kc & 3) * 16; wofs = (((r >> 4) * 2 + (kc >> 2)) * 1024 + (ob ^ (((ob >> 9) & 1) << 5))) >> 1; }
    int robase; { const int ob = fr * 64 + fq * 16; robase = (ob ^ (((ob >> 9) & 1) << 5)) >> 1; }
#define GT_STORE(ST) do { bf16_t* sA_ = sbase + (ST) * 32768; bf16_t* sB_ = sA_ + 16384; \
    _Pragma("unroll") for (int i = 0; i < NA; ++i) *(u32x4*)(sA_ + wofs + i * 4096) = ra[i]; \
    _Pragma("unroll") for (int i = 0; i < NB; ++i) *(u32x4*)(sB_ + wofs + i * 4096) = rb[i]; } while (0)
#define GT_KSTEP(ks) do { bf16x8 bfr[NN]; \
      _Pragma("unroll") for (int n = 0; n < NN; ++n) bfr[n] = *(const bf16x8*)(sB_ + ((wc * NN + n) * 2 + (ks)) * 512); \
      _Pragma("unroll") for (int m = 0; m < MM; ++m) { const bf16x8 af = *(const bf16x8*)(sA_ + ((wr * MM + m) * 2 + (ks)) * 512); \
        _Pragma("unroll") for (int n = 0; n < NN; ++n) acc[m][n] = MFMA16(bfr[n], af, acc[m][n]); } } while (0)
#define GT_COMPUTE(ST) do { const bf16_t* sA_ = sbase + (ST) * 32768 + robase; const bf16_t* sB_ = sA_ + 16384; __builtin_amdgcn_s_setprio(1); \
    if (KU) { GT_KSTEP(0); GT_KSTEP(1); } else { _Pragma("unroll 1") for (int ks = 0; ks < 2; ++ks) GT_KSTEP(ks); } \
    __builtin_amdgcn_s_setprio(0); } while (0)
    __syncthreads();
    GT_STORE(0);
    GT_LOAD(1);
    __syncthreads();
#pragma unroll 1
    for (int kt = 0; kt < nk; kt += 2) {
      GT_STORE(1); GT_LOAD(kt + 2); GT_COMPUTE(0); __syncthreads();
      GT_STORE(0); GT_LOAD(kt + 3); GT_COMPUTE(1); __syncthreads();
    }
  }
#undef GT_LOAD
#undef GT_STORE
#undef GT_COMPUTE
#undef GT_KSTEP
};
template <int MM, int NN> DI void gemm_tile(f32x4 (&acc)[MM][NN], const TileSrc& s, char* smem) { Gemm<MM, NN> g; g.begin(s); g.run(acc, smem); }

DI float gelu_tanh(float x) { const float u = 0.7978845608f * (x + 0.044715f * x * x * x); const float e = __expf(2.f * u); const float th = 1.f - 2.f * __builtin_amdgcn_rcpf(e + 1.f); return 0.5f * x * (1.f + th); }

struct TileIter {
  int m_lo, rows, NTn, G, efull, count, e, stride;
  DI void init(int MTn, int NTn_) { const int x = blockIdx.x & 7; m_lo = (x * MTn) >> 3; rows = (((x + 1) * MTn) >> 3) - m_lo; NTn = NTn_; G = (rows + 1) >> 1;
    efull = (rows / G) * G * NTn; count = rows * NTn; e = blockIdx.x >> 3; stride = gridDim.x >> 3; }
  DI bool next(int& mt, int& nt) { if (e >= count) return false;
    if (e < efull) { const int grp = e / (G * NTn), rem = e - grp * G * NTn; nt = rem / G; mt = m_lo + grp * G + (rem - nt * G); }
    else { const int rem = e - efull, gsz = rows - (rows / G) * G; nt = rem / gsz; mt = m_lo + (rows / G) * G + (rem - nt * gsz); }
    e += stride; return true; }
};

__device__ void phase_win(const P& p, int l, char* smem) {
  const bf16_t* H = (const bf16_t*)(p.ws + WS_H); const bf16_t* Wt = (const bf16_t*)(p.ws + WS_WIN);
  bf16_t* zr = (bf16_t*)(p.ws + WS_ZR); bf16_t* zn = (bf16_t*)(p.ws + WS_ZN); bf16_t* zt = (bf16_t*)(p.ws + WS_ZT);
  const int tid = ptid(), lane = tid & 63, wave = tid >> 6, wr = wave >> 2, wc = wave & 3, fr = lane & 15, fq = lane >> 4;
  Gemm<8, 4> gm;
  TileIter ti; ti.init(48, 14);
  const int x = blockIdx.x & 7, nconv = (343 - x + 7) >> 3, nloc = ti.count + nconv;
  const float* cw = p.rwkv_conv + (size_t)l * 3 * NZR;
  for (int e = (int)(blockIdx.x >> 3); e < nloc; e += (int)(gridDim.x >> 3)) {
    f32x4 acc[8][4]; zero_acc<8, 4>(acc);
    if (e < nconv) {
      const int c = x + 8 * e, mt = c / 7, nt = c - mt * 7;
      const int n0 = nt * 256, arow0 = mt * 254 - 1;
      { TileSrc s{H, LDH, arow0, Wt, LDH, n0, n0 + 128, D}; gm.begin(s); }
      gm.run(acc, smem);
      float* sC = (float*)smem;
#pragma unroll 1
      for (int sl = 0; sl < 2; ++sl) {
        __syncthreads();
        if ((wc >> 1) == sl) {
#pragma unroll
          for (int m = 0; m < 8; ++m)
#pragma unroll
            for (int n = 0; n < 4; ++n) *(f32x4*)(sC + (wr * 128 + m * 16 + fr) * 132 + (wc & 1) * 64 + n * 16 + fq * 4) = acc[m][n];
        }
        __syncthreads();
        const int nb = n0 + sl * 128, c8 = (tid & 15) * 8;
        const f32x4 w0a = *(const f32x4*)(cw + nb + c8), w0b = *(const f32x4*)(cw + nb + c8 + 4), w1a = *(const f32x4*)(cw + NZR + nb + c8), w1b = *(const f32x4*)(cw + NZR + nb + c8 + 4),
                    w2a = *(const f32x4*)(cw + 2 * NZR + nb + c8), w2b = *(const f32x4*)(cw + 2 * NZR + nb + c8 + 4);
        const bool sg = nb + c8 >= 1664;
        for (int ee = tid; ee < 254 * 16; ee += NTP) {
          const int tr = 1 + (ee >> 4), g = arow0 + tr;
          if (g < MT) { int t, T, mi; tokinfo(g, t, T, mi);
            const float pm = t > 0 ? 1.f : 0.f, nm = t < T - 1 ? 1.f : 0.f;
            const float* r0 = sC + (tr - 1) * 132 + c8; const float* r1 = r0 + 132; const float* r2 = r1 + 132;
            f32x4 ya = (*(const f32x4*)r0 * w0a) * pm + *(const f32x4*)r1 * w1a + (*(const f32x4*)r2 * w2a) * nm;
            f32x4 yb = (*(const f32x4*)(r0 + 4) * w0b) * pm + *(const f32x4*)(r1 + 4) * w1b + (*(const f32x4*)(r2 + 4) * w2b) * nm;
            if (sg) {
#pragma unroll
              for (int j = 0; j < 4; ++j) { ya[j] = sigmoidf_(ya[j]); yb[j] = sigmoidf_(yb[j]); } }
            const u32x4 o = {pack2(ya[0], ya[1]), pack2(ya[2], ya[3]), pack2(yb[0], yb[1]), pack2(yb[2], yb[3])};
            *(u32x4*)(zr + (size_t)g * NZR + nb + c8) = o; }
        }
      }
    } else {
      int mt, nt; ti.e = e - nconv; ti.next(mt, nt);
      const int n0 = nt * 256, row0 = mt * 256;
      { TileSrc s{H, LDH, row0, Wt, LDH, NZR + n0, NZR + n0 + 128, D}; gm.begin(s, true); }
      gm.run(acc, smem);
#pragma unroll
      for (int m = 0; m < 8; ++m) { const int row = row0 + wr * 128 + m * 16 + fr;
#pragma unroll
        for (int g = 0; g < 2; ++g) { const int col = n0 + wc * 64 + g * 32 + fq * 8; const f32x4 v0 = acc[m][2 * g], v1 = acc[m][2 * g + 1];
          const u32x4 o = {pack2(v0[0], v0[1]), pack2(v0[2], v0[3]), pack2(v1[0], v1[1]), pack2(v1[2], v1[3])};
          if (col < NZN) {
            *(u32x4*)(zn + (size_t)row * NZN + col) = o;
            if (row < MC && col >= 512) { const int part = col - 512, isv = part >> 9, pp = part & 511, hh = pp >> 6, d = pp & 63, b = row >> 8, t = row & 255;
              float* dst = p.out + (isv ? O_V : O_K) + ((((size_t)b * 2 + l) * 8 + hh) * 256 + t) * 64 + d; *(f32x4*)dst = v0; *(f32x4*)(dst + 4) = v1; }
          } else { *(u32x4*)(zt + (size_t)row * LZT + (col - NZN)) = o; }
        } }
    }
  }
}

__device__ void phase_merge(const P& p, char* smem) {
  const bf16_t* H = (const bf16_t*)(p.ws + WS_H); const bf16_t* Wt = (const bf16_t*)(p.ws + WS_WIN); const bf16_t* Wo3 = (const bf16_t*)(p.ws + WS_WO3);
  bf16_t* mg = (bf16_t*)(p.ws + WS_MERGED);
  const int tid = ptid(), lane = tid & 63, wave = tid >> 6, wr = wave >> 2, wc = wave & 3, fr = lane & 15, fq = lane >> 4;
  TileIter ti; int mt, nt; ti.init(96, 8);
  while (ti.next(mt, nt)) {
    const int n0 = nt * 128, row0 = mt * 128;
    f32x4 macc[4][2]; zero_acc<4, 2>(macc);
#pragma unroll 1
    for (int i = 0; i < 3; ++i) {
      const bf16_t* O = (const bf16_t*)(p.ws + (i == 0 ? WS_OA : (i == 1 ? WS_ONA : WS_ORET)));
      f32x4 g[4][2]; zero_acc<4, 2>(g);
      { TileSrc s{H, LDH, row0, Wt, LDH, 5376 + i * 1024 + n0, 5376 + i * 1024 + n0 + 64, D}; { Gemm<4, 2, 1> gm; gm.begin(s, true); gm.run(g, smem); } }
      f32x4 a2[4][2]; zero_acc<4, 2>(a2);
      { TileSrc s{O, LDO, row0, Wo3 + (size_t)i * 1024 * LDO, LDO, n0, n0 + 64, 512}; { Gemm<4, 2, 1> gm; gm.begin(s, true); gm.run(a2, smem); } }
#pragma unroll
      for (int m = 0; m < 4; ++m)
#pragma unroll
        for (int n = 0; n < 2; ++n)
#pragma unroll
          for (int j = 0; j < 4; ++j) macc[m][n][j] += sigmoidf_(g[m][n][j]) * a2[m][n][j];
    }
#pragma unroll
    for (int m = 0; m < 4; ++m) { const int row = row0 + wr * 64 + m * 16 + fr;
      { const int col = n0 + wc * 32 + fq * 8; const u32x4 o = {pack2(macc[m][0][0], macc[m][0][1]), pack2(macc[m][0][2], macc[m][0][3]), pack2(macc[m][1][0], macc[m][1][1]), pack2(macc[m][1][2], macc[m][1][3])}; *(u32x4*)(mg + (size_t)row * LDH + col) = o; } }
  }
}

__device__ void phase_gemm_f32(const bf16_t* A, int lda, int K, const bf16_t* Bt, int ldb, float* C, char* smem) {
  const int tid = ptid(), lane = tid & 63, wave = tid >> 6, wr = wave >> 2, wc = wave & 3, fr = lane & 15, fq = lane >> 4;
  TileIter ti; int mt, nt; ti.init(64, 4);
  while (ti.next(mt, nt)) {
    const int n0 = nt * 256, row0 = mt * 192;
    f32x4 acc[6][4]; zero_acc<6, 4>(acc);
    TileSrc s{A, lda, row0, Bt, ldb, n0, n0 + 128, K}; { Gemm<6, 4, GEMM_F32_KU> gm; gm.begin(s, true); gm.run(acc, smem); }
#pragma unroll
    for (int m = 0; m < 6; ++m) { const int row = row0 + wr * 96 + m * 16 + fr;
#pragma unroll
      for (int g = 0; g < 2; ++g) { float* dst = C + (size_t)row * D + n0 + wc * 64 + g * 32 + fq * 8; *(f32x4*)dst = acc[m][2 * g]; *(f32x4*)(dst + 4) = acc[m][2 * g + 1]; } }
  }
}

__device__ void phase_ffn_up(const P& p, int l, char* smem) {
  const bf16_t* H = (const bf16_t*)(p.ws + WS_H); const bf16_t* Wt = (const bf16_t*)(p.ws + WS_WUP); bf16_t* hid = (bf16_t*)(p.ws + WS_HID);
  const int tid = ptid(), lane = tid & 63, wave = tid >> 6, wr = wave >> 2, wc = wave & 3, fr = lane & 15, fq = lane >> 4;
  const float* cw = p.ffn_conv + (size_t)l * 3 * 2 * FF;
  TileIter ti; int mt, nt; ti.init(49, 22);
  Gemm<8, 4> gm;
  while (ti.next(mt, nt)) {
    const int c0 = nt * 128, arow0 = mt * 254 - 1;
    f32x4 acc[8][4]; zero_acc<8, 4>(acc);
    { TileSrc s{H, LDH, arow0, Wt, LDH, c0, FF + c0, D}; gm.begin(s); }
    gm.run(acc, smem);
    float* sC = (float*)smem;
#pragma unroll 1
    for (int sl = 0; sl < 2; ++sl) {
      __syncthreads();
      if ((wc & 1) == sl) { const int cb = (wc >> 1) * 64;
#pragma unroll
        for (int m = 0; m < 8; ++m)
#pragma unroll
          for (int n = 0; n < 4; ++n) *(f32x4*)(sC + (wr * 128 + m * 16 + fr) * 132 + cb + n * 16 + fq * 4) = acc[m][n];
      }
      __syncthreads();
      const int cq = c0 + sl * 64, c4 = (tid & 15) * 4;
      const f32x4 v0 = *(const f32x4*)(cw + cq + c4), v1 = *(const f32x4*)(cw + 2 * FF + cq + c4), v2 = *(const f32x4*)(cw + 4 * FF + cq + c4);
      const f32x4 g0 = *(const f32x4*)(cw + FF + cq + c4), g1 = *(const f32x4*)(cw + 3 * FF + cq + c4), g2 = *(const f32x4*)(cw + 5 * FF + cq + c4);
      for (int e = tid; e < 254 * 16; e += NTP) {
        const int tr = 1 + (e >> 4), g = arow0 + tr;
        if (g < MT) { int t, T, mi; tokinfo(g, t, T, mi);
          const float pm = t > 0 ? 1.f : 0.f, nm = t < T - 1 ? 1.f : 0.f;
          const f32x4 va = *(const f32x4*)(sC + (tr - 1) * 132 + c4), vb = *(const f32x4*)(sC + tr * 132 + c4), vc = *(const f32x4*)(sC + (tr + 1) * 132 + c4);
          const f32x4 ga = *(const f32x4*)(sC + (tr - 1) * 132 + 64 + c4), gb = *(const f32x4*)(sC + tr * 132 + 64 + c4), gc = *(const f32x4*)(sC + (tr + 1) * 132 + 64 + c4);
          float r[4];
#pragma unroll
          for (int j = 0; j < 4; ++j) { const float val = pm * va[j] * v0[j] + vb[j] * v1[j] + nm * vc[j] * v2[j]; const float gt = pm * ga[j] * g0[j] + gb[j] * g1[j] + nm * gc[j] * g2[j]; r[j] = gelu_tanh(gt) * val; }
          u32x2 o; o.x = pack2(r[0], r[1]); o.y = pack2(r[2], r[3]);
          *(u32x2*)(hid + (size_t)g * FF + cq + c4) = o; }
      }
    }
  }
}

template <int CTRL> DI float dppf(float v) { return __int_as_float(__builtin_amdgcn_mov_dpp(__float_as_int(v), CTRL, 0xF, 0xF, true)); }
DI float row16_sum(float v) { v += dppf<0xB1>(v); v += dppf<0x4E>(v); v += dppf<0x141>(v); v += dppf<0x140>(v); return v; }

DI float frcp(float x) { return __builtin_amdgcn_rcpf(x); }
DI float fsig(float x) { return frcp(1.f + __expf(-x)); }
__device__ void scan_task(const P& p, int l, int seq, int h, int d, int half, char* smem) {
  float* sR = (float*)smem; float* sW = sR + 1024; float* sKD = sW + 1024; float* sB = sKD + 1024; float* sNK = sB + 1024; float* sV = sNK + 1024; float* sK = sV + 1024; float* sY = sK + 1024;
  float* sKn = sY + 2048; float* sKK = sKn + 16; bf16_t* sWT = (bf16_t*)(sKK + 64); bf16_t* sAL = sWT + 16 * LDT;
  const int tid = tidx(), lane = tid & 63, wave = tid >> 6, fr = lane & 15, fq = lane >> 4;
  const int row0 = seq < 32 ? seq * 256 : MC + (seq - 32) * 1024, T = seq < 32 ? 256 : 1024, nch = T >> 4;
  const bf16_t* zr = (const bf16_t*)(p.ws + WS_ZR);
  float* yout = (float*)(p.ws + WS_Y) + (size_t)d * MT * 512;
  __syncthreads();
  if (tid < 64) sKK[tid] = p.rwkv_k_k[l * 512 + h * 64 + tid];
  const int cc = wave * 16 + fr, gc = h * 64 + cc;
  bf16x8 bw[2], ba[2];
#pragma unroll
  for (int ks = 0; ks < 2; ++ks)
#pragma unroll
    for (int e = 0; e < 8; ++e) { const int k = ks * 32 + fq * 8 + e;
      bw[ks][e] = (short)f2bf(p.rwkv_w_up[((size_t)(l * 2 + d) * 64 + k) * 512 + gc]); ba[ks][e] = (short)f2bf(p.rwkv_a_up[((size_t)(l * 2 + d) * 64 + k) * 512 + gc]); }
  const float w0c = p.rwkv_w0[(l * 2 + d) * 512 + gc], a0c = p.rwkv_a0[(l * 2 + d) * 512 + gc], kac = p.rwkv_k_a[l * 512 + gc];
  const int rg = tid >> 4, kq = tid & 15, rbase = half * 32 + rg * 2;
  f32x2 S[2][2];
  if (seq >= 32) { const float* s0 = p.state_rwkv + (((((size_t)(seq - 32) * 2 + l) * 2 + d) * 8 + h) * 64 + rbase) * 64 + kq * 4;
#pragma unroll
    for (int r = 0; r < 2; ++r) { const f32x4 x = *(const f32x4*)(s0 + r * 64); S[r][0] = (f32x2){x[0], x[1]}; S[r][1] = (f32x2){x[2], x[3]}; } }
  else {
#pragma unroll
    for (int r = 0; r < 2; ++r) { S[r][0] = (f32x2){0.f, 0.f}; S[r][1] = (f32x2){0.f, 0.f}; } }
  if (seq >= 32) __builtin_amdgcn_s_setprio(2);
  const int at = (tid & 127) >> 3, apart = tid & 7, ahi = tid >> 7;
  size_t coff[3];
  { const int sb0 = ahi ? 512 + h * 64 : h * 64, sb1 = ahi ? 1536 : 1024 + h * 64, sb2 = 1600;
    coff[0] = (size_t)at * NZR + sb0 + apart * 8; coff[1] = (size_t)at * NZR + sb1 + apart * 8; coff[2] = (size_t)at * NZR + sb2 + apart * 8; }
  u32x4 pre[3];
  { const int t0 = (d ? nch - 1 : 0) * 16;
#pragma unroll
    for (int i = 0; i < 3; ++i) pre[i] = *(const u32x4*)(zr + (size_t)(row0 + t0) * NZR + coff[i]); }
  __syncthreads();
  for (int ci = 0; ci < nch; ++ci) {
    const int chunk = d ? nch - 1 - ci : ci, t0 = chunk * 16;
    { const int o = at * 64 + apart * 8; float f[8];
      unpack8(pre[0], f);
      if (ahi == 0) { *(f32x4*)(sR + o) = (f32x4){f[0], f[1], f[2], f[3]}; *(f32x4*)(sR + o + 4) = (f32x4){f[4], f[5], f[6], f[7]}; }
      else { *(f32x4*)(sK + o) = (f32x4){f[0], f[1], f[2], f[3]}; *(f32x4*)(sK + o + 4) = (f32x4){f[4], f[5], f[6], f[7]}; float ps = 0.f;
#pragma unroll
        for (int e = 0; e < 8; ++e) { const float kk = f[e] * sKK[apart * 8 + e]; ps += kk * kk; }
        ps += dppf<0xB1>(ps); ps += dppf<0x4E>(ps); ps += dppf<0x141>(ps);
        if (apart == 0) sKn[at] = ps; }
      unpack8(pre[1], f);
      if (ahi == 0) { *(f32x4*)(sV + o) = (f32x4){f[0], f[1], f[2], f[3]}; *(f32x4*)(sV + o + 4) = (f32x4){f[4], f[5], f[6], f[7]}; }
      else { float g[8];
#pragma unroll
        for (int e = 0; e < 8; ++e) g[e] = 1.f - 2.f * frcp(__expf(2.f * f[e]) + 1.f);
        *(u32x4*)(sWT + at * LDT + apart * 8) = pack8(g); }
      if (ahi == 0) *(u32x4*)(sAL + at * LDT + apart * 8) = pre[2];
    }
    __syncthreads();
    {
      f32x4 aw = {0.f, 0.f, 0.f, 0.f}, aa = {0.f, 0.f, 0.f, 0.f};
#pragma unroll
      for (int ks = 0; ks < 2; ++ks) { const bf16x8 fw = *(const bf16x8*)(sWT + fr * LDT + ks * 32 + fq * 8); const bf16x8 fa = *(const bf16x8*)(sAL + fr * LDT + ks * 32 + fq * 8);
        aw = MFMA16(fw, bw[ks], aw); aa = MFMA16(fa, ba[ks], aa); }
      const float kkc = sKK[cc];
#pragma unroll
      for (int j = 0; j < 4; ++j) { const int t = fq * 4 + j, o = t * 64 + cc;
        const float dec = __expf(-0.6065306597f * fsig(w0c + aw[j]));
        const float a = fsig(a0c + aa[j]);
        const float kv = sK[o];
        const float kkv = kv * kkc * __builtin_amdgcn_rsqf(fmaxf(sKn[t], 1e-24f));
        sW[o] = dec; sKD[o] = kv * (1.f + (a - 1.f) * kac); sB[o] = kkv * a; sNK[o] = -kkv; }
    }
    __syncthreads();
    { const int cn = ci + 1 < nch ? ci + 1 : ci; const int nt0 = (d ? nch - 1 - cn : cn) * 16;
#pragma unroll
      for (int i = 0; i < 3; ++i) pre[i] = *(const u32x4*)(zr + (size_t)(row0 + nt0) * NZR + coff[i]); }
#pragma unroll 8
    for (int si = 0; si < 16; ++si) {
      const int t = d ? 15 - si : si, o = t * 64 + kq * 4;
      const f32x4 an4 = *(const f32x4*)(sNK + o), w4 = *(const f32x4*)(sW + o), b4 = *(const f32x4*)(sB + o), kd4 = *(const f32x4*)(sKD + o), r4 = *(const f32x4*)(sR + o);
      const f32x2 v2 = *(const f32x2*)(sV + t * 64 + rbase);
      const f32x2 an[2] = {{an4[0], an4[1]}, {an4[2], an4[3]}}, wv[2] = {{w4[0], w4[1]}, {w4[2], w4[3]}}, bv[2] = {{b4[0], b4[1]}, {b4[2], b4[3]}}, kd[2] = {{kd4[0], kd4[1]}, {kd4[2], kd4[3]}}, rv[2] = {{r4[0], r4[1]}, {r4[2], r4[3]}};
      float sa[2];
#pragma unroll
      for (int r = 0; r < 2; ++r) { const f32x2 t2 = S[r][0] * an[0] + S[r][1] * an[1]; sa[r] = row16_sum(t2.x + t2.y); }
      f32x2 yv;
#pragma unroll
      for (int r = 0; r < 2; ++r) { const f32x2 sav = {sa[r], sa[r]}, vvv = {v2[r], v2[r]};
        S[r][0] = S[r][0] * wv[0] + (sav * bv[0] + vvv * kd[0]); S[r][1] = S[r][1] * wv[1] + (sav * bv[1] + vvv * kd[1]);
        const f32x2 y2 = S[r][0] * rv[0] + S[r][1] * rv[1]; float yp = y2.x + y2.y; yp += dppf<0xB1>(yp); yp += dppf<0x4E>(yp); yv[r] = yp; }
      if ((kq & 3) == 0) { sY[((t * 32 + rg * 2) * 4) + (kq >> 2)] = yv[0]; sY[((t * 32 + rg * 2 + 1) * 4) + (kq >> 2)] = yv[1]; }
    }
    __syncthreads();
    { const int t = tid >> 4, lr = (tid & 15) * 2; const f32x4 p0 = *(const f32x4*)(sY + (t * 32 + lr) * 4), p1 = *(const f32x4*)(sY + (t * 32 + lr + 1) * 4);
      *(f32x2*)(yout + (size_t)(row0 + t0 + t) * 512 + h * 64 + half * 32 + lr) = (f32x2){p0[0] + p0[1] + p0[2] + p0[3], p1[0] + p1[1] + p1[2] + p1[3]}; }
  }
  __builtin_amdgcn_s_setprio(0);
  if (seq < 32) { float* so = p.out + O_RW + (((((size_t)seq * 2 + l) * 2 + d) * 8 + h) * 64 + rbase) * 64 + kq * 4;
#pragma unroll
    for (int r = 0; r < 2; ++r) *(f32x4*)(so + r * 64) = (f32x4){S[r][0].x, S[r][0].y, S[r][1].x, S[r][1].y}; }
}

DI void qk_scores(const bf16_t* sK, const bf16x8 (&qf)[2], f32x4 (&sacc)[4], int fr, int fq) {
#pragma unroll
  for (int nt = 0; nt < 4; ++nt) { sacc[nt] = (f32x4){0.f, 0.f, 0.f, 0.f};
#pragma unroll
    for (int ks = 0; ks < 2; ++ks) { const bf16x8 kf = *(const bf16x8*)(sK + (nt * 16 + fr) * LDT + ks * 32 + fq * 8); sacc[nt] = MFMA16(kf, qf[ks], sacc[nt]); } }
}
DI void pv_accum(const bf16_t* sVt, const f32x4 (&pacc)[4], f32x4 (&o)[4], int fr, int fq) {
#pragma unroll
  for (int s = 0; s < 2; ++s) {
    bf16x8 pf; { const unsigned a = pack2(pacc[2 * s][0], pacc[2 * s][1]), b = pack2(pacc[2 * s][2], pacc[2 * s][3]), c = pack2(pacc[2 * s + 1][0], pacc[2 * s + 1][1]), dd = pack2(pacc[2 * s + 1][2], pacc[2 * s + 1][3]);
      const u32x4 u = (u32x4){a, b, c, dd}; pf = __builtin_bit_cast(bf16x8, u); }
#pragma unroll
    for (int dt = 0; dt < 4; ++dt) { const u32x2 lo = *(const u32x2*)(sVt + (dt * 16 + fr) * LDT + 32 * s + 4 * fq), hi = *(const u32x2*)(sVt + (dt * 16 + fr) * LDT + 32 * s + 16 + 4 * fq);
      const u32x4 u = (u32x4){lo[0], lo[1], hi[0], hi[1]}; const bf16x8 vf = __builtin_bit_cast(bf16x8, u); o[dt] = MFMA16(vf, pf, o[dt]); }
  }
}
DI void put_kv(bf16_t* sK, bf16_t* sVt, int key, int part, const float (&kf)[8], int vkey, int vpart, const float (&vf)[8]) {
  *(u32x4*)(sK + key * LDT + part * 8) = pack8(kf);
#pragma unroll
  for (int e = 0; e < 8; ++e) sVt[(vpart * 8 + e) * LDT + vkey] = f2bf(vf[e]);
}
DI void softmax_tile(f32x4 (&sacc)[4], f32x4 (&o)[4], float& mrun, float& lrun) {
  float mx = sacc[0][0];
#pragma unroll
  for (int nt = 0; nt < 4; ++nt)
#pragma unroll
    for (int j = 0; j < 4; ++j) mx = fmaxf(mx, sacc[nt][j]);
  mx = fmaxf(mx, shfl_x(mx, 16)); mx = fmaxf(mx, shfl_x(mx, 32));
  const float mnew = fmaxf(mrun, mx), alpha = __builtin_amdgcn_exp2f(mrun - mnew); mrun = mnew;
  float ls = 0.f;
#pragma unroll
  for (int nt = 0; nt < 4; ++nt)
#pragma unroll
    for (int j = 0; j < 4; ++j) { const float pv = __builtin_amdgcn_exp2f(sacc[nt][j] - mnew); sacc[nt][j] = pv; ls += pv; }
  lrun = lrun * alpha + ls;
#pragma unroll
  for (int dt = 0; dt < 4; ++dt) o[dt] *= alpha;
}
constexpr float LOG2E = 1.4426950408889634f;

__device__ void dense_task(const P& p, int b, int h, int qb, char* smem) {
  bf16_t* sK = (bf16_t*)smem; bf16_t* sVt = sK + 64 * LDT;
  const int tid = tidx(), lane = tid & 63, wave = tid >> 6, fr = lane & 15, fq = lane >> 4;
  const bf16_t* zn = (const bf16_t*)(p.ws + WS_ZN); bf16_t* ona = (bf16_t*)(p.ws + WS_ONA);
  const int qrow = b * 256 + qb * 64 + wave * 16 + fr;
  bf16x8 qf[2];
#pragma unroll
  for (int ks = 0; ks < 2; ++ks) qf[ks] = *(const bf16x8*)(zn + (size_t)qrow * NZN + h * 64 + ks * 32 + fq * 8);
  f32x4 o[4]; for (int dt = 0; dt < 4; ++dt) o[dt] = (f32x4){0.f, 0.f, 0.f, 0.f};
  float mrun = -1e30f, lrun = 0.f;
  u32x4 pk[2], pv[2];
#pragma unroll
  for (int i = 0; i < 2; ++i) { const int c = tid + 256 * i, key = c >> 3, part = c & 7, vkey = c & 63, vpart = c >> 6; pk[i] = *(const u32x4*)(zn + (size_t)(b * 256 + key) * NZN + h * 64 + part * 8 + 512); pv[i] = *(const u32x4*)(zn + (size_t)(b * 256 + vkey) * NZN + h * 64 + vpart * 8 + 1024); }
  for (int kt = 0; kt < 4; ++kt) {
    __syncthreads();
#pragma unroll
    for (int i = 0; i < 2; ++i) { const int c = tid + 256 * i, key = c >> 3, part = c & 7, vkey = c & 63, vpart = c >> 6;
      *(u32x4*)(sK + key * LDT + part * 8) = pk[i];
#pragma unroll
      for (int e = 0; e < 4; ++e) { sVt[(vpart * 8 + 2 * e) * LDT + vkey] = (bf16_t)(pv[i][e] & 0xffffu); sVt[(vpart * 8 + 2 * e + 1) * LDT + vkey] = (bf16_t)(pv[i][e] >> 16); } }
    __syncthreads();
    { const int kn = kt < 3 ? kt + 1 : 3;
#pragma unroll
      for (int i = 0; i < 2; ++i) { const int c = tid + 256 * i, key = c >> 3, part = c & 7, vkey = c & 63, vpart = c >> 6; pk[i] = *(const u32x4*)(zn + (size_t)(b * 256 + kn * 64 + key) * NZN + h * 64 + part * 8 + 512); pv[i] = *(const u32x4*)(zn + (size_t)(b * 256 + kn * 64 + vkey) * NZN + h * 64 + vpart * 8 + 1024); } }
    f32x4 sacc[4]; qk_scores(sK, qf, sacc, fr, fq);
#pragma unroll
    for (int nt = 0; nt < 4; ++nt) sacc[nt] *= (0.125f * LOG2E);
    softmax_tile(sacc, o, mrun, lrun);
    pv_accum(sVt, sacc, o, fr, fq);
  }
  lrun += shfl_x(lrun, 16); lrun += shfl_x(lrun, 32); const float inv = 1.f / lrun;
#pragma unroll
  for (int dt = 0; dt < 4; ++dt) { u32x2 ov; ov.x = pack2(o[dt][0] * inv, o[dt][1] * inv); ov.y = pack2(o[dt][2] * inv, o[dt][3] * inv); *(u32x2*)(ona + (size_t)qrow * LDO + h * 64 + dt * 16 + fq * 4) = ov; }
}

__device__ void na_task(const P& p, int l, int b, int h, int r, char* smem) {
  bf16_t* sK = (bf16_t*)smem; bf16_t* sVt = sK + 64 * LDT; float* sRpb = (float*)(sVt + 64 * LDT);
  const int tid = tidx(), lane = tid & 63, wave = tid >> 6, fr = lane & 15, fq = lane >> 4;
  const bf16_t* zn = (const bf16_t*)(p.ws + WS_ZN); bf16_t* ona = (bf16_t*)(p.ws + WS_ONA);
  const int base = MC + b * 1024, qcol = wave * 16 + fr, qrow = base + r * 64 + qcol;
  int rs = r - 4; rs = rs < 0 ? 0 : (rs > 8 ? 8 : rs);
  int cs = qcol - 8; cs = cs < 0 ? 0 : (cs > 48 ? 48 : cs);
  __syncthreads();
  for (int e = tid; e < 465; e += NT) sRpb[e] = p.na_rpb[((size_t)l * 8 + h) * 465 + e] * LOG2E;
  bf16x8 qf[2];
#pragma unroll
  for (int ks = 0; ks < 2; ++ks) qf[ks] = *(const bf16x8*)(zn + (size_t)qrow * NZN + h * 64 + ks * 32 + fq * 8);
  f32x4 o[4]; for (int dt = 0; dt < 4; ++dt) o[dt] = (f32x4){0.f, 0.f, 0.f, 0.f};
  float mrun = -1e30f, lrun = 0.f;
  u32x4 pre[8];
#define NA_ISSUE(KT) do { const int kt_ = (KT); \
    if (kt_ < 8) { _Pragma("unroll") for (int i = 0; i < 2; ++i) { const int c = tid + 256 * i, key = c >> 3, part = c & 7, vkey = c & 63, vpart = c >> 6; \
        pre[4 * i] = *(const u32x4*)(zn + (size_t)(base + (rs + kt_) * 64 + key) * NZN + h * 64 + part * 8 + 512); pre[4 * i + 1] = *(const u32x4*)(zn + (size_t)(base + (rs + kt_) * 64 + vkey) * NZN + h * 64 + vpart * 8 + 1024); } } \
    else { _Pragma("unroll") for (int i = 0; i < 2; ++i) { const int c = tid + 256 * i, key = c >> 3, part = c & 7, vkey = c & 63, vpart = c >> 6; const size_t cb_ = (((size_t)b * 2 + l) * 8 + h) * 256 + (kt_ - 8) * 64; const size_t co = (cb_ + key) * 64 + part * 8, cv = (cb_ + vkey) * 64 + vpart * 8; \
        pre[4 * i] = *(const u32x4*)(p.cache_k + co); pre[4 * i + 1] = *(const u32x4*)(p.cache_k + co + 4); pre[4 * i + 2] = *(const u32x4*)(p.cache_v + cv); pre[4 * i + 3] = *(const u32x4*)(p.cache_v + cv + 4); } } } while (0)
  NA_ISSUE(0);
  for (int kt = 0; kt < 12; ++kt) {
    __syncthreads();
    if (kt < 8) {
#pragma unroll
      for (int i = 0; i < 2; ++i) { const int c = tid + 256 * i, key = c >> 3, part = c & 7, vkey = c & 63, vpart = c >> 6;
        *(u32x4*)(sK + key * LDT + part * 8) = pre[4 * i];
#pragma unroll
        for (int e = 0; e < 4; ++e) { sVt[(vpart * 8 + 2 * e) * LDT + vkey] = (bf16_t)(pre[4 * i + 1][e] & 0xffffu); sVt[(vpart * 8 + 2 * e + 1) * LDT + vkey] = (bf16_t)(pre[4 * i + 1][e] >> 16); } }
    } else {
#pragma unroll
      for (int i = 0; i < 2; ++i) { const int c = tid + 256 * i, key = c >> 3, part = c & 7, vkey = c & 63, vpart = c >> 6;
        const f32x4 k0 = __builtin_bit_cast(f32x4, pre[4 * i]), k1 = __builtin_bit_cast(f32x4, pre[4 * i + 1]), v0 = __builtin_bit_cast(f32x4, pre[4 * i + 2]), v1 = __builtin_bit_cast(f32x4, pre[4 * i + 3]);
        const float kf[8] = {k0[0], k0[1], k0[2], k0[3], k1[0], k1[1], k1[2], k1[3]}; const float vf[8] = {v0[0], v0[1], v0[2], v0[3], v1[0], v1[1], v1[2], v1[3]};
        put_kv(sK, sVt, key, part, kf, vkey, vpart, vf); }
    }
    __syncthreads();
    NA_ISSUE(kt < 11 ? kt + 1 : 11);
    f32x4 sacc[4]; qk_scores(sK, qf, sacc, fr, fq);
    if (kt < 8) { const int dr = rs + kt - r + 7;
#pragma unroll
      for (int nt = 0; nt < 4; ++nt)
#pragma unroll
        for (int j = 0; j < 4; ++j) { const int kc = nt * 16 + fq * 4 + j; const bool valid = kc >= cs && kc < cs + 16; int dc = kc - qcol; dc = dc < -15 ? -15 : (dc > 15 ? 15 : dc);
          sacc[nt][j] = valid ? sacc[nt][j] * (0.125f * LOG2E) + sRpb[dr * 31 + dc + 15] : -1e30f; }
    } else {
#pragma unroll
      for (int nt = 0; nt < 4; ++nt) sacc[nt] *= (0.125f * LOG2E);
    }
    softmax_tile(sacc, o, mrun, lrun);
    pv_accum(sVt, sacc, o, fr, fq);
  }
#undef NA_ISSUE
  lrun += shfl_x(lrun, 16); lrun += shfl_x(lrun, 32); const float inv = 1.f / lrun;
#pragma unroll
  for (int dt = 0; dt < 4; ++dt) { u32x2 ov; ov.x = pack2(o[dt][0] * inv, o[dt][1] * inv); ov.y = pack2(o[dt][2] * inv, o[dt][3] * inv); *(u32x2*)(ona + (size_t)qrow * LDO + h * 64 + dt * 16 + fq * 4) = ov; }
}

DI void rope8(const float (&own)[8], const float (&par)[8], int part, int n, float (&out)[8]) {
  const float pos = (float)((part >> 2) ? (n & 63) : (n >> 6));
  const bool isx2 = (part & 3) >= 2;
#pragma unroll
  for (int e = 0; e < 8; ++e) { const int i = (part & 1) * 8 + e; const float ang = pos * __builtin_amdgcn_exp2f(-(float)i * 0.830482023721841f); const float sn = __sinf(ang), cs = __cosf(ang);
    out[e] = isx2 ? par[e] * sn + own[e] * cs : own[e] * cs - par[e] * sn; }
}

DI void rope8t(const float (&own)[8], const float (&par)[8], int part, int n, const float* tab, float (&out)[8]) {
  const int pos = (part >> 2) ? (n & 63) : (n >> 6);
  const bool isx2 = (part & 3) >= 2;
  const float* tb = tab + (pos * 16 + (part & 1) * 8) * 2;
#pragma unroll
  for (int e = 0; e < 8; e += 2) { const f32x4 cssn = *(const f32x4*)(tb + 2 * e);
    out[e] = isx2 ? par[e] * cssn[1] + own[e] * cssn[0] : own[e] * cssn[0] - par[e] * cssn[1];
    out[e + 1] = isx2 ? par[e + 1] * cssn[3] + own[e + 1] * cssn[2] : own[e + 1] * cssn[2] - par[e + 1] * cssn[3]; }
}

__device__ void ret_task(const P& p, int l, int seq, int h, int qb, char* smem) {
  bf16_t* sK = (bf16_t*)smem; bf16_t* sVt = sK + 64 * LDT; bf16_t* sQ = sVt + 64 * LDT; float* sRope = (float*)(sQ + 64 * LDT);
  const int tid = tidx(), lane = tid & 63, wave = tid >> 6, fr = lane & 15, fq = lane >> 4;
  const bf16_t* zt = (const bf16_t*)(p.ws + WS_ZT); bf16_t* oret = (bf16_t*)(p.ws + WS_ORET);
  const bool lat = seq >= 32;
  const int row0 = lat ? MC + (seq - 32) * 1024 : seq * 256, T = lat ? 1024 : 256, nkt = T >> 6;
  const float xf = p.ret_decay[(l * 2 + 0) * 8 + h], xb = p.ret_decay[(l * 2 + 1) * 8 + h];
  const float lgf = -log1pf(__expf(-xf)) * LOG2E, lgb = -log1pf(__expf(-xb)) * LOG2E;
  __syncthreads();
  if (lat) {
#pragma unroll
    for (int j = 0; j < 4; ++j) { const int e = tid + 256 * j; const float ang = (float)(e >> 4) * __builtin_amdgcn_exp2f(-(float)(e & 15) * 0.830482023721841f); sRope[2 * e] = __cosf(ang); sRope[2 * e + 1] = __sinf(ang); }
    __syncthreads();
  }
#pragma unroll
  for (int i = 0; i < 2; ++i) { const int c = tid + 256 * i, qi = c >> 3, part = c & 7; const int n = qb * 64 + qi; const size_t ro = (size_t)(row0 + n) * LZT + h * 64;
    const u32x4 own = *(const u32x4*)(zt + ro + part * 8);
    if (lat) { const u32x4 par = *(const u32x4*)(zt + ro + (part ^ 2) * 8); float fo[8], fp[8], out[8]; unpack8(own, fo); unpack8(par, fp); rope8t(fo, fp, part, n, sRope, out); *(u32x4*)(sQ + qi * LDT + part * 8) = pack8(out); }
    else *(u32x4*)(sQ + qi * LDT + part * 8) = own; }
  __syncthreads();
  const int qi = wave * 16 + fr, nq = qb * 64 + qi;
  bf16x8 qf[2];
#pragma unroll
  for (int ks = 0; ks < 2; ++ks) qf[ks] = *(const bf16x8*)(sQ + qi * LDT + ks * 32 + fq * 8);
  f32x4 o[4]; for (int dt = 0; dt < 4; ++dt) o[dt] = (f32x4){0.f, 0.f, 0.f, 0.f};
  u32x4 rk[2], rp[2], rv[2];
#define RET_ISSUE(KT) do { _Pragma("unroll") for (int i = 0; i < 2; ++i) { const int c = tid + 256 * i, key = c >> 3, part = c & 7, vkey = c & 63, vpart = c >> 6; const size_t ro = (size_t)(row0 + (KT) * 64 + key) * LZT + h * 64; \
    rk[i] = *(const u32x4*)(zt + ro + 512 + part * 8); rp[i] = *(const u32x4*)(zt + ro + 512 + (part ^ 2) * 8); rv[i] = *(const u32x4*)(zt + (size_t)(row0 + (KT) * 64 + vkey) * LZT + h * 64 + 1024 + vpart * 8); } } while (0)
  RET_ISSUE(0);
  for (int kt = 0; kt < nkt; ++kt) {
    __syncthreads();
#pragma unroll
    for (int i = 0; i < 2; ++i) { const int c = tid + 256 * i, key = c >> 3, part = c & 7, vkey = c & 63, vpart = c >> 6; const int n = kt * 64 + key;
      float kf[8]; unpack8(rk[i], kf);
      if (lat) { float fp[8], out[8]; unpack8(rp[i], fp); rope8t(kf, fp, part, n, sRope, out);
#pragma unroll
        for (int e = 0; e < 8; ++e) kf[e] = out[e]; }
#pragma unroll
      for (int e = 0; e < 8; ++e) kf[e] *= 0.125f;
      *(u32x4*)(sK + key * LDT + part * 8) = pack8(kf);
#pragma unroll
      for (int e = 0; e < 4; ++e) { sVt[(vpart * 8 + 2 * e) * LDT + vkey] = (bf16_t)(rv[i][e] & 0xffffu); sVt[(vpart * 8 + 2 * e + 1) * LDT + vkey] = (bf16_t)(rv[i][e] >> 16); } }
    __syncthreads();
    RET_ISSUE(kt + 1 < nkt ? kt + 1 : kt);
    f32x4 sacc[4]; qk_scores(sK, qf, sacc, fr, fq);
#pragma unroll
    for (int nt = 0; nt < 4; ++nt)
#pragma unroll
      for (int j = 0; j < 4; ++j) { const int mk = kt * 64 + nt * 16 + fq * 4 + j; const int df = nq - mk;
        const float ex = __builtin_amdgcn_exp2f((df > 0 ? lgf : -lgb) * (float)df); sacc[nt][j] *= (df == 0 ? 2.f : ex); }
    pv_accum(sVt, sacc, o, fr, fq);
  }
#undef RET_ISSUE
  if (lat) {
    for (int dir = 0; dir < 2; ++dir) {
      __syncthreads();
      const float* s0 = p.state_ret + ((((size_t)(seq - 32) * 2 + l) * 2 + dir) * 8 + h) * 4096;
#pragma unroll
      for (int i = 0; i < 2; ++i) { const int c = tid + 256 * i, dk = c & 63, part = c >> 6; const float4 a = *(const float4*)(s0 + dk * 64 + part * 8), bq = *(const float4*)(s0 + dk * 64 + part * 8 + 4);
        const float vf[8] = {a.x, a.y, a.z, a.w, bq.x, bq.y, bq.z, bq.w};
#pragma unroll
        for (int e = 0; e < 8; ++e) sVt[(part * 8 + e) * LDT + dk] = f2bf(vf[e]); }
      __syncthreads();
      const float xi = dir == 0 ? exp2f(lgf * (float)(nq + 1)) : exp2f(lgb * (float)(T - nq));
      f32x4 pacc[4];
#pragma unroll
      for (int s = 0; s < 2; ++s)
#pragma unroll
        for (int hh = 0; hh < 2; ++hh)
#pragma unroll
          for (int j = 0; j < 4; ++j) pacc[2 * s + hh][j] = xi * bf2f(sQ[qi * LDT + 32 * s + 16 * hh + 4 * fq + j]);
      pv_accum(sVt, pacc, o, fr, fq);
    }
  }
  float s1 = 0.f;
#pragma unroll
  for (int dt = 0; dt < 4; ++dt)
#pragma unroll
    for (int j = 0; j < 4; ++j) s1 += o[dt][j];
  s1 += shfl_x(s1, 16); s1 += shfl_x(s1, 32); const float mu = s1 * (1.f / 64.f);
  float s2 = 0.f;
#pragma unroll
  for (int dt = 0; dt < 4; ++dt)
#pragma unroll
    for (int j = 0; j < 4; ++j) { const float dlt = o[dt][j] - mu; s2 += dlt * dlt; }
  s2 += shfl_x(s2, 16); s2 += shfl_x(s2, 32); const float rstd = rsqrtf(s2 * (1.f / 64.f) + 1e-5f);
  const size_t qrow = (size_t)(row0 + nq);
#pragma unroll
  for (int dt = 0; dt < 4; ++dt) { const int dv = h * 64 + dt * 16 + fq * 4; const u32x2 gr = *(const u32x2*)(zt + qrow * LZT + 1536 + dv); const float4 gn = *(const float4*)(p.ret_gn + l * 512 + dv);
    const float g0 = bflo(gr.x), g1 = bfhi(gr.x), g2 = bflo(gr.y), g3 = bfhi(gr.y);
    u32x2 ov; ov.x = pack2((o[dt][0] - mu) * rstd * gn.x * g0 * sigmoidf_(g0), (o[dt][1] - mu) * rstd * gn.y * g1 * sigmoidf_(g1));
    ov.y = pack2((o[dt][2] - mu) * rstd * gn.z * g2 * sigmoidf_(g2), (o[dt][3] - mu) * rstd * gn.w * g3 * sigmoidf_(g3));
    *(u32x2*)(oret + qrow * LDO + dv) = ov; }
}

__device__ void retstate_task(const P& p, int l, int b, int h, char* smem) {
  float* sKf = (float*)smem; float* sKb = sKf + 64 * 64; float* sV = sKb + 64 * 64;
  const int tid = tidx(), dk = tid >> 2, dq = tid & 3;
  const bf16_t* zt = (const bf16_t*)(p.ws + WS_ZT);
  const float xf = p.ret_decay[(l * 2 + 0) * 8 + h], xb = p.ret_decay[(l * 2 + 1) * 8 + h];
  const float lgf = -log1pf(__expf(-xf)) * LOG2E, lgb = -log1pf(__expf(-xb)) * LOG2E;
  float af[16], ab[16];
#pragma unroll
  for (int i = 0; i < 16; ++i) { af[i] = 0.f; ab[i] = 0.f; }
  for (int kt = 0; kt < 4; ++kt) {
    __syncthreads();
#pragma unroll
    for (int i = 0; i < 2; ++i) { const int c = tid + 256 * i, key = c >> 3, part = c & 7, m = kt * 64 + key; const size_t ro = (size_t)(b * 256 + m) * LZT + h * 64 + part * 8;
      float kf[8], vf[8]; unpack8(*(const u32x4*)(zt + ro + 512), kf); unpack8(*(const u32x4*)(zt + ro + 1024), vf);
      const float wf = 0.125f * exp2f(lgf * (float)(255 - m)), wb = 0.125f * exp2f(lgb * (float)m);
#pragma unroll
      for (int e = 0; e < 8; ++e) { sKf[key * 64 + part * 8 + e] = kf[e] * wf; sKb[key * 64 + part * 8 + e] = kf[e] * wb; sV[key * 64 + part * 8 + e] = vf[e]; } }
    __syncthreads();
    for (int m = 0; m < 64; ++m) { const float kf = sKf[m * 64 + dk], kb = sKb[m * 64 + dk];
#pragma unroll
      for (int i = 0; i < 4; ++i) { const f32x4 vv = *(const f32x4*)(sV + m * 64 + dq * 16 + i * 4);
#pragma unroll
        for (int j = 0; j < 4; ++j) { af[i * 4 + j] += kf * vv[j]; ab[i * 4 + j] += kb * vv[j]; } } }
  }
  float* of = p.out + O_RT + ((((size_t)b * 2 + l) * 2 + 0) * 8 + h) * 4096 + dk * 64 + dq * 16; float* ob = of + 8 * 4096;
#pragma unroll
  for (int i = 0; i < 16; ++i) { of[i] = af[i]; ob[i] = ab[i]; }
}

constexpr int Q_SCAN_L = 64, Q_SCAN_C = 512, Q_RET_L = 256, Q_NA = 256, Q_DENSE = 512, Q_RET_C = 512, Q_RST = 128;
template <int QMASK> __device__ void phase_mixers(const P& p, int l, char* smem_, int rep = 0) {
  __shared__ int s_task;
  int* ctr = (int*)(p.ws + WS_CTRL) + 64 * (l + 1) + 4 * rep;
  const int vb = vhalf(); char* smem = smem_ + vb * VSMEM;
  if (QMASK & 1) for (;;) {
    __syncthreads();
    if (ptid() == 0) s_task = atomicAdd(ctr, 1);
    __syncthreads();
    const int tk = s_task;
    if (tk >= Q_SCAN_L + Q_SCAN_C) break;
    const bool lat = tk < Q_SCAN_L; const int t2 = lat ? tk : tk - Q_SCAN_L;
    scan_task(p, l, (lat ? 32 : 0) + (t2 >> 4), (t2 >> 1) & 7, t2 & 1, vb, smem);
  }
  if (QMASK & 2) for (;;) {
    __syncthreads();
    if (ptid() == 0) s_task = atomicAdd(ctr + 16, 1);
    __syncthreads();
    const int tk = s_task;
    if (tk >= Q_RET_L + Q_RET_C) break;
    if (tk < Q_RET_L) ret_task(p, l, 32 + (tk >> 6), (tk >> 3) & 7, (tk & 7) * 2 + vb, smem);
    else { const int t2 = tk - Q_RET_L; ret_task(p, l, t2 >> 4, (t2 >> 1) & 7, (t2 & 1) * 2 + vb, smem); }
  }
  if (QMASK & 4) for (;;) {
    __syncthreads();
    if (ptid() == 0) s_task = atomicAdd(ctr + 32, 1);
    __syncthreads();
    int tk = s_task;
    if (tk >= Q_NA + Q_DENSE + Q_RST) break;
    if (tk < Q_NA) { na_task(p, l, tk >> 6, (tk >> 3) & 7, (tk & 7) * 2 + vb, smem); continue; } tk -= Q_NA;
    if (tk < Q_DENSE) { dense_task(p, tk >> 4, (tk >> 1) & 7, (tk & 1) * 2 + vb, smem); continue; } tk -= Q_DENSE;
    retstate_task(p, l, tk >> 2, (tk & 3) * 2 + vb, smem);
  }
}

__device__ void phase_rwkv_post(const P& p, int l, char* smem) {
  const bf16_t* zr = (const bf16_t*)(p.ws + WS_ZR); const float* yf = (const float*)(p.ws + WS_Y); const float* yb = yf + (size_t)MT * 512; bf16_t* oa = (bf16_t*)(p.ws + WS_OA);
  const bf16_t* Gt = (const bf16_t*)(p.ws + WS_WG);
  const int tid = ptid(), lane = tid & 63, wave = tid >> 6, wr = wave >> 2, wc = wave & 3, fr = lane & 15, fq = lane >> 4;
  TileIter ti; int mt, nt; ti.init(96, 2);
  while (ti.next(mt, nt)) {
    const int row0 = mt * 128, n0 = nt * 256;
    f32x4 acc[4][4]; zero_acc<4, 4>(acc);
    TileSrc s{zr + 1664, NZR, row0, Gt, LDG, n0, n0 + 128, 128}; { Gemm<4, 4, 1> gm; gm.begin(s, true); gm.run(acc, smem); }
    const int cb = n0 + wc * 64 + fq * 8;
#pragma unroll
    for (int m = 0; m < 4; ++m) { const size_t row = (size_t)(row0 + wr * 64 + m * 16 + fr);
      f32x4 y[4]; float s1 = 0.f, rk = 0.f; f32x4 vv[4];
#pragma unroll
      for (int n = 0; n < 4; ++n) { const int c = cb + 32 * (n >> 1) + 4 * (n & 1); y[n] = *(const f32x4*)(yf + row * 512 + c) + *(const f32x4*)(yb + row * 512 + c); s1 += y[n][0] + y[n][1] + y[n][2] + y[n][3];
        const u32x2 rr = *(const u32x2*)(zr + row * NZR + c), kk = *(const u32x2*)(zr + row * NZR + 512 + c), v2 = *(const u32x2*)(zr + row * NZR + 1024 + c); const f32x4 rkw = *(const f32x4*)(p.rwkv_r_k + l * 512 + c);
        rk += bflo(rr.x) * bflo(kk.x) * rkw[0] + bfhi(rr.x) * bfhi(kk.x) * rkw[1] + bflo(rr.y) * bflo(kk.y) * rkw[2] + bfhi(rr.y) * bfhi(kk.y) * rkw[3];
        vv[n] = (f32x4){bflo(v2.x), bfhi(v2.x), bflo(v2.y), bfhi(v2.y)}; }
      s1 += shfl_x(s1, 16); s1 += shfl_x(s1, 32); rk += shfl_x(rk, 16); rk += shfl_x(rk, 32);
      const float mu = s1 * (1.f / 64.f); float s2 = 0.f;
#pragma unroll
      for (int n = 0; n < 4; ++n)
#pragma unroll
        for (int j = 0; j < 4; ++j) { const float dl = y[n][j] - mu; s2 += dl * dl; }
      s2 += shfl_x(s2, 16); s2 += shfl_x(s2, 32); const float rstd = rsqrtf(s2 * (1.f / 64.f) + 64e-5f);
#pragma unroll
      for (int n = 0; n < 4; ++n) { const int c = cb + 32 * (n >> 1) + 4 * (n & 1); const f32x4 lg = *(const f32x4*)(p.rwkv_ln_g + l * 512 + c), lb = *(const f32x4*)(p.rwkv_ln_b + l * 512 + c);
        float o[4];
#pragma unroll
        for (int j = 0; j < 4; ++j) o[j] = ((y[n][j] - mu) * rstd * lg[j] + lb[j] + rk * vv[n][j]) * acc[m][n][j];
        u32x2 ov; ov.x = pack2(o[0], o[1]); ov.y = pack2(o[2], o[3]); *(u32x2*)(oa + row * LDO + c) = ov; }
    }
  }
}

DI void convert_layer_a(const P& p, int l, char* smem) {
  convert_T(p.w_in + (size_t)l * D * INC, D, INC, (bf16_t*)(p.ws + WS_WIN), LDH, smem);
  convert_T(p.w_o_rwkv + (size_t)l * 512 * D, 512, D, (bf16_t*)(p.ws + WS_WO3), LDO, smem);
  convert_T(p.w_o_na + (size_t)l * 512 * D, 512, D, (bf16_t*)(p.ws + WS_WO3) + (size_t)1024 * LDO, LDO, smem);
  convert_T(p.w_o_ret + (size_t)l * 512 * D, 512, D, (bf16_t*)(p.ws + WS_WO3) + (size_t)2 * 1024 * LDO, LDO, smem);
  convert_T(p.w_out + (size_t)l * D * D, D, D, (bf16_t*)(p.ws + WS_WOUT), LDH, smem);
  convert_T(p.rwkv_g_up + (size_t)l * 128 * 512, 128, 512, (bf16_t*)(p.ws + WS_WG), LDG, smem);
}
DI void convert_layer_b(const P& p, int l, char* smem) {
  convert_T(p.ffn_up + (size_t)l * D * 2 * FF, D, 2 * FF, (bf16_t*)(p.ws + WS_WUP), LDH, smem);
  convert_T(p.ffn_down + (size_t)l * FF * D, FF, D, (bf16_t*)(p.ws + WS_WDN), FF, smem);
}

typedef __attribute__((address_space(4))) const P* KP;
DI KP kargs() { KP k = (KP)__builtin_amdgcn_kernarg_segment_ptr(); asm volatile("" : "+s"(k)); return k; }
template <int PH> DI void run_phase(int l, char* smem) {
#if defined(__HIP_DEVICE_COMPILE__)
  const P p = *kargs();
#else
  const P p{};
#endif
  const float* mod = (const float*)(p.ws + WS_MOD);
  float* xbuf = p.out;
  if (PH == 0) { ada_phase(p, smem); convert_layer_a(p, 0, smem); }
  else if (PH == 1) { norm_phase(p, nullptr, nullptr, nullptr, nullptr, 0, nullptr, p.norm_mix_pre, mod, 0, (bf16_t*)(p.ws + WS_H)); }
  else if (PH == 2) phase_win(p, l, smem);
  else if (PH == 4) phase_mixers<7>(p, l, smem);
  else if (PH == 5) phase_rwkv_post(p, l, smem);
  else if (PH == 6) phase_merge(p, smem);
  else if (PH == 7) { phase_gemm_f32((const bf16_t*)(p.ws + WS_MERGED), LDH, D, (const bf16_t*)(p.ws + WS_WOUT), LDH, (float*)(p.ws + WS_U), smem); }
  else if (PH == 8) { convert_layer_b(p, l, smem);
    norm_phase(p, l == 0 ? nullptr : xbuf, (const float*)(p.ws + WS_U), p.norm_mix_post + l * D, mod + (size_t)l * 5 * 6144, 2, xbuf, p.norm_ffn_pre + l * D, mod + (size_t)l * 5 * 6144, 3, (bf16_t*)(p.ws + WS_H)); }
  else if (PH == 9) phase_ffn_up(p, l, smem);
  else if (PH == 11) { phase_gemm_f32((const bf16_t*)(p.ws + WS_HID), FF, FF, (const bf16_t*)(p.ws + WS_WDN), FF, (float*)(p.ws + WS_F), smem); }
  else if (PH == 12) {
    if (l == 0) { norm_phase(p, xbuf, (const float*)(p.ws + WS_F), p.norm_ffn_post, mod, 5, xbuf, p.norm_mix_pre + D, mod + (size_t)5 * 6144, 0, (bf16_t*)(p.ws + WS_H)); convert_layer_a(p, 1, smem); }
    else norm_phase(p, xbuf, (const float*)(p.ws + WS_F), p.norm_ffn_post + D, mod + (size_t)5 * 6144, 5, xbuf, nullptr, nullptr, 0, nullptr);
  }
}

#if MEGA
__global__ void __launch_bounds__(NTP, 1) mega_kernel(P p_) {
  extern __shared__ __attribute__((aligned(16))) char smem[];
  __shared__ u32x4 xb_words;
  cg::grid_group grid = cg::this_grid();
  if (ptid() == 0) xb_words = (u32x4){0u, 0u, 0u, 0u};
  __syncthreads();
#if defined(__HIP_DEVICE_COMPILE__)
  (void)xcd_barrier_post((unsigned*)(p_.ws + WS_BAR), (volatile LAS unsigned*)&xb_words);
#define GSYNC() do { XcdBarrier xb_; xb_.bar = (unsigned*)(kargs()->ws + WS_BAR); xb_.x = xb_xcc_id(); xb_.st = (volatile LAS unsigned*)&xb_words; xcd_barrier(xb_); } while (0)
#else
#define GSYNC() do { } while (0)
#endif
  run_phase<0>(0, smem); grid.sync();
  run_phase<1>(0, smem); GSYNC();
#pragma unroll
  for (int l = 0; l < 2; ++l) {
    run_phase<2>(l, smem); GSYNC();
    if (PROBE_MASK & 1) { run_phase<2>(l, smem); GSYNC(); }
    run_phase<4>(l, smem); GSYNC();
    run_phase<5>(l, smem); GSYNC();
    run_phase<6>(l, smem); GSYNC();
    if (PROBE_MASK & 8) { run_phase<6>(l, smem); GSYNC(); }
    run_phase<7>(l, smem); GSYNC();
    if (PROBE_MASK & 16) { run_phase<7>(l, smem); GSYNC(); }
    run_phase<8>(l, smem); GSYNC();
    run_phase<9>(l, smem); GSYNC();
    if (PROBE_MASK & 32) { run_phase<9>(l, smem); GSYNC(); }
    run_phase<11>(l, smem); GSYNC();
    if (PROBE_MASK & 64) { run_phase<11>(l, smem); GSYNC(); }
    run_phase<12>(l, smem); if (l == 0) GSYNC();
  }
#undef GSYNC
}
#else
template <int PH> __global__ void __launch_bounds__(NTP, 1) phase_kernel(P p, int l) {
  extern __shared__ __attribute__((aligned(16))) char smem[];
  run_phase<PH>(l, smem);
}
#endif

extern "C" void kernel_launch(void* const* d_in, const int* in_sizes, int n_in, void* d_out, int out_size, void* d_ws, size_t ws_size, hipStream_t stream) {
  if (ws_size < WS_END || n_in < 36) { fprintf(stderr, "workspace too small: %zu < %zu\n", ws_size, (size_t)WS_END); return; }
  P p{};
  const float** pp = (const float**)&p;
  for (int i = 0; i < 36; ++i) pp[i] = (const float*)d_in[i];
  p.out = (float*)d_out; p.ws = (char*)d_ws;
  hipMemsetAsync(d_ws, 0, WS_WIN, stream);
#if MEGA
  static int grid_blocks = 0;
  if (!grid_blocks) {
    int dev = 0, cus = 0, per_cu = 0; hipGetDevice(&dev);
    hipDeviceGetAttribute(&cus, hipDeviceAttributeMultiprocessorCount, dev);
    hipFuncSetAttribute((const void*)mega_kernel, hipFuncAttributeMaxDynamicSharedMemorySize, SMEM_BYTES);
    hipOccupancyMaxActiveBlocksPerMultiprocessor(&per_cu, mega_kernel, NTP, SMEM_BYTES);
    if (per_cu > 1) per_cu = 1;
    grid_blocks = cus * per_cu;
  }
  void* args[] = {&p};
  hipError_t e = hipLaunchCooperativeKernel((void*)mega_kernel, dim3(grid_blocks), dim3(NTP), args, SMEM_BYTES, stream);
  if (e != hipSuccess) fprintf(stderr, "cooperative launch failed: %s (grid %d)\n", hipGetErrorString(e), grid_blocks);
#else
  const int G = 512;
#define LAUNCH(PH, L) do { hipFuncSetAttribute((const void*)phase_kernel<PH>, hipFuncAttributeMaxDynamicSharedMemorySize, SMEM_BYTES); phase_kernel<PH><<<G, NT, SMEM_BYTES, stream>>>(p, L); } while (0)
  LAUNCH(0, 0); LAUNCH(1, 0);
  for (int l = 0; l < 2; ++l) { LAUNCH(2, l); LAUNCH(4, l); LAUNCH(5, l); LAUNCH(6, l); LAUNCH(7, l); LAUNCH(8, l); LAUNCH(9, l); LAUNCH(11, l); LAUNCH(12, l); }
#endif
}
```

```cpp
#include <hip/hip_runtime.h>
#include <hip/hip_cooperative_groups.h>
#include <cstdio>
namespace cg = cooperative_groups;

#ifndef MEGA
#define MEGA 1
#endif
#define PROBE_MASK 0
#define GEMM_F32_KU 1
#define FFN_UP_KU 1

typedef unsigned short bf16_t;
typedef short bf16x8 __attribute__((ext_vector_type(8)));
typedef short bf16x4 __attribute__((ext_vector_type(4)));
typedef float f32x4 __attribute__((ext_vector_type(4)));
typedef float f32x2 __attribute__((ext_vector_type(2)));
typedef unsigned u32x4 __attribute__((ext_vector_type(4)));
typedef unsigned u32x2 __attribute__((ext_vector_type(2)));
#define DI __device__ __forceinline__
#define MFMA16(a, b, c) __builtin_amdgcn_mfma_f32_16x16x32_bf16((a), (b), (c), 0, 0, 0)

constexpr int NT = 256;
constexpr int NTP = 512;
constexpr int VSMEM = 65536;
constexpr int D = 1024, MC = 8192, ML = 4096, MT = 12288;
constexpr int NZR = 1792, NZN = 1536, NZT = 2048, INC = 8448, FF = 2816;
constexpr int LDH = 1088, LDO = 576, LZT = 2112, LDG = 136;
constexpr int LDT = 72;
constexpr int SMEM_BYTES = 139264;
constexpr int SMEM_BYTES_GEMM_ = 131072;
constexpr size_t O_K = 12582912, O_V = 20971520, O_RW = 29360128, O_RT = 33554432;
constexpr size_t WS_CTRL = 0;
constexpr size_t WS_MOD = 4096;
constexpr size_t WS_BAR = 262144;
constexpr size_t WS_CUF = 278528;
constexpr size_t WS_WG = 294912;
constexpr size_t WS_WIN = 434176;
constexpr size_t WS_WUP = WS_WIN;
constexpr size_t WS_WDN = WS_WIN + (size_t)5632 * LDH * 2;
constexpr size_t WS_WO3 = WS_WIN + (size_t)INC * LDH * 2;
constexpr size_t WS_WOUT = WS_WO3 + (size_t)3 * 1024 * LDO * 2;
constexpr size_t WS_H = WS_WOUT + (size_t)1024 * LDH * 2;
constexpr size_t WS_Z = WS_H + (size_t)MT * LDH * 2;
constexpr size_t WS_ZR = WS_Z;
constexpr size_t WS_ZN = WS_ZR + (size_t)MT * NZR * 2;
constexpr size_t WS_ZT = WS_ZN + (size_t)MT * NZN * 2;
constexpr size_t WS_MERGED = WS_ZR;
constexpr size_t WS_OA = WS_ZN;
constexpr size_t WS_U = WS_ZT;
constexpr size_t WS_HID = WS_Z;
constexpr size_t WS_F = WS_ZT;
constexpr size_t WS_Y = WS_ZT + (size_t)MT * LZT * 2;
constexpr size_t WS_ONA = WS_Y + (size_t)2 * MT * 512 * 4;
constexpr size_t WS_ORET = WS_ONA + (size_t)MT * LDO * 2;
constexpr size_t WS_END = WS_ORET + (size_t)MT * LDO * 2;

struct P {
  const float *x_prompt, *x_sample, *cache_k, *cache_v, *state_rwkv, *state_ret, *c, *c_ctx, *ada_w, *ada_b;
  const float *norm_mix_pre, *norm_mix_post, *norm_ffn_pre, *norm_ffn_post, *w_in, *rwkv_conv, *rwkv_w0, *rwkv_w_up, *rwkv_a0, *rwkv_a_up, *rwkv_g_up;
  const float *rwkv_k_k, *rwkv_k_a, *rwkv_r_k, *rwkv_ln_g, *rwkv_ln_b, *na_rpb, *ret_decay, *ret_gn, *w_o_rwkv, *w_o_na, *w_o_ret, *w_out, *ffn_up, *ffn_conv, *ffn_down;
  float* out; char* ws;
};

DI int threadIdx_x_raw() { return (int)__builtin_amdgcn_workitem_id_x(); }
DI int ptid() { int t = threadIdx_x_raw(); asm volatile("" : "+v"(t)); return t; }
DI int tidx() { return ptid() & 255; }
DI int vhalf() { return ptid() >> 8; }
DI int vblk() { return (int)blockIdx.x * 2 + vhalf(); }
DI int vgrid() { return (int)gridDim.x * 2; }
DI unsigned cvt_pk_bf16(float lo, float hi) { unsigned r; asm("v_cvt_pk_bf16_f32 %0, %1, %2" : "=v"(r) : "v"(lo), "v"(hi)); return r; }
DI bf16_t f2bf(float x) { return (bf16_t)(cvt_pk_bf16(x, 0.f) & 0xffffu); }
DI float bf2f(bf16_t b) { return __uint_as_float(((unsigned)b) << 16); }
DI unsigned pack2(float a, float b) { return cvt_pk_bf16(a, b); }
DI float bflo(unsigned u) { return __uint_as_float(u << 16); }
DI float bfhi(unsigned u) { return __uint_as_float(u & 0xffff0000u); }
DI void unpack8(const u32x4 r, float (&f)[8]) { f[0] = bflo(r[0]); f[1] = bfhi(r[0]); f[2] = bflo(r[1]); f[3] = bfhi(r[1]); f[4] = bflo(r[2]); f[5] = bfhi(r[2]); f[6] = bflo(r[3]); f[7] = bfhi(r[3]); }
DI u32x4 pack8(const float (&f)[8]) { u32x4 r; r[0] = pack2(f[0], f[1]); r[1] = pack2(f[2], f[3]); r[2] = pack2(f[4], f[5]); r[3] = pack2(f[6], f[7]); return r; }
DI float sigmoidf_(float x) { return __builtin_amdgcn_rcpf(1.f + __expf(-x)); }
DI float shfl_x(float v, int m) { const int lane = ptid() & 63; return __int_as_float(__builtin_amdgcn_ds_bpermute((lane ^ m) << 2, __float_as_int(v))); }
DI float wave_sum(float v) { for (int o = 32; o > 0; o >>= 1) v += shfl_x(v, o); return v; }
DI void tokinfo(int m, int& t, int& T, int& mi) { if (m < MC) { t = m & 255; T = 256; mi = 0; } else { int q = m - MC; t = q & 1023; T = 1024; mi = 1 + (q >> 10); } }

#define XB_TMO      128
#define XB_XCNT(j)  (256  + 64 * (j))
#define XB_XSUB(j)  (1280 + 64 * (j))
#define XB_XGEN(j)  (2304 + 64 * (j))
#define XB_TOP      3328
#define XB_TOPGEN   3392
#define XB_SPIN_CAP (1u << 20)
#define LAS __attribute__((address_space(3)))
DI unsigned xb_ld(unsigned* p) { return __hip_atomic_load(p, __ATOMIC_RELAXED, __HIP_MEMORY_SCOPE_AGENT); }
DI unsigned xb_add(unsigned* p, unsigned v) { return __hip_atomic_fetch_add(p, v, __ATOMIC_RELAXED, __HIP_MEMORY_SCOPE_AGENT); }
DI unsigned xb_xcc_id() { return (unsigned)__builtin_amdgcn_s_getreg((3 << 11) | 20) & 0xFu; }
#define XB_SPIN(cond, bar) do { unsigned _sp = 0; while (cond) { __builtin_amdgcn_s_sleep(1); \
    if ((++_sp & 255u) == 0u) { if (xb_ld(&(bar)[XB_TMO])) break; if (_sp > XB_SPIN_CAP) { atomicAdd(&(bar)[XB_TMO], 1u); break; } } } } while (0)
struct XcdBarrier { unsigned* bar; unsigned x; volatile LAS unsigned* st; };
DI XcdBarrier xcd_barrier_post(unsigned* bar, volatile LAS unsigned* st) {
  XcdBarrier b; b.bar = bar; b.x = xb_xcc_id(); b.st = st;
  if (ptid() == 0) (void)xb_add(&bar[XB_XCNT(b.x)], 1u);
  return b;
}
DI void xcd_barrier_complete(unsigned* bar, unsigned x, unsigned& nloc, unsigned& nx) {
  const unsigned G = gridDim.x * gridDim.y * gridDim.z;
  unsigned sum, cnt, mine, sp = 0u;
  for (;;) {
    sum = 0u; cnt = 0u; mine = 0u;
#pragma unroll
    for (unsigned j = 0; j < 16; ++j) { const unsigned c = xb_ld(&bar[XB_XCNT(j)]); sum += c; cnt += (c > 0u) ? 1u : 0u; mine = (j == x) ? c : mine; }
    if (sum == G) break;
    __builtin_amdgcn_s_sleep(1);
    if ((++sp & 255u) == 0u) { if (xb_ld(&bar[XB_TMO])) break; if (sp > XB_SPIN_CAP) { atomicAdd(&bar[XB_TMO], 1u); break; } }
  }
  nloc = mine > 0u ? mine : 1u; nx = cnt > 0u ? cnt : 1u;
}
DI void xcd_barrier(const XcdBarrier& b) {
  asm volatile("s_waitcnt vmcnt(0)" ::: "memory");
  __syncthreads();
  if (ptid() == 0) {
    unsigned* bar = b.bar;
    __builtin_amdgcn_s_waitcnt(0);
    unsigned nloc = b.st[0], nx = b.st[1];
    if (nloc == 0u) { xcd_barrier_complete(bar, b.x, nloc, nx); b.st[0] = nloc; b.st[1] = nx; }
    const unsigned old = xb_add(&bar[XB_XSUB(b.x)], 1u);
    const unsigned gen = old / nloc;
    if (old + 1u == (gen + 1u) * nloc) {
      __builtin_amdgcn_fence(__ATOMIC_RELEASE, "agent");
      asm volatile("s_waitcnt vmcnt(0)" ::: "memory");
      const unsigned og = xb_add(&bar[XB_TOP], 1u);
      const unsigned tg = og / nx;
      if (og + 1u == (tg + 1u) * nx) xb_add(&bar[XB_TOPGEN], 1u);
      else XB_SPIN(xb_ld(&bar[XB_TOPGEN]) == tg, bar);
      __builtin_amdgcn_fence(__ATOMIC_ACQUIRE, "agent");
      xb_add(&bar[XB_XGEN(b.x)], 1u);
      asm volatile("s_waitcnt vmcnt(0)" ::: "memory");
    } else {
      XB_SPIN(xb_ld(&bar[XB_XGEN(b.x)]) == gen, bar);
      __builtin_amdgcn_fence(__ATOMIC_ACQUIRE, "agent");
      asm volatile("s_waitcnt vmcnt(0)" ::: "memory");
    }
  }
  __syncthreads();
}

__device__ void convert_T(const float* __restrict__ W, int K, int N, bf16_t* __restrict__ Wt, int ldt, char* smem) {
  float* t = (float*)(smem + vhalf() * VSMEM);
  const int tid = tidx(), ntn = N >> 6, nitems = (K >> 6) * ntn;
  const int kr = tid >> 4, c4 = (tid & 15) * 4;
  f32x4 v[4];
  { const int it = vblk() < nitems ? vblk() : 0; const int k0 = (it / ntn) << 6, n0 = (it % ntn) << 6;
#pragma unroll
    for (int i = 0; i < 4; ++i) v[i] = *(const f32x4*)(W + (size_t)(k0 + kr + 16 * i) * N + n0 + c4); }
  for (int it = vblk(); it < nitems; it += vgrid()) {
    const int k0 = (it / ntn) << 6, n0 = (it % ntn) << 6;
    __syncthreads();
#pragma unroll
    for (int i = 0; i < 4; ++i) { const int k = kr + 16 * i; t[k * 65 + c4] = v[i][0]; t[k * 65 + c4 + 1] = v[i][1]; t[k * 65 + c4 + 2] = v[i][2]; t[k * 65 + c4 + 3] = v[i][3]; }
    __syncthreads();
    { const int itn = it + vgrid() < nitems ? it + vgrid() : it; const int k1 = (itn / ntn) << 6, n1 = (itn % ntn) << 6;
#pragma unroll
      for (int i = 0; i < 4; ++i) v[i] = *(const f32x4*)(W + (size_t)(k1 + kr + 16 * i) * N + n1 + c4); }
#pragma unroll
    for (int i = 0; i < 2; ++i) { const int c = tid + 256 * i, n = c >> 3, kc = c & 7; float f[8];
#pragma unroll
      for (int e = 0; e < 8; ++e) f[e] = t[(kc * 8 + e) * 65 + n];
      *(u32x4*)(Wt + (size_t)(n0 + n) * ldt + k0 + kc * 8) = pack8(f); }
  }
}

__device__ void ada_phase(const P& p, char* smem) {
  float* sc = (float*)(smem + vhalf() * VSMEM);
  float* red = sc + 640;
  float* mod = (float*)(p.ws + WS_MOD);
  const int tid = tidx(), kq = tid >> 5, cq = tid & 31;
  for (int it = vblk(); it < 2 * 48 * 8; it += vgrid()) {
    const int l = it / 384, rem = it % 384, nb = rem >> 3, ks = rem & 7;
    const int n0 = nb * 128, k0 = ks * 128;
    __syncthreads();
    for (int e = tid; e < 640; e += NT) { const int i = e >> 7, k = e & 127; const float v = (i == 0) ? p.c_ctx[k0 + k] : p.c[(i - 1) * D + k0 + k]; sc[e] = v * sigmoidf_(v); }
    __syncthreads();
    float acc[5][4];
#pragma unroll
    for (int i = 0; i < 5; ++i)
#pragma unroll
      for (int j = 0; j < 4; ++j) acc[i][j] = 0.f;
    const float* wp = p.ada_w + ((size_t)l * D + k0 + kq * 16) * 6144 + n0 + cq * 4;
#pragma unroll 4
    for (int kk = 0; kk < 16; ++kk) { const float4 w = *(const float4*)(wp + (size_t)kk * 6144);
#pragma unroll
      for (int i = 0; i < 5; ++i) { const float s = sc[i * 128 + kq * 16 + kk]; acc[i][0] += s * w.x; acc[i][1] += s * w.y; acc[i][2] += s * w.z; acc[i][3] += s * w.w; } }
#pragma unroll
    for (int i = 0; i < 5; ++i)
#pragma unroll
      for (int j = 0; j < 4; ++j) red[(kq * 5 + i) * 128 + cq * 4 + j] = acc[i][j];
    __syncthreads();
    for (int e = tid; e < 640; e += NT) { const int i = e >> 7, n = e & 127; float s = 0.f;
#pragma unroll
      for (int q = 0; q < 8; ++q) s += red[(q * 5 + i) * 128 + n];
      if (ks == 0) s += p.ada_b[l * 6144 + n0 + n];
      atomicAdd(mod + ((size_t)l * 5 + i) * 6144 + n0 + n, s); }
  }
}

__device__ void norm_phase(const P& p, const float* xin  , const float* u, const float* gpost, const float* modU, int gate_idx,
                           float* xout, const float* gpre, const float* modN, int shift_idx, bf16_t* hout) {
  const int lane = tidx() & 63, wave = tidx() >> 6, nw = NT / 64;
  for (int m = vblk() * nw + wave; m < MT; m += vgrid() * nw) {
    int t, T, mi; tokinfo(m, t, T, mi);
    const float* xr = xin ? xin + (size_t)m * D : (m < MC ? p.x_prompt + (size_t)m * D : p.x_sample + (size_t)(m - MC) * D);
    float4 x[4];
#pragma unroll
    for (int i = 0; i < 4; ++i) x[i] = *(const float4*)(xr + i * 256 + lane * 4);
    if (u) {
      float4 uu[4]; float ss = 0.f;
#pragma unroll
      for (int i = 0; i < 4; ++i) { uu[i] = *(const float4*)(u + (size_t)m * D + i * 256 + lane * 4); ss += uu[i].x * uu[i].x + uu[i].y * uu[i].y + uu[i].z * uu[i].z + uu[i].w * uu[i].w; }
      ss = wave_sum(ss); const float rs = rsqrtf(ss * (1.f / D) + 1e-6f);
#pragma unroll
      for (int i = 0; i < 4; ++i) { const int c = i * 256 + lane * 4; const float4 g = *(const float4*)(gpost + c); const float4 ga = *(const float4*)(modU + ((size_t)mi * 6 + gate_idx) * D + c);
        x[i].x += ga.x * uu[i].x * rs * g.x; x[i].y += ga.y * uu[i].y * rs * g.y; x[i].z += ga.z * uu[i].z * rs * g.z; x[i].w += ga.w * uu[i].w * rs * g.w; }
    }
    if (xout) {
#pragma unroll
      for (int i = 0; i < 4; ++i) *(float4*)(xout + (size_t)m * D + i * 256 + lane * 4) = x[i];
    }
    if (hout) {
      float ss = 0.f;
#pragma unroll
      for (int i = 0; i < 4; ++i) ss += x[i].x * x[i].x + x[i].y * x[i].y + x[i].z * x[i].z + x[i].w * x[i].w;
      ss = wave_sum(ss); const float rs = rsqrtf(ss * (1.f / D) + 1e-6f);
#pragma unroll
      for (int i = 0; i < 4; ++i) { const int c = i * 256 + lane * 4; const float4 g = *(const float4*)(gpre + c);
        const float4 sh = *(const float4*)(modN + ((size_t)mi * 6 + shift_idx) * D + c); const float4 sc = *(const float4*)(modN + ((size_t)mi * 6 + shift_idx + 1) * D + c);
        u32x2 o; o.x = pack2(x[i].x * rs * g.x * (1.f + sc.x) + sh.x, x[i].y * rs * g.y * (1.f + sc.y) + sh.y); o.y = pack2(x[i].z * rs * g.z * (1.f + sc.z) + sh.z, x[i].w * rs * g.w * (1.f + sc.w) + sh.w);
        *(u32x2*)(hout + (size_t)m * LDH + c) = o; }
    }
  }
}

struct TileSrc { const bf16_t* A; int lda; int arow0; const bf16_t* B; int ldb; int brow0, brow1; int K; };

template <int MM, int NN> DI void zero_acc(f32x4 (&acc)[MM][NN]) {
#pragma unroll
  for (int m = 0; m < MM; ++m)
#pragma unroll
    for (int n = 0; n < NN; ++n) acc[m][n] = (f32x4){0.f, 0.f, 0.f, 0.f};
}

template <int MM, int NN, int KU = 0> struct Gemm {
  static constexpr int NA = MM / 2, NB = NN;
  unsigned oa_[NA], ob_[NB]; const bf16_t* A; const bf16_t* B; int nk; u32x4 ra[NA], rb[NB];
#define GT_LOAD(KT) do { const int kn_ = ((KT) < nk ? (KT) : nk - 1) * 64; \
    _Pragma("unroll") for (int i = 0; i < NA; ++i) ra[i] = *(const u32x4*)(A + (oa_[i] + kn_)); \
    _Pragma("unroll") for (int i = 0; i < NB; ++i) rb[i] = *(const u32x4*)(B + (ob_[i] + kn_)); } while (0)
  DI void begin(const TileSrc& s, const bool perm = false) {
    const int tid = ptid();
#pragma unroll
    for (int i = 0; i < NA; ++i) { const int row = (tid >> 3) + 64 * i, kc = tid & 7;
      int ar = s.arow0 + row; ar = ar < 0 ? 0 : (ar > MT - 1 ? MT - 1 : ar);
      oa_[i] = (unsigned)ar * (unsigned)s.lda + kc * 8; }
#pragma unroll
    for (int i = 0; i < NB; ++i) { const int row = (tid >> 3) + 64 * i, kc = tid & 7;
      const int rr = perm ? ((row & ~31) | (8 * ((row & 15) >> 2) + 4 * ((row >> 4) & 1) + (row & 3))) : row;
      const int br = rr < 32 * NN ? s.brow0 + rr : s.brow1 + rr - 32 * NN;
      ob_[i] = (unsigned)br * (unsigned)s.ldb + kc * 8; }
    A = s.A; B = s.B; nk = s.K >> 6;
    GT_LOAD(0);
  }
  DI void run(f32x4 (&acc)[MM][NN], char* smem) {
    bf16_t* sbase = (bf16_t*)smem;
    const int tid = ptid(), lane = tid & 63, wave = tid >> 6, wr = wave >> 2, wc = wave & 3, fr = lane & 15, fq = lane >> 4;
    int wofs; { const int r = tid >> 3, kc = tid & 7, ob = (r & 15) * 64 + (kc & 3) * 16; wofs = (((r >> 4) * 2 + (kc >> 2)) * 1024 + (ob ^ (((ob >> 9) & 1) << 5))) >> 1; }
    int robase; { const int ob = fr * 64 + fq * 16; robase = (ob ^ (((ob >> 9) & 1) << 5)) >> 1; }
#define GT_STORE(ST) do { bf16_t* sA_ = sbase + (ST) * 32768; bf16_t* sB_ = sA_ + 16384; \
    _Pragma("unroll") for (int i = 0; i < NA; ++i) *(u32x4*)(sA_ + wofs + i * 4096) = ra[i]; \
    _Pragma("unroll") for (int i = 0; i < NB; ++i) *(u32x4*)(sB_ + wofs + i * 4096) = rb[i]; } while (0)
#define GT_KSTEP(ks) do { bf16x8 bfr[NN]; \
      _Pragma("unroll") for (int n = 0; n < NN; ++n) bfr[n] = *(const bf16x8*)(sB_ + ((wc * NN + n) * 2 + (ks)) * 512); \
      _Pragma("unroll") for (int m = 0; m < MM; ++m) { const bf16x8 af = *(const bf16x8*)(sA_ + ((wr * MM + m) * 2 + (ks)) * 512); \
        _Pragma("unroll") for (int n = 0; n < NN; ++n) acc[m][n] = MFMA16(bfr[n], af, acc[m][n]); } } while (0)
#define GT_COMPUTE(ST) do { const bf16_t* sA_ = sbase + (ST) * 32768 + robase; const bf16_t* sB_ = sA_ + 16384; __builtin_amdgcn_s_setprio(1); \
    if (KU) { GT_KSTEP(0); GT_KSTEP(1); } else { _Pragma("unroll 1") for (int ks = 0; ks < 2; ++ks) GT_KSTEP(ks); } \
    __builtin_amdgcn_s_setprio(0); } while (0)
    __syncthreads();
    GT_STORE(0);
    GT_LOAD(1);
    __syncthreads();
#pragma unroll 1
    for (int kt = 0; kt < nk; kt += 2) {
      GT_STORE(1); GT_LOAD(kt + 2); GT_COMPUTE(0); __syncthreads();
      GT_STORE(0); GT_LOAD(kt + 3); GT_COMPUTE(1); __syncthreads();
    }
  }
#undef GT_LOAD
#undef GT_STORE
#undef GT_COMPUTE
#undef GT_KSTEP
};
template <int MM, int NN> DI void gemm_tile(f32x4 (&acc)[MM][NN], const TileSrc& s, char* smem) { Gemm<MM, NN> g; g.begin(s); g.run(acc, smem); }

DI float gelu_tanh(float x) { const float u = 0.7978845608f * (x + 0.044715f * x * x * x); const float e = __expf(2.f * u); const float th = 1.f - 2.f * __builtin_amdgcn_rcpf(e + 1.f); return 0.5f * x * (1.f + th); }

struct TileIter {
  int m_lo, rows, NTn, G, efull, count, e, stride;
  DI void init(int MTn, int NTn_) { const int x = blockIdx.x & 7; m_lo = (x * MTn) >> 3; rows = (((x + 1) * MTn) >> 3) - m_lo; NTn = NTn_; G = (rows + 1) >> 1;
    efull = (rows / G) * G * NTn; count = rows * NTn; e = blockIdx.x >> 3; stride = gridDim.x >> 3; }
  DI bool next(int& mt, int& nt) { if (e >= count) return false;
    if (e < efull) { const int grp = e / (G * NTn), rem = e - grp * G * NTn; nt = rem / G; mt = m_lo + grp * G + (rem - nt * G); }
    else { const int rem = e - efull, gsz = rows - (rows / G) * G; nt = rem / gsz; mt = m_lo + (rows / G) * G + (rem - nt * gsz); }
    e += stride; return true; }
};

__device__ void phase_win(const P& p, int l, char* smem) {
  const bf16_t* H = (const bf16_t*)(p.ws + WS_H); const bf16_t* Wt = (const bf16_t*)(p.ws + WS_WIN);
  bf16_t* zr = (bf16_t*)(p.ws + WS_ZR); bf16_t* zn = (bf16_t*)(p.ws + WS_ZN); bf16_t* zt = (bf16_t*)(p.ws + WS_ZT);
  const int tid = ptid(), lane = tid & 63, wave = tid >> 6, wr = wave >> 2, wc = wave & 3, fr = lane & 15, fq = lane >> 4;
  Gemm<8, 4> gm;
  TileIter ti; ti.init(48, 14);
  const int x = blockIdx.x & 7, nconv = (343 - x + 7) >> 3, nloc = ti.count + nconv;
  const float* cw = p.rwkv_conv + (size_t)l * 3 * NZR;
  for (int e = (int)(blockIdx.x >> 3); e < nloc; e += (int)(gridDim.x >> 3)) {
    f32x4 acc[8][4]; zero_acc<8, 4>(acc);
    if (e < nconv) {
      const int c = x + 8 * e, mt = c / 7, nt = c - mt * 7;
      const int n0 = nt * 256, arow0 = mt * 254 - 1;
      { TileSrc s{H, LDH, arow0, Wt, LDH, n0, n0 + 128, D}; gm.begin(s); }
      gm.run(acc, smem);
      float* sC = (float*)smem;
#pragma unroll 1
      for (int sl = 0; sl < 2; ++sl) {
        __syncthreads();
        if ((wc >> 1) == sl) {
#pragma unroll
          for (int m = 0; m < 8; ++m)
#pragma unroll
            for (int n = 0; n < 4; ++n) *(f32x4*)(sC + (wr * 128 + m * 16 + fr) * 132 + (wc & 1) * 64 + n * 16 + fq * 4) = acc[m][n];
        }
        __syncthreads();
        const int nb = n0 + sl * 128, c8 = (tid & 15) * 8;
        const f32x4 w0a = *(const f32x4*)(cw + nb + c8), w0b = *(const f32x4*)(cw + nb + c8 + 4), w1a = *(const f32x4*)(cw + NZR + nb + c8), w1b = *(const f32x4*)(cw + NZR + nb + c8 + 4),
                    w2a = *(const f32x4*)(cw + 2 * NZR + nb + c8), w2b = *(const f32x4*)(cw + 2 * NZR + nb + c8 + 4);
        const bool sg = nb + c8 >= 1664;
        for (int ee = tid; ee < 254 * 16; ee += NTP) {
          const int tr = 1 + (ee >> 4), g = arow0 + tr;
          if (g < MT) { int t, T, mi; tokinfo(g, t, T, mi);
            const float pm = t > 0 ? 1.f : 0.f, nm = t < T - 1 ? 1.f : 0.f;
            const float* r0 = sC + (tr - 1) * 132 + c8; const float* r1 = r0 + 132; const float* r2 = r1 + 132;
            f32x4 ya = (*(const f32x4*)r0 * w0a) * pm + *(const f32x4*)r1 * w1a + (*(const f32x4*)r2 * w2a) * nm;
            f32x4 yb = (*(const f32x4*)(r0 + 4) * w0b) * pm + *(const f32x4*)(r1 + 4) * w1b + (*(const f32x4*)(r2 + 4) * w2b) * nm;
            if (sg) {
#pragma unroll
              for (int j = 0; j < 4; ++j) { ya[j] = sigmoidf_(ya[j]); yb[j] = sigmoidf_(yb[j]); } }
            const u32x4 o = {pack2(ya[0], ya[1]), pack2(ya[2], ya[3]), pack2(yb[0], yb[1]), pack2(yb[2], yb[3])};
            *(u32x4*)(zr + (size_t)g * NZR + nb + c8) = o; }
        }
      }
    } else {
      int mt, nt; ti.e = e - nconv; ti.next(mt, nt);
      const int n0 = nt * 256, row0 = mt * 256;
      { TileSrc s{H, LDH, row0, Wt, LDH, NZR + n0, NZR + n0 + 128, D}; gm.begin(s, true); }
      gm.run(acc, smem);
#pragma unroll
      for (int m = 0; m < 8; ++m) { const int row = row0 + wr * 128 + m * 16 + fr;
#pragma unroll
        for (int g = 0; g < 2; ++g) { const int col = n0 + wc * 64 + g * 32 + fq * 8; const f32x4 v0 = acc[m][2 * g], v1 = acc[m][2 * g + 1];
          const u32x4 o = {pack2(v0[0], v0[1]), pack2(v0[2], v0[3]), pack2(v1[0], v1[1]), pack2(v1[2], v1[3])};
          if (col < NZN) {
            *(u32x4*)(zn + (size_t)row * NZN + col) = o;
            if (row < MC && col >= 512) { const int part = col - 512, isv = part >> 9, pp = part & 511, hh = pp >> 6, d = pp & 63, b = row >> 8, t = row & 255;
              float* dst = p.out + (isv ? O_V : O_K) + ((((size_t)b * 2 + l) * 8 + hh) * 256 + t) * 64 + d; *(f32x4*)dst = v0; *(f32x4*)(dst + 4) = v1; }
          } else { *(u32x4*)(zt + (size_t)row * LZT + (col - NZN)) = o; }
        } }
    }
  }
}

__device__ void phase_merge(const P& p, char* smem) {
  const bf16_t* H = (const bf16_t*)(p.ws + WS_H); const bf16_t* Wt = (const bf16_t*)(p.ws + WS_WIN); const bf16_t* Wo3 = (const bf16_t*)(p.ws + WS_WO3);
  bf16_t* mg = (bf16_t*)(p.ws + WS_MERGED);
  const int tid = ptid(), lane = tid & 63, wave = tid >> 6, wr = wave >> 2, wc = wave & 3, fr = lane & 15, fq = lane >> 4;
  TileIter ti; int mt, nt; ti.init(96, 8);
  while (ti.next(mt, nt)) {
    const int n0 = nt * 128, row0 = mt * 128;
    f32x4 macc[4][2]; zero_acc<4, 2>(macc);
#pragma unroll 1
    for (int i = 0; i < 3; ++i) {
      const bf16_t* O = (const bf16_t*)(p.ws + (i == 0 ? WS_OA : (i == 1 ? WS_ONA : WS_ORET)));
      f32x4 g[4][2]; zero_acc<4, 2>(g);
      { TileSrc s{H, LDH, row0, Wt, LDH, 5376 + i * 1024 + n0, 5376 + i * 1024 + n0 + 64, D}; { Gemm<4, 2, 1> gm; gm.begin(s, true); gm.run(g, smem); } }
      f32x4 a2[4][2]; zero_acc<4, 2>(a2);
      { TileSrc s{O, LDO, row0, Wo3 + (size_t)i * 1024 * LDO, LDO, n0, n0 + 64, 512}; { Gemm<4, 2, 1> gm; gm.begin(s, true); gm.run(a2, smem); } }
#pragma unroll
      for (int m = 0; m < 4; ++m)
#pragma unroll
        for (int n = 0; n < 2; ++n)
#pragma unroll
          for (int j = 0; j < 4; ++j) macc[m][n][j] += sigmoidf_(g[m][n][j]) * a2[m][n][j];
    }
#pragma unroll
    for (int m = 0; m < 4; ++m) { const int row = row0 + wr * 64 + m * 16 + fr;
      { const int col = n0 + wc * 32 + fq * 8; const u32x4 o = {pack2(macc[m][0][0], macc[m][0][1]), pack2(macc[m][0][2], macc[m][0][3]), pack2(macc[m][1][0], macc[m][1][1]), pack2(macc[m][1][2], macc[m][1][3])}; *(u32x4*)(mg + (size_t)row * LDH + col) = o; } }
  }
}

__device__ void phase_gemm_f32(const bf16_t* A, int lda, int K, const bf16_t* Bt, int ldb, float* C, char* smem) {
  const int tid = ptid(), lane = tid & 63, wave = tid >> 6, wr = wave >> 2, wc = wave & 3, fr = lane & 15, fq = lane >> 4;
  TileIter ti; int mt, nt; ti.init(64, 4);
  while (ti.next(mt, nt)) {
    const int n0 = nt * 256, row0 = mt * 192;
    f32x4 acc[6][4]; zero_acc<6, 4>(acc);
    TileSrc s{A, lda, row0, Bt, ldb, n0, n0 + 128, K}; { Gemm<6, 4, GEMM_F32_KU> gm; gm.begin(s, true); gm.run(acc, smem); }
#pragma unroll
    for (int m = 0; m < 6; ++m) { const int row = row0 + wr * 96 + m * 16 + fr;
#pragma unroll
      for (int g = 0; g < 2; ++g) { float* dst = C + (size_t)row * D + n0 + wc * 64 + g * 32 + fq * 8; *(f32x4*)dst = acc[m][2 * g]; *(f32x4*)(dst + 4) = acc[m][2 * g + 1]; } }
  }
}

__device__ void phase_ffn_up(const P& p, int l, char* smem) {
  const bf16_t* H = (const bf16_t*)(p.ws + WS_H); const bf16_t* Wt = (const bf16_t*)(p.ws + WS_WUP); bf16_t* hid = (bf16_t*)(p.ws + WS_HID);
  const int tid = ptid(), lane = tid & 63, wave = tid >> 6, wr = wave >> 2, wc = wave & 3, fr = lane & 15, fq = lane >> 4;
  const float* cw = p.ffn_conv + (size_t)l * 3 * 2 * FF;
  Gemm<6, 4, FFN_UP_KU> gm;
  for (int it = blockIdx.x; it < 65 * 22; it += gridDim.x) {
    const int mt = it / 22, nt = it - mt * 22;
    const int c0 = nt * 128, arow0 = mt * 190 - 1;
    f32x4 acc[6][4]; zero_acc<6, 4>(acc);
    { TileSrc s{H, LDH, arow0, Wt, LDH, c0, FF + c0, D}; gm.begin(s); }
    gm.run(acc, smem);
    float* sC = (float*)smem;
#pragma unroll 1
    for (int sl = 0; sl < 2; ++sl) {
      __syncthreads();
      if ((wc & 1) == sl) { const int cb = (wc >> 1) * 64;
#pragma unroll
        for (int m = 0; m < 6; ++m)
#pragma unroll
          for (int n = 0; n < 4; ++n) *(f32x4*)(sC + (wr * 96 + m * 16 + fr) * 132 + cb + n * 16 + fq * 4) = acc[m][n];
      }
      __syncthreads();
      const int cq = c0 + sl * 64, c4 = (tid & 15) * 4;
      const f32x4 v0 = *(const f32x4*)(cw + cq + c4), v1 = *(const f32x4*)(cw + 2 * FF + cq + c4), v2 = *(const f32x4*)(cw + 4 * FF + cq + c4);
      const f32x4 g0 = *(const f32x4*)(cw + FF + cq + c4), g1 = *(const f32x4*)(cw + 3 * FF + cq + c4), g2 = *(const f32x4*)(cw + 5 * FF + cq + c4);
      for (int e = tid; e < 190 * 16; e += NTP) {
        const int tr = 1 + (e >> 4), g = arow0 + tr;
        if (g < MT) { int t, T, mi; tokinfo(g, t, T, mi);
          const float pm = t > 0 ? 1.f : 0.f, nm = t < T - 1 ? 1.f : 0.f;
          const f32x4 va = *(const f32x4*)(sC + (tr - 1) * 132 + c4), vb = *(const f32x4*)(sC + tr * 132 + c4), vc = *(const f32x4*)(sC + (tr + 1) * 132 + c4);
          const f32x4 ga = *(const f32x4*)(sC + (tr - 1) * 132 + 64 + c4), gb = *(const f32x4*)(sC + tr * 132 + 64 + c4), gc = *(const f32x4*)(sC + (tr + 1) * 132 + 64 + c4);
          float r[4];
#pragma unroll
          for (int j = 0; j < 4; ++j) { const float val = pm * va[j] * v0[j] + vb[j] * v1[j] + nm * vc[j] * v2[j]; const float gt = pm * ga[j] * g0[j] + gb[j] * g1[j] + nm * gc[j] * g2[j]; r[j] = gelu_tanh(gt) * val; }
          u32x2 o; o.x = pack2(r[0], r[1]); o.y = pack2(r[2], r[3]);
          *(u32x2*)(hid + (size_t)g * FF + cq + c4) = o; }
      }
    }
  }
}

template <int CTRL> DI float dppf(float v) { return __int_as_float(__builtin_amdgcn_mov_dpp(__float_as_int(v), CTRL, 0xF, 0xF, true)); }
DI float row16_sum(float v) { v += dppf<0xB1>(v); v += dppf<0x4E>(v); v += dppf<0x141>(v); v += dppf<0x140>(v); return v; }

DI float frcp(float x) { return __builtin_amdgcn_rcpf(x); }
DI float fsig(float x) { return frcp(1.f + __expf(-x)); }
__device__ void scan_task(const P& p, int l, int seq, int h, int d, int half, char* smem) {
  float* sR = (float*)smem; float* sW = sR + 1024; float* sKD = sW + 1024; float* sB = sKD + 1024; float* sNK = sB + 1024; float* sV = sNK + 1024; float* sK = sV + 1024; float* sY = sK + 1024;
  float* sKn = sY + 2048; float* sKK = sKn + 16; bf16_t* sWT = (bf16_t*)(sKK + 64); bf16_t* sAL = sWT + 16 * LDT;
  const int tid = tidx(), lane = tid & 63, wave = tid >> 6, fr = lane & 15, fq = lane >> 4;
  const int row0 = seq < 32 ? seq * 256 : MC + (seq - 32) * 1024, T = seq < 32 ? 256 : 1024, nch = T >> 4;
  const bf16_t* zr = (const bf16_t*)(p.ws + WS_ZR);
  float* yout = (float*)(p.ws + WS_Y) + (size_t)d * MT * 512;
  __syncthreads();
  if (tid < 64) sKK[tid] = p.rwkv_k_k[l * 512 + h * 64 + tid];
  const int cc = wave * 16 + fr, gc = h * 64 + cc;
  bf16x8 bw[2], ba[2];
#pragma unroll
  for (int ks = 0; ks < 2; ++ks)
#pragma unroll
    for (int e = 0; e < 8; ++e) { const int k = ks * 32 + fq * 8 + e;
      bw[ks][e] = (short)f2bf(p.rwkv_w_up[((size_t)(l * 2 + d) * 64 + k) * 512 + gc]); ba[ks][e] = (short)f2bf(p.rwkv_a_up[((size_t)(l * 2 + d) * 64 + k) * 512 + gc]); }
  const float w0c = p.rwkv_w0[(l * 2 + d) * 512 + gc], a0c = p.rwkv_a0[(l * 2 + d) * 512 + gc], kac = p.rwkv_k_a[l * 512 + gc];
  const int rg = tid >> 4, kq = tid & 15, rbase = half * 32 + rg * 2;
  f32x2 S[2][2];
  if (seq >= 32) { const float* s0 = p.state_rwkv + (((((size_t)(seq - 32) * 2 + l) * 2 + d) * 8 + h) * 64 + rbase) * 64 + kq * 4;
#pragma unroll
    for (int r = 0; r < 2; ++r) { const f32x4 x = *(const f32x4*)(s0 + r * 64); S[r][0] = (f32x2){x[0], x[1]}; S[r][1] = (f32x2){x[2], x[3]}; } }
  else {
#pragma unroll
    for (int r = 0; r < 2; ++r) { S[r][0] = (f32x2){0.f, 0.f}; S[r][1] = (f32x2){0.f, 0.f}; } }
  if (seq >= 32) __builtin_amdgcn_s_setprio(2);
  const int at = (tid & 127) >> 3, apart = tid & 7, ahi = tid >> 7;
  size_t coff[3];
  { const int sb0 = ahi ? 512 + h * 64 : h * 64, sb1 = ahi ? 1536 : 1024 + h * 64, sb2 = 1600;
    coff[0] = (size_t)at * NZR + sb0 + apart * 8; coff[1] = (size_t)at * NZR + sb1 + apart * 8; coff[2] = (size_t)at * NZR + sb2 + apart * 8; }
  u32x4 pre[3];
  { const int t0 = (d ? nch - 1 : 0) * 16;
#pragma unroll
    for (int i = 0; i < 3; ++i) pre[i] = *(const u32x4*)(zr + (size_t)(row0 + t0) * NZR + coff[i]); }
  __syncthreads();
  for (int ci = 0; ci < nch; ++ci) {
    const int chunk = d ? nch - 1 - ci : ci, t0 = chunk * 16;
    { const int o = at * 64 + apart * 8; float f[8];
      unpack8(pre[0], f);
      if (ahi == 0) { *(f32x4*)(sR + o) = (f32x4){f[0], f[1], f[2], f[3]}; *(f32x4*)(sR + o + 4) = (f32x4){f[4], f[5], f[6], f[7]}; }
      else { *(f32x4*)(sK + o) = (f32x4){f[0], f[1], f[2], f[3]}; *(f32x4*)(sK + o + 4) = (f32x4){f[4], f[5], f[6], f[7]}; float ps = 0.f;
#pragma unroll
        for (int e = 0; e < 8; ++e) { const float kk = f[e] * sKK[apart * 8 + e]; ps += kk * kk; }
        ps += dppf<0xB1>(ps); ps += dppf<0x4E>(ps); ps += dppf<0x141>(ps);
        if (apart == 0) sKn[at] = ps; }
      unpack8(pre[1], f);
      if (ahi == 0) { *(f32x4*)(sV + o) = (f32x4){f[0], f[1], f[2], f[3]}; *(f32x4*)(sV + o + 4) = (f32x4){f[4], f[5], f[6], f[7]}; }
      else { float g[8];
#pragma unroll
        for (int e = 0; e < 8; ++e) g[e] = 1.f - 2.f * frcp(__expf(2.f * f[e]) + 1.f);
        *(u32x4*)(sWT + at * LDT + apart * 8) = pack8(g); }
      if (ahi == 0) *(u32x4*)(sAL + at * LDT + apart * 8) = pre[2];
    }
    __syncthreads();
    {
      f32x4 aw = {0.f, 0.f, 0.f, 0.f}, aa = {0.f, 0.f, 0.f, 0.f};
#pragma unroll
      for (int ks = 0; ks < 2; ++ks) { const bf16x8 fw = *(const bf16x8*)(sWT + fr * LDT + ks * 32 + fq * 8); const bf16x8 fa = *(const bf16x8*)(sAL + fr * LDT + ks * 32 + fq * 8);
        aw = MFMA16(fw, bw[ks], aw); aa = MFMA16(fa, ba[ks], aa); }
      const float kkc = sKK[cc];
#pragma unroll
      for (int j = 0; j < 4; ++j) { const int t = fq * 4 + j, o = t * 64 + cc;
        const float dec = __expf(-0.6065306597f * fsig(w0c + aw[j]));
        const float a = fsig(a0c + aa[j]);
        const float kv = sK[o];
        const float kkv = kv * kkc * __builtin_amdgcn_rsqf(fmaxf(sKn[t], 1e-24f));
        sW[o] = dec; sKD[o] = kv * (1.f + (a - 1.f) * kac); sB[o] = kkv * a; sNK[o] = -kkv; }
    }
    __syncthreads();
    { const int cn = ci + 1 < nch ? ci + 1 : ci; const int nt0 = (d ? nch - 1 - cn : cn) * 16;
#pragma unroll
      for (int i = 0; i < 3; ++i) pre[i] = *(const u32x4*)(zr + (size_t)(row0 + nt0) * NZR + coff[i]); }
#pragma unroll 8
    for (int si = 0; si < 16; ++si) {
      const int t = d ? 15 - si : si, o = t * 64 + kq * 4;
      const f32x4 an4 = *(const f32x4*)(sNK + o), w4 = *(const f32x4*)(sW + o), b4 = *(const f32x4*)(sB + o), kd4 = *(const f32x4*)(sKD + o), r4 = *(const f32x4*)(sR + o);
      const f32x2 v2 = *(const f32x2*)(sV + t * 64 + rbase);
      const f32x2 an[2] = {{an4[0], an4[1]}, {an4[2], an4[3]}}, wv[2] = {{w4[0], w4[1]}, {w4[2], w4[3]}}, bv[2] = {{b4[0], b4[1]}, {b4[2], b4[3]}}, kd[2] = {{kd4[0], kd4[1]}, {kd4[2], kd4[3]}}, rv[2] = {{r4[0], r4[1]}, {r4[2], r4[3]}};
      float sa[2];
#pragma unroll
      for (int r = 0; r < 2; ++r) { const f32x2 t2 = S[r][0] * an[0] + S[r][1] * an[1]; sa[r] = row16_sum(t2.x + t2.y); }
      f32x2 yv;
#pragma unroll
      for (int r = 0; r < 2; ++r) { const f32x2 sav = {sa[r], sa[r]}, vvv = {v2[r], v2[r]};
        S[r][0] = S[r][0] * wv[0] + (sav * bv[0] + vvv * kd[0]); S[r][1] = S[r][1] * wv[1] + (sav * bv[1] + vvv * kd[1]);
        const f32x2 y2 = S[r][0] * rv[0] + S[r][1] * rv[1]; float yp = y2.x + y2.y; yp += dppf<0xB1>(yp); yp += dppf<0x4E>(yp); yv[r] = yp; }
      if ((kq & 3) == 0) { sY[((t * 32 + rg * 2) * 4) + (kq >> 2)] = yv[0]; sY[((t * 32 + rg * 2 + 1) * 4) + (kq >> 2)] = yv[1]; }
    }
    __syncthreads();
    { const int t = tid >> 4, lr = (tid & 15) * 2; const f32x4 p0 = *(const f32x4*)(sY + (t * 32 + lr) * 4), p1 = *(const f32x4*)(sY + (t * 32 + lr + 1) * 4);
      *(f32x2*)(yout + (size_t)(row0 + t0 + t) * 512 + h * 64 + half * 32 + lr) = (f32x2){p0[0] + p0[1] + p0[2] + p0[3], p1[0] + p1[1] + p1[2] + p1[3]}; }
  }
  __builtin_amdgcn_s_setprio(0);
  if (seq < 32) { float* so = p.out + O_RW + (((((size_t)seq * 2 + l) * 2 + d) * 8 + h) * 64 + rbase) * 64 + kq * 4;
#pragma unroll
    for (int r = 0; r < 2; ++r) *(f32x4*)(so + r * 64) = (f32x4){S[r][0].x, S[r][0].y, S[r][1].x, S[r][1].y}; }
}

DI void qk_scores(const bf16_t* sK, const bf16x8 (&qf)[2], f32x4 (&sacc)[4], int fr, int fq) {
#pragma unroll
  for (int nt = 0; nt < 4; ++nt) { sacc[nt] = (f32x4){0.f, 0.f, 0.f, 0.f};
#pragma unroll
    for (int ks = 0; ks < 2; ++ks) { const bf16x8 kf = *(const bf16x8*)(sK + (nt * 16 + fr) * LDT + ks * 32 + fq * 8); sacc[nt] = MFMA16(kf, qf[ks], sacc[nt]); } }
}
DI void pv_accum(const bf16_t* sVt, const f32x4 (&pacc)[4], f32x4 (&o)[4], int fr, int fq) {
#pragma unroll
  for (int s = 0; s < 2; ++s) {
    bf16x8 pf; { const unsigned a = pack2(pacc[2 * s][0], pacc[2 * s][1]), b = pack2(pacc[2 * s][2], pacc[2 * s][3]), c = pack2(pacc[2 * s + 1][0], pacc[2 * s + 1][1]), dd = pack2(pacc[2 * s + 1][2], pacc[2 * s + 1][3]);
      const u32x4 u = (u32x4){a, b, c, dd}; pf = __builtin_bit_cast(bf16x8, u); }
#pragma unroll
    for (int dt = 0; dt < 4; ++dt) { const u32x2 lo = *(const u32x2*)(sVt + (dt * 16 + fr) * LDT + 32 * s + 4 * fq), hi = *(const u32x2*)(sVt + (dt * 16 + fr) * LDT + 32 * s + 16 + 4 * fq);
      const u32x4 u = (u32x4){lo[0], lo[1], hi[0], hi[1]}; const bf16x8 vf = __builtin_bit_cast(bf16x8, u); o[dt] = MFMA16(vf, pf, o[dt]); }
  }
}
DI void put_kv(bf16_t* sK, bf16_t* sVt, int key, int part, const float (&kf)[8], int vkey, int vpart, const float (&vf)[8]) {
  *(u32x4*)(sK + key * LDT + part * 8) = pack8(kf);
#pragma unroll
  for (int e = 0; e < 8; ++e) sVt[(vpart * 8 + e) * LDT + vkey] = f2bf(vf[e]);
}
DI void softmax_tile(f32x4 (&sacc)[4], f32x4 (&o)[4], float& mrun, float& lrun) {
  float mx = sacc[0][0];
#pragma unroll
  for (int nt = 0; nt < 4; ++nt)
#pragma unroll
    for (int j = 0; j < 4; ++j) mx = fmaxf(mx, sacc[nt][j]);
  mx = fmaxf(mx, shfl_x(mx, 16)); mx = fmaxf(mx, shfl_x(mx, 32));
  const float mnew = fmaxf(mrun, mx), alpha = __builtin_amdgcn_exp2f(mrun - mnew); mrun = mnew;
  float ls = 0.f;
#pragma unroll
  for (int nt = 0; nt < 4; ++nt)
#pragma unroll
    for (int j = 0; j < 4; ++j) { const float pv = __builtin_amdgcn_exp2f(sacc[nt][j] - mnew); sacc[nt][j] = pv; ls += pv; }
  lrun = lrun * alpha + ls;
#pragma unroll
  for (int dt = 0; dt < 4; ++dt) o[dt] *= alpha;
}
constexpr float LOG2E = 1.4426950408889634f;

__device__ void dense_task(const P& p, int b, int h, int qb, char* smem) {
  bf16_t* sK = (bf16_t*)smem; bf16_t* sVt = sK + 64 * LDT;
  const int tid = tidx(), lane = tid & 63, wave = tid >> 6, fr = lane & 15, fq = lane >> 4;
  const bf16_t* zn = (const bf16_t*)(p.ws + WS_ZN); bf16_t* ona = (bf16_t*)(p.ws + WS_ONA);
  const int qrow = b * 256 + qb * 64 + wave * 16 + fr;
  bf16x8 qf[2];
#pragma unroll
  for (int ks = 0; ks < 2; ++ks) qf[ks] = *(const bf16x8*)(zn + (size_t)qrow * NZN + h * 64 + ks * 32 + fq * 8);
  f32x4 o[4]; for (int dt = 0; dt < 4; ++dt) o[dt] = (f32x4){0.f, 0.f, 0.f, 0.f};
  float mrun = -1e30f, lrun = 0.f;
  u32x4 pk[2], pv[2];
#pragma unroll
  for (int i = 0; i < 2; ++i) { const int c = tid + 256 * i, key = c >> 3, part = c & 7, vkey = c & 63, vpart = c >> 6; pk[i] = *(const u32x4*)(zn + (size_t)(b * 256 + key) * NZN + h * 64 + part * 8 + 512); pv[i] = *(const u32x4*)(zn + (size_t)(b * 256 + vkey) * NZN + h * 64 + vpart * 8 + 1024); }
  for (int kt = 0; kt < 4; ++kt) {
    __syncthreads();
#pragma unroll
    for (int i = 0; i < 2; ++i) { const int c = tid + 256 * i, key = c >> 3, part = c & 7, vkey = c & 63, vpart = c >> 6;
      *(u32x4*)(sK + key * LDT + part * 8) = pk[i];
#pragma unroll
      for (int e = 0; e < 4; ++e) { sVt[(vpart * 8 + 2 * e) * LDT + vkey] = (bf16_t)(pv[i][e] & 0xffffu); sVt[(vpart * 8 + 2 * e + 1) * LDT + vkey] = (bf16_t)(pv[i][e] >> 16); } }
    __syncthreads();
    { const int kn = kt < 3 ? kt + 1 : 3;
#pragma unroll
      for (int i = 0; i < 2; ++i) { const int c = tid + 256 * i, key = c >> 3, part = c & 7, vkey = c & 63, vpart = c >> 6; pk[i] = *(const u32x4*)(zn + (size_t)(b * 256 + kn * 64 + key) * NZN + h * 64 + part * 8 + 512); pv[i] = *(const u32x4*)(zn + (size_t)(b * 256 + kn * 64 + vkey) * NZN + h * 64 + vpart * 8 + 1024); } }
    f32x4 sacc[4]; qk_scores(sK, qf, sacc, fr, fq);
#pragma unroll
    for (int nt = 0; nt < 4; ++nt) sacc[nt] *= (0.125f * LOG2E);
    softmax_tile(sacc, o, mrun, lrun);
    pv_accum(sVt, sacc, o, fr, fq);
  }
  lrun += shfl_x(lrun, 16); lrun += shfl_x(lrun, 32); const float inv = 1.f / lrun;
#pragma unroll
  for (int dt = 0; dt < 4; ++dt) { u32x2 ov; ov.x = pack2(o[dt][0] * inv, o[dt][1] * inv); ov.y = pack2(o[dt][2] * inv, o[dt][3] * inv); *(u32x2*)(ona + (size_t)qrow * LDO + h * 64 + dt * 16 + fq * 4) = ov; }
}

__device__ void na_task(const P& p, int l, int b, int h, int r, char* smem) {
  bf16_t* sK = (bf16_t*)smem; bf16_t* sVt = sK + 64 * LDT; float* sRpb = (float*)(sVt + 64 * LDT);
  const int tid = tidx(), lane = tid & 63, wave = tid >> 6, fr = lane & 15, fq = lane >> 4;
  const bf16_t* zn = (const bf16_t*)(p.ws + WS_ZN); bf16_t* ona = (bf16_t*)(p.ws + WS_ONA);
  const int base = MC + b * 1024, qcol = wave * 16 + fr, qrow = base + r * 64 + qcol;
  int rs = r - 4; rs = rs < 0 ? 0 : (rs > 8 ? 8 : rs);
  int cs = qcol - 8; cs = cs < 0 ? 0 : (cs > 48 ? 48 : cs);
  __syncthreads();
  for (int e = tid; e < 465; e += NT) sRpb[e] = p.na_rpb[((size_t)l * 8 + h) * 465 + e] * LOG2E;
  bf16x8 qf[2];
#pragma unroll
  for (int ks = 0; ks < 2; ++ks) qf[ks] = *(const bf16x8*)(zn + (size_t)qrow * NZN + h * 64 + ks * 32 + fq * 8);
  f32x4 o[4]; for (int dt = 0; dt < 4; ++dt) o[dt] = (f32x4){0.f, 0.f, 0.f, 0.f};
  float mrun = -1e30f, lrun = 0.f;
  u32x4 pre[8];
#define NA_ISSUE(KT) do { const int kt_ = (KT); \
    if (kt_ < 8) { _Pragma("unroll") for (int i = 0; i < 2; ++i) { const int c = tid + 256 * i, key = c >> 3, part = c & 7, vkey = c & 63, vpart = c >> 6; \
        pre[4 * i] = *(const u32x4*)(zn + (size_t)(base + (rs + kt_) * 64 + key) * NZN + h * 64 + part * 8 + 512); pre[4 * i + 1] = *(const u32x4*)(zn + (size_t)(base + (rs + kt_) * 64 + vkey) * NZN + h * 64 + vpart * 8 + 1024); } } \
    else { _Pragma("unroll") for (int i = 0; i < 2; ++i) { const int c = tid + 256 * i, key = c >> 3, part = c & 7, vkey = c & 63, vpart = c >> 6; const size_t cb_ = (((size_t)b * 2 + l) * 8 + h) * 256 + (kt_ - 8) * 64; const size_t co = (cb_ + key) * 64 + part * 8, cv = (cb_ + vkey) * 64 + vpart * 8; \
        pre[4 * i] = *(const u32x4*)(p.cache_k + co); pre[4 * i + 1] = *(const u32x4*)(p.cache_k + co + 4); pre[4 * i + 2] = *(const u32x4*)(p.cache_v + cv); pre[4 * i + 3] = *(const u32x4*)(p.cache_v + cv + 4); } } } while (0)
  NA_ISSUE(0);
  for (int kt = 0; kt < 12; ++kt) {
    __syncthreads();
    if (kt < 8) {
#pragma unroll
      for (int i = 0; i < 2; ++i) { const int c = tid + 256 * i, key = c >> 3, part = c & 7, vkey = c & 63, vpart = c >> 6;
        *(u32x4*)(sK + key * LDT + part * 8) = pre[4 * i];
#pragma unroll
        for (int e = 0; e < 4; ++e) { sVt[(vpart * 8 + 2 * e) * LDT + vkey] = (bf16_t)(pre[4 * i + 1][e] & 0xffffu); sVt[(vpart * 8 + 2 * e + 1) * LDT + vkey] = (bf16_t)(pre[4 * i + 1][e] >> 16); } }
    } else {
#pragma unroll
      for (int i = 0; i < 2; ++i) { const int c = tid + 256 * i, key = c >> 3, part = c & 7, vkey = c & 63, vpart = c >> 6;
        const f32x4 k0 = __builtin_bit_cast(f32x4, pre[4 * i]), k1 = __builtin_bit_cast(f32x4, pre[4 * i + 1]), v0 = __builtin_bit_cast(f32x4, pre[4 * i + 2]), v1 = __builtin_bit_cast(f32x4, pre[4 * i + 3]);
        const float kf[8] = {k0[0], k0[1], k0[2], k0[3], k1[0], k1[1], k1[2], k1[3]}; const float vf[8] = {v0[0], v0[1], v0[2], v0[3], v1[0], v1[1], v1[2], v1[3]};
        put_kv(sK, sVt, key, part, kf, vkey, vpart, vf); }
    }
    __syncthreads();
    NA_ISSUE(kt < 11 ? kt + 1 : 11);
    f32x4 sacc[4]; qk_scores(sK, qf, sacc, fr, fq);
    if (kt < 8) { const int dr = rs + kt - r + 7;
#pragma unroll
      for (int nt = 0; nt < 4; ++nt)
#pragma unroll
        for (int j = 0; j < 4; ++j) { const int kc = nt * 16 + fq * 4 + j; const bool valid = kc >= cs && kc < cs + 16; int dc = kc - qcol; dc = dc < -15 ? -15 : (dc > 15 ? 15 : dc);
          sacc[nt][j] = valid ? sacc[nt][j] * (0.125f * LOG2E) + sRpb[dr * 31 + dc + 15] : -1e30f; }
    } else {
#pragma unroll
      for (int nt = 0; nt < 4; ++nt) sacc[nt] *= (0.125f * LOG2E);
    }
    softmax_tile(sacc, o, mrun, lrun);
    pv_accum(sVt, sacc, o, fr, fq);
  }
#undef NA_ISSUE
  lrun += shfl_x(lrun, 16); lrun += shfl_x(lrun, 32); const float inv = 1.f / lrun;
#pragma unroll
  for (int dt = 0; dt < 4; ++dt) { u32x2 ov; ov.x = pack2(o[dt][0] * inv, o[dt][1] * inv); ov.y = pack2(o[dt][2] * inv, o[dt][3] * inv); *(u32x2*)(ona + (size_t)qrow * LDO + h * 64 + dt * 16 + fq * 4) = ov; }
}

DI void rope8(const float (&own)[8], const float (&par)[8], int part, int n, float (&out)[8]) {
  const float pos = (float)((part >> 2) ? (n & 63) : (n >> 6));
  const bool isx2 = (part & 3) >= 2;
#pragma unroll
  for (int e = 0; e < 8; ++e) { const int i = (part & 1) * 8 + e; const float ang = pos * __builtin_amdgcn_exp2f(-(float)i * 0.830482023721841f); const float sn = __sinf(ang), cs = __cosf(ang);
    out[e] = isx2 ? par[e] * sn + own[e] * cs : own[e] * cs - par[e] * sn; }
}

DI void rope8t(const float (&own)[8], const float (&par)[8], int part, int n, const float* tab, float (&out)[8]) {
  const int pos = (part >> 2) ? (n & 63) : (n >> 6);
  const bool isx2 = (part & 3) >= 2;
  const float* tb = tab + (pos * 16 + (part & 1) * 8) * 2;
#pragma unroll
  for (int e = 0; e < 8; e += 2) { const f32x4 cssn = *(const f32x4*)(tb + 2 * e);
    out[e] = isx2 ? par[e] * cssn[1] + own[e] * cssn[0] : own[e] * cssn[0] - par[e] * cssn[1];
    out[e + 1] = isx2 ? par[e + 1] * cssn[3] + own[e + 1] * cssn[2] : own[e + 1] * cssn[2] - par[e + 1] * cssn[3]; }
}

__device__ void ret_task(const P& p, int l, int seq, int h, int qb, char* smem) {
  bf16_t* sK = (bf16_t*)smem; bf16_t* sVt = sK + 64 * LDT; bf16_t* sQ = sVt + 64 * LDT; float* sRope = (float*)(sQ + 64 * LDT);
  const int tid = tidx(), lane = tid & 63, wave = tid >> 6, fr = lane & 15, fq = lane >> 4;
  const bf16_t* zt = (const bf16_t*)(p.ws + WS_ZT); bf16_t* oret = (bf16_t*)(p.ws + WS_ORET);
  const bool lat = seq >= 32;
  const int row0 = lat ? MC + (seq - 32) * 1024 : seq * 256, T = lat ? 1024 : 256, nkt = T >> 6;
  const float xf = p.ret_decay[(l * 2 + 0) * 8 + h], xb = p.ret_decay[(l * 2 + 1) * 8 + h];
  const float lgf = -log1pf(__expf(-xf)) * LOG2E, lgb = -log1pf(__expf(-xb)) * LOG2E;
  __syncthreads();
  if (lat) {
#pragma unroll
    for (int j = 0; j < 4; ++j) { const int e = tid + 256 * j; const float ang = (float)(e >> 4) * __builtin_amdgcn_exp2f(-(float)(e & 15) * 0.830482023721841f); sRope[2 * e] = __cosf(ang); sRope[2 * e + 1] = __sinf(ang); }
    __syncthreads();
  }
#pragma unroll
  for (int i = 0; i < 2; ++i) { const int c = tid + 256 * i, qi = c >> 3, part = c & 7; const int n = qb * 64 + qi; const size_t ro = (size_t)(row0 + n) * LZT + h * 64;
    const u32x4 own = *(const u32x4*)(zt + ro + part * 8);
    if (lat) { const u32x4 par = *(const u32x4*)(zt + ro + (part ^ 2) * 8); float fo[8], fp[8], out[8]; unpack8(own, fo); unpack8(par, fp); rope8t(fo, fp, part, n, sRope, out); *(u32x4*)(sQ + qi * LDT + part * 8) = pack8(out); }
    else *(u32x4*)(sQ + qi * LDT + part * 8) = own; }
  __syncthreads();
  const int qi = wave * 16 + fr, nq = qb * 64 + qi;
  bf16x8 qf[2];
#pragma unroll
  for (int ks = 0; ks < 2; ++ks) qf[ks] = *(const bf16x8*)(sQ + qi * LDT + ks * 32 + fq * 8);
  f32x4 o[4]; for (int dt = 0; dt < 4; ++dt) o[dt] = (f32x4){0.f, 0.f, 0.f, 0.f};
  u32x4 rk[2], rp[2], rv[2];
#define RET_ISSUE(KT) do { _Pragma("unroll") for (int i = 0; i < 2; ++i) { const int c = tid + 256 * i, key = c >> 3, part = c & 7, vkey = c & 63, vpart = c >> 6; const size_t ro = (size_t)(row0 + (KT) * 64 + key) * LZT + h * 64; \
    rk[i] = *(const u32x4*)(zt + ro + 512 + part * 8); rp[i] = *(const u32x4*)(zt + ro + 512 + (part ^ 2) * 8); rv[i] = *(const u32x4*)(zt + (size_t)(row0 + (KT) * 64 + vkey) * LZT + h * 64 + 1024 + vpart * 8); } } while (0)
  RET_ISSUE(0);
  for (int kt = 0; kt < nkt; ++kt) {
    __syncthreads();
#pragma unroll
    for (int i = 0; i < 2; ++i) { const int c = tid + 256 * i, key = c >> 3, part = c & 7, vkey = c & 63, vpart = c >> 6; const int n = kt * 64 + key;
      float kf[8]; unpack8(rk[i], kf);
      if (lat) { float fp[8], out[8]; unpack8(rp[i], fp); rope8t(kf, fp, part, n, sRope, out);
#pragma unroll
        for (int e = 0; e < 8; ++e) kf[e] = out[e]; }
#pragma unroll
      for (int e = 0; e < 8; ++e) kf[e] *= 0.125f;
      *(u32x4*)(sK + key * LDT + part * 8) = pack8(kf);
#pragma unroll
      for (int e = 0; e < 4; ++e) { sVt[(vpart * 8 + 2 * e) * LDT + vkey] = (bf16_t)(rv[i][e] & 0xffffu); sVt[(vpart * 8 + 2 * e + 1) * LDT + vkey] = (bf16_t)(rv[i][e] >> 16); } }
    __syncthreads();
    RET_ISSUE(kt + 1 < nkt ? kt + 1 : kt);
    f32x4 sacc[4]; qk_scores(sK, qf, sacc, fr, fq);
#pragma unroll
    for (int nt = 0; nt < 4; ++nt)
#pragma unroll
      for (int j = 0; j < 4; ++j) { const int mk = kt * 64 + nt * 16 + fq * 4 + j; const int df = nq - mk;
        const float ex = __builtin_amdgcn_exp2f((df > 0 ? lgf : -lgb) * (float)df); sacc[nt][j] *= (df == 0 ? 2.f : ex); }
    pv_accum(sVt, sacc, o, fr, fq);
  }
#undef RET_ISSUE
  if (lat) {
    for (int dir = 0; dir < 2; ++dir) {
      __syncthreads();
      const float* s0 = p.state_ret + ((((size_t)(seq - 32) * 2 + l) * 2 + dir) * 8 + h) * 4096;
#pragma unroll
      for (int i = 0; i < 2; ++i) { const int c = tid + 256 * i, dk = c & 63, part = c >> 6; const float4 a = *(const float4*)(s0 + dk * 64 + part * 8), bq = *(const float4*)(s0 + dk * 64 + part * 8 + 4);
        const float vf[8] = {a.x, a.y, a.z, a.w, bq.x, bq.y, bq.z, bq.w};
#pragma unroll
        for (int e = 0; e < 8; ++e) sVt[(part * 8 + e) * LDT + dk] = f2bf(vf[e]); }
      __syncthreads();
      const float xi = dir == 0 ? exp2f(lgf * (float)(nq + 1)) : exp2f(lgb * (float)(T - nq));
      f32x4 pacc[4];
#pragma unroll
      for (int s = 0; s < 2; ++s)
#pragma unroll
        for (int hh = 0; hh < 2; ++hh)
#pragma unroll
          for (int j = 0; j < 4; ++j) pacc[2 * s + hh][j] = xi * bf2f(sQ[qi * LDT + 32 * s + 16 * hh + 4 * fq + j]);
      pv_accum(sVt, pacc, o, fr, fq);
    }
  }
  float s1 = 0.f;
#pragma unroll
  for (int dt = 0; dt < 4; ++dt)
#pragma unroll
    for (int j = 0; j < 4; ++j) s1 += o[dt][j];
  s1 += shfl_x(s1, 16); s1 += shfl_x(s1, 32); const float mu = s1 * (1.f / 64.f);
  float s2 = 0.f;
#pragma unroll
  for (int dt = 0; dt < 4; ++dt)
#pragma unroll
    for (int j = 0; j < 4; ++j) { const float dlt = o[dt][j] - mu; s2 += dlt * dlt; }
  s2 += shfl_x(s2, 16); s2 += shfl_x(s2, 32); const float rstd = rsqrtf(s2 * (1.f / 64.f) + 1e-5f);
  const size_t qrow = (size_t)(row0 + nq);
#pragma unroll
  for (int dt = 0; dt < 4; ++dt) { const int dv = h * 64 + dt * 16 + fq * 4; const u32x2 gr = *(const u32x2*)(zt + qrow * LZT + 1536 + dv); const float4 gn = *(const float4*)(p.ret_gn + l * 512 + dv);
    const float g0 = bflo(gr.x), g1 = bfhi(gr.x), g2 = bflo(gr.y), g3 = bfhi(gr.y);
    u32x2 ov; ov.x = pack2((o[dt][0] - mu) * rstd * gn.x * g0 * sigmoidf_(g0), (o[dt][1] - mu) * rstd * gn.y * g1 * sigmoidf_(g1));
    ov.y = pack2((o[dt][2] - mu) * rstd * gn.z * g2 * sigmoidf_(g2), (o[dt][3] - mu) * rstd * gn.w * g3 * sigmoidf_(g3));
    *(u32x2*)(oret + qrow * LDO + dv) = ov; }
}

__device__ void retstate_task(const P& p, int l, int b, int h, char* smem) {
  float* sKf = (float*)smem; float* sKb = sKf + 64 * 64; float* sV = sKb + 64 * 64;
  const int tid = tidx(), dk = tid >> 2, dq = tid & 3;
  const bf16_t* zt = (const bf16_t*)(p.ws + WS_ZT);
  const float xf = p.ret_decay[(l * 2 + 0) * 8 + h], xb = p.ret_decay[(l * 2 + 1) * 8 + h];
  const float lgf = -log1pf(__expf(-xf)) * LOG2E, lgb = -log1pf(__expf(-xb)) * LOG2E;
  float af[16], ab[16];
#pragma unroll
  for (int i = 0; i < 16; ++i) { af[i] = 0.f; ab[i] = 0.f; }
  for (int kt = 0; kt < 4; ++kt) {
    __syncthreads();
#pragma unroll
    for (int i = 0; i < 2; ++i) { const int c = tid + 256 * i, key = c >> 3, part = c & 7, m = kt * 64 + key; const size_t ro = (size_t)(b * 256 + m) * LZT + h * 64 + part * 8;
      float kf[8], vf[8]; unpack8(*(const u32x4*)(zt + ro + 512), kf); unpack8(*(const u32x4*)(zt + ro + 1024), vf);
      const float wf = 0.125f * exp2f(lgf * (float)(255 - m)), wb = 0.125f * exp2f(lgb * (float)m);
#pragma unroll
      for (int e = 0; e < 8; ++e) { sKf[key * 64 + part * 8 + e] = kf[e] * wf; sKb[key * 64 + part * 8 + e] = kf[e] * wb; sV[key * 64 + part * 8 + e] = vf[e]; } }
    __syncthreads();
    for (int m = 0; m < 64; ++m) { const float kf = sKf[m * 64 + dk], kb = sKb[m * 64 + dk];
#pragma unroll
      for (int i = 0; i < 4; ++i) { const f32x4 vv = *(const f32x4*)(sV + m * 64 + dq * 16 + i * 4);
#pragma unroll
        for (int j = 0; j < 4; ++j) { af[i * 4 + j] += kf * vv[j]; ab[i * 4 + j] += kb * vv[j]; } } }
  }
  float* of = p.out + O_RT + ((((size_t)b * 2 + l) * 2 + 0) * 8 + h) * 4096 + dk * 64 + dq * 16; float* ob = of + 8 * 4096;
#pragma unroll
  for (int i = 0; i < 16; ++i) { of[i] = af[i]; ob[i] = ab[i]; }
}

constexpr int Q_SCAN_L = 64, Q_SCAN_C = 512, Q_RET_L = 256, Q_NA = 256, Q_DENSE = 512, Q_RET_C = 512, Q_RST = 128;
template <int QMASK> __device__ void phase_mixers(const P& p, int l, char* smem_, int rep = 0) {
  __shared__ int s_task;
  int* ctr = (int*)(p.ws + WS_CTRL) + 64 * (l + 1) + 4 * rep;
  const int vb = vhalf(); char* smem = smem_ + vb * VSMEM;
  if (QMASK & 1) for (;;) {
    __syncthreads();
    if (ptid() == 0) s_task = atomicAdd(ctr, 1);
    __syncthreads();
    const int tk = s_task;
    if (tk >= Q_SCAN_L + Q_SCAN_C) break;
    const bool lat = tk < Q_SCAN_L; const int t2 = lat ? tk : tk - Q_SCAN_L;
    scan_task(p, l, (lat ? 32 : 0) + (t2 >> 4), (t2 >> 1) & 7, t2 & 1, vb, smem);
  }
  if (QMASK & 2) for (;;) {
    __syncthreads();
    if (ptid() == 0) s_task = atomicAdd(ctr + 16, 1);
    __syncthreads();
    const int tk = s_task;
    if (tk >= Q_RET_L + Q_RET_C) break;
    if (tk < Q_RET_L) ret_task(p, l, 32 + (tk >> 6), (tk >> 3) & 7, (tk & 7) * 2 + vb, smem);
    else { const int t2 = tk - Q_RET_L; ret_task(p, l, t2 >> 4, (t2 >> 1) & 7, (t2 & 1) * 2 + vb, smem); }
  }
  if (QMASK & 4) for (;;) {
    __syncthreads();
    if (ptid() == 0) s_task = atomicAdd(ctr + 32, 1);
    __syncthreads();
    int tk = s_task;
    if (tk >= Q_NA + Q_DENSE + Q_RST) break;
    if (tk < Q_NA) { na_task(p, l, tk >> 6, (tk >> 3) & 7, (tk & 7) * 2 + vb, smem); continue; } tk -= Q_NA;
    if (tk < Q_DENSE) { dense_task(p, tk >> 4, (tk >> 1) & 7, (tk & 1) * 2 + vb, smem); continue; } tk -= Q_DENSE;
    retstate_task(p, l, tk >> 2, (tk & 3) * 2 + vb, smem);
  }
}

__device__ void phase_rwkv_post(const P& p, int l, char* smem) {
  const bf16_t* zr = (const bf16_t*)(p.ws + WS_ZR); const float* yf = (const float*)(p.ws + WS_Y); const float* yb = yf + (size_t)MT * 512; bf16_t* oa = (bf16_t*)(p.ws + WS_OA);
  const bf16_t* Gt = (const bf16_t*)(p.ws + WS_WG);
  const int tid = ptid(), lane = tid & 63, wave = tid >> 6, wr = wave >> 2, wc = wave & 3, fr = lane & 15, fq = lane >> 4;
  TileIter ti; int mt, nt; ti.init(96, 2);
  while (ti.next(mt, nt)) {
    const int row0 = mt * 128, n0 = nt * 256;
    f32x4 acc[4][4]; zero_acc<4, 4>(acc);
    TileSrc s{zr + 1664, NZR, row0, Gt, LDG, n0, n0 + 128, 128}; { Gemm<4, 4, 1> gm; gm.begin(s, true); gm.run(acc, smem); }
    const int cb = n0 + wc * 64 + fq * 8;
#pragma unroll
    for (int m = 0; m < 4; ++m) { const size_t row = (size_t)(row0 + wr * 64 + m * 16 + fr);
      f32x4 y[4]; float s1 = 0.f, rk = 0.f; f32x4 vv[4];
#pragma unroll
      for (int n = 0; n < 4; ++n) { const int c = cb + 32 * (n >> 1) + 4 * (n & 1); y[n] = *(const f32x4*)(yf + row * 512 + c) + *(const f32x4*)(yb + row * 512 + c); s1 += y[n][0] + y[n][1] + y[n][2] + y[n][3];
        const u32x2 rr = *(const u32x2*)(zr + row * NZR + c), kk = *(const u32x2*)(zr + row * NZR + 512 + c), v2 = *(const u32x2*)(zr + row * NZR + 1024 + c); const f32x4 rkw = *(const f32x4*)(p.rwkv_r_k + l * 512 + c);
        rk += bflo(rr.x) * bflo(kk.x) * rkw[0] + bfhi(rr.x) * bfhi(kk.x) * rkw[1] + bflo(rr.y) * bflo(kk.y) * rkw[2] + bfhi(rr.y) * bfhi(kk.y) * rkw[3];
        vv[n] = (f32x4){bflo(v2.x), bfhi(v2.x), bflo(v2.y), bfhi(v2.y)}; }
      s1 += shfl_x(s1, 16); s1 += shfl_x(s1, 32); rk += shfl_x(rk, 16); rk += shfl_x(rk, 32);
      const float mu = s1 * (1.f / 64.f); float s2 = 0.f;
#pragma unroll
      for (int n = 0; n < 4; ++n)
#pragma unroll
        for (int j = 0; j < 4; ++j) { const float dl = y[n][j] - mu; s2 += dl * dl; }
      s2 += shfl_x(s2, 16); s2 += shfl_x(s2, 32); const float rstd = rsqrtf(s2 * (1.f / 64.f) + 64e-5f);
#pragma unroll
      for (int n = 0; n < 4; ++n) { const int c = cb + 32 * (n >> 1) + 4 * (n & 1); const f32x4 lg = *(const f32x4*)(p.rwkv_ln_g + l * 512 + c), lb = *(const f32x4*)(p.rwkv_ln_b + l * 512 + c);
        float o[4];
#pragma unroll
        for (int j = 0; j < 4; ++j) o[j] = ((y[n][j] - mu) * rstd * lg[j] + lb[j] + rk * vv[n][j]) * acc[m][n][j];
        u32x2 ov; ov.x = pack2(o[0], o[1]); ov.y = pack2(o[2], o[3]); *(u32x2*)(oa + row * LDO + c) = ov; }
    }
  }
}

DI void convert_layer_a(const P& p, int l, char* smem) {
  convert_T(p.w_in + (size_t)l * D * INC, D, INC, (bf16_t*)(p.ws + WS_WIN), LDH, smem);
  convert_T(p.w_o_rwkv + (size_t)l * 512 * D, 512, D, (bf16_t*)(p.ws + WS_WO3), LDO, smem);
  convert_T(p.w_o_na + (size_t)l * 512 * D, 512, D, (bf16_t*)(p.ws + WS_WO3) + (size_t)1024 * LDO, LDO, smem);
  convert_T(p.w_o_ret + (size_t)l * 512 * D, 512, D, (bf16_t*)(p.ws + WS_WO3) + (size_t)2 * 1024 * LDO, LDO, smem);
  convert_T(p.w_out + (size_t)l * D * D, D, D, (bf16_t*)(p.ws + WS_WOUT), LDH, smem);
  convert_T(p.rwkv_g_up + (size_t)l * 128 * 512, 128, 512, (bf16_t*)(p.ws + WS_WG), LDG, smem);
}
DI void convert_layer_b(const P& p, int l, char* smem) {
  convert_T(p.ffn_up + (size_t)l * D * 2 * FF, D, 2 * FF, (bf16_t*)(p.ws + WS_WUP), LDH, smem);
  convert_T(p.ffn_down + (size_t)l * FF * D, FF, D, (bf16_t*)(p.ws + WS_WDN), FF, smem);
}

typedef __attribute__((address_space(4))) const P* KP;
DI KP kargs() { KP k = (KP)__builtin_amdgcn_kernarg_segment_ptr(); asm volatile("" : "+s"(k)); return k; }
template <int PH> DI void run_phase(int l, char* smem) {
#if defined(__HIP_DEVICE_COMPILE__)
  const P p = *kargs();
#else
  const P p{};
#endif
  const float* mod = (const float*)(p.ws + WS_MOD);
  float* xbuf = p.out;
  if (PH == 0) { ada_phase(p, smem); convert_layer_a(p, 0, smem); }
  else if (PH == 1) { norm_phase(p, nullptr, nullptr, nullptr, nullptr, 0, nullptr, p.norm_mix_pre, mod, 0, (bf16_t*)(p.ws + WS_H)); }
  else if (PH == 2) phase_win(p, l, smem);
  else if (PH == 4) phase_mixers<7>(p, l, smem);
  else if (PH == 5) phase_rwkv_post(p, l, smem);
  else if (PH == 6) phase_merge(p, smem);
  else if (PH == 7) { phase_gemm_f32((const bf16_t*)(p.ws + WS_MERGED), LDH, D, (const bf16_t*)(p.ws + WS_WOUT), LDH, (float*)(p.ws + WS_U), smem); }
  else if (PH == 8) { convert_layer_b(p, l, smem);
    norm_phase(p, l == 0 ? nullptr : xbuf, (const float*)(p.ws + WS_U), p.norm_mix_post + l * D, mod + (size_t)l * 5 * 6144, 2, xbuf, p.norm_ffn_pre + l * D, mod + (size_t)l * 5 * 6144, 3, (bf16_t*)(p.ws + WS_H)); }
  else if (PH == 9) phase_ffn_up(p, l, smem);
  else if (PH == 11) { phase_gemm_f32((const bf16_t*)(p.ws + WS_HID), FF, FF, (const bf16_t*)(p.ws + WS_WDN), FF, (float*)(p.ws + WS_F), smem); }
  else if (PH == 12) {
    if (l == 0) { norm_phase(p, xbuf, (const float*)(p.ws + WS_F), p.norm_ffn_post, mod, 5, xbuf, p.norm_mix_pre + D, mod + (size_t)5 * 6144, 0, (bf16_t*)(p.ws + WS_H)); convert_layer_a(p, 1, smem); }
    else norm_phase(p, xbuf, (const float*)(p.ws + WS_F), p.norm_ffn_post + D, mod + (size_t)5 * 6144, 5, xbuf, nullptr, nullptr, 0, nullptr);
  }
}

#if MEGA
__global__ void __launch_bounds__(NTP, 1) mega_kernel(P p_) {
  extern __shared__ __attribute__((aligned(16))) char smem[];
  __shared__ u32x4 xb_words;
  cg::grid_group grid = cg::this_grid();
  if (ptid() == 0) xb_words = (u32x4){0u, 0u, 0u, 0u};
  __syncthreads();
#if defined(__HIP_DEVICE_COMPILE__)
  (void)xcd_barrier_post((unsigned*)(p_.ws + WS_BAR), (volatile LAS unsigned*)&xb_words);
#define GSYNC() do { XcdBarrier xb_; xb_.bar = (unsigned*)(kargs()->ws + WS_BAR); xb_.x = xb_xcc_id(); xb_.st = (volatile LAS unsigned*)&xb_words; xcd_barrier(xb_); } while (0)
#else
#define GSYNC() do { } while (0)
#endif
  run_phase<0>(0, smem); grid.sync();
  run_phase<1>(0, smem); GSYNC();
#pragma unroll
  for (int l = 0; l < 2; ++l) {
    run_phase<2>(l, smem); GSYNC();
    if (PROBE_MASK & 1) { run_phase<2>(l, smem); GSYNC(); }
    run_phase<4>(l, smem); GSYNC();
    run_phase<5>(l, smem); GSYNC();
    run_phase<6>(l, smem); GSYNC();
    if (PROBE_MASK & 8) { run_phase<6>(l, smem); GSYNC(); }
    run_phase<7>(l, smem); GSYNC();
    if (PROBE_MASK & 16) { run_phase<7>(l, smem); GSYNC(); }
    run_phase<8>(l, smem); GSYNC();
    run_phase<9>(l, smem); GSYNC();
    if (PROBE_MASK & 32) { run_phase<9>(l, smem); GSYNC(); }
    run_phase<11>(l, smem); GSYNC();
    if (PROBE_MASK & 64) { run_phase<11>(l, smem); GSYNC(); }
    run_phase<12>(l, smem); if (l == 0) GSYNC();
  }
#undef GSYNC
}
#else
template <int PH> __global__ void __launch_bounds__(NTP, 1) phase_kernel(P p, int l) {
  extern __shared__ __attribute__((aligned(16))) char smem[];
  run_phase<PH>(l, smem);
}
#endif

extern "C" void kernel_launch(void* const* d_in, const int* in_sizes, int n_in, void* d_out, int out_size, void* d_ws, size_t ws_size, hipStream_t stream) {
  if (ws_size < WS_END || n_in < 36) { fprintf(stderr, "workspace too small: %zu < %zu\n", ws_size, (size_t)WS_END); return; }
  P p{};
  const float** pp = (const float**)&p;
  for (int i = 0; i < 36; ++i) pp[i] = (const float*)d_in[i];
  p.out = (float*)d_out; p.ws = (char*)d_ws;
  hipMemsetAsync(d_ws, 0, WS_WIN, stream);
#if MEGA
  static int grid_blocks = 0;
  if (!grid_blocks) {
    int dev = 0, cus = 0, per_cu = 0; hipGetDevice(&dev);
    hipDeviceGetAttribute(&cus, hipDeviceAttributeMultiprocessorCount, dev);
    hipFuncSetAttribute((const void*)mega_kernel, hipFuncAttributeMaxDynamicSharedMemorySize, SMEM_BYTES);
    hipOccupancyMaxActiveBlocksPerMultiprocessor(&per_cu, mega_kernel, NTP, SMEM_BYTES);
    if (per_cu > 1) per_cu = 1;
    grid_blocks = cus * per_cu;
  }
  void* args[] = {&p};
  hipError_t e = hipLaunchCooperativeKernel((void*)mega_kernel, dim3(grid_blocks), dim3(NTP), args, SMEM_BYTES, stream);
  if (e != hipSuccess) fprintf(stderr, "cooperative launch failed: %s (grid %d)\n", hipGetErrorString(e), grid_blocks);
#else
  const int G = 512;
#define LAUNCH(PH, L) do { hipFuncSetAttribute((const void*)phase_kernel<PH>, hipFuncAttributeMaxDynamicSharedMemorySize, SMEM_BYTES); phase_kernel<PH><<<G, NT, SMEM_BYTES, stream>>>(p, L); } while (0)
  LAUNCH(0, 0); LAUNCH(1, 0);
  for (int l = 0; l < 2; ++l) { LAUNCH(2, l); LAUNCH(4, l); LAUNCH(5, l); LAUNCH(6, l); LAUNCH(7, l); LAUNCH(8, l); LAUNCH(9, l); LAUNCH(11, l); LAUNCH(12, l); }
#endif
}
```

```cpp
#include <hip/hip_runtime.h>
#include <hip/hip_cooperative_groups.h>
#include <cstdio>
namespace cg = cooperative_groups;

#ifndef MEGA
#define MEGA 1
#endif
#define PROBE_MASK 0
#define GEMM_F32_KU 1
#define FFN_UP_KU 1

typedef unsigned short bf16_t;
typedef short bf16x8 __attribute__((ext_vector_type(8)));
typedef short bf16x4 __attribute__((ext_vector_type(4)));
typedef float f32x4 __attribute__((ext_vector_type(4)));
typedef float f32x2 __attribute__((ext_vector_type(2)));
typedef unsigned u32x4 __attribute__((ext_vector_type(4)));
typedef unsigned u32x2 __attribute__((ext_vector_type(2)));
#define DI __device__ __forceinline__
#define MFMA16(a, b, c) __builtin_amdgcn_mfma_f32_16x16x32_bf16((a), (b), (c), 0, 0, 0)

constexpr int NT = 256;
constexpr int NTP = 512;
constexpr int VSMEM = 65536;
constexpr int D = 1024, MC = 8192, ML = 4096, MT = 12288;
constexpr int NZR = 1792, NZN = 1536, NZT = 2048, INC = 8448, FF = 2816;
constexpr int LDH = 1088, LDO = 576, LZT = 2112, LDG = 136;
constexpr int LDT = 72;
constexpr int SMEM_BYTES = 139264;
constexpr int SMEM_BYTES_GEMM_ = 131072;
constexpr size_t O_K = 12582912, O_V = 20971520, O_RW = 29360128, O_RT = 33554432;
constexpr size_t WS_CTRL = 0;
constexpr size_t WS_MOD = 4096;
constexpr size_t WS_BAR = 262144;
constexpr size_t WS_CUF = 278528;
constexpr size_t WS_WG = 294912;
constexpr size_t WS_WIN = 434176;
constexpr size_t WS_WUP = WS_WIN;
constexpr size_t WS_WDN = WS_WIN + (size_t)5632 * LDH * 2;
constexpr size_t WS_WO3 = WS_WIN + (size_t)INC * LDH * 2;
constexpr size_t WS_WOUT = WS_WO3 + (size_t)3 * 1024 * LDO * 2;
constexpr size_t WS_H = WS_WOUT + (size_t)1024 * LDH * 2;
constexpr size_t WS_Z = WS_H + (size_t)MT * LDH * 2;
constexpr size_t WS_ZR = WS_Z;
constexpr size_t WS_ZN = WS_ZR + (size_t)MT * NZR * 2;
constexpr size_t WS_ZT = WS_ZN + (size_t)MT * NZN * 2;
constexpr size_t WS_MERGED = WS_ZR;
constexpr size_t WS_OA = WS_ZN;
constexpr size_t WS_U = WS_ZT;
constexpr size_t WS_HID = WS_Z;
constexpr size_t WS_F = WS_ZT;
constexpr size_t WS_Y = WS_ZT + (size_t)MT * LZT * 2;
constexpr size_t WS_ONA = WS_Y + (size_t)2 * MT * 512 * 4;
constexpr size_t WS_ORET = WS_ONA + (size_t)MT * LDO * 2;
constexpr size_t WS_END = WS_ORET + (size_t)MT * LDO * 2;

struct P {
  const float *x_prompt, *x_sample, *cache_k, *cache_v, *state_rwkv, *state_ret, *c, *c_ctx, *ada_w, *ada_b;
  const float *norm_mix_pre, *norm_mix_post, *norm_ffn_pre, *norm_ffn_post, *w_in, *rwkv_conv, *rwkv_w0, *rwkv_w_up, *rwkv_a0, *rwkv_a_up, *rwkv_g_up;
  const float *rwkv_k_k, *rwkv_k_a, *rwkv_r_k, *rwkv_ln_g, *rwkv_ln_b, *na_rpb, *ret_decay, *ret_gn, *w_o_rwkv, *w_o_na, *w_o_ret, *w_out, *ffn_up, *ffn_conv, *ffn_down;
  float* out; char* ws;
};

DI int threadIdx_x_raw() { return (int)__builtin_amdgcn_workitem_id_x(); }
DI int ptid() { int t = threadIdx_x_raw(); asm volatile("" : "+v"(t)); return t; }
DI int tidx() { return ptid() & 255; }
DI int vhalf() { return ptid() >> 8; }
DI int vblk() { return (int)blockIdx.x * 2 + vhalf(); }
DI int vgrid() { return (int)gridDim.x * 2; }
DI unsigned cvt_pk_bf16(float lo, float hi) { unsigned r; asm("v_cvt_pk_bf16_f32 %0, %1, %2" : "=v"(r) : "v"(lo), "v"(hi)); return r; }
DI bf16_t f2bf(float x) { return (bf16_t)(cvt_pk_bf16(x, 0.f) & 0xffffu); }
DI float bf2f(bf16_t b) { return __uint_as_float(((unsigned)b) << 16); }
DI unsigned pack2(float a, float b) { return cvt_pk_bf16(a, b); }
DI float bflo(unsigned u) { return __uint_as_float(u << 16); }
DI float bfhi(unsigned u) { return __uint_as_float(u & 0xffff0000u); }
DI void unpack8(const u32x4 r, float (&f)[8]) { f[0] = bflo(r[0]); f[1] = bfhi(r[0]); f[2] = bflo(r[1]); f[3] = bfhi(r[1]); f[4] = bflo(r[2]); f[5] = bfhi(r[2]); f[6] = bflo(r[3]); f[7] = bfhi(r[3]); }
DI u32x4 pack8(const float (&f)[8]) { u32x4 r; r[0] = pack2(f[0], f[1]); r[1] = pack2(f[2], f[3]); r[2] = pack2(f[4], f[5]); r[3] = pack2(f[6], f[7]); return r; }
DI float sigmoidf_(float x) { return __builtin_amdgcn_rcpf(1.f + __expf(-x)); }
DI float shfl_x(float v, int m) { const int lane = ptid() & 63; return __int_as_float(__builtin_amdgcn_ds_bpermute((lane ^ m) << 2, __float_as_int(v))); }
DI float wave_sum(float v) { for (int o = 32; o > 0; o >>= 1) v += shfl_x(v, o); return v; }
DI void tokinfo(int m, int& t, int& T, int& mi) { if (m < MC) { t = m & 255; T = 256; mi = 0; } else { int q = m - MC; t = q & 1023; T = 1024; mi = 1 + (q >> 10); } }

#define XB_TMO      128
#define XB_XCNT(j)  (256  + 64 * (j))
#define XB_XSUB(j)  (1280 + 64 * (j))
#define XB_XGEN(j)  (2304 + 64 * (j))
#define XB_TOP      3328
#define XB_TOPGEN   3392
#define XB_SPIN_CAP (1u << 20)
#define LAS __attribute__((address_space(3)))
DI unsigned xb_ld(unsigned* p) { return __hip_atomic_load(p, __ATOMIC_RELAXED, __HIP_MEMORY_SCOPE_AGENT); }
DI unsigned xb_add(unsigned* p, unsigned v) { return __hip_atomic_fetch_add(p, v, __ATOMIC_RELAXED, __HIP_MEMORY_SCOPE_AGENT); }
DI unsigned xb_xcc_id() { return (unsigned)__builtin_amdgcn_s_getreg((3 << 11) | 20) & 0xFu; }
#define XB_SPIN(cond, bar) do { unsigned _sp = 0; while (cond) { __builtin_amdgcn_s_sleep(1); \
    if ((++_sp & 255u) == 0u) { if (xb_ld(&(bar)[XB_TMO])) break; if (_sp > XB_SPIN_CAP) { atomicAdd(&(bar)[XB_TMO], 1u); break; } } } } while (0)
struct XcdBarrier { unsigned* bar; unsigned x; volatile LAS unsigned* st; };
DI XcdBarrier xcd_barrier_post(unsigned* bar, volatile LAS unsigned* st) {
  XcdBarrier b; b.bar = bar; b.x = xb_xcc_id(); b.st = st;
  if (ptid() == 0) (void)xb_add(&bar[XB_XCNT(b.x)], 1u);
  return b;
}
DI void xcd_barrier_complete(unsigned* bar, unsigned x, unsigned& nloc, unsigned& nx) {
  const unsigned G = gridDim.x * gridDim.y * gridDim.z;
  unsigned sum, cnt, mine, sp = 0u;
  for (;;) {
    sum = 0u; cnt = 0u; mine = 0u;
#pragma unroll
    for (unsigned j = 0; j < 16; ++j) { const unsigned c = xb_ld(&bar[XB_XCNT(j)]); sum += c; cnt += (c > 0u) ? 1u : 0u; mine = (j == x) ? c : mine; }
    if (sum == G) break;
    __builtin_amdgcn_s_sleep(1);
    if ((++sp & 255u) == 0u) { if (xb_ld(&bar[XB_TMO])) break; if (sp > XB_SPIN_CAP) { atomicAdd(&bar[XB_TMO], 1u); break; } }
  }
  nloc = mine > 0u ? mine : 1u; nx = cnt > 0u ? cnt : 1u;
}
DI void xcd_barrier(const XcdBarrier& b) {
  asm volatile("s_waitcnt vmcnt(0)" ::: "memory");
  __syncthreads();
  if (ptid() == 0) {
    unsigned* bar = b.bar;
    __builtin_amdgcn_s_waitcnt(0);
    unsigned nloc = b.st[0], nx = b.st[1];
    if (nloc == 0u) { xcd_barrier_complete(bar, b.x, nloc, nx); b.st[0] = nloc; b.st[1] = nx; }
    const unsigned old = xb_add(&bar[XB_XSUB(b.x)], 1u);
    const unsigned gen = old / nloc;
    if (old + 1u == (gen + 1u) * nloc) {
      __builtin_amdgcn_fence(__ATOMIC_RELEASE, "agent");
      asm volatile("s_waitcnt vmcnt(0)" ::: "memory");
      const unsigned og = xb_add(&bar[XB_TOP], 1u);
      const unsigned tg = og / nx;
      if (og + 1u == (tg + 1u) * nx) xb_add(&bar[XB_TOPGEN], 1u);
      else XB_SPIN(xb_ld(&bar[XB_TOPGEN]) == tg, bar);
      __builtin_amdgcn_fence(__ATOMIC_ACQUIRE, "agent");
      xb_add(&bar[XB_XGEN(b.x)], 1u);
      asm volatile("s_waitcnt vmcnt(0)" ::: "memory");
    } else {
      XB_SPIN(xb_ld(&bar[XB_XGEN(b.x)]) == gen, bar);
      __builtin_amdgcn_fence(__ATOMIC_ACQUIRE, "agent");
      asm volatile("s_waitcnt vmcnt(0)" ::: "memory");
    }
  }
  __syncthreads();
}

__device__ void convert_T(const float* __restrict__ W, int K, int N, bf16_t* __restrict__ Wt, int ldt, char* smem) {
  float* t = (float*)(smem + vhalf() * VSMEM);
  const int tid = tidx(), ntn = N >> 6, nitems = (K >> 6) * ntn;
  const int kr = tid >> 4, c4 = (tid & 15) * 4;
  f32x4 v[4];
  { const int it = vblk() < nitems ? vblk() : 0; const int k0 = (it / ntn) << 6, n0 = (it % ntn) << 6;
#pragma unroll
    for (int i = 0; i < 4; ++i) v[i] = *(const f32x4*)(W + (size_t)(k0 + kr + 16 * i) * N + n0 + c4); }
  for (int it = vblk(); it < nitems; it += vgrid()) {
    const int k0 = (it / ntn) << 6, n0 = (it % ntn) << 6;
    __syncthreads();
#pragma unroll
    for (int i = 0; i < 4; ++i) { const int k = kr + 16 * i; t[k * 65 + c4] = v[i][0]; t[k * 65 + c4 + 1] = v[i][1]; t[k * 65 + c4 + 2] = v[i][2]; t[k * 65 + c4 + 3] = v[i][3]; }
    __syncthreads();
    { const int itn = it + vgrid() < nitems ? it + vgrid() : it; const int k1 = (itn / ntn) << 6, n1 = (itn % ntn) << 6;
#pragma unroll
      for (int i = 0; i < 4; ++i) v[i] = *(const f32x4*)(W + (size_t)(k1 + kr + 16 * i) * N + n1 + c4); }
#pragma unroll
    for (int i = 0; i < 2; ++i) { const int c = tid + 256 * i, n = c >> 3, kc = c & 7; float f[8];
#pragma unroll
      for (int e = 0; e < 8; ++e) f[e] = t[(kc * 8 + e) * 65 + n];
      *(u32x4*)(Wt + (size_t)(n0 + n) * ldt + k0 + kc * 8) = pack8(f); }
  }
}

__device__ void ada_phase(const P& p, char* smem) {
  float* sc = (float*)(smem + vhalf() * VSMEM);
  float* red = sc + 640;
  float* mod = (float*)(p.ws + WS_MOD);
  const int tid = tidx(), kq = tid >> 5, cq = tid & 31;
  for (int it = vblk(); it < 2 * 48 * 8; it += vgrid()) {
    const int l = it / 384, rem = it % 384, nb = rem >> 3, ks = rem & 7;
    const int n0 = nb * 128, k0 = ks * 128;
    __syncthreads();
    for (int e = tid; e < 640; e += NT) { const int i = e >> 7, k = e & 127; const float v = (i == 0) ? p.c_ctx[k0 + k] : p.c[(i - 1) * D + k0 + k]; sc[e] = v * sigmoidf_(v); }
    __syncthreads();
    float acc[5][4];
#pragma unroll
    for (int i = 0; i < 5; ++i)
#pragma unroll
      for (int j = 0; j < 4; ++j) acc[i][j] = 0.f;
    const float* wp = p.ada_w + ((size_t)l * D + k0 + kq * 16) * 6144 + n0 + cq * 4;
#pragma unroll 4
    for (int kk = 0; kk < 16; ++kk) { const float4 w = *(const float4*)(wp + (size_t)kk * 6144);
#pragma unroll
      for (int i = 0; i < 5; ++i) { const float s = sc[i * 128 + kq * 16 + kk]; acc[i][0] += s * w.x; acc[i][1] += s * w.y; acc[i][2] += s * w.z; acc[i][3] += s * w.w; } }
#pragma unroll
    for (int i = 0; i < 5; ++i)
#pragma unroll
      for (int j = 0; j < 4; ++j) red[(kq * 5 + i) * 128 + cq * 4 + j] = acc[i][j];
    __syncthreads();
    for (int e = tid; e < 640; e += NT) { const int i = e >> 7, n = e & 127; float s = 0.f;
#pragma unroll
      for (int q = 0; q < 8; ++q) s += red[(q * 5 + i) * 128 + n];
      if (ks == 0) s += p.ada_b[l * 6144 + n0 + n];
      atomicAdd(mod + ((size_t)l * 5 + i) * 6144 + n0 + n, s); }
  }
}

__device__ void norm_phase(const P& p, const float* xin  , const float* u, const float* gpost, const float* modU, int gate_idx,
                           float* xout, const float* gpre, const float* modN, int shift_idx, bf16_t* hout) {
  const int lane = tidx() & 63, wave = tidx() >> 6, nw = NT / 64;
  for (int m = vblk() * nw + wave; m < MT; m += vgrid() * nw) {
    int t, T, mi; tokinfo(m, t, T, mi);
    const float* xr = xin ? xin + (size_t)m * D : (m < MC ? p.x_prompt + (size_t)m * D : p.x_sample + (size_t)(m - MC) * D);
    float4 x[4];
#pragma unroll
    for (int i = 0; i < 4; ++i) x[i] = *(const float4*)(xr + i * 256 + lane * 4);
    if (u) {
      float4 uu[4]; float ss = 0.f;
#pragma unroll
      for (int i = 0; i < 4; ++i) { uu[i] = *(const float4*)(u + (size_t)m * D + i * 256 + lane * 4); ss += uu[i].x * uu[i].x + uu[i].y * uu[i].y + uu[i].z * uu[i].z + uu[i].w * uu[i].w; }
      ss = wave_sum(ss); const float rs = rsqrtf(ss * (1.f / D) + 1e-6f);
#pragma unroll
      for (int i = 0; i < 4; ++i) { const int c = i * 256 + lane * 4; const float4 g = *(const float4*)(gpost + c); const float4 ga = *(const float4*)(modU + ((size_t)mi * 6 + gate_idx) * D + c);
        x[i].x += ga.x * uu[i].x * rs * g.x; x[i].y += ga.y * uu[i].y * rs * g.y; x[i].z += ga.z * uu[i].z * rs * g.z; x[i].w += ga.w * uu[i].w * rs * g.w; }
    }
    if (xout) {
#pragma unroll
      for (int i = 0; i < 4; ++i) *(float4*)(xout + (size_t)m * D + i * 256 + lane * 4) = x[i];
    }
    if (hout) {
      float ss = 0.f;
#pragma unroll
      for (int i = 0; i < 4; ++i) ss += x[i].x * x[i].x + x[i].y * x[i].y + x[i].z * x[i].z + x[i].w * x[i].w;
      ss = wave_sum(ss); const float rs = rsqrtf(ss * (1.f / D) + 1e-6f);
#pragma unroll
      for (int i = 0; i < 4; ++i) { const int c = i * 256 + lane * 4; const float4 g = *(const float4*)(gpre + c);
        const float4 sh = *(const float4*)(modN + ((size_t)mi * 6 + shift_idx) * D + c); const float4 sc = *(const float4*)(modN + ((size_t)mi * 6 + shift_idx + 1) * D + c);
        u32x2 o; o.x = pack2(x[i].x * rs * g.x * (1.f + sc.x) + sh.x, x[i].y * rs * g.y * (1.f + sc.y) + sh.y); o.y = pack2(x[i].z * rs * g.z * (1.f + sc.z) + sh.z, x[i].w * rs * g.w * (1.f + sc.w) + sh.w);
        *(u32x2*)(hout + (size_t)m * LDH + c) = o; }
    }
  }
}

struct TileSrc { const bf16_t* A; int lda; int arow0; const bf16_t* B; int ldb; int brow0, brow1; int K; };

template <int MM, int NN> DI void zero_acc(f32x4 (&acc)[MM][NN]) {
#pragma unroll
  for (int m = 0; m < MM; ++m)
#pragma unroll
    for (int n = 0; n < NN; ++n) acc[m][n] = (f32x4){0.f, 0.f, 0.f, 0.f};
}

template <int MM, int NN, int KU = 0> struct Gemm {
  static constexpr int NA = MM / 2, NB = NN;
  unsigned oa_[NA], ob_[NB]; const bf16_t* A; const bf16_t* B; int nk; u32x4 ra[NA], rb[NB];
#define GT_LOAD(KT) do { const int kn_ = ((KT) < nk ? (KT) : nk - 1) * 64; \
    _Pragma("unroll") for (int i = 0; i < NA; ++i) ra[i] = *(const u32x4*)(A + (oa_[i] + kn_)); \
    _Pragma("unroll") for (int i = 0; i < NB; ++i) rb[i] = *(const u32x4*)(B + (ob_[i] + kn_)); } while (0)
  DI void begin(const TileSrc& s, const bool perm = false) {
    const int tid = ptid();
#pragma unroll
    for (int i = 0; i < NA; ++i) { const int row = (tid >> 3) + 64 * i, kc = tid & 7;
      int ar = s.arow0 + row; ar = ar < 0 ? 0 : (ar > MT - 1 ? MT - 1 : ar);
      oa_[i] = (unsigned)ar * (unsigned)s.lda + kc * 8; }
#pragma unroll
    for (int i = 0; i < NB; ++i) { const int row = (tid >> 3) + 64 * i, kc = tid & 7;
      const int rr = perm ? ((row & ~31) | (8 * ((row & 15) >> 2) + 4 * ((row >> 4) & 1) + (row & 3))) : row;
      const int br = rr < 32 * NN ? s.brow0 + rr : s.brow1 + rr - 32 * NN;
      ob_[i] = (unsigned)br * (unsigned)s.ldb + kc * 8; }
    A = s.A; B = s.B; nk = s.K >> 6;
    GT_LOAD(0);
  }
  DI void run(f32x4 (&acc)[MM][NN], char* smem) {
    bf16_t* sbase = (bf16_t*)smem;
    const int tid = ptid(), lane = tid & 63, wave = tid >> 6, wr = wave >> 2, wc = wave & 3, fr = lane & 15, fq = lane >> 4;
    int wofs; { const int r = tid >> 3, kc = tid & 7, ob = (r & 15) * 64 + (kc & 3) * 16; wofs = (((r >> 4) * 2 + (kc >> 2)) * 1024 + (ob ^ (((ob >> 9) & 1) << 5))) >> 1; }
    int robase; { const int ob = fr * 64 + fq * 16; robase = (ob ^ (((ob >> 9) & 1) << 5)) >> 1; }
#define GT_STORE(ST) do { bf16_t* sA_ = sbase + (ST) * 32768; bf16_t* sB_ = sA_ + 16384; \
    _Pragma("unroll") for (int i = 0; i < NA; ++i) *(u32x4*)(sA_ + wofs + i * 4096) = ra[i]; \
    _Pragma("unroll") for (int i = 0; i < NB; ++i) *(u32x4*)(sB_ + wofs + i * 4096) = rb[i]; } while (0)
#define GT_KSTEP(ks) do { bf16x8 bfr[NN]; \
      _Pragma("unroll") for (int n = 0; n < NN; ++n) bfr[n] = *(const bf16x8*)(sB_ + ((wc * NN + n) * 2 + (ks)) * 512); \
      _Pragma("unroll") for (int m = 0; m < MM; ++m) { const bf16x8 af = *(const bf16x8*)(sA_ + ((wr * MM + m) * 2 + (ks)) * 512); \
        _Pragma("unroll") for (int n = 0; n < NN; ++n) acc[m][n] = MFMA16(bfr[n], af, acc[m][n]); } } while (0)
#define GT_COMPUTE(ST) do { const bf16_t* sA_ = sbase + (ST) * 32768 + robase; const bf16_t* sB_ = sA_ + 16384; __builtin_amdgcn_s_setprio(1); \
    if (KU) { GT_KSTEP(0); GT_KSTEP(1); } else { _Pragma("unroll 1") for (int ks = 0; ks < 2; ++ks) GT_KSTEP(ks); } \
    __builtin_amdgcn_s_setprio(0); } while (0)
    __syncthreads();
    GT_STORE(0);
    GT_LOAD(1);
    __syncthreads();
#pragma unroll 1
    for (int kt = 0; kt < nk; kt += 2) {
      GT_STORE(1); GT_LOAD(kt + 2); GT_COMPUTE(0); __syncthreads();
      GT_STORE(0); GT_LOAD(kt + 3); GT_COMPUTE(1); __syncthreads();
    }
  }
#undef GT_LOAD
#undef GT_STORE
#undef GT_COMPUTE
#undef GT_KSTEP
};
template <int MM, int NN> DI void gemm_tile(f32x4 (&acc)[MM][NN], const TileSrc& s, char* smem) { Gemm<MM, NN> g; g.begin(s); g.run(acc, smem); }

DI float gelu_tanh(float x) { const float u = 0.7978845608f * (x + 0.044715f * x * x * x); const float e = __expf(2.f * u); const float th = 1.f - 2.f * __builtin_amdgcn_rcpf(e + 1.f); return 0.5f * x * (1.f + th); }

struct TileIter {
  int m_lo, rows, NTn, G, efull, count, e, stride;
  DI void init(int MTn, int NTn_) { const int x = blockIdx.x & 7; m_lo = (x * MTn) >> 3; rows = (((x + 1) * MTn) >> 3) - m_lo; NTn = NTn_; G = (rows + 1) >> 1;
    efull = (rows / G) * G * NTn; count = rows * NTn; e = blockIdx.x >> 3; stride = gridDim.x >> 3; }
  DI bool next(int& mt, int& nt) { if (e >= count) return false;
    if (e < efull) { const int grp = e / (G * NTn), rem = e - grp * G * NTn; nt = rem / G; mt = m_lo + grp * G + (rem - nt * G); }
    else { const int rem = e - efull, gsz = rows - (rows / G) * G; nt = rem / gsz; mt = m_lo + (rows / G) * G + (rem - nt * gsz); }
    e += stride; return true; }
};

__device__ void phase_win(const P& p, int l, char* smem) {
  const bf16_t* H = (const bf16_t*)(p.ws + WS_H); const bf16_t* Wt = (const bf16_t*)(p.ws + WS_WIN);
  bf16_t* zr = (bf16_t*)(p.ws + WS_ZR); bf16_t* zn = (bf16_t*)(p.ws + WS_ZN); bf16_t* zt = (bf16_t*)(p.ws + WS_ZT);
  const int tid = ptid(), lane = tid & 63, wave = tid >> 6, wr = wave >> 2, wc = wave & 3, fr = lane & 15, fq = lane >> 4;
  Gemm<8, 4> gm;
  TileIter ti; ti.init(48, 14);
  const int x = blockIdx.x & 7, nconv = (343 - x + 7) >> 3, nloc = ti.count + nconv;
  const float* cw = p.rwkv_conv + (size_t)l * 3 * NZR;
  for (int e = (int)(blockIdx.x >> 3); e < nloc; e += (int)(gridDim.x >> 3)) {
    f32x4 acc[8][4]; zero_acc<8, 4>(acc);
    if (e < nconv) {
      const int c = x + 8 * e, mt = c / 7, nt = c - mt * 7;
      const int n0 = nt * 256, arow0 = mt * 254 - 1;
      { TileSrc s{H, LDH, arow0, Wt, LDH, n0, n0 + 128, D}; gm.begin(s); }
      gm.run(acc, smem);
      float* sC = (float*)smem;
#pragma unroll 1
      for (int sl = 0; sl < 2; ++sl) {
        __syncthreads();
        if ((wc >> 1) == sl) {
#pragma unroll
          for (int m = 0; m < 8; ++m)
#pragma unroll
            for (int n = 0; n < 4; ++n) *(f32x4*)(sC + (wr * 128 + m * 16 + fr) * 132 + (wc & 1) * 64 + n * 16 + fq * 4) = acc[m][n];
        }
        __syncthreads();
        const int nb = n0 + sl * 128, c8 = (tid & 15) * 8;
        const f32x4 w0a = *(const f32x4*)(cw + nb + c8), w0b = *(const f32x4*)(cw + nb + c8 + 4), w1a = *(const f32x4*)(cw + NZR + nb + c8), w1b = *(const f32x4*)(cw + NZR + nb + c8 + 4),
                    w2a = *(const f32x4*)(cw + 2 * NZR + nb + c8), w2b = *(const f32x4*)(cw + 2 * NZR + nb + c8 + 4);
        const bool sg = nb + c8 >= 1664;
        for (int ee = tid; ee < 254 * 16; ee += NTP) {
          const int tr = 1 + (ee >> 4), g = arow0 + tr;
          if (g < MT) { int t, T, mi; tokinfo(g, t, T, mi);
            const float pm = t > 0 ? 1.f : 0.f, nm = t < T - 1 ? 1.f : 0.f;
            const float* r0 = sC + (tr - 1) * 132 + c8; const float* r1 = r0 + 132; const float* r2 = r1 + 132;
            f32x4 ya = (*(const f32x4*)r0 * w0a) * pm + *(const f32x4*)r1 * w1a + (*(const f32x4*)r2 * w2a) * nm;
            f32x4 yb = (*(const f32x4*)(r0 + 4) * w0b) * pm + *(const f32x4*)(r1 + 4) * w1b + (*(const f32x4*)(r2 + 4) * w2b) * nm;
            if (sg) {
#pragma unroll
              for (int j = 0; j < 4; ++j) { ya[j] = sigmoidf_(ya[j]); yb[j] = sigmoidf_(yb[j]); } }
            const u32x4 o = {pack2(ya[0], ya[1]), pack2(ya[2], ya[3]), pack2(yb[0], yb[1]), pack2(yb[2], yb[3])};
            *(u32x4*)(zr + (size_t)g * NZR + nb + c8) = o; }
        }
      }
    } else {
      int mt, nt; ti.e = e - nconv; ti.next(mt, nt);
      const int n0 = nt * 256, row0 = mt * 256;
      { TileSrc s{H, LDH, row0, Wt, LDH, NZR + n0, NZR + n0 + 128, D}; gm.begin(s, true); }
      gm.run(acc, smem);
#pragma unroll
      for (int m = 0; m < 8; ++m) { const int row = row0 + wr * 128 + m * 16 + fr;
#pragma unroll
        for (int g = 0; g < 2; ++g) { const int col = n0 + wc * 64 + g * 32 + fq * 8; const f32x4 v0 = acc[m][2 * g], v1 = acc[m][2 * g + 1];
          const u32x4 o = {pack2(v0[0], v0[1]), pack2(v0[2], v0[3]), pack2(v1[0], v1[1]), pack2(v1[2], v1[3])};
          if (col < NZN) {
            *(u32x4*)(zn + (size_t)row * NZN + col) = o;
            if (row < MC && col >= 512) { const int part = col - 512, isv = part >> 9, pp = part & 511, hh = pp >> 6, d = pp & 63, b = row >> 8, t = row & 255;
              float* dst = p.out + (isv ? O_V : O_K) + ((((size_t)b * 2 + l) * 8 + hh) * 256 + t) * 64 + d; *(f32x4*)dst = v0; *(f32x4*)(dst + 4) = v1; }
          } else { *(u32x4*)(zt + (size_t)row * LZT + (col - NZN)) = o; }
        } }
    }
  }
}

__device__ void phase_merge(const P& p, char* smem) {
  const bf16_t* H = (const bf16_t*)(p.ws + WS_H); const bf16_t* Wt = (const bf16_t*)(p.ws + WS_WIN); const bf16_t* Wo3 = (const bf16_t*)(p.ws + WS_WO3);
  bf16_t* mg = (bf16_t*)(p.ws + WS_MERGED);
  const int tid = ptid(), lane = tid & 63, wave = tid >> 6, wr = wave >> 2, wc = wave & 3, fr = lane & 15, fq = lane >> 4;
  TileIter ti; int mt, nt; ti.init(64, 8);
  while (ti.next(mt, nt)) {
    const int n0 = nt * 128, row0 = mt * 192;
    f32x4 macc[6][2]; zero_acc<6, 2>(macc);
#pragma unroll 1
    for (int i = 0; i < 3; ++i) {
      const bf16_t* O = (const bf16_t*)(p.ws + (i == 0 ? WS_OA : (i == 1 ? WS_ONA : WS_ORET)));
      f32x4 g[6][2]; zero_acc<6, 2>(g);
      { TileSrc s{H, LDH, row0, Wt, LDH, 5376 + i * 1024 + n0, 5376 + i * 1024 + n0 + 64, D}; { Gemm<6, 2, 1> gm; gm.begin(s, true); gm.run(g, smem); } }
      f32x4 a2[6][2]; zero_acc<6, 2>(a2);
      { TileSrc s{O, LDO, row0, Wo3 + (size_t)i * 1024 * LDO, LDO, n0, n0 + 64, 512}; { Gemm<6, 2, 1> gm; gm.begin(s, true); gm.run(a2, smem); } }
#pragma unroll
      for (int m = 0; m < 6; ++m)
#pragma unroll
        for (int n = 0; n < 2; ++n)
#pragma unroll
          for (int j = 0; j < 4; ++j) macc[m][n][j] += sigmoidf_(g[m][n][j]) * a2[m][n][j];
    }
#pragma unroll
    for (int m = 0; m < 6; ++m) { const int row = row0 + wr * 96 + m * 16 + fr;
      { const int col = n0 + wc * 32 + fq * 8; const u32x4 o = {pack2(macc[m][0][0], macc[m][0][1]), pack2(macc[m][0][2], macc[m][0][3]), pack2(macc[m][1][0], macc[m][1][1]), pack2(macc[m][1][2], macc[m][1][3])}; *(u32x4*)(mg + (size_t)row * LDH + col) = o; } }
  }
}

__device__ void phase_gemm_f32(const bf16_t* A, int lda, int K, const bf16_t* Bt, int ldb, float* C, char* smem) {
  const int tid = ptid(), lane = tid & 63, wave = tid >> 6, wr = wave >> 2, wc = wave & 3, fr = lane & 15, fq = lane >> 4;
  TileIter ti; int mt, nt; ti.init(64, 4);
  while (ti.next(mt, nt)) {
    const int n0 = nt * 256, row0 = mt * 192;
    f32x4 acc[6][4]; zero_acc<6, 4>(acc);
    TileSrc s{A, lda, row0, Bt, ldb, n0, n0 + 128, K}; { Gemm<6, 4, GEMM_F32_KU> gm; gm.begin(s, true); gm.run(acc, smem); }
#pragma unroll
    for (int m = 0; m < 6; ++m) { const int row = row0 + wr * 96 + m * 16 + fr;
#pragma unroll
      for (int g = 0; g < 2; ++g) { float* dst = C + (size_t)row * D + n0 + wc * 64 + g * 32 + fq * 8; *(f32x4*)dst = acc[m][2 * g]; *(f32x4*)(dst + 4) = acc[m][2 * g + 1]; } }
  }
}

__device__ void phase_ffn_up(const P& p, int l, char* smem) {
  const bf16_t* H = (const bf16_t*)(p.ws + WS_H); const bf16_t* Wt = (const bf16_t*)(p.ws + WS_WUP); bf16_t* hid = (bf16_t*)(p.ws + WS_HID);
  const int tid = ptid(), lane = tid & 63, wave = tid >> 6, wr = wave >> 2, wc = wave & 3, fr = lane & 15, fq = lane >> 4;
  const float* cw = p.ffn_conv + (size_t)l * 3 * 2 * FF;
  Gemm<6, 4, FFN_UP_KU> gm;
  for (int it = blockIdx.x; it < 65 * 22; it += gridDim.x) {
    const int mt = it / 22, nt = it - mt * 22;
    const int c0 = nt * 128, arow0 = mt * 190 - 1;
    f32x4 acc[6][4]; zero_acc<6, 4>(acc);
    { TileSrc s{H, LDH, arow0, Wt, LDH, c0, FF + c0, D}; gm.begin(s); }
    gm.run(acc, smem);
    float* sC = (float*)smem;
#pragma unroll 1
    for (int sl = 0; sl < 2; ++sl) {
      __syncthreads();
      if ((wc & 1) == sl) { const int cb = (wc >> 1) * 64;
#pragma unroll
        for (int m = 0; m < 6; ++m)
#pragma unroll
          for (int n = 0; n < 4; ++n) *(f32x4*)(sC + (wr * 96 + m * 16 + fr) * 132 + cb + n * 16 + fq * 4) = acc[m][n];
      }
      __syncthreads();
      const int cq = c0 + sl * 64, c4 = (tid & 15) * 4;
      const f32x4 v0 = *(const f32x4*)(cw + cq + c4), v1 = *(const f32x4*)(cw + 2 * FF + cq + c4), v2 = *(const f32x4*)(cw + 4 * FF + cq + c4);
      const f32x4 g0 = *(const f32x4*)(cw + FF + cq + c4), g1 = *(const f32x4*)(cw + 3 * FF + cq + c4), g2 = *(const f32x4*)(cw + 5 * FF + cq + c4);
      for (int e = tid; e < 190 * 16; e += NTP) {
        const int tr = 1 + (e >> 4), g = arow0 + tr;
        if (g < MT) { int t, T, mi; tokinfo(g, t, T, mi);
          const float pm = t > 0 ? 1.f : 0.f, nm = t < T - 1 ? 1.f : 0.f;
          const f32x4 va = *(const f32x4*)(sC + (tr - 1) * 132 + c4), vb = *(const f32x4*)(sC + tr * 132 + c4), vc = *(const f32x4*)(sC + (tr + 1) * 132 + c4);
          const f32x4 ga = *(const f32x4*)(sC + (tr - 1) * 132 + 64 + c4), gb = *(const f32x4*)(sC + tr * 132 + 64 + c4), gc = *(const f32x4*)(sC + (tr + 1) * 132 + 64 + c4);
          float r[4];
#pragma unroll
          for (int j = 0; j < 4; ++j) { const float val = pm * va[j] * v0[j] + vb[j] * v1[j] + nm * vc[j] * v2[j]; const float gt = pm * ga[j] * g0[j] + gb[j] * g1[j] + nm * gc[j] * g2[j]; r[j] = gelu_tanh(gt) * val; }
          u32x2 o; o.x = pack2(r[0], r[1]); o.y = pack2(r[2], r[3]);
          *(u32x2*)(hid + (size_t)g * FF + cq + c4) = o; }
      }
    }
  }
}

template <int CTRL> DI float dppf(float v) { return __int_as_float(__builtin_amdgcn_mov_dpp(__float_as_int(v), CTRL, 0xF, 0xF, true)); }
DI float row16_sum(float v) { v += dppf<0xB1>(v); v += dppf<0x4E>(v); v += dppf<0x141>(v); v += dppf<0x140>(v); return v; }

DI float frcp(float x) { return __builtin_amdgcn_rcpf(x); }
DI float fsig(float x) { return frcp(1.f + __expf(-x)); }
__device__ void scan_task(const P& p, int l, int seq, int h, int d, int half, char* smem) {
  float* sR = (float*)smem; float* sW = sR + 1024; float* sKD = sW + 1024; float* sB = sKD + 1024; float* sNK = sB + 1024; float* sV = sNK + 1024; float* sK = sV + 1024; float* sY = sK + 1024;
  float* sKn = sY + 2048; float* sKK = sKn + 16; bf16_t* sWT = (bf16_t*)(sKK + 64); bf16_t* sAL = sWT + 16 * LDT;
  const int tid = tidx(), lane = tid & 63, wave = tid >> 6, fr = lane & 15, fq = lane >> 4;
  const int row0 = seq < 32 ? seq * 256 : MC + (seq - 32) * 1024, T = seq < 32 ? 256 : 1024, nch = T >> 4;
  const bf16_t* zr = (const bf16_t*)(p.ws + WS_ZR);
  float* yout = (float*)(p.ws + WS_Y) + (size_t)d * MT * 512;
  __syncthreads();
  if (tid < 64) sKK[tid] = p.rwkv_k_k[l * 512 + h * 64 + tid];
  const int cc = wave * 16 + fr, gc = h * 64 + cc;
  bf16x8 bw[2], ba[2];
#pragma unroll
  for (int ks = 0; ks < 2; ++ks)
#pragma unroll
    for (int e = 0; e < 8; ++e) { const int k = ks * 32 + fq * 8 + e;
      bw[ks][e] = (short)f2bf(p.rwkv_w_up[((size_t)(l * 2 + d) * 64 + k) * 512 + gc]); ba[ks][e] = (short)f2bf(p.rwkv_a_up[((size_t)(l * 2 + d) * 64 + k) * 512 + gc]); }
  const float w0c = p.rwkv_w0[(l * 2 + d) * 512 + gc], a0c = p.rwkv_a0[(l * 2 + d) * 512 + gc], kac = p.rwkv_k_a[l * 512 + gc];
  const int rg = tid >> 4, kq = tid & 15, rbase = half * 32 + rg * 2;
  f32x2 S[2][2];
  if (seq >= 32) { const float* s0 = p.state_rwkv + (((((size_t)(seq - 32) * 2 + l) * 2 + d) * 8 + h) * 64 + rbase) * 64 + kq * 4;
#pragma unroll
    for (int r = 0; r < 2; ++r) { const f32x4 x = *(const f32x4*)(s0 + r * 64); S[r][0] = (f32x2){x[0], x[1]}; S[r][1] = (f32x2){x[2], x[3]}; } }
  else {
#pragma unroll
    for (int r = 0; r < 2; ++r) { S[r][0] = (f32x2){0.f, 0.f}; S[r][1] = (f32x2){0.f, 0.f}; } }
  if (seq >= 32) __builtin_amdgcn_s_setprio(2);
  const int at = (tid & 127) >> 3, apart = tid & 7, ahi = tid >> 7;
  size_t coff[3];
  { const int sb0 = ahi ? 512 + h * 64 : h * 64, sb1 = ahi ? 1536 : 1024 + h * 64, sb2 = 1600;
    coff[0] = (size_t)at * NZR + sb0 + apart * 8; coff[1] = (size_t)at * NZR + sb1 + apart * 8; coff[2] = (size_t)at * NZR + sb2 + apart * 8; }
  u32x4 pre[3];
  { const int t0 = (d ? nch - 1 : 0) * 16;
#pragma unroll
    for (int i = 0; i < 3; ++i) pre[i] = *(const u32x4*)(zr + (size_t)(row0 + t0) * NZR + coff[i]); }
  __syncthreads();
  for (int ci = 0; ci < nch; ++ci) {
    const int chunk = d ? nch - 1 - ci : ci, t0 = chunk * 16;
    { const int o = at * 64 + apart * 8; float f[8];
      unpack8(pre[0], f);
      if (ahi == 0) { *(f32x4*)(sR + o) = (f32x4){f[0], f[1], f[2], f[3]}; *(f32x4*)(sR + o + 4) = (f32x4){f[4], f[5], f[6], f[7]}; }
      else { *(f32x4*)(sK + o) = (f32x4){f[0], f[1], f[2], f[3]}; *(f32x4*)(sK + o + 4) = (f32x4){f[4], f[5], f[6], f[7]}; float ps = 0.f;
#pragma unroll
        for (int e = 0; e < 8; ++e) { const float kk = f[e] * sKK[apart * 8 + e]; ps += kk * kk; }
        ps += dppf<0xB1>(ps); ps += dppf<0x4E>(ps); ps += dppf<0x141>(ps);
        if (apart == 0) sKn[at] = ps; }
      unpack8(pre[1], f);
      if (ahi == 0) { *(f32x4*)(sV + o) = (f32x4){f[0], f[1], f[2], f[3]}; *(f32x4*)(sV + o + 4) = (f32x4){f[4], f[5], f[6], f[7]}; }
      else { float g[8];
#pragma unroll
        for (int e = 0; e < 8; ++e) g[e] = 1.f - 2.f * frcp(__expf(2.f * f[e]) + 1.f);
        *(u32x4*)(sWT + at * LDT + apart * 8) = pack8(g); }
      if (ahi == 0) *(u32x4*)(sAL + at * LDT + apart * 8) = pre[2];
    }
    __syncthreads();
    {
      f32x4 aw = {0.f, 0.f, 0.f, 0.f}, aa = {0.f, 0.f, 0.f, 0.f};
#pragma unroll
      for (int ks = 0; ks < 2; ++ks) { const bf16x8 fw = *(const bf16x8*)(sWT + fr * LDT + ks * 32 + fq * 8); const bf16x8 fa = *(const bf16x8*)(sAL + fr * LDT + ks * 32 + fq * 8);
        aw = MFMA16(fw, bw[ks], aw); aa = MFMA16(fa, ba[ks], aa); }
      const float kkc = sKK[cc];
#pragma unroll
      for (int j = 0; j < 4; ++j) { const int t = fq * 4 + j, o = t * 64 + cc;
        const float dec = __expf(-0.6065306597f * fsig(w0c + aw[j]));
        const float a = fsig(a0c + aa[j]);
        const float kv = sK[o];
        const float kkv = kv * kkc * __builtin_amdgcn_rsqf(fmaxf(sKn[t], 1e-24f));
        sW[o] = dec; sKD[o] = kv * (1.f + (a - 1.f) * kac); sB[o] = kkv * a; sNK[o] = -kkv; }
    }
    __syncthreads();
    { const int cn = ci + 1 < nch ? ci + 1 : ci; const int nt0 = (d ? nch - 1 - cn : cn) * 16;
#pragma unroll
      for (int i = 0; i < 3; ++i) pre[i] = *(const u32x4*)(zr + (size_t)(row0 + nt0) * NZR + coff[i]); }
#pragma unroll 8
    for (int si = 0; si < 16; ++si) {
      const int t = d ? 15 - si : si, o = t * 64 + kq * 4;
      const f32x4 an4 = *(const f32x4*)(sNK + o), w4 = *(const f32x4*)(sW + o), b4 = *(const f32x4*)(sB + o), kd4 = *(const f32x4*)(sKD + o), r4 = *(const f32x4*)(sR + o);
      const f32x2 v2 = *(const f32x2*)(sV + t * 64 + rbase);
      const f32x2 an[2] = {{an4[0], an4[1]}, {an4[2], an4[3]}}, wv[2] = {{w4[0], w4[1]}, {w4[2], w4[3]}}, bv[2] = {{b4[0], b4[1]}, {b4[2], b4[3]}}, kd[2] = {{kd4[0], kd4[1]}, {kd4[2], kd4[3]}}, rv[2] = {{r4[0], r4[1]}, {r4[2], r4[3]}};
      float sa[2];
#pragma unroll
      for (int r = 0; r < 2; ++r) { const f32x2 t2 = S[r][0] * an[0] + S[r][1] * an[1]; sa[r] = row16_sum(t2.x + t2.y); }
      f32x2 yv;
#pragma unroll
      for (int r = 0; r < 2; ++r) { const f32x2 sav = {sa[r], sa[r]}, vvv = {v2[r], v2[r]};
        S[r][0] = S[r][0] * wv[0] + (sav * bv[0] + vvv * kd[0]); S[r][1] = S[r][1] * wv[1] + (sav * bv[1] + vvv * kd[1]);
        const f32x2 y2 = S[r][0] * rv[0] + S[r][1] * rv[1]; float yp = y2.x + y2.y; yp += dppf<0xB1>(yp); yp += dppf<0x4E>(yp); yv[r] = yp; }
      if ((kq & 3) == 0) { sY[((t * 32 + rg * 2) * 4) + (kq >> 2)] = yv[0]; sY[((t * 32 + rg * 2 + 1) * 4) + (kq >> 2)] = yv[1]; }
    }
    __syncthreads();
    { const int t = tid >> 4, lr = (tid & 15) * 2; const f32x4 p0 = *(const f32x4*)(sY + (t * 32 + lr) * 4), p1 = *(const f32x4*)(sY + (t * 32 + lr + 1) * 4);
      *(f32x2*)(yout + (size_t)(row0 + t0 + t) * 512 + h * 64 + half * 32 + lr) = (f32x2){p0[0] + p0[1] + p0[2] + p0[3], p1[0] + p1[1] + p1[2] + p1[3]}; }
  }
  __builtin_amdgcn_s_setprio(0);
  if (seq < 32) { float* so = p.out + O_RW + (((((size_t)seq * 2 + l) * 2 + d) * 8 + h) * 64 + rbase) * 64 + kq * 4;
#pragma unroll
    for (int r = 0; r < 2; ++r) *(f32x4*)(so + r * 64) = (f32x4){S[r][0].x, S[r][0].y, S[r][1].x, S[r][1].y}; }
}

DI void qk_scores(const bf16_t* sK, const bf16x8 (&qf)[2], f32x4 (&sacc)[4], int fr, int fq) {
#pragma unroll
  for (int nt = 0; nt < 4; ++nt) { sacc[nt] = (f32x4){0.f, 0.f, 0.f, 0.f};
#pragma unroll
    for (int ks = 0; ks < 2; ++ks) { const bf16x8 kf = *(const bf16x8*)(sK + (nt * 16 + fr) * LDT + ks * 32 + fq * 8); sacc[nt] = MFMA16(kf, qf[ks], sacc[nt]); } }
}
DI void pv_accum(const bf16_t* sVt, const f32x4 (&pacc)[4], f32x4 (&o)[4], int fr, int fq) {
#pragma unroll
  for (int s = 0; s < 2; ++s) {
    bf16x8 pf; { const unsigned a = pack2(pacc[2 * s][0], pacc[2 * s][1]), b = pack2(pacc[2 * s][2], pacc[2 * s][3]), c = pack2(pacc[2 * s + 1][0], pacc[2 * s + 1][1]), dd = pack2(pacc[2 * s + 1][2], pacc[2 * s + 1][3]);
      const u32x4 u = (u32x4){a, b, c, dd}; pf = __builtin_bit_cast(bf16x8, u); }
#pragma unroll
    for (int dt = 0; dt < 4; ++dt) { const u32x2 lo = *(const u32x2*)(sVt + (dt * 16 + fr) * LDT + 32 * s + 4 * fq), hi = *(const u32x2*)(sVt + (dt * 16 + fr) * LDT + 32 * s + 16 + 4 * fq);
      const u32x4 u = (u32x4){lo[0], lo[1], hi[0], hi[1]}; const bf16x8 vf = __builtin_bit_cast(bf16x8, u); o[dt] = MFMA16(vf, pf, o[dt]); }
  }
}
DI void put_kv(bf16_t* sK, bf16_t* sVt, int key, int part, const float (&kf)[8], int vkey, int vpart, const float (&vf)[8]) {
  *(u32x4*)(sK + key * LDT + part * 8) = pack8(kf);
#pragma unroll
  for (int e = 0; e < 8; ++e) sVt[(vpart * 8 + e) * LDT + vkey] = f2bf(vf[e]);
}
DI void softmax_tile(f32x4 (&sacc)[4], f32x4 (&o)[4], float& mrun, float& lrun) {
  float mx = sacc[0][0];
#pragma unroll
  for (int nt = 0; nt < 4; ++nt)
#pragma unroll
    for (int j = 0; j < 4; ++j) mx = fmaxf(mx, sacc[nt][j]);
  mx = fmaxf(mx, shfl_x(mx, 16)); mx = fmaxf(mx, shfl_x(mx, 32));
  const float mnew = fmaxf(mrun, mx), alpha = __builtin_amdgcn_exp2f(mrun - mnew); mrun = mnew;
  float ls = 0.f;
#pragma unroll
  for (int nt = 0; nt < 4; ++nt)
#pragma unroll
    for (int j = 0; j < 4; ++j) { const float pv = __builtin_amdgcn_exp2f(sacc[nt][j] - mnew); sacc[nt][j] = pv; ls += pv; }
  lrun = lrun * alpha + ls;
#pragma unroll
  for (int dt = 0; dt < 4; ++dt) o[dt] *= alpha;
}
constexpr float LOG2E = 1.4426950408889634f;

__device__ void dense_task(const P& p, int b, int h, int qb, char* smem) {
  bf16_t* sK = (bf16_t*)smem; bf16_t* sVt = sK + 64 * LDT;
  const int tid = tidx(), lane = tid & 63, wave = tid >> 6, fr = lane & 15, fq = lane >> 4;
  const bf16_t* zn = (const bf16_t*)(p.ws + WS_ZN); bf16_t* ona = (bf16_t*)(p.ws + WS_ONA);
  const int qrow = b * 256 + qb * 64 + wave * 16 + fr;
  bf16x8 qf[2];
#pragma unroll
  for (int ks = 0; ks < 2; ++ks) qf[ks] = *(const bf16x8*)(zn + (size_t)qrow * NZN + h * 64 + ks * 32 + fq * 8);
  f32x4 o[4]; for (int dt = 0; dt < 4; ++dt) o[dt] = (f32x4){0.f, 0.f, 0.f, 0.f};
  float mrun = -1e30f, lrun = 0.f;
  u32x4 pk[2], pv[2];
#pragma unroll
  for (int i = 0; i < 2; ++i) { const int c = tid + 256 * i, key = c >> 3, part = c & 7, vkey = c & 63, vpart = c >> 6; pk[i] = *(const u32x4*)(zn + (size_t)(b * 256 + key) * NZN + h * 64 + part * 8 + 512); pv[i] = *(const u32x4*)(zn + (size_t)(b * 256 + vkey) * NZN + h * 64 + vpart * 8 + 1024); }
  for (int kt = 0; kt < 4; ++kt) {
    __syncthreads();
#pragma unroll
    for (int i = 0; i < 2; ++i) { const int c = tid + 256 * i, key = c >> 3, part = c & 7, vkey = c & 63, vpart = c >> 6;
      *(u32x4*)(sK + key * LDT + part * 8) = pk[i];
#pragma unroll
      for (int e = 0; e < 4; ++e) { sVt[(vpart * 8 + 2 * e) * LDT + vkey] = (bf16_t)(pv[i][e] & 0xffffu); sVt[(vpart * 8 + 2 * e + 1) * LDT + vkey] = (bf16_t)(pv[i][e] >> 16); } }
    __syncthreads();
    { const int kn = kt < 3 ? kt + 1 : 3;
#pragma unroll
      for (int i = 0; i < 2; ++i) { const int c = tid + 256 * i, key = c >> 3, part = c & 7, vkey = c & 63, vpart = c >> 6; pk[i] = *(const u32x4*)(zn + (size_t)(b * 256 + kn * 64 + key) * NZN + h * 64 + part * 8 + 512); pv[i] = *(const u32x4*)(zn + (size_t)(b * 256 + kn * 64 + vkey) * NZN + h * 64 + vpart * 8 + 1024); } }
    f32x4 sacc[4]; qk_scores(sK, qf, sacc, fr, fq);
#pragma unroll
    for (int nt = 0; nt < 4; ++nt) sacc[nt] *= (0.125f * LOG2E);
    softmax_tile(sacc, o, mrun, lrun);
    pv_accum(sVt, sacc, o, fr, fq);
  }
  lrun += shfl_x(lrun, 16); lrun += shfl_x(lrun, 32); const float inv = 1.f / lrun;
#pragma unroll
  for (int dt = 0; dt < 4; ++dt) { u32x2 ov; ov.x = pack2(o[dt][0] * inv, o[dt][1] * inv); ov.y = pack2(o[dt][2] * inv, o[dt][3] * inv); *(u32x2*)(ona + (size_t)qrow * LDO + h * 64 + dt * 16 + fq * 4) = ov; }
}

__device__ void na_task(const P& p, int l, int b, int h, int r, char* smem) {
  bf16_t* sK = (bf16_t*)smem; bf16_t* sVt = sK + 64 * LDT; float* sRpb = (float*)(sVt + 64 * LDT);
  const int tid = tidx(), lane = tid & 63, wave = tid >> 6, fr = lane & 15, fq = lane >> 4;
  const bf16_t* zn = (const bf16_t*)(p.ws + WS_ZN); bf16_t* ona = (bf16_t*)(p.ws + WS_ONA);
  const int base = MC + b * 1024, qcol = wave * 16 + fr, qrow = base + r * 64 + qcol;
  int rs = r - 4; rs = rs < 0 ? 0 : (rs > 8 ? 8 : rs);
  int cs = qcol - 8; cs = cs < 0 ? 0 : (cs > 48 ? 48 : cs);
  __syncthreads();
  for (int e = tid; e < 465; e += NT) sRpb[e] = p.na_rpb[((size_t)l * 8 + h) * 465 + e] * LOG2E;
  bf16x8 qf[2];
#pragma unroll
  for (int ks = 0; ks < 2; ++ks) qf[ks] = *(const bf16x8*)(zn + (size_t)qrow * NZN + h * 64 + ks * 32 + fq * 8);
  f32x4 o[4]; for (int dt = 0; dt < 4; ++dt) o[dt] = (f32x4){0.f, 0.f, 0.f, 0.f};
  float mrun = -1e30f, lrun = 0.f;
  u32x4 pre[8];
#define NA_ISSUE(KT) do { const int kt_ = (KT); \
    if (kt_ < 8) { _Pragma("unroll") for (int i = 0; i < 2; ++i) { const int c = tid + 256 * i, key = c >> 3, part = c & 7, vkey = c & 63, vpart = c >> 6; \
        pre[4 * i] = *(const u32x4*)(zn + (size_t)(base + (rs + kt_) * 64 + key) * NZN + h * 64 + part * 8 + 512); pre[4 * i + 1] = *(const u32x4*)(zn + (size_t)(base + (rs + kt_) * 64 + vkey) * NZN + h * 64 + vpart * 8 + 1024); } } \
    else { _Pragma("unroll") for (int i = 0; i < 2; ++i) { const int c = tid + 256 * i, key = c >> 3, part = c & 7, vkey = c & 63, vpart = c >> 6; const size_t cb_ = (((size_t)b * 2 + l) * 8 + h) * 256 + (kt_ - 8) * 64; const size_t co = (cb_ + key) * 64 + part * 8, cv = (cb_ + vkey) * 64 + vpart * 8; \
        pre[4 * i] = *(const u32x4*)(p.cache_k + co); pre[4 * i + 1] = *(const u32x4*)(p.cache_k + co + 4); pre[4 * i + 2] = *(const u32x4*)(p.cache_v + cv); pre[4 * i + 3] = *(const u32x4*)(p.cache_v + cv + 4); } } } while (0)
  NA_ISSUE(0);
  for (int kt = 0; kt < 12; ++kt) {
    __syncthreads();
    if (kt < 8) {
#pragma unroll
      for (int i = 0; i < 2; ++i) { const int c = tid + 256 * i, key = c >> 3, part = c & 7, vkey = c & 63, vpart = c >> 6;
        *(u32x4*)(sK + key * LDT + part * 8) = pre[4 * i];
#pragma unroll
        for (int e = 0; e < 4; ++e) { sVt[(vpart * 8 + 2 * e) * LDT + vkey] = (bf16_t)(pre[4 * i + 1][e] & 0xffffu); sVt[(vpart * 8 + 2 * e + 1) * LDT + vkey] = (bf16_t)(pre[4 * i + 1][e] >> 16); } }
    } else {
#pragma unroll
      for (int i = 0; i < 2; ++i) { const int c = tid + 256 * i, key = c >> 3, part = c & 7, vkey = c & 63, vpart = c >> 6;
        const f32x4 k0 = __builtin_bit_cast(f32x4, pre[4 * i]), k1 = __builtin_bit_cast(f32x4, pre[4 * i + 1]), v0 = __builtin_bit_cast(f32x4, pre[4 * i + 2]), v1 = __builtin_bit_cast(f32x4, pre[4 * i + 3]);
        const float kf[8] = {k0[0], k0[1], k0[2], k0[3], k1[0], k1[1], k1[2], k1[3]}; const float vf[8] = {v0[0], v0[1], v0[2], v0[3], v1[0], v1[1], v1[2], v1[3]};
        put_kv(sK, sVt, key, part, kf, vkey, vpart, vf); }
    }
    __syncthreads();
    NA_ISSUE(kt < 11 ? kt + 1 : 11);
    f32x4 sacc[4]; qk_scores(sK, qf, sacc, fr, fq);
    if (kt < 8) { const int dr = rs + kt - r + 7;
#pragma unroll
      for (int nt = 0; nt < 4; ++nt)
#pragma unroll
        for (int j = 0; j < 4; ++j) { const int kc = nt * 16 + fq * 4 + j; const bool valid = kc >= cs && kc < cs + 16; int dc = kc - qcol; dc = dc < -15 ? -15 : (dc > 15 ? 15 : dc);
          sacc[nt][j] = valid ? sacc[nt][j] * (0.125f * LOG2E) + sRpb[dr * 31 + dc + 15] : -1e30f; }
    } else {
#pragma unroll
      for (int nt = 0; nt < 4; ++nt) sacc[nt] *= (0.125f * LOG2E);
    }
    softmax_tile(sacc, o, mrun, lrun);
    pv_accum(sVt, sacc, o, fr, fq);
  }
#undef NA_ISSUE
  lrun += shfl_x(lrun, 16); lrun += shfl_x(lrun, 32); const float inv = 1.f / lrun;
#pragma unroll
  for (int dt = 0; dt < 4; ++dt) { u32x2 ov; ov.x = pack2(o[dt][0] * inv, o[dt][1] * inv); ov.y = pack2(o[dt][2] * inv, o[dt][3] * inv); *(u32x2*)(ona + (size_t)qrow * LDO + h * 64 + dt * 16 + fq * 4) = ov; }
}

DI void rope8(const float (&own)[8], const float (&par)[8], int part, int n, float (&out)[8]) {
  const float pos = (float)((part >> 2) ? (n & 63) : (n >> 6));
  const bool isx2 = (part & 3) >= 2;
#pragma unroll
  for (int e = 0; e < 8; ++e) { const int i = (part & 1) * 8 + e; const float ang = pos * __builtin_amdgcn_exp2f(-(float)i * 0.830482023721841f); const float sn = __sinf(ang), cs = __cosf(ang);
    out[e] = isx2 ? par[e] * sn + own[e] * cs : own[e] * cs - par[e] * sn; }
}

DI void rope8t(const float (&own)[8], const float (&par)[8], int part, int n, const float* tab, float (&out)[8]) {
  const int pos = (part >> 2) ? (n & 63) : (n >> 6);
  const bool isx2 = (part & 3) >= 2;
  const float* tb = tab + (pos * 16 + (part & 1) * 8) * 2;
#pragma unroll
  for (int e = 0; e < 8; e += 2) { const f32x4 cssn = *(const f32x4*)(tb + 2 * e);
    out[e] = isx2 ? par[e] * cssn[1] + own[e] * cssn[0] : own[e] * cssn[0] - par[e] * cssn[1];
    out[e + 1] = isx2 ? par[e + 1] * cssn[3] + own[e + 1] * cssn[2] : own[e + 1] * cssn[2] - par[e + 1] * cssn[3]; }
}

__device__ void ret_task(const P& p, int l, int seq, int h, int qb, char* smem) {
  bf16_t* sK = (bf16_t*)smem; bf16_t* sVt = sK + 64 * LDT; bf16_t* sQ = sVt + 64 * LDT; float* sRope = (float*)(sQ + 64 * LDT);
  const int tid = tidx(), lane = tid & 63, wave = tid >> 6, fr = lane & 15, fq = lane >> 4;
  const bf16_t* zt = (const bf16_t*)(p.ws + WS_ZT); bf16_t* oret = (bf16_t*)(p.ws + WS_ORET);
  const bool lat = seq >= 32;
  const int row0 = lat ? MC + (seq - 32) * 1024 : seq * 256, T = lat ? 1024 : 256, nkt = T >> 6;
  const float xf = p.ret_decay[(l * 2 + 0) * 8 + h], xb = p.ret_decay[(l * 2 + 1) * 8 + h];
  const float lgf = -log1pf(__expf(-xf)) * LOG2E, lgb = -log1pf(__expf(-xb)) * LOG2E;
  __syncthreads();
  if (lat) {
#pragma unroll
    for (int j = 0; j < 4; ++j) { const int e = tid + 256 * j; const float ang = (float)(e >> 4) * __builtin_amdgcn_exp2f(-(float)(e & 15) * 0.830482023721841f); sRope[2 * e] = __cosf(ang); sRope[2 * e + 1] = __sinf(ang); }
    __syncthreads();
  }
#pragma unroll
  for (int i = 0; i < 2; ++i) { const int c = tid + 256 * i, qi = c >> 3, part = c & 7; const int n = qb * 64 + qi; const size_t ro = (size_t)(row0 + n) * LZT + h * 64;
    const u32x4 own = *(const u32x4*)(zt + ro + part * 8);
    if (lat) { const u32x4 par = *(const u32x4*)(zt + ro + (part ^ 2) * 8); float fo[8], fp[8], out[8]; unpack8(own, fo); unpack8(par, fp); rope8t(fo, fp, part, n, sRope, out); *(u32x4*)(sQ + qi * LDT + part * 8) = pack8(out); }
    else *(u32x4*)(sQ + qi * LDT + part * 8) = own; }
  __syncthreads();
  const int qi = wave * 16 + fr, nq = qb * 64 + qi;
  bf16x8 qf[2];
#pragma unroll
  for (int ks = 0; ks < 2; ++ks) qf[ks] = *(const bf16x8*)(sQ + qi * LDT + ks * 32 + fq * 8);
  f32x4 o[4]; for (int dt = 0; dt < 4; ++dt) o[dt] = (f32x4){0.f, 0.f, 0.f, 0.f};
  u32x4 rk[2], rp[2], rv[2];
#define RET_ISSUE(KT) do { _Pragma("unroll") for (int i = 0; i < 2; ++i) { const int c = tid + 256 * i, key = c >> 3, part = c & 7, vkey = c & 63, vpart = c >> 6; const size_t ro = (size_t)(row0 + (KT) * 64 + key) * LZT + h * 64; \
    rk[i] = *(const u32x4*)(zt + ro + 512 + part * 8); rp[i] = *(const u32x4*)(zt + ro + 512 + (part ^ 2) * 8); rv[i] = *(const u32x4*)(zt + (size_t)(row0 + (KT) * 64 + vkey) * LZT + h * 64 + 1024 + vpart * 8); } } while (0)
  RET_ISSUE(0);
  for (int kt = 0; kt < nkt; ++kt) {
    __syncthreads();
#pragma unroll
    for (int i = 0; i < 2; ++i) { const int c = tid + 256 * i, key = c >> 3, part = c & 7, vkey = c & 63, vpart = c >> 6; const int n = kt * 64 + key;
      float kf[8]; unpack8(rk[i], kf);
      if (lat) { float fp[8], out[8]; unpack8(rp[i], fp); rope8t(kf, fp, part, n, sRope, out);
#pragma unroll
        for (int e = 0; e < 8; ++e) kf[e] = out[e]; }
#pragma unroll
      for (int e = 0; e < 8; ++e) kf[e] *= 0.125f;
      *(u32x4*)(sK + key * LDT + part * 8) = pack8(kf);
#pragma unroll
      for (int e = 0; e < 4; ++e) { sVt[(vpart * 8 + 2 * e) * LDT + vkey] = (bf16_t)(rv[i][e] & 0xffffu); sVt[(vpart * 8 + 2 * e + 1) * LDT + vkey] = (bf16_t)(rv[i][e] >> 16); } }
    __syncthreads();
    RET_ISSUE(kt + 1 < nkt ? kt + 1 : kt);
    f32x4 sacc[4]; qk_scores(sK, qf, sacc, fr, fq);
#pragma unroll
    for (int nt = 0; nt < 4; ++nt)
#pragma unroll
      for (int j = 0; j < 4; ++j) { const int mk = kt * 64 + nt * 16 + fq * 4 + j; const int df = nq - mk;
        const float ex = __builtin_amdgcn_exp2f((df > 0 ? lgf : -lgb) * (float)df); sacc[nt][j] *= (df == 0 ? 2.f : ex); }
    pv_accum(sVt, sacc, o, fr, fq);
  }
#undef RET_ISSUE
  if (lat) {
    for (int dir = 0; dir < 2; ++dir) {
      __syncthreads();
      const float* s0 = p.state_ret + ((((size_t)(seq - 32) * 2 + l) * 2 + dir) * 8 + h) * 4096;
#pragma unroll
      for (int i = 0; i < 2; ++i) { const int c = tid + 256 * i, dk = c & 63, part = c >> 6; const float4 a = *(const float4*)(s0 + dk * 64 + part * 8), bq = *(const float4*)(s0 + dk * 64 + part * 8 + 4);
        const float vf[8] = {a.x, a.y, a.z, a.w, bq.x, bq.y, bq.z, bq.w};
#pragma unroll
        for (int e = 0; e < 8; ++e) sVt[(part * 8 + e) * LDT + dk] = f2bf(vf[e]); }
      __syncthreads();
      const float xi = dir == 0 ? exp2f(lgf * (float)(nq + 1)) : exp2f(lgb * (float)(T - nq));
      f32x4 pacc[4];
#pragma unroll
      for (int s = 0; s < 2; ++s)
#pragma unroll
        for (int hh = 0; hh < 2; ++hh)
#pragma unroll
          for (int j = 0; j < 4; ++j) pacc[2 * s + hh][j] = xi * bf2f(sQ[qi * LDT + 32 * s + 16 * hh + 4 * fq + j]);
      pv_accum(sVt, pacc, o, fr, fq);
    }
  }
  float s1 = 0.f;
#pragma unroll
  for (int dt = 0; dt < 4; ++dt)
#pragma unroll
    for (int j = 0; j < 4; ++j) s1 += o[dt][j];
  s1 += shfl_x(s1, 16); s1 += shfl_x(s1, 32); const float mu = s1 * (1.f / 64.f);
  float s2 = 0.f;
#pragma unroll
  for (int dt = 0; dt < 4; ++dt)
#pragma unroll
    for (int j = 0; j < 4; ++j) { const float dlt = o[dt][j] - mu; s2 += dlt * dlt; }
  s2 += shfl_x(s2, 16); s2 += shfl_x(s2, 32); const float rstd = rsqrtf(s2 * (1.f / 64.f) + 1e-5f);
  const size_t qrow = (size_t)(row0 + nq);
#pragma unroll
  for (int dt = 0; dt < 4; ++dt) { const int dv = h * 64 + dt * 16 + fq * 4; const u32x2 gr = *(const u32x2*)(zt + qrow * LZT + 1536 + dv); const float4 gn = *(const float4*)(p.ret_gn + l * 512 + dv);
    const float g0 = bflo(gr.x), g1 = bfhi(gr.x), g2 = bflo(gr.y), g3 = bfhi(gr.y);
    u32x2 ov; ov.x = pack2((o[dt][0] - mu) * rstd * gn.x * g0 * sigmoidf_(g0), (o[dt][1] - mu) * rstd * gn.y * g1 * sigmoidf_(g1));
    ov.y = pack2((o[dt][2] - mu) * rstd * gn.z * g2 * sigmoidf_(g2), (o[dt][3] - mu) * rstd * gn.w * g3 * sigmoidf_(g3));
    *(u32x2*)(oret + qrow * LDO + dv) = ov; }
}

__device__ void retstate_task(const P& p, int l, int b, int h, char* smem) {
  float* sKf = (float*)smem; float* sKb = sKf + 64 * 64; float* sV = sKb + 64 * 64;
  const int tid = tidx(), dk = tid >> 2, dq = tid & 3;
  const bf16_t* zt = (const bf16_t*)(p.ws + WS_ZT);
  const float xf = p.ret_decay[(l * 2 + 0) * 8 + h], xb = p.ret_decay[(l * 2 + 1) * 8 + h];
  const float lgf = -log1pf(__expf(-xf)) * LOG2E, lgb = -log1pf(__expf(-xb)) * LOG2E;
  float af[16], ab[16];
#pragma unroll
  for (int i = 0; i < 16; ++i) { af[i] = 0.f; ab[i] = 0.f; }
  for (int kt = 0; kt < 4; ++kt) {
    __syncthreads();
#pragma unroll
    for (int i = 0; i < 2; ++i) { const int c = tid + 256 * i, key = c >> 3, part = c & 7, m = kt * 64 + key; const size_t ro = (size_t)(b * 256 + m) * LZT + h * 64 + part * 8;
      float kf[8], vf[8]; unpack8(*(const u32x4*)(zt + ro + 512), kf); unpack8(*(const u32x4*)(zt + ro + 1024), vf);
      const float wf = 0.125f * exp2f(lgf * (float)(255 - m)), wb = 0.125f * exp2f(lgb * (float)m);
#pragma unroll
      for (int e = 0; e < 8; ++e) { sKf[key * 64 + part * 8 + e] = kf[e] * wf; sKb[key * 64 + part * 8 + e] = kf[e] * wb; sV[key * 64 + part * 8 + e] = vf[e]; } }
    __syncthreads();
    for (int m = 0; m < 64; ++m) { const float kf = sKf[m * 64 + dk], kb = sKb[m * 64 + dk];
#pragma unroll
      for (int i = 0; i < 4; ++i) { const f32x4 vv = *(const f32x4*)(sV + m * 64 + dq * 16 + i * 4);
#pragma unroll
        for (int j = 0; j < 4; ++j) { af[i * 4 + j] += kf * vv[j]; ab[i * 4 + j] += kb * vv[j]; } } }
  }
  float* of = p.out + O_RT + ((((size_t)b * 2 + l) * 2 + 0) * 8 + h) * 4096 + dk * 64 + dq * 16; float* ob = of + 8 * 4096;
#pragma unroll
  for (int i = 0; i < 16; ++i) { of[i] = af[i]; ob[i] = ab[i]; }
}

constexpr int Q_SCAN_L = 64, Q_SCAN_C = 512, Q_RET_L = 256, Q_NA = 256, Q_DENSE = 512, Q_RET_C = 512, Q_RST = 128;
template <int QMASK> __device__ void phase_mixers(const P& p, int l, char* smem_, int rep = 0) {
  __shared__ int s_task;
  int* ctr = (int*)(p.ws + WS_CTRL) + 64 * (l + 1) + 4 * rep;
  const int vb = vhalf(); char* smem = smem_ + vb * VSMEM;
  if (QMASK & 1) for (;;) {
    __syncthreads();
    if (ptid() == 0) s_task = atomicAdd(ctr, 1);
    __syncthreads();
    const int tk = s_task;
    if (tk >= Q_SCAN_L + Q_SCAN_C) break;
    const bool lat = tk < Q_SCAN_L; const int t2 = lat ? tk : tk - Q_SCAN_L;
    scan_task(p, l, (lat ? 32 : 0) + (t2 >> 4), (t2 >> 1) & 7, t2 & 1, vb, smem);
  }
  if (QMASK & 2) for (;;) {
    __syncthreads();
    if (ptid() == 0) s_task = atomicAdd(ctr + 16, 1);
    __syncthreads();
    const int tk = s_task;
    if (tk >= Q_RET_L + Q_RET_C) break;
    if (tk < Q_RET_L) ret_task(p, l, 32 + (tk >> 6), (tk >> 3) & 7, (tk & 7) * 2 + vb, smem);
    else { const int t2 = tk - Q_RET_L; ret_task(p, l, t2 >> 4, (t2 >> 1) & 7, (t2 & 1) * 2 + vb, smem); }
  }
  if (QMASK & 4) for (;;) {
    __syncthreads();
    if (ptid() == 0) s_task = atomicAdd(ctr + 32, 1);
    __syncthreads();
    int tk = s_task;
    if (tk >= Q_NA + Q_DENSE + Q_RST) break;
    if (tk < Q_NA) { na_task(p, l, tk >> 6, (tk >> 3) & 7, (tk & 7) * 2 + vb, smem); continue; } tk -= Q_NA;
    if (tk < Q_DENSE) { dense_task(p, tk >> 4, (tk >> 1) & 7, (tk & 1) * 2 + vb, smem); continue; } tk -= Q_DENSE;
    retstate_task(p, l, tk >> 2, (tk & 3) * 2 + vb, smem);
  }
}

__device__ void phase_rwkv_post(const P& p, int l, char* smem) {
  const bf16_t* zr = (const bf16_t*)(p.ws + WS_ZR); const float* yf = (const float*)(p.ws + WS_Y); const float* yb = yf + (size_t)MT * 512; bf16_t* oa = (bf16_t*)(p.ws + WS_OA);
  const bf16_t* Gt = (const bf16_t*)(p.ws + WS_WG);
  const int tid = ptid(), lane = tid & 63, wave = tid >> 6, wr = wave >> 2, wc = wave & 3, fr = lane & 15, fq = lane >> 4;
  TileIter ti; int mt, nt; ti.init(96, 2);
  while (ti.next(mt, nt)) {
    const int row0 = mt * 128, n0 = nt * 256;
    f32x4 acc[4][4]; zero_acc<4, 4>(acc);
    TileSrc s{zr + 1664, NZR, row0, Gt, LDG, n0, n0 + 128, 128}; { Gemm<4, 4, 1> gm; gm.begin(s, true); gm.run(acc, smem); }
    const int cb = n0 + wc * 64 + fq * 8;
#pragma unroll
    for (int m = 0; m < 4; ++m) { const size_t row = (size_t)(row0 + wr * 64 + m * 16 + fr);
      f32x4 y[4]; float s1 = 0.f, rk = 0.f; f32x4 vv[4];
#pragma unroll
      for (int n = 0; n < 4; ++n) { const int c = cb + 32 * (n >> 1) + 4 * (n & 1); y[n] = *(const f32x4*)(yf + row * 512 + c) + *(const f32x4*)(yb + row * 512 + c); s1 += y[n][0] + y[n][1] + y[n][2] + y[n][3];
        const u32x2 rr = *(const u32x2*)(zr + row * NZR + c), kk = *(const u32x2*)(zr + row * NZR + 512 + c), v2 = *(const u32x2*)(zr + row * NZR + 1024 + c); const f32x4 rkw = *(const f32x4*)(p.rwkv_r_k + l * 512 + c);
        rk += bflo(rr.x) * bflo(kk.x) * rkw[0] + bfhi(rr.x) * bfhi(kk.x) * rkw[1] + bflo(rr.y) * bflo(kk.y) * rkw[2] + bfhi(rr.y) * bfhi(kk.y) * rkw[3];
        vv[n] = (f32x4){bflo(v2.x), bfhi(v2.x), bflo(v2.y), bfhi(v2.y)}; }
      s1 += shfl_x(s1, 16); s1 += shfl_x(s1, 32); rk += shfl_x(rk, 16); rk += shfl_x(rk, 32);
      const float mu = s1 * (1.f / 64.f); float s2 = 0.f;
#pragma unroll
      for (int n = 0; n < 4; ++n)
#pragma unroll
        for (int j = 0; j < 4; ++j) { const float dl = y[n][j] - mu; s2 += dl * dl; }
      s2 += shfl_x(s2, 16); s2 += shfl_x(s2, 32); const float rstd = rsqrtf(s2 * (1.f / 64.f) + 64e-5f);
#pragma unroll
      for (int n = 0; n < 4; ++n) { const int c = cb + 32 * (n >> 1) + 4 * (n & 1); const f32x4 lg = *(const f32x4*)(p.rwkv_ln_g + l * 512 + c), lb = *(const f32x4*)(p.rwkv_ln_b + l * 512 + c);
        float o[4];
#pragma unroll
        for (int j = 0; j < 4; ++j) o[j] = ((y[n][j] - mu) * rstd * lg[j] + lb[j] + rk * vv[n][j]) * acc[m][n][j];
        u32x2 ov; ov.x = pack2(o[0], o[1]); ov.y = pack2(o[2], o[3]); *(u32x2*)(oa + row * LDO + c) = ov; }
    }
  }
}

DI void convert_layer_a(const P& p, int l, char* smem) {
  convert_T(p.w_in + (size_t)l * D * INC, D, INC, (bf16_t*)(p.ws + WS_WIN), LDH, smem);
  convert_T(p.w_o_rwkv + (size_t)l * 512 * D, 512, D, (bf16_t*)(p.ws + WS_WO3), LDO, smem);
  convert_T(p.w_o_na + (size_t)l * 512 * D, 512, D, (bf16_t*)(p.ws + WS_WO3) + (size_t)1024 * LDO, LDO, smem);
  convert_T(p.w_o_ret + (size_t)l * 512 * D, 512, D, (bf16_t*)(p.ws + WS_WO3) + (size_t)2 * 1024 * LDO, LDO, smem);
  convert_T(p.w_out + (size_t)l * D * D, D, D, (bf16_t*)(p.ws + WS_WOUT), LDH, smem);
  convert_T(p.rwkv_g_up + (size_t)l * 128 * 512, 128, 512, (bf16_t*)(p.ws + WS_WG), LDG, smem);
}
DI void convert_layer_b(const P& p, int l, char* smem) {
  convert_T(p.ffn_up + (size_t)l * D * 2 * FF, D, 2 * FF, (bf16_t*)(p.ws + WS_WUP), LDH, smem);
  convert_T(p.ffn_down + (size_t)l * FF * D, FF, D, (bf16_t*)(p.ws + WS_WDN), FF, smem);
}

typedef __attribute__((address_space(4))) const P* KP;
DI KP kargs() { KP k = (KP)__builtin_amdgcn_kernarg_segment_ptr(); asm volatile("" : "+s"(k)); return k; }
template <int PH> DI void run_phase(int l, char* smem) {
#if defined(__HIP_DEVICE_COMPILE__)
  const P p = *kargs();
#else
  const P p{};
#endif
  const float* mod = (const float*)(p.ws + WS_MOD);
  float* xbuf = p.out;
  if (PH == 0) { ada_phase(p, smem); convert_layer_a(p, 0, smem); }
  else if (PH == 1) { norm_phase(p, nullptr, nullptr, nullptr, nullptr, 0, nullptr, p.norm_mix_pre, mod, 0, (bf16_t*)(p.ws + WS_H)); }
  else if (PH == 2) phase_win(p, l, smem);
  else if (PH == 4) phase_mixers<7>(p, l, smem);
  else if (PH == 5) phase_rwkv_post(p, l, smem);
  else if (PH == 6) phase_merge(p, smem);
  else if (PH == 7) { phase_gemm_f32((const bf16_t*)(p.ws + WS_MERGED), LDH, D, (const bf16_t*)(p.ws + WS_WOUT), LDH, (float*)(p.ws + WS_U), smem); }
  else if (PH == 8) { convert_layer_b(p, l, smem);
    norm_phase(p, l == 0 ? nullptr : xbuf, (const float*)(p.ws + WS_U), p.norm_mix_post + l * D, mod + (size_t)l * 5 * 6144, 2, xbuf, p.norm_ffn_pre + l * D, mod + (size_t)l * 5 * 6144, 3, (bf16_t*)(p.ws + WS_H)); }
  else if (PH == 9) phase_ffn_up(p, l, smem);
  else if (PH == 11) { phase_gemm_f32((const bf16_t*)(p.ws + WS_HID), FF, FF, (const bf16_t*)(p.ws + WS_WDN), FF, (float*)(p.ws + WS_F), smem); }
  else if (PH == 12) {
    if (l == 0) { norm_phase(p, xbuf, (const float*)(p.ws + WS_F), p.norm_ffn_post, mod, 5, xbuf, p.norm_mix_pre + D, mod + (size_t)5 * 6144, 0, (bf16_t*)(p.ws + WS_H)); convert_layer_a(p, 1, smem); }
    else norm_phase(p, xbuf, (const float*)(p.ws + WS_F), p.norm_ffn_post + D, mod + (size_t)5 * 6144, 5, xbuf, nullptr, nullptr, 0, nullptr);
  }
}

#if MEGA
__global__ void __launch_bounds__(NTP, 1) mega_kernel(P p_) {
  extern __shared__ __attribute__((aligned(16))) char smem[];
  __shared__ u32x4 xb_words;
  cg::grid_group grid = cg::this_grid();
  if (ptid() == 0) xb_words = (u32x4){0u, 0u, 0u, 0u};
  __syncthreads();
#if defined(__HIP_DEVICE_COMPILE__)
  (void)xcd_barrier_post((unsigned*)(p_.ws + WS_BAR), (volatile LAS unsigned*)&xb_words);
#define GSYNC() do { XcdBarrier xb_; xb_.bar = (unsigned*)(kargs()->ws + WS_BAR); xb_.x = xb_xcc_id(); xb_.st = (volatile LAS unsigned*)&xb_words; xcd_barrier(xb_); } while (0)
#else
#define GSYNC() do { } while (0)
#endif
  run_phase<0>(0, smem); grid.sync();
  run_phase<1>(0, smem); GSYNC();
#pragma unroll
  for (int l = 0; l < 2; ++l) {
    run_phase<2>(l, smem); GSYNC();
    if (PROBE_MASK & 1) { run_phase<2>(l, smem); GSYNC(); }
    run_phase<4>(l, smem); GSYNC();
    run_phase<5>(l, smem); GSYNC();
    run_phase<6>(l, smem); GSYNC();
    if (PROBE_MASK & 8) { run_phase<6>(l, smem); GSYNC(); }
    run_phase<7>(l, smem); GSYNC();
    if (PROBE_MASK & 16) { run_phase<7>(l, smem); GSYNC(); }
    run_phase<8>(l, smem); GSYNC();
    run_phase<9>(l, smem); GSYNC();
    if (PROBE_MASK & 32) { run_phase<9>(l, smem); GSYNC(); }
    run_phase<11>(l, smem); GSYNC();
    if (PROBE_MASK & 64) { run_phase<11>(l, smem); GSYNC(); }
    run_phase<12>(l, smem); if (l == 0) GSYNC();
  }
#undef GSYNC
}
#else
template <int PH> __global__ void __launch_bounds__(NTP, 1) phase_kernel(P p, int l) {
  extern __shared__ __attribute__((aligned(16))) char smem[];
  run_phase<PH>(l, smem);
}
#endif

extern "C" void kernel_launch(void* const* d_in, const int* in_sizes, int n_in, void* d_out, int out_size, void* d_ws, size_t ws_size, hipStream_t stream) {
  if (ws_size < WS_END || n_in < 36) { fprintf(stderr, "workspace too small: %zu < %zu\n", ws_size, (size_t)WS_END); return; }
  P p{};
  const float** pp = (const float**)&p;
  for (int i = 0; i < 36; ++i) pp[i] = (const float*)d_in[i];
  p.out = (float*)d_out; p.ws = (char*)d_ws;
  hipMemsetAsync(d_ws, 0, WS_WIN, stream);
#if MEGA
  static int grid_blocks = 0;
  if (!grid_blocks) {
    int dev = 0, cus = 0, per_cu = 0; hipGetDevice(&dev);
    hipDeviceGetAttribute(&cus, hipDeviceAttributeMultiprocessorCount, dev);
    hipFuncSetAttribute((const void*)mega_kernel, hipFuncAttributeMaxDynamicSharedMemorySize, SMEM_BYTES);
    hipOccupancyMaxActiveBlocksPerMultiprocessor(&per_cu, mega_kernel, NTP, SMEM_BYTES);
    if (per_cu > 1) per_cu = 1;
    grid_blocks = cus * per_cu;
  }
  void* args[] = {&p};
  hipError_t e = hipLaunchCooperativeKernel((void*)mega_kernel, dim3(grid_blocks), dim3(NTP), args, SMEM_BYTES, stream);
  if (e != hipSuccess) fprintf(stderr, "cooperative launch failed: %s (grid %d)\n", hipGetErrorString(e), grid_blocks);
#else
  const int G = 512;
#define LAUNCH(PH, L) do { hipFuncSetAttribute((const void*)phase_kernel<PH>, hipFuncAttributeMaxDynamicSharedMemorySize, SMEM_BYTES); phase_kernel<PH><<<G, NT, SMEM_BYTES, stream>>>(p, L); } while (0)
  LAUNCH(0, 0); LAUNCH(1, 0);
  for (int l = 0; l < 2; ++l) { LAUNCH(2, l); LAUNCH(4, l); LAUNCH(5, l); LAUNCH(6, l); LAUNCH(7, l); LAUNCH(8, l); LAUNCH(9, l); LAUNCH(11, l); LAUNCH(12, l); }
#endif
}
```

```cpp
#include <hip/hip_runtime.h>
#include <hip/hip_cooperative_groups.h>
#include <cstdio>
namespace cg = cooperative_groups;

#ifndef MEGA
#define MEGA 1
#endif
#define PROBE_MASK 0
#define GEMM_F32_KU 1
#define FFN_UP_KU 1

typedef unsigned short bf16_t;
typedef short bf16x8 __attribute__((ext_vector_type(8)));
typedef short bf16x4 __attribute__((ext_vector_type(4)));
typedef float f32x4 __attribute__((ext_vector_type(4)));
typedef float f32x2 __attribute__((ext_vector_type(2)));
typedef unsigned u32x4 __attribute__((ext_vector_type(4)));
typedef unsigned u32x2 __attribute__((ext_vector_type(2)));
#define DI __device__ __forceinline__
#define MFMA16(a, b, c) __builtin_amdgcn_mfma_f32_16x16x32_bf16((a), (b), (c), 0, 0, 0)

constexpr int NT = 256;
constexpr int NTP = 512;
constexpr int VSMEM = 65536;
constexpr int D = 1024, MC = 8192, ML = 4096, MT = 12288;
constexpr int NZR = 1792, NZN = 1536, NZT = 2048, INC = 8448, FF = 2816;
constexpr int LDH = 1088, LDO = 576, LZT = 2112, LDG = 136;
constexpr int LDT = 72;
constexpr int SMEM_BYTES = 139264;
constexpr int SMEM_BYTES_GEMM_ = 131072;
constexpr size_t O_K = 12582912, O_V = 20971520, O_RW = 29360128, O_RT = 33554432;
constexpr size_t WS_CTRL = 0;
constexpr size_t WS_MOD = 4096;
constexpr size_t WS_BAR = 262144;
constexpr size_t WS_CUF = 278528;
constexpr size_t WS_WG = 294912;
constexpr size_t WS_WIN = 434176;
constexpr size_t WS_WUP = WS_WIN;
constexpr size_t WS_WDN = WS_WIN + (size_t)5632 * LDH * 2;
constexpr size_t WS_WO3 = WS_WIN + (size_t)INC * LDH * 2;
constexpr size_t WS_WOUT = WS_WO3 + (size_t)3 * 1024 * LDO * 2;
constexpr size_t WS_H = WS_WOUT + (size_t)1024 * LDH * 2;
constexpr size_t WS_Z = WS_H + (size_t)MT * LDH * 2;
constexpr size_t WS_ZR = WS_Z;
constexpr size_t WS_ZN = WS_ZR + (size_t)MT * NZR * 2;
constexpr size_t WS_ZT = WS_ZN + (size_t)MT * NZN * 2;
constexpr size_t WS_MERGED = WS_ZR;
constexpr size_t WS_OA = WS_ZN;
constexpr size_t WS_U = WS_ZT;
constexpr size_t WS_HID = WS_Z;
constexpr size_t WS_F = WS_ZT;
constexpr size_t WS_Y = WS_ZT + (size_t)MT * LZT * 2;
constexpr size_t WS_ONA = WS_Y + (size_t)2 * MT * 512 * 4;
constexpr size_t WS_ORET = WS_ONA + (size_t)MT * LDO * 2;
constexpr size_t WS_END = WS_ORET + (size_t)MT * LDO * 2;

struct P {
  const float *x_prompt, *x_sample, *cache_k, *cache_v, *state_rwkv, *state_ret, *c, *c_ctx, *ada_w, *ada_b;
  const float *norm_mix_pre, *norm_mix_post, *norm_ffn_pre, *norm_ffn_post, *w_in, *rwkv_conv, *rwkv_w0, *rwkv_w_up, *rwkv_a0, *rwkv_a_up, *rwkv_g_up;
  const float *rwkv_k_k, *rwkv_k_a, *rwkv_r_k, *rwkv_ln_g, *rwkv_ln_b, *na_rpb, *ret_decay, *ret_gn, *w_o_rwkv, *w_o_na, *w_o_ret, *w_out, *ffn_up, *ffn_conv, *ffn_down;
  float* out; char* ws;
};

DI int threadIdx_x_raw() { return (int)__builtin_amdgcn_workitem_id_x(); }
DI int ptid() { int t = threadIdx_x_raw(); asm volatile("" : "+v"(t)); return t; }
DI int tidx() { return ptid() & 255; }
DI int vhalf() { return ptid() >> 8; }
DI int vblk() { return (int)blockIdx.x * 2 + vhalf(); }
DI int vgrid() { return (int)gridDim.x * 2; }
DI unsigned cvt_pk_bf16(float lo, float hi) { unsigned r; asm("v_cvt_pk_bf16_f32 %0, %1, %2" : "=v"(r) : "v"(lo), "v"(hi)); return r; }
DI bf16_t f2bf(float x) { return (bf16_t)(cvt_pk_bf16(x, 0.f) & 0xffffu); }
DI float bf2f(bf16_t b) { return __uint_as_float(((unsigned)b) << 16); }
DI unsigned pack2(float a, float b) { return cvt_pk_bf16(a, b); }
DI float bflo(unsigned u) { return __uint_as_float(u << 16); }
DI float bfhi(unsigned u) { return __uint_as_float(u & 0xffff0000u); }
DI void unpack8(const u32x4 r, float (&f)[8]) { f[0] = bflo(r[0]); f[1] = bfhi(r[0]); f[2] = bflo(r[1]); f[3] = bfhi(r[1]); f[4] = bflo(r[2]); f[5] = bfhi(r[2]); f[6] = bflo(r[3]); f[7] = bfhi(r[3]); }
DI u32x4 pack8(const float (&f)[8]) { u32x4 r; r[0] = pack2(f[0], f[1]); r[1] = pack2(f[2], f[3]); r[2] = pack2(f[4], f[5]); r[3] = pack2(f[6], f[7]); return r; }
DI float sigmoidf_(float x) { return __builtin_amdgcn_rcpf(1.f + __expf(-x)); }
DI float shfl_x(float v, int m) { const int lane = ptid() & 63; return __int_as_float(__builtin_amdgcn_ds_bpermute((lane ^ m) << 2, __float_as_int(v))); }
DI float wave_sum(float v) { for (int o = 32; o > 0; o >>= 1) v += shfl_x(v, o); return v; }
DI void tokinfo(int m, int& t, int& T, int& mi) { if (m < MC) { t = m & 255; T = 256; mi = 0; } else { int q = m - MC; t = q & 1023; T = 1024; mi = 1 + (q >> 10); } }

#define XB_TMO      128
#define XB_XCNT(j)  (256  + 64 * (j))
#define XB_XSUB(j)  (1280 + 64 * (j))
#define XB_XGEN(j)  (2304 + 64 * (j))
#define XB_TOP      3328
#define XB_TOPGEN   3392
#define XB_SPIN_CAP (1u << 20)
#define LAS __attribute__((address_space(3)))
DI unsigned xb_ld(unsigned* p) { return __hip_atomic_load(p, __ATOMIC_RELAXED, __HIP_MEMORY_SCOPE_AGENT); }
DI unsigned xb_add(unsigned* p, unsigned v) { return __hip_atomic_fetch_add(p, v, __ATOMIC_RELAXED, __HIP_MEMORY_SCOPE_AGENT); }
DI unsigned xb_xcc_id() { return (unsigned)__builtin_amdgcn_s_getreg((3 << 11) | 20) & 0xFu; }
#define XB_SPIN(cond, bar) do { unsigned _sp = 0; while (cond) { __builtin_amdgcn_s_sleep(1); \
    if ((++_sp & 255u) == 0u) { if (xb_ld(&(bar)[XB_TMO])) break; if (_sp > XB_SPIN_CAP) { atomicAdd(&(bar)[XB_TMO], 1u); break; } } } } while (0)
struct XcdBarrier { unsigned* bar; unsigned x; volatile LAS unsigned* st; };
DI XcdBarrier xcd_barrier_post(unsigned* bar, volatile LAS unsigned* st) {
  XcdBarrier b; b.bar = bar; b.x = xb_xcc_id(); b.st = st;
  if (ptid() == 0) (void)xb_add(&bar[XB_XCNT(b.x)], 1u);
  return b;
}
DI void xcd_barrier_complete(unsigned* bar, unsigned x, unsigned& nloc, unsigned& nx) {
  const unsigned G = gridDim.x * gridDim.y * gridDim.z;
  unsigned sum, cnt, mine, sp = 0u;
  for (;;) {
    sum = 0u; cnt = 0u; mine = 0u;
#pragma unroll
    for (unsigned j = 0; j < 16; ++j) { const unsigned c = xb_ld(&bar[XB_XCNT(j)]); sum += c; cnt += (c > 0u) ? 1u : 0u; mine = (j == x) ? c : mine; }
    if (sum == G) break;
    __builtin_amdgcn_s_sleep(1);
    if ((++sp & 255u) == 0u) { if (xb_ld(&bar[XB_TMO])) break; if (sp > XB_SPIN_CAP) { atomicAdd(&bar[XB_TMO], 1u); break; } }
  }
  nloc = mine > 0u ? mine : 1u; nx = cnt > 0u ? cnt : 1u;
}
DI void xcd_barrier(const XcdBarrier& b) {
  asm volatile("s_waitcnt vmcnt(0)" ::: "memory");
  __syncthreads();
  if (ptid() == 0) {
    unsigned* bar = b.bar;
    __builtin_amdgcn_s_waitcnt(0);
    unsigned nloc = b.st[0], nx = b.st[1];
    if (nloc == 0u) { xcd_barrier_complete(bar, b.x, nloc, nx); b.st[0] = nloc; b.st[1] = nx; }
    const unsigned old = xb_add(&bar[XB_XSUB(b.x)], 1u);
    const unsigned gen = old / nloc;
    if (old + 1u == (gen + 1u) * nloc) {
      __builtin_amdgcn_fence(__ATOMIC_RELEASE, "agent");
      asm volatile("s_waitcnt vmcnt(0)" ::: "memory");
      const unsigned og = xb_add(&bar[XB_TOP], 1u);
      const unsigned tg = og / nx;
      if (og + 1u == (tg + 1u) * nx) xb_add(&bar[XB_TOPGEN], 1u);
      else XB_SPIN(xb_ld(&bar[XB_TOPGEN]) == tg, bar);
      __builtin_amdgcn_fence(__ATOMIC_ACQUIRE, "agent");
      xb_add(&bar[XB_XGEN(b.x)], 1u);
      asm volatile("s_waitcnt vmcnt(0)" ::: "memory");
    } else {
      XB_SPIN(xb_ld(&bar[XB_XGEN(b.x)]) == gen, bar);
      __builtin_amdgcn_fence(__ATOMIC_ACQUIRE, "agent");
      asm volatile("s_waitcnt vmcnt(0)" ::: "memory");
    }
  }
  __syncthreads();
}

__device__ void convert_T(const float* __restrict__ W, int K, int N, bf16_t* __restrict__ Wt, int ldt, char* smem) {
  float* t = (float*)(smem + vhalf() * VSMEM);
  const int tid = tidx(), ntn = N >> 6, nitems = (K >> 6) * ntn;
  const int kr = tid >> 4, c4 = (tid & 15) * 4;
  f32x4 v[4];
  { const int it = vblk() < nitems ? vblk() : 0; const int k0 = (it / ntn) << 6, n0 = (it % ntn) << 6;
#pragma unroll
    for (int i = 0; i < 4; ++i) v[i] = *(const f32x4*)(W + (size_t)(k0 + kr + 16 * i) * N + n0 + c4); }
  for (int it = vblk(); it < nitems; it += vgrid()) {
    const int k0 = (it / ntn) << 6, n0 = (it % ntn) << 6;
    __syncthreads();
#pragma unroll
    for (int i = 0; i < 4; ++i) { const int k = kr + 16 * i; t[k * 65 + c4] = v[i][0]; t[k * 65 + c4 + 1] = v[i][1]; t[k * 65 + c4 + 2] = v[i][2]; t[k * 65 + c4 + 3] = v[i][3]; }
    __syncthreads();
    { const int itn = it + vgrid() < nitems ? it + vgrid() : it; const int k1 = (itn / ntn) << 6, n1 = (itn % ntn) << 6;
#pragma unroll
      for (int i = 0; i < 4; ++i) v[i] = *(const f32x4*)(W + (size_t)(k1 + kr + 16 * i) * N + n1 + c4); }
#pragma unroll
    for (int i = 0; i < 2; ++i) { const int c = tid + 256 * i, n = c >> 3, kc = c & 7; float f[8];
#pragma unroll
      for (int e = 0; e < 8; ++e) f[e] = t[(kc * 8 + e) * 65 + n];
      *(u32x4*)(Wt + (size_t)(n0 + n) * ldt + k0 + kc * 8) = pack8(f); }
  }
}

__device__ void ada_phase(const P& p, char* smem) {
  float* sc = (float*)(smem + vhalf() * VSMEM);
  float* red = sc + 640;
  float* mod = (float*)(p.ws + WS_MOD);
  const int tid = tidx(), kq = tid >> 5, cq = tid & 31;
  for (int it = vblk(); it < 2 * 48 * 8; it += vgrid()) {
    const int l = it / 384, rem = it % 384, nb = rem >> 3, ks = rem & 7;
    const int n0 = nb * 128, k0 = ks * 128;
    __syncthreads();
    for (int e = tid; e < 640; e += NT) { const int i = e >> 7, k = e & 127; const float v = (i == 0) ? p.c_ctx[k0 + k] : p.c[(i - 1) * D + k0 + k]; sc[e] = v * sigmoidf_(v); }
    __syncthreads();
    float acc[5][4];
#pragma unroll
    for (int i = 0; i < 5; ++i)
#pragma unroll
      for (int j = 0; j < 4; ++j) acc[i][j] = 0.f;
    const float* wp = p.ada_w + ((size_t)l * D + k0 + kq * 16) * 6144 + n0 + cq * 4;
#pragma unroll 4
    for (int kk = 0; kk < 16; ++kk) { const float4 w = *(const float4*)(wp + (size_t)kk * 6144);
#pragma unroll
      for (int i = 0; i < 5; ++i) { const float s = sc[i * 128 + kq * 16 + kk]; acc[i][0] += s * w.x; acc[i][1] += s * w.y; acc[i][2] += s * w.z; acc[i][3] += s * w.w; } }
#pragma unroll
    for (int i = 0; i < 5; ++i)
#pragma unroll
      for (int j = 0; j < 4; ++j) red[(kq * 5 + i) * 128 + cq * 4 + j] = acc[i][j];
    __syncthreads();
    for (int e = tid; e < 640; e += NT) { const int i = e >> 7, n = e & 127; float s = 0.f;
#pragma unroll
      for (int q = 0; q < 8; ++q) s += red[(q * 5 + i) * 128 + n];
      if (ks == 0) s += p.ada_b[l * 6144 + n0 + n];
      atomicAdd(mod + ((size_t)l * 5 + i) * 6144 + n0 + n, s); }
  }
}

__device__ void norm_phase(const P& p, const float* xin  , const bf16_t* u  , const float* gpost, const float* modU, int gate_idx,
                           float* xout, const float* gpre, const float* modN, int shift_idx, bf16_t* hout) {
  const int lane = tidx() & 63, wave = tidx() >> 6, nw = NT / 64;
  for (int m = vblk() * nw + wave; m < MT; m += vgrid() * nw) {
    int t, T, mi; tokinfo(m, t, T, mi);
    const float* xr = xin ? xin + (size_t)m * D : (m < MC ? p.x_prompt + (size_t)m * D : p.x_sample + (size_t)(m - MC) * D);
    float4 x[4];
#pragma unroll
    for (int i = 0; i < 4; ++i) x[i] = *(const float4*)(xr + i * 256 + lane * 4);
    if (u) {
      float4 uu[4]; float ss = 0.f;
#pragma unroll
      for (int i = 0; i < 4; ++i) { const u32x2 ur = *(const u32x2*)(u + (size_t)m * D + i * 256 + lane * 4); uu[i] = make_float4(bflo(ur.x), bfhi(ur.x), bflo(ur.y), bfhi(ur.y)); ss += uu[i].x * uu[i].x + uu[i].y * uu[i].y + uu[i].z * uu[i].z + uu[i].w * uu[i].w; }
      ss = wave_sum(ss); const float rs = rsqrtf(ss * (1.f / D) + 1e-6f);
#pragma unroll
      for (int i = 0; i < 4; ++i) { const int c = i * 256 + lane * 4; const float4 g = *(const float4*)(gpost + c); const float4 ga = *(const float4*)(modU + ((size_t)mi * 6 + gate_idx) * D + c);
        x[i].x += ga.x * uu[i].x * rs * g.x; x[i].y += ga.y * uu[i].y * rs * g.y; x[i].z += ga.z * uu[i].z * rs * g.z; x[i].w += ga.w * uu[i].w * rs * g.w; }
    }
    if (xout) {
#pragma unroll
      for (int i = 0; i < 4; ++i) *(float4*)(xout + (size_t)m * D + i * 256 + lane * 4) = x[i];
    }
    if (hout) {
      float ss = 0.f;
#pragma unroll
      for (int i = 0; i < 4; ++i) ss += x[i].x * x[i].x + x[i].y * x[i].y + x[i].z * x[i].z + x[i].w * x[i].w;
      ss = wave_sum(ss); const float rs = rsqrtf(ss * (1.f / D) + 1e-6f);
#pragma unroll
      for (int i = 0; i < 4; ++i) { const int c = i * 256 + lane * 4; const float4 g = *(const float4*)(gpre + c);
        const float4 sh = *(const float4*)(modN + ((size_t)mi * 6 + shift_idx) * D + c); const float4 sc = *(const float4*)(modN + ((size_t)mi * 6 + shift_idx + 1) * D + c);
        u32x2 o; o.x = pack2(x[i].x * rs * g.x * (1.f + sc.x) + sh.x, x[i].y * rs * g.y * (1.f + sc.y) + sh.y); o.y = pack2(x[i].z * rs * g.z * (1.f + sc.z) + sh.z, x[i].w * rs * g.w * (1.f + sc.w) + sh.w);
        *(u32x2*)(hout + (size_t)m * LDH + c) = o; }
    }
  }
}

struct TileSrc { const bf16_t* A; int lda; int arow0; const bf16_t* B; int ldb; int brow0, brow1; int K; };

template <int MM, int NN> DI void zero_acc(f32x4 (&acc)[MM][NN]) {
#pragma unroll
  for (int m = 0; m < MM; ++m)
#pragma unroll
    for (int n = 0; n < NN; ++n) acc[m][n] = (f32x4){0.f, 0.f, 0.f, 0.f};
}

template <int MM, int NN, int KU = 0> struct Gemm {
  static constexpr int NA = MM / 2, NB = NN;
  unsigned oa_[NA], ob_[NB]; const bf16_t* A; const bf16_t* B; int nk; u32x4 ra[NA], rb[NB];
#define GT_LOAD(KT) do { const int kn_ = ((KT) < nk ? (KT) : nk - 1) * 64; \
    _Pragma("unroll") for (int i = 0; i < NA; ++i) ra[i] = *(const u32x4*)(A + (oa_[i] + kn_)); \
    _Pragma("unroll") for (int i = 0; i < NB; ++i) rb[i] = *(const u32x4*)(B + (ob_[i] + kn_)); } while (0)
  DI void begin(const TileSrc& s, const bool perm = false) {
    const int tid = ptid();
#pragma unroll
    for (int i = 0; i < NA; ++i) { const int row = (tid >> 3) + 64 * i, kc = tid & 7;
      int ar = s.arow0 + row; ar = ar < 0 ? 0 : (ar > MT - 1 ? MT - 1 : ar);
      oa_[i] = (unsigned)ar * (unsigned)s.lda + kc * 8; }
#pragma unroll
    for (int i = 0; i < NB; ++i) { const int row = (tid >> 3) + 64 * i, kc = tid & 7;
      const int rr = perm ? ((row & ~31) | (8 * ((row & 15) >> 2) + 4 * ((row >> 4) & 1) + (row & 3))) : row;
      const int br = rr < 32 * NN ? s.brow0 + rr : s.brow1 + rr - 32 * NN;
      ob_[i] = (unsigned)br * (unsigned)s.ldb + kc * 8; }
    A = s.A; B = s.B; nk = s.K >> 6;
    GT_LOAD(0);
  }
  DI void run(f32x4 (&acc)[MM][NN], char* smem) {
    bf16_t* sbase = (bf16_t*)smem;
    const int tid = ptid(), lane = tid & 63, wave = tid >> 6, wr = wave >> 2, wc = wave & 3, fr = lane & 15, fq = lane >> 4;
    int wofs; { const int r = tid >> 3, kc = tid & 7, ob = (r & 15) * 64 + (kc & 3) * 16; wofs = (((r >> 4) * 2 + (kc >> 2)) * 1024 + (ob ^ (((ob >> 9) & 1) << 5))) >> 1; }
    int robase; { const int ob = fr * 64 + fq * 16; robase = (ob ^ (((ob >> 9) & 1) << 5)) >> 1; }
#define GT_STORE(ST) do { bf16_t* sA_ = sbase + (ST) * 32768; bf16_t* sB_ = sA_ + 16384; \
    _Pragma("unroll") for (int i = 0; i < NA; ++i) *(u32x4*)(sA_ + wofs + i * 4096) = ra[i]; \
    _Pragma("unroll") for (int i = 0; i < NB; ++i) *(u32x4*)(sB_ + wofs + i * 4096) = rb[i]; } while (0)
#define GT_KSTEP(ks) do { bf16x8 bfr[NN]; \
      _Pragma("unroll") for (int n = 0; n < NN; ++n) bfr[n] = *(const bf16x8*)(sB_ + ((wc * NN + n) * 2 + (ks)) * 512); \
      _Pragma("unroll") for (int m = 0; m < MM; ++m) { const bf16x8 af = *(const bf16x8*)(sA_ + ((wr * MM + m) * 2 + (ks)) * 512); \
        _Pragma("unroll") for (int n = 0; n < NN; ++n) acc[m][n] = MFMA16(bfr[n], af, acc[m][n]); } } while (0)
#define GT_COMPUTE(ST) do { const bf16_t* sA_ = sbase + (ST) * 32768 + robase; const bf16_t* sB_ = sA_ + 16384; __builtin_amdgcn_s_setprio(1); \
    if (KU) { GT_KSTEP(0); GT_KSTEP(1); } else { _Pragma("unroll 1") for (int ks = 0; ks < 2; ++ks) GT_KSTEP(ks); } \
    __builtin_amdgcn_s_setprio(0); } while (0)
    __syncthreads();
    GT_STORE(0);
    GT_LOAD(1);
    __syncthreads();
#pragma unroll 1
    for (int kt = 0; kt < nk; kt += 2) {
      GT_STORE(1); GT_LOAD(kt + 2); GT_COMPUTE(0); __syncthreads();
      GT_STORE(0); GT_LOAD(kt + 3); GT_COMPUTE(1); __syncthreads();
    }
  }
#undef GT_LOAD
#undef GT_STORE
#undef GT_COMPUTE
#undef GT_KSTEP
};
template <int MM, int NN> DI void gemm_tile(f32x4 (&acc)[MM][NN], const TileSrc& s, char* smem) { Gemm<MM, NN> g; g.begin(s); g.run(acc, smem); }

DI float gelu_tanh(float x) { const float u = 0.7978845608f * (x + 0.044715f * x * x * x); const float e = __expf(2.f * u); const float th = 1.f - 2.f * __builtin_amdgcn_rcpf(e + 1.f); return 0.5f * x * (1.f + th); }

struct TileIter {
  int m_lo, rows, NTn, G, efull, count, e, stride;
  DI void init(int MTn, int NTn_) { const int x = blockIdx.x & 7; m_lo = (x * MTn) >> 3; rows = (((x + 1) * MTn) >> 3) - m_lo; NTn = NTn_; G = (rows + 1) >> 1;
    efull = (rows / G) * G * NTn; count = rows * NTn; e = blockIdx.x >> 3; stride = gridDim.x >> 3; }
  DI bool next(int& mt, int& nt) { if (e >= count) return false;
    if (e < efull) { const int grp = e / (G * NTn), rem = e - grp * G * NTn; nt = rem / G; mt = m_lo + grp * G + (rem - nt * G); }
    else { const int rem = e - efull, gsz = rows - (rows / G) * G; nt = rem / gsz; mt = m_lo + (rows / G) * G + (rem - nt * gsz); }
    e += stride; return true; }
};

__device__ void phase_win(const P& p, int l, char* smem) {
  const bf16_t* H = (const bf16_t*)(p.ws + WS_H); const bf16_t* Wt = (const bf16_t*)(p.ws + WS_WIN);
  bf16_t* zr = (bf16_t*)(p.ws + WS_ZR); bf16_t* zn = (bf16_t*)(p.ws + WS_ZN); bf16_t* zt = (bf16_t*)(p.ws + WS_ZT);
  const int tid = ptid(), lane = tid & 63, wave = tid >> 6, wr = wave >> 2, wc = wave & 3, fr = lane & 15, fq = lane >> 4;
  Gemm<8, 4> gm;
  TileIter ti; ti.init(48, 14);
  const int x = blockIdx.x & 7, nconv = (343 - x + 7) >> 3, nloc = ti.count + nconv;
  const float* cw = p.rwkv_conv + (size_t)l * 3 * NZR;
  for (int e = (int)(blockIdx.x >> 3); e < nloc; e += (int)(gridDim.x >> 3)) {
    f32x4 acc[8][4]; zero_acc<8, 4>(acc);
    if (e < nconv) {
      const int c = x + 8 * e, mt = c / 7, nt = c - mt * 7;
      const int n0 = nt * 256, arow0 = mt * 254 - 1;
      { TileSrc s{H, LDH, arow0, Wt, LDH, n0, n0 + 128, D}; gm.begin(s); }
      gm.run(acc, smem);
      float* sC = (float*)smem;
#pragma unroll 1
      for (int sl = 0; sl < 2; ++sl) {
        __syncthreads();
        if ((wc >> 1) == sl) {
#pragma unroll
          for (int m = 0; m < 8; ++m)
#pragma unroll
            for (int n = 0; n < 4; ++n) *(f32x4*)(sC + (wr * 128 + m * 16 + fr) * 132 + (wc & 1) * 64 + n * 16 + fq * 4) = acc[m][n];
        }
        __syncthreads();
        const int nb = n0 + sl * 128, c8 = (tid & 15) * 8;
        const f32x4 w0a = *(const f32x4*)(cw + nb + c8), w0b = *(const f32x4*)(cw + nb + c8 + 4), w1a = *(const f32x4*)(cw + NZR + nb + c8), w1b = *(const f32x4*)(cw + NZR + nb + c8 + 4),
                    w2a = *(const f32x4*)(cw + 2 * NZR + nb + c8), w2b = *(const f32x4*)(cw + 2 * NZR + nb + c8 + 4);
        const bool sg = nb + c8 >= 1664;
        for (int ee = tid; ee < 254 * 16; ee += NTP) {
          const int tr = 1 + (ee >> 4), g = arow0 + tr;
          if (g < MT) { int t, T, mi; tokinfo(g, t, T, mi);
            const float pm = t > 0 ? 1.f : 0.f, nm = t < T - 1 ? 1.f : 0.f;
            const float* r0 = sC + (tr - 1) * 132 + c8; const float* r1 = r0 + 132; const float* r2 = r1 + 132;
            f32x4 ya = (*(const f32x4*)r0 * w0a) * pm + *(const f32x4*)r1 * w1a + (*(const f32x4*)r2 * w2a) * nm;
            f32x4 yb = (*(const f32x4*)(r0 + 4) * w0b) * pm + *(const f32x4*)(r1 + 4) * w1b + (*(const f32x4*)(r2 + 4) * w2b) * nm;
            if (sg) {
#pragma unroll
              for (int j = 0; j < 4; ++j) { ya[j] = sigmoidf_(ya[j]); yb[j] = sigmoidf_(yb[j]); } }
            const u32x4 o = {pack2(ya[0], ya[1]), pack2(ya[2], ya[3]), pack2(yb[0], yb[1]), pack2(yb[2], yb[3])};
            *(u32x4*)(zr + (size_t)g * NZR + nb + c8) = o; }
        }
      }
    } else {
      int mt, nt; ti.e = e - nconv; ti.next(mt, nt);
      const int n0 = nt * 256, row0 = mt * 256;
      { TileSrc s{H, LDH, row0, Wt, LDH, NZR + n0, NZR + n0 + 128, D}; gm.begin(s, true); }
      gm.run(acc, smem);
#pragma unroll
      for (int m = 0; m < 8; ++m) { const int row = row0 + wr * 128 + m * 16 + fr;
#pragma unroll
        for (int g = 0; g < 2; ++g) { const int col = n0 + wc * 64 + g * 32 + fq * 8; const f32x4 v0 = acc[m][2 * g], v1 = acc[m][2 * g + 1];
          const u32x4 o = {pack2(v0[0], v0[1]), pack2(v0[2], v0[3]), pack2(v1[0], v1[1]), pack2(v1[2], v1[3])};
          if (col < NZN) {
            *(u32x4*)(zn + (size_t)row * NZN + col) = o;
            if (row < MC && col >= 512) { const int part = col - 512, isv = part >> 9, pp = part & 511, hh = pp >> 6, d = pp & 63, b = row >> 8, t = row & 255;
              float* dst = p.out + (isv ? O_V : O_K) + ((((size_t)b * 2 + l) * 8 + hh) * 256 + t) * 64 + d; *(f32x4*)dst = v0; *(f32x4*)(dst + 4) = v1; }
          } else { *(u32x4*)(zt + (size_t)row * LZT + (col - NZN)) = o; }
        } }
    }
  }
}

__device__ void phase_merge(const P& p, char* smem) {
  const bf16_t* H = (const bf16_t*)(p.ws + WS_H); const bf16_t* Wt = (const bf16_t*)(p.ws + WS_WIN); const bf16_t* Wo3 = (const bf16_t*)(p.ws + WS_WO3);
  bf16_t* mg = (bf16_t*)(p.ws + WS_MERGED);
  const int tid = ptid(), lane = tid & 63, wave = tid >> 6, wr = wave >> 2, wc = wave & 3, fr = lane & 15, fq = lane >> 4;
  TileIter ti; int mt, nt; ti.init(64, 8);
  while (ti.next(mt, nt)) {
    const int n0 = nt * 128, row0 = mt * 192;
    f32x4 macc[6][2]; zero_acc<6, 2>(macc);
#pragma unroll 1
    for (int i = 0; i < 3; ++i) {
      const bf16_t* O = (const bf16_t*)(p.ws + (i == 0 ? WS_OA : (i == 1 ? WS_ONA : WS_ORET)));
      f32x4 g[6][2]; zero_acc<6, 2>(g);
      { TileSrc s{H, LDH, row0, Wt, LDH, 5376 + i * 1024 + n0, 5376 + i * 1024 + n0 + 64, D}; { Gemm<6, 2, 1> gm; gm.begin(s, true); gm.run(g, smem); } }
      f32x4 a2[6][2]; zero_acc<6, 2>(a2);
      { TileSrc s{O, LDO, row0, Wo3 + (size_t)i * 1024 * LDO, LDO, n0, n0 + 64, 512}; { Gemm<6, 2, 1> gm; gm.begin(s, true); gm.run(a2, smem); } }
#pragma unroll
      for (int m = 0; m < 6; ++m)
#pragma unroll
        for (int n = 0; n < 2; ++n)
#pragma unroll
          for (int j = 0; j < 4; ++j) macc[m][n][j] += sigmoidf_(g[m][n][j]) * a2[m][n][j];
    }
#pragma unroll
    for (int m = 0; m < 6; ++m) { const int row = row0 + wr * 96 + m * 16 + fr;
      { const int col = n0 + wc * 32 + fq * 8; const u32x4 o = {pack2(macc[m][0][0], macc[m][0][1]), pack2(macc[m][0][2], macc[m][0][3]), pack2(macc[m][1][0], macc[m][1][1]), pack2(macc[m][1][2], macc[m][1][3])}; *(u32x4*)(mg + (size_t)row * LDH + col) = o; } }
  }
}

DI void phase_gemm_f32(const bf16_t* A, int lda, int K, const bf16_t* Bt, int ldb, bf16_t* C, char* smem) {
  const int tid = ptid(), lane = tid & 63, wave = tid >> 6, wr = wave >> 2, wc = wave & 3, fr = lane & 15, fq = lane >> 4;
  TileIter ti; int mt, nt; ti.init(64, 4);
  while (ti.next(mt, nt)) {
    const int n0 = nt * 256, row0 = mt * 192;
    f32x4 acc[6][4]; zero_acc<6, 4>(acc);
    TileSrc s{A, lda, row0, Bt, ldb, n0, n0 + 128, K}; { Gemm<6, 4, GEMM_F32_KU> gm; gm.begin(s, true); gm.run(acc, smem); }
#pragma unroll
    for (int m = 0; m < 6; ++m) { const int row = row0 + wr * 96 + m * 16 + fr;
#pragma unroll
      for (int g = 0; g < 2; ++g) { const f32x4 v0 = acc[m][2 * g], v1 = acc[m][2 * g + 1]; *(u32x4*)(C + (size_t)row * D + n0 + wc * 64 + g * 32 + fq * 8) = (u32x4){pack2(v0[0], v0[1]), pack2(v0[2], v0[3]), pack2(v1[0], v1[1]), pack2(v1[2], v1[3])}; } }
  }
}

__device__ void phase_ffn_up(const P& p, int l, char* smem) {
  const bf16_t* H = (const bf16_t*)(p.ws + WS_H); const bf16_t* Wt = (const bf16_t*)(p.ws + WS_WUP); bf16_t* hid = (bf16_t*)(p.ws + WS_HID);
  const int tid = ptid(), lane = tid & 63, wave = tid >> 6, wr = wave >> 2, wc = wave & 3, fr = lane & 15, fq = lane >> 4;
  const float* cw = p.ffn_conv + (size_t)l * 3 * 2 * FF;
  Gemm<6, 4, FFN_UP_KU> gm;
  for (int it = blockIdx.x; it < 65 * 22; it += gridDim.x) {
    const int mt = it / 22, nt = it - mt * 22;
    const int c0 = nt * 128, arow0 = mt * 190 - 1;
    f32x4 acc[6][4]; zero_acc<6, 4>(acc);
    { TileSrc s{H, LDH, arow0, Wt, LDH, c0, FF + c0, D}; gm.begin(s); }
    gm.run(acc, smem);
    float* sC = (float*)smem;
#pragma unroll 1
    for (int sl = 0; sl < 2; ++sl) {
      __syncthreads();
      if ((wc & 1) == sl) { const int cb = (wc >> 1) * 64;
#pragma unroll
        for (int m = 0; m < 6; ++m)
#pragma unroll
          for (int n = 0; n < 4; ++n) *(f32x4*)(sC + (wr * 96 + m * 16 + fr) * 132 + cb + n * 16 + fq * 4) = acc[m][n];
      }
      __syncthreads();
      const int cq = c0 + sl * 64, c4 = (tid & 15) * 4;
      const f32x4 v0 = *(const f32x4*)(cw + cq + c4), v1 = *(const f32x4*)(cw + 2 * FF + cq + c4), v2 = *(const f32x4*)(cw + 4 * FF + cq + c4);
      const f32x4 g0 = *(const f32x4*)(cw + FF + cq + c4), g1 = *(const f32x4*)(cw + 3 * FF + cq + c4), g2 = *(const f32x4*)(cw + 5 * FF + cq + c4);
      for (int e = tid; e < 190 * 16; e += NTP) {
        const int tr = 1 + (e >> 4), g = arow0 + tr;
        if (g < MT) { int t, T, mi; tokinfo(g, t, T, mi);
          const float pm = t > 0 ? 1.f : 0.f, nm = t < T - 1 ? 1.f : 0.f;
          const f32x4 va = *(const f32x4*)(sC + (tr - 1) * 132 + c4), vb = *(const f32x4*)(sC + tr * 132 + c4), vc = *(const f32x4*)(sC + (tr + 1) * 132 + c4);
          const f32x4 ga = *(const f32x4*)(sC + (tr - 1) * 132 + 64 + c4), gb = *(const f32x4*)(sC + tr * 132 + 64 + c4), gc = *(const f32x4*)(sC + (tr + 1) * 132 + 64 + c4);
          float r[4];
#pragma unroll
          for (int j = 0; j < 4; ++j) { const float val = pm * va[j] * v0[j] + vb[j] * v1[j] + nm * vc[j] * v2[j]; const float gt = pm * ga[j] * g0[j] + gb[j] * g1[j] + nm * gc[j] * g2[j]; r[j] = gelu_tanh(gt) * val; }
          u32x2 o; o.x = pack2(r[0], r[1]); o.y = pack2(r[2], r[3]);
          *(u32x2*)(hid + (size_t)g * FF + cq + c4) = o; }
      }
    }
  }
}

template <int CTRL> DI float dppf(float v) { return __int_as_float(__builtin_amdgcn_mov_dpp(__float_as_int(v), CTRL, 0xF, 0xF, true)); }
DI float row16_sum(float v) { v += dppf<0xB1>(v); v += dppf<0x4E>(v); v += dppf<0x141>(v); v += dppf<0x140>(v); return v; }

DI float frcp(float x) { return __builtin_amdgcn_rcpf(x); }
DI float fsig(float x) { return frcp(1.f + __expf(-x)); }
__device__ void scan_task(const P& p, int l, int seq, int h, int d, int half, char* smem) {
  float* sR = (float*)smem; float* sW = sR + 1024; float* sKD = sW + 1024; float* sB = sKD + 1024; float* sNK = sB + 1024; float* sV = sNK + 1024; float* sK = sV + 1024; float* sY = sK + 1024;
  float* sKn = sY + 2048; float* sKK = sKn + 16; bf16_t* sWT = (bf16_t*)(sKK + 64); bf16_t* sAL = sWT + 16 * LDT;
  const int tid = tidx(), lane = tid & 63, wave = tid >> 6, fr = lane & 15, fq = lane >> 4;
  const int row0 = seq < 32 ? seq * 256 : MC + (seq - 32) * 1024, T = seq < 32 ? 256 : 1024, nch = T >> 4;
  const bf16_t* zr = (const bf16_t*)(p.ws + WS_ZR);
  float* yout = (float*)(p.ws + WS_Y) + (size_t)d * MT * 512;
  __syncthreads();
  if (tid < 64) sKK[tid] = p.rwkv_k_k[l * 512 + h * 64 + tid];
  const int cc = wave * 16 + fr, gc = h * 64 + cc;
  bf16x8 bw[2], ba[2];
#pragma unroll
  for (int ks = 0; ks < 2; ++ks)
#pragma unroll
    for (int e = 0; e < 8; ++e) { const int k = ks * 32 + fq * 8 + e;
      bw[ks][e] = (short)f2bf(p.rwkv_w_up[((size_t)(l * 2 + d) * 64 + k) * 512 + gc]); ba[ks][e] = (short)f2bf(p.rwkv_a_up[((size_t)(l * 2 + d) * 64 + k) * 512 + gc]); }
  const float w0c = p.rwkv_w0[(l * 2 + d) * 512 + gc], a0c = p.rwkv_a0[(l * 2 + d) * 512 + gc], kac = p.rwkv_k_a[l * 512 + gc];
  const int rg = tid >> 4, kq = tid & 15, rbase = half * 32 + rg * 2;
  f32x2 S[2][2];
  if (seq >= 32) { const float* s0 = p.state_rwkv + (((((size_t)(seq - 32) * 2 + l) * 2 + d) * 8 + h) * 64 + rbase) * 64 + kq * 4;
#pragma unroll
    for (int r = 0; r < 2; ++r) { const f32x4 x = *(const f32x4*)(s0 + r * 64); S[r][0] = (f32x2){x[0], x[1]}; S[r][1] = (f32x2){x[2], x[3]}; } }
  else {
#pragma unroll
    for (int r = 0; r < 2; ++r) { S[r][0] = (f32x2){0.f, 0.f}; S[r][1] = (f32x2){0.f, 0.f}; } }
  if (seq >= 32) __builtin_amdgcn_s_setprio(2);
  const int at = (tid & 127) >> 3, apart = tid & 7, ahi = tid >> 7;
  size_t coff[3];
  { const int sb0 = ahi ? 512 + h * 64 : h * 64, sb1 = ahi ? 1536 : 1024 + h * 64, sb2 = 1600;
    coff[0] = (size_t)at * NZR + sb0 + apart * 8; coff[1] = (size_t)at * NZR + sb1 + apart * 8; coff[2] = (size_t)at * NZR + sb2 + apart * 8; }
  u32x4 pre[3];
  { const int t0 = (d ? nch - 1 : 0) * 16;
#pragma unroll
    for (int i = 0; i < 3; ++i) pre[i] = *(const u32x4*)(zr + (size_t)(row0 + t0) * NZR + coff[i]); }
  __syncthreads();
  for (int ci = 0; ci < nch; ++ci) {
    const int chunk = d ? nch - 1 - ci : ci, t0 = chunk * 16;
    { const int o = at * 64 + apart * 8; float f[8];
      unpack8(pre[0], f);
      if (ahi == 0) { *(f32x4*)(sR + o) = (f32x4){f[0], f[1], f[2], f[3]}; *(f32x4*)(sR + o + 4) = (f32x4){f[4], f[5], f[6], f[7]}; }
      else { *(f32x4*)(sK + o) = (f32x4){f[0], f[1], f[2], f[3]}; *(f32x4*)(sK + o + 4) = (f32x4){f[4], f[5], f[6], f[7]}; float ps = 0.f;
#pragma unroll
        for (int e = 0; e < 8; ++e) { const float kk = f[e] * sKK[apart * 8 + e]; ps += kk * kk; }
        ps += dppf<0xB1>(ps); ps += dppf<0x4E>(ps); ps += dppf<0x141>(ps);
        if (apart == 0) sKn[at] = ps; }
      unpack8(pre[1], f);
      if (ahi == 0) { *(f32x4*)(sV + o) = (f32x4){f[0], f[1], f[2], f[3]}; *(f32x4*)(sV + o + 4) = (f32x4){f[4], f[5], f[6], f[7]}; }
      else { float g[8];
#pragma unroll
        for (int e = 0; e < 8; ++e) g[e] = 1.f - 2.f * frcp(__expf(2.f * f[e]) + 1.f);
        *(u32x4*)(sWT + at * LDT + apart * 8) = pack8(g); }
      if (ahi == 0) *(u32x4*)(sAL + at * LDT + apart * 8) = pre[2];
    }
    __syncthreads();
    {
      f32x4 aw = {0.f, 0.f, 0.f, 0.f}, aa = {0.f, 0.f, 0.f, 0.f};
#pragma unroll
      for (int ks = 0; ks < 2; ++ks) { const bf16x8 fw = *(const bf16x8*)(sWT + fr * LDT + ks * 32 + fq * 8); const bf16x8 fa = *(const bf16x8*)(sAL + fr * LDT + ks * 32 + fq * 8);
        aw = MFMA16(fw, bw[ks], aw); aa = MFMA16(fa, ba[ks], aa); }
      const float kkc = sKK[cc];
#pragma unroll
      for (int j = 0; j < 4; ++j) { const int t = fq * 4 + j, o = t * 64 + cc;
        const float dec = __expf(-0.6065306597f * fsig(w0c + aw[j]));
        const float a = fsig(a0c + aa[j]);
        const float kv = sK[o];
        const float kkv = kv * kkc * __builtin_amdgcn_rsqf(fmaxf(sKn[t], 1e-24f));
        sW[o] = dec; sKD[o] = kv * (1.f + (a - 1.f) * kac); sB[o] = kkv * a; sNK[o] = -kkv; }
    }
    __syncthreads();
    { const int cn = ci + 1 < nch ? ci + 1 : ci; const int nt0 = (d ? nch - 1 - cn : cn) * 16;
#pragma unroll
      for (int i = 0; i < 3; ++i) pre[i] = *(const u32x4*)(zr + (size_t)(row0 + nt0) * NZR + coff[i]); }
#pragma unroll 8
    for (int si = 0; si < 16; ++si) {
      const int t = d ? 15 - si : si, o = t * 64 + kq * 4;
      const f32x4 an4 = *(const f32x4*)(sNK + o), w4 = *(const f32x4*)(sW + o), b4 = *(const f32x4*)(sB + o), kd4 = *(const f32x4*)(sKD + o), r4 = *(const f32x4*)(sR + o);
      const f32x2 v2 = *(const f32x2*)(sV + t * 64 + rbase);
      const f32x2 an[2] = {{an4[0], an4[1]}, {an4[2], an4[3]}}, wv[2] = {{w4[0], w4[1]}, {w4[2], w4[3]}}, bv[2] = {{b4[0], b4[1]}, {b4[2], b4[3]}}, kd[2] = {{kd4[0], kd4[1]}, {kd4[2], kd4[3]}}, rv[2] = {{r4[0], r4[1]}, {r4[2], r4[3]}};
      float sa[2];
#pragma unroll
      for (int r = 0; r < 2; ++r) { const f32x2 t2 = S[r][0] * an[0] + S[r][1] * an[1]; sa[r] = row16_sum(t2.x + t2.y); }
      f32x2 yv;
#pragma unroll
      for (int r = 0; r < 2; ++r) { const f32x2 sav = {sa[r], sa[r]}, vvv = {v2[r], v2[r]};
        S[r][0] = S[r][0] * wv[0] + (sav * bv[0] + vvv * kd[0]); S[r][1] = S[r][1] * wv[1] + (sav * bv[1] + vvv * kd[1]);
        const f32x2 y2 = S[r][0] * rv[0] + S[r][1] * rv[1]; float yp = y2.x + y2.y; yp += dppf<0xB1>(yp); yp += dppf<0x4E>(yp); yv[r] = yp; }
      if ((kq & 3) == 0) { sY[((t * 32 + rg * 2) * 4) + (kq >> 2)] = yv[0]; sY[((t * 32 + rg * 2 + 1) * 4) + (kq >> 2)] = yv[1]; }
    }
    __syncthreads();
    { const int t = tid >> 4, lr = (tid & 15) * 2; const f32x4 p0 = *(const f32x4*)(sY + (t * 32 + lr) * 4), p1 = *(const f32x4*)(sY + (t * 32 + lr + 1) * 4);
      *(f32x2*)(yout + (size_t)(row0 + t0 + t) * 512 + h * 64 + half * 32 + lr) = (f32x2){p0[0] + p0[1] + p0[2] + p0[3], p1[0] + p1[1] + p1[2] + p1[3]}; }
  }
  __builtin_amdgcn_s_setprio(0);
  if (seq < 32) { float* so = p.out + O_RW + (((((size_t)seq * 2 + l) * 2 + d) * 8 + h) * 64 + rbase) * 64 + kq * 4;
#pragma unroll
    for (int r = 0; r < 2; ++r) *(f32x4*)(so + r * 64) = (f32x4){S[r][0].x, S[r][0].y, S[r][1].x, S[r][1].y}; }
}

DI void qk_scores(const bf16_t* sK, const bf16x8 (&qf)[2], f32x4 (&sacc)[4], int fr, int fq) {
#pragma unroll
  for (int nt = 0; nt < 4; ++nt) { sacc[nt] = (f32x4){0.f, 0.f, 0.f, 0.f};
#pragma unroll
    for (int ks = 0; ks < 2; ++ks) { const bf16x8 kf = *(const bf16x8*)(sK + (nt * 16 + fr) * LDT + ks * 32 + fq * 8); sacc[nt] = MFMA16(kf, qf[ks], sacc[nt]); } }
}
DI void pv_accum(const bf16_t* sVt, const f32x4 (&pacc)[4], f32x4 (&o)[4], int fr, int fq) {
#pragma unroll
  for (int s = 0; s < 2; ++s) {
    bf16x8 pf; { const unsigned a = pack2(pacc[2 * s][0], pacc[2 * s][1]), b = pack2(pacc[2 * s][2], pacc[2 * s][3]), c = pack2(pacc[2 * s + 1][0], pacc[2 * s + 1][1]), dd = pack2(pacc[2 * s + 1][2], pacc[2 * s + 1][3]);
      const u32x4 u = (u32x4){a, b, c, dd}; pf = __builtin_bit_cast(bf16x8, u); }
#pragma unroll
    for (int dt = 0; dt < 4; ++dt) { const u32x2 lo = *(const u32x2*)(sVt + (dt * 16 + fr) * LDT + 32 * s + 4 * fq), hi = *(const u32x2*)(sVt + (dt * 16 + fr) * LDT + 32 * s + 16 + 4 * fq);
      const u32x4 u = (u32x4){lo[0], lo[1], hi[0], hi[1]}; const bf16x8 vf = __builtin_bit_cast(bf16x8, u); o[dt] = MFMA16(vf, pf, o[dt]); }
  }
}
DI void put_kv(bf16_t* sK, bf16_t* sVt, int key, int part, const float (&kf)[8], int vkey, int vpart, const float (&vf)[8]) {
  *(u32x4*)(sK + key * LDT + part * 8) = pack8(kf);
#pragma unroll
  for (int e = 0; e < 8; ++e) sVt[(vpart * 8 + e) * LDT + vkey] = f2bf(vf[e]);
}
DI void softmax_tile(f32x4 (&sacc)[4], f32x4 (&o)[4], float& mrun, float& lrun) {
  float mx = sacc[0][0];
#pragma unroll
  for (int nt = 0; nt < 4; ++nt)
#pragma unroll
    for (int j = 0; j < 4; ++j) mx = fmaxf(mx, sacc[nt][j]);
  mx = fmaxf(mx, shfl_x(mx, 16)); mx = fmaxf(mx, shfl_x(mx, 32));
  const float mnew = fmaxf(mrun, mx), alpha = __builtin_amdgcn_exp2f(mrun - mnew); mrun = mnew;
  float ls = 0.f;
#pragma unroll
  for (int nt = 0; nt < 4; ++nt)
#pragma unroll
    for (int j = 0; j < 4; ++j) { const float pv = __builtin_amdgcn_exp2f(sacc[nt][j] - mnew); sacc[nt][j] = pv; ls += pv; }
  lrun = lrun * alpha + ls;
#pragma unroll
  for (int dt = 0; dt < 4; ++dt) o[dt] *= alpha;
}
constexpr float LOG2E = 1.4426950408889634f;

__device__ void dense_task(const P& p, int b, int h, int qb, char* smem) {
  bf16_t* sK = (bf16_t*)smem; bf16_t* sVt = sK + 64 * LDT;
  const int tid = tidx(), lane = tid & 63, wave = tid >> 6, fr = lane & 15, fq = lane >> 4;
  const bf16_t* zn = (const bf16_t*)(p.ws + WS_ZN); bf16_t* ona = (bf16_t*)(p.ws + WS_ONA);
  const int qrow = b * 256 + qb * 64 + wave * 16 + fr;
  bf16x8 qf[2];
#pragma unroll
  for (int ks = 0; ks < 2; ++ks) qf[ks] = *(const bf16x8*)(zn + (size_t)qrow * NZN + h * 64 + ks * 32 + fq * 8);
  f32x4 o[4]; for (int dt = 0; dt < 4; ++dt) o[dt] = (f32x4){0.f, 0.f, 0.f, 0.f};
  float mrun = -1e30f, lrun = 0.f;
  u32x4 pk[2], pv[2];
#pragma unroll
  for (int i = 0; i < 2; ++i) { const int c = tid + 256 * i, key = c >> 3, part = c & 7, vkey = c & 63, vpart = c >> 6; pk[i] = *(const u32x4*)(zn + (size_t)(b * 256 + key) * NZN + h * 64 + part * 8 + 512); pv[i] = *(const u32x4*)(zn + (size_t)(b * 256 + vkey) * NZN + h * 64 + vpart * 8 + 1024); }
  for (int kt = 0; kt < 4; ++kt) {
    __syncthreads();
#pragma unroll
    for (int i = 0; i < 2; ++i) { const int c = tid + 256 * i, key = c >> 3, part = c & 7, vkey = c & 63, vpart = c >> 6;
      *(u32x4*)(sK + key * LDT + part * 8) = pk[i];
#pragma unroll
      for (int e = 0; e < 4; ++e) { sVt[(vpart * 8 + 2 * e) * LDT + vkey] = (bf16_t)(pv[i][e] & 0xffffu); sVt[(vpart * 8 + 2 * e + 1) * LDT + vkey] = (bf16_t)(pv[i][e] >> 16); } }
    __syncthreads();
    { const int kn = kt < 3 ? kt + 1 : 3;
#pragma unroll
      for (int i = 0; i < 2; ++i) { const int c = tid + 256 * i, key = c >> 3, part = c & 7, vkey = c & 63, vpart = c >> 6; pk[i] = *(const u32x4*)(zn + (size_t)(b * 256 + kn * 64 + key) * NZN + h * 64 + part * 8 + 512); pv[i] = *(const u32x4*)(zn + (size_t)(b * 256 + kn * 64 + vkey) * NZN + h * 64 + vpart * 8 + 1024); } }
    f32x4 sacc[4]; qk_scores(sK, qf, sacc, fr, fq);
#pragma unroll
    for (int nt = 0; nt < 4; ++nt) sacc[nt] *= (0.125f * LOG2E);
    softmax_tile(sacc, o, mrun, lrun);
    pv_accum(sVt, sacc, o, fr, fq);
  }
  lrun += shfl_x(lrun, 16); lrun += shfl_x(lrun, 32); const float inv = 1.f / lrun;
#pragma unroll
  for (int dt = 0; dt < 4; ++dt) { u32x2 ov; ov.x = pack2(o[dt][0] * inv, o[dt][1] * inv); ov.y = pack2(o[dt][2] * inv, o[dt][3] * inv); *(u32x2*)(ona + (size_t)qrow * LDO + h * 64 + dt * 16 + fq * 4) = ov; }
}

__device__ void na_task(const P& p, int l, int b, int h, int r, char* smem) {
  bf16_t* sK = (bf16_t*)smem; bf16_t* sVt = sK + 64 * LDT; float* sRpb = (float*)(sVt + 64 * LDT);
  const int tid = tidx(), lane = tid & 63, wave = tid >> 6, fr = lane & 15, fq = lane >> 4;
  const bf16_t* zn = (const bf16_t*)(p.ws + WS_ZN); bf16_t* ona = (bf16_t*)(p.ws + WS_ONA);
  const int base = MC + b * 1024, qcol = wave * 16 + fr, qrow = base + r * 64 + qcol;
  int rs = r - 4; rs = rs < 0 ? 0 : (rs > 8 ? 8 : rs);
  int cs = qcol - 8; cs = cs < 0 ? 0 : (cs > 48 ? 48 : cs);
  __syncthreads();
  for (int e = tid; e < 465; e += NT) sRpb[e] = p.na_rpb[((size_t)l * 8 + h) * 465 + e] * LOG2E;
  bf16x8 qf[2];
#pragma unroll
  for (int ks = 0; ks < 2; ++ks) qf[ks] = *(const bf16x8*)(zn + (size_t)qrow * NZN + h * 64 + ks * 32 + fq * 8);
  f32x4 o[4]; for (int dt = 0; dt < 4; ++dt) o[dt] = (f32x4){0.f, 0.f, 0.f, 0.f};
  float mrun = -1e30f, lrun = 0.f;
  u32x4 pre[8];
#define NA_ISSUE(KT) do { const int kt_ = (KT); \
    if (kt_ < 8) { _Pragma("unroll") for (int i = 0; i < 2; ++i) { const int c = tid + 256 * i, key = c >> 3, part = c & 7, vkey = c & 63, vpart = c >> 6; \
        pre[4 * i] = *(const u32x4*)(zn + (size_t)(base + (rs + kt_) * 64 + key) * NZN + h * 64 + part * 8 + 512); pre[4 * i + 1] = *(const u32x4*)(zn + (size_t)(base + (rs + kt_) * 64 + vkey) * NZN + h * 64 + vpart * 8 + 1024); } } \
    else { _Pragma("unroll") for (int i = 0; i < 2; ++i) { const int c = tid + 256 * i, key = c >> 3, part = c & 7, vkey = c & 63, vpart = c >> 6; const size_t cb_ = (((size_t)b * 2 + l) * 8 + h) * 256 + (kt_ - 8) * 64; const size_t co = (cb_ + key) * 64 + part * 8, cv = (cb_ + vkey) * 64 + vpart * 8; \
        pre[4 * i] = *(const u32x4*)(p.cache_k + co); pre[4 * i + 1] = *(const u32x4*)(p.cache_k + co + 4); pre[4 * i + 2] = *(const u32x4*)(p.cache_v + cv); pre[4 * i + 3] = *(const u32x4*)(p.cache_v + cv + 4); } } } while (0)
  NA_ISSUE(0);
  for (int kt = 0; kt < 12; ++kt) {
    __syncthreads();
    if (kt < 8) {
#pragma unroll
      for (int i = 0; i < 2; ++i) { const int c = tid + 256 * i, key = c >> 3, part = c & 7, vkey = c & 63, vpart = c >> 6;
        *(u32x4*)(sK + key * LDT + part * 8) = pre[4 * i];
#pragma unroll
        for (int e = 0; e < 4; ++e) { sVt[(vpart * 8 + 2 * e) * LDT + vkey] = (bf16_t)(pre[4 * i + 1][e] & 0xffffu); sVt[(vpart * 8 + 2 * e + 1) * LDT + vkey] = (bf16_t)(pre[4 * i + 1][e] >> 16); } }
    } else {
#pragma unroll
      for (int i = 0; i < 2; ++i) { const int c = tid + 256 * i, key = c >> 3, part = c & 7, vkey = c & 63, vpart = c >> 6;
        const f32x4 k0 = __builtin_bit_cast(f32x4, pre[4 * i]), k1 = __builtin_bit_cast(f32x4, pre[4 * i + 1]), v0 = __builtin_bit_cast(f32x4, pre[4 * i + 2]), v1 = __builtin_bit_cast(f32x4, pre[4 * i + 3]);
        const float kf[8] = {k0[0], k0[1], k0[2], k0[3], k1[0], k1[1], k1[2], k1[3]}; const float vf[8] = {v0[0], v0[1], v0[2], v0[3], v1[0], v1[1], v1[2], v1[3]};
        put_kv(sK, sVt, key, part, kf, vkey, vpart, vf); }
    }
    __syncthreads();
    NA_ISSUE(kt < 11 ? kt + 1 : 11);
    f32x4 sacc[4]; qk_scores(sK, qf, sacc, fr, fq);
    if (kt < 8) { const int dr = rs + kt - r + 7;
#pragma unroll
      for (int nt = 0; nt < 4; ++nt)
#pragma unroll
        for (int j = 0; j < 4; ++j) { const int kc = nt * 16 + fq * 4 + j; const bool valid = kc >= cs && kc < cs + 16; int dc = kc - qcol; dc = dc < -15 ? -15 : (dc > 15 ? 15 : dc);
          sacc[nt][j] = valid ? sacc[nt][j] * (0.125f * LOG2E) + sRpb[dr * 31 + dc + 15] : -1e30f; }
    } else {
#pragma unroll
      for (int nt = 0; nt < 4; ++nt) sacc[nt] *= (0.125f * LOG2E);
    }
    softmax_tile(sacc, o, mrun, lrun);
    pv_accum(sVt, sacc, o, fr, fq);
  }
#undef NA_ISSUE
  lrun += shfl_x(lrun, 16); lrun += shfl_x(lrun, 32); const float inv = 1.f / lrun;
#pragma unroll
  for (int dt = 0; dt < 4; ++dt) { u32x2 ov; ov.x = pack2(o[dt][0] * inv, o[dt][1] * inv); ov.y = pack2(o[dt][2] * inv, o[dt][3] * inv); *(u32x2*)(ona + (size_t)qrow * LDO + h * 64 + dt * 16 + fq * 4) = ov; }
}

DI void rope8(const float (&own)[8], const float (&par)[8], int part, int n, float (&out)[8]) {
  const float pos = (float)((part >> 2) ? (n & 63) : (n >> 6));
  const bool isx2 = (part & 3) >= 2;
#pragma unroll
  for (int e = 0; e < 8; ++e) { const int i = (part & 1) * 8 + e; const float ang = pos * __builtin_amdgcn_exp2f(-(float)i * 0.830482023721841f); const float sn = __sinf(ang), cs = __cosf(ang);
    out[e] = isx2 ? par[e] * sn + own[e] * cs : own[e] * cs - par[e] * sn; }
}

DI void rope8t(const float (&own)[8], const float (&par)[8], int part, int n, const float* tab, float (&out)[8]) {
  const int pos = (part >> 2) ? (n & 63) : (n >> 6);
  const bool isx2 = (part & 3) >= 2;
  const float* tb = tab + (pos * 16 + (part & 1) * 8) * 2;
#pragma unroll
  for (int e = 0; e < 8; e += 2) { const f32x4 cssn = *(const f32x4*)(tb + 2 * e);
    out[e] = isx2 ? par[e] * cssn[1] + own[e] * cssn[0] : own[e] * cssn[0] - par[e] * cssn[1];
    out[e + 1] = isx2 ? par[e + 1] * cssn[3] + own[e + 1] * cssn[2] : own[e + 1] * cssn[2] - par[e + 1] * cssn[3]; }
}

__device__ void ret_task(const P& p, int l, int seq, int h, int qb, char* smem) {
  bf16_t* sK = (bf16_t*)smem; bf16_t* sVt = sK + 64 * LDT; bf16_t* sQ = sVt + 64 * LDT; float* sRope = (float*)(sQ + 64 * LDT);
  const int tid = tidx(), lane = tid & 63, wave = tid >> 6, fr = lane & 15, fq = lane >> 4;
  const bf16_t* zt = (const bf16_t*)(p.ws + WS_ZT); bf16_t* oret = (bf16_t*)(p.ws + WS_ORET);
  const bool lat = seq >= 32;
  const int row0 = lat ? MC + (seq - 32) * 1024 : seq * 256, T = lat ? 1024 : 256, nkt = T >> 6;
  const float xf = p.ret_decay[(l * 2 + 0) * 8 + h], xb = p.ret_decay[(l * 2 + 1) * 8 + h];
  const float lgf = -log1pf(__expf(-xf)) * LOG2E, lgb = -log1pf(__expf(-xb)) * LOG2E;
  __syncthreads();
  if (lat) {
#pragma unroll
    for (int j = 0; j < 4; ++j) { const int e = tid + 256 * j; const float ang = (float)(e >> 4) * __builtin_amdgcn_exp2f(-(float)(e & 15) * 0.830482023721841f); sRope[2 * e] = __cosf(ang); sRope[2 * e + 1] = __sinf(ang); }
    __syncthreads();
  }
#pragma unroll
  for (int i = 0; i < 2; ++i) { const int c = tid + 256 * i, qi = c >> 3, part = c & 7; const int n = qb * 64 + qi; const size_t ro = (size_t)(row0 + n) * LZT + h * 64;
    const u32x4 own = *(const u32x4*)(zt + ro + part * 8);
    if (lat) { const u32x4 par = *(const u32x4*)(zt + ro + (part ^ 2) * 8); float fo[8], fp[8], out[8]; unpack8(own, fo); unpack8(par, fp); rope8t(fo, fp, part, n, sRope, out); *(u32x4*)(sQ + qi * LDT + part * 8) = pack8(out); }
    else *(u32x4*)(sQ + qi * LDT + part * 8) = own; }
  __syncthreads();
  const int qi = wave * 16 + fr, nq = qb * 64 + qi;
  bf16x8 qf[2];
#pragma unroll
  for (int ks = 0; ks < 2; ++ks) qf[ks] = *(const bf16x8*)(sQ + qi * LDT + ks * 32 + fq * 8);
  f32x4 o[4]; for (int dt = 0; dt < 4; ++dt) o[dt] = (f32x4){0.f, 0.f, 0.f, 0.f};
  u32x4 rk[2], rp[2], rv[2];
#define RET_ISSUE(KT) do { _Pragma("unroll") for (int i = 0; i < 2; ++i) { const int c = tid + 256 * i, key = c >> 3, part = c & 7, vkey = c & 63, vpart = c >> 6; const size_t ro = (size_t)(row0 + (KT) * 64 + key) * LZT + h * 64; \
    rk[i] = *(const u32x4*)(zt + ro + 512 + part * 8); rp[i] = *(const u32x4*)(zt + ro + 512 + (part ^ 2) * 8); rv[i] = *(const u32x4*)(zt + (size_t)(row0 + (KT) * 64 + vkey) * LZT + h * 64 + 1024 + vpart * 8); } } while (0)
  RET_ISSUE(0);
  for (int kt = 0; kt < nkt; ++kt) {
    __syncthreads();
#pragma unroll
    for (int i = 0; i < 2; ++i) { const int c = tid + 256 * i, key = c >> 3, part = c & 7, vkey = c & 63, vpart = c >> 6; const int n = kt * 64 + key;
      float kf[8]; unpack8(rk[i], kf);
      if (lat) { float fp[8], out[8]; unpack8(rp[i], fp); rope8t(kf, fp, part, n, sRope, out);
#pragma unroll
        for (int e = 0; e < 8; ++e) kf[e] = out[e]; }
#pragma unroll
      for (int e = 0; e < 8; ++e) kf[e] *= 0.125f;
      *(u32x4*)(sK + key * LDT + part * 8) = pack8(kf);
#pragma unroll
      for (int e = 0; e < 4; ++e) { sVt[(vpart * 8 + 2 * e) * LDT + vkey] = (bf16_t)(rv[i][e] & 0xffffu); sVt[(vpart * 8 + 2 * e + 1) * LDT + vkey] = (bf16_t)(rv[i][e] >> 16); } }
    __syncthreads();
    RET_ISSUE(kt + 1 < nkt ? kt + 1 : kt);
    f32x4 sacc[4]; qk_scores(sK, qf, sacc, fr, fq);
#pragma unroll
    for (int nt = 0; nt < 4; ++nt)
#pragma unroll
      for (int j = 0; j < 4; ++j) { const int mk = kt * 64 + nt * 16 + fq * 4 + j; const int df = nq - mk;
        const float ex = __builtin_amdgcn_exp2f((df > 0 ? lgf : -lgb) * (float)df); sacc[nt][j] *= (df == 0 ? 2.f : ex); }
    pv_accum(sVt, sacc, o, fr, fq);
  }
#undef RET_ISSUE
  if (lat) {
    for (int dir = 0; dir < 2; ++dir) {
      __syncthreads();
      const float* s0 = p.state_ret + ((((size_t)(seq - 32) * 2 + l) * 2 + dir) * 8 + h) * 4096;
#pragma unroll
      for (int i = 0; i < 2; ++i) { const int c = tid + 256 * i, dk = c & 63, part = c >> 6; const float4 a = *(const float4*)(s0 + dk * 64 + part * 8), bq = *(const float4*)(s0 + dk * 64 + part * 8 + 4);
        const float vf[8] = {a.x, a.y, a.z, a.w, bq.x, bq.y, bq.z, bq.w};
#pragma unroll
        for (int e = 0; e < 8; ++e) sVt[(part * 8 + e) * LDT + dk] = f2bf(vf[e]); }
      __syncthreads();
      const float xi = dir == 0 ? exp2f(lgf * (float)(nq + 1)) : exp2f(lgb * (float)(T - nq));
      f32x4 pacc[4];
#pragma unroll
      for (int s = 0; s < 2; ++s)
#pragma unroll
        for (int hh = 0; hh < 2; ++hh)
#pragma unroll
          for (int j = 0; j < 4; ++j) pacc[2 * s + hh][j] = xi * bf2f(sQ[qi * LDT + 32 * s + 16 * hh + 4 * fq + j]);
      pv_accum(sVt, pacc, o, fr, fq);
    }
  }
  float s1 = 0.f;
#pragma unroll
  for (int dt = 0; dt < 4; ++dt)
#pragma unroll
    for (int j = 0; j < 4; ++j) s1 += o[dt][j];
  s1 += shfl_x(s1, 16); s1 += shfl_x(s1, 32); const float mu = s1 * (1.f / 64.f);
  float s2 = 0.f;
#pragma unroll
  for (int dt = 0; dt < 4; ++dt)
#pragma unroll
    for (int j = 0; j < 4; ++j) { const float dlt = o[dt][j] - mu; s2 += dlt * dlt; }
  s2 += shfl_x(s2, 16); s2 += shfl_x(s2, 32); const float rstd = rsqrtf(s2 * (1.f / 64.f) + 1e-5f);
  const size_t qrow = (size_t)(row0 + nq);
#pragma unroll
  for (int dt = 0; dt < 4; ++dt) { const int dv = h * 64 + dt * 16 + fq * 4; const u32x2 gr = *(const u32x2*)(zt + qrow * LZT + 1536 + dv); const float4 gn = *(const float4*)(p.ret_gn + l * 512 + dv);
    const float g0 = bflo(gr.x), g1 = bfhi(gr.x), g2 = bflo(gr.y), g3 = bfhi(gr.y);
    u32x2 ov; ov.x = pack2((o[dt][0] - mu) * rstd * gn.x * g0 * sigmoidf_(g0), (o[dt][1] - mu) * rstd * gn.y * g1 * sigmoidf_(g1));
    ov.y = pack2((o[dt][2] - mu) * rstd * gn.z * g2 * sigmoidf_(g2), (o[dt][3] - mu) * rstd * gn.w * g3 * sigmoidf_(g3));
    *(u32x2*)(oret + qrow * LDO + dv) = ov; }
}

__device__ void retstate_task(const P& p, int l, int b, int h, char* smem) {
  float* sKf = (float*)smem; float* sKb = sKf + 64 * 64; float* sV = sKb + 64 * 64;
  const int tid = tidx(), dk = tid >> 2, dq = tid & 3;
  const bf16_t* zt = (const bf16_t*)(p.ws + WS_ZT);
  const float xf = p.ret_decay[(l * 2 + 0) * 8 + h], xb = p.ret_decay[(l * 2 + 1) * 8 + h];
  const float lgf = -log1pf(__expf(-xf)) * LOG2E, lgb = -log1pf(__expf(-xb)) * LOG2E;
  float af[16], ab[16];
#pragma unroll
  for (int i = 0; i < 16; ++i) { af[i] = 0.f; ab[i] = 0.f; }
  for (int kt = 0; kt < 4; ++kt) {
    __syncthreads();
#pragma unroll
    for (int i = 0; i < 2; ++i) { const int c = tid + 256 * i, key = c >> 3, part = c & 7, m = kt * 64 + key; const size_t ro = (size_t)(b * 256 + m) * LZT + h * 64 + part * 8;
      float kf[8], vf[8]; unpack8(*(const u32x4*)(zt + ro + 512), kf); unpack8(*(const u32x4*)(zt + ro + 1024), vf);
      const float wf = 0.125f * exp2f(lgf * (float)(255 - m)), wb = 0.125f * exp2f(lgb * (float)m);
#pragma unroll
      for (int e = 0; e < 8; ++e) { sKf[key * 64 + part * 8 + e] = kf[e] * wf; sKb[key * 64 + part * 8 + e] = kf[e] * wb; sV[key * 64 + part * 8 + e] = vf[e]; } }
    __syncthreads();
    for (int m = 0; m < 64; ++m) { const float kf = sKf[m * 64 + dk], kb = sKb[m * 64 + dk];
#pragma unroll
      for (int i = 0; i < 4; ++i) { const f32x4 vv = *(const f32x4*)(sV + m * 64 + dq * 16 + i * 4);
#pragma unroll
        for (int j = 0; j < 4; ++j) { af[i * 4 + j] += kf * vv[j]; ab[i * 4 + j] += kb * vv[j]; } } }
  }
  float* of = p.out + O_RT + ((((size_t)b * 2 + l) * 2 + 0) * 8 + h) * 4096 + dk * 64 + dq * 16; float* ob = of + 8 * 4096;
#pragma unroll
  for (int i = 0; i < 16; ++i) { of[i] = af[i]; ob[i] = ab[i]; }
}

constexpr int Q_SCAN_L = 64, Q_SCAN_C = 512, Q_RET_L = 256, Q_NA = 256, Q_DENSE = 512, Q_RET_C = 512, Q_RST = 128;
template <int QMASK> __device__ void phase_mixers(const P& p, int l, char* smem_, int rep = 0) {
  __shared__ int s_task;
  int* ctr = (int*)(p.ws + WS_CTRL) + 64 * (l + 1) + 4 * rep;
  const int vb = vhalf(); char* smem = smem_ + vb * VSMEM;
  if (QMASK & 1) for (;;) {
    __syncthreads();
    if (ptid() == 0) s_task = atomicAdd(ctr, 1);
    __syncthreads();
    const int tk = s_task;
    if (tk >= Q_SCAN_L + Q_SCAN_C) break;
    const bool lat = tk < Q_SCAN_L; const int t2 = lat ? tk : tk - Q_SCAN_L;
    scan_task(p, l, (lat ? 32 : 0) + (t2 >> 4), (t2 >> 1) & 7, t2 & 1, vb, smem);
  }
  if (QMASK & 2) for (;;) {
    __syncthreads();
    if (ptid() == 0) s_task = atomicAdd(ctr + 16, 1);
    __syncthreads();
    const int tk = s_task;
    if (tk >= Q_RET_L + Q_RET_C) break;
    if (tk < Q_RET_L) ret_task(p, l, 32 + (tk >> 6), (tk >> 3) & 7, (tk & 7) * 2 + vb, smem);
    else { const int t2 = tk - Q_RET_L; ret_task(p, l, t2 >> 4, (t2 >> 1) & 7, (t2 & 1) * 2 + vb, smem); }
  }
  if (QMASK & 4) for (;;) {
    __syncthreads();
    if (ptid() == 0) s_task = atomicAdd(ctr + 32, 1);
    __syncthreads();
    int tk = s_task;
    if (tk >= Q_NA + Q_DENSE + Q_RST) break;
    if (tk < Q_NA) { na_task(p, l, tk >> 6, (tk >> 3) & 7, (tk & 7) * 2 + vb, smem); continue; } tk -= Q_NA;
    if (tk < Q_DENSE) { dense_task(p, tk >> 4, (tk >> 1) & 7, (tk & 1) * 2 + vb, smem); continue; } tk -= Q_DENSE;
    retstate_task(p, l, tk >> 2, (tk & 3) * 2 + vb, smem);
  }
}

__device__ void phase_rwkv_post(const P& p, int l, char* smem) {
  const bf16_t* zr = (const bf16_t*)(p.ws + WS_ZR); const float* yf = (const float*)(p.ws + WS_Y); const float* yb = yf + (size_t)MT * 512; bf16_t* oa = (bf16_t*)(p.ws + WS_OA);
  const bf16_t* Gt = (const bf16_t*)(p.ws + WS_WG);
  const int tid = ptid(), lane = tid & 63, wave = tid >> 6, wr = wave >> 2, wc = wave & 3, fr = lane & 15, fq = lane >> 4;
  TileIter ti; int mt, nt; ti.init(96, 2);
  while (ti.next(mt, nt)) {
    const int row0 = mt * 128, n0 = nt * 256;
    f32x4 acc[4][4]; zero_acc<4, 4>(acc);
    TileSrc s{zr + 1664, NZR, row0, Gt, LDG, n0, n0 + 128, 128}; { Gemm<4, 4, 1> gm; gm.begin(s, true); gm.run(acc, smem); }
    const int cb = n0 + wc * 64 + fq * 8;
#pragma unroll
    for (int m = 0; m < 4; ++m) { const size_t row = (size_t)(row0 + wr * 64 + m * 16 + fr);
      f32x4 y[4]; float s1 = 0.f, rk = 0.f; f32x4 vv[4];
#pragma unroll
      for (int n = 0; n < 4; ++n) { const int c = cb + 32 * (n >> 1) + 4 * (n & 1); y[n] = *(const f32x4*)(yf + row * 512 + c) + *(const f32x4*)(yb + row * 512 + c); s1 += y[n][0] + y[n][1] + y[n][2] + y[n][3];
        const u32x2 rr = *(const u32x2*)(zr + row * NZR + c), kk = *(const u32x2*)(zr + row * NZR + 512 + c), v2 = *(const u32x2*)(zr + row * NZR + 1024 + c); const f32x4 rkw = *(const f32x4*)(p.rwkv_r_k + l * 512 + c);
        rk += bflo(rr.x) * bflo(kk.x) * rkw[0] + bfhi(rr.x) * bfhi(kk.x) * rkw[1] + bflo(rr.y) * bflo(kk.y) * rkw[2] + bfhi(rr.y) * bfhi(kk.y) * rkw[3];
        vv[n] = (f32x4){bflo(v2.x), bfhi(v2.x), bflo(v2.y), bfhi(v2.y)}; }
      s1 += shfl_x(s1, 16); s1 += shfl_x(s1, 32); rk += shfl_x(rk, 16); rk += shfl_x(rk, 32);
      const float mu = s1 * (1.f / 64.f); float s2 = 0.f;
#pragma unroll
      for (int n = 0; n < 4; ++n)
#pragma unroll
        for (int j = 0; j < 4; ++j) { const float dl = y[n][j] - mu; s2 += dl * dl; }
      s2 += shfl_x(s2, 16); s2 += shfl_x(s2, 32); const float rstd = rsqrtf(s2 * (1.f / 64.f) + 64e-5f);
#pragma unroll
      for (int n = 0; n < 4; ++n) { const int c = cb + 32 * (n >> 1) + 4 * (n & 1); const f32x4 lg = *(const f32x4*)(p.rwkv_ln_g + l * 512 + c), lb = *(const f32x4*)(p.rwkv_ln_b + l * 512 + c);
        float o[4];
#pragma unroll
        for (int j = 0; j < 4; ++j) o[j] = ((y[n][j] - mu) * rstd * lg[j] + lb[j] + rk * vv[n][j]) * acc[m][n][j];
        u32x2 ov; ov.x = pack2(o[0], o[1]); ov.y = pack2(o[2], o[3]); *(u32x2*)(oa + row * LDO + c) = ov; }
    }
  }
}

DI void convert_layer_a(const P& p, int l, char* smem) {
  convert_T(p.w_in + (size_t)l * D * INC, D, INC, (bf16_t*)(p.ws + WS_WIN), LDH, smem);
  convert_T(p.w_o_rwkv + (size_t)l * 512 * D, 512, D, (bf16_t*)(p.ws + WS_WO3), LDO, smem);
  convert_T(p.w_o_na + (size_t)l * 512 * D, 512, D, (bf16_t*)(p.ws + WS_WO3) + (size_t)1024 * LDO, LDO, smem);
  convert_T(p.w_o_ret + (size_t)l * 512 * D, 512, D, (bf16_t*)(p.ws + WS_WO3) + (size_t)2 * 1024 * LDO, LDO, smem);
  convert_T(p.w_out + (size_t)l * D * D, D, D, (bf16_t*)(p.ws + WS_WOUT), LDH, smem);
  convert_T(p.rwkv_g_up + (size_t)l * 128 * 512, 128, 512, (bf16_t*)(p.ws + WS_WG), LDG, smem);
}
DI void convert_layer_b(const P& p, int l, char* smem) {
  convert_T(p.ffn_up + (size_t)l * D * 2 * FF, D, 2 * FF, (bf16_t*)(p.ws + WS_WUP), LDH, smem);
  convert_T(p.ffn_down + (size_t)l * FF * D, FF, D, (bf16_t*)(p.ws + WS_WDN), FF, smem);
}

typedef __attribute__((address_space(4))) const P* KP;
DI KP kargs() { KP k = (KP)__builtin_amdgcn_kernarg_segment_ptr(); asm volatile("" : "+s"(k)); return k; }
template <int PH> DI void run_phase(int l, char* smem) {
#if defined(__HIP_DEVICE_COMPILE__)
  const P p = *kargs();
#else
  const P p{};
#endif
  const float* mod = (const float*)(p.ws + WS_MOD);
  float* xbuf = p.out;
  if (PH == 0) { ada_phase(p, smem); convert_layer_a(p, 0, smem); }
  else if (PH == 1) { norm_phase(p, nullptr, nullptr, nullptr, nullptr, 0, nullptr, p.norm_mix_pre, mod, 0, (bf16_t*)(p.ws + WS_H)); }
  else if (PH == 2) phase_win(p, l, smem);
  else if (PH == 4) phase_mixers<7>(p, l, smem);
  else if (PH == 5) phase_rwkv_post(p, l, smem);
  else if (PH == 6) phase_merge(p, smem);
  else if (PH == 7) { phase_gemm_f32((const bf16_t*)(p.ws + WS_MERGED), LDH, D, (const bf16_t*)(p.ws + WS_WOUT), LDH, (bf16_t*)(p.ws + WS_U), smem); }
  else if (PH == 8) { convert_layer_b(p, l, smem);
    norm_phase(p, l == 0 ? nullptr : xbuf, (const bf16_t*)(p.ws + WS_U), p.norm_mix_post + l * D, mod + (size_t)l * 5 * 6144, 2, xbuf, p.norm_ffn_pre + l * D, mod + (size_t)l * 5 * 6144, 3, (bf16_t*)(p.ws + WS_H)); }
  else if (PH == 9) phase_ffn_up(p, l, smem);
  else if (PH == 11) { phase_gemm_f32((const bf16_t*)(p.ws + WS_HID), FF, FF, (const bf16_t*)(p.ws + WS_WDN), FF, (bf16_t*)(p.ws + WS_F), smem); }
  else if (PH == 12) {
    if (l == 0) { norm_phase(p, xbuf, (const bf16_t*)(p.ws + WS_F), p.norm_ffn_post, mod, 5, xbuf, p.norm_mix_pre + D, mod + (size_t)5 * 6144, 0, (bf16_t*)(p.ws + WS_H)); convert_layer_a(p, 1, smem); }
    else norm_phase(p, xbuf, (const bf16_t*)(p.ws + WS_F), p.norm_ffn_post + D, mod + (size_t)5 * 6144, 5, xbuf, nullptr, nullptr, 0, nullptr);
  }
}

#if MEGA
__global__ void __launch_bounds__(NTP, 1) mega_kernel(P p_) {
  extern __shared__ __attribute__((aligned(16))) char smem[];
  __shared__ u32x4 xb_words;
  cg::grid_group grid = cg::this_grid();
  if (ptid() == 0) xb_words = (u32x4){0u, 0u, 0u, 0u};
  __syncthreads();
#if defined(__HIP_DEVICE_COMPILE__)
  (void)xcd_barrier_post((unsigned*)(p_.ws + WS_BAR), (volatile LAS unsigned*)&xb_words);
#define GSYNC() do { XcdBarrier xb_; xb_.bar = (unsigned*)(kargs()->ws + WS_BAR); xb_.x = xb_xcc_id(); xb_.st = (volatile LAS unsigned*)&xb_words; xcd_barrier(xb_); } while (0)
#else
#define GSYNC() do { } while (0)
#endif
  run_phase<0>(0, smem); grid.sync();
  run_phase<1>(0, smem); GSYNC();
#pragma unroll
  for (int l = 0; l < 2; ++l) {
    run_phase<2>(l, smem); GSYNC();
    if (PROBE_MASK & 1) { run_phase<2>(l, smem); GSYNC(); }
    run_phase<4>(l, smem); GSYNC();
    run_phase<5>(l, smem); GSYNC();
    run_phase<6>(l, smem); GSYNC();
    if (PROBE_MASK & 8) { run_phase<6>(l, smem); GSYNC(); }
    run_phase<7>(l, smem); GSYNC();
    if (PROBE_MASK & 16) { run_phase<7>(l, smem); GSYNC(); }
    run_phase<8>(l, smem); GSYNC();
    run_phase<9>(l, smem); GSYNC();
    if (PROBE_MASK & 32) { run_phase<9>(l, smem); GSYNC(); }
    run_phase<11>(l, smem); GSYNC();
    if (PROBE_MASK & 64) { run_phase<11>(l, smem); GSYNC(); }
    run_phase<12>(l, smem); if (l == 0) GSYNC();
  }
#undef GSYNC
}
#else
template <int PH> __global__ void __launch_bounds__(NTP, 1) phase_kernel(P p, int l) {
  extern __shared__ __attribute__((aligned(16))) char smem[];
  run_phase<PH>(l, smem);
}
#endif

extern "C" void kernel_launch(void* const* d_in, const int* in_sizes, int n_in, void* d_out, int out_size, void* d_ws, size_t ws_size, hipStream_t stream) {
  if (ws_size < WS_END || n_in < 36) { fprintf(stderr, "workspace too small: %zu < %zu\n", ws_size, (size_t)WS_END); return; }
  P p{};
  const float** pp = (const float**)&p;
  for (int i = 0; i < 36; ++i) pp[i] = (const float*)d_in[i];
  p.out = (float*)d_out; p.ws = (char*)d_ws;
  hipMemsetAsync(d_ws, 0, WS_WIN, stream);
#if MEGA
  static int grid_blocks = 0;
  if (!grid_blocks) {
    int dev = 0, cus = 0, per_cu = 0; hipGetDevice(&dev);
    hipDeviceGetAttribute(&cus, hipDeviceAttributeMultiprocessorCount, dev);
    hipFuncSetAttribute((const void*)mega_kernel, hipFuncAttributeMaxDynamicSharedMemorySize, SMEM_BYTES);
    hipOccupancyMaxActiveBlocksPerMultiprocessor(&per_cu, mega_kernel, NTP, SMEM_BYTES);
    if (per_cu > 1) per_cu = 1;
    grid_blocks = cus * per_cu;
  }
  void* args[] = {&p};
  hipError_t e = hipLaunchCooperativeKernel((void*)mega_kernel, dim3(grid_blocks), dim3(NTP), args, SMEM_BYTES, stream);
  if (e != hipSuccess) fprintf(stderr, "cooperative launch failed: %s (grid %d)\n", hipGetErrorString(e), grid_blocks);
#else
  const int G = 512;
#define LAUNCH(PH, L) do { hipFuncSetAttribute((const void*)phase_kernel<PH>, hipFuncAttributeMaxDynamicSharedMemorySize, SMEM_BYTES); phase_kernel<PH><<<G, NT, SMEM_BYTES, stream>>>(p, L); } while (0)
  LAUNCH(0, 0); LAUNCH(1, 0);
  for (int l = 0; l < 2; ++l) { LAUNCH(2, l); LAUNCH(4, l); LAUNCH(5, l); LAUNCH(6, l); LAUNCH(7, l); LAUNCH(8, l); LAUNCH(9, l); LAUNCH(11, l); LAUNCH(12, l); }
#endif
}
```

```cpp
#include <hip/hip_runtime.h>
#include <hip/hip_cooperative_groups.h>
#include <cstdio>
namespace cg = cooperative_groups;

#ifndef MEGA
#define MEGA 1
#endif
#define PROBE_MASK 0
#define GEMM_F32_KU 1
#define FFN_UP_KU 1

typedef unsigned short bf16_t;
typedef short bf16x8 __attribute__((ext_vector_type(8)));
typedef short bf16x4 __attribute__((ext_vector_type(4)));
typedef float f32x4 __attribute__((ext_vector_type(4)));
typedef float f32x2 __attribute__((ext_vector_type(2)));
typedef unsigned u32x4 __attribute__((ext_vector_type(4)));
typedef unsigned u32x2 __attribute__((ext_vector_type(2)));
#define DI __device__ __forceinline__
#define MFMA16(a, b, c) __builtin_amdgcn_mfma_f32_16x16x32_bf16((a), (b), (c), 0, 0, 0)

constexpr int NT = 256;
constexpr int NTP = 512;
constexpr int VSMEM = 65536;
constexpr int D = 1024, MC = 8192, ML = 4096, MT = 12288;
constexpr int NZR = 1792, NZN = 1536, NZT = 2048, INC = 8448, FF = 2816;
constexpr int LDH = 1088, LDO = 576, LZT = 2112, LDG = 136;
constexpr int LDT = 72;
constexpr int SMEM_BYTES = 139264;
constexpr int SMEM_BYTES_GEMM_ = 131072;
constexpr size_t O_K = 12582912, O_V = 20971520, O_RW = 29360128, O_RT = 33554432;
constexpr size_t WS_CTRL = 0;
constexpr size_t WS_MOD = 4096;
constexpr size_t WS_BAR = 262144;
constexpr size_t WS_CUF = 278528;
constexpr size_t WS_WG = 294912;
constexpr size_t WS_WIN = 434176;
constexpr size_t WS_WUP = WS_WIN;
constexpr size_t WS_WDN = WS_WIN + (size_t)5632 * LDH * 2;
constexpr size_t WS_WO3 = WS_WIN + (size_t)INC * LDH * 2;
constexpr size_t WS_WOUT = WS_WO3 + (size_t)3 * 1024 * LDO * 2;
constexpr size_t WS_H = WS_WOUT + (size_t)1024 * LDH * 2;
constexpr size_t WS_Z = WS_H + (size_t)MT * LDH * 2;
constexpr size_t WS_ZR = WS_Z;
constexpr size_t WS_ZN = WS_ZR + (size_t)MT * NZR * 2;
constexpr size_t WS_ZT = WS_ZN + (size_t)MT * NZN * 2;
constexpr size_t WS_MERGED = WS_ZR;
constexpr size_t WS_OA = WS_ZN;
constexpr size_t WS_U = WS_ZT;
constexpr size_t WS_HID = WS_Z;
constexpr size_t WS_F = WS_ZT;
constexpr size_t WS_Y = WS_ZT + (size_t)MT * LZT * 2;
constexpr size_t WS_ONA = WS_Y + (size_t)2 * MT * 512 * 4;
constexpr size_t WS_ORET = WS_ONA + (size_t)MT * LDO * 2;
constexpr size_t WS_END = WS_ORET + (size_t)MT * LDO * 2;

struct P {
  const float *x_prompt, *x_sample, *cache_k, *cache_v, *state_rwkv, *state_ret, *c, *c_ctx, *ada_w, *ada_b;
  const float *norm_mix_pre, *norm_mix_post, *norm_ffn_pre, *norm_ffn_post, *w_in, *rwkv_conv, *rwkv_w0, *rwkv_w_up, *rwkv_a0, *rwkv_a_up, *rwkv_g_up;
  const float *rwkv_k_k, *rwkv_k_a, *rwkv_r_k, *rwkv_ln_g, *rwkv_ln_b, *na_rpb, *ret_decay, *ret_gn, *w_o_rwkv, *w_o_na, *w_o_ret, *w_out, *ffn_up, *ffn_conv, *ffn_down;
  float* out; char* ws;
};

DI int threadIdx_x_raw() { return (int)__builtin_amdgcn_workitem_id_x(); }
DI int ptid() { int t = threadIdx_x_raw(); asm volatile("" : "+v"(t)); return t; }
DI int tidx() { return ptid() & 255; }
DI int vhalf() { return ptid() >> 8; }
DI int vblk() { return (int)blockIdx.x * 2 + vhalf(); }
DI int vgrid() { return (int)gridDim.x * 2; }
DI unsigned cvt_pk_bf16(float lo, float hi) { unsigned r; asm("v_cvt_pk_bf16_f32 %0, %1, %2" : "=v"(r) : "v"(lo), "v"(hi)); return r; }
DI bf16_t f2bf(float x) { return (bf16_t)(cvt_pk_bf16(x, 0.f) & 0xffffu); }
DI float bf2f(bf16_t b) { return __uint_as_float(((unsigned)b) << 16); }
DI unsigned pack2(float a, float b) { return cvt_pk_bf16(a, b); }
DI float bflo(unsigned u) { return __uint_as_float(u << 16); }
DI float bfhi(unsigned u) { return __uint_as_float(u & 0xffff0000u); }
DI void unpack8(const u32x4 r, float (&f)[8]) { f[0] = bflo(r[0]); f[1] = bfhi(r[0]); f[2] = bflo(r[1]); f[3] = bfhi(r[1]); f[4] = bflo(r[2]); f[5] = bfhi(r[2]); f[6] = bflo(r[3]); f[7] = bfhi(r[3]); }
DI u32x4 pack8(const float (&f)[8]) { u32x4 r; r[0] = pack2(f[0], f[1]); r[1] = pack2(f[2], f[3]); r[2] = pack2(f[4], f[5]); r[3] = pack2(f[6], f[7]); return r; }
DI float sigmoidf_(float x) { return __builtin_amdgcn_rcpf(1.f + __expf(-x)); }
DI float shfl_x(float v, int m) { const int lane = ptid() & 63; return __int_as_float(__builtin_amdgcn_ds_bpermute((lane ^ m) << 2, __float_as_int(v))); }
DI float wave_sum(float v) { for (int o = 32; o > 0; o >>= 1) v += shfl_x(v, o); return v; }
DI void tokinfo(int m, int& t, int& T, int& mi) { if (m < MC) { t = m & 255; T = 256; mi = 0; } else { int q = m - MC; t = q & 1023; T = 1024; mi = 1 + (q >> 10); } }

#define XB_TMO      128
#define XB_XCNT(j)  (256  + 64 * (j))
#define XB_XSUB(j)  (1280 + 64 * (j))
#define XB_XGEN(j)  (2304 + 64 * (j))
#define XB_TOP      3328
#define XB_TOPGEN   3392
#define XB_SPIN_CAP (1u << 20)
#define LAS __attribute__((address_space(3)))
DI unsigned xb_ld(unsigned* p) { return __hip_atomic_load(p, __ATOMIC_RELAXED, __HIP_MEMORY_SCOPE_AGENT); }
DI unsigned xb_add(unsigned* p, unsigned v) { return __hip_atomic_fetch_add(p, v, __ATOMIC_RELAXED, __HIP_MEMORY_SCOPE_AGENT); }
DI unsigned xb_xcc_id() { return (unsigned)__builtin_amdgcn_s_getreg((3 << 11) | 20) & 0xFu; }
#define XB_SPIN(cond, bar) do { unsigned _sp = 0; while (cond) { __builtin_amdgcn_s_sleep(1); \
    if ((++_sp & 255u) == 0u) { if (xb_ld(&(bar)[XB_TMO])) break; if (_sp > XB_SPIN_CAP) { atomicAdd(&(bar)[XB_TMO], 1u); break; } } } } while (0)
struct XcdBarrier { unsigned* bar; unsigned x; volatile LAS unsigned* st; };
DI XcdBarrier xcd_barrier_post(unsigned* bar, volatile LAS unsigned* st) {
  XcdBarrier b; b.bar = bar; b.x = xb_xcc_id(); b.st = st;
  if (ptid() == 0) (void)xb_add(&bar[XB_XCNT(b.x)], 1u);
  return b;
}
DI void xcd_barrier_complete(unsigned* bar, unsigned x, unsigned& nloc, unsigned& nx) {
  const unsigned G = gridDim.x * gridDim.y * gridDim.z;
  unsigned sum, cnt, mine, sp = 0u;
  for (;;) {
    sum = 0u; cnt = 0u; mine = 0u;
#pragma unroll
    for (unsigned j = 0; j < 16; ++j) { const unsigned c = xb_ld(&bar[XB_XCNT(j)]); sum += c; cnt += (c > 0u) ? 1u : 0u; mine = (j == x) ? c : mine; }
    if (sum == G) break;
    __builtin_amdgcn_s_sleep(1);
    if ((++sp & 255u) == 0u) { if (xb_ld(&bar[XB_TMO])) break; if (sp > XB_SPIN_CAP) { atomicAdd(&bar[XB_TMO], 1u); break; } }
  }
  nloc = mine > 0u ? mine : 1u; nx = cnt > 0u ? cnt : 1u;
}
DI void xcd_barrier(const XcdBarrier& b) {
  asm volatile("s_waitcnt vmcnt(0)" ::: "memory");
  __syncthreads();
  if (ptid() == 0) {
    unsigned* bar = b.bar;
    __builtin_amdgcn_s_waitcnt(0);
    unsigned nloc = b.st[0], nx = b.st[1];
    if (nloc == 0u) { xcd_barrier_complete(bar, b.x, nloc, nx); b.st[0] = nloc; b.st[1] = nx; }
    const unsigned old = xb_add(&bar[XB_XSUB(b.x)], 1u);
    const unsigned gen = old / nloc;
    if (old + 1u == (gen + 1u) * nloc) {
      __builtin_amdgcn_fence(__ATOMIC_RELEASE, "agent");
      asm volatile("s_waitcnt vmcnt(0)" ::: "memory");
      const unsigned og = xb_add(&bar[XB_TOP], 1u);
      const unsigned tg = og / nx;
      if (og + 1u == (tg + 1u) * nx) xb_add(&bar[XB_TOPGEN], 1u);
      else XB_SPIN(xb_ld(&bar[XB_TOPGEN]) == tg, bar);
      __builtin_amdgcn_fence(__ATOMIC_ACQUIRE, "agent");
      xb_add(&bar[XB_XGEN(b.x)], 1u);
      asm volatile("s_waitcnt vmcnt(0)" ::: "memory");
    } else {
      XB_SPIN(xb_ld(&bar[XB_XGEN(b.x)]) == gen, bar);
      __builtin_amdgcn_fence(__ATOMIC_ACQUIRE, "agent");
      asm volatile("s_waitcnt vmcnt(0)" ::: "memory");
    }
  }
  __syncthreads();
}

__device__ void convert_T(const float* __restrict__ W, int K, int N, bf16_t* __restrict__ Wt, int ldt, char* smem) {
  float* t = (float*)(smem + vhalf() * VSMEM);
  const int tid = tidx(), ntn = N >> 6, nitems = (K >> 6) * ntn;
  const int kr = tid >> 4, c4 = (tid & 15) * 4;
  f32x4 v[4];
  { const int it = vblk() < nitems ? vblk() : 0; const int k0 = (it / ntn) << 6, n0 = (it % ntn) << 6;
#pragma unroll
    for (int i = 0; i < 4; ++i) v[i] = *(const f32x4*)(W + (size_t)(k0 + kr + 16 * i) * N + n0 + c4); }
  for (int it = vblk(); it < nitems; it += vgrid()) {
    const int k0 = (it / ntn) << 6, n0 = (it % ntn) << 6;
    __syncthreads();
#pragma unroll
    for (int i = 0; i < 4; ++i) { const int k = kr + 16 * i; t[k * 65 + c4] = v[i][0]; t[k * 65 + c4 + 1] = v[i][1]; t[k * 65 + c4 + 2] = v[i][2]; t[k * 65 + c4 + 3] = v[i][3]; }
    __syncthreads();
    { const int itn = it + vgrid() < nitems ? it + vgrid() : it; const int k1 = (itn / ntn) << 6, n1 = (itn % ntn) << 6;
#pragma unroll
      for (int i = 0; i < 4; ++i) v[i] = *(const f32x4*)(W + (size_t)(k1 + kr + 16 * i) * N + n1 + c4); }
#pragma unroll
    for (int i = 0; i < 2; ++i) { const int c = tid + 256 * i, n = c >> 3, kc = c & 7; float f[8];
#pragma unroll
      for (int e = 0; e < 8; ++e) f[e] = t[(kc * 8 + e) * 65 + n];
      *(u32x4*)(Wt + (size_t)(n0 + n) * ldt + k0 + kc * 8) = pack8(f); }
  }
}

__device__ void ada_phase(const P& p, char* smem) {
  float* sc = (float*)(smem + vhalf() * VSMEM);
  float* red = sc + 640;
  float* mod = (float*)(p.ws + WS_MOD);
  const int tid = tidx(), kq = tid >> 5, cq = tid & 31;
  for (int it = vblk(); it < 2 * 48 * 8; it += vgrid()) {
    const int l = it / 384, rem = it % 384, nb = rem >> 3, ks = rem & 7;
    const int n0 = nb * 128, k0 = ks * 128;
    __syncthreads();
    for (int e = tid; e < 640; e += NT) { const int i = e >> 7, k = e & 127; const float v = (i == 0) ? p.c_ctx[k0 + k] : p.c[(i - 1) * D + k0 + k]; sc[e] = v * sigmoidf_(v); }
    __syncthreads();
    float acc[5][4];
#pragma unroll
    for (int i = 0; i < 5; ++i)
#pragma unroll
      for (int j = 0; j < 4; ++j) acc[i][j] = 0.f;
    const float* wp = p.ada_w + ((size_t)l * D + k0 + kq * 16) * 6144 + n0 + cq * 4;
#pragma unroll 4
    for (int kk = 0; kk < 16; ++kk) { const float4 w = *(const float4*)(wp + (size_t)kk * 6144);
#pragma unroll
      for (int i = 0; i < 5; ++i) { const float s = sc[i * 128 + kq * 16 + kk]; acc[i][0] += s * w.x; acc[i][1] += s * w.y; acc[i][2] += s * w.z; acc[i][3] += s * w.w; } }
#pragma unroll
    for (int i = 0; i < 5; ++i)
#pragma unroll
      for (int j = 0; j < 4; ++j) red[(kq * 5 + i) * 128 + cq * 4 + j] = acc[i][j];
    __syncthreads();
    for (int e = tid; e < 640; e += NT) { const int i = e >> 7, n = e & 127; float s = 0.f;
#pragma unroll
      for (int q = 0; q < 8; ++q) s += red[(q * 5 + i) * 128 + n];
      if (ks == 0) s += p.ada_b[l * 6144 + n0 + n];
      atomicAdd(mod + ((size_t)l * 5 + i) * 6144 + n0 + n, s); }
  }
}

__device__ void norm_phase(const P& p, const float* xin  , const bf16_t* u  , const float* gpost, const float* modU, int gate_idx,
                           float* xout, const float* gpre, const float* modN, int shift_idx, bf16_t* hout) {
  const int lane = tidx() & 63, wave = tidx() >> 6, nw = NT / 64;
  for (int m = vblk() * nw + wave; m < MT; m += vgrid() * nw) {
    int t, T, mi; tokinfo(m, t, T, mi);
    const float* xr = xin ? xin + (size_t)m * D : (m < MC ? p.x_prompt + (size_t)m * D : p.x_sample + (size_t)(m - MC) * D);
    float4 x[4];
#pragma unroll
    for (int i = 0; i < 4; ++i) x[i] = *(const float4*)(xr + i * 256 + lane * 4);
    if (u) {
      float4 uu[4]; float ss = 0.f;
#pragma unroll
      for (int i = 0; i < 4; ++i) { const u32x2 ur = *(const u32x2*)(u + (size_t)m * D + i * 256 + lane * 4); uu[i] = make_float4(bflo(ur.x), bfhi(ur.x), bflo(ur.y), bfhi(ur.y)); ss += uu[i].x * uu[i].x + uu[i].y * uu[i].y + uu[i].z * uu[i].z + uu[i].w * uu[i].w; }
      ss = wave_sum(ss); const float rs = rsqrtf(ss * (1.f / D) + 1e-6f);
#pragma unroll
      for (int i = 0; i < 4; ++i) { const int c = i * 256 + lane * 4; const float4 g = *(const float4*)(gpost + c); const float4 ga = *(const float4*)(modU + ((size_t)mi * 6 + gate_idx) * D + c);
        x[i].x += ga.x * uu[i].x * rs * g.x; x[i].y += ga.y * uu[i].y * rs * g.y; x[i].z += ga.z * uu[i].z * rs * g.z; x[i].w += ga.w * uu[i].w * rs * g.w; }
    }
    if (xout) {
#pragma unroll
      for (int i = 0; i < 4; ++i) *(float4*)(xout + (size_t)m * D + i * 256 + lane * 4) = x[i];
    }
    if (hout) {
      float ss = 0.f;
#pragma unroll
      for (int i = 0; i < 4; ++i) ss += x[i].x * x[i].x + x[i].y * x[i].y + x[i].z * x[i].z + x[i].w * x[i].w;
      ss = wave_sum(ss); const float rs = rsqrtf(ss * (1.f / D) + 1e-6f);
#pragma unroll
      for (int i = 0; i < 4; ++i) { const int c = i * 256 + lane * 4; const float4 g = *(const float4*)(gpre + c);
        const float4 sh = *(const float4*)(modN + ((size_t)mi * 6 + shift_idx) * D + c); const float4 sc = *(const float4*)(modN + ((size_t)mi * 6 + shift_idx + 1) * D + c);
        u32x2 o; o.x = pack2(x[i].x * rs * g.x * (1.f + sc.x) + sh.x, x[i].y * rs * g.y * (1.f + sc.y) + sh.y); o.y = pack2(x[i].z * rs * g.z * (1.f + sc.z) + sh.z, x[i].w * rs * g.w * (1.f + sc.w) + sh.w);
        *(u32x2*)(hout + (size_t)m * LDH + c) = o; }
    }
  }
}

struct TileSrc { const bf16_t* A; int lda; int arow0; const bf16_t* B; int ldb; int brow0, brow1; int K; };

template <int MM, int NN> DI void zero_acc(f32x4 (&acc)[MM][NN]) {
#pragma unroll
  for (int m = 0; m < MM; ++m)
#pragma unroll
    for (int n = 0; n < NN; ++n) acc[m][n] = (f32x4){0.f, 0.f, 0.f, 0.f};
}

template <int MM, int NN, int KU = 0> struct Gemm {
  static constexpr int NA = MM / 2, NB = NN;
  unsigned oa_[NA], ob_[NB]; const bf16_t* A; const bf16_t* B; int nk; u32x4 ra[NA], rb[NB];
#define GT_LOAD(KT) do { const int kn_ = ((KT) < nk ? (KT) : nk - 1) * 64; \
    _Pragma("unroll") for (int i = 0; i < NA; ++i) ra[i] = *(const u32x4*)(A + (oa_[i] + kn_)); \
    _Pragma("unroll") for (int i = 0; i < NB; ++i) rb[i] = *(const u32x4*)(B + (ob_[i] + kn_)); } while (0)
  DI void begin(const TileSrc& s, const bool perm = false) {
    const int tid = ptid();
#pragma unroll
    for (int i = 0; i < NA; ++i) { const int row = (tid >> 3) + 64 * i, kc = tid & 7;
      int ar = s.arow0 + row; ar = ar < 0 ? 0 : (ar > MT - 1 ? MT - 1 : ar);
      oa_[i] = (unsigned)ar * (unsigned)s.lda + kc * 8; }
#pragma unroll
    for (int i = 0; i < NB; ++i) { const int row = (tid >> 3) + 64 * i, kc = tid & 7;
      const int rr = perm ? ((row & ~31) | (8 * ((row & 15) >> 2) + 4 * ((row >> 4) & 1) + (row & 3))) : row;
      const int br = rr < 32 * NN ? s.brow0 + rr : s.brow1 + rr - 32 * NN;
      ob_[i] = (unsigned)br * (unsigned)s.ldb + kc * 8; }
    A = s.A; B = s.B; nk = s.K >> 6;
    GT_LOAD(0);
  }
  DI void run(f32x4 (&acc)[MM][NN], char* smem) {
    bf16_t* sbase = (bf16_t*)smem;
    const int tid = ptid(), lane = tid & 63, wave = tid >> 6, wr = wave >> 2, wc = wave & 3, fr = lane & 15, fq = lane >> 4;
    int wofs; { const int r = tid >> 3, kc = tid & 7, ob = (r & 15) * 64 + (kc & 3) * 16; wofs = (((r >> 4) * 2 + (kc >> 2)) * 1024 + (ob ^ (((ob >> 9) & 1) << 5))) >> 1; }
    int robase; { const int ob = fr * 64 + fq * 16; robase = (ob ^ (((ob >> 9) & 1) << 5)) >> 1; }
#define GT_STORE(ST) do { bf16_t* sA_ = sbase + (ST) * 32768; bf16_t* sB_ = sA_ + 16384; \
    _Pragma("unroll") for (int i = 0; i < NA; ++i) *(u32x4*)(sA_ + wofs + i * 4096) = ra[i]; \
    _Pragma("unroll") for (int i = 0; i < NB; ++i) *(u32x4*)(sB_ + wofs + i * 4096) = rb[i]; } while (0)
#define GT_KSTEP(ks) do { bf16x8 bfr[NN]; \
      _Pragma("unroll") for (int n = 0; n < NN; ++n) bfr[n] = *(const bf16x8*)(sB_ + ((wc * NN + n) * 2 + (ks)) * 512); \
      _Pragma("unroll") for (int m = 0; m < MM; ++m) { const bf16x8 af = *(const bf16x8*)(sA_ + ((wr * MM + m) * 2 + (ks)) * 512); \
        _Pragma("unroll") for (int n = 0; n < NN; ++n) acc[m][n] = MFMA16(bfr[n], af, acc[m][n]); } } while (0)
#define GT_COMPUTE(ST) do { const bf16_t* sA_ = sbase + (ST) * 32768 + robase; const bf16_t* sB_ = sA_ + 16384; __builtin_amdgcn_s_setprio(1); \
    if (KU) { GT_KSTEP(0); GT_KSTEP(1); } else { _Pragma("unroll 1") for (int ks = 0; ks < 2; ++ks) GT_KSTEP(ks); } \
    __builtin_amdgcn_s_setprio(0); } while (0)
    __syncthreads();
    GT_STORE(0);
    GT_LOAD(1);
    __syncthreads();
#pragma unroll 1
    for (int kt = 0; kt < nk; kt += 2) {
      GT_STORE(1); GT_LOAD(kt + 2); GT_COMPUTE(0); __syncthreads();
      GT_STORE(0); GT_LOAD(kt + 3); GT_COMPUTE(1); __syncthreads();
    }
  }
#undef GT_LOAD
#undef GT_STORE
#undef GT_COMPUTE
#undef GT_KSTEP
};
template <int MM, int NN> DI void gemm_tile(f32x4 (&acc)[MM][NN], const TileSrc& s, char* smem) { Gemm<MM, NN> g; g.begin(s); g.run(acc, smem); }

DI float gelu_tanh(float x) { const float u = 0.7978845608f * (x + 0.044715f * x * x * x); const float e = __expf(2.f * u); const float th = 1.f - 2.f * __builtin_amdgcn_rcpf(e + 1.f); return 0.5f * x * (1.f + th); }

struct TileIter {
  int m_lo, rows, NTn, G, efull, count, e, stride;
  DI void init(int MTn, int NTn_) { const int x = blockIdx.x & 7; m_lo = (x * MTn) >> 3; rows = (((x + 1) * MTn) >> 3) - m_lo; NTn = NTn_; G = (rows + 1) >> 1;
    efull = (rows / G) * G * NTn; count = rows * NTn; e = blockIdx.x >> 3; stride = gridDim.x >> 3; }
  DI bool next(int& mt, int& nt) { if (e >= count) return false;
    if (e < efull) { const int grp = e / (G * NTn), rem = e - grp * G * NTn; nt = rem / G; mt = m_lo + grp * G + (rem - nt * G); }
    else { const int rem = e - efull, gsz = rows - (rows / G) * G; nt = rem / gsz; mt = m_lo + (rows / G) * G + (rem - nt * gsz); }
    e += stride; return true; }
};

__device__ void phase_win(const P& p, int l, char* smem) {
  const bf16_t* H = (const bf16_t*)(p.ws + WS_H); const bf16_t* Wt = (const bf16_t*)(p.ws + WS_WIN);
  bf16_t* zr = (bf16_t*)(p.ws + WS_ZR); bf16_t* zn = (bf16_t*)(p.ws + WS_ZN); bf16_t* zt = (bf16_t*)(p.ws + WS_ZT);
  const int tid = ptid(), lane = tid & 63, wave = tid >> 6, wr = wave >> 2, wc = wave & 3, fr = lane & 15, fq = lane >> 4;
  Gemm<8, 4> gm;
  TileIter ti; ti.init(48, 14);
  const int x = blockIdx.x & 7, nconv = (343 - x + 7) >> 3, nloc = ti.count + nconv;
  const float* cw = p.rwkv_conv + (size_t)l * 3 * NZR;
  for (int e = (int)(blockIdx.x >> 3); e < nloc; e += (int)(gridDim.x >> 3)) {
    f32x4 acc[8][4]; zero_acc<8, 4>(acc);
    if (e < nconv) {
      const int c = x + 8 * e, mt = c / 7, nt = c - mt * 7;
      const int n0 = nt * 256, arow0 = mt * 254 - 1;
      { TileSrc s{H, LDH, arow0, Wt, LDH, n0, n0 + 128, D}; gm.begin(s); }
      gm.run(acc, smem);
      float* sC = (float*)smem;
#pragma unroll 1
      for (int sl = 0; sl < 2; ++sl) {
        __syncthreads();
        if ((wc >> 1) == sl) {
#pragma unroll
          for (int m = 0; m < 8; ++m)
#pragma unroll
            for (int n = 0; n < 4; ++n) *(f32x4*)(sC + (wr * 128 + m * 16 + fr) * 132 + (wc & 1) * 64 + n * 16 + fq * 4) = acc[m][n];
        }
        __syncthreads();
        const int nb = n0 + sl * 128, c8 = (tid & 15) * 8;
        const f32x4 w0a = *(const f32x4*)(cw + nb + c8), w0b = *(const f32x4*)(cw + nb + c8 + 4), w1a = *(const f32x4*)(cw + NZR + nb + c8), w1b = *(const f32x4*)(cw + NZR + nb + c8 + 4),
                    w2a = *(const f32x4*)(cw + 2 * NZR + nb + c8), w2b = *(const f32x4*)(cw + 2 * NZR + nb + c8 + 4);
        const bool sg = nb + c8 >= 1664;
        for (int ee = tid; ee < 254 * 16; ee += NTP) {
          const int tr = 1 + (ee >> 4), g = arow0 + tr;
          if (g < MT) { int t, T, mi; tokinfo(g, t, T, mi);
            const float pm = t > 0 ? 1.f : 0.f, nm = t < T - 1 ? 1.f : 0.f;
            const float* r0 = sC + (tr - 1) * 132 + c8; const float* r1 = r0 + 132; const float* r2 = r1 + 132;
            f32x4 ya = (*(const f32x4*)r0 * w0a) * pm + *(const f32x4*)r1 * w1a + (*(const f32x4*)r2 * w2a) * nm;
            f32x4 yb = (*(const f32x4*)(r0 + 4) * w0b) * pm + *(const f32x4*)(r1 + 4) * w1b + (*(const f32x4*)(r2 + 4) * w2b) * nm;
            if (sg) {
#pragma unroll
              for (int j = 0; j < 4; ++j) { ya[j] = sigmoidf_(ya[j]); yb[j] = sigmoidf_(yb[j]); } }
            const u32x4 o = {pack2(ya[0], ya[1]), pack2(ya[2], ya[3]), pack2(yb[0], yb[1]), pack2(yb[2], yb[3])};
            *(u32x4*)(zr + (size_t)g * NZR + nb + c8) = o; }
        }
      }
    } else {
      int mt, nt; ti.e = e - nconv; ti.next(mt, nt);
      const int n0 = nt * 256, row0 = mt * 256;
      { TileSrc s{H, LDH, row0, Wt, LDH, NZR + n0, NZR + n0 + 128, D}; gm.begin(s, true); }
      gm.run(acc, smem);
#pragma unroll
      for (int m = 0; m < 8; ++m) { const int row = row0 + wr * 128 + m * 16 + fr;
#pragma unroll
        for (int g = 0; g < 2; ++g) { const int col = n0 + wc * 64 + g * 32 + fq * 8; const f32x4 v0 = acc[m][2 * g], v1 = acc[m][2 * g + 1];
          const u32x4 o = {pack2(v0[0], v0[1]), pack2(v0[2], v0[3]), pack2(v1[0], v1[1]), pack2(v1[2], v1[3])};
          if (col < NZN) {
            *(u32x4*)(zn + (size_t)row * NZN + col) = o;
            if (row < MC && col >= 512) { const int part = col - 512, isv = part >> 9, pp = part & 511, hh = pp >> 6, d = pp & 63, b = row >> 8, t = row & 255;
              float* dst = p.out + (isv ? O_V : O_K) + ((((size_t)b * 2 + l) * 8 + hh) * 256 + t) * 64 + d; *(f32x4*)dst = v0; *(f32x4*)(dst + 4) = v1; }
          } else { *(u32x4*)(zt + (size_t)row * LZT + (col - NZN)) = o; }
        } }
    }
  }
}

__device__ void phase_merge(const P& p, char* smem) {
  const bf16_t* H = (const bf16_t*)(p.ws + WS_H); const bf16_t* Wt = (const bf16_t*)(p.ws + WS_WIN); const bf16_t* Wo3 = (const bf16_t*)(p.ws + WS_WO3);
  bf16_t* mg = (bf16_t*)(p.ws + WS_MERGED);
  const int tid = ptid(), lane = tid & 63, wave = tid >> 6, wr = wave >> 2, wc = wave & 3, fr = lane & 15, fq = lane >> 4;
  TileIter ti; int mt, nt; ti.init(64, 8);
  while (ti.next(mt, nt)) {
    const int n0 = nt * 128, row0 = mt * 192;
    f32x4 macc[6][2]; zero_acc<6, 2>(macc);
#pragma unroll 1
    for (int i = 0; i < 3; ++i) {
      const bf16_t* O = (const bf16_t*)(p.ws + (i == 0 ? WS_OA : (i == 1 ? WS_ONA : WS_ORET)));
      f32x4 g[6][2]; zero_acc<6, 2>(g);
      { TileSrc s{H, LDH, row0, Wt, LDH, 5376 + i * 1024 + n0, 5376 + i * 1024 + n0 + 64, D}; { Gemm<6, 2, 1> gm; gm.begin(s, true); gm.run(g, smem); } }
      f32x4 a2[6][2]; zero_acc<6, 2>(a2);
      { TileSrc s{O, LDO, row0, Wo3 + (size_t)i * 1024 * LDO, LDO, n0, n0 + 64, 512}; { Gemm<6, 2, 1> gm; gm.begin(s, true); gm.run(a2, smem); } }
#pragma unroll
      for (int m = 0; m < 6; ++m)
#pragma unroll
        for (int n = 0; n < 2; ++n)
#pragma unroll
          for (int j = 0; j < 4; ++j) macc[m][n][j] += sigmoidf_(g[m][n][j]) * a2[m][n][j];
    }
#pragma unroll
    for (int m = 0; m < 6; ++m) { const int row = row0 + wr * 96 + m * 16 + fr;
      { const int col = n0 + wc * 32 + fq * 8; const u32x4 o = {pack2(macc[m][0][0], macc[m][0][1]), pack2(macc[m][0][2], macc[m][0][3]), pack2(macc[m][1][0], macc[m][1][1]), pack2(macc[m][1][2], macc[m][1][3])}; *(u32x4*)(mg + (size_t)row * LDH + col) = o; } }
  }
}

DI void phase_gemm_f32(const bf16_t* A, int lda, int K, const bf16_t* Bt, int ldb, bf16_t* C, char* smem) {
  const int tid = ptid(), lane = tid & 63, wave = tid >> 6, wr = wave >> 2, wc = wave & 3, fr = lane & 15, fq = lane >> 4;
  TileIter ti; int mt, nt; ti.init(64, 4);
  while (ti.next(mt, nt)) {
    const int n0 = nt * 256, row0 = mt * 192;
    f32x4 acc[6][4]; zero_acc<6, 4>(acc);
    TileSrc s{A, lda, row0, Bt, ldb, n0, n0 + 128, K}; { Gemm<6, 4, GEMM_F32_KU> gm; gm.begin(s, true); gm.run(acc, smem); }
#pragma unroll
    for (int m = 0; m < 6; ++m) { const int row = row0 + wr * 96 + m * 16 + fr;
#pragma unroll
      for (int g = 0; g < 2; ++g) { const f32x4 v0 = acc[m][2 * g], v1 = acc[m][2 * g + 1]; *(u32x4*)(C + (size_t)row * D + n0 + wc * 64 + g * 32 + fq * 8) = (u32x4){pack2(v0[0], v0[1]), pack2(v0[2], v0[3]), pack2(v1[0], v1[1]), pack2(v1[2], v1[3])}; } }
  }
}

__device__ void phase_ffn_up(const P& p, int l, char* smem) {
  const bf16_t* H = (const bf16_t*)(p.ws + WS_H); const bf16_t* Wt = (const bf16_t*)(p.ws + WS_WUP); bf16_t* hid = (bf16_t*)(p.ws + WS_HID);
  const int tid = ptid(), lane = tid & 63, wave = tid >> 6, wr = wave >> 2, wc = wave & 3, fr = lane & 15, fq = lane >> 4;
  const float* cw = p.ffn_conv + (size_t)l * 3 * 2 * FF;
  Gemm<6, 4, FFN_UP_KU> gm;
  for (int it = blockIdx.x; it < 65 * 22; it += gridDim.x) {
    const int mt = it / 22, nt = it - mt * 22;
    const int c0 = nt * 128, arow0 = mt * 190 - 1;
    f32x4 acc[6][4]; zero_acc<6, 4>(acc);
    { TileSrc s{H, LDH, arow0, Wt, LDH, c0, FF + c0, D}; gm.begin(s); }
    gm.run(acc, smem);
    float* sC = (float*)smem;
#pragma unroll 1
    for (int sl = 0; sl < 2; ++sl) {
      __syncthreads();
      if ((wc & 1) == sl) { const int cb = (wc >> 1) * 64;
#pragma unroll
        for (int m = 0; m < 6; ++m)
#pragma unroll
          for (int n = 0; n < 4; ++n) *(f32x4*)(sC + (wr * 96 + m * 16 + fr) * 132 + cb + n * 16 + fq * 4) = acc[m][n];
      }
      __syncthreads();
      const int cq = c0 + sl * 64, c4 = (tid & 15) * 4;
      const f32x4 v0 = *(const f32x4*)(cw + cq + c4), v1 = *(const f32x4*)(cw + 2 * FF + cq + c4), v2 = *(const f32x4*)(cw + 4 * FF + cq + c4);
      const f32x4 g0 = *(const f32x4*)(cw + FF + cq + c4), g1 = *(const f32x4*)(cw + 3 * FF + cq + c4), g2 = *(const f32x4*)(cw + 5 * FF + cq + c4);
      for (int e = tid; e < 190 * 16; e += NTP) {
        const int tr = 1 + (e >> 4), g = arow0 + tr;
        if (g < MT) { int t, T, mi; tokinfo(g, t, T, mi);
          const float pm = t > 0 ? 1.f : 0.f, nm = t < T - 1 ? 1.f : 0.f;
          const f32x4 va = *(const f32x4*)(sC + (tr - 1) * 132 + c4), vb = *(const f32x4*)(sC + tr * 132 + c4), vc = *(const f32x4*)(sC + (tr + 1) * 132 + c4);
          const f32x4 ga = *(const f32x4*)(sC + (tr - 1) * 132 + 64 + c4), gb = *(const f32x4*)(sC + tr * 132 + 64 + c4), gc = *(const f32x4*)(sC + (tr + 1) * 132 + 64 + c4);
          float r[4];
#pragma unroll
          for (int j = 0; j < 4; ++j) { const float val = pm * va[j] * v0[j] + vb[j] * v1[j] + nm * vc[j] * v2[j]; const float gt = pm * ga[j] * g0[j] + gb[j] * g1[j] + nm * gc[j] * g2[j]; r[j] = gelu_tanh(gt) * val; }
          u32x2 o; o.x = pack2(r[0], r[1]); o.y = pack2(r[2], r[3]);
          *(u32x2*)(hid + (size_t)g * FF + cq + c4) = o; }
      }
    }
  }
}

template <int CTRL> DI float dppf(float v) { return __int_as_float(__builtin_amdgcn_mov_dpp(__float_as_int(v), CTRL, 0xF, 0xF, true)); }
DI float row16_sum(float v) { v += dppf<0xB1>(v); v += dppf<0x4E>(v); v += dppf<0x141>(v); v += dppf<0x140>(v); return v; }

DI float frcp(float x) { return __builtin_amdgcn_rcpf(x); }
DI float fsig(float x) { return frcp(1.f + __expf(-x)); }
__device__ void scan_task(const P& p, int l, int seq, int h, int d, int half, char* smem) {
  float* sR = (float*)smem; float* sW = sR + 1024; float* sKD = sW + 1024; float* sB = sKD + 1024; float* sNK = sB + 1024; float* sV = sNK + 1024; float* sK = sV + 1024; float* sY = sK + 1024;
  float* sKn = sY + 2048; float* sKK = sKn + 16; bf16_t* sWT = (bf16_t*)(sKK + 64); bf16_t* sAL = sWT + 16 * LDT;
  const int tid = tidx(), lane = tid & 63, wave = tid >> 6, fr = lane & 15, fq = lane >> 4;
  const int row0 = seq < 32 ? seq * 256 : MC + (seq - 32) * 1024, T = seq < 32 ? 256 : 1024, nch = T >> 4;
  const bf16_t* zr = (const bf16_t*)(p.ws + WS_ZR);
  bf16_t* yout = (bf16_t*)(p.ws + WS_Y) + (size_t)d * MT * 512;
  __syncthreads();
  if (tid < 64) sKK[tid] = p.rwkv_k_k[l * 512 + h * 64 + tid];
  const int cc = wave * 16 + fr, gc = h * 64 + cc;
  bf16x8 bw[2], ba[2];
#pragma unroll
  for (int ks = 0; ks < 2; ++ks)
#pragma unroll
    for (int e = 0; e < 8; ++e) { const int k = ks * 32 + fq * 8 + e;
      bw[ks][e] = (short)f2bf(p.rwkv_w_up[((size_t)(l * 2 + d) * 64 + k) * 512 + gc]); ba[ks][e] = (short)f2bf(p.rwkv_a_up[((size_t)(l * 2 + d) * 64 + k) * 512 + gc]); }
  const float w0c = p.rwkv_w0[(l * 2 + d) * 512 + gc], a0c = p.rwkv_a0[(l * 2 + d) * 512 + gc], kac = p.rwkv_k_a[l * 512 + gc];
  const int rg = tid >> 4, kq = tid & 15, rbase = half * 32 + rg * 2;
  f32x2 S[2][2];
  if (seq >= 32) { const float* s0 = p.state_rwkv + (((((size_t)(seq - 32) * 2 + l) * 2 + d) * 8 + h) * 64 + rbase) * 64 + kq * 4;
#pragma unroll
    for (int r = 0; r < 2; ++r) { const f32x4 x = *(const f32x4*)(s0 + r * 64); S[r][0] = (f32x2){x[0], x[1]}; S[r][1] = (f32x2){x[2], x[3]}; } }
  else {
#pragma unroll
    for (int r = 0; r < 2; ++r) { S[r][0] = (f32x2){0.f, 0.f}; S[r][1] = (f32x2){0.f, 0.f}; } }
  if (seq >= 32) __builtin_amdgcn_s_setprio(2);
  const int at = (tid & 127) >> 3, apart = tid & 7, ahi = tid >> 7;
  size_t coff[3];
  { const int sb0 = ahi ? 512 + h * 64 : h * 64, sb1 = ahi ? 1536 : 1024 + h * 64, sb2 = 1600;
    coff[0] = (size_t)at * NZR + sb0 + apart * 8; coff[1] = (size_t)at * NZR + sb1 + apart * 8; coff[2] = (size_t)at * NZR + sb2 + apart * 8; }
  u32x4 pre[3];
  { const int t0 = (d ? nch - 1 : 0) * 16;
#pragma unroll
    for (int i = 0; i < 3; ++i) pre[i] = *(const u32x4*)(zr + (size_t)(row0 + t0) * NZR + coff[i]); }
  __syncthreads();
  for (int ci = 0; ci < nch; ++ci) {
    const int chunk = d ? nch - 1 - ci : ci, t0 = chunk * 16;
    { const int o = at * 64 + apart * 8; float f[8];
      unpack8(pre[0], f);
      if (ahi == 0) { *(f32x4*)(sR + o) = (f32x4){f[0], f[1], f[2], f[3]}; *(f32x4*)(sR + o + 4) = (f32x4){f[4], f[5], f[6], f[7]}; }
      else { *(f32x4*)(sK + o) = (f32x4){f[0], f[1], f[2], f[3]}; *(f32x4*)(sK + o + 4) = (f32x4){f[4], f[5], f[6], f[7]}; float ps = 0.f;
#pragma unroll
        for (int e = 0; e < 8; ++e) { const float kk = f[e] * sKK[apart * 8 + e]; ps += kk * kk; }
        ps += dppf<0xB1>(ps); ps += dppf<0x4E>(ps); ps += dppf<0x141>(ps);
        if (apart == 0) sKn[at] = ps; }
      unpack8(pre[1], f);
      if (ahi == 0) { *(f32x4*)(sV + o) = (f32x4){f[0], f[1], f[2], f[3]}; *(f32x4*)(sV + o + 4) = (f32x4){f[4], f[5], f[6], f[7]}; }
      else { float g[8];
#pragma unroll
        for (int e = 0; e < 8; ++e) g[e] = 1.f - 2.f * frcp(__expf(2.f * f[e]) + 1.f);
        *(u32x4*)(sWT + at * LDT + apart * 8) = pack8(g); }
      if (ahi == 0) *(u32x4*)(sAL + at * LDT + apart * 8) = pre[2];
    }
    __syncthreads();
    {
      f32x4 aw = {0.f, 0.f, 0.f, 0.f}, aa = {0.f, 0.f, 0.f, 0.f};
#pragma unroll
      for (int ks = 0; ks < 2; ++ks) { const bf16x8 fw = *(const bf16x8*)(sWT + fr * LDT + ks * 32 + fq * 8); const bf16x8 fa = *(const bf16x8*)(sAL + fr * LDT + ks * 32 + fq * 8);
        aw = MFMA16(fw, bw[ks], aw); aa = MFMA16(fa, ba[ks], aa); }
      const float kkc = sKK[cc];
#pragma unroll
      for (int j = 0; j < 4; ++j) { const int t = fq * 4 + j, o = t * 64 + cc;
        const float dec = __expf(-0.6065306597f * fsig(w0c + aw[j]));
        const float a = fsig(a0c + aa[j]);
        const float kv = sK[o];
        const float kkv = kv * kkc * __builtin_amdgcn_rsqf(fmaxf(sKn[t], 1e-24f));
        sW[o] = dec; sKD[o] = kv * (1.f + (a - 1.f) * kac); sB[o] = kkv * a; sNK[o] = -kkv; }
    }
    __syncthreads();
    { const int cn = ci + 1 < nch ? ci + 1 : ci; const int nt0 = (d ? nch - 1 - cn : cn) * 16;
#pragma unroll
      for (int i = 0; i < 3; ++i) pre[i] = *(const u32x4*)(zr + (size_t)(row0 + nt0) * NZR + coff[i]); }
#pragma unroll 8
    for (int si = 0; si < 16; ++si) {
      const int t = d ? 15 - si : si, o = t * 64 + kq * 4;
      const f32x4 an4 = *(const f32x4*)(sNK + o), w4 = *(const f32x4*)(sW + o), b4 = *(const f32x4*)(sB + o), kd4 = *(const f32x4*)(sKD + o), r4 = *(const f32x4*)(sR + o);
      const f32x2 v2 = *(const f32x2*)(sV + t * 64 + rbase);
      const f32x2 an[2] = {{an4[0], an4[1]}, {an4[2], an4[3]}}, wv[2] = {{w4[0], w4[1]}, {w4[2], w4[3]}}, bv[2] = {{b4[0], b4[1]}, {b4[2], b4[3]}}, kd[2] = {{kd4[0], kd4[1]}, {kd4[2], kd4[3]}}, rv[2] = {{r4[0], r4[1]}, {r4[2], r4[3]}};
      float sa[2];
#pragma unroll
      for (int r = 0; r < 2; ++r) { const f32x2 t2 = S[r][0] * an[0] + S[r][1] * an[1]; sa[r] = row16_sum(t2.x + t2.y); }
      f32x2 yv;
#pragma unroll
      for (int r = 0; r < 2; ++r) { const f32x2 sav = {sa[r], sa[r]}, vvv = {v2[r], v2[r]};
        S[r][0] = S[r][0] * wv[0] + (sav * bv[0] + vvv * kd[0]); S[r][1] = S[r][1] * wv[1] + (sav * bv[1] + vvv * kd[1]);
        const f32x2 y2 = S[r][0] * rv[0] + S[r][1] * rv[1]; float yp = y2.x + y2.y; yp += dppf<0xB1>(yp); yp += dppf<0x4E>(yp); yv[r] = yp; }
      if ((kq & 3) == 0) { sY[((t * 32 + rg * 2) * 4) + (kq >> 2)] = yv[0]; sY[((t * 32 + rg * 2 + 1) * 4) + (kq >> 2)] = yv[1]; }
    }
    __syncthreads();
    { const int t = tid >> 4, lr = (tid & 15) * 2; const f32x4 p0 = *(const f32x4*)(sY + (t * 32 + lr) * 4), p1 = *(const f32x4*)(sY + (t * 32 + lr + 1) * 4);
      *(unsigned*)(yout + (size_t)(row0 + t0 + t) * 512 + h * 64 + half * 32 + lr) = pack2(p0[0] + p0[1] + p0[2] + p0[3], p1[0] + p1[1] + p1[2] + p1[3]); }
  }
  __builtin_amdgcn_s_setprio(0);
  if (seq < 32) { float* so = p.out + O_RW + (((((size_t)seq * 2 + l) * 2 + d) * 8 + h) * 64 + rbase) * 64 + kq * 4;
#pragma unroll
    for (int r = 0; r < 2; ++r) *(f32x4*)(so + r * 64) = (f32x4){S[r][0].x, S[r][0].y, S[r][1].x, S[r][1].y}; }
}

DI void qk_scores(const bf16_t* sK, const bf16x8 (&qf)[2], f32x4 (&sacc)[4], int fr, int fq) {
#pragma unroll
  for (int nt = 0; nt < 4; ++nt) { sacc[nt] = (f32x4){0.f, 0.f, 0.f, 0.f};
#pragma unroll
    for (int ks = 0; ks < 2; ++ks) { const bf16x8 kf = *(const bf16x8*)(sK + (nt * 16 + fr) * LDT + ks * 32 + fq * 8); sacc[nt] = MFMA16(kf, qf[ks], sacc[nt]); } }
}
DI void pv_accum(const bf16_t* sVt, const f32x4 (&pacc)[4], f32x4 (&o)[4], int fr, int fq) {
#pragma unroll
  for (int s = 0; s < 2; ++s) {
    bf16x8 pf; { const unsigned a = pack2(pacc[2 * s][0], pacc[2 * s][1]), b = pack2(pacc[2 * s][2], pacc[2 * s][3]), c = pack2(pacc[2 * s + 1][0], pacc[2 * s + 1][1]), dd = pack2(pacc[2 * s + 1][2], pacc[2 * s + 1][3]);
      const u32x4 u = (u32x4){a, b, c, dd}; pf = __builtin_bit_cast(bf16x8, u); }
#pragma unroll
    for (int dt = 0; dt < 4; ++dt) { const u32x2 lo = *(const u32x2*)(sVt + (dt * 16 + fr) * LDT + 32 * s + 4 * fq), hi = *(const u32x2*)(sVt + (dt * 16 + fr) * LDT + 32 * s + 16 + 4 * fq);
      const u32x4 u = (u32x4){lo[0], lo[1], hi[0], hi[1]}; const bf16x8 vf = __builtin_bit_cast(bf16x8, u); o[dt] = MFMA16(vf, pf, o[dt]); }
  }
}
DI void put_kv(bf16_t* sK, bf16_t* sVt, int key, int part, const float (&kf)[8], int vkey, int vpart, const float (&vf)[8]) {
  *(u32x4*)(sK + key * LDT + part * 8) = pack8(kf);
#pragma unroll
  for (int e = 0; e < 8; ++e) sVt[(vpart * 8 + e) * LDT + vkey] = f2bf(vf[e]);
}
DI void softmax_tile(f32x4 (&sacc)[4], f32x4 (&o)[4], float& mrun, float& lrun) {
  float mx = sacc[0][0];
#pragma unroll
  for (int nt = 0; nt < 4; ++nt)
#pragma unroll
    for (int j = 0; j < 4; ++j) mx = fmaxf(mx, sacc[nt][j]);
  mx = fmaxf(mx, shfl_x(mx, 16)); mx = fmaxf(mx, shfl_x(mx, 32));
  const float mnew = fmaxf(mrun, mx), alpha = __builtin_amdgcn_exp2f(mrun - mnew); mrun = mnew;
  float ls = 0.f;
#pragma unroll
  for (int nt = 0; nt < 4; ++nt)
#pragma unroll
    for (int j = 0; j < 4; ++j) { const float pv = __builtin_amdgcn_exp2f(sacc[nt][j] - mnew); sacc[nt][j] = pv; ls += pv; }
  lrun = lrun * alpha + ls;
#pragma unroll
  for (int dt = 0; dt < 4; ++dt) o[dt] *= alpha;
}
constexpr float LOG2E = 1.4426950408889634f;

__device__ void dense_task(const P& p, int b, int h, int qb, char* smem) {
  bf16_t* sK = (bf16_t*)smem; bf16_t* sVt = sK + 64 * LDT;
  const int tid = tidx(), lane = tid & 63, wave = tid >> 6, fr = lane & 15, fq = lane >> 4;
  const bf16_t* zn = (const bf16_t*)(p.ws + WS_ZN); bf16_t* ona = (bf16_t*)(p.ws + WS_ONA);
  const int qrow = b * 256 + qb * 64 + wave * 16 + fr;
  bf16x8 qf[2];
#pragma unroll
  for (int ks = 0; ks < 2; ++ks) qf[ks] = *(const bf16x8*)(zn + (size_t)qrow * NZN + h * 64 + ks * 32 + fq * 8);
  f32x4 o[4]; for (int dt = 0; dt < 4; ++dt) o[dt] = (f32x4){0.f, 0.f, 0.f, 0.f};
  float mrun = -1e30f, lrun = 0.f;
  u32x4 pk[2], pv[2];
#pragma unroll
  for (int i = 0; i < 2; ++i) { const int c = tid + 256 * i, key = c >> 3, part = c & 7, vkey = c & 63, vpart = c >> 6; pk[i] = *(const u32x4*)(zn + (size_t)(b * 256 + key) * NZN + h * 64 + part * 8 + 512); pv[i] = *(const u32x4*)(zn + (size_t)(b * 256 + vkey) * NZN + h * 64 + vpart * 8 + 1024); }
  for (int kt = 0; kt < 4; ++kt) {
    __syncthreads();
#pragma unroll
    for (int i = 0; i < 2; ++i) { const int c = tid + 256 * i, key = c >> 3, part = c & 7, vkey = c & 63, vpart = c >> 6;
      *(u32x4*)(sK + key * LDT + part * 8) = pk[i];
#pragma unroll
      for (int e = 0; e < 4; ++e) { sVt[(vpart * 8 + 2 * e) * LDT + vkey] = (bf16_t)(pv[i][e] & 0xffffu); sVt[(vpart * 8 + 2 * e + 1) * LDT + vkey] = (bf16_t)(pv[i][e] >> 16); } }
    __syncthreads();
    { const int kn = kt < 3 ? kt + 1 : 3;
#pragma unroll
      for (int i = 0; i < 2; ++i) { const int c = tid + 256 * i, key = c >> 3, part = c & 7, vkey = c & 63, vpart = c >> 6; pk[i] = *(const u32x4*)(zn + (size_t)(b * 256 + kn * 64 + key) * NZN + h * 64 + part * 8 + 512); pv[i] = *(const u32x4*)(zn + (size_t)(b * 256 + kn * 64 + vkey) * NZN + h * 64 + vpart * 8 + 1024); } }
    f32x4 sacc[4]; qk_scores(sK, qf, sacc, fr, fq);
#pragma unroll
    for (int nt = 0; nt < 4; ++nt) sacc[nt] *= (0.125f * LOG2E);
    softmax_tile(sacc, o, mrun, lrun);
    pv_accum(sVt, sacc, o, fr, fq);
  }
  lrun += shfl_x(lrun, 16); lrun += shfl_x(lrun, 32); const float inv = 1.f / lrun;
#pragma unroll
  for (int dt = 0; dt < 4; ++dt) { u32x2 ov; ov.x = pack2(o[dt][0] * inv, o[dt][1] * inv); ov.y = pack2(o[dt][2] * inv, o[dt][3] * inv); *(u32x2*)(ona + (size_t)qrow * LDO + h * 64 + dt * 16 + fq * 4) = ov; }
}

__device__ void na_task(const P& p, int l, int b, int h, int r, char* smem) {
  bf16_t* sK = (bf16_t*)smem; bf16_t* sVt = sK + 64 * LDT; float* sRpb = (float*)(sVt + 64 * LDT);
  const int tid = tidx(), lane = tid & 63, wave = tid >> 6, fr = lane & 15, fq = lane >> 4;
  const bf16_t* zn = (const bf16_t*)(p.ws + WS_ZN); bf16_t* ona = (bf16_t*)(p.ws + WS_ONA);
  const int base = MC + b * 1024, qcol = wave * 16 + fr, qrow = base + r * 64 + qcol;
  int rs = r - 4; rs = rs < 0 ? 0 : (rs > 8 ? 8 : rs);
  int cs = qcol - 8; cs = cs < 0 ? 0 : (cs > 48 ? 48 : cs);
  __syncthreads();
  for (int e = tid; e < 465; e += NT) sRpb[e] = p.na_rpb[((size_t)l * 8 + h) * 465 + e] * LOG2E;
  bf16x8 qf[2];
#pragma unroll
  for (int ks = 0; ks < 2; ++ks) qf[ks] = *(const bf16x8*)(zn + (size_t)qrow * NZN + h * 64 + ks * 32 + fq * 8);
  f32x4 o[4]; for (int dt = 0; dt < 4; ++dt) o[dt] = (f32x4){0.f, 0.f, 0.f, 0.f};
  float mrun = -1e30f, lrun = 0.f;
  u32x4 pre[8];
#define NA_ISSUE(KT) do { const int kt_ = (KT); \
    if (kt_ < 8) { _Pragma("unroll") for (int i = 0; i < 2; ++i) { const int c = tid + 256 * i, key = c >> 3, part = c & 7, vkey = c & 63, vpart = c >> 6; \
        pre[4 * i] = *(const u32x4*)(zn + (size_t)(base + (rs + kt_) * 64 + key) * NZN + h * 64 + part * 8 + 512); pre[4 * i + 1] = *(const u32x4*)(zn + (size_t)(base + (rs + kt_) * 64 + vkey) * NZN + h * 64 + vpart * 8 + 1024); } } \
    else { _Pragma("unroll") for (int i = 0; i < 2; ++i) { const int c = tid + 256 * i, key = c >> 3, part = c & 7, vkey = c & 63, vpart = c >> 6; const size_t cb_ = (((size_t)b * 2 + l) * 8 + h) * 256 + (kt_ - 8) * 64; const size_t co = (cb_ + key) * 64 + part * 8, cv = (cb_ + vkey) * 64 + vpart * 8; \
        pre[4 * i] = *(const u32x4*)(p.cache_k + co); pre[4 * i + 1] = *(const u32x4*)(p.cache_k + co + 4); pre[4 * i + 2] = *(const u32x4*)(p.cache_v + cv); pre[4 * i + 3] = *(const u32x4*)(p.cache_v + cv + 4); } } } while (0)
  NA_ISSUE(0);
  for (int kt = 0; kt < 12; ++kt) {
    __syncthreads();
    if (kt < 8) {
#pragma unroll
      for (int i = 0; i < 2; ++i) { const int c = tid + 256 * i, key = c >> 3, part = c & 7, vkey = c & 63, vpart = c >> 6;
        *(u32x4*)(sK + key * LDT + part * 8) = pre[4 * i];
#pragma unroll
        for (int e = 0; e < 4; ++e) { sVt[(vpart * 8 + 2 * e) * LDT + vkey] = (bf16_t)(pre[4 * i + 1][e] & 0xffffu); sVt[(vpart * 8 + 2 * e + 1) * LDT + vkey] = (bf16_t)(pre[4 * i + 1][e] >> 16); } }
    } else {
#pragma unroll
      for (int i = 0; i < 2; ++i) { const int c = tid + 256 * i, key = c >> 3, part = c & 7, vkey = c & 63, vpart = c >> 6;
        const f32x4 k0 = __builtin_bit_cast(f32x4, pre[4 * i]), k1 = __builtin_bit_cast(f32x4, pre[4 * i + 1]), v0 = __builtin_bit_cast(f32x4, pre[4 * i + 2]), v1 = __builtin_bit_cast(f32x4, pre[4 * i + 3]);
        const float kf[8] = {k0[0], k0[1], k0[2], k0[3], k1[0], k1[1], k1[2], k1[3]}; const float vf[8] = {v0[0], v0[1], v0[2], v0[3], v1[0], v1[1], v1[2], v1[3]};
        put_kv(sK, sVt, key, part, kf, vkey, vpart, vf); }
    }
    __syncthreads();
    NA_ISSUE(kt < 11 ? kt + 1 : 11);
    f32x4 sacc[4]; qk_scores(sK, qf, sacc, fr, fq);
    if (kt < 8) { const int dr = rs + kt - r + 7;
#pragma unroll
      for (int nt = 0; nt < 4; ++nt)
#pragma unroll
        for (int j = 0; j < 4; ++j) { const int kc = nt * 16 + fq * 4 + j; const bool valid = kc >= cs && kc < cs + 16; int dc = kc - qcol; dc = dc < -15 ? -15 : (dc > 15 ? 15 : dc);
          sacc[nt][j] = valid ? sacc[nt][j] * (0.125f * LOG2E) + sRpb[dr * 31 + dc + 15] : -1e30f; }
    } else {
#pragma unroll
      for (int nt = 0; nt < 4; ++nt) sacc[nt] *= (0.125f * LOG2E);
    }
    softmax_tile(sacc, o, mrun, lrun);
    pv_accum(sVt, sacc, o, fr, fq);
  }
#undef NA_ISSUE
  lrun += shfl_x(lrun, 16); lrun += shfl_x(lrun, 32); const float inv = 1.f / lrun;
#pragma unroll
  for (int dt = 0; dt < 4; ++dt) { u32x2 ov; ov.x = pack2(o[dt][0] * inv, o[dt][1] * inv); ov.y = pack2(o[dt][2] * inv, o[dt][3] * inv); *(u32x2*)(ona + (size_t)qrow * LDO + h * 64 + dt * 16 + fq * 4) = ov; }
}

DI void rope8(const float (&own)[8], const float (&par)[8], int part, int n, float (&out)[8]) {
  const float pos = (float)((part >> 2) ? (n & 63) : (n >> 6));
  const bool isx2 = (part & 3) >= 2;
#pragma unroll
  for (int e = 0; e < 8; ++e) { const int i = (part & 1) * 8 + e; const float ang = pos * __builtin_amdgcn_exp2f(-(float)i * 0.830482023721841f); const float sn = __sinf(ang), cs = __cosf(ang);
    out[e] = isx2 ? par[e] * sn + own[e] * cs : own[e] * cs - par[e] * sn; }
}

DI void rope8t(const float (&own)[8], const float (&par)[8], int part, int n, const float* tab, float (&out)[8]) {
  const int pos = (part >> 2) ? (n & 63) : (n >> 6);
  const bool isx2 = (part & 3) >= 2;
  const float* tb = tab + (pos * 16 + (part & 1) * 8) * 2;
#pragma unroll
  for (int e = 0; e < 8; e += 2) { const f32x4 cssn = *(const f32x4*)(tb + 2 * e);
    out[e] = isx2 ? par[e] * cssn[1] + own[e] * cssn[0] : own[e] * cssn[0] - par[e] * cssn[1];
    out[e + 1] = isx2 ? par[e + 1] * cssn[3] + own[e + 1] * cssn[2] : own[e + 1] * cssn[2] - par[e + 1] * cssn[3]; }
}

__device__ void ret_task(const P& p, int l, int seq, int h, int qb, char* smem) {
  bf16_t* sK = (bf16_t*)smem; bf16_t* sVt = sK + 64 * LDT; bf16_t* sQ = sVt + 64 * LDT; float* sRope = (float*)(sQ + 64 * LDT);
  const int tid = tidx(), lane = tid & 63, wave = tid >> 6, fr = lane & 15, fq = lane >> 4;
  const bf16_t* zt = (const bf16_t*)(p.ws + WS_ZT); bf16_t* oret = (bf16_t*)(p.ws + WS_ORET);
  const bool lat = seq >= 32;
  const int row0 = lat ? MC + (seq - 32) * 1024 : seq * 256, T = lat ? 1024 : 256, nkt = T >> 6;
  const float xf = p.ret_decay[(l * 2 + 0) * 8 + h], xb = p.ret_decay[(l * 2 + 1) * 8 + h];
  const float lgf = -log1pf(__expf(-xf)) * LOG2E, lgb = -log1pf(__expf(-xb)) * LOG2E;
  __syncthreads();
  if (lat) {
#pragma unroll
    for (int j = 0; j < 4; ++j) { const int e = tid + 256 * j; const float ang = (float)(e >> 4) * __builtin_amdgcn_exp2f(-(float)(e & 15) * 0.830482023721841f); sRope[2 * e] = __cosf(ang); sRope[2 * e + 1] = __sinf(ang); }
    __syncthreads();
  }
#pragma unroll
  for (int i = 0; i < 2; ++i) { const int c = tid + 256 * i, qi = c >> 3, part = c & 7; const int n = qb * 64 + qi; const size_t ro = (size_t)(row0 + n) * LZT + h * 64;
    const u32x4 own = *(const u32x4*)(zt + ro + part * 8);
    if (lat) { const u32x4 par = *(const u32x4*)(zt + ro + (part ^ 2) * 8); float fo[8], fp[8], out[8]; unpack8(own, fo); unpack8(par, fp); rope8t(fo, fp, part, n, sRope, out); *(u32x4*)(sQ + qi * LDT + part * 8) = pack8(out); }
    else *(u32x4*)(sQ + qi * LDT + part * 8) = own; }
  __syncthreads();
  const int qi = wave * 16 + fr, nq = qb * 64 + qi;
  bf16x8 qf[2];
#pragma unroll
  for (int ks = 0; ks < 2; ++ks) qf[ks] = *(const bf16x8*)(sQ + qi * LDT + ks * 32 + fq * 8);
  f32x4 o[4]; for (int dt = 0; dt < 4; ++dt) o[dt] = (f32x4){0.f, 0.f, 0.f, 0.f};
  u32x4 rk[2], rp[2], rv[2];
#define RET_ISSUE(KT) do { _Pragma("unroll") for (int i = 0; i < 2; ++i) { const int c = tid + 256 * i, key = c >> 3, part = c & 7, vkey = c & 63, vpart = c >> 6; const size_t ro = (size_t)(row0 + (KT) * 64 + key) * LZT + h * 64; \
    rk[i] = *(const u32x4*)(zt + ro + 512 + part * 8); rp[i] = *(const u32x4*)(zt + ro + 512 + (part ^ 2) * 8); rv[i] = *(const u32x4*)(zt + (size_t)(row0 + (KT) * 64 + vkey) * LZT + h * 64 + 1024 + vpart * 8); } } while (0)
  RET_ISSUE(0);
  for (int kt = 0; kt < nkt; ++kt) {
    __syncthreads();
#pragma unroll
    for (int i = 0; i < 2; ++i) { const int c = tid + 256 * i, key = c >> 3, part = c & 7, vkey = c & 63, vpart = c >> 6; const int n = kt * 64 + key;
      float kf[8]; unpack8(rk[i], kf);
      if (lat) { float fp[8], out[8]; unpack8(rp[i], fp); rope8t(kf, fp, part, n, sRope, out);
#pragma unroll
        for (int e = 0; e < 8; ++e) kf[e] = out[e]; }
#pragma unroll
      for (int e = 0; e < 8; ++e) kf[e] *= 0.125f;
      *(u32x4*)(sK + key * LDT + part * 8) = pack8(kf);
#pragma unroll
      for (int e = 0; e < 4; ++e) { sVt[(vpart * 8 + 2 * e) * LDT + vkey] = (bf16_t)(rv[i][e] & 0xffffu); sVt[(vpart * 8 + 2 * e + 1) * LDT + vkey] = (bf16_t)(rv[i][e] >> 16); } }
    __syncthreads();
    RET_ISSUE(kt + 1 < nkt ? kt + 1 : kt);
    f32x4 sacc[4]; qk_scores(sK, qf, sacc, fr, fq);
#pragma unroll
    for (int nt = 0; nt < 4; ++nt)
#pragma unroll
      for (int j = 0; j < 4; ++j) { const int mk = kt * 64 + nt * 16 + fq * 4 + j; const int df = nq - mk;
        const float ex = __builtin_amdgcn_exp2f((df > 0 ? lgf : -lgb) * (float)df); sacc[nt][j] *= (df == 0 ? 2.f : ex); }
    pv_accum(sVt, sacc, o, fr, fq);
  }
#undef RET_ISSUE
  if (lat) {
    for (int dir = 0; dir < 2; ++dir) {
      __syncthreads();
      const float* s0 = p.state_ret + ((((size_t)(seq - 32) * 2 + l) * 2 + dir) * 8 + h) * 4096;
#pragma unroll
      for (int i = 0; i < 2; ++i) { const int c = tid + 256 * i, dk = c & 63, part = c >> 6; const float4 a = *(const float4*)(s0 + dk * 64 + part * 8), bq = *(const float4*)(s0 + dk * 64 + part * 8 + 4);
        const float vf[8] = {a.x, a.y, a.z, a.w, bq.x, bq.y, bq.z, bq.w};
#pragma unroll
        for (int e = 0; e < 8; ++e) sVt[(part * 8 + e) * LDT + dk] = f2bf(vf[e]); }
      __syncthreads();
      const float xi = dir == 0 ? exp2f(lgf * (float)(nq + 1)) : exp2f(lgb * (float)(T - nq));
      f32x4 pacc[4];
#pragma unroll
      for (int s = 0; s < 2; ++s)
#pragma unroll
        for (int hh = 0; hh < 2; ++hh)
#pragma unroll
          for (int j = 0; j < 4; ++j) pacc[2 * s + hh][j] = xi * bf2f(sQ[qi * LDT + 32 * s + 16 * hh + 4 * fq + j]);
      pv_accum(sVt, pacc, o, fr, fq);
    }
  }
  float s1 = 0.f;
#pragma unroll
  for (int dt = 0; dt < 4; ++dt)
#pragma unroll
    for (int j = 0; j < 4; ++j) s1 += o[dt][j];
  s1 += shfl_x(s1, 16); s1 += shfl_x(s1, 32); const float mu = s1 * (1.f / 64.f);
  float s2 = 0.f;
#pragma unroll
  for (int dt = 0; dt < 4; ++dt)
#pragma unroll
    for (int j = 0; j < 4; ++j) { const float dlt = o[dt][j] - mu; s2 += dlt * dlt; }
  s2 += shfl_x(s2, 16); s2 += shfl_x(s2, 32); const float rstd = rsqrtf(s2 * (1.f / 64.f) + 1e-5f);
  const size_t qrow = (size_t)(row0 + nq);
#pragma unroll
  for (int dt = 0; dt < 4; ++dt) { const int dv = h * 64 + dt * 16 + fq * 4; const u32x2 gr = *(const u32x2*)(zt + qrow * LZT + 1536 + dv); const float4 gn = *(const float4*)(p.ret_gn + l * 512 + dv);
    const float g0 = bflo(gr.x), g1 = bfhi(gr.x), g2 = bflo(gr.y), g3 = bfhi(gr.y);
    u32x2 ov; ov.x = pack2((o[dt][0] - mu) * rstd * gn.x * g0 * sigmoidf_(g0), (o[dt][1] - mu) * rstd * gn.y * g1 * sigmoidf_(g1));
    ov.y = pack2((o[dt][2] - mu) * rstd * gn.z * g2 * sigmoidf_(g2), (o[dt][3] - mu) * rstd * gn.w * g3 * sigmoidf_(g3));
    *(u32x2*)(oret + qrow * LDO + dv) = ov; }
}

__device__ void retstate_task(const P& p, int l, int b, int h, char* smem) {
  float* sKf = (float*)smem; float* sKb = sKf + 64 * 64; float* sV = sKb + 64 * 64;
  const int tid = tidx(), dk = tid >> 2, dq = tid & 3;
  const bf16_t* zt = (const bf16_t*)(p.ws + WS_ZT);
  const float xf = p.ret_decay[(l * 2 + 0) * 8 + h], xb = p.ret_decay[(l * 2 + 1) * 8 + h];
  const float lgf = -log1pf(__expf(-xf)) * LOG2E, lgb = -log1pf(__expf(-xb)) * LOG2E;
  float af[16], ab[16];
#pragma unroll
  for (int i = 0; i < 16; ++i) { af[i] = 0.f; ab[i] = 0.f; }
  for (int kt = 0; kt < 4; ++kt) {
    __syncthreads();
#pragma unroll
    for (int i = 0; i < 2; ++i) { const int c = tid + 256 * i, key = c >> 3, part = c & 7, m = kt * 64 + key; const size_t ro = (size_t)(b * 256 + m) * LZT + h * 64 + part * 8;
      float kf[8], vf[8]; unpack8(*(const u32x4*)(zt + ro + 512), kf); unpack8(*(const u32x4*)(zt + ro + 1024), vf);
      const float wf = 0.125f * exp2f(lgf * (float)(255 - m)), wb = 0.125f * exp2f(lgb * (float)m);
#pragma unroll
      for (int e = 0; e < 8; ++e) { sKf[key * 64 + part * 8 + e] = kf[e] * wf; sKb[key * 64 + part * 8 + e] = kf[e] * wb; sV[key * 64 + part * 8 + e] = vf[e]; } }
    __syncthreads();
    for (int m = 0; m < 64; ++m) { const float kf = sKf[m * 64 + dk], kb = sKb[m * 64 + dk];
#pragma unroll
      for (int i = 0; i < 4; ++i) { const f32x4 vv = *(const f32x4*)(sV + m * 64 + dq * 16 + i * 4);
#pragma unroll
        for (int j = 0; j < 4; ++j) { af[i * 4 + j] += kf * vv[j]; ab[i * 4 + j] += kb * vv[j]; } } }
  }
  float* of = p.out + O_RT + ((((size_t)b * 2 + l) * 2 + 0) * 8 + h) * 4096 + dk * 64 + dq * 16; float* ob = of + 8 * 4096;
#pragma unroll
  for (int i = 0; i < 16; ++i) { of[i] = af[i]; ob[i] = ab[i]; }
}

constexpr int Q_SCAN_L = 64, Q_SCAN_C = 512, Q_RET_L = 256, Q_NA = 256, Q_DENSE = 512, Q_RET_C = 512, Q_RST = 128;
template <int QMASK> __device__ void phase_mixers(const P& p, int l, char* smem_, int rep = 0) {
  __shared__ int s_task;
  int* ctr = (int*)(p.ws + WS_CTRL) + 64 * (l + 1) + 4 * rep;
  const int vb = vhalf(); char* smem = smem_ + vb * VSMEM;
  if (QMASK & 1) for (;;) {
    __syncthreads();
    if (ptid() == 0) s_task = atomicAdd(ctr, 1);
    __syncthreads();
    const int tk = s_task;
    if (tk >= Q_SCAN_L + Q_SCAN_C) break;
    const bool lat = tk < Q_SCAN_L; const int t2 = lat ? tk : tk - Q_SCAN_L;
    scan_task(p, l, (lat ? 32 : 0) + (t2 >> 4), (t2 >> 1) & 7, t2 & 1, vb, smem);
  }
  if (QMASK & 2) for (;;) {
    __syncthreads();
    if (ptid() == 0) s_task = atomicAdd(ctr + 16, 1);
    __syncthreads();
    const int tk = s_task;
    if (tk >= Q_RET_L + Q_RET_C) break;
    if (tk < Q_RET_L) ret_task(p, l, 32 + (tk >> 6), (tk >> 3) & 7, (tk & 7) * 2 + vb, smem);
    else { const int t2 = tk - Q_RET_L; ret_task(p, l, t2 >> 4, (t2 >> 1) & 7, (t2 & 1) * 2 + vb, smem); }
  }
  if (QMASK & 4) for (;;) {
    __syncthreads();
    if (ptid() == 0) s_task = atomicAdd(ctr + 32, 1);
    __syncthreads();
    int tk = s_task;
    if (tk >= Q_NA + Q_DENSE + Q_RST) break;
    if (tk < Q_NA) { na_task(p, l, tk >> 6, (tk >> 3) & 7, (tk & 7) * 2 + vb, smem); continue; } tk -= Q_NA;
    if (tk < Q_DENSE) { dense_task(p, tk >> 4, (tk >> 1) & 7, (tk & 1) * 2 + vb, smem); continue; } tk -= Q_DENSE;
    retstate_task(p, l, tk >> 2, (tk & 3) * 2 + vb, smem);
  }
}

__device__ void phase_rwkv_post(const P& p, int l, char* smem) {
  const bf16_t* zr = (const bf16_t*)(p.ws + WS_ZR); const bf16_t* yf = (const bf16_t*)(p.ws + WS_Y); const bf16_t* yb = yf + (size_t)MT * 512; bf16_t* oa = (bf16_t*)(p.ws + WS_OA);
  const bf16_t* Gt = (const bf16_t*)(p.ws + WS_WG);
  const int tid = ptid(), lane = tid & 63, wave = tid >> 6, wr = wave >> 2, wc = wave & 3, fr = lane & 15, fq = lane >> 4;
  TileIter ti; int mt, nt; ti.init(96, 2);
  while (ti.next(mt, nt)) {
    const int row0 = mt * 128, n0 = nt * 256;
    f32x4 acc[4][4]; zero_acc<4, 4>(acc);
    TileSrc s{zr + 1664, NZR, row0, Gt, LDG, n0, n0 + 128, 128}; { Gemm<4, 4, 1> gm; gm.begin(s, true); gm.run(acc, smem); }
    const int cb = n0 + wc * 64 + fq * 8;
#pragma unroll
    for (int m = 0; m < 4; ++m) { const size_t row = (size_t)(row0 + wr * 64 + m * 16 + fr);
      f32x4 y[4]; float s1 = 0.f, rk = 0.f; f32x4 vv[4];
#pragma unroll
      for (int n = 0; n < 4; ++n) { const int c = cb + 32 * (n >> 1) + 4 * (n & 1); { const u32x2 ya = *(const u32x2*)(yf + row * 512 + c), yc = *(const u32x2*)(yb + row * 512 + c); y[n] = (f32x4){bflo(ya.x) + bflo(yc.x), bfhi(ya.x) + bfhi(yc.x), bflo(ya.y) + bflo(yc.y), bfhi(ya.y) + bfhi(yc.y)}; } s1 += y[n][0] + y[n][1] + y[n][2] + y[n][3];
        const u32x2 rr = *(const u32x2*)(zr + row * NZR + c), kk = *(const u32x2*)(zr + row * NZR + 512 + c), v2 = *(const u32x2*)(zr + row * NZR + 1024 + c); const f32x4 rkw = *(const f32x4*)(p.rwkv_r_k + l * 512 + c);
        rk += bflo(rr.x) * bflo(kk.x) * rkw[0] + bfhi(rr.x) * bfhi(kk.x) * rkw[1] + bflo(rr.y) * bflo(kk.y) * rkw[2] + bfhi(rr.y) * bfhi(kk.y) * rkw[3];
        vv[n] = (f32x4){bflo(v2.x), bfhi(v2.x), bflo(v2.y), bfhi(v2.y)}; }
      s1 += shfl_x(s1, 16); s1 += shfl_x(s1, 32); rk += shfl_x(rk, 16); rk += shfl_x(rk, 32);
      const float mu = s1 * (1.f / 64.f); float s2 = 0.f;
#pragma unroll
      for (int n = 0; n < 4; ++n)
#pragma unroll
        for (int j = 0; j < 4; ++j) { const float dl = y[n][j] - mu; s2 += dl * dl; }
      s2 += shfl_x(s2, 16); s2 += shfl_x(s2, 32); const float rstd = rsqrtf(s2 * (1.f / 64.f) + 64e-5f);
#pragma unroll
      for (int n = 0; n < 4; ++n) { const int c = cb + 32 * (n >> 1) + 4 * (n & 1); const f32x4 lg = *(const f32x4*)(p.rwkv_ln_g + l * 512 + c), lb = *(const f32x4*)(p.rwkv_ln_b + l * 512 + c);
        float o[4];
#pragma unroll
        for (int j = 0; j < 4; ++j) o[j] = ((y[n][j] - mu) * rstd * lg[j] + lb[j] + rk * vv[n][j]) * acc[m][n][j];
        u32x2 ov; ov.x = pack2(o[0], o[1]); ov.y = pack2(o[2], o[3]); *(u32x2*)(oa + row * LDO + c) = ov; }
    }
  }
}

DI void convert_layer_a(const P& p, int l, char* smem) {
  convert_T(p.w_in + (size_t)l * D * INC, D, INC, (bf16_t*)(p.ws + WS_WIN), LDH, smem);
  convert_T(p.w_o_rwkv + (size_t)l * 512 * D, 512, D, (bf16_t*)(p.ws + WS_WO3), LDO, smem);
  convert_T(p.w_o_na + (size_t)l * 512 * D, 512, D, (bf16_t*)(p.ws + WS_WO3) + (size_t)1024 * LDO, LDO, smem);
  convert_T(p.w_o_ret + (size_t)l * 512 * D, 512, D, (bf16_t*)(p.ws + WS_WO3) + (size_t)2 * 1024 * LDO, LDO, smem);
  convert_T(p.w_out + (size_t)l * D * D, D, D, (bf16_t*)(p.ws + WS_WOUT), LDH, smem);
  convert_T(p.rwkv_g_up + (size_t)l * 128 * 512, 128, 512, (bf16_t*)(p.ws + WS_WG), LDG, smem);
}
DI void convert_layer_b(const P& p, int l, char* smem) {
  convert_T(p.ffn_up + (size_t)l * D * 2 * FF, D, 2 * FF, (bf16_t*)(p.ws + WS_WUP), LDH, smem);
  convert_T(p.ffn_down + (size_t)l * FF * D, FF, D, (bf16_t*)(p.ws + WS_WDN), FF, smem);
}

typedef __attribute__((address_space(4))) const P* KP;
DI KP kargs() { KP k = (KP)__builtin_amdgcn_kernarg_segment_ptr(); asm volatile("" : "+s"(k)); return k; }
template <int PH> DI void run_phase(int l, char* smem) {
#if defined(__HIP_DEVICE_COMPILE__)
  const P p = *kargs();
#else
  const P p{};
#endif
  const float* mod = (const float*)(p.ws + WS_MOD);
  float* xbuf = p.out;
  if (PH == 0) { ada_phase(p, smem); convert_layer_a(p, 0, smem); }
  else if (PH == 1) { norm_phase(p, nullptr, nullptr, nullptr, nullptr, 0, nullptr, p.norm_mix_pre, mod, 0, (bf16_t*)(p.ws + WS_H)); }
  else if (PH == 2) phase_win(p, l, smem);
  else if (PH == 4) phase_mixers<7>(p, l, smem);
  else if (PH == 5) phase_rwkv_post(p, l, smem);
  else if (PH == 6) phase_merge(p, smem);
  else if (PH == 7) { phase_gemm_f32((const bf16_t*)(p.ws + WS_MERGED), LDH, D, (const bf16_t*)(p.ws + WS_WOUT), LDH, (bf16_t*)(p.ws + WS_U), smem); }
  else if (PH == 8) { convert_layer_b(p, l, smem);
    norm_phase(p, l == 0 ? nullptr : xbuf, (const bf16_t*)(p.ws + WS_U), p.norm_mix_post + l * D, mod + (size_t)l * 5 * 6144, 2, xbuf, p.norm_ffn_pre + l * D, mod + (size_t)l * 5 * 6144, 3, (bf16_t*)(p.ws + WS_H)); }
  else if (PH == 9) phase_ffn_up(p, l, smem);
  else if (PH == 11) { phase_gemm_f32((const bf16_t*)(p.ws + WS_HID), FF, FF, (const bf16_t*)(p.ws + WS_WDN), FF, (bf16_t*)(p.ws + WS_F), smem); }
  else if (PH == 12) {
    if (l == 0) { norm_phase(p, xbuf, (const bf16_t*)(p.ws + WS_F), p.norm_ffn_post, mod, 5, xbuf, p.norm_mix_pre + D, mod + (size_t)5 * 6144, 0, (bf16_t*)(p.ws + WS_H)); convert_layer_a(p, 1, smem); }
    else norm_phase(p, xbuf, (const bf16_t*)(p.ws + WS_F), p.norm_ffn_post + D, mod + (size_t)5 * 6144, 5, xbuf, nullptr, nullptr, 0, nullptr);
  }
}

#if MEGA
__global__ void __launch_bounds__(NTP, 1) mega_kernel(P p_) {
  extern __shared__ __attribute__((aligned(16))) char smem[];
  __shared__ u32x4 xb_words;
  cg::grid_group grid = cg::this_grid();
  if (ptid() == 0) xb_words = (u32x4){0u, 0u, 0u, 0u};
  __syncthreads();
#if defined(__HIP_DEVICE_COMPILE__)
  (void)xcd_barrier_post((unsigned*)(p_.ws + WS_BAR), (volatile LAS unsigned*)&xb_words);
#define GSYNC() do { XcdBarrier xb_; xb_.bar = (unsigned*)(kargs()->ws + WS_BAR); xb_.x = xb_xcc_id(); xb_.st = (volatile LAS unsigned*)&xb_words; xcd_barrier(xb_); } while (0)
#else
#define GSYNC() do { } while (0)
#endif
  run_phase<0>(0, smem); grid.sync();
  run_phase<1>(0, smem); GSYNC();
#pragma unroll
  for (int l = 0; l < 2; ++l) {
    run_phase<2>(l, smem); GSYNC();
    if (PROBE_MASK & 1) { run_phase<2>(l, smem); GSYNC(); }
    run_phase<4>(l, smem); GSYNC();
    run_phase<5>(l, smem); GSYNC();
    run_phase<6>(l, smem); GSYNC();
    if (PROBE_MASK & 8) { run_phase<6>(l, smem); GSYNC(); }
    run_phase<7>(l, smem); GSYNC();
    if (PROBE_MASK & 16) { run_phase<7>(l, smem); GSYNC(); }
    run_phase<8>(l, smem); GSYNC();
    run_phase<9>(l, smem); GSYNC();
    if (PROBE_MASK & 32) { run_phase<9>(l, smem); GSYNC(); }
    run_phase<11>(l, smem); GSYNC();
    if (PROBE_MASK & 64) { run_phase<11>(l, smem); GSYNC(); }
    run_phase<12>(l, smem); if (l == 0) GSYNC();
  }
#undef GSYNC
}
#else
template <int PH> __global__ void __launch_bounds__(NTP, 1) phase_kernel(P p, int l) {
  extern __shared__ __attribute__((aligned(16))) char smem[];
  run_phase<PH>(l, smem);
}
#endif

extern "C" void kernel_launch(void* const* d_in, const int* in_sizes, int n_in, void* d_out, int out_size, void* d_ws, size_t ws_size, hipStream_t stream) {
  if (ws_size < WS_END || n_in < 36) { fprintf(stderr, "workspace too small: %zu < %zu\n", ws_size, (size_t)WS_END); return; }
  P p{};
  const float** pp = (const float**)&p;
  for (int i = 0; i < 36; ++i) pp[i] = (const float*)d_in[i];
  p.out = (float*)d_out; p.ws = (char*)d_ws;
  hipMemsetAsync(d_ws, 0, WS_WIN, stream);
#if MEGA
  static int grid_blocks = 0;
  if (!grid_blocks) {
    int dev = 0, cus = 0, per_cu = 0; hipGetDevice(&dev);
    hipDeviceGetAttribute(&cus, hipDeviceAttributeMultiprocessorCount, dev);
    hipFuncSetAttribute((const void*)mega_kernel, hipFuncAttributeMaxDynamicSharedMemorySize, SMEM_BYTES);
    hipOccupancyMaxActiveBlocksPerMultiprocessor(&per_cu, mega_kernel, NTP, SMEM_BYTES);
    if (per_cu > 1) per_cu = 1;
    grid_blocks = cus * per_cu;
  }
  void* args[] = {&p};
  hipError_t e = hipLaunchCooperativeKernel((void*)mega_kernel, dim3(grid_blocks), dim3(NTP), args, SMEM_BYTES, stream);
  if (e != hipSuccess) fprintf(stderr, "cooperative launch failed: %s (grid %d)\n", hipGetErrorString(e), grid_blocks);
#else
  const int G = 512;
#define LAUNCH(PH, L) do { hipFuncSetAttribute((const void*)phase_kernel<PH>, hipFuncAttributeMaxDynamicSharedMemorySize, SMEM_BYTES); phase_kernel<PH><<<G, NT, SMEM_BYTES, stream>>>(p, L); } while (0)
  LAUNCH(0, 0); LAUNCH(1, 0);
  for (int l = 0; l < 2; ++l) { LAUNCH(2, l); LAUNCH(4, l); LAUNCH(5, l); LAUNCH(6, l); LAUNCH(7, l); LAUNCH(8, l); LAUNCH(9, l); LAUNCH(11, l); LAUNCH(12, l); }
#endif
}
```
